# Optimizing an MI355X kernel written in HIP

```python
import math
import jax
import jax.numpy as jnp
from jax import lax
import numpy as np

D_MODEL = 1024
BATCH = 8
SEQ = 2048
DEPTH = 2

MEM_LEN = 256
EPS = 1e-6

HY_C = D_MODEL // 2
HY_ORDER = 2
HY_SHORT = 3
FILT_BANDS = 16
FILT_EMB = 2 * FILT_BANDS + 1
FILT_HIDDEN = 64
DECAY_TARGET = 1e-2
FAST_DECAY_PCT = 0.3
SLOW_DECAY_PCT = 1.5
MOD_SHIFT = 0.05

AT_GROUPS = ((128, 1), (512, 4), (2048, 16))
AT_HEADS = 4
AT_HD = D_MODEL // 8
AT_W = len(AT_GROUPS) * AT_HEADS * AT_HD
AT_OUT = AT_HEADS * AT_HD
NUM_BUCKETS = 32
REL_MAX_DIST = 1024
NEG_INF = -1e30

XA_HEADS = 4
XA_HD = D_MODEL // 8
XA_W = XA_HEADS * XA_HD

D_FF = 2816
N_EXPERTS = 8
TOP_K = 2
MOE_BLOCK = 256

kernel_name = 'hybrid_hyena_dilated_moe_encoder'


def rmsnorm(x, g):
    xf = x.astype(jnp.float32)
    y = xf * lax.rsqrt(jnp.mean(xf * xf, axis=-1, keepdims=True) + EPS)
    return (y * g.astype(jnp.float32)).astype(x.dtype)


def rel_bucket(rel):
    half = NUM_BUCKETS // 2
    exact = half // 2
    n = np.abs(rel)
    large = exact + (np.log(np.maximum(n, 1) / exact) / np.log(REL_MAX_DIST / exact) * (half - exact)).astype(np.int32)
    large = np.minimum(large, half - 1)
    return (np.where(rel > 0, half, 0) + np.where(n < exact, n, large)).astype(np.int32)


def implicit_filters(L, w1, b1, w2, b2, w3, freq):
    t = jnp.linspace(0.0, 1.0, L, dtype=jnp.float32)[:, None]
    f = jnp.linspace(1e-4, FILT_BANDS - 1, FILT_BANDS, dtype=jnp.float32)[None]
    ang = (2.0 * math.pi / L) * jnp.arange(L, dtype=jnp.float32)[:, None] * f
    feats = jnp.concatenate([t, jnp.cos(ang), -jnp.sin(ang)], axis=-1)
    fr = freq.astype(jnp.float32)
    h = jnp.sin(fr * (feats @ w1.astype(jnp.float32) + b1.astype(jnp.float32)))
    h = jnp.sin(fr * (h @ w2.astype(jnp.float32) + b2.astype(jnp.float32)))
    h = (h @ w3.astype(jnp.float32)).reshape(L, HY_ORDER, 2, HY_C)
    deltas = jnp.abs(jnp.linspace(math.log(DECAY_TARGET) / SLOW_DECAY_PCT,
                                  math.log(DECAY_TARGET) / FAST_DECAY_PCT, HY_C, dtype=jnp.float32))
    h = h * (jnp.exp(-t[:, :, None, None] * deltas) + MOD_SHIFT)
    fwd = h[:, :, 0]
    bwd = h[1:, :, 1][::-1]
    filt = jnp.concatenate([fwd, jnp.zeros((1, HY_ORDER, HY_C), jnp.float32), bwd], axis=0)
    filt = filt / (jnp.sum(jnp.abs(filt), axis=0, keepdims=True) + 1e-6)
    return jnp.fft.rfft(filt, axis=0)


def fftconv(u, filt_f, skip):
    L = u.shape[1]
    uf = jnp.fft.rfft(u.astype(jnp.float32), n=2 * L, axis=1)
    y = jnp.fft.irfft(uf * filt_f[None], n=2 * L, axis=1)[:, :L]
    return y + u.astype(jnp.float32) * skip.astype(jnp.float32)


def hyena(u, conv_w, conv_b, filt_f, skip):
    pad = HY_SHORT // 2
    up = jnp.pad(u, ((0, 0), (pad, pad), (0, 0)))
    S = u.shape[1]
    uc = conv_b.astype(jnp.float32) + sum(up[:, j:j + S].astype(jnp.float32) * conv_w[j].astype(jnp.float32)
                                          for j in range(HY_SHORT))
    chunks = jnp.split(uc, HY_ORDER + 1, axis=-1)
    z = chunks[0]
    for o in range(HY_ORDER):
        z = chunks[o + 1] * fftconv(z, filt_f[:, o], skip[o])
    return z


def head_rms(t, g):
    tf = t.astype(jnp.float32)
    return tf * lax.rsqrt(jnp.mean(tf * tf, axis=-1, keepdims=True) + EPS) * g.astype(jnp.float32)


def dilated_group(q, k, v, window, dil, bias_table):
    B, S, H, HD = q.shape
    band = window // (2 * dil)
    L = S // dil
    nb = -(-L // band)
    Lp = nb * band

    def to_sub(t):
        return t.reshape(B, L, dil, H, HD).transpose(0, 2, 3, 1, 4)

    def key_blocks(t):
        tp = jnp.pad(to_sub(t), ((0, 0), (0, 0), (0, 0), (band, Lp - L + band), (0, 0)))
        tp = tp.reshape(B, dil, H, nb + 2, band, HD)
        return jnp.concatenate([tp[:, :, :, :-2], tp[:, :, :, 1:-1], tp[:, :, :, 2:]], axis=4)

    qb = jnp.pad(to_sub(q), ((0, 0), (0, 0), (0, 0), (0, Lp - L), (0, 0))).reshape(B, dil, H, nb, band, HD)
    kb = key_blocks(k)
    vb = key_blocks(v)
    rel = np.arange(3 * band)[None, :] - band - np.arange(band)[:, None]
    key_idx = np.arange(nb)[:, None] * band + np.arange(3 * band)[None, :] - band
    mask = (np.abs(rel) <= band)[None] & ((key_idx >= 0) & (key_idx < L))[:, None, :]
    bias = jnp.moveaxis(bias_table[rel_bucket(rel * dil)], -1, 0).astype(jnp.float32)
    s = jnp.einsum('brhnqd,brhnkd->brhnqk', qb, kb, preferred_element_type=jnp.float32) * (HD ** -0.5)
    s = jnp.where(mask, s + bias[None, None, :, None], NEG_INF)
    m = jnp.max(s, axis=-1, keepdims=True)
    p = jnp.exp(s - m)
    z = jnp.sum(p, axis=-1, keepdims=True)
    o = jnp.einsum('brhnqk,brhnkd->brhnqd', p, vb.astype(jnp.float32)) / z
    lse = (m + jnp.log(z))[..., 0]
    o = o.reshape(B, dil, H, Lp, HD)[:, :, :, :L].transpose(0, 3, 1, 2, 4).reshape(B, S, H, HD)
    lse = lse.reshape(B, dil, H, Lp)[..., :L].transpose(0, 3, 1, 2).reshape(B, S, H)
    return o, lse


def dilated_attention(qkv, q_gain, k_gain, rel_bias):
    B, S, _ = qkv.shape
    t = qkv.reshape(B, S, 3, len(AT_GROUPS), AT_HEADS, AT_HD)
    q = head_rms(t[:, :, 0], q_gain).astype(qkv.dtype)
    k = head_rms(t[:, :, 1], k_gain).astype(qkv.dtype)
    v = t[:, :, 2]
    outs, lses = [], []
    for g, (window, dil) in enumerate(AT_GROUPS):
        o, lse = dilated_group(q[:, :, g], k[:, :, g], v[:, :, g], window, dil,
                               rel_bias[:, g * AT_HEADS:(g + 1) * AT_HEADS])
        outs.append(o)
        lses.append(lse)
    w = jax.nn.softmax(jnp.stack(lses), axis=0)
    o = jnp.sum(w[..., None] * jnp.stack(outs), axis=0)
    return o.reshape(B, S, AT_OUT)


def cross_attention(xq, m, w_kv, q_gain, k_gain):
    B, S, _ = xq.shape
    M = m.shape[1]
    q = head_rms(xq.reshape(B, S, XA_HEADS, XA_HD), q_gain)
    kv = (m @ w_kv).reshape(B, M, 2, XA_HEADS, XA_HD)
    k = head_rms(kv[:, :, 0], k_gain)
    v = kv[:, :, 1].astype(jnp.float32)
    s = jnp.einsum('bshd,bmhd->bhsm', q, k) * (XA_HD ** -0.5)
    p = jax.nn.softmax(s, axis=-1)
    return jnp.einsum('bhsm,bmhd->bshd', p, v).reshape(B, S, XA_W)


def swiglu(h, wg, wu, wd):
    return (jax.nn.silu(h @ wg) * (h @ wu)) @ wd


def moe_swiglu(h, router, wg, wu, wd):
    B, S, D = h.shape
    T = B * S
    A = T * TOP_K
    hf = h.reshape(T, D)
    logits = jnp.dot(hf, router, preferred_element_type=jnp.float32)
    top_v, top_i = lax.top_k(logits, TOP_K)
    gates = jax.nn.softmax(top_v, axis=-1).reshape(A)
    expert = top_i.reshape(A)
    token = jnp.repeat(jnp.arange(T, dtype=jnp.int32), TOP_K)
    order = jnp.argsort(expert)
    e_s, tok_s, g_s = expert[order], token[order], gates[order]
    counts = jnp.bincount(expert, length=N_EXPERTS)
    padded = (counts + MOE_BLOCK - 1) // MOE_BLOCK * MOE_BLOCK
    start = jnp.cumsum(counts) - counts
    pend = jnp.cumsum(padded)
    pstart = pend - padded
    dest = pstart[e_s] + jnp.arange(A, dtype=jnp.int32) - start[e_s]
    P = A + N_EXPERTS * MOE_BLOCK
    nblk = P // MOE_BLOCK
    buf_tok = jnp.zeros((P,), jnp.int32).at[dest].set(tok_s)
    buf_gate = jnp.zeros((P,), jnp.float32).at[dest].set(g_s)
    blk_expert = jnp.minimum(jnp.searchsorted(pend, jnp.arange(nblk, dtype=jnp.int32) * MOE_BLOCK, side='right'),
                             N_EXPERTS - 1)
    xb = hf[buf_tok].reshape(nblk, MOE_BLOCK, D)

    def expert_block(args):
        xe, e = args
        return (jax.nn.silu(xe @ wg[e]) * (xe @ wu[e])) @ wd[e]

    yb = lax.map(expert_block, (xb, blk_expert)).reshape(P, D)
    out = jnp.zeros((T, D), jnp.float32).at[buf_tok].add(yb.astype(jnp.float32) * buf_gate[:, None])
    return out.reshape(B, S, D).astype(h.dtype)


def setup_inputs(seed: int = 0) -> dict:
    key = jax.random.key(seed)
    ks = iter(jax.random.split(key, 32))
    NHY = (DEPTH + 1) // 2
    NAT = DEPTH // 2

    def nrm(shape, scale):
        return jax.random.normal(next(ks), shape, jnp.float32) * scale

    def gain(shape):
        return 1.0 + nrm(shape, 0.02)

    return {
        'x': nrm((BATCH, SEQ, D_MODEL), 1.0),
        'mem': nrm((BATCH, MEM_LEN, D_MODEL), 1.0),
        'rel_bias': nrm((NUM_BUCKETS, len(AT_GROUPS) * AT_HEADS), 0.5),
        'norm_mix': gain((DEPTH, D_MODEL)),
        'norm_mem': gain((DEPTH, D_MODEL)),
        'norm_ffn': gain((DEPTH, D_MODEL)),
        'w_mem_kv': nrm((DEPTH, D_MODEL, 2 * XA_W), D_MODEL ** -0.5),
        'xq_norm': gain((DEPTH, XA_HD)),
        'xk_norm': gain((DEPTH, XA_HD)),
        'w_out': nrm((DEPTH, D_MODEL, D_MODEL), D_MODEL ** -0.5),
        'hy_w_in': nrm((NHY, D_MODEL, (HY_ORDER + 1) * HY_C + XA_W), D_MODEL ** -0.5),
        'hy_conv_w': nrm((NHY, HY_SHORT, (HY_ORDER + 1) * HY_C), HY_SHORT ** -0.5),
        'hy_conv_b': nrm((NHY, (HY_ORDER + 1) * HY_C), 0.02),
        'hy_filt_w1': nrm((NHY, FILT_EMB, FILT_HIDDEN), FILT_EMB ** -0.5),
        'hy_filt_b1': nrm((NHY, FILT_HIDDEN), 0.1),
        'hy_filt_w2': nrm((NHY, FILT_HIDDEN, FILT_HIDDEN), FILT_HIDDEN ** -0.5),
        'hy_filt_b2': nrm((NHY, FILT_HIDDEN), 0.1),
        'hy_filt_w3': nrm((NHY, FILT_HIDDEN, HY_ORDER * 2 * HY_C), FILT_HIDDEN ** -0.5),
        'hy_sin_freq': 1.0 + nrm((NHY, FILT_HIDDEN), 0.1),
        'hy_skip': nrm((NHY, HY_ORDER, HY_C), 1.0),
        'at_w_in': nrm((NAT, D_MODEL, 3 * AT_W + XA_W), D_MODEL ** -0.5),
        'at_q_norm': gain((NAT, AT_HD)),
        'at_k_norm': gain((NAT, AT_HD)),
        'ffn_w_gate': nrm((NHY, D_MODEL, D_FF), D_MODEL ** -0.5),
        'ffn_w_up': nrm((NHY, D_MODEL, D_FF), D_MODEL ** -0.5),
        'ffn_w_down': nrm((NHY, D_FF, D_MODEL), D_FF ** -0.5),
        'moe_router': nrm((NAT, D_MODEL, N_EXPERTS), D_MODEL ** -0.5),
        'moe_w_gate': nrm((NAT, N_EXPERTS, D_MODEL, D_FF), D_MODEL ** -0.5),
        'moe_w_up': nrm((NAT, N_EXPERTS, D_MODEL, D_FF), D_MODEL ** -0.5),
        'moe_w_down': nrm((NAT, N_EXPERTS, D_FF, D_MODEL), D_FF ** -0.5),
    }


def reference(x, mem, rel_bias, norm_mix, norm_mem, norm_ffn, w_mem_kv, xq_norm, xk_norm, w_out,
              hy_w_in, hy_conv_w, hy_conv_b, hy_filt_w1, hy_filt_b1, hy_filt_w2, hy_filt_b2, hy_filt_w3,
              hy_sin_freq, hy_skip, at_w_in, at_q_norm, at_k_norm, ffn_w_gate, ffn_w_up, ffn_w_down,
              moe_router, moe_w_gate, moe_w_up, moe_w_down):
    S = x.shape[1]
    for i in range(DEPTH):
        j = i // 2
        h = rmsnorm(x, norm_mix[i])
        m = rmsnorm(mem, norm_mem[i])
        if i % 2 == 0:
            z = h @ hy_w_in[j]
            filt_f = implicit_filters(S, hy_filt_w1[j], hy_filt_b1[j], hy_filt_w2[j], hy_filt_b2[j],
                                      hy_filt_w3[j], hy_sin_freq[j])
            self_out = hyena(z[..., :(HY_ORDER + 1) * HY_C], hy_conv_w[j], hy_conv_b[j], filt_f, hy_skip[j])
            xq = z[..., (HY_ORDER + 1) * HY_C:]
        else:
            z = h @ at_w_in[j]
            self_out = dilated_attention(z[..., :3 * AT_W], at_q_norm[j], at_k_norm[j], rel_bias)
            xq = z[..., 3 * AT_W:]
        cross = cross_attention(xq, m, w_mem_kv[i], xq_norm[i], xk_norm[i])
        mixed = jnp.concatenate([self_out, cross], axis=-1).astype(x.dtype)
        x = x + mixed @ w_out[i]
        hf = rmsnorm(x, norm_ffn[i])
        if i % 2 == 0:
            x = x + swiglu(hf, ffn_w_gate[j], ffn_w_up[j], ffn_w_down[j])
        else:
            x = x + moe_swiglu(hf, moe_router[j], moe_w_gate[j], moe_w_up[j], moe_w_down[j])
    return x
```

```cpp
#include <hip/hip_runtime.h>
#include <cstdio>
#include <cstdint>

namespace pg8 {
#define PG8_LAS __attribute__((address_space(3)))
typedef unsigned short bf16_t;
typedef short bf16x8 __attribute__((ext_vector_type(8)));
typedef float f32x4 __attribute__((ext_vector_type(4)));
typedef unsigned u32x4 __attribute__((ext_vector_type(4)));
constexpr int BM = 256, BK = 64, HALF = 128, HTB = HALF * BK * 2  , STAGE_BYTES = 8 * HTB, NXCD = 8, WGM = 8;

__host__ __device__ __forceinline__ int lds_byte(int r, int c) { const int st = (r >> 4) * 2 + (c >> 5), rr = r & 15, cc = c & 31, ob = rr * 64 + cc * 2; return st * 1024 + (ob ^ (((ob >> 9) & 1) << 5)); }
__host__ __device__ __forceinline__ void stage_rc(int b, int& R, int& C) { const int st = b / 1024, sb = b % 1024, swz = sb ^ (((sb >> 9) & 1) << 5); R = (st >> 1) * 16 + swz / 64; C = (st & 1) * 32 + (swz % 64) / 2; }
__host__ __device__ __forceinline__ int perm32(int rho) { const int n = rho >> 4, i = rho & 15; return 8 * (i >> 2) + 4 * n + (i & 3); }

struct Unit { int pm, pn, e, koff, idx; };
struct Gemm { const bf16_t* A; const bf16_t* Bt; int lda, ldb, K; size_t estride; };

struct StaticOrder {
    int nM, nN, nwg, G, c;
    __device__ __forceinline__ int gather_row(const Unit&, int slot) const { return slot; }
    __host__ __device__ void init(int nM_, int nN_, int G_, int c_) { nM = nM_; nN = nN_; nwg = nM * nN; G = G_; c = c_; }
    __host__ __device__ bool next(int i, Unit& u) const {
        const long L = (long)i * G + c; if (L >= nwg) return false;
        int wgid = (int)L; { const int q = nwg / NXCD, r = nwg % NXCD, xcd = wgid % NXCD, off = wgid / NXCD; wgid = (xcd < r ? xcd * (q + 1) : r * (q + 1) + (xcd - r) * q) + off; }
        const int nig = WGM * nN, gid = wgid / nig, fm = gid * WGM, gsz = (nM - fm) < WGM ? (nM - fm) : WGM;
        u.pm = fm + ((wgid % nig) % gsz); u.pn = (wgid % nig) / gsz; u.e = 0; u.koff = 0; return true;
    }
};
struct MoeOrder : StaticOrder {
    int t0, t1, t2, t3, t4, t5, t6;
    const volatile PG8_LAS int* lay;
    const int* list;
    __device__ __forceinline__ int gather_row(const Unit& u, int slot) const { const int rank = slot - lay[40 + u.e]; return rank < lay[32 + u.e] ? list[(size_t)u.e * 16384 + rank] : 0; }
    __host__ __device__ bool next(int i, Unit& u) const {
        if (!StaticOrder::next(i, u)) return false;
        const int p = u.pm; u.e = (p >= t0) + (p >= t1) + (p >= t2) + (p >= t3) + (p >= t4) + (p >= t5) + (p >= t6); return true;
    }
};

struct MoeTailOrder {
    int pm0, ntail, nN, G, c, khalf; int t0, t1, t2, t3, t4, t5, t6;
    __device__ __forceinline__ int gather_row(const Unit&, int slot) const { return slot; }
    __device__ __forceinline__ bool next(int i, Unit& u) const {
        const int L = i * G + c; if (L >= ntail * nN * 2) return false;
        const int kh = L & 1, q = L >> 1; u.pn = q % nN; u.pm = pm0 + q / nN; u.koff = kh * khalf;
        const int p = u.pm; u.e = (p >= t0) + (p >= t1) + (p >= t2) + (p >= t3) + (p >= t4) + (p >= t5) + (p >= t6); return true;
    }
};
__device__ __forceinline__ unsigned cvt_pk_bf16(float lo, float hi) { unsigned r; asm volatile("v_cvt_pk_bf16_f32 %0, %1, %2" : "=v"(r) : "v"(lo), "v"(hi)); return r; }

template <class Epi, class Sched, bool ALIGN_EPI, bool GATHER = false>
__device__ __forceinline__ void gemm_phase(PG8_LAS unsigned char* lds, const Gemm g, const Sched& S, const Epi& E, const int wid) {
    int lane = (int)__builtin_amdgcn_mbcnt_hi(~0u, __builtin_amdgcn_mbcnt_lo(~0u, 0u)); asm volatile("" : "+v"(lane));
    const int tid = wid * 64 + lane, wr = wid >> 2, wc = wid & 3, fr = lane & 15, fq = lane >> 4;
    const int K = g.K, nt = K / BK;
    unsigned cvo[4], nvo[4], voffB[2]; int rowA[2], colA[2];
#pragma unroll
    for (int i = 0; i < 2; ++i) { int R, C; stage_rc(tid * 16 + i * 8192, R, C); const int Rb = (R & ~31) + perm32(R & 31); rowA[i] = R; colA[i] = C;
        voffB[i] = (unsigned)(Rb * g.ldb + C) * 2u; }
    const size_t kstep = (size_t)(BK * 2);
    const size_t hstepB = (size_t)HALF * g.ldb * 2;
    const size_t tstepA = GATHER ? (size_t)0 : (size_t)2 * HALF * g.lda * 2, tstepB = 2 * hstepB;
#define PG8_ROWOFFS(vo, u) do { _Pragma("unroll") for (int _h = 0; _h < 2; ++_h) _Pragma("unroll") for (int _i = 0; _i < 2; ++_i) { \
        const int _r = _h * HALF + rowA[_i]; const unsigned _row = GATHER ? (unsigned)S.gather_row(u, (u).pm * BM + _r) : (unsigned)_r; \
        (vo)[2 * _h + _i] = (_row * (unsigned)g.lda + (unsigned)colA[_i]) * 2u; } } while (0)
    const unsigned ldsw = (unsigned)wid * 1024u;
    const int aoff = lds_byte(wr * 64 + fr, fq * 8), boff = lds_byte(wc * 32 + fr, fq * 8);
#define PG8_SA(b, h) (((b) * 2 + (h)) * HTB)
#define PG8_SB(b, h) ((4 + (b) * 2 + (h)) * HTB)
#define PG8_STAGE(bufoff, gbase, voff) do { _Pragma("unroll") for (int _i = 0; _i < 2; ++_i) \
        __builtin_amdgcn_global_load_lds((const unsigned*)((const char*)(gbase) + (voff)[_i]), (PG8_LAS unsigned*)(lds + (bufoff) + ldsw + _i * 8192), 16, 0, 0); } while (0)
#define PG8_STAGEA(bufoff, gbase, vo, h) do { _Pragma("unroll") for (int _i = 0; _i < 2; ++_i) \
        __builtin_amdgcn_global_load_lds((const unsigned*)((const char*)(gbase) + (vo)[2 * (h) + _i]), (PG8_LAS unsigned*)(lds + (bufoff) + ldsw + _i * 8192), 16, 0, 0); } while (0)
#define PG8_LDA(dst, b, h) do { _Pragma("unroll") for (int m = 0; m < 4; ++m) _Pragma("unroll") for (int k = 0; k < 2; ++k) dst[m][k] = *(const PG8_LAS bf16x8*)(lds + PG8_SA(b, h) + aoff + m * 2048 + k * 1024); } while (0)
#define PG8_LDB(dst, b, h) do { _Pragma("unroll") for (int n = 0; n < 2; ++n) _Pragma("unroll") for (int k = 0; k < 2; ++k) dst[n][k] = *(const PG8_LAS bf16x8*)(lds + PG8_SB(b, h) + boff + n * 2048 + k * 1024); } while (0)
#define PG8_MMA(ai, bj, At, Bt) do { __builtin_amdgcn_s_setprio(1); _Pragma("unroll") for (int m = 0; m < 4; ++m) _Pragma("unroll") for (int n = 0; n < 2; ++n) _Pragma("unroll") for (int k = 0; k < 2; ++k) \
        acc[ai][bj][m][n] = __builtin_amdgcn_mfma_f32_16x16x32_bf16(Bt[n][k], At[m][k], acc[ai][bj][m][n], 0, 0, 0); __builtin_amdgcn_s_setprio(0); } while (0)
#define PG8_WAIT_V(n) asm volatile("s_waitcnt vmcnt(" #n ")" ::: "memory")
#define PG8_WAIT_L(n) asm volatile("s_waitcnt lgkmcnt(" #n ")" ::: "memory")
#define PG8_BAR __builtin_amdgcn_s_barrier()
#define PG8_SCHED __builtin_amdgcn_sched_barrier(0)
    Unit cur, nxt; int ui = 0;
    if (!S.next(0, cur)) return;
    cur.idx = 0;
    f32x4 acc[2][2][4][2];
#pragma unroll
    for (int a = 0; a < 2; ++a)
#pragma unroll
        for (int b = 0; b < 2; ++b)
#pragma unroll
            for (int m = 0; m < 4; ++m)
#pragma unroll
                for (int n = 0; n < 2; ++n) acc[a][b][m][n] = (f32x4){0.f, 0.f, 0.f, 0.f};
    bf16x8 At[4][2], B0[2][2], B1[2][2];
    const char* cA = (const char*)g.A + (size_t)cur.pm * tstepA + cur.koff; const char* cB = (const char*)g.Bt + (size_t)cur.e * g.estride + (size_t)cur.pn * tstepB + cur.koff;
    PG8_ROWOFFS(cvo, cur);
#pragma unroll
    for (int i = 0; i < 4; ++i) nvo[i] = cvo[i];
    PG8_STAGE(PG8_SB(0, 0), cB, voffB); PG8_STAGE(PG8_SB(0, 1), cB + hstepB, voffB); PG8_STAGEA(PG8_SA(0, 0), cA, cvo, 0); PG8_STAGEA(PG8_SA(0, 1), cA, cvo, 1);
    if (wr == 1) PG8_BAR;
    PG8_WAIT_V(2); PG8_BAR;
    PG8_STAGE(PG8_SB(1, 0), cB + kstep, voffB); PG8_STAGEA(PG8_SA(1, 0), cA + kstep, cvo, 0); PG8_STAGE(PG8_SB(1, 1), cB + hstepB + kstep, voffB);
    PG8_WAIT_V(6); PG8_BAR;
    for (;;) {
        const bool has_next = S.next(ui + 1, nxt); nxt.idx = ui + 1;
        const char* nA = has_next ? (const char*)g.A + (size_t)nxt.pm * tstepA + nxt.koff : cA;
        const char* nB = has_next ? (const char*)g.Bt + (size_t)nxt.e * g.estride + (size_t)nxt.pn * tstepB + nxt.koff : cB;
        if constexpr (GATHER) { if (has_next) PG8_ROWOFFS(nvo, nxt); }
        for (int t = 0; t < nt; t += 2) {
            const bool last = (t == nt - 2);
            const char* a1 = cA + (size_t)(t + 1) * kstep;
            const char* a2 = last ? nA : cA + (size_t)(t + 2) * kstep; const char* b2 = last ? nB : cB + (size_t)(t + 2) * kstep;
            const char* a3 = a2 + kstep; const char* b3 = b2 + kstep;
            unsigned vo2[4];
#pragma unroll
            for (int i = 0; i < 4; ++i) vo2[i] = (GATHER && last) ? nvo[i] : cvo[i];
            PG8_LDB(B0, 0, 0); PG8_LDB(B1, 0, 1); PG8_SCHED; PG8_LDA(At, 0, 0); PG8_STAGEA(PG8_SA(1, 1), a1, cvo, 1);
            PG8_WAIT_V(8); PG8_WAIT_L(0); PG8_BAR; PG8_MMA(0, 0, At, B0); PG8_MMA(0, 1, At, B1); PG8_BAR; PG8_SCHED;
            PG8_LDA(At, 0, 1); PG8_STAGE(PG8_SB(0, 0), b2, voffB); PG8_STAGE(PG8_SB(0, 1), b2 + hstepB, voffB); PG8_STAGEA(PG8_SA(0, 0), a2, vo2, 0);
            PG8_WAIT_V(8); PG8_WAIT_L(0); PG8_BAR; PG8_MMA(1, 0, At, B0); PG8_MMA(1, 1, At, B1); PG8_BAR; PG8_SCHED;
            PG8_LDB(B0, 1, 0); PG8_LDB(B1, 1, 1); PG8_SCHED; PG8_LDA(At, 1, 0); PG8_STAGEA(PG8_SA(0, 1), a2, vo2, 1);
            PG8_WAIT_V(8); PG8_WAIT_L(0); PG8_BAR; PG8_MMA(0, 0, At, B0); PG8_MMA(0, 1, At, B1); PG8_BAR; PG8_SCHED;
            PG8_LDA(At, 1, 1); PG8_STAGE(PG8_SB(1, 0), b3, voffB); PG8_STAGE(PG8_SB(1, 1), b3 + hstepB, voffB); PG8_STAGEA(PG8_SA(1, 0), a3, vo2, 0);
            PG8_WAIT_V(8); PG8_WAIT_L(0); PG8_BAR; PG8_MMA(1, 0, At, B0); PG8_MMA(1, 1, At, B1); PG8_BAR; PG8_SCHED;
        }
        if constexpr (ALIGN_EPI) { if (wr == 0) PG8_BAR; }
        E(acc, cur, wr, wc, fr, fq);
        if (!has_next) break;
#pragma unroll
        for (int a = 0; a < 2; ++a)
#pragma unroll
            for (int b = 0; b < 2; ++b)
#pragma unroll
                for (int m = 0; m < 4; ++m)
#pragma unroll
                    for (int n = 0; n < 2; ++n) acc[a][b][m][n] = (f32x4){0.f, 0.f, 0.f, 0.f};
        cur = nxt; cA = nA; cB = nB; ++ui;
        if constexpr (GATHER) {
#pragma unroll
            for (int i = 0; i < 4; ++i) cvo[i] = nvo[i]; }
        if constexpr (ALIGN_EPI) { if (wr == 1) PG8_BAR; }
    }
    PG8_WAIT_V(0);
    if constexpr (!ALIGN_EPI) { if (wr == 0) PG8_BAR; }
    PG8_BAR;
#undef PG8_SA
#undef PG8_SB
#undef PG8_STAGE
#undef PG8_STAGEA
#undef PG8_ROWOFFS
#undef PG8_LDA
#undef PG8_LDB
#undef PG8_MMA
#undef PG8_WAIT_V
#undef PG8_WAIT_L
#undef PG8_BAR
#undef PG8_SCHED
}
}

constexpr int NB = 8, SEQ = 2048, D = 1024, T = NB * SEQ;
constexpr int MEML = 256, TM = NB * MEML;
constexpr int HYC = 512, NZ0 = 2048;
constexpr int FF = 2816, NGU = 2 * FF;
constexpr int ATW = 1536, NQKV = 3 * ATW, NQ1 = NQKV + 512;
constexpr int NE = 8, PMAX = 2 * T + NE * 256;
constexpr float EPS = 1e-6f;
constexpr int NWAVES = 8;

constexpr size_t MiB = 1u << 20;
constexpr size_t WS_CTL = 0, CTL_ZERO_BYTES = 1 * MiB;
constexpr size_t WS_WGU1 = 1 * MiB;
constexpr size_t WS_WD1 = 89 * MiB;
constexpr size_t WS_SMALL = 133 * MiB;
constexpr size_t WS_RSTD0 = WS_SMALL;
constexpr size_t WS_SSQ16 = WS_SMALL + 64 * 1024;
constexpr size_t WS_LSE = WS_SSQ16 + 1 * MiB;
constexpr size_t WS_TOKE = WS_LSE + 768 * 1024;
constexpr size_t WS_TOKR = WS_TOKE + 128 * 1024;
constexpr size_t WS_TOKG = WS_TOKR + 128 * 1024;
constexpr size_t WS_RSTD3 = WS_TOKG + 128 * 1024;
constexpr size_t WS_LIST = WS_RSTD3 + 64 * 1024;
constexpr size_t WS_RSTDS = WS_LIST + 512 * 1024;
static_assert(WS_RSTDS + PMAX * 4 <= WS_SMALL + 4 * MiB, "small region");
constexpr size_t WS_WO = 137 * MiB;
constexpr size_t WS_WIN1 = 141 * MiB;
constexpr size_t WS_WKV = 151 * MiB;
constexpr size_t WS_WIN0 = 155 * MiB;
constexpr size_t WS_WGU0 = 159 * MiB;
constexpr size_t WS_WD0 = 170 * MiB;
constexpr size_t WS_KV = 176 * MiB;
constexpr size_t WS_XB = 184 * MiB;
constexpr size_t WS_YT = 336 * MiB;
constexpr size_t WS_MIX0 = 216 * MiB;
constexpr size_t WS_MN = 248 * MiB;
constexpr size_t WS_ZT = 256 * MiB;
constexpr size_t WS_XQ0 = 304 * MiB;
constexpr size_t WS_HF = 320 * MiB;
constexpr size_t WS_HID0 = 248 * MiB;
constexpr size_t WS_QKV1 = 248 * MiB;
constexpr size_t WS_XQ1 = 392 * MiB;
constexpr size_t WS_OG12 = 216 * MiB;
constexpr size_t WS_MIX1 = 141 * MiB;
constexpr size_t WS_XB3 = 137 * MiB;
constexpr size_t WS_XS = 137 * MiB;
constexpr size_t WS_HID1 = 205 * MiB;
constexpr size_t WS_Y2 = 392 * MiB;
constexpr size_t WS_END = 408 * MiB;
static_assert(WS_HID1 + (size_t)PMAX * FF * 2 <= WS_END && WS_XQ1 + (size_t)T * 512 * 2 <= WS_END && WS_XS + (size_t)PMAX * 2048 <= WS_HID1, "ws map");

constexpr int CW_CNT = 64;
constexpr int CW_BAR = 4096;

constexpr int SCR_BYTES = 147456;
constexpr int MISC_OFF = SCR_BYTES;
constexpr int LDS_BYTES = SCR_BYTES + 4096;

#define LAS __attribute__((address_space(3)))
typedef unsigned short bf16;
typedef unsigned v4u __attribute__((ext_vector_type(4)));
typedef unsigned v2u __attribute__((ext_vector_type(2)));
typedef float f32x4 __attribute__((ext_vector_type(4)));
typedef float f32x2 __attribute__((ext_vector_type(2)));
#define LDS_WAIT() asm volatile("s_waitcnt lgkmcnt(0)" ::: "memory")
__device__ __forceinline__ unsigned f2bf(float f) { unsigned u = __builtin_bit_cast(unsigned, f); return (u + 0x7fffu + ((u >> 16) & 1u)) >> 16; }
__device__ __forceinline__ unsigned pk2(float lo, float hi) { unsigned r; asm("v_cvt_pk_bf16_f32 %0, %1, %2" : "=v"(r) : "v"(lo), "v"(hi)); return r; }
__device__ __forceinline__ float bflo(unsigned w) { return __builtin_bit_cast(float, w << 16); }
__device__ __forceinline__ float bfhi(unsigned w) { return __builtin_bit_cast(float, w & 0xffff0000u); }
__device__ __forceinline__ float bf1(bf16 b) { return __builtin_bit_cast(float, ((unsigned)b) << 16); }
__device__ __forceinline__ float wave_sum(float v) {
#pragma unroll
    for (int o = 1; o < 64; o <<= 1) v += __shfl_xor(v, o);
    return v;
}
__device__ __forceinline__ float wave_max(float v) {
#pragma unroll
    for (int o = 1; o < 64; o <<= 1) v = fmaxf(v, __shfl_xor(v, o));
    return v;
}

#define XB_TMO      128
#define XB_XCNT(j)  (256  + 64 * (j))
#define XB_XSUB(j)  (1280 + 64 * (j))
#define XB_XGEN(j)  (2304 + 64 * (j))
#define XB_TOP      3328
#define XB_TOPGEN   3392
#define XCD_BAR_WORDS 3456
#define XB_SPIN_CAP (1u << 18)

__device__ __forceinline__ unsigned xb_ld(unsigned* p)              { return __hip_atomic_load(p, __ATOMIC_RELAXED, __HIP_MEMORY_SCOPE_AGENT); }
__device__ __forceinline__ unsigned xb_add(unsigned* p, unsigned v) { return __hip_atomic_fetch_add(p, v, __ATOMIC_RELAXED, __HIP_MEMORY_SCOPE_AGENT); }
__device__ __forceinline__ unsigned xb_xcc_id() { return (unsigned)__builtin_amdgcn_s_getreg((3 << 11) | 20) & 0xFu; }
#define XB_SPIN(cond, bar) do { unsigned _sp = 0; while (cond) { __builtin_amdgcn_s_sleep(1); \
    if ((++_sp & 255u) == 0u) { if (xb_ld(&(bar)[XB_TMO])) break; if (_sp > XB_SPIN_CAP) { atomicAdd(&(bar)[XB_TMO], 1u); break; } } } } while (0)

struct XcdBarrier {
    unsigned* bar; unsigned x;
    volatile LAS unsigned* st;
};
__device__ __forceinline__ XcdBarrier xcd_barrier_post(unsigned* bar, volatile LAS unsigned* st, int tid) {
    XcdBarrier b; b.bar = bar; b.x = xb_xcc_id(); b.st = st;
    if (tid == 0) (void)xb_add(&bar[XB_XCNT(b.x)], 1u);
    return b;
}
__device__ __forceinline__ void xcd_barrier_complete(unsigned* bar, unsigned x, unsigned& nloc, unsigned& nx) {
    const unsigned G = gridDim.x * gridDim.y * gridDim.z;
    unsigned sum, cnt, mine, sp = 0u;
    for (;;) {
        sum = 0u; cnt = 0u; mine = 0u;
#pragma unroll
        for (unsigned j = 0; j < 16; ++j) { const unsigned c = xb_ld(&bar[XB_XCNT(j)]); sum += c; cnt += (c > 0u) ? 1u : 0u; mine = (j == x) ? c : mine; }
        if (sum == G) break;
        __builtin_amdgcn_s_sleep(1);
        if ((++sp & 255u) == 0u) { if (xb_ld(&bar[XB_TMO])) break; if (sp > XB_SPIN_CAP) { atomicAdd(&bar[XB_TMO], 1u); break; } }
    }
    nloc = mine > 0u ? mine : 1u; nx = cnt > 0u ? cnt : 1u;
}
__device__ __forceinline__ void xcd_barrier(const XcdBarrier& b, int tid) {
    asm volatile("s_waitcnt vmcnt(0)" ::: "memory");
    __syncthreads();
    if (tid == 0) {
        unsigned* bar = b.bar;
        __builtin_amdgcn_s_waitcnt(0);
        unsigned nloc = b.st[0], nx = b.st[1];
        if (nloc == 0u) { xcd_barrier_complete(bar, b.x, nloc, nx); b.st[0] = nloc; b.st[1] = nx; }
        const unsigned old = xb_add(&bar[XB_XSUB(b.x)], 1u);
        const unsigned gen = old / nloc;
        if (old + 1u == (gen + 1u) * nloc) {
            __builtin_amdgcn_fence(__ATOMIC_RELEASE, "agent");
            asm volatile("s_waitcnt vmcnt(0)" ::: "memory");
            const unsigned og = xb_add(&bar[XB_TOP], 1u);
            const unsigned tg = og / nx;
            if (og + 1u == (tg + 1u) * nx) xb_add(&bar[XB_TOPGEN], 1u);
            else XB_SPIN(xb_ld(&bar[XB_TOPGEN]) == tg, bar);
            __builtin_amdgcn_fence(__ATOMIC_ACQUIRE, "agent");
            xb_add(&bar[XB_XGEN(b.x)], 1u);
            asm volatile("s_waitcnt vmcnt(0)" ::: "memory");
        } else {
            XB_SPIN(xb_ld(&bar[XB_XGEN(b.x)]) == gen, bar);
            __builtin_amdgcn_fence(__ATOMIC_ACQUIRE, "agent");
            asm volatile("s_waitcnt vmcnt(0)" ::: "memory");
        }
    }
    __syncthreads();
}

struct Args { const float* in[30]; float* out; unsigned char* ws; int ph_lo, ph_hi, bslot, pad; };
enum { I_X = 0, I_MEM, I_RELB, I_NMIX, I_NMEM, I_NFFN, I_WKV, I_XQN, I_XKN, I_WOUT, I_HYWIN, I_HYCW, I_HYCB, I_FW1, I_FB1, I_FW2, I_FB2, I_FW3, I_FREQ, I_SKIP,
       I_ATWIN, I_ATQN, I_ATKN, I_FFG, I_FFU, I_FFD, I_ROUTER, I_MOEG, I_MOEU, I_MOED };

struct Frame {
    LAS unsigned char* lds;
    unsigned char* ws;
    int tid, lane, wave, G, bid;
};

constexpr int RSL_OFF = 131072;
template <int SCALE> struct EpiB {
    bf16* O; int ldc; const float* sc; int split_tile; bf16* O2; int ldc2; const LAS float* rsl;
    __device__ __forceinline__ void operator()(const f32x4 (&acc)[2][2][4][2], const pg8::Unit& u, int wr, int wc, int fr, int fq) const {
        const int row0 = u.pm * 256 + wr * 64 + fr;
        bf16* base = O; int ld = ldc; int colt = u.pn * 256;
        if (u.pn >= split_tile) { base = O2; ld = ldc2; colt -= split_tile * 256; }
        if (u.koff != 0) base = O2;
        const int col0 = colt + wc * 32 + 8 * fq;
        float rsv[2][4];
        if (SCALE == 1) {
#pragma unroll
            for (int ai = 0; ai < 2; ++ai)
#pragma unroll
                for (int m = 0; m < 4; ++m) rsv[ai][m] = sc[row0 + ai * 128 + m * 16];
            asm volatile("s_waitcnt vmcnt(0)" ::: "memory");
        }
        f32x4 cs[2][2];
        if (SCALE == 3) {
#pragma unroll
            for (int bj = 0; bj < 2; ++bj)
#pragma unroll
                for (int n = 0; n < 2; ++n) cs[bj][n] = *(const f32x4*)(sc + u.pn * 256 + bj * 128 + wc * 32 + 8 * fq + 4 * n);
            asm volatile("s_waitcnt vmcnt(0)" ::: "memory");
        }
#pragma unroll
        for (int ai = 0; ai < 2; ++ai)
#pragma unroll
            for (int m = 0; m < 4; ++m) {
                const int row = row0 + ai * 128 + m * 16;
                float rs = 1.f;
                if (SCALE == 1) rs = rsv[ai][m];
                if (SCALE == 2) { const f32x4* p = (const f32x4*)(sc + (size_t)row * 16); const f32x4 a = p[0], b = p[1], c = p[2], d = p[3];
                    const float s = ((a.x + a.y) + (a.z + a.w)) + ((b.x + b.y) + (b.z + b.w)) + ((c.x + c.y) + (c.z + c.w)) + ((d.x + d.y) + (d.z + d.w));
                    rs = 1.0f / sqrtf(s * (1.0f / D) + EPS); }
                if (SCALE == 4) rs = rsl[u.idx * 256 + (row - u.pm * 256)];
                bf16* rowp = base + (size_t)row * ld + col0;
#pragma unroll
                for (int bj = 0; bj < 2; ++bj) {
                    f32x4 v0 = acc[ai][bj][m][0], v1 = acc[ai][bj][m][1];
                    if (SCALE == 1 || SCALE == 2 || SCALE == 4) { v0 = v0 * rs; v1 = v1 * rs; }
                    if (SCALE == 3) { v0 = v0 * cs[bj][0]; v1 = v1 * cs[bj][1]; }
                    v4u w; w.x = pk2(v0[0], v0[1]); w.y = pk2(v0[2], v0[3]); w.z = pk2(v1[0], v1[1]); w.w = pk2(v1[2], v1[3]);
                    *(v4u*)(rowp + bj * 128) = w;
                }
            }
    }
};
template <bool XF32, bool SSQ> struct EpiRes {
    const float* xf; const bf16* xi; int ldi; bf16* xo; int ldo; float* ssq16;
    __device__ __forceinline__ void operator()(const f32x4 (&acc)[2][2][4][2], const pg8::Unit& u, int wr, int wc, int fr, int fq) const {
        const int row0 = u.pm * 256 + wr * 64 + fr, col0 = u.pn * 256 + wc * 32 + 8 * fq;
        if constexpr (!XF32) {
            v4u res[2][4][2];
#pragma unroll
            for (int ai = 0; ai < 2; ++ai)
#pragma unroll
                for (int m = 0; m < 4; ++m)
#pragma unroll
                    for (int bj = 0; bj < 2; ++bj) res[ai][m][bj] = *(const v4u*)(xi + (size_t)(row0 + ai * 128 + m * 16) * ldi + col0 + bj * 128);
            asm volatile("s_waitcnt vmcnt(0)" ::: "memory");
#pragma unroll
            for (int ai = 0; ai < 2; ++ai)
#pragma unroll
                for (int m = 0; m < 4; ++m) {
                    const int row = row0 + ai * 128 + m * 16;
                    float ss = 0.f;
#pragma unroll
                    for (int bj = 0; bj < 2; ++bj) {
                        const v4u w0 = res[ai][m][bj];
                        const f32x4 r0 = (f32x4){bflo(w0.x), bfhi(w0.x), bflo(w0.y), bfhi(w0.y)}, r1 = (f32x4){bflo(w0.z), bfhi(w0.z), bflo(w0.w), bfhi(w0.w)};
                        const f32x4 v0 = acc[ai][bj][m][0] + r0, v1 = acc[ai][bj][m][1] + r1;
                        v4u w; w.x = pk2(v0[0], v0[1]); w.y = pk2(v0[2], v0[3]); w.z = pk2(v1[0], v1[1]); w.w = pk2(v1[2], v1[3]);
                        *(v4u*)(xo + (size_t)row * ldo + col0 + bj * 128) = w;
                        if (SSQ) ss += ((v0[0] * v0[0] + v0[1] * v0[1]) + (v0[2] * v0[2] + v0[3] * v0[3])) + ((v1[0] * v1[0] + v1[1] * v1[1]) + (v1[2] * v1[2] + v1[3] * v1[3]));
                    }
                    if (SSQ) { ss += __shfl_xor(ss, 16); ss += __shfl_xor(ss, 32);
                        if (fq == 0) ssq16[(size_t)row * 16 + u.pn * 4 + wc] = ss; }
                }
        } else {
#pragma unroll
            for (int ai = 0; ai < 2; ++ai)
#pragma unroll
                for (int m = 0; m < 4; ++m) {
                    const int row = row0 + ai * 128 + m * 16;
                    float ss = 0.f;
#pragma unroll
                    for (int bj = 0; bj < 2; ++bj) {
                        const size_t off = (size_t)row * D + col0 + bj * 128; const f32x4 r0 = *(const f32x4*)(xf + off), r1 = *(const f32x4*)(xf + off + 4);
                        const f32x4 v0 = acc[ai][bj][m][0] + r0, v1 = acc[ai][bj][m][1] + r1;
                        v4u w; w.x = pk2(v0[0], v0[1]); w.y = pk2(v0[2], v0[3]); w.z = pk2(v1[0], v1[1]); w.w = pk2(v1[2], v1[3]);
                        *(v4u*)(xo + (size_t)row * ldo + col0 + bj * 128) = w;
                        if (SSQ) ss += ((v0[0] * v0[0] + v0[1] * v0[1]) + (v0[2] * v0[2] + v0[3] * v0[3])) + ((v1[0] * v1[0] + v1[1] * v1[1]) + (v1[2] * v1[2] + v1[3] * v1[3]));
                    }
                    if (SSQ) { ss += __shfl_xor(ss, 16); ss += __shfl_xor(ss, 32);
                        if (fq == 0) ssq16[(size_t)row * 16 + u.pn * 4 + wc] = ss; }
                }
        }
    }
};
template <int SCALE> struct EpiSwiglu {
    bf16* H; int ldh; const float* sc; const LAS float* rsl;
    __device__ __forceinline__ void operator()(const f32x4 (&acc)[2][2][4][2], const pg8::Unit& u, int wr, int wc, int fr, int fq) const {
        const int row0 = u.pm * 256 + wr * 64 + fr, col0 = u.pn * 128 + wc * 32 + 8 * fq;
#pragma unroll
        for (int ai = 0; ai < 2; ++ai)
#pragma unroll
            for (int m = 0; m < 4; ++m) {
                const int row = row0 + ai * 128 + m * 16;
                float rs = 1.f;
                if (SCALE == 1) rs = sc[row];
                if (SCALE == 2) { const f32x4* p = (const f32x4*)(sc + (size_t)row * 16); const f32x4 a = p[0], b = p[1], c = p[2], d = p[3];
                    const float s = ((a.x + a.y) + (a.z + a.w)) + ((b.x + b.y) + (b.z + b.w)) + ((c.x + c.y) + (c.z + c.w)) + ((d.x + d.y) + (d.z + d.w));
                    rs = 1.0f / sqrtf(s * (1.0f / D) + EPS); }
                if (SCALE == 4) rs = rsl[u.idx * 256 + (row - u.pm * 256)];
                float h[8];
#pragma unroll
                for (int n = 0; n < 2; ++n)
#pragma unroll
                    for (int j = 0; j < 4; ++j) { const float gv = acc[ai][0][m][n][j] * rs, uv = acc[ai][1][m][n][j] * rs;
                        h[n * 4 + j] = gv * uv * __builtin_amdgcn_rcpf(1.0f + __expf(-gv)); }
                v4u w; w.x = pk2(h[0], h[1]); w.y = pk2(h[2], h[3]); w.z = pk2(h[4], h[5]); w.w = pk2(h[6], h[7]);
                *(v4u*)(H + (size_t)row * ldh + col0) = w;
            }
    }
};

template <class Sched>
__device__ __forceinline__ void fill_rstd_table(LAS unsigned char* lds, const Sched& S, const float* ssq16, int tid) {
    LAS float* rsl = (LAS float*)(lds + RSL_OFF);
    pg8::Unit u;
    for (int ui = 0; ui < 16 && S.next(ui, u); ++ui) {
        if (tid < 256) { const f32x4* p = (const f32x4*)(ssq16 + (size_t)(u.pm * 256 + tid) * 16); const f32x4 a = p[0], b = p[1], c = p[2], d = p[3];
            const float s = ((a.x + a.y) + (a.z + a.w)) + ((b.x + b.y) + (b.z + b.w)) + ((c.x + c.y) + (c.z + c.w)) + ((d.x + d.y) + (d.z + d.w));
            rsl[ui * 256 + tid] = 1.0f / sqrtf(s * (1.0f / D) + EPS); }
    }
    __syncthreads();
}

__device__ __forceinline__ void p0_transpose_item(const float* W, int K, int N, bf16* WT, const float* gain, int mode, LAS float* scr, int item, int lane) {
    const int nblk = N / 64, kb = item / nblk, nb = item % nblk, k0 = 64 * kb, n0 = 64 * nb;
    const int lr = lane >> 4, lc = lane & 15;
    f32x4 v[16];
#pragma unroll
    for (int i = 0; i < 16; ++i) v[i] = *(const f32x4*)(W + (size_t)(k0 + 4 * i + lr) * N + n0 + 4 * lc);
    if (gain) {
#pragma unroll
        for (int i = 0; i < 16; ++i) v[i] = v[i] * gain[k0 + 4 * i + lr];
    }
#pragma unroll
    for (int i = 0; i < 16; ++i) { LAS float* s = scr + (4 * i + lr) * 65 + 4 * lc; s[0] = v[i].x; s[1] = v[i].y; s[2] = v[i].z; s[3] = v[i].w; }
    LDS_WAIT(); asm volatile("" ::: "memory");
    const int c = lane & 7;
    const int d0 = (mode == 0) ? n0 : (256 * (n0 / 128) + (n0 % 128) + (mode == 2 ? 128 : 0));
#pragma unroll
    for (int j = 0; j < 8; ++j) { const int n = (lane >> 3) + 8 * j; const LAS float* s = scr + (8 * c) * 65 + n;
        v4u o; o.x = pk2(s[0 * 65], s[1 * 65]); o.y = pk2(s[2 * 65], s[3 * 65]); o.z = pk2(s[4 * 65], s[5 * 65]); o.w = pk2(s[6 * 65], s[7 * 65]);
        *(v4u*)(WT + (size_t)(d0 + n) * K + k0 + 8 * c) = o; }
    LDS_WAIT(); asm volatile("" ::: "memory");
}
__device__ __forceinline__ float row_to_bf16(const float* xrow, bf16* orow, const float* gain, bool normalize, int lane) {
    const f32x4* xr = (const f32x4*)xrow + lane;
    f32x4 v[4]; float s = 0.f;
#pragma unroll
    for (int j = 0; j < 4; ++j) { v[j] = xr[64 * j]; s += (v[j].x * v[j].x + v[j].y * v[j].y) + (v[j].z * v[j].z + v[j].w * v[j].w); }
    const float rstd = 1.0f / sqrtf(wave_sum(s) * (1.f / D) + EPS);
    unsigned long long* o8 = (unsigned long long*)orow + lane;
#pragma unroll
    for (int j = 0; j < 4; ++j) {
        f32x4 w = v[j];
        if (normalize) { const f32x4 g = ((const f32x4*)gain)[lane + 64 * j]; w = w * rstd * g; }
        o8[64 * j] = (unsigned long long)pk2(w.x, w.y) | ((unsigned long long)pk2(w.z, w.w) << 32);
    }
    return rstd;
}
__device__ __forceinline__ void p0_filter_block(Frame& F, const Args& a, float* Hf, int jb) {
    const float* w1 = a.in[I_FW1]; const float* b1 = a.in[I_FB1]; const float* w2 = a.in[I_FW2]; const float* b2 = a.in[I_FB2]; const float* w3 = a.in[I_FW3]; const float* fr = a.in[I_FREQ];
    LAS float* h2s = (LAS float*)(F.lds + MISC_OFF + 256);
    const int lane = F.lane, j0 = jb * 8;
    LAS float* W1s = (LAS float*)F.lds; LAS float* W2s = W1s + 33 * 64;
    for (int i = F.tid; i < 33 * 64; i += 512) W1s[i] = w1[i];
    for (int i = F.tid; i < 64 * 64; i += 512) W2s[i] = w2[i];
    __syncthreads();
    {
        const int j = j0 + F.wave;
        const float freq = fr[lane], bb1 = b1[lane], bb2 = b2[lane];
        float feat = 0.f;
        {
            const int fi = (lane >= 17) ? lane - 17 : lane - 1;
            const float f = 1e-4f + (float)fi * ((15.0f - 1e-4f) / 15.0f);
            const float ang = (6.283185307179586f / 2048.0f) * (float)j * f;
            if (lane == 0) feat = (float)j * (1.0f / 2047.0f);
            else if (lane <= 16) feat = cosf(ang);
            else if (lane <= 32) feat = -sinf(ang);
        }
        float s1 = bb1;
#pragma unroll
        for (int i = 0; i < 33; ++i) s1 += __shfl(feat, i) * W1s[i * 64 + lane];
        const float h1 = sinf(freq * s1);
        float s2 = bb2;
#pragma unroll 16
        for (int i = 0; i < 64; ++i) s2 += __shfl(h1, i) * W2s[i * 64 + lane];
        h2s[lane * 8 + F.wave] = sinf(freq * s2);
    }
    __syncthreads();
    const int n0 = F.wave * 256;
    float acc[4][8];
#pragma unroll
    for (int q = 0; q < 4; ++q)
#pragma unroll
        for (int jj = 0; jj < 8; ++jj) acc[q][jj] = 0.f;
#pragma unroll 1
    for (int i0 = 0; i0 < 64; i0 += 8) {
        float w[8][4];
#pragma unroll
        for (int ii = 0; ii < 8; ++ii)
#pragma unroll
            for (int q = 0; q < 4; ++q) w[ii][q] = w3[(size_t)(i0 + ii) * 2048 + n0 + q * 64 + lane];
#pragma unroll
        for (int ii = 0; ii < 8; ++ii) {
            const f32x4 ha = *(const LAS f32x4*)(h2s + (i0 + ii) * 8), hb = *(const LAS f32x4*)(h2s + (i0 + ii) * 8 + 4);
#pragma unroll
            for (int q = 0; q < 4; ++q) {
                acc[q][0] += ha.x * w[ii][q]; acc[q][1] += ha.y * w[ii][q]; acc[q][2] += ha.z * w[ii][q]; acc[q][3] += ha.w * w[ii][q];
                acc[q][4] += hb.x * w[ii][q]; acc[q][5] += hb.y * w[ii][q]; acc[q][6] += hb.z * w[ii][q]; acc[q][7] += hb.w * w[ii][q]; }
        }
    }
    const float da = -3.0701134573253945f, db = -15.350567286626973f;
#pragma unroll
    for (int q = 0; q < 4; ++q) {
        const int n = n0 + q * 64 + lane, c = n & 511;
        const float delta = fabsf(da + (db - da) * ((float)c * (1.0f / 511.0f)));
        float o[8];
#pragma unroll
        for (int jj = 0; jj < 8; ++jj) { const float t = (float)(j0 + jj) * (1.0f / 2047.0f); o[jj] = acc[q][jj] * (expf(-t * delta) + 0.05f); }
        f32x4* dst = (f32x4*)(Hf + (size_t)n * 2048 + j0);
        dst[0] = (f32x4){o[0], o[1], o[2], o[3]}; dst[1] = (f32x4){o[4], o[5], o[6], o[7]};
    }
    __syncthreads();
}
constexpr int IT_MOE = 16 * 44, N_MOE_ITEMS = 24 * IT_MOE;
constexpr int MOE_P1_HI = 4608, MOE_P5_HI = 12608, MOE_P0_LO = MOE_P5_HI;
__device__ __forceinline__ void moe_convert(Frame& F, const Args& a, int lo, int hi, int gwl, int ngw) {
    LAS float* scr = (LAS float*)(F.lds + F.wave * 16640);
    unsigned char* ws = F.ws;
    for (int r = lo + gwl; r < hi; r += ngw) {
        const int mid = r / IT_MOE, li = r % IT_MOE, kind = mid >> 3, e = mid & 7;
        if (kind == 0) p0_transpose_item(a.in[I_MOEG] + (size_t)e * D * FF, D, FF, (bf16*)(ws + WS_WGU1) + (size_t)e * NGU * D, a.in[I_NFFN] + D, 1, scr, li, F.lane);
        else if (kind == 1) p0_transpose_item(a.in[I_MOEU] + (size_t)e * D * FF, D, FF, (bf16*)(ws + WS_WGU1) + (size_t)e * NGU * D, a.in[I_NFFN] + D, 2, scr, li, F.lane);
        else p0_transpose_item(a.in[I_MOED] + (size_t)e * FF * D, FF, D, (bf16*)(ws + WS_WD1) + (size_t)e * D * FF, nullptr, 0, scr, li, F.lane);
    }
}
__device__ __forceinline__ void p0_prologue(Frame& F, const Args& a) {
    LAS float* scr = (LAS float*)(F.lds + F.wave * 16640);
    const int gw = F.bid * NWAVES + F.wave, NGW = F.G * NWAVES;
    unsigned char* ws = F.ws;
    for (int jb = F.bid; jb < 256; jb += F.G) p0_filter_block(F, a, (float*)(ws + WS_HF), jb);
    for (int m = gw; m < T; m += NGW) { const float r = row_to_bf16(a.in[I_X] + (size_t)m * D, (bf16*)(ws + WS_XB) + (size_t)m * D, nullptr, false, F.lane); if (F.lane == 0) ((float*)(ws + WS_RSTD0))[m] = r; }
    for (int m = gw; m < 2 * TM; m += NGW) { const int l = m / TM, r = m % TM;
        (void)row_to_bf16(a.in[I_MEM] + (size_t)r * D, (bf16*)(ws + WS_MN) + (size_t)m * D, a.in[I_NMEM] + l * D, true, F.lane); }
    constexpr int IT_A = 16 * 32, IT_SQ = 16 * 16, IT_G = 16 * 44, IT_D = 44 * 16, IT_W1 = 16 * 80;
    constexpr int NSMALL = IT_A + 4 * IT_SQ + 2 * IT_G + IT_D + IT_W1;
    for (int it = gw; it < NSMALL; it += NGW) {
        int r = it;
        if (r < IT_A) { p0_transpose_item(a.in[I_HYWIN], D, NZ0, (bf16*)(ws + WS_WIN0), a.in[I_NMIX], 0, scr, r, F.lane); continue; } r -= IT_A;
        if (r < IT_SQ) { p0_transpose_item(a.in[I_WKV], D, D, (bf16*)(ws + WS_WKV), nullptr, 0, scr, r, F.lane); continue; } r -= IT_SQ;
        if (r < IT_SQ) { p0_transpose_item(a.in[I_WKV] + (size_t)D * D, D, D, (bf16*)(ws + WS_WKV) + (size_t)D * D, nullptr, 0, scr, r, F.lane); continue; } r -= IT_SQ;
        if (r < IT_SQ) { p0_transpose_item(a.in[I_WOUT], D, D, (bf16*)(ws + WS_WO), nullptr, 0, scr, r, F.lane); continue; } r -= IT_SQ;
        if (r < IT_SQ) { p0_transpose_item(a.in[I_WOUT] + (size_t)D * D, D, D, (bf16*)(ws + WS_WO) + (size_t)D * D, nullptr, 0, scr, r, F.lane); continue; } r -= IT_SQ;
        if (r < IT_G) { p0_transpose_item(a.in[I_FFG], D, FF, (bf16*)(ws + WS_WGU0), a.in[I_NFFN], 1, scr, r, F.lane); continue; } r -= IT_G;
        if (r < IT_G) { p0_transpose_item(a.in[I_FFU], D, FF, (bf16*)(ws + WS_WGU0), a.in[I_NFFN], 2, scr, r, F.lane); continue; } r -= IT_G;
        if (r < IT_D) { p0_transpose_item(a.in[I_FFD], FF, D, (bf16*)(ws + WS_WD0), nullptr, 0, scr, r, F.lane); continue; } r -= IT_D;
        p0_transpose_item(a.in[I_ATWIN], D, NQ1, (bf16*)(ws + WS_WIN1), a.in[I_NMIX] + D, 0, scr, r, F.lane);
    }
    moe_convert(F, a, (F.G == 256) ? MOE_P0_LO : 0, N_MOE_ITEMS, gw, NGW);
}
__device__ __forceinline__ float block_sum(Frame& F, float v) {
    LAS float* red = (LAS float*)(F.lds + MISC_OFF + 64);
    v = wave_sum(v);
    __syncthreads();
    if (F.lane == 0) red[F.wave] = v;
    __syncthreads();
    float s = 0.f;
#pragma unroll
    for (int w = 0; w < NWAVES; ++w) s += red[w];
    return s;
}
__device__ __forceinline__ int rel_bucket_dev(int rel) {
    const int n = rel < 0 ? -rel : rel;
    const int large = 8 + (n >= 15) + (n >= 27) + (n >= 50) + (n >= 91) + (n >= 166) + (n >= 305) + (n >= 559);
    return (rel > 0 ? 16 : 0) + (n < 8 ? n : large);
}
__device__ __forceinline__ void merge_token(Frame& F, int token) {
    const bf16* og = (const bf16*)(F.ws + WS_OG12); const float* lse = (const float*)(F.ws + WS_LSE);
    bf16* mix = (bf16*)(F.ws + WS_MIX1);
    const int lane = F.lane, h = lane >> 4;
    const float l0 = lse[(size_t)token * 4 + h], l1 = lse[((size_t)T + token) * 4 + h], l2 = lse[((size_t)2 * T + token) * 4 + h];
    const float mx = fmaxf(l0, fmaxf(l1, l2));
    float w0 = __expf(l0 - mx), w1 = __expf(l1 - mx), w2 = __expf(l2 - mx);
    const float iz = 1.0f / (w0 + w1 + w2); w0 *= iz; w1 *= iz; w2 *= iz;
    const v4u a0 = *(const v4u*)(mix + (size_t)token * D + 8 * lane);
    const v4u a1 = *(const v4u*)(og + (size_t)token * 512 + 8 * lane);
    const v4u a2 = *(const v4u*)(og + ((size_t)T + token) * 512 + 8 * lane);
    v4u o;
    o.x = pk2(w0 * bflo(a0.x) + w1 * bflo(a1.x) + w2 * bflo(a2.x), w0 * bfhi(a0.x) + w1 * bfhi(a1.x) + w2 * bfhi(a2.x));
    o.y = pk2(w0 * bflo(a0.y) + w1 * bflo(a1.y) + w2 * bflo(a2.y), w0 * bfhi(a0.y) + w1 * bfhi(a1.y) + w2 * bfhi(a2.y));
    o.z = pk2(w0 * bflo(a0.z) + w1 * bflo(a1.z) + w2 * bflo(a2.z), w0 * bfhi(a0.z) + w1 * bfhi(a1.z) + w2 * bfhi(a2.z));
    o.w = pk2(w0 * bflo(a0.w) + w1 * bflo(a1.w) + w2 * bflo(a2.w), w0 * bfhi(a0.w) + w1 * bfhi(a1.w) + w2 * bfhi(a2.w));
    *(v4u*)(mix + (size_t)token * D + 8 * lane) = o;
}

constexpr int RT_OFF_R = 0, RT_OFF_REC = 32768, RT_OFF_CNT = 32768 + 64 * 32;
__device__ __forceinline__ void route_block(Frame& F, const Args& a, int blk) {
    LAS float* RL = (LAS float*)(F.lds + RT_OFF_R); volatile LAS int* REC = (volatile LAS int*)(F.lds + RT_OFF_REC); LAS int* CNT = (LAS int*)(F.lds + RT_OFF_CNT);
    const int lane = F.lane;
    const float* g = a.in[I_NFFN] + D; const float* rt = a.in[I_ROUTER];
    __syncthreads();
    for (int i = F.tid; i < 2048; i += 512) { const f32x4 r = ((const f32x4*)rt)[i]; const float gg = g[i >> 1]; ((LAS f32x4*)RL)[i] = r * gg; }
    if (F.tid < 16) CNT[F.tid] = 0;
    __syncthreads();
    for (int q = 0; q < 8; ++q) {
        const int tl = F.wave * 8 + q, token = blk * 64 + tl;
        const bf16* xr = (const bf16*)a.out + (size_t)token * 2048 + 1024;
        f32x4 v[4]; float s = 0.f;
#pragma unroll
        for (int j = 0; j < 4; ++j) { const v2u w = ((const v2u*)xr)[lane + 64 * j]; v[j] = (f32x4){bflo(w.x), bfhi(w.x), bflo(w.y), bfhi(w.y)}; s += (v[j].x * v[j].x + v[j].y * v[j].y) + (v[j].z * v[j].z + v[j].w * v[j].w); }
        const float rstd = 1.0f / sqrtf(wave_sum(s) * (1.f / D) + EPS);
        { unsigned long long* o8 = (unsigned long long*)((bf16*)(F.ws + WS_XB3) + (size_t)token * D) + lane;
#pragma unroll
          for (int j = 0; j < 4; ++j) o8[64 * j] = (unsigned long long)pk2(v[j].x * rstd, v[j].y * rstd) | ((unsigned long long)pk2(v[j].z * rstd, v[j].w * rstd) << 32); }
        float lg[8];
#pragma unroll
        for (int e = 0; e < 8; ++e) lg[e] = 0.f;
#pragma unroll
        for (int j = 0; j < 4; ++j) {
            const int k0 = 4 * (lane + 64 * j);
#pragma unroll
            for (int qq = 0; qq < 4; ++qq) {
                const float hn = v[j][qq] * rstd;
                const f32x4 r0 = *(const LAS f32x4*)(RL + (k0 + qq) * 8), r1 = *(const LAS f32x4*)(RL + (k0 + qq) * 8 + 4);
                lg[0] += hn * r0.x; lg[1] += hn * r0.y; lg[2] += hn * r0.z; lg[3] += hn * r0.w;
                lg[4] += hn * r1.x; lg[5] += hn * r1.y; lg[6] += hn * r1.z; lg[7] += hn * r1.w;
            }
        }
#pragma unroll
        for (int e = 0; e < 8; ++e) lg[e] = wave_sum(lg[e]);
        int i1 = 0; float v1 = lg[0];
#pragma unroll
        for (int e = 1; e < 8; ++e) if (lg[e] > v1) { v1 = lg[e]; i1 = e; }
        int i2 = -1; float v2 = -3.0e38f;
#pragma unroll
        for (int e = 0; e < 8; ++e) if (e != i1 && lg[e] > v2) { v2 = lg[e]; i2 = e; }
        const float e2 = __expf(v2 - v1), g1 = 1.0f / (1.0f + e2), g2 = e2 * g1;
        if (lane == 0) {
            const int r1 = __hip_atomic_fetch_add(CNT + i1, 1, __ATOMIC_RELAXED, __HIP_MEMORY_SCOPE_WORKGROUP);
            const int r2 = __hip_atomic_fetch_add(CNT + i2, 1, __ATOMIC_RELAXED, __HIP_MEMORY_SCOPE_WORKGROUP);
            REC[tl * 8 + 0] = i1; REC[tl * 8 + 1] = i2; REC[tl * 8 + 2] = r1; REC[tl * 8 + 3] = r2;
            REC[tl * 8 + 4] = __builtin_bit_cast(int, g1); REC[tl * 8 + 5] = __builtin_bit_cast(int, g2); REC[tl * 8 + 6] = __builtin_bit_cast(int, rstd);
        }
    }
    __syncthreads();
    if (F.tid < 8) { unsigned* cnt = (unsigned*)(F.ws + WS_CTL) + CW_CNT; CNT[8 + F.tid] = (int)__hip_atomic_fetch_add(cnt + F.tid, (unsigned)CNT[F.tid], __ATOMIC_RELAXED, __HIP_MEMORY_SCOPE_AGENT); }
    __syncthreads();
    if (F.tid < 64) {
        const int tl = F.tid, token = blk * 64 + tl;
        const int i1 = REC[tl * 8 + 0], i2 = REC[tl * 8 + 1], r1 = CNT[8 + i1] + REC[tl * 8 + 2], r2 = CNT[8 + i2] + REC[tl * 8 + 3];
        int* toke = (int*)(F.ws + WS_TOKE); int* tokr = (int*)(F.ws + WS_TOKR); int* tokg = (int*)(F.ws + WS_TOKG); int* list = (int*)(F.ws + WS_LIST);
        list[(size_t)i1 * T + r1] = token; list[(size_t)i2 * T + r2] = token;
        toke[token * 2] = i1; toke[token * 2 + 1] = i2; tokr[token * 2] = r1; tokr[token * 2 + 1] = r2;
        tokg[token * 2] = REC[tl * 8 + 4]; tokg[token * 2 + 1] = REC[tl * 8 + 5];
        ((int*)(F.ws + WS_RSTD3))[token] = REC[tl * 8 + 6];
    }
}
__device__ __forceinline__ void moe_layout(Frame& F) {
    volatile LAS int* M = (volatile LAS int*)(F.lds + MISC_OFF);
    __syncthreads();
    if (F.tid == 0) {
        const unsigned* cnt = (const unsigned*)(F.ws + WS_CTL) + CW_CNT;
        int acc = 0;
        for (int e = 0; e < 8; ++e) { const int c = (int)__hip_atomic_load(cnt + e, __ATOMIC_RELAXED, __HIP_MEMORY_SCOPE_AGENT); M[32 + e] = c; M[40 + e] = acc; acc += (c + 255) & ~255; }
        M[48] = acc;
    }
    __syncthreads();
}
__device__ __forceinline__ int ml_ps(Frame& F, int e) { return ((volatile LAS int*)(F.lds + MISC_OFF))[40 + e]; }
__device__ __forceinline__ int ml_cnt(Frame& F, int e) { return ((volatile LAS int*)(F.lds + MISC_OFF))[32 + e]; }
__device__ __forceinline__ int ml_total(Frame& F) { return ((volatile LAS int*)(F.lds + MISC_OFF))[48]; }
__device__ __forceinline__ int ml_expert(Frame& F, int slot) { int e = 0;
#pragma unroll
    for (int i = 1; i < 8; ++i) e += (slot >= ml_ps(F, i)) ? 1 : 0;
    return e; }

constexpr int HY_CS = 4168, HY_M0 = 2080, HY_UR = 2592, HY_UP = 256;
constexpr int HY_OFF_CP = 64, HY_OFF_UB = HY_OFF_CP + 8 * HY_CS * 2, HY_OFF_X = HY_OFF_UB + 8 * HY_UR * 2;
static_assert(HY_OFF_X + 8 * 2048 * 2 <= SCR_BYTES, "hyena LDS");
typedef short bf16x8_t __attribute__((ext_vector_type(8)));

struct HyStage { v4u raw[4]; float zm[4], zp[4]; };
struct HyFilt { float f[4], b[4]; };
__device__ __forceinline__ void hy_short_load(HyStage& s, const bf16* zr, int tid) {
#pragma unroll
    for (int k = 0; k < 4; ++k) {
        const int item = tid + 512 * k, b = item >> 8, t8 = (item & 255) * 8;
        const bf16* p = zr + b * SEQ + t8;
        s.raw[k] = *(const v4u*)p;
        s.zm[k] = (t8 > 0) ? bf1(p[-1]) : 0.f; s.zp[k] = (t8 + 8 < SEQ) ? bf1(p[8]) : 0.f;
    }
}
__device__ __forceinline__ void hy_short_store(LAS unsigned char* dst, int stride_el, int pad_el, const HyStage& s, float w0, float w1, float w2, float cb, int tid) {
#pragma unroll
    for (int k = 0; k < 4; ++k) {
        const int item = tid + 512 * k, b = item >> 8, t8 = (item & 255) * 8;
        float z[10];
        z[0] = s.zm[k]; z[1] = bflo(s.raw[k].x); z[2] = bfhi(s.raw[k].x); z[3] = bflo(s.raw[k].y); z[4] = bfhi(s.raw[k].y); z[5] = bflo(s.raw[k].z); z[6] = bfhi(s.raw[k].z); z[7] = bflo(s.raw[k].w); z[8] = bfhi(s.raw[k].w); z[9] = s.zp[k];
        float o[8];
#pragma unroll
        for (int i = 0; i < 8; ++i) o[i] = cb + z[i] * w0 + z[i + 1] * w1 + z[i + 2] * w2;
        v4u w; w.x = pk2(o[0], o[1]); w.y = pk2(o[2], o[3]); w.z = pk2(o[4], o[5]); w.w = pk2(o[6], o[7]);
        *(LAS v4u*)(dst + (size_t)(b * stride_el + pad_el + t8) * 2) = w;
    }
}
__device__ __forceinline__ void hy_filt_load(HyFilt& q, const float* Hf, int o, int c, int tid) {
    const float* fw = Hf + ((size_t)(o * 2 + 0) * 512 + c) * 2048;
    const float* bw = Hf + ((size_t)(o * 2 + 1) * 512 + c) * 2048;
#pragma unroll
    for (int i = 0; i < 4; ++i) { const int j = tid + 512 * i; q.f[i] = fw[j]; q.b[i] = (j >= 1) ? bw[j] : 0.f; }
}
__device__ __forceinline__ void hy_filt_build(Frame& F, const HyFilt& q) {
    LAS float* Kf = (LAS float*)(F.lds + HY_OFF_X);
    float s = 0.f;
#pragma unroll
    for (int i = 0; i < 4; ++i) s += fabsf(q.f[i]) + fabsf(q.b[i]);
    const float tot = block_sum(F, s);
    const float inv = 1.0f / (tot + 1e-6f);
#pragma unroll
    for (int i = 0; i < 4; ++i) { const int j = F.tid + 512 * i; Kf[HY_M0 - j] = q.f[i] * inv; if (j >= 1) Kf[HY_M0 + j] = q.b[i] * inv; }
    if (F.tid < 33) Kf[F.tid] = 0.f;
    if (F.tid < 48) Kf[4128 + F.tid] = 0.f;
    __syncthreads();
    LAS unsigned* cp = (LAS unsigned*)(F.lds + HY_OFF_CP);
    for (int p = F.tid; p < 8 * (HY_CS / 2); p += 512) { const int j = p / (HY_CS / 2), xp = p - j * (HY_CS / 2), x = 2 * xp + j; cp[p] = pk2(Kf[x], Kf[x + 1]); }
    __syncthreads();
}
__device__ __forceinline__ void hy_conv_mfma(Frame& F, f32x4 (&C)[8]) {
    const int lane = F.lane, w = F.wave, r = lane & 15, kq = lane >> 4;
    const int jc = (-r) & 7, cr = (r + 7) >> 3;
    const LAS unsigned char* abase = F.lds + HY_OFF_CP + (size_t)(jc * HY_CS + HY_M0 - 32 * (8 * w - 63) + 8 * kq - 8 * cr) * 2;
    const LAS unsigned char* bbase = F.lds + HY_OFF_UB + (size_t)((r & 7) * HY_UR + HY_UP + 16 * (r >> 3) + 8 * kq) * 2;
#pragma unroll
    for (int i = 0; i < 8; ++i) C[i] = (f32x4){0.f, 0.f, 0.f, 0.f};
    bf16x8_t Bw[9];
#pragma unroll
    for (int i = 0; i < 8; ++i) Bw[i] = *(const LAS bf16x8_t*)(bbase + 64 * (63 + i));
    bf16x8_t An = *(const LAS bf16x8_t*)(abase);
#pragma unroll 1
    for (int Q = 0; Q < 8; ++Q) {
        const LAS unsigned char* ab = abase - 64 * (9 * Q);
        const LAS unsigned char* bb = bbase + 64 * (63 - 9 * Q);
#pragma unroll
        for (int qq = 0; qq < 9; ++qq) {
            const bf16x8_t A = An;
            An = *(const LAS bf16x8_t*)(ab - 64 * (qq + 1));
            Bw[(8 - qq + 9) % 9] = *(const LAS bf16x8_t*)(bb + 64 * (-1 - qq));
#pragma unroll
            for (int i = 7; i >= 0; --i) C[i] = __builtin_amdgcn_mfma_f32_16x16x32_bf16(A, Bw[(i - qq + 9) % 9], C[i], 0, 0, 0);
        }
    }
}
__device__ __forceinline__ void hyena_units(Frame& F, const Args& a) {
    const bf16* zT = (const bf16*)(F.ws + WS_ZT);
    const float* Hf = (const float*)(F.ws + WS_HF);
    const float* cw = a.in[I_HYCW]; const float* cbp = a.in[I_HYCB]; const float* skip = a.in[I_SKIP];
    bf16* yT = (bf16*)(F.ws + WS_YT);
    LAS unsigned char* UB = F.lds + HY_OFF_UB; LAS unsigned char* XB = F.lds + HY_OFF_X;
    int c = F.bid; if (c >= HYC) return;
    HyStage sA, sC, sG; HyFilt fB, fF;
    hy_short_load(sA, zT + (size_t)c * T, F.tid); hy_filt_load(fB, Hf, 0, c, F.tid); hy_short_load(sC, zT + (size_t)(HYC + c) * T, F.tid);
#pragma unroll 1
    for (;;) {
        const int lane = F.lane, w = F.wave, n = lane & 15, bb = n & 7, hh = n >> 3, rq = lane >> 4;
        __syncthreads();
        for (int p = F.tid; p < 8 * 272; p += 512) { const int b = p / 272, q = p - b * 272; const int el = (q < 128) ? 2 * q : (HY_UP + SEQ + 2 * (q - 128)); *(LAS unsigned*)(UB + (size_t)(b * HY_UR + el) * 2) = 0u; }
        { const int ch = c; hy_short_store(UB, HY_UR, HY_UP, sA, cw[ch], cw[1536 + ch], cw[3072 + ch], cbp[ch], F.tid); }
        hy_filt_build(F, fB);
        { const int ch = HYC + c; hy_short_store(XB, SEQ, 0, sC, cw[ch], cw[1536 + ch], cw[3072 + ch], cbp[ch], F.tid); }
        hy_filt_load(fF, Hf, 1, c, F.tid); hy_short_load(sG, zT + (size_t)(2 * HYC + c) * T, F.tid);
        __syncthreads();
        f32x4 C[8];
        hy_conv_mfma(F, C);
        __syncthreads();
        {   const float sk = skip[c];
#pragma unroll
            for (int i = 0; i < 8; ++i) {
                const int t0 = 32 * (8 * w + i) + 16 * hh + 4 * rq;
                LAS v2u* up = (LAS v2u*)(UB + (size_t)(bb * HY_UR + HY_UP + t0) * 2);
                const v2u uu = *up; const v2u xx = *(const LAS v2u*)(XB + (size_t)(bb * SEQ + t0) * 2);
                v2u o;
                o.x = pk2(bflo(xx.x) * (C[i][0] + bflo(uu.x) * sk), bfhi(xx.x) * (C[i][1] + bfhi(uu.x) * sk));
                o.y = pk2(bflo(xx.y) * (C[i][2] + bflo(uu.y) * sk), bfhi(xx.y) * (C[i][3] + bfhi(uu.y) * sk));
                *up = o;
            }
        }
        __syncthreads();
        hy_filt_build(F, fF);
        { const int ch = 2 * HYC + c; hy_short_store(XB, SEQ, 0, sG, cw[ch], cw[1536 + ch], cw[3072 + ch], cbp[ch], F.tid); }
        const int cn = c + F.G; const bool more = cn < HYC;
        if (more) { hy_short_load(sA, zT + (size_t)cn * T, F.tid); hy_filt_load(fB, Hf, 0, cn, F.tid); hy_short_load(sC, zT + (size_t)(HYC + cn) * T, F.tid); }
        __syncthreads();
        hy_conv_mfma(F, C);
        {   const float sk = skip[HYC + c];
#pragma unroll
            for (int i = 0; i < 8; ++i) {
                const int t0 = 32 * (8 * w + i) + 16 * hh + 4 * rq;
                const v2u uu = *(const LAS v2u*)(UB + (size_t)(bb * HY_UR + HY_UP + t0) * 2); const v2u xx = *(const LAS v2u*)(XB + (size_t)(bb * SEQ + t0) * 2);
                v2u o;
                o.x = pk2(bflo(xx.x) * (C[i][0] + bflo(uu.x) * sk), bfhi(xx.x) * (C[i][1] + bfhi(uu.x) * sk));
                o.y = pk2(bflo(xx.y) * (C[i][2] + bflo(uu.y) * sk), bfhi(xx.y) * (C[i][3] + bfhi(uu.y) * sk));
                *(v2u*)(yT + (size_t)c * T + bb * SEQ + t0) = o;
            }
        }
        if (!more) break;
        c = cn;
    }
}
__device__ __forceinline__ void hy_transpose_tile(Frame& F, int tile) {
    const bf16* yT = (const bf16*)(F.ws + WS_YT); bf16* mix = (bf16*)(F.ws + WS_MIX0);
    LAS unsigned* scr = (LAS unsigned*)(F.lds + F.wave * (64 * 36 * 4));
    const int lane = F.lane, ct = tile & 7, tt = tile >> 3, c0 = 64 * ct, tok0 = 64 * tt;
    const int rr = lane >> 3, ch = lane & 7;
    v4u raw[8];
#pragma unroll
    for (int i = 0; i < 8; ++i) raw[i] = *(const v4u*)(yT + (size_t)(c0 + 8 * i + rr) * T + tok0 + 8 * ch);
#pragma unroll
    for (int i = 0; i < 8; ++i) {
        v4u o; o.x = __shfl_xor(raw[i].x, 8); o.y = __shfl_xor(raw[i].y, 8); o.z = __shfl_xor(raw[i].z, 8); o.w = __shfl_xor(raw[i].w, 8);
        const bool odd = rr & 1;
        const unsigned a0 = odd ? o.z : raw[i].x, a1 = odd ? o.w : raw[i].y;
        const unsigned b0 = odd ? raw[i].z : o.x, b1 = odd ? raw[i].w : o.y;
        const int cp = (8 * i + (rr & ~1)) >> 1;
        const int tb = 8 * ch + (odd ? 4 : 0);
        scr[(tb + 0) * 36 + cp] = (a0 & 0xffffu) | (b0 << 16);
        scr[(tb + 1) * 36 + cp] = (a0 >> 16) | (b0 & 0xffff0000u);
        scr[(tb + 2) * 36 + cp] = (a1 & 0xffffu) | (b1 << 16);
        scr[(tb + 3) * 36 + cp] = (a1 >> 16) | (b1 & 0xffff0000u);
    }
    LDS_WAIT(); asm volatile("" ::: "memory");
#pragma unroll
    for (int i = 0; i < 8; ++i) { const int tk = 8 * i + rr; const v4u w = *(const LAS v4u*)(scr + tk * 36 + 4 * ch);
        *(v4u*)(mix + (size_t)(tok0 + tk) * D + c0 + 8 * ch) = w; }
    LDS_WAIT(); asm volatile("" ::: "memory");
}

constexpr int AT_KSTR = 136;
template <int NT, bool DIL>
__device__ __forceinline__ void attn_wave16(const LAS unsigned char* Ks, const LAS unsigned char* VT, int vstr, int k0, const bf16* qrow, const LAS float* bt, int dil, int relbase, int lbase, int L,
                                            bf16* orow, float* lse_out, int lane) {
    const int r = lane & 15, rq = lane >> 4;
    bf16x8_t Qf[4];
    {
        v4u raw[4]; float ss = 0.f;
#pragma unroll
        for (int st = 0; st < 4; ++st) { raw[st] = *(const v4u*)(qrow + 32 * st + 8 * rq);
            const float a0 = bflo(raw[st].x), a1 = bfhi(raw[st].x), a2 = bflo(raw[st].y), a3 = bfhi(raw[st].y), a4 = bflo(raw[st].z), a5 = bfhi(raw[st].z), a6 = bflo(raw[st].w), a7 = bfhi(raw[st].w);
            ss += (a0 * a0 + a1 * a1) + (a2 * a2 + a3 * a3) + (a4 * a4 + a5 * a5) + (a6 * a6 + a7 * a7); }
        ss += __shfl_xor(ss, 16); ss += __shfl_xor(ss, 32);
        const float sc = 0.08838834764831845f / sqrtf(ss * (1.f / 128.f) + EPS);
#pragma unroll
        for (int st = 0; st < 4; ++st) { v4u w;
            w.x = pk2(bflo(raw[st].x) * sc, bfhi(raw[st].x) * sc); w.y = pk2(bflo(raw[st].y) * sc, bfhi(raw[st].y) * sc);
            w.z = pk2(bflo(raw[st].z) * sc, bfhi(raw[st].z) * sc); w.w = pk2(bflo(raw[st].w) * sc, bfhi(raw[st].w) * sc);
            Qf[st] = __builtin_bit_cast(bf16x8_t, w); }
    }
    f32x4 S[NT];
    const LAS unsigned char* kb = Ks + (size_t)(k0 + r) * (AT_KSTR * 2) + 16 * rq;
#pragma unroll
    for (int kt = 0; kt < NT; ++kt) {
        f32x4 acc = (f32x4){0.f, 0.f, 0.f, 0.f};
#pragma unroll
        for (int st = 0; st < 4; ++st) { const bf16x8_t A = *(const LAS bf16x8_t*)(kb + kt * 16 * (AT_KSTR * 2) + 64 * st); acc = __builtin_amdgcn_mfma_f32_16x16x32_bf16(A, Qf[st], acc, 0, 0, 0); }
        S[kt] = acc;
        asm volatile("" ::: "memory");
    }
    float mx = -3.0e38f;
#pragma unroll
    for (int kt = 0; kt < NT; ++kt)
#pragma unroll
        for (int g = 0; g < 4; ++g) {
            float s = S[kt][g];
            if (DIL) { const int rel = relbase + 16 * kt + g, lk = lbase + 16 * kt + g; const bool ok = (lk >= 0) && (lk < L);
                s = ok ? s + bt[rel + 128] : -3.0e38f; S[kt][g] = s; }
            mx = fmaxf(mx, s);
        }
    mx = fmaxf(mx, __shfl_xor(mx, 16)); mx = fmaxf(mx, __shfl_xor(mx, 32));
    float z = 0.f;
#pragma unroll
    for (int kt = 0; kt < NT; ++kt)
#pragma unroll
        for (int g = 0; g < 4; ++g) { const float p = __expf(S[kt][g] - mx); S[kt][g] = p; z += p; }
    z += __shfl_xor(z, 16); z += __shfl_xor(z, 32);
    const float iz = 1.0f / z;
    bf16x8_t Pf[NT / 2];
#pragma unroll
    for (int ks = 0; ks < NT / 2; ++ks) { v4u w; w.x = pk2(S[2 * ks][0], S[2 * ks][1]); w.y = pk2(S[2 * ks][2], S[2 * ks][3]); w.z = pk2(S[2 * ks + 1][0], S[2 * ks + 1][1]); w.w = pk2(S[2 * ks + 1][2], S[2 * ks + 1][3]);
        Pf[ks] = __builtin_bit_cast(bf16x8_t, w); }
    const LAS unsigned char* vb = VT + ((size_t)r * vstr + k0 + 4 * rq) * 2;
#pragma unroll
    for (int dt = 0; dt < 8; ++dt) {
        f32x4 o = (f32x4){0.f, 0.f, 0.f, 0.f};
#pragma unroll
        for (int ks = 0; ks < NT / 2; ++ks) {
            const LAS unsigned char* p = vb + (size_t)dt * 16 * vstr * 2 + 64 * ks;
            const v2u lo = *(const LAS v2u*)p, hi = *(const LAS v2u*)(p + 32);
            v4u w; w.x = lo.x; w.y = lo.y; w.z = hi.x; w.w = hi.y;
            o = __builtin_amdgcn_mfma_f32_16x16x32_bf16(__builtin_bit_cast(bf16x8_t, w), Pf[ks], o, 0, 0, 0);
        }
        v2u ow; ow.x = pk2(o[0] * iz, o[1] * iz); ow.y = pk2(o[2] * iz, o[3] * iz);
        *(v2u*)(orow + 16 * dt + 4 * rq) = ow;
        asm volatile("" ::: "memory");
    }
    if (DIL) { if (rq == 0) *lse_out = mx + logf(z); }
}
template <int NB, int BS, class RowFn>
__device__ __forceinline__ void attn_stage_k(LAS unsigned char* Ks, int nk, const float* qg, const float* kg, const bf16* kbase, RowFn rowoff, int wave, int lane) {
    const int rr = lane >> 4, cc = lane & 15;
    float gf[8];
    { const f32x4 a0 = *(const f32x4*)(qg + 8 * cc), a1 = *(const f32x4*)(qg + 8 * cc + 4), b0 = *(const f32x4*)(kg + 8 * cc), b1 = *(const f32x4*)(kg + 8 * cc + 4);
      gf[0] = a0.x * b0.x; gf[1] = a0.y * b0.y; gf[2] = a0.z * b0.z; gf[3] = a0.w * b0.w; gf[4] = a1.x * b1.x; gf[5] = a1.y * b1.y; gf[6] = a1.z * b1.z; gf[7] = a1.w * b1.w; }
#pragma unroll 1
    for (int bt = 0; bt < NB; ++bt) {
        v4u raw[BS];
#pragma unroll
        for (int i = 0; i < BS; ++i) { const int j = ((bt * BS + i) * 8 + wave) * 4 + rr; const long off = (j < nk) ? rowoff(j) : -1;
            raw[i] = *(const v4u*)(kbase + (off < 0 ? 0 : off) + 8 * cc); if (off < 0) raw[i] = (v4u){0u, 0u, 0u, 0u}; }
#pragma unroll
        for (int i = 0; i < BS; ++i) { const int j = ((bt * BS + i) * 8 + wave) * 4 + rr;
            const float k0 = bflo(raw[i].x), k1 = bfhi(raw[i].x), k2 = bflo(raw[i].y), k3 = bfhi(raw[i].y), k4 = bflo(raw[i].z), k5 = bfhi(raw[i].z), k6 = bflo(raw[i].w), k7 = bfhi(raw[i].w);
            float ss = (k0 * k0 + k1 * k1) + (k2 * k2 + k3 * k3) + (k4 * k4 + k5 * k5) + (k6 * k6 + k7 * k7);
            ss += __shfl_xor(ss, 1); ss += __shfl_xor(ss, 2); ss += __shfl_xor(ss, 4); ss += __shfl_xor(ss, 8);
            const float sc = 1.0f / sqrtf(ss * (1.f / 128.f) + EPS);
            v4u w; w.x = pk2(k0 * sc * gf[0], k1 * sc * gf[1]); w.y = pk2(k2 * sc * gf[2], k3 * sc * gf[3]); w.z = pk2(k4 * sc * gf[4], k5 * sc * gf[5]); w.w = pk2(k6 * sc * gf[6], k7 * sc * gf[7]);
            if (j < nk) *(LAS v4u*)(Ks + (size_t)j * (AT_KSTR * 2) + 16 * cc) = w; }
    }
}
__device__ __forceinline__ void attn_stage_vpair(LAS unsigned char* VT, int vstr, int j0, int dch, const v4u va, const v4u vb) {
    LAS unsigned char* p = VT + ((size_t)(8 * dch) * vstr + j0) * 2;
    const size_t rs = (size_t)vstr * 2;
    *(LAS unsigned*)(p + 0 * rs) = (va.x & 0xffffu) | (vb.x << 16);         *(LAS unsigned*)(p + 1 * rs) = (va.x >> 16) | (vb.x & 0xffff0000u);
    *(LAS unsigned*)(p + 2 * rs) = (va.y & 0xffffu) | (vb.y << 16);         *(LAS unsigned*)(p + 3 * rs) = (va.y >> 16) | (vb.y & 0xffff0000u);
    *(LAS unsigned*)(p + 4 * rs) = (va.z & 0xffffu) | (vb.z << 16);         *(LAS unsigned*)(p + 5 * rs) = (va.z >> 16) | (vb.z & 0xffff0000u);
    *(LAS unsigned*)(p + 6 * rs) = (va.w & 0xffffu) | (vb.w << 16);         *(LAS unsigned*)(p + 7 * rs) = (va.w >> 16) | (vb.w & 0xffff0000u);
}
template <int NB, int BS, int NPR, class RowFn>
__device__ __forceinline__ void attn_stage_v(LAS unsigned char* VT, int vstr, const bf16* vbase, RowFn rowoff, int tid) {
#pragma unroll 1
    for (int bt = 0; bt < NB; ++bt) {
        v4u va[BS], vb[BS];
#pragma unroll
        for (int k = 0; k < BS; ++k) { const int it = tid + 512 * (bt * BS + k), pr = it % NPR, dch = it / NPR;
            const long oa = (it < NPR * 16) ? rowoff(2 * pr) : -1, ob = (it < NPR * 16) ? rowoff(2 * pr + 1) : -1;
            va[k] = *(const v4u*)(vbase + (oa < 0 ? 0 : oa + 8 * dch)); vb[k] = *(const v4u*)(vbase + (ob < 0 ? 0 : ob + 8 * dch));
            if (oa < 0) va[k] = (v4u){0u, 0u, 0u, 0u}; if (ob < 0) vb[k] = (v4u){0u, 0u, 0u, 0u}; }
#pragma unroll
        for (int k = 0; k < BS; ++k) { const int it = tid + 512 * (bt * BS + k), pr = it % NPR, dch = it / NPR; if (it < NPR * 16) attn_stage_vpair(VT, vstr, 2 * pr, dch, va[k], vb[k]); }
    }
}

constexpr int XA_VSTR = 264, XA_OFF_VT = 256 * AT_KSTR * 2;
static_assert(XA_OFF_VT + 128 * XA_VSTR * 2 <= SCR_BYTES, "cross LDS");
__device__ __forceinline__ void cross_unit(Frame& F, const bf16* xq, const bf16* kv, const float* qg, const float* kg, bf16* mix, int unit) {
    int lane = (int)__builtin_amdgcn_mbcnt_hi(~0u, __builtin_amdgcn_mbcnt_lo(~0u, 0u)); asm volatile("" : "+v"(lane)); const int tid = F.wave * 64 + lane;
    const int b = unit >> 5, h = (unit >> 3) & 3, qc = unit & 7;
    LAS unsigned char* Ks = F.lds; LAS unsigned char* VT = F.lds + XA_OFF_VT;
    const bf16* kbase = kv + (size_t)(b * MEML) * 1024 + h * 128;
    __syncthreads();
    attn_stage_k<2, 4>(Ks, MEML, qg, kg, kbase, [=](int j) { return (long)j * 1024; }, F.wave, lane);
    attn_stage_v<2, 2, 128>(VT, XA_VSTR, kbase + 512, [=](int j) { return (long)j * 1024; }, tid);
    __syncthreads();
#pragma unroll 1
    for (int a = F.wave; a < 16; a += NWAVES) {
        const int token = b * SEQ + qc * 256 + 16 * a + (lane & 15);
        attn_wave16<16, false>(Ks, VT, XA_VSTR, 0, xq + (size_t)token * 512 + h * 128, nullptr, 1, 0, 0, 0, mix + (size_t)token * D + 512 + h * 128, nullptr, lane);
    }
}
constexpr int DA_VSTR = 280, DA_NK = 272, DA_OFF_VT = DA_NK * AT_KSTR * 2, DA_OFF_BT = DA_OFF_VT + 128 * DA_VSTR * 2;
static_assert(DA_OFF_BT + 320 * 4 <= SCR_BYTES, "dilated LDS");
__device__ __forceinline__ void dil_unit(Frame& F, const Args& a, int unit) {
    const int bh = unit / 48, sub = unit % 48, b = bh >> 2, h = bh & 3, g = sub >> 4, w16 = sub & 15;
    const int dil = (g == 0) ? 1 : (g == 1 ? 4 : 16), L = SEQ / dil, nch = L / 128;
    const int r = w16 / nch, n128 = w16 % nch;
    int lane = (int)__builtin_amdgcn_mbcnt_hi(~0u, __builtin_amdgcn_mbcnt_lo(~0u, 0u)); asm volatile("" : "+v"(lane)); const int tid = F.wave * 64 + lane;
    const bf16* qkv = (const bf16*)(F.ws + WS_QKV1);
    float* lse = (float*)(F.ws + WS_LSE);
    LAS unsigned char* Ks = F.lds; LAS unsigned char* VT = F.lds + DA_OFF_VT; LAS float* bt = (LAS float*)(F.lds + DA_OFF_BT);
    const int lk0 = 128 * n128 - 64;
    const bf16* base = qkv + (size_t)(b * SEQ + r) * NQKV + g * 512 + h * 128;
    const size_t lstep = (size_t)dil * NQKV;
    __syncthreads();
    if (tid < 320) { const int rel = tid - 128; bt[tid] = (rel >= -64 && rel <= 64) ? a.in[I_RELB][rel_bucket_dev(rel * dil) * 12 + g * 4 + h] : -3.0e38f; }
    attn_stage_k<3, 3>(Ks, DA_NK, a.in[I_ATQN], a.in[I_ATKN], base + ATW, [=](int j) { const int lk = lk0 + j; return (lk >= 0 && lk < L) ? (long)lk * (long)lstep : -1L; }, F.wave, lane);
    attn_stage_v<3, 2, DA_NK / 2>(VT, DA_VSTR, base + 2 * ATW, [=](int j) { const int lk = lk0 + j; return (lk >= 0 && lk < L) ? (long)lk * (long)lstep : -1L; }, tid);
    __syncthreads();
    {
        const int aq = F.wave, i = 16 * aq + (lane & 15), lq = 128 * n128 + i, token = b * SEQ + lq * dil + r, k0 = 16 * aq, rq = lane >> 4;
        attn_wave16<10, true>(Ks, VT, DA_VSTR, k0, base + (size_t)lq * lstep, bt, dil, k0 + 4 * rq - 64 - i, lk0 + k0 + 4 * rq, L,
                              (g == 0) ? (bf16*)(F.ws + WS_MIX1) + (size_t)token * D + h * 128 : (bf16*)(F.ws + WS_OG12) + ((size_t)(g - 1) * T + token) * 512 + h * 128,
                              lse + ((size_t)g * T + token) * 4 + h, lane);
    }
}
__device__ __forceinline__ void combine_phase(Frame& F, const Args& a) {
    moe_layout(F);
    const int gw = F.bid * NWAVES + F.wave, NGW = F.G * NWAVES, lane = F.lane;
    const int* toke = (const int*)(F.ws + WS_TOKE); const int* tokr = (const int*)(F.ws + WS_TOKR); const float* tokg = (const float*)(F.ws + WS_TOKG);
    const bf16* y = (const bf16*)(F.ws + WS_XS); const bf16* y2 = (const bf16*)(F.ws + WS_Y2);
    for (int token = gw; token < T; token += NGW) {
        const int e0 = toke[token * 2], e1 = toke[token * 2 + 1];
        const int s0 = ml_ps(F, e0) + tokr[token * 2], s1 = ml_ps(F, e1) + tokr[token * 2 + 1];
        const float g0 = tokg[token * 2], g1 = tokg[token * 2 + 1];
        f32x4* xo = (f32x4*)(a.out + (size_t)token * D); const v2u* xi = (const v2u*)((const bf16*)a.out + (size_t)token * 2048 + 1024);
        const v2u* y0 = (const v2u*)(y + (size_t)s0 * D); const v2u* y1 = (const v2u*)(y + (size_t)s1 * D);
        v2u xw[4], p0[4], p1[4];
#pragma unroll
        for (int j = 0; j < 4; ++j) { const int q = lane + 64 * j; xw[j] = xi[q]; p0[j] = y0[q]; p1[j] = y1[q]; }
        f32x4 r[4];
#pragma unroll
        for (int j = 0; j < 4; ++j) {
            const int q = lane + 64 * j;
            f32x4 x = (f32x4){bflo(xw[j].x), bfhi(xw[j].x), bflo(xw[j].y), bfhi(xw[j].y)};
            f32x4 a0 = (f32x4){bflo(p0[j].x), bfhi(p0[j].x), bflo(p0[j].y), bfhi(p0[j].y)}, a1 = (f32x4){bflo(p1[j].x), bfhi(p1[j].x), bflo(p1[j].y), bfhi(p1[j].y)};
            if (s0 >= 2 * T) { const v2u t = ((const v2u*)(y2 + (size_t)(s0 - 2 * T) * D))[q]; a0 = a0 + (f32x4){bflo(t.x), bfhi(t.x), bflo(t.y), bfhi(t.y)}; }
            if (s1 >= 2 * T) { const v2u t = ((const v2u*)(y2 + (size_t)(s1 - 2 * T) * D))[q]; a1 = a1 + (f32x4){bflo(t.x), bfhi(t.x), bflo(t.y), bfhi(t.y)}; }
            r[j] = x + g0 * a0 + g1 * a1;
        }
        asm volatile("s_waitcnt vmcnt(0)" ::: "memory");
#pragma unroll
        for (int j = 0; j < 4; ++j) xo[lane + 64 * j] = r[j];
    }
}

constexpr int NPHASE = 15;
__global__ void __launch_bounds__(NWAVES * 64, 2) mega_fwd(Args args) {
    extern __shared__ __attribute__((aligned(16))) unsigned char lds_raw[];
    Frame F;
    F.lds = (LAS unsigned char*)lds_raw; F.ws = args.ws;
    F.wave = __builtin_amdgcn_readfirstlane((int)threadIdx.x >> 6); F.G = gridDim.x; F.bid = blockIdx.x;
#define PH_BEGIN() do { int l_ = (int)__builtin_amdgcn_mbcnt_hi(~0u, __builtin_amdgcn_mbcnt_lo(~0u, 0u)); asm volatile("" : "+v"(l_)); F.lane = l_; F.tid = F.wave * 64 + l_; } while (0)
    PH_BEGIN();
    unsigned char* ws = args.ws;
    volatile LAS unsigned* MISC = (volatile LAS unsigned*)(F.lds + MISC_OFF);
    for (int u = F.tid; u < (LDS_BYTES - MISC_OFF) / 4; u += NWAVES * 64) MISC[u] = 0u;
    __syncthreads();
    const int lo = args.ph_lo, hi = args.ph_hi;
    const bool use_bar = (hi - lo) > 1;
    XcdBarrier bar; bar.bar = (unsigned*)(ws + WS_CTL) + CW_BAR + args.bslot * XCD_BAR_WORDS; bar.x = 0; bar.st = nullptr;
    if (use_bar) bar = xcd_barrier_post((unsigned*)(ws + WS_CTL) + CW_BAR + args.bslot * XCD_BAR_WORDS, MISC + 8, F.tid);
#define IN(k) (lo <= (k) && (k) < hi)
#define SEAM(k) do { if (IN(k) && IN((k) + 1)) { PH_BEGIN(); xcd_barrier(bar, F.tid); } } while (0)
    const int gw = F.bid * NWAVES + F.wave, NGW = F.G * NWAVES;
    LAS unsigned char* ring = F.lds;

    if (IN(0)) { PH_BEGIN(); p0_prologue(F, args); }
    SEAM(0);
    if (IN(1)) { PH_BEGIN();
        {   pg8::Gemm g{(const bf16*)(ws + WS_WIN0), (const bf16*)(ws + WS_XB), D, D, D, 0};
            pg8::StaticOrder S; S.init(ATW / 256, T / 256, F.G, F.bid);
            EpiB<3> E{(bf16*)(ws + WS_ZT), T, (const float*)(ws + WS_RSTD0), 1 << 30, nullptr, 0, nullptr};
            pg8::gemm_phase<EpiB<3>, pg8::StaticOrder, true>(ring, g, S, E, F.wave); }
        {   pg8::Gemm g{(const bf16*)(ws + WS_XB), (const bf16*)(ws + WS_WIN0) + (size_t)ATW * D, D, D, D, 0};
            pg8::StaticOrder S; S.init(T / 256, 2, F.G, (F.bid + 128) % F.G);
            EpiB<1> E{(bf16*)(ws + WS_XQ0), 512, (const float*)(ws + WS_RSTD0), 1 << 30, nullptr, 0, nullptr};
            pg8::gemm_phase<EpiB<1>, pg8::StaticOrder, true>(ring, g, S, E, F.wave); }
        {   pg8::Gemm g{(const bf16*)(ws + WS_MN), (const bf16*)(ws + WS_WKV), D, D, D, (size_t)D * D * 2};
            pg8::MoeOrder S; S.init(2 * TM / 256, 4, F.G, F.bid); S.t0 = TM / 256; S.t1 = S.t2 = S.t3 = S.t4 = S.t5 = S.t6 = 1 << 30; S.lay = nullptr; S.list = nullptr;
            EpiB<0> E{(bf16*)(ws + WS_KV), D, nullptr, 1 << 30, nullptr, 0, nullptr};
            pg8::gemm_phase<EpiB<0>, pg8::MoeOrder, true>(ring, g, S, E, F.wave); }
        if (F.G == 256 && F.bid >= 64) { PH_BEGIN(); moe_convert(F, args, 0, MOE_P1_HI, (F.bid - 64) * NWAVES + F.wave, 192 * NWAVES); }
    }
    SEAM(1);
    if (IN(2)) { PH_BEGIN();
        hyena_units(F, args);
        for (int u = F.bid; u < 256; u += F.G)
            cross_unit(F, (const bf16*)(ws + WS_XQ0), (const bf16*)(ws + WS_KV), args.in[I_XQN], args.in[I_XKN], (bf16*)(ws + WS_MIX0), u);
    }
    SEAM(2);
    if (IN(3)) { PH_BEGIN(); for (int t = gw; t < 2048; t += NGW) hy_transpose_tile(F, t); }
    SEAM(3);
    if (IN(4)) { PH_BEGIN();
        pg8::Gemm g{(const bf16*)(ws + WS_MIX0), (const bf16*)(ws + WS_WO), D, D, D, 0};
        pg8::StaticOrder S; S.init(T / 256, 4, F.G, F.bid);
        EpiRes<false, true> E{nullptr, (const bf16*)(ws + WS_XB), D, (bf16*)(ws + WS_XB), D, (float*)(ws + WS_SSQ16)};
        pg8::gemm_phase<EpiRes<false, true>, pg8::StaticOrder, true>(ring, g, S, E, F.wave);
    }
    SEAM(4);
    if (IN(5)) { PH_BEGIN();
        pg8::Gemm g{(const bf16*)(ws + WS_XB), (const bf16*)(ws + WS_WGU0), D, D, D, 0};
        pg8::StaticOrder S; S.init(T / 256, NGU / 256, F.G, F.bid);
        fill_rstd_table(F.lds, S, (const float*)(ws + WS_SSQ16), F.tid);
        EpiSwiglu<4> E{(bf16*)(ws + WS_HID0), FF, nullptr, (const LAS float*)(F.lds + RSL_OFF)};
        pg8::gemm_phase<EpiSwiglu<4>, pg8::StaticOrder, true>(ring, g, S, E, F.wave);
        if (F.G == 256 && F.bid >= 128) { PH_BEGIN(); moe_convert(F, args, MOE_P1_HI, MOE_P5_HI, (F.bid - 128) * NWAVES + F.wave, 128 * NWAVES); }
    }
    SEAM(5);
    if (IN(6)) { PH_BEGIN();
        pg8::Gemm g{(const bf16*)(ws + WS_HID0), (const bf16*)(ws + WS_WD0), FF, FF, FF, 0};
        pg8::StaticOrder S; S.init(T / 256, 4, F.G, F.bid);
        EpiRes<false, true> E{nullptr, (const bf16*)(ws + WS_XB), D, (bf16*)(ws + WS_XB), D, (float*)(ws + WS_SSQ16)};
        pg8::gemm_phase<EpiRes<false, true>, pg8::StaticOrder, true>(ring, g, S, E, F.wave);
    }
    SEAM(6);
    if (IN(7)) { PH_BEGIN();
        pg8::Gemm g{(const bf16*)(ws + WS_XB), (const bf16*)(ws + WS_WIN1), D, D, D, 0};
        pg8::StaticOrder S; S.init(T / 256, NQ1 / 256, F.G, F.bid);
        fill_rstd_table(F.lds, S, (const float*)(ws + WS_SSQ16), F.tid);
        EpiB<4> E{(bf16*)(ws + WS_QKV1), NQKV, nullptr, NQKV / 256, (bf16*)(ws + WS_XQ1), 512, (const LAS float*)(F.lds + RSL_OFF)};
        pg8::gemm_phase<EpiB<4>, pg8::StaticOrder, true>(ring, g, S, E, F.wave);
    }
    SEAM(7);
    if (IN(8)) { PH_BEGIN();
        for (int u = F.bid; u < NB * 4 * 48; u += F.G) dil_unit(F, args, u);
        for (int u = F.bid; u < 256; u += F.G)
            cross_unit(F, (const bf16*)(ws + WS_XQ1), (const bf16*)(ws + WS_KV) + (size_t)TM * D, args.in[I_XQN] + 128, args.in[I_XKN] + 128, (bf16*)(ws + WS_MIX1), u);
    }
    SEAM(8);
    if (IN(9)) { PH_BEGIN(); for (int t = gw; t < T; t += NGW) merge_token(F, t); }
    SEAM(9);
    if (IN(10)) { PH_BEGIN();
        pg8::Gemm g{(const bf16*)(ws + WS_MIX1), (const bf16*)(ws + WS_WO) + (size_t)D * D, D, D, D, 0};
        pg8::StaticOrder S; S.init(T / 256, 4, F.G, F.bid);
        EpiRes<false, false> E{nullptr, (const bf16*)(ws + WS_XB), D, (bf16*)args.out + 1024, 2048, nullptr};
        pg8::gemm_phase<EpiRes<false, false>, pg8::StaticOrder, true>(ring, g, S, E, F.wave);
    }
    SEAM(10);
    if (IN(11)) { PH_BEGIN(); for (int blk = F.bid; blk < T / 64; blk += F.G) route_block(F, args, blk); }
    SEAM(11);
    if (IN(12)) { PH_BEGIN();
        moe_layout(F);
        pg8::Gemm g{(const bf16*)(ws + WS_XB3), (const bf16*)(ws + WS_WGU1), D, D, D, (size_t)NGU * D * 2};
        pg8::MoeOrder S; S.init(ml_total(F) / 256, NGU / 256, F.G, F.bid); S.lay = (const volatile LAS int*)(F.lds + MISC_OFF); S.list = (const int*)(ws + WS_LIST);
        S.t0 = ml_ps(F, 1) / 256; S.t1 = ml_ps(F, 2) / 256; S.t2 = ml_ps(F, 3) / 256; S.t3 = ml_ps(F, 4) / 256; S.t4 = ml_ps(F, 5) / 256; S.t5 = ml_ps(F, 6) / 256; S.t6 = ml_ps(F, 7) / 256;
        EpiSwiglu<0> E{(bf16*)(ws + WS_HID1), FF, nullptr, nullptr};
        if (F.bid & 1) { __builtin_amdgcn_s_sleep(127); __builtin_amdgcn_s_sleep(127); __builtin_amdgcn_s_sleep(127); }
        pg8::gemm_phase<EpiSwiglu<0>, pg8::MoeOrder, true, true>(ring, g, S, E, F.wave);
    }
    SEAM(12);
    if (IN(13)) { PH_BEGIN();
        moe_layout(F);
        const int nMt = ml_total(F) / 256;
        {   pg8::Gemm g{(const bf16*)(ws + WS_HID1), (const bf16*)(ws + WS_WD1), FF, FF, FF, (size_t)D * FF * 2};
            pg8::MoeOrder S; S.init(nMt < 128 ? nMt : 128, 4, F.G, F.bid); S.lay = nullptr; S.list = nullptr;
            S.t0 = ml_ps(F, 1) / 256; S.t1 = ml_ps(F, 2) / 256; S.t2 = ml_ps(F, 3) / 256; S.t3 = ml_ps(F, 4) / 256; S.t4 = ml_ps(F, 5) / 256; S.t5 = ml_ps(F, 6) / 256; S.t6 = ml_ps(F, 7) / 256;
            EpiB<0> E{(bf16*)(ws + WS_XS), D, nullptr, 1 << 30, nullptr, 0, nullptr};
            pg8::gemm_phase<EpiB<0>, pg8::MoeOrder, true>(ring, g, S, E, F.wave); }
        if (nMt > 128) {
            pg8::Gemm g{(const bf16*)(ws + WS_HID1), (const bf16*)(ws + WS_WD1), FF, FF, FF / 2, (size_t)D * FF * 2};
            pg8::MoeTailOrder S; S.pm0 = 128; S.ntail = nMt - 128; S.nN = 4; S.G = F.G; S.c = F.bid; S.khalf = FF;
            S.t0 = ml_ps(F, 1) / 256; S.t1 = ml_ps(F, 2) / 256; S.t2 = ml_ps(F, 3) / 256; S.t3 = ml_ps(F, 4) / 256; S.t4 = ml_ps(F, 5) / 256; S.t5 = ml_ps(F, 6) / 256; S.t6 = ml_ps(F, 7) / 256;
            EpiB<0> E{(bf16*)(ws + WS_XS), D, nullptr, 1 << 30, (bf16*)(ws + WS_Y2) - (size_t)2 * T * D, D, nullptr};
            pg8::gemm_phase<EpiB<0>, pg8::MoeTailOrder, true>(ring, g, S, E, F.wave); }
    }
    SEAM(13);
    if (IN(14)) { PH_BEGIN(); combine_phase(F, args); }
#undef IN
#undef SEAM
}

#ifndef MK_ONE_LAUNCH
#define MK_ONE_LAUNCH 1
#endif
extern "C" void kernel_launch(void* const* d_in, const int* in_sizes, int n_in, void* d_out, int out_size, void* d_ws, size_t ws_size, hipStream_t stream) {
    static int grid = 0;
    if (grid == 0) {
        if (n_in != 30 || in_sizes[0] != T * D || out_size != T * D || ws_size < WS_END) {
            fprintf(stderr, "kernel_launch: unexpected problem (n_in %d, in0 %d, out %d, ws %zu, need %zu); nothing launched\n", n_in, n_in > 0 ? in_sizes[0] : -1, out_size, ws_size, (size_t)WS_END); grid = -1; return; }
        int dev = 0, cus = 0, per_cu = 0;
        if (hipGetDevice(&dev) != hipSuccess || hipDeviceGetAttribute(&cus, hipDeviceAttributeMultiprocessorCount, dev) != hipSuccess) { grid = -1; return; }
        if (hipFuncSetAttribute((const void*)mega_fwd, hipFuncAttributeMaxDynamicSharedMemorySize, LDS_BYTES) != hipSuccess) { fprintf(stderr, "kernel_launch: hipFuncSetAttribute failed\n"); grid = -1; return; }
        if (hipOccupancyMaxActiveBlocksPerMultiprocessor(&per_cu, (const void*)mega_fwd, NWAVES * 64, LDS_BYTES) != hipSuccess || per_cu < 1)
            fprintf(stderr, "kernel_launch: note: occupancy query reports %d workgroups per CU\n", per_cu);
        (void)hipGetLastError();
        grid = cus;
    }
    if (grid < 0) return;
    if (hipMemsetAsync((char*)d_ws + WS_CTL, 0, CTL_ZERO_BYTES, stream) != hipSuccess) return;
    Args a{};
    for (int i = 0; i < 30; ++i) a.in[i] = (const float*)d_in[i];
    a.out = (float*)d_out; a.ws = (unsigned char*)d_ws;
#if defined(PROBE_PHASE)
    a.ph_lo = 0; a.ph_hi = PROBE_PHASE + 1; a.bslot = 0;
    hipLaunchKernelGGL(mega_fwd, dim3(grid), dim3(NWAVES * 64), LDS_BYTES, stream, a);
    a.ph_lo = PROBE_PHASE; a.ph_hi = NPHASE; a.bslot = 1;
    hipLaunchKernelGGL(mega_fwd, dim3(grid), dim3(NWAVES * 64), LDS_BYTES, stream, a);
#elif MK_ONE_LAUNCH
    a.ph_lo = 0; a.ph_hi = NPHASE; a.bslot = 0;
    hipLaunchKernelGGL(mega_fwd, dim3(grid), dim3(NWAVES * 64), LDS_BYTES, stream, a);
#else
    for (int p = 0; p < NPHASE; ++p) { a.ph_lo = p; a.ph_hi = p + 1; a.bslot = 0; hipLaunchKernelGGL(mega_fwd, dim3(grid), dim3(NWAVES * 64), LDS_BYTES, stream, a); }
#endif
}
```

```cpp
#include <hip/hip_runtime.h>
#include <cstdio>
#include <cstdint>

namespace pg8 {
#define PG8_LAS __attribute__((address_space(3)))
typedef unsigned short bf16_t;
typedef short bf16x8 __attribute__((ext_vector_type(8)));
typedef float f32x4 __attribute__((ext_vector_type(4)));
typedef unsigned u32x4 __attribute__((ext_vector_type(4)));
constexpr int BM = 256, BK = 64, HALF = 128, HTB = HALF * BK * 2  , STAGE_BYTES = 8 * HTB, NXCD = 8, WGM = 8;

__host__ __device__ __forceinline__ int lds_byte(int r, int c) { const int st = (r >> 4) * 2 + (c >> 5), rr = r & 15, cc = c & 31, ob = rr * 64 + cc * 2; return st * 1024 + (ob ^ (((ob >> 9) & 1) << 5)); }
__host__ __device__ __forceinline__ void stage_rc(int b, int& R, int& C) { const int st = b / 1024, sb = b % 1024, swz = sb ^ (((sb >> 9) & 1) << 5); R = (st >> 1) * 16 + swz / 64; C = (st & 1) * 32 + (swz % 64) / 2; }
__host__ __device__ __forceinline__ int perm32(int rho) { const int n = rho >> 4, i = rho & 15; return 8 * (i >> 2) + 4 * n + (i & 3); }

struct Unit { int pm, pn, e, koff, idx; };
struct Gemm { const bf16_t* A; const bf16_t* Bt; int lda, ldb, K; size_t estride; };

struct StaticOrder {
    int nM, nN, nwg, G, c;
    __device__ __forceinline__ int gather_row(const Unit&, int slot) const { return slot; }
    __host__ __device__ void init(int nM_, int nN_, int G_, int c_) { nM = nM_; nN = nN_; nwg = nM * nN; G = G_; c = c_; }
    __host__ __device__ bool next(int i, Unit& u) const {
        const long L = (long)i * G + c; if (L >= nwg) return false;
        int wgid = (int)L; { const int q = nwg / NXCD, r = nwg % NXCD, xcd = wgid % NXCD, off = wgid / NXCD; wgid = (xcd < r ? xcd * (q + 1) : r * (q + 1) + (xcd - r) * q) + off; }
        const int nig = WGM * nN, gid = wgid / nig, fm = gid * WGM, gsz = (nM - fm) < WGM ? (nM - fm) : WGM;
        u.pm = fm + ((wgid % nig) % gsz); u.pn = (wgid % nig) / gsz; u.e = 0; u.koff = 0; return true;
    }
};
struct MoeOrder : StaticOrder {
    int t0, t1, t2, t3, t4, t5, t6;
    const volatile PG8_LAS int* lay;
    const int* list;
    __device__ __forceinline__ int gather_row(const Unit& u, int slot) const { const int rank = slot - lay[40 + u.e]; return rank < lay[32 + u.e] ? list[(size_t)u.e * 16384 + rank] : 0; }
    __host__ __device__ bool next(int i, Unit& u) const {
        if (!StaticOrder::next(i, u)) return false;
        const int p = u.pm; u.e = (p >= t0) + (p >= t1) + (p >= t2) + (p >= t3) + (p >= t4) + (p >= t5) + (p >= t6); return true;
    }
};

struct MoeTailOrder {
    int pm0, ntail, nN, G, c, khalf; int t0, t1, t2, t3, t4, t5, t6;
    __device__ __forceinline__ int gather_row(const Unit&, int slot) const { return slot; }
    __device__ __forceinline__ bool next(int i, Unit& u) const {
        const int L = i * G + c; if (L >= ntail * nN * 2) return false;
        const int kh = L & 1, q = L >> 1; u.pn = q % nN; u.pm = pm0 + q / nN; u.koff = kh * khalf;
        const int p = u.pm; u.e = (p >= t0) + (p >= t1) + (p >= t2) + (p >= t3) + (p >= t4) + (p >= t5) + (p >= t6); return true;
    }
};
struct MoeTailOrder2 {
    int pm0, ntail, nN, G, c, koff; int t0, t1, t2, t3, t4, t5, t6;
    __device__ __forceinline__ int gather_row(const Unit&, int slot) const { return slot; }
    __device__ __forceinline__ bool next(int i, Unit& u) const {
        const int L = i * G + c; if (L >= ntail * nN) return false;
        u.pn = L % nN; u.pm = pm0 + L / nN; u.koff = koff;
        const int p = u.pm; u.e = (p >= t0) + (p >= t1) + (p >= t2) + (p >= t3) + (p >= t4) + (p >= t5) + (p >= t6); return true;
    }
};
__device__ __forceinline__ unsigned cvt_pk_bf16(float lo, float hi) { unsigned r; asm volatile("v_cvt_pk_bf16_f32 %0, %1, %2" : "=v"(r) : "v"(lo), "v"(hi)); return r; }

typedef int v8i __attribute__((ext_vector_type(8)));
typedef int v4i __attribute__((ext_vector_type(4)));
template <class Epi, class Sched, bool ALIGN_EPI, bool GATHER = false, bool FP8 = false>
__device__ __forceinline__ void gemm_phase(PG8_LAS unsigned char* lds, const Gemm g, const Sched& S, const Epi& E, const int wid) {
    int lane = (int)__builtin_amdgcn_mbcnt_hi(~0u, __builtin_amdgcn_mbcnt_lo(~0u, 0u)); asm volatile("" : "+v"(lane));
    const int tid = wid * 64 + lane, wr = wid >> 2, wc = wid & 3, fr = lane & 15, fq = lane >> 4;
    const int K = g.K, nt = K / BK;
    unsigned cvo[4], nvo[4], voffB[2]; int rowA[2], colA[2];
#pragma unroll
    for (int i = 0; i < 2; ++i) { int R, C; stage_rc(tid * 16 + i * 8192, R, C); const int Rb = (R & ~31) + perm32(R & 31); rowA[i] = R; colA[i] = C;
        voffB[i] = (unsigned)(Rb * g.ldb + C) * 2u; }
    const size_t kstep = (size_t)(BK * 2);
    const size_t hstepB = (size_t)HALF * g.ldb * 2;
    const size_t tstepA = GATHER ? (size_t)0 : (size_t)2 * HALF * g.lda * 2, tstepB = 2 * hstepB;
#define PG8_ROWOFFS(vo, u) do { _Pragma("unroll") for (int _h = 0; _h < 2; ++_h) _Pragma("unroll") for (int _i = 0; _i < 2; ++_i) { \
        const int _r = _h * HALF + rowA[_i]; const unsigned _row = GATHER ? (unsigned)S.gather_row(u, (u).pm * BM + _r) : (unsigned)_r; \
        (vo)[2 * _h + _i] = (_row * (unsigned)g.lda + (unsigned)colA[_i]) * 2u; } } while (0)
    const unsigned ldsw = (unsigned)wid * 1024u;
    const int aoff = lds_byte(wr * 64 + fr, fq * 8), boff = lds_byte(wc * 32 + fr, fq * 8);
#define PG8_SA(b, h) (((b) * 2 + (h)) * HTB)
#define PG8_SB(b, h) ((4 + (b) * 2 + (h)) * HTB)
#define PG8_STAGE(bufoff, gbase, voff) do { _Pragma("unroll") for (int _i = 0; _i < 2; ++_i) \
        __builtin_amdgcn_global_load_lds((const unsigned*)((const char*)(gbase) + (voff)[_i]), (PG8_LAS unsigned*)(lds + (bufoff) + ldsw + _i * 8192), 16, 0, 0); } while (0)
#define PG8_STAGEA(bufoff, gbase, vo, h) do { _Pragma("unroll") for (int _i = 0; _i < 2; ++_i) \
        __builtin_amdgcn_global_load_lds((const unsigned*)((const char*)(gbase) + (vo)[2 * (h) + _i]), (PG8_LAS unsigned*)(lds + (bufoff) + ldsw + _i * 8192), 16, 0, 0); } while (0)
#define PG8_LDA(dst, b, h) do { _Pragma("unroll") for (int m = 0; m < 4; ++m) dst[m] = __builtin_shufflevector(*(const PG8_LAS v4i*)(lds + PG8_SA(b, h) + aoff + m * 2048), *(const PG8_LAS v4i*)(lds + PG8_SA(b, h) + aoff + m * 2048 + 1024), 0, 1, 2, 3, 4, 5, 6, 7); } while (0)
#define PG8_LDB(dst, b, h) do { _Pragma("unroll") for (int n = 0; n < 2; ++n) dst[n] = __builtin_shufflevector(*(const PG8_LAS v4i*)(lds + PG8_SB(b, h) + boff + n * 2048), *(const PG8_LAS v4i*)(lds + PG8_SB(b, h) + boff + n * 2048 + 1024), 0, 1, 2, 3, 4, 5, 6, 7); } while (0)
#define PG8_HALF(x, k) __builtin_bit_cast(bf16x8, __builtin_shufflevector(x, x, 4 * (k), 4 * (k) + 1, 4 * (k) + 2, 4 * (k) + 3))
#define PG8_MMA(ai, bj, At, Bt) do { if constexpr (FP8) __builtin_amdgcn_sched_barrier(0); __builtin_amdgcn_s_setprio(1); _Pragma("unroll") for (int m = 0; m < 4; ++m) _Pragma("unroll") for (int n = 0; n < 2; ++n) { \
        if constexpr (FP8) acc[ai][bj][m][n] = __builtin_amdgcn_mfma_scale_f32_16x16x128_f8f6f4(Bt[n], At[m], acc[ai][bj][m][n], 0, 0, 0, 0x7f7f7f7f, 0, 0x7f7f7f7f); \
        else { acc[ai][bj][m][n] = __builtin_amdgcn_mfma_f32_16x16x32_bf16(PG8_HALF(Bt[n], 0), PG8_HALF(At[m], 0), acc[ai][bj][m][n], 0, 0, 0); \
               acc[ai][bj][m][n] = __builtin_amdgcn_mfma_f32_16x16x32_bf16(PG8_HALF(Bt[n], 1), PG8_HALF(At[m], 1), acc[ai][bj][m][n], 0, 0, 0); } } \
        if constexpr (FP8) { _Pragma("unroll") for (int m = 0; m < 4; ++m) _Pragma("unroll") for (int n = 0; n < 2; ++n) asm volatile("" : "+v"(acc[ai][bj][m][n])); }   \
        __builtin_amdgcn_s_setprio(0); if constexpr (FP8) __builtin_amdgcn_sched_barrier(0); } while (0)
#define PG8_WAIT_V(n) asm volatile("s_waitcnt vmcnt(" #n ")" ::: "memory")
#define PG8_WAIT_L(n) asm volatile("s_waitcnt lgkmcnt(" #n ")" ::: "memory")
#define PG8_BAR __builtin_amdgcn_s_barrier()
#define PG8_SCHED __builtin_amdgcn_sched_barrier(0)
    Unit cur, nxt; int ui = 0;
    if (!S.next(0, cur)) return;
    cur.idx = 0;
    f32x4 acc[2][2][4][2];
#pragma unroll
    for (int a = 0; a < 2; ++a)
#pragma unroll
        for (int b = 0; b < 2; ++b)
#pragma unroll
            for (int m = 0; m < 4; ++m)
#pragma unroll
                for (int n = 0; n < 2; ++n) acc[a][b][m][n] = (f32x4){0.f, 0.f, 0.f, 0.f};
    v8i At[4], B0[2], B1[2];
    const char* cA = (const char*)g.A + (size_t)cur.pm * tstepA + cur.koff; const char* cB = (const char*)g.Bt + (size_t)cur.e * g.estride + (size_t)cur.pn * tstepB + cur.koff;
    PG8_ROWOFFS(cvo, cur);
#pragma unroll
    for (int i = 0; i < 4; ++i) nvo[i] = cvo[i];
    PG8_STAGE(PG8_SB(0, 0), cB, voffB); PG8_STAGE(PG8_SB(0, 1), cB + hstepB, voffB); PG8_STAGEA(PG8_SA(0, 0), cA, cvo, 0); PG8_STAGEA(PG8_SA(0, 1), cA, cvo, 1);
    if (wr == 1) PG8_BAR;
    PG8_WAIT_V(2); PG8_BAR;
    PG8_STAGE(PG8_SB(1, 0), cB + kstep, voffB); PG8_STAGEA(PG8_SA(1, 0), cA + kstep, cvo, 0); PG8_STAGE(PG8_SB(1, 1), cB + hstepB + kstep, voffB);
    PG8_WAIT_V(6); PG8_BAR;
    for (;;) {
        const bool has_next = S.next(ui + 1, nxt); nxt.idx = ui + 1;
        const char* nA = has_next ? (const char*)g.A + (size_t)nxt.pm * tstepA + nxt.koff : cA;
        const char* nB = has_next ? (const char*)g.Bt + (size_t)nxt.e * g.estride + (size_t)nxt.pn * tstepB + nxt.koff : cB;
        if constexpr (GATHER) { if (has_next) PG8_ROWOFFS(nvo, nxt); }
        for (int t = 0; t < nt; t += 2) {
            const bool last = (t == nt - 2);
            const char* a1 = cA + (size_t)(t + 1) * kstep;
            const char* a2 = last ? nA : cA + (size_t)(t + 2) * kstep; const char* b2 = last ? nB : cB + (size_t)(t + 2) * kstep;
            const char* a3 = a2 + kstep; const char* b3 = b2 + kstep;
            unsigned vo2[4];
#pragma unroll
            for (int i = 0; i < 4; ++i) vo2[i] = (GATHER && last) ? nvo[i] : cvo[i];
            PG8_LDB(B0, 0, 0); PG8_LDB(B1, 0, 1); PG8_SCHED; PG8_LDA(At, 0, 0); PG8_STAGEA(PG8_SA(1, 1), a1, cvo, 1);
            PG8_WAIT_V(8); PG8_WAIT_L(0); PG8_BAR; PG8_MMA(0, 0, At, B0); PG8_MMA(0, 1, At, B1); PG8_BAR; PG8_SCHED;
            PG8_LDA(At, 0, 1); PG8_STAGE(PG8_SB(0, 0), b2, voffB); PG8_STAGE(PG8_SB(0, 1), b2 + hstepB, voffB); PG8_STAGEA(PG8_SA(0, 0), a2, vo2, 0);
            PG8_WAIT_V(8); PG8_WAIT_L(0); PG8_BAR; PG8_MMA(1, 0, At, B0); PG8_MMA(1, 1, At, B1); PG8_BAR; PG8_SCHED;
            PG8_LDB(B0, 1, 0); PG8_LDB(B1, 1, 1); PG8_SCHED; PG8_LDA(At, 1, 0); PG8_STAGEA(PG8_SA(0, 1), a2, vo2, 1);
            PG8_WAIT_V(8); PG8_WAIT_L(0); PG8_BAR; PG8_MMA(0, 0, At, B0); PG8_MMA(0, 1, At, B1); PG8_BAR; PG8_SCHED;
            PG8_LDA(At, 1, 1); PG8_STAGE(PG8_SB(1, 0), b3, voffB); PG8_STAGE(PG8_SB(1, 1), b3 + hstepB, voffB); PG8_STAGEA(PG8_SA(1, 0), a3, vo2, 0);
            PG8_WAIT_V(8); PG8_WAIT_L(0); PG8_BAR; PG8_MMA(1, 0, At, B0); PG8_MMA(1, 1, At, B1); PG8_BAR; PG8_SCHED;
        }
        if constexpr (ALIGN_EPI) { if (wr == 0) PG8_BAR; }
        E(acc, cur, wr, wc, fr, fq);
        if (!has_next) break;
#pragma unroll
        for (int a = 0; a < 2; ++a)
#pragma unroll
            for (int b = 0; b < 2; ++b)
#pragma unroll
                for (int m = 0; m < 4; ++m)
#pragma unroll
                    for (int n = 0; n < 2; ++n) acc[a][b][m][n] = (f32x4){0.f, 0.f, 0.f, 0.f};
        cur = nxt; cA = nA; cB = nB; ++ui;
        if constexpr (GATHER) {
#pragma unroll
            for (int i = 0; i < 4; ++i) cvo[i] = nvo[i]; }
        if constexpr (ALIGN_EPI) { if (wr == 1) PG8_BAR; }
    }
    PG8_WAIT_V(0);
    if constexpr (!ALIGN_EPI) { if (wr == 0) PG8_BAR; }
    PG8_BAR;
#undef PG8_SA
#undef PG8_SB
#undef PG8_STAGE
#undef PG8_STAGEA
#undef PG8_ROWOFFS
#undef PG8_LDA
#undef PG8_LDB
#undef PG8_MMA
#undef PG8_HALF
#undef PG8_WAIT_V
#undef PG8_WAIT_L
#undef PG8_BAR
#undef PG8_SCHED
}
}

constexpr int NB = 8, SEQ = 2048, D = 1024, T = NB * SEQ;
constexpr int MEML = 256, TM = NB * MEML;
constexpr int HYC = 512, NZ0 = 2048;
constexpr int FF = 2816, NGU = 2 * FF;
constexpr int ATW = 1536, NQKV = 3 * ATW, NQ1 = NQKV + 512;
constexpr int NE = 8, PMAX = 2 * T + NE * 256;
constexpr float EPS = 1e-6f;
constexpr float MOE_WGU_SCALE = 32.0f, MOE_WD_SCALE = 64.0f;
constexpr int NWAVES = 8;

constexpr size_t MiB = 1u << 20;
constexpr size_t WS_CTL = 0, CTL_ZERO_BYTES = 1 * MiB;
constexpr size_t WS_WGU1 = 1 * MiB;
constexpr size_t WS_WD1 = 89 * MiB;
constexpr size_t WS_SMALL = 133 * MiB;
constexpr size_t WS_RSTD0 = WS_SMALL;
constexpr size_t WS_SSQ16 = WS_SMALL + 64 * 1024;
constexpr size_t WS_LSE = WS_SSQ16 + 1 * MiB;
constexpr size_t WS_TOKE = WS_LSE + 768 * 1024;
constexpr size_t WS_TOKR = WS_TOKE + 128 * 1024;
constexpr size_t WS_TOKG = WS_TOKR + 128 * 1024;
constexpr size_t WS_RSTD3 = WS_TOKG + 128 * 1024;
constexpr size_t WS_LIST = WS_RSTD3 + 64 * 1024;
constexpr size_t WS_RSTDS = WS_LIST + 512 * 1024;
static_assert(WS_RSTDS + PMAX * 4 <= WS_SMALL + 4 * MiB, "small region");
constexpr size_t WS_WO = 137 * MiB;
constexpr size_t WS_WIN1 = 141 * MiB;
constexpr size_t WS_WKV = 151 * MiB;
constexpr size_t WS_WIN0 = 155 * MiB;
constexpr size_t WS_WGU0 = 159 * MiB;
constexpr size_t WS_WD0 = 170 * MiB;
constexpr size_t WS_KV = 176 * MiB;
constexpr size_t WS_XB = 184 * MiB;
constexpr size_t WS_YT = 336 * MiB;
constexpr size_t WS_MIX0 = 216 * MiB;
constexpr size_t WS_MN = 248 * MiB;
constexpr size_t WS_ZT = 256 * MiB;
constexpr size_t WS_XQ0 = 304 * MiB;
constexpr size_t WS_HF = 320 * MiB;
constexpr size_t WS_HID0 = 248 * MiB;
constexpr size_t WS_QKV1 = 248 * MiB;
constexpr size_t WS_XQ1 = 392 * MiB;
constexpr size_t WS_OG12 = 216 * MiB;
constexpr size_t WS_MIX1 = 141 * MiB;
constexpr size_t WS_XB3 = 137 * MiB;
constexpr size_t WS_XS = 137 * MiB;
constexpr size_t WS_HID1 = 205 * MiB;
constexpr size_t WS_Y2 = 392 * MiB;
constexpr size_t WS_END = 408 * MiB;
static_assert(WS_HID1 + (size_t)PMAX * FF * 2 <= WS_END && WS_XQ1 + (size_t)T * 512 * 2 <= WS_END && WS_XS + (size_t)PMAX * 2048 <= WS_HID1, "ws map");

constexpr int CW_CNT = 64;
constexpr int CW_BAR = 4096;

constexpr int SCR_BYTES = 147456;
constexpr int MISC_OFF = SCR_BYTES;
constexpr int LDS_BYTES = SCR_BYTES + 4096;

#define LAS __attribute__((address_space(3)))
typedef unsigned short bf16;
typedef unsigned v4u __attribute__((ext_vector_type(4)));
typedef unsigned v2u __attribute__((ext_vector_type(2)));
typedef float f32x4 __attribute__((ext_vector_type(4)));
typedef float f32x2 __attribute__((ext_vector_type(2)));
#define LDS_WAIT() asm volatile("s_waitcnt lgkmcnt(0)" ::: "memory")
__device__ __forceinline__ unsigned f2bf(float f) { unsigned u = __builtin_bit_cast(unsigned, f); return (u + 0x7fffu + ((u >> 16) & 1u)) >> 16; }
__device__ __forceinline__ unsigned pk2(float lo, float hi) { unsigned r; asm("v_cvt_pk_bf16_f32 %0, %1, %2" : "=v"(r) : "v"(lo), "v"(hi)); return r; }
__device__ __forceinline__ unsigned pk4_fp8(float a, float b, float c, float d) { unsigned w = 0u; w = __builtin_amdgcn_cvt_pk_fp8_f32(a, b, w, false); w = __builtin_amdgcn_cvt_pk_fp8_f32(c, d, w, true); return w; }
__device__ __forceinline__ float bflo(unsigned w) { return __builtin_bit_cast(float, w << 16); }
__device__ __forceinline__ float bfhi(unsigned w) { return __builtin_bit_cast(float, w & 0xffff0000u); }
__device__ __forceinline__ float bf1(bf16 b) { return __builtin_bit_cast(float, ((unsigned)b) << 16); }
__device__ __forceinline__ float wave_sum(float v) {
#pragma unroll
    for (int o = 1; o < 64; o <<= 1) v += __shfl_xor(v, o);
    return v;
}
__device__ __forceinline__ float wave_max(float v) {
#pragma unroll
    for (int o = 1; o < 64; o <<= 1) v = fmaxf(v, __shfl_xor(v, o));
    return v;
}

#define XB_TMO      128
#define XB_XCNT(j)  (256  + 64 * (j))
#define XB_XSUB(j)  (1280 + 64 * (j))
#define XB_XGEN(j)  (2304 + 64 * (j))
#define XB_TOP      3328
#define XB_TOPGEN   3392
#define XCD_BAR_WORDS 3456
#define XB_SPIN_CAP (1u << 18)

__device__ __forceinline__ unsigned xb_ld(unsigned* p)              { return __hip_atomic_load(p, __ATOMIC_RELAXED, __HIP_MEMORY_SCOPE_AGENT); }
__device__ __forceinline__ unsigned xb_add(unsigned* p, unsigned v) { return __hip_atomic_fetch_add(p, v, __ATOMIC_RELAXED, __HIP_MEMORY_SCOPE_AGENT); }
__device__ __forceinline__ unsigned xb_xcc_id() { return (unsigned)__builtin_amdgcn_s_getreg((3 << 11) | 20) & 0xFu; }
#define XB_SPIN(cond, bar) do { unsigned _sp = 0; while (cond) { __builtin_amdgcn_s_sleep(1); \
    if ((++_sp & 255u) == 0u) { if (xb_ld(&(bar)[XB_TMO])) break; if (_sp > XB_SPIN_CAP) { atomicAdd(&(bar)[XB_TMO], 1u); break; } } } } while (0)

struct XcdBarrier {
    unsigned* bar; unsigned x;
    volatile LAS unsigned* st;
};
__device__ __forceinline__ XcdBarrier xcd_barrier_post(unsigned* bar, volatile LAS unsigned* st, int tid) {
    XcdBarrier b; b.bar = bar; b.x = xb_xcc_id(); b.st = st;
    if (tid == 0) (void)xb_add(&bar[XB_XCNT(b.x)], 1u);
    return b;
}
__device__ __forceinline__ void xcd_barrier_complete(unsigned* bar, unsigned x, unsigned& nloc, unsigned& nx) {
    const unsigned G = gridDim.x * gridDim.y * gridDim.z;
    unsigned sum, cnt, mine, sp = 0u;
    for (;;) {
        sum = 0u; cnt = 0u; mine = 0u;
#pragma unroll
        for (unsigned j = 0; j < 16; ++j) { const unsigned c = xb_ld(&bar[XB_XCNT(j)]); sum += c; cnt += (c > 0u) ? 1u : 0u; mine = (j == x) ? c : mine; }
        if (sum == G) break;
        __builtin_amdgcn_s_sleep(1);
        if ((++sp & 255u) == 0u) { if (xb_ld(&bar[XB_TMO])) break; if (sp > XB_SPIN_CAP) { atomicAdd(&bar[XB_TMO], 1u); break; } }
    }
    nloc = mine > 0u ? mine : 1u; nx = cnt > 0u ? cnt : 1u;
}
__device__ __forceinline__ void xcd_barrier(const XcdBarrier& b, int tid) {
    asm volatile("s_waitcnt vmcnt(0)" ::: "memory");
    __syncthreads();
    if (tid == 0) {
        unsigned* bar = b.bar;
        __builtin_amdgcn_s_waitcnt(0);
        unsigned nloc = b.st[0], nx = b.st[1];
        if (nloc == 0u) { xcd_barrier_complete(bar, b.x, nloc, nx); b.st[0] = nloc; b.st[1] = nx; }
        const unsigned old = xb_add(&bar[XB_XSUB(b.x)], 1u);
        const unsigned gen = old / nloc;
        if (old + 1u == (gen + 1u) * nloc) {
            __builtin_amdgcn_fence(__ATOMIC_RELEASE, "agent");
            asm volatile("s_waitcnt vmcnt(0)" ::: "memory");
            const unsigned og = xb_add(&bar[XB_TOP], 1u);
            const unsigned tg = og / nx;
            if (og + 1u == (tg + 1u) * nx) xb_add(&bar[XB_TOPGEN], 1u);
            else XB_SPIN(xb_ld(&bar[XB_TOPGEN]) == tg, bar);
            __builtin_amdgcn_fence(__ATOMIC_ACQUIRE, "agent");
            xb_add(&bar[XB_XGEN(b.x)], 1u);
            asm volatile("s_waitcnt vmcnt(0)" ::: "memory");
        } else {
            XB_SPIN(xb_ld(&bar[XB_XGEN(b.x)]) == gen, bar);
            __builtin_amdgcn_fence(__ATOMIC_ACQUIRE, "agent");
            asm volatile("s_waitcnt vmcnt(0)" ::: "memory");
        }
    }
    __syncthreads();
}

struct Args { const float* in[30]; float* out; unsigned char* ws; int ph_lo, ph_hi, bslot, pad; };
enum { I_X = 0, I_MEM, I_RELB, I_NMIX, I_NMEM, I_NFFN, I_WKV, I_XQN, I_XKN, I_WOUT, I_HYWIN, I_HYCW, I_HYCB, I_FW1, I_FB1, I_FW2, I_FB2, I_FW3, I_FREQ, I_SKIP,
       I_ATWIN, I_ATQN, I_ATKN, I_FFG, I_FFU, I_FFD, I_ROUTER, I_MOEG, I_MOEU, I_MOED };

struct Frame {
    LAS unsigned char* lds;
    unsigned char* ws;
    int tid, lane, wave, G, bid;
};

constexpr int RSL_OFF = 131072;
template <int SCALE> struct EpiB {
    bf16* O; int ldc; const float* sc; int split_tile; bf16* O2; int ldc2; const LAS float* rsl; float kc;
    __device__ __forceinline__ void operator()(const f32x4 (&acc)[2][2][4][2], const pg8::Unit& u, int wr, int wc, int fr, int fq) const {
        const int row0 = u.pm * 256 + wr * 64 + fr;
        bf16* base = O; int ld = ldc; int colt = u.pn * 256;
        if (u.pn >= split_tile) { base = O2; ld = ldc2; colt -= split_tile * 256; }
        if (u.koff != 0) base = O2;
        const int col0 = colt + wc * 32 + 8 * fq;
        float rsv[2][4];
        if (SCALE == 1) {
#pragma unroll
            for (int ai = 0; ai < 2; ++ai)
#pragma unroll
                for (int m = 0; m < 4; ++m) rsv[ai][m] = sc[row0 + ai * 128 + m * 16];
            asm volatile("s_waitcnt vmcnt(0)" ::: "memory");
        }
        f32x4 cs[2][2];
        if (SCALE == 3) {
#pragma unroll
            for (int bj = 0; bj < 2; ++bj)
#pragma unroll
                for (int n = 0; n < 2; ++n) cs[bj][n] = *(const f32x4*)(sc + u.pn * 256 + bj * 128 + wc * 32 + 8 * fq + 4 * n);
            asm volatile("s_waitcnt vmcnt(0)" ::: "memory");
        }
#pragma unroll
        for (int ai = 0; ai < 2; ++ai)
#pragma unroll
            for (int m = 0; m < 4; ++m) {
                const int row = row0 + ai * 128 + m * 16;
                float rs = 1.f;
                if (SCALE == 1) rs = rsv[ai][m];
                if (SCALE == 2) { const f32x4* p = (const f32x4*)(sc + (size_t)row * 16); const f32x4 a = p[0], b = p[1], c = p[2], d = p[3];
                    const float s = ((a.x + a.y) + (a.z + a.w)) + ((b.x + b.y) + (b.z + b.w)) + ((c.x + c.y) + (c.z + c.w)) + ((d.x + d.y) + (d.z + d.w));
                    rs = 1.0f / sqrtf(s * (1.0f / D) + EPS); }
                if (SCALE == 4) rs = rsl[u.idx * 256 + (row - u.pm * 256)];
                if (SCALE == 5) rs = kc;
                bf16* rowp = base + (size_t)row * ld + col0;
#pragma unroll
                for (int bj = 0; bj < 2; ++bj) {
                    f32x4 v0 = acc[ai][bj][m][0], v1 = acc[ai][bj][m][1];
                    if (SCALE == 1 || SCALE == 2 || SCALE == 4 || SCALE == 5) { v0 = v0 * rs; v1 = v1 * rs; }
                    if (SCALE == 3) { v0 = v0 * cs[bj][0]; v1 = v1 * cs[bj][1]; }
                    v4u w; w.x = pk2(v0[0], v0[1]); w.y = pk2(v0[2], v0[3]); w.z = pk2(v1[0], v1[1]); w.w = pk2(v1[2], v1[3]);
                    *(v4u*)(rowp + bj * 128) = w;
                }
            }
    }
};
template <bool XF32, bool SSQ> struct EpiRes {
    const float* xf; const bf16* xi; int ldi; bf16* xo; int ldo; float* ssq16;
    __device__ __forceinline__ void operator()(const f32x4 (&acc)[2][2][4][2], const pg8::Unit& u, int wr, int wc, int fr, int fq) const {
        const int row0 = u.pm * 256 + wr * 64 + fr, col0 = u.pn * 256 + wc * 32 + 8 * fq;
        if constexpr (!XF32) {
            v4u res[2][4][2];
#pragma unroll
            for (int ai = 0; ai < 2; ++ai)
#pragma unroll
                for (int m = 0; m < 4; ++m)
#pragma unroll
                    for (int bj = 0; bj < 2; ++bj) res[ai][m][bj] = *(const v4u*)(xi + (size_t)(row0 + ai * 128 + m * 16) * ldi + col0 + bj * 128);
            asm volatile("s_waitcnt vmcnt(0)" ::: "memory");
#pragma unroll
            for (int ai = 0; ai < 2; ++ai)
#pragma unroll
                for (int m = 0; m < 4; ++m) {
                    const int row = row0 + ai * 128 + m * 16;
                    float ss = 0.f;
#pragma unroll
                    for (int bj = 0; bj < 2; ++bj) {
                        const v4u w0 = res[ai][m][bj];
                        const f32x4 r0 = (f32x4){bflo(w0.x), bfhi(w0.x), bflo(w0.y), bfhi(w0.y)}, r1 = (f32x4){bflo(w0.z), bfhi(w0.z), bflo(w0.w), bfhi(w0.w)};
                        const f32x4 v0 = acc[ai][bj][m][0] + r0, v1 = acc[ai][bj][m][1] + r1;
                        v4u w; w.x = pk2(v0[0], v0[1]); w.y = pk2(v0[2], v0[3]); w.z = pk2(v1[0], v1[1]); w.w = pk2(v1[2], v1[3]);
                        *(v4u*)(xo + (size_t)row * ldo + col0 + bj * 128) = w;
                        if (SSQ) ss += ((v0[0] * v0[0] + v0[1] * v0[1]) + (v0[2] * v0[2] + v0[3] * v0[3])) + ((v1[0] * v1[0] + v1[1] * v1[1]) + (v1[2] * v1[2] + v1[3] * v1[3]));
                    }
                    if (SSQ) { ss += __shfl_xor(ss, 16); ss += __shfl_xor(ss, 32);
                        if (fq == 0) ssq16[(size_t)row * 16 + u.pn * 4 + wc] = ss; }
                }
        } else {
#pragma unroll
            for (int ai = 0; ai < 2; ++ai)
#pragma unroll
                for (int m = 0; m < 4; ++m) {
                    const int row = row0 + ai * 128 + m * 16;
                    float ss = 0.f;
#pragma unroll
                    for (int bj = 0; bj < 2; ++bj) {
                        const size_t off = (size_t)row * D + col0 + bj * 128; const f32x4 r0 = *(const f32x4*)(xf + off), r1 = *(const f32x4*)(xf + off + 4);
                        const f32x4 v0 = acc[ai][bj][m][0] + r0, v1 = acc[ai][bj][m][1] + r1;
                        v4u w; w.x = pk2(v0[0], v0[1]); w.y = pk2(v0[2], v0[3]); w.z = pk2(v1[0], v1[1]); w.w = pk2(v1[2], v1[3]);
                        *(v4u*)(xo + (size_t)row * ldo + col0 + bj * 128) = w;
                        if (SSQ) ss += ((v0[0] * v0[0] + v0[1] * v0[1]) + (v0[2] * v0[2] + v0[3] * v0[3])) + ((v1[0] * v1[0] + v1[1] * v1[1]) + (v1[2] * v1[2] + v1[3] * v1[3]));
                    }
                    if (SSQ) { ss += __shfl_xor(ss, 16); ss += __shfl_xor(ss, 32);
                        if (fq == 0) ssq16[(size_t)row * 16 + u.pn * 4 + wc] = ss; }
                }
        }
    }
};
template <int SCALE, bool OUT8 = false> struct EpiSwiglu {
    bf16* H; int ldh; const float* sc; const LAS float* rsl; float kc;
    __device__ __forceinline__ void operator()(const f32x4 (&acc)[2][2][4][2], const pg8::Unit& u, int wr, int wc, int fr, int fq) const {
        const int row0 = u.pm * 256 + wr * 64 + fr, col0 = u.pn * 128 + wc * 32 + 8 * fq;
#pragma unroll
        for (int ai = 0; ai < 2; ++ai)
#pragma unroll
            for (int m = 0; m < 4; ++m) {
                const int row = row0 + ai * 128 + m * 16;
                float rs = 1.f;
                if (SCALE == 1) rs = sc[row];
                if (SCALE == 2) { const f32x4* p = (const f32x4*)(sc + (size_t)row * 16); const f32x4 a = p[0], b = p[1], c = p[2], d = p[3];
                    const float s = ((a.x + a.y) + (a.z + a.w)) + ((b.x + b.y) + (b.z + b.w)) + ((c.x + c.y) + (c.z + c.w)) + ((d.x + d.y) + (d.z + d.w));
                    rs = 1.0f / sqrtf(s * (1.0f / D) + EPS); }
                if (SCALE == 4) rs = rsl[u.idx * 256 + (row - u.pm * 256)];
                if (SCALE == 5) rs = kc;
                float h[8];
#pragma unroll
                for (int n = 0; n < 2; ++n)
#pragma unroll
                    for (int j = 0; j < 4; ++j) { const float gv = acc[ai][0][m][n][j] * rs, uv = acc[ai][1][m][n][j] * rs;
                        h[n * 4 + j] = gv * uv * __builtin_amdgcn_rcpf(1.0f + __expf(-gv)); }
                if (OUT8) { v2u w; w.x = pk4_fp8(h[0], h[1], h[2], h[3]); w.y = pk4_fp8(h[4], h[5], h[6], h[7]); *(v2u*)((unsigned char*)H + (size_t)row * ldh + col0) = w; }
                else { v4u w; w.x = pk2(h[0], h[1]); w.y = pk2(h[2], h[3]); w.z = pk2(h[4], h[5]); w.w = pk2(h[6], h[7]);
                    *(v4u*)(H + (size_t)row * ldh + col0) = w; }
            }
    }
};

template <class Sched>
__device__ __forceinline__ void fill_rstd_table(LAS unsigned char* lds, const Sched& S, const float* ssq16, int tid) {
    LAS float* rsl = (LAS float*)(lds + RSL_OFF);
    pg8::Unit u;
    for (int ui = 0; ui < 16 && S.next(ui, u); ++ui) {
        if (tid < 256) { const f32x4* p = (const f32x4*)(ssq16 + (size_t)(u.pm * 256 + tid) * 16); const f32x4 a = p[0], b = p[1], c = p[2], d = p[3];
            const float s = ((a.x + a.y) + (a.z + a.w)) + ((b.x + b.y) + (b.z + b.w)) + ((c.x + c.y) + (c.z + c.w)) + ((d.x + d.y) + (d.z + d.w));
            rsl[ui * 256 + tid] = 1.0f / sqrtf(s * (1.0f / D) + EPS); }
    }
    __syncthreads();
}

__device__ __forceinline__ void p0_transpose_item(const float* W, int K, int N, bf16* WT, const float* gain, int mode, LAS float* scr, int item, int lane) {
    const int nblk = N / 64, kb = item / nblk, nb = item % nblk, k0 = 64 * kb, n0 = 64 * nb;
    const int lr = lane >> 4, lc = lane & 15;
    f32x4 v[16];
#pragma unroll
    for (int i = 0; i < 16; ++i) v[i] = *(const f32x4*)(W + (size_t)(k0 + 4 * i + lr) * N + n0 + 4 * lc);
    if (gain) {
#pragma unroll
        for (int i = 0; i < 16; ++i) v[i] = v[i] * gain[k0 + 4 * i + lr];
    }
#pragma unroll
    for (int i = 0; i < 16; ++i) { LAS float* s = scr + (4 * i + lr) * 65 + 4 * lc; s[0] = v[i].x; s[1] = v[i].y; s[2] = v[i].z; s[3] = v[i].w; }
    LDS_WAIT(); asm volatile("" ::: "memory");
    const int c = lane & 7;
    const int d0 = (mode == 0) ? n0 : (256 * (n0 / 128) + (n0 % 128) + (mode == 2 ? 128 : 0));
#pragma unroll
    for (int j = 0; j < 8; ++j) { const int n = (lane >> 3) + 8 * j; const LAS float* s = scr + (8 * c) * 65 + n;
        v4u o; o.x = pk2(s[0 * 65], s[1 * 65]); o.y = pk2(s[2 * 65], s[3 * 65]); o.z = pk2(s[4 * 65], s[5 * 65]); o.w = pk2(s[6 * 65], s[7 * 65]);
        *(v4u*)(WT + (size_t)(d0 + n) * K + k0 + 8 * c) = o; }
    LDS_WAIT(); asm volatile("" ::: "memory");
}
__device__ __forceinline__ void p0_transpose_item8(const float* W, int K, int N, unsigned char* WT8, const float* gain, float s8, int mode, LAS float* scr, int item, int lane) {
    const int nblk = N / 64, kb = item / nblk, nb = item % nblk, k0 = 64 * kb, n0 = 64 * nb;
    const int lr = lane >> 4, lc = lane & 15;
    f32x4 v[16];
#pragma unroll
    for (int i = 0; i < 16; ++i) v[i] = *(const f32x4*)(W + (size_t)(k0 + 4 * i + lr) * N + n0 + 4 * lc);
#pragma unroll
    for (int i = 0; i < 16; ++i) { const float g = gain ? gain[k0 + 4 * i + lr] * s8 : s8; v[i] = v[i] * g; }
#pragma unroll
    for (int i = 0; i < 16; ++i) { LAS float* s = scr + (4 * i + lr) * 65 + 4 * lc; s[0] = v[i].x; s[1] = v[i].y; s[2] = v[i].z; s[3] = v[i].w; }
    LDS_WAIT(); asm volatile("" ::: "memory");
    const int c = lane & 3;
    const int d0 = (mode == 0) ? n0 : (256 * (n0 / 128) + (n0 % 128) + (mode == 2 ? 128 : 0));
#pragma unroll
    for (int j = 0; j < 4; ++j) { const int n = (lane >> 2) + 16 * j; const LAS float* s = scr + (16 * c) * 65 + n;
        v4u o; o.x = pk4_fp8(s[0 * 65], s[1 * 65], s[2 * 65], s[3 * 65]); o.y = pk4_fp8(s[4 * 65], s[5 * 65], s[6 * 65], s[7 * 65]);
        o.z = pk4_fp8(s[8 * 65], s[9 * 65], s[10 * 65], s[11 * 65]); o.w = pk4_fp8(s[12 * 65], s[13 * 65], s[14 * 65], s[15 * 65]);
        *(v4u*)(WT8 + (size_t)(d0 + n) * K + k0 + 16 * c) = o; }
    LDS_WAIT(); asm volatile("" ::: "memory");
}
__device__ __forceinline__ float row_to_bf16(const float* xrow, bf16* orow, const float* gain, bool normalize, int lane) {
    const f32x4* xr = (const f32x4*)xrow + lane;
    f32x4 v[4]; float s = 0.f;
#pragma unroll
    for (int j = 0; j < 4; ++j) { v[j] = xr[64 * j]; s += (v[j].x * v[j].x + v[j].y * v[j].y) + (v[j].z * v[j].z + v[j].w * v[j].w); }
    const float rstd = 1.0f / sqrtf(wave_sum(s) * (1.f / D) + EPS);
    unsigned long long* o8 = (unsigned long long*)orow + lane;
#pragma unroll
    for (int j = 0; j < 4; ++j) {
        f32x4 w = v[j];
        if (normalize) { const f32x4 g = ((const f32x4*)gain)[lane + 64 * j]; w = w * rstd * g; }
        o8[64 * j] = (unsigned long long)pk2(w.x, w.y) | ((unsigned long long)pk2(w.z, w.w) << 32);
    }
    return rstd;
}
__device__ __forceinline__ void p0_filter_block(Frame& F, const Args& a, float* Hf, int jb) {
    const float* w1 = a.in[I_FW1]; const float* b1 = a.in[I_FB1]; const float* w2 = a.in[I_FW2]; const float* b2 = a.in[I_FB2]; const float* w3 = a.in[I_FW3]; const float* fr = a.in[I_FREQ];
    LAS float* h2s = (LAS float*)(F.lds + MISC_OFF + 256);
    const int lane = F.lane, j0 = jb * 8;
    LAS float* W1s = (LAS float*)F.lds; LAS float* W2s = W1s + 33 * 64;
    for (int i = F.tid; i < 33 * 64; i += 512) W1s[i] = w1[i];
    for (int i = F.tid; i < 64 * 64; i += 512) W2s[i] = w2[i];
    __syncthreads();
    {
        const int j = j0 + F.wave;
        const float freq = fr[lane], bb1 = b1[lane], bb2 = b2[lane];
        float feat = 0.f;
        {
            const int fi = (lane >= 17) ? lane - 17 : lane - 1;
            const float f = 1e-4f + (float)fi * ((15.0f - 1e-4f) / 15.0f);
            const float ang = (6.283185307179586f / 2048.0f) * (float)j * f;
            if (lane == 0) feat = (float)j * (1.0f / 2047.0f);
            else if (lane <= 16) feat = cosf(ang);
            else if (lane <= 32) feat = -sinf(ang);
        }
        float s1 = bb1;
#pragma unroll
        for (int i = 0; i < 33; ++i) s1 += __shfl(feat, i) * W1s[i * 64 + lane];
        const float h1 = sinf(freq * s1);
        float s2 = bb2;
#pragma unroll 16
        for (int i = 0; i < 64; ++i) s2 += __shfl(h1, i) * W2s[i * 64 + lane];
        h2s[lane * 8 + F.wave] = sinf(freq * s2);
    }
    __syncthreads();
    const int n0 = F.wave * 256;
    float acc[4][8];
#pragma unroll
    for (int q = 0; q < 4; ++q)
#pragma unroll
        for (int jj = 0; jj < 8; ++jj) acc[q][jj] = 0.f;
#pragma unroll 1
    for (int i0 = 0; i0 < 64; i0 += 8) {
        float w[8][4];
#pragma unroll
        for (int ii = 0; ii < 8; ++ii)
#pragma unroll
            for (int q = 0; q < 4; ++q) w[ii][q] = w3[(size_t)(i0 + ii) * 2048 + n0 + q * 64 + lane];
#pragma unroll
        for (int ii = 0; ii < 8; ++ii) {
            const f32x4 ha = *(const LAS f32x4*)(h2s + (i0 + ii) * 8), hb = *(const LAS f32x4*)(h2s + (i0 + ii) * 8 + 4);
#pragma unroll
            for (int q = 0; q < 4; ++q) {
                acc[q][0] += ha.x * w[ii][q]; acc[q][1] += ha.y * w[ii][q]; acc[q][2] += ha.z * w[ii][q]; acc[q][3] += ha.w * w[ii][q];
                acc[q][4] += hb.x * w[ii][q]; acc[q][5] += hb.y * w[ii][q]; acc[q][6] += hb.z * w[ii][q]; acc[q][7] += hb.w * w[ii][q]; }
        }
    }
    const float da = -3.0701134573253945f, db = -15.350567286626973f;
#pragma unroll
    for (int q = 0; q < 4; ++q) {
        const int n = n0 + q * 64 + lane, c = n & 511;
        const float delta = fabsf(da + (db - da) * ((float)c * (1.0f / 511.0f)));
        float o[8];
#pragma unroll
        for (int jj = 0; jj < 8; ++jj) { const float t = (float)(j0 + jj) * (1.0f / 2047.0f); o[jj] = acc[q][jj] * (expf(-t * delta) + 0.05f); }
        f32x4* dst = (f32x4*)(Hf + (size_t)n * 2048 + j0);
        dst[0] = (f32x4){o[0], o[1], o[2], o[3]}; dst[1] = (f32x4){o[4], o[5], o[6], o[7]};
    }
    __syncthreads();
}
constexpr int IT_MOE = 16 * 44, N_MOE_ITEMS = 24 * IT_MOE;
constexpr int MOE_P1_HI = 4608, MOE_P5_HI = 12608, MOE_P0_LO = MOE_P5_HI;
__device__ __forceinline__ void moe_convert(Frame& F, const Args& a, int lo, int hi, int gwl, int ngw) {
    LAS float* scr = (LAS float*)(F.lds + F.wave * 16640);
    unsigned char* ws = F.ws;
    for (int r = lo + gwl; r < hi; r += ngw) {
        const int mid = r / IT_MOE, li = r % IT_MOE, kind = mid >> 3, e = mid & 7;
        if (kind == 0) p0_transpose_item8(a.in[I_MOEG] + (size_t)e * D * FF, D, FF, ws + WS_WGU1 + (size_t)e * NGU * D, a.in[I_NFFN] + D, MOE_WGU_SCALE, 1, scr, li, F.lane);
        else if (kind == 1) p0_transpose_item8(a.in[I_MOEU] + (size_t)e * D * FF, D, FF, ws + WS_WGU1 + (size_t)e * NGU * D, a.in[I_NFFN] + D, MOE_WGU_SCALE, 2, scr, li, F.lane);
        else p0_transpose_item8(a.in[I_MOED] + (size_t)e * FF * D, FF, D, ws + WS_WD1 + (size_t)e * D * FF, nullptr, MOE_WD_SCALE, 0, scr, li, F.lane);
    }
}
__device__ __forceinline__ void p0_prologue(Frame& F, const Args& a) {
    LAS float* scr = (LAS float*)(F.lds + F.wave * 16640);
    const int gw = F.bid * NWAVES + F.wave, NGW = F.G * NWAVES;
    unsigned char* ws = F.ws;
    for (int jb = F.bid; jb < 256; jb += F.G) p0_filter_block(F, a, (float*)(ws + WS_HF), jb);
    for (int m = gw; m < T; m += NGW) { const float r = row_to_bf16(a.in[I_X] + (size_t)m * D, (bf16*)(ws + WS_XB) + (size_t)m * D, nullptr, false, F.lane); if (F.lane == 0) ((float*)(ws + WS_RSTD0))[m] = r; }
    for (int m = gw; m < 2 * TM; m += NGW) { const int l = m / TM, r = m % TM;
        (void)row_to_bf16(a.in[I_MEM] + (size_t)r * D, (bf16*)(ws + WS_MN) + (size_t)m * D, a.in[I_NMEM] + l * D, true, F.lane); }
    constexpr int IT_A = 16 * 32, IT_SQ = 16 * 16, IT_G = 16 * 44, IT_D = 44 * 16, IT_W1 = 16 * 80;
    constexpr int NSMALL = IT_A + 4 * IT_SQ + 2 * IT_G + IT_D + IT_W1;
    for (int it = gw; it < NSMALL; it += NGW) {
        int r = it;
        if (r < IT_A) { p0_transpose_item(a.in[I_HYWIN], D, NZ0, (bf16*)(ws + WS_WIN0), a.in[I_NMIX], 0, scr, r, F.lane); continue; } r -= IT_A;
        if (r < IT_SQ) { p0_transpose_item(a.in[I_WKV], D, D, (bf16*)(ws + WS_WKV), nullptr, 0, scr, r, F.lane); continue; } r -= IT_SQ;
        if (r < IT_SQ) { p0_transpose_item(a.in[I_WKV] + (size_t)D * D, D, D, (bf16*)(ws + WS_WKV) + (size_t)D * D, nullptr, 0, scr, r, F.lane); continue; } r -= IT_SQ;
        if (r < IT_SQ) { p0_transpose_item(a.in[I_WOUT], D, D, (bf16*)(ws + WS_WO), nullptr, 0, scr, r, F.lane); continue; } r -= IT_SQ;
        if (r < IT_SQ) { p0_transpose_item(a.in[I_WOUT] + (size_t)D * D, D, D, (bf16*)(ws + WS_WO) + (size_t)D * D, nullptr, 0, scr, r, F.lane); continue; } r -= IT_SQ;
        if (r < IT_G) { p0_transpose_item(a.in[I_FFG], D, FF, (bf16*)(ws + WS_WGU0), a.in[I_NFFN], 1, scr, r, F.lane); continue; } r -= IT_G;
        if (r < IT_G) { p0_transpose_item(a.in[I_FFU], D, FF, (bf16*)(ws + WS_WGU0), a.in[I_NFFN], 2, scr, r, F.lane); continue; } r -= IT_G;
        if (r < IT_D) { p0_transpose_item(a.in[I_FFD], FF, D, (bf16*)(ws + WS_WD0), nullptr, 0, scr, r, F.lane); continue; } r -= IT_D;
        p0_transpose_item(a.in[I_ATWIN], D, NQ1, (bf16*)(ws + WS_WIN1), a.in[I_NMIX] + D, 0, scr, r, F.lane);
    }
    moe_convert(F, a, (F.G == 256) ? MOE_P0_LO : 0, N_MOE_ITEMS, gw, NGW);
}
__device__ __forceinline__ float block_sum(Frame& F, float v) {
    LAS float* red = (LAS float*)(F.lds + MISC_OFF + 64);
    v = wave_sum(v);
    __syncthreads();
    if (F.lane == 0) red[F.wave] = v;
    __syncthreads();
    float s = 0.f;
#pragma unroll
    for (int w = 0; w < NWAVES; ++w) s += red[w];
    return s;
}
__device__ __forceinline__ int rel_bucket_dev(int rel) {
    const int n = rel < 0 ? -rel : rel;
    const int large = 8 + (n >= 15) + (n >= 27) + (n >= 50) + (n >= 91) + (n >= 166) + (n >= 305) + (n >= 559);
    return (rel > 0 ? 16 : 0) + (n < 8 ? n : large);
}
__device__ __forceinline__ void merge_token(Frame& F, int token) {
    const bf16* og = (const bf16*)(F.ws + WS_OG12); const float* lse = (const float*)(F.ws + WS_LSE);
    bf16* mix = (bf16*)(F.ws + WS_MIX1);
    const int lane = F.lane, h = lane >> 4;
    const float l0 = lse[(size_t)token * 4 + h], l1 = lse[((size_t)T + token) * 4 + h], l2 = lse[((size_t)2 * T + token) * 4 + h];
    const float mx = fmaxf(l0, fmaxf(l1, l2));
    float w0 = __expf(l0 - mx), w1 = __expf(l1 - mx), w2 = __expf(l2 - mx);
    const float iz = 1.0f / (w0 + w1 + w2); w0 *= iz; w1 *= iz; w2 *= iz;
    const v4u a0 = *(const v4u*)(mix + (size_t)token * D + 8 * lane);
    const v4u a1 = *(const v4u*)(og + (size_t)token * 512 + 8 * lane);
    const v4u a2 = *(const v4u*)(og + ((size_t)T + token) * 512 + 8 * lane);
    v4u o;
    o.x = pk2(w0 * bflo(a0.x) + w1 * bflo(a1.x) + w2 * bflo(a2.x), w0 * bfhi(a0.x) + w1 * bfhi(a1.x) + w2 * bfhi(a2.x));
    o.y = pk2(w0 * bflo(a0.y) + w1 * bflo(a1.y) + w2 * bflo(a2.y), w0 * bfhi(a0.y) + w1 * bfhi(a1.y) + w2 * bfhi(a2.y));
    o.z = pk2(w0 * bflo(a0.z) + w1 * bflo(a1.z) + w2 * bflo(a2.z), w0 * bfhi(a0.z) + w1 * bfhi(a1.z) + w2 * bfhi(a2.z));
    o.w = pk2(w0 * bflo(a0.w) + w1 * bflo(a1.w) + w2 * bflo(a2.w), w0 * bfhi(a0.w) + w1 * bfhi(a1.w) + w2 * bfhi(a2.w));
    *(v4u*)(mix + (size_t)token * D + 8 * lane) = o;
}

constexpr int RT_OFF_R = 0, RT_OFF_REC = 32768, RT_OFF_CNT = 32768 + 64 * 32;
__device__ __forceinline__ void route_block(Frame& F, const Args& a, int blk) {
    LAS float* RL = (LAS float*)(F.lds + RT_OFF_R); volatile LAS int* REC = (volatile LAS int*)(F.lds + RT_OFF_REC); LAS int* CNT = (LAS int*)(F.lds + RT_OFF_CNT);
    const int lane = F.lane;
    const float* g = a.in[I_NFFN] + D; const float* rt = a.in[I_ROUTER];
    __syncthreads();
    for (int i = F.tid; i < 2048; i += 512) { const f32x4 r = ((const f32x4*)rt)[i]; const float gg = g[i >> 1]; ((LAS f32x4*)RL)[i] = r * gg; }
    if (F.tid < 16) CNT[F.tid] = 0;
    __syncthreads();
    for (int q = 0; q < 8; ++q) {
        const int tl = F.wave * 8 + q, token = blk * 64 + tl;
        const bf16* xr = (const bf16*)a.out + (size_t)token * 2048 + 1024;
        f32x4 v[4]; float s = 0.f;
#pragma unroll
        for (int j = 0; j < 4; ++j) { const v2u w = ((const v2u*)xr)[lane + 64 * j]; v[j] = (f32x4){bflo(w.x), bfhi(w.x), bflo(w.y), bfhi(w.y)}; s += (v[j].x * v[j].x + v[j].y * v[j].y) + (v[j].z * v[j].z + v[j].w * v[j].w); }
        const float rstd = 1.0f / sqrtf(wave_sum(s) * (1.f / D) + EPS);
        { unsigned* o4 = (unsigned*)(F.ws + WS_XB3 + (size_t)token * D) + lane;
#pragma unroll
          for (int j = 0; j < 4; ++j) o4[64 * j] = pk4_fp8(v[j].x * rstd, v[j].y * rstd, v[j].z * rstd, v[j].w * rstd); }
        float lg[8];
#pragma unroll
        for (int e = 0; e < 8; ++e) lg[e] = 0.f;
#pragma unroll
        for (int j = 0; j < 4; ++j) {
            const int k0 = 4 * (lane + 64 * j);
#pragma unroll
            for (int qq = 0; qq < 4; ++qq) {
                const float hn = v[j][qq] * rstd;
                const f32x4 r0 = *(const LAS f32x4*)(RL + (k0 + qq) * 8), r1 = *(const LAS f32x4*)(RL + (k0 + qq) * 8 + 4);
                lg[0] += hn * r0.x; lg[1] += hn * r0.y; lg[2] += hn * r0.z; lg[3] += hn * r0.w;
                lg[4] += hn * r1.x; lg[5] += hn * r1.y; lg[6] += hn * r1.z; lg[7] += hn * r1.w;
            }
        }
#pragma unroll
        for (int e = 0; e < 8; ++e) lg[e] = wave_sum(lg[e]);
        int i1 = 0; float v1 = lg[0];
#pragma unroll
        for (int e = 1; e < 8; ++e) if (lg[e] > v1) { v1 = lg[e]; i1 = e; }
        int i2 = -1; float v2 = -3.0e38f;
#pragma unroll
        for (int e = 0; e < 8; ++e) if (e != i1 && lg[e] > v2) { v2 = lg[e]; i2 = e; }
        const float e2 = __expf(v2 - v1), g1 = 1.0f / (1.0f + e2), g2 = e2 * g1;
        if (lane == 0) {
            const int r1 = __hip_atomic_fetch_add(CNT + i1, 1, __ATOMIC_RELAXED, __HIP_MEMORY_SCOPE_WORKGROUP);
            const int r2 = __hip_atomic_fetch_add(CNT + i2, 1, __ATOMIC_RELAXED, __HIP_MEMORY_SCOPE_WORKGROUP);
            REC[tl * 8 + 0] = i1; REC[tl * 8 + 1] = i2; REC[tl * 8 + 2] = r1; REC[tl * 8 + 3] = r2;
            REC[tl * 8 + 4] = __builtin_bit_cast(int, g1); REC[tl * 8 + 5] = __builtin_bit_cast(int, g2); REC[tl * 8 + 6] = __builtin_bit_cast(int, rstd);
        }
    }
    __syncthreads();
    if (F.tid < 8) { unsigned* cnt = (unsigned*)(F.ws + WS_CTL) + CW_CNT; CNT[8 + F.tid] = (int)__hip_atomic_fetch_add(cnt + F.tid, (unsigned)CNT[F.tid], __ATOMIC_RELAXED, __HIP_MEMORY_SCOPE_AGENT); }
    __syncthreads();
    if (F.tid < 64) {
        const int tl = F.tid, token = blk * 64 + tl;
        const int i1 = REC[tl * 8 + 0], i2 = REC[tl * 8 + 1], r1 = CNT[8 + i1] + REC[tl * 8 + 2], r2 = CNT[8 + i2] + REC[tl * 8 + 3];
        int* toke = (int*)(F.ws + WS_TOKE); int* tokr = (int*)(F.ws + WS_TOKR); int* tokg = (int*)(F.ws + WS_TOKG); int* list = (int*)(F.ws + WS_LIST);
        list[(size_t)i1 * T + r1] = token; list[(size_t)i2 * T + r2] = token;
        toke[token * 2] = i1; toke[token * 2 + 1] = i2; tokr[token * 2] = r1; tokr[token * 2 + 1] = r2;
        tokg[token * 2] = REC[tl * 8 + 4]; tokg[token * 2 + 1] = REC[tl * 8 + 5];
        ((int*)(F.ws + WS_RSTD3))[token] = REC[tl * 8 + 6];
    }
}
__device__ __forceinline__ void moe_layout(Frame& F) {
    volatile LAS int* M = (volatile LAS int*)(F.lds + MISC_OFF);
    __syncthreads();
    if (F.tid == 0) {
        const unsigned* cnt = (const unsigned*)(F.ws + WS_CTL) + CW_CNT;
        int acc = 0;
        for (int e = 0; e < 8; ++e) { const int c = (int)__hip_atomic_load(cnt + e, __ATOMIC_RELAXED, __HIP_MEMORY_SCOPE_AGENT); M[32 + e] = c; M[40 + e] = acc; acc += (c + 255) & ~255; }
        M[48] = acc;
    }
    __syncthreads();
}
__device__ __forceinline__ int ml_ps(Frame& F, int e) { return ((volatile LAS int*)(F.lds + MISC_OFF))[40 + e]; }
__device__ __forceinline__ int ml_cnt(Frame& F, int e) { return ((volatile LAS int*)(F.lds + MISC_OFF))[32 + e]; }
__device__ __forceinline__ int ml_total(Frame& F) { return ((volatile LAS int*)(F.lds + MISC_OFF))[48]; }
__device__ __forceinline__ int ml_expert(Frame& F, int slot) { int e = 0;
#pragma unroll
    for (int i = 1; i < 8; ++i) e += (slot >= ml_ps(F, i)) ? 1 : 0;
    return e; }

constexpr int HY_CS = 4168, HY_M0 = 2080, HY_UR = 2592, HY_UP = 256;
constexpr int HY_OFF_CP = 64, HY_OFF_UB = HY_OFF_CP + 8 * HY_CS * 2, HY_OFF_X = HY_OFF_UB + 8 * HY_UR * 2;
static_assert(HY_OFF_X + 8 * 2048 * 2 <= SCR_BYTES, "hyena LDS");
typedef short bf16x8_t __attribute__((ext_vector_type(8)));

struct HyStage { v4u raw[4]; float zm[4], zp[4]; };
struct HyFilt { float f[4], b[4]; };
__device__ __forceinline__ void hy_short_load(HyStage& s, const bf16* zr, int tid) {
#pragma unroll
    for (int k = 0; k < 4; ++k) {
        const int item = tid + 512 * k, b = item >> 8, t8 = (item & 255) * 8;
        const bf16* p = zr + b * SEQ + t8;
        s.raw[k] = *(const v4u*)p;
        s.zm[k] = (t8 > 0) ? bf1(p[-1]) : 0.f; s.zp[k] = (t8 + 8 < SEQ) ? bf1(p[8]) : 0.f;
    }
}
__device__ __forceinline__ void hy_short_store(LAS unsigned char* dst, int stride_el, int pad_el, const HyStage& s, float w0, float w1, float w2, float cb, int tid) {
#pragma unroll
    for (int k = 0; k < 4; ++k) {
        const int item = tid + 512 * k, b = item >> 8, t8 = (item & 255) * 8;
        float z[10];
        z[0] = s.zm[k]; z[1] = bflo(s.raw[k].x); z[2] = bfhi(s.raw[k].x); z[3] = bflo(s.raw[k].y); z[4] = bfhi(s.raw[k].y); z[5] = bflo(s.raw[k].z); z[6] = bfhi(s.raw[k].z); z[7] = bflo(s.raw[k].w); z[8] = bfhi(s.raw[k].w); z[9] = s.zp[k];
        float o[8];
#pragma unroll
        for (int i = 0; i < 8; ++i) o[i] = cb + z[i] * w0 + z[i + 1] * w1 + z[i + 2] * w2;
        v4u w; w.x = pk2(o[0], o[1]); w.y = pk2(o[2], o[3]); w.z = pk2(o[4], o[5]); w.w = pk2(o[6], o[7]);
        *(LAS v4u*)(dst + (size_t)(b * stride_el + pad_el + t8) * 2) = w;
    }
}
__device__ __forceinline__ void hy_filt_load(HyFilt& q, const float* Hf, int o, int c, int tid) {
    const float* fw = Hf + ((size_t)(o * 2 + 0) * 512 + c) * 2048;
    const float* bw = Hf + ((size_t)(o * 2 + 1) * 512 + c) * 2048;
#pragma unroll
    for (int i = 0; i < 4; ++i) { const int j = tid + 512 * i; q.f[i] = fw[j]; q.b[i] = (j >= 1) ? bw[j] : 0.f; }
}
__device__ __forceinline__ void hy_filt_build(Frame& F, const HyFilt& q) {
    LAS float* Kf = (LAS float*)(F.lds + HY_OFF_X);
    float s = 0.f;
#pragma unroll
    for (int i = 0; i < 4; ++i) s += fabsf(q.f[i]) + fabsf(q.b[i]);
    const float tot = block_sum(F, s);
    const float inv = 1.0f / (tot + 1e-6f);
#pragma unroll
    for (int i = 0; i < 4; ++i) { const int j = F.tid + 512 * i; Kf[HY_M0 - j] = q.f[i] * inv; if (j >= 1) Kf[HY_M0 + j] = q.b[i] * inv; }
    if (F.tid < 33) Kf[F.tid] = 0.f;
    if (F.tid < 48) Kf[4128 + F.tid] = 0.f;
    __syncthreads();
    LAS unsigned* cp = (LAS unsigned*)(F.lds + HY_OFF_CP);
    for (int p = F.tid; p < 8 * (HY_CS / 2); p += 512) { const int j = p / (HY_CS / 2), xp = p - j * (HY_CS / 2), x = 2 * xp + j; cp[p] = pk2(Kf[x], Kf[x + 1]); }
    __syncthreads();
}
__device__ __forceinline__ void hy_conv_mfma(Frame& F, f32x4 (&C)[8]) {
    const int lane = F.lane, w = F.wave, r = lane & 15, kq = lane >> 4;
    const int jc = (-r) & 7, cr = (r + 7) >> 3;
    const LAS unsigned char* abase = F.lds + HY_OFF_CP + (size_t)(jc * HY_CS + HY_M0 - 32 * (8 * w - 63) + 8 * kq - 8 * cr) * 2;
    const LAS unsigned char* bbase = F.lds + HY_OFF_UB + (size_t)((r & 7) * HY_UR + HY_UP + 16 * (r >> 3) + 8 * kq) * 2;
#pragma unroll
    for (int i = 0; i < 8; ++i) C[i] = (f32x4){0.f, 0.f, 0.f, 0.f};
    bf16x8_t Bw[9];
#pragma unroll
    for (int i = 0; i < 8; ++i) Bw[i] = *(const LAS bf16x8_t*)(bbase + 64 * (63 + i));
    bf16x8_t An = *(const LAS bf16x8_t*)(abase);
#pragma unroll 1
    for (int Q = 0; Q < 8; ++Q) {
        const LAS unsigned char* ab = abase - 64 * (9 * Q);
        const LAS unsigned char* bb = bbase + 64 * (63 - 9 * Q);
#pragma unroll
        for (int qq = 0; qq < 9; ++qq) {
            const bf16x8_t A = An;
            An = *(const LAS bf16x8_t*)(ab - 64 * (qq + 1));
            Bw[(8 - qq + 9) % 9] = *(const LAS bf16x8_t*)(bb + 64 * (-1 - qq));
#pragma unroll
            for (int i = 7; i >= 0; --i) C[i] = __builtin_amdgcn_mfma_f32_16x16x32_bf16(A, Bw[(i - qq + 9) % 9], C[i], 0, 0, 0);
        }
    }
}
__device__ __forceinline__ void hyena_units(Frame& F, const Args& a) {
    const bf16* zT = (const bf16*)(F.ws + WS_ZT);
    const float* Hf = (const float*)(F.ws + WS_HF);
    const float* cw = a.in[I_HYCW]; const float* cbp = a.in[I_HYCB]; const float* skip = a.in[I_SKIP];
    bf16* yT = (bf16*)(F.ws + WS_YT);
    LAS unsigned char* UB = F.lds + HY_OFF_UB; LAS unsigned char* XB = F.lds + HY_OFF_X;
    int c = F.bid; if (c >= HYC) return;
    HyStage sA, sC, sG; HyFilt fB, fF;
    hy_short_load(sA, zT + (size_t)c * T, F.tid); hy_filt_load(fB, Hf, 0, c, F.tid); hy_short_load(sC, zT + (size_t)(HYC + c) * T, F.tid);
#pragma unroll 1
    for (;;) {
        const int lane = F.lane, w = F.wave, n = lane & 15, bb = n & 7, hh = n >> 3, rq = lane >> 4;
        __syncthreads();
        for (int p = F.tid; p < 8 * 272; p += 512) { const int b = p / 272, q = p - b * 272; const int el = (q < 128) ? 2 * q : (HY_UP + SEQ + 2 * (q - 128)); *(LAS unsigned*)(UB + (size_t)(b * HY_UR + el) * 2) = 0u; }
        { const int ch = c; hy_short_store(UB, HY_UR, HY_UP, sA, cw[ch], cw[1536 + ch], cw[3072 + ch], cbp[ch], F.tid); }
        hy_filt_build(F, fB);
        { const int ch = HYC + c; hy_short_store(XB, SEQ, 0, sC, cw[ch], cw[1536 + ch], cw[3072 + ch], cbp[ch], F.tid); }
        hy_filt_load(fF, Hf, 1, c, F.tid); hy_short_load(sG, zT + (size_t)(2 * HYC + c) * T, F.tid);
        __syncthreads();
        f32x4 C[8];
        hy_conv_mfma(F, C);
        __syncthreads();
        {   const float sk = skip[c];
#pragma unroll
            for (int i = 0; i < 8; ++i) {
                const int t0 = 32 * (8 * w + i) + 16 * hh + 4 * rq;
                LAS v2u* up = (LAS v2u*)(UB + (size_t)(bb * HY_UR + HY_UP + t0) * 2);
                const v2u uu = *up; const v2u xx = *(const LAS v2u*)(XB + (size_t)(bb * SEQ + t0) * 2);
                v2u o;
                o.x = pk2(bflo(xx.x) * (C[i][0] + bflo(uu.x) * sk), bfhi(xx.x) * (C[i][1] + bfhi(uu.x) * sk));
                o.y = pk2(bflo(xx.y) * (C[i][2] + bflo(uu.y) * sk), bfhi(xx.y) * (C[i][3] + bfhi(uu.y) * sk));
                *up = o;
            }
        }
        __syncthreads();
        hy_filt_build(F, fF);
        { const int ch = 2 * HYC + c; hy_short_store(XB, SEQ, 0, sG, cw[ch], cw[1536 + ch], cw[3072 + ch], cbp[ch], F.tid); }
        const int cn = c + F.G; const bool more = cn < HYC;
        if (more) { hy_short_load(sA, zT + (size_t)cn * T, F.tid); hy_filt_load(fB, Hf, 0, cn, F.tid); hy_short_load(sC, zT + (size_t)(HYC + cn) * T, F.tid); }
        __syncthreads();
        hy_conv_mfma(F, C);
        {   const float sk = skip[HYC + c];
#pragma unroll
            for (int i = 0; i < 8; ++i) {
                const int t0 = 32 * (8 * w + i) + 16 * hh + 4 * rq;
                const v2u uu = *(const LAS v2u*)(UB + (size_t)(bb * HY_UR + HY_UP + t0) * 2); const v2u xx = *(const LAS v2u*)(XB + (size_t)(bb * SEQ + t0) * 2);
                v2u o;
                o.x = pk2(bflo(xx.x) * (C[i][0] + bflo(uu.x) * sk), bfhi(xx.x) * (C[i][1] + bfhi(uu.x) * sk));
                o.y = pk2(bflo(xx.y) * (C[i][2] + bflo(uu.y) * sk), bfhi(xx.y) * (C[i][3] + bfhi(uu.y) * sk));
                *(v2u*)(yT + (size_t)c * T + bb * SEQ + t0) = o;
            }
        }
        if (!more) break;
        c = cn;
    }
}
__device__ __forceinline__ void hy_transpose_tile(Frame& F, int tile) {
    const bf16* yT = (const bf16*)(F.ws + WS_YT); bf16* mix = (bf16*)(F.ws + WS_MIX0);
    LAS unsigned* scr = (LAS unsigned*)(F.lds + F.wave * (64 * 36 * 4));
    const int lane = F.lane, ct = tile & 7, tt = tile >> 3, c0 = 64 * ct, tok0 = 64 * tt;
    const int rr = lane >> 3, ch = lane & 7;
    v4u raw[8];
#pragma unroll
    for (int i = 0; i < 8; ++i) raw[i] = *(const v4u*)(yT + (size_t)(c0 + 8 * i + rr) * T + tok0 + 8 * ch);
#pragma unroll
    for (int i = 0; i < 8; ++i) {
        v4u o; o.x = __shfl_xor(raw[i].x, 8); o.y = __shfl_xor(raw[i].y, 8); o.z = __shfl_xor(raw[i].z, 8); o.w = __shfl_xor(raw[i].w, 8);
        const bool odd = rr & 1;
        const unsigned a0 = odd ? o.z : raw[i].x, a1 = odd ? o.w : raw[i].y;
        const unsigned b0 = odd ? raw[i].z : o.x, b1 = odd ? raw[i].w : o.y;
        const int cp = (8 * i + (rr & ~1)) >> 1;
        const int tb = 8 * ch + (odd ? 4 : 0);
        scr[(tb + 0) * 36 + cp] = (a0 & 0xffffu) | (b0 << 16);
        scr[(tb + 1) * 36 + cp] = (a0 >> 16) | (b0 & 0xffff0000u);
        scr[(tb + 2) * 36 + cp] = (a1 & 0xffffu) | (b1 << 16);
        scr[(tb + 3) * 36 + cp] = (a1 >> 16) | (b1 & 0xffff0000u);
    }
    LDS_WAIT(); asm volatile("" ::: "memory");
#pragma unroll
    for (int i = 0; i < 8; ++i) { const int tk = 8 * i + rr; const v4u w = *(const LAS v4u*)(scr + tk * 36 + 4 * ch);
        *(v4u*)(mix + (size_t)(tok0 + tk) * D + c0 + 8 * ch) = w; }
    LDS_WAIT(); asm volatile("" ::: "memory");
}

constexpr int AT_KSTR = 136;
template <int NT, bool DIL>
__device__ __forceinline__ void attn_wave16(const LAS unsigned char* Ks, const LAS unsigned char* VT, int vstr, int k0, const bf16* qrow, const LAS float* bt, int dil, int relbase, int lbase, int L,
                                            bf16* orow, float* lse_out, int lane) {
    const int r = lane & 15, rq = lane >> 4;
    bf16x8_t Qf[4];
    {
        v4u raw[4]; float ss = 0.f;
#pragma unroll
        for (int st = 0; st < 4; ++st) { raw[st] = *(const v4u*)(qrow + 32 * st + 8 * rq);
            const float a0 = bflo(raw[st].x), a1 = bfhi(raw[st].x), a2 = bflo(raw[st].y), a3 = bfhi(raw[st].y), a4 = bflo(raw[st].z), a5 = bfhi(raw[st].z), a6 = bflo(raw[st].w), a7 = bfhi(raw[st].w);
            ss += (a0 * a0 + a1 * a1) + (a2 * a2 + a3 * a3) + (a4 * a4 + a5 * a5) + (a6 * a6 + a7 * a7); }
        ss += __shfl_xor(ss, 16); ss += __shfl_xor(ss, 32);
        const float sc = 0.08838834764831845f / sqrtf(ss * (1.f / 128.f) + EPS);
#pragma unroll
        for (int st = 0; st < 4; ++st) { v4u w;
            w.x = pk2(bflo(raw[st].x) * sc, bfhi(raw[st].x) * sc); w.y = pk2(bflo(raw[st].y) * sc, bfhi(raw[st].y) * sc);
            w.z = pk2(bflo(raw[st].z) * sc, bfhi(raw[st].z) * sc); w.w = pk2(bflo(raw[st].w) * sc, bfhi(raw[st].w) * sc);
            Qf[st] = __builtin_bit_cast(bf16x8_t, w); }
    }
    f32x4 S[NT];
    const LAS unsigned char* kb = Ks + (size_t)(k0 + r) * (AT_KSTR * 2) + 16 * rq;
#pragma unroll
    for (int kt = 0; kt < NT; ++kt) {
        f32x4 acc = (f32x4){0.f, 0.f, 0.f, 0.f};
#pragma unroll
        for (int st = 0; st < 4; ++st) { const bf16x8_t A = *(const LAS bf16x8_t*)(kb + kt * 16 * (AT_KSTR * 2) + 64 * st); acc = __builtin_amdgcn_mfma_f32_16x16x32_bf16(A, Qf[st], acc, 0, 0, 0); }
        S[kt] = acc;
        asm volatile("" ::: "memory");
    }
    float mx = -3.0e38f;
#pragma unroll
    for (int kt = 0; kt < NT; ++kt)
#pragma unroll
        for (int g = 0; g < 4; ++g) {
            float s = S[kt][g];
            if (DIL) { const int rel = relbase + 16 * kt + g, lk = lbase + 16 * kt + g; const bool ok = (lk >= 0) && (lk < L);
                s = ok ? s + bt[rel + 128] : -3.0e38f; S[kt][g] = s; }
            mx = fmaxf(mx, s);
        }
    mx = fmaxf(mx, __shfl_xor(mx, 16)); mx = fmaxf(mx, __shfl_xor(mx, 32));
    float z = 0.f;
#pragma unroll
    for (int kt = 0; kt < NT; ++kt)
#pragma unroll
        for (int g = 0; g < 4; ++g) { const float p = __expf(S[kt][g] - mx); S[kt][g] = p; z += p; }
    z += __shfl_xor(z, 16); z += __shfl_xor(z, 32);
    const float iz = 1.0f / z;
    bf16x8_t Pf[NT / 2];
#pragma unroll
    for (int ks = 0; ks < NT / 2; ++ks) { v4u w; w.x = pk2(S[2 * ks][0], S[2 * ks][1]); w.y = pk2(S[2 * ks][2], S[2 * ks][3]); w.z = pk2(S[2 * ks + 1][0], S[2 * ks + 1][1]); w.w = pk2(S[2 * ks + 1][2], S[2 * ks + 1][3]);
        Pf[ks] = __builtin_bit_cast(bf16x8_t, w); }
    const LAS unsigned char* vb = VT + ((size_t)r * vstr + k0 + 4 * rq) * 2;
#pragma unroll
    for (int dt = 0; dt < 8; ++dt) {
        f32x4 o = (f32x4){0.f, 0.f, 0.f, 0.f};
#pragma unroll
        for (int ks = 0; ks < NT / 2; ++ks) {
            const LAS unsigned char* p = vb + (size_t)dt * 16 * vstr * 2 + 64 * ks;
            const v2u lo = *(const LAS v2u*)p, hi = *(const LAS v2u*)(p + 32);
            v4u w; w.x = lo.x; w.y = lo.y; w.z = hi.x; w.w = hi.y;
            o = __builtin_amdgcn_mfma_f32_16x16x32_bf16(__builtin_bit_cast(bf16x8_t, w), Pf[ks], o, 0, 0, 0);
        }
        v2u ow; ow.x = pk2(o[0] * iz, o[1] * iz); ow.y = pk2(o[2] * iz, o[3] * iz);
        *(v2u*)(orow + 16 * dt + 4 * rq) = ow;
        asm volatile("" ::: "memory");
    }
    if (DIL) { if (rq == 0) *lse_out = mx + logf(z); }
}
template <int NB, int BS, class RowFn>
__device__ __forceinline__ void attn_stage_k(LAS unsigned char* Ks, int nk, const float* qg, const float* kg, const bf16* kbase, RowFn rowoff, int wave, int lane) {
    const int rr = lane >> 4, cc = lane & 15;
    float gf[8];
    { const f32x4 a0 = *(const f32x4*)(qg + 8 * cc), a1 = *(const f32x4*)(qg + 8 * cc + 4), b0 = *(const f32x4*)(kg + 8 * cc), b1 = *(const f32x4*)(kg + 8 * cc + 4);
      gf[0] = a0.x * b0.x; gf[1] = a0.y * b0.y; gf[2] = a0.z * b0.z; gf[3] = a0.w * b0.w; gf[4] = a1.x * b1.x; gf[5] = a1.y * b1.y; gf[6] = a1.z * b1.z; gf[7] = a1.w * b1.w; }
#pragma unroll 1
    for (int bt = 0; bt < NB; ++bt) {
        v4u raw[BS];
#pragma unroll
        for (int i = 0; i < BS; ++i) { const int j = ((bt * BS + i) * 8 + wave) * 4 + rr; const long off = (j < nk) ? rowoff(j) : -1;
            raw[i] = *(const v4u*)(kbase + (off < 0 ? 0 : off) + 8 * cc); if (off < 0) raw[i] = (v4u){0u, 0u, 0u, 0u}; }
#pragma unroll
        for (int i = 0; i < BS; ++i) { const int j = ((bt * BS + i) * 8 + wave) * 4 + rr;
            const float k0 = bflo(raw[i].x), k1 = bfhi(raw[i].x), k2 = bflo(raw[i].y), k3 = bfhi(raw[i].y), k4 = bflo(raw[i].z), k5 = bfhi(raw[i].z), k6 = bflo(raw[i].w), k7 = bfhi(raw[i].w);
            float ss = (k0 * k0 + k1 * k1) + (k2 * k2 + k3 * k3) + (k4 * k4 + k5 * k5) + (k6 * k6 + k7 * k7);
            ss += __shfl_xor(ss, 1); ss += __shfl_xor(ss, 2); ss += __shfl_xor(ss, 4); ss += __shfl_xor(ss, 8);
            const float sc = 1.0f / sqrtf(ss * (1.f / 128.f) + EPS);
            v4u w; w.x = pk2(k0 * sc * gf[0], k1 * sc * gf[1]); w.y = pk2(k2 * sc * gf[2], k3 * sc * gf[3]); w.z = pk2(k4 * sc * gf[4], k5 * sc * gf[5]); w.w = pk2(k6 * sc * gf[6], k7 * sc * gf[7]);
            if (j < nk) *(LAS v4u*)(Ks + (size_t)j * (AT_KSTR * 2) + 16 * cc) = w; }
    }
}
__device__ __forceinline__ void attn_stage_vpair(LAS unsigned char* VT, int vstr, int j0, int dch, const v4u va, const v4u vb) {
    LAS unsigned char* p = VT + ((size_t)(8 * dch) * vstr + j0) * 2;
    const size_t rs = (size_t)vstr * 2;
    *(LAS unsigned*)(p + 0 * rs) = (va.x & 0xffffu) | (vb.x << 16);         *(LAS unsigned*)(p + 1 * rs) = (va.x >> 16) | (vb.x & 0xffff0000u);
    *(LAS unsigned*)(p + 2 * rs) = (va.y & 0xffffu) | (vb.y << 16);         *(LAS unsigned*)(p + 3 * rs) = (va.y >> 16) | (vb.y & 0xffff0000u);
    *(LAS unsigned*)(p + 4 * rs) = (va.z & 0xffffu) | (vb.z << 16);         *(LAS unsigned*)(p + 5 * rs) = (va.z >> 16) | (vb.z & 0xffff0000u);
    *(LAS unsigned*)(p + 6 * rs) = (va.w & 0xffffu) | (vb.w << 16);         *(LAS unsigned*)(p + 7 * rs) = (va.w >> 16) | (vb.w & 0xffff0000u);
}
template <int NB, int BS, int NPR, class RowFn>
__device__ __forceinline__ void attn_stage_v(LAS unsigned char* VT, int vstr, const bf16* vbase, RowFn rowoff, int tid) {
#pragma unroll 1
    for (int bt = 0; bt < NB; ++bt) {
        v4u va[BS], vb[BS];
#pragma unroll
        for (int k = 0; k < BS; ++k) { const int it = tid + 512 * (bt * BS + k), pr = it % NPR, dch = it / NPR;
            const long oa = (it < NPR * 16) ? rowoff(2 * pr) : -1, ob = (it < NPR * 16) ? rowoff(2 * pr + 1) : -1;
            va[k] = *(const v4u*)(vbase + (oa < 0 ? 0 : oa + 8 * dch)); vb[k] = *(const v4u*)(vbase + (ob < 0 ? 0 : ob + 8 * dch));
            if (oa < 0) va[k] = (v4u){0u, 0u, 0u, 0u}; if (ob < 0) vb[k] = (v4u){0u, 0u, 0u, 0u}; }
#pragma unroll
        for (int k = 0; k < BS; ++k) { const int it = tid + 512 * (bt * BS + k), pr = it % NPR, dch = it / NPR; if (it < NPR * 16) attn_stage_vpair(VT, vstr, 2 * pr, dch, va[k], vb[k]); }
    }
}

constexpr int XA_VSTR = 264, XA_OFF_VT = 256 * AT_KSTR * 2;
static_assert(XA_OFF_VT + 128 * XA_VSTR * 2 <= SCR_BYTES, "cross LDS");
__device__ __forceinline__ void cross_unit(Frame& F, const bf16* xq, const bf16* kv, const float* qg, const float* kg, bf16* mix, int unit) {
    int lane = (int)__builtin_amdgcn_mbcnt_hi(~0u, __builtin_amdgcn_mbcnt_lo(~0u, 0u)); asm volatile("" : "+v"(lane)); const int tid = F.wave * 64 + lane;
    const int b = unit >> 5, h = (unit >> 3) & 3, qc = unit & 7;
    LAS unsigned char* Ks = F.lds; LAS unsigned char* VT = F.lds + XA_OFF_VT;
    const bf16* kbase = kv + (size_t)(b * MEML) * 1024 + h * 128;
    __syncthreads();
    attn_stage_k<2, 4>(Ks, MEML, qg, kg, kbase, [=](int j) { return (long)j * 1024; }, F.wave, lane);
    attn_stage_v<2, 2, 128>(VT, XA_VSTR, kbase + 512, [=](int j) { return (long)j * 1024; }, tid);
    __syncthreads();
#pragma unroll 1
    for (int a = F.wave; a < 16; a += NWAVES) {
        const int token = b * SEQ + qc * 256 + 16 * a + (lane & 15);
        attn_wave16<16, false>(Ks, VT, XA_VSTR, 0, xq + (size_t)token * 512 + h * 128, nullptr, 1, 0, 0, 0, mix + (size_t)token * D + 512 + h * 128, nullptr, lane);
    }
}
constexpr int DA_VSTR = 280, DA_NK = 272, DA_OFF_VT = DA_NK * AT_KSTR * 2, DA_OFF_BT = DA_OFF_VT + 128 * DA_VSTR * 2;
static_assert(DA_OFF_BT + 320 * 4 <= SCR_BYTES, "dilated LDS");
__device__ __forceinline__ void dil_unit(Frame& F, const Args& a, int unit) {
    const int bh = unit / 48, sub = unit % 48, b = bh >> 2, h = bh & 3, g = sub >> 4, w16 = sub & 15;
    const int dil = (g == 0) ? 1 : (g == 1 ? 4 : 16), L = SEQ / dil, nch = L / 128;
    const int r = w16 / nch, n128 = w16 % nch;
    int lane = (int)__builtin_amdgcn_mbcnt_hi(~0u, __builtin_amdgcn_mbcnt_lo(~0u, 0u)); asm volatile("" : "+v"(lane)); const int tid = F.wave * 64 + lane;
    const bf16* qkv = (const bf16*)(F.ws + WS_QKV1);
    float* lse = (float*)(F.ws + WS_LSE);
    LAS unsigned char* Ks = F.lds; LAS unsigned char* VT = F.lds + DA_OFF_VT; LAS float* bt = (LAS float*)(F.lds + DA_OFF_BT);
    const int lk0 = 128 * n128 - 64;
    const bf16* base = qkv + (size_t)(b * SEQ + r) * NQKV + g * 512 + h * 128;
    const size_t lstep = (size_t)dil * NQKV;
    __syncthreads();
    if (tid < 320) { const int rel = tid - 128; bt[tid] = (rel >= -64 && rel <= 64) ? a.in[I_RELB][rel_bucket_dev(rel * dil) * 12 + g * 4 + h] : -3.0e38f; }
    attn_stage_k<3, 3>(Ks, DA_NK, a.in[I_ATQN], a.in[I_ATKN], base + ATW, [=](int j) { const int lk = lk0 + j; return (lk >= 0 && lk < L) ? (long)lk * (long)lstep : -1L; }, F.wave, lane);
    attn_stage_v<3, 2, DA_NK / 2>(VT, DA_VSTR, base + 2 * ATW, [=](int j) { const int lk = lk0 + j; return (lk >= 0 && lk < L) ? (long)lk * (long)lstep : -1L; }, tid);
    __syncthreads();
    {
        const int aq = F.wave, i = 16 * aq + (lane & 15), lq = 128 * n128 + i, token = b * SEQ + lq * dil + r, k0 = 16 * aq, rq = lane >> 4;
        attn_wave16<10, true>(Ks, VT, DA_VSTR, k0, base + (size_t)lq * lstep, bt, dil, k0 + 4 * rq - 64 - i, lk0 + k0 + 4 * rq, L,
                              (g == 0) ? (bf16*)(F.ws + WS_MIX1) + (size_t)token * D + h * 128 : (bf16*)(F.ws + WS_OG12) + ((size_t)(g - 1) * T + token) * 512 + h * 128,
                              lse + ((size_t)g * T + token) * 4 + h, lane);
    }
}
__device__ __forceinline__ void combine_phase(Frame& F, const Args& a) {
    moe_layout(F);
    const int gw = F.bid * NWAVES + F.wave, NGW = F.G * NWAVES, lane = F.lane;
    const int* toke = (const int*)(F.ws + WS_TOKE); const int* tokr = (const int*)(F.ws + WS_TOKR); const float* tokg = (const float*)(F.ws + WS_TOKG);
    const bf16* y = (const bf16*)(F.ws + WS_XS); const bf16* y2 = (const bf16*)(F.ws + WS_Y2);
    for (int token = gw; token < T; token += NGW) {
        const int e0 = toke[token * 2], e1 = toke[token * 2 + 1];
        const int s0 = ml_ps(F, e0) + tokr[token * 2], s1 = ml_ps(F, e1) + tokr[token * 2 + 1];
        const float g0 = tokg[token * 2], g1 = tokg[token * 2 + 1];
        f32x4* xo = (f32x4*)(a.out + (size_t)token * D); const v2u* xi = (const v2u*)((const bf16*)a.out + (size_t)token * 2048 + 1024);
        const v2u* y0 = (const v2u*)(y + (size_t)s0 * D); const v2u* y1 = (const v2u*)(y + (size_t)s1 * D);
        v2u xw[4], p0[4], p1[4];
#pragma unroll
        for (int j = 0; j < 4; ++j) { const int q = lane + 64 * j; xw[j] = xi[q]; p0[j] = y0[q]; p1[j] = y1[q]; }
        f32x4 r[4];
#pragma unroll
        for (int j = 0; j < 4; ++j) {
            const int q = lane + 64 * j;
            f32x4 x = (f32x4){bflo(xw[j].x), bfhi(xw[j].x), bflo(xw[j].y), bfhi(xw[j].y)};
            f32x4 a0 = (f32x4){bflo(p0[j].x), bfhi(p0[j].x), bflo(p0[j].y), bfhi(p0[j].y)}, a1 = (f32x4){bflo(p1[j].x), bfhi(p1[j].x), bflo(p1[j].y), bfhi(p1[j].y)};
            if (s0 >= 2 * T) { const v2u t = ((const v2u*)(y2 + (size_t)(s0 - 2 * T) * D))[q]; a0 = a0 + (f32x4){bflo(t.x), bfhi(t.x), bflo(t.y), bfhi(t.y)}; }
            if (s1 >= 2 * T) { const v2u t = ((const v2u*)(y2 + (size_t)(s1 - 2 * T) * D))[q]; a1 = a1 + (f32x4){bflo(t.x), bfhi(t.x), bflo(t.y), bfhi(t.y)}; }
            r[j] = x + g0 * a0 + g1 * a1;
        }
        asm volatile("s_waitcnt vmcnt(0)" ::: "memory");
#pragma unroll
        for (int j = 0; j < 4; ++j) xo[lane + 64 * j] = r[j];
    }
}

constexpr int NPHASE = 15;
__global__ void __launch_bounds__(NWAVES * 64, 2) mega_fwd(Args args) {
    extern __shared__ __attribute__((aligned(16))) unsigned char lds_raw[];
    Frame F;
    F.lds = (LAS unsigned char*)lds_raw; F.ws = args.ws;
    F.wave = __builtin_amdgcn_readfirstlane((int)threadIdx.x >> 6); F.G = gridDim.x; F.bid = blockIdx.x;
#define PH_BEGIN() do { int l_ = (int)__builtin_amdgcn_mbcnt_hi(~0u, __builtin_amdgcn_mbcnt_lo(~0u, 0u)); asm volatile("" : "+v"(l_)); F.lane = l_; F.tid = F.wave * 64 + l_; } while (0)
    PH_BEGIN();
    unsigned char* ws = args.ws;
    volatile LAS unsigned* MISC = (volatile LAS unsigned*)(F.lds + MISC_OFF);
    for (int u = F.tid; u < (LDS_BYTES - MISC_OFF) / 4; u += NWAVES * 64) MISC[u] = 0u;
    __syncthreads();
    const int lo = args.ph_lo, hi = args.ph_hi;
    const bool use_bar = (hi - lo) > 1;
    XcdBarrier bar; bar.bar = (unsigned*)(ws + WS_CTL) + CW_BAR + args.bslot * XCD_BAR_WORDS; bar.x = 0; bar.st = nullptr;
    if (use_bar) bar = xcd_barrier_post((unsigned*)(ws + WS_CTL) + CW_BAR + args.bslot * XCD_BAR_WORDS, MISC + 8, F.tid);
#define IN(k) (lo <= (k) && (k) < hi)
#define SEAM(k) do { if (IN(k) && IN((k) + 1)) { PH_BEGIN(); xcd_barrier(bar, F.tid); } } while (0)
    const int gw = F.bid * NWAVES + F.wave, NGW = F.G * NWAVES;
    LAS unsigned char* ring = F.lds;

    if (IN(0)) { PH_BEGIN(); p0_prologue(F, args); }
    SEAM(0);
    if (IN(1)) { PH_BEGIN();
        {   pg8::Gemm g{(const bf16*)(ws + WS_WIN0), (const bf16*)(ws + WS_XB), D, D, D, 0};
            pg8::StaticOrder S; S.init(ATW / 256, T / 256, F.G, F.bid);
            EpiB<3> E{(bf16*)(ws + WS_ZT), T, (const float*)(ws + WS_RSTD0), 1 << 30, nullptr, 0, nullptr, 1.0f};
            pg8::gemm_phase<EpiB<3>, pg8::StaticOrder, true>(ring, g, S, E, F.wave); }
        {   pg8::Gemm g{(const bf16*)(ws + WS_XB), (const bf16*)(ws + WS_WIN0) + (size_t)ATW * D, D, D, D, 0};
            pg8::StaticOrder S; S.init(T / 256, 2, F.G, (F.bid + 128) % F.G);
            EpiB<1> E{(bf16*)(ws + WS_XQ0), 512, (const float*)(ws + WS_RSTD0), 1 << 30, nullptr, 0, nullptr, 1.0f};
            pg8::gemm_phase<EpiB<1>, pg8::StaticOrder, true>(ring, g, S, E, F.wave); }
        {   pg8::Gemm g{(const bf16*)(ws + WS_MN), (const bf16*)(ws + WS_WKV), D, D, D, (size_t)D * D * 2};
            pg8::MoeOrder S; S.init(2 * TM / 256, 4, F.G, F.bid); S.t0 = TM / 256; S.t1 = S.t2 = S.t3 = S.t4 = S.t5 = S.t6 = 1 << 30; S.lay = nullptr; S.list = nullptr;
            EpiB<0> E{(bf16*)(ws + WS_KV), D, nullptr, 1 << 30, nullptr, 0, nullptr, 1.0f};
            pg8::gemm_phase<EpiB<0>, pg8::MoeOrder, true>(ring, g, S, E, F.wave); }
        if (F.G == 256 && F.bid >= 64) { PH_BEGIN(); moe_convert(F, args, 0, MOE_P1_HI, (F.bid - 64) * NWAVES + F.wave, 192 * NWAVES); }
    }
    SEAM(1);
    if (IN(2)) { PH_BEGIN();
        hyena_units(F, args);
        for (int u = F.bid; u < 256; u += F.G)
            cross_unit(F, (const bf16*)(ws + WS_XQ0), (const bf16*)(ws + WS_KV), args.in[I_XQN], args.in[I_XKN], (bf16*)(ws + WS_MIX0), u);
    }
    SEAM(2);
    if (IN(3)) { PH_BEGIN(); for (int t = gw; t < 2048; t += NGW) hy_transpose_tile(F, t); }
    SEAM(3);
    if (IN(4)) { PH_BEGIN();
        pg8::Gemm g{(const bf16*)(ws + WS_MIX0), (const bf16*)(ws + WS_WO), D, D, D, 0};
        pg8::StaticOrder S; S.init(T / 256, 4, F.G, F.bid);
        EpiRes<false, true> E{nullptr, (const bf16*)(ws + WS_XB), D, (bf16*)(ws + WS_XB), D, (float*)(ws + WS_SSQ16)};
        pg8::gemm_phase<EpiRes<false, true>, pg8::StaticOrder, true>(ring, g, S, E, F.wave);
    }
    SEAM(4);
    if (IN(5)) { PH_BEGIN();
        pg8::Gemm g{(const bf16*)(ws + WS_XB), (const bf16*)(ws + WS_WGU0), D, D, D, 0};
        pg8::StaticOrder S; S.init(T / 256, NGU / 256, F.G, F.bid);
        fill_rstd_table(F.lds, S, (const float*)(ws + WS_SSQ16), F.tid);
        EpiSwiglu<4> E{(bf16*)(ws + WS_HID0), FF, nullptr, (const LAS float*)(F.lds + RSL_OFF), 1.0f};
        pg8::gemm_phase<EpiSwiglu<4>, pg8::StaticOrder, true>(ring, g, S, E, F.wave);
        if (F.G == 256 && F.bid >= 128) { PH_BEGIN(); moe_convert(F, args, MOE_P1_HI, MOE_P5_HI, (F.bid - 128) * NWAVES + F.wave, 128 * NWAVES); }
    }
    SEAM(5);
    if (IN(6)) { PH_BEGIN();
        pg8::Gemm g{(const bf16*)(ws + WS_HID0), (const bf16*)(ws + WS_WD0), FF, FF, FF, 0};
        pg8::StaticOrder S; S.init(T / 256, 4, F.G, F.bid);
        EpiRes<false, true> E{nullptr, (const bf16*)(ws + WS_XB), D, (bf16*)(ws + WS_XB), D, (float*)(ws + WS_SSQ16)};
        pg8::gemm_phase<EpiRes<false, true>, pg8::StaticOrder, true>(ring, g, S, E, F.wave);
    }
    SEAM(6);
    if (IN(7)) { PH_BEGIN();
        pg8::Gemm g{(const bf16*)(ws + WS_XB), (const bf16*)(ws + WS_WIN1), D, D, D, 0};
        pg8::StaticOrder S; S.init(T / 256, NQ1 / 256, F.G, F.bid);
        fill_rstd_table(F.lds, S, (const float*)(ws + WS_SSQ16), F.tid);
        EpiB<4> E{(bf16*)(ws + WS_QKV1), NQKV, nullptr, NQKV / 256, (bf16*)(ws + WS_XQ1), 512, (const LAS float*)(F.lds + RSL_OFF), 1.0f};
        pg8::gemm_phase<EpiB<4>, pg8::StaticOrder, true>(ring, g, S, E, F.wave);
    }
    SEAM(7);
    if (IN(8)) { PH_BEGIN();
        for (int u = F.bid; u < NB * 4 * 48; u += F.G) dil_unit(F, args, u);
        for (int u = F.bid; u < 256; u += F.G)
            cross_unit(F, (const bf16*)(ws + WS_XQ1), (const bf16*)(ws + WS_KV) + (size_t)TM * D, args.in[I_XQN] + 128, args.in[I_XKN] + 128, (bf16*)(ws + WS_MIX1), u);
    }
    SEAM(8);
    if (IN(9)) { PH_BEGIN(); for (int t = gw; t < T; t += NGW) merge_token(F, t); }
    SEAM(9);
    if (IN(10)) { PH_BEGIN();
        pg8::Gemm g{(const bf16*)(ws + WS_MIX1), (const bf16*)(ws + WS_WO) + (size_t)D * D, D, D, D, 0};
        pg8::StaticOrder S; S.init(T / 256, 4, F.G, F.bid);
        EpiRes<false, false> E{nullptr, (const bf16*)(ws + WS_XB), D, (bf16*)args.out + 1024, 2048, nullptr};
        pg8::gemm_phase<EpiRes<false, false>, pg8::StaticOrder, true>(ring, g, S, E, F.wave);
    }
    SEAM(10);
    if (IN(11)) { PH_BEGIN(); for (int blk = F.bid; blk < T / 64; blk += F.G) route_block(F, args, blk); }
    SEAM(11);
    if (IN(12)) { PH_BEGIN();
        moe_layout(F);
        pg8::Gemm g{(const bf16*)(ws + WS_XB3), (const bf16*)(ws + WS_WGU1), D / 2, D / 2, D / 2, (size_t)NGU * D};
        pg8::MoeOrder S; S.init(ml_total(F) / 256, NGU / 256, F.G, F.bid); S.lay = (const volatile LAS int*)(F.lds + MISC_OFF); S.list = (const int*)(ws + WS_LIST);
        S.t0 = ml_ps(F, 1) / 256; S.t1 = ml_ps(F, 2) / 256; S.t2 = ml_ps(F, 3) / 256; S.t3 = ml_ps(F, 4) / 256; S.t4 = ml_ps(F, 5) / 256; S.t5 = ml_ps(F, 6) / 256; S.t6 = ml_ps(F, 7) / 256;
        EpiSwiglu<5, true> E{(bf16*)(ws + WS_HID1), FF, nullptr, nullptr, 1.0f / MOE_WGU_SCALE};
        if (F.bid & 1) { __builtin_amdgcn_s_sleep(127); __builtin_amdgcn_s_sleep(127); }
        pg8::gemm_phase<EpiSwiglu<5, true>, pg8::MoeOrder, true, true, true>(ring, g, S, E, F.wave);
    }
    SEAM(12);
    if (IN(13)) { PH_BEGIN();
        moe_layout(F);
        const int nMt = ml_total(F) / 256;
        const int q1 = ml_ps(F, 1) / 256, q2 = ml_ps(F, 2) / 256, q3 = ml_ps(F, 3) / 256, q4 = ml_ps(F, 4) / 256, q5 = ml_ps(F, 5) / 256, q6 = ml_ps(F, 6) / 256, q7 = ml_ps(F, 7) / 256;
        {   pg8::Gemm g{(const bf16*)(ws + WS_HID1), (const bf16*)(ws + WS_WD1), FF / 2, FF / 2, FF / 2, (size_t)D * FF};
            pg8::MoeOrder S; S.init(nMt < 128 ? nMt : 128, 4, F.G, F.bid); S.lay = nullptr; S.list = nullptr;
            S.t0 = q1; S.t1 = q2; S.t2 = q3; S.t3 = q4; S.t4 = q5; S.t5 = q6; S.t6 = q7;
            EpiB<5> E{(bf16*)(ws + WS_XS), D, nullptr, 1 << 30, nullptr, 0, nullptr, 1.0f / MOE_WD_SCALE};
            pg8::gemm_phase<EpiB<5>, pg8::MoeOrder, true, false, true>(ring, g, S, E, F.wave); }
        if (nMt > 128) {
            const int half = F.G / 2; const bool second = F.bid >= half;
            pg8::Gemm g{(const bf16*)(ws + WS_HID1), (const bf16*)(ws + WS_WD1), FF / 2, FF / 2, second ? 640 : 768, (size_t)D * FF};
            pg8::MoeTailOrder2 S; S.pm0 = 128; S.ntail = nMt - 128; S.nN = 4; S.G = second ? F.G - half : half; S.c = second ? F.bid - half : F.bid; S.koff = second ? 12 * 128 : 0;
            S.t0 = q1; S.t1 = q2; S.t2 = q3; S.t3 = q4; S.t4 = q5; S.t5 = q6; S.t6 = q7;
            EpiB<5> E{(bf16*)(ws + WS_XS), D, nullptr, 1 << 30, (bf16*)(ws + WS_Y2) - (size_t)2 * T * D, D, nullptr, 1.0f / MOE_WD_SCALE};
            pg8::gemm_phase<EpiB<5>, pg8::MoeTailOrder2, true, false, true>(ring, g, S, E, F.wave); }
    }
    SEAM(13);
    if (IN(14)) { PH_BEGIN(); combine_phase(F, args); }
#undef IN
#undef SEAM
}

#ifndef MK_ONE_LAUNCH
#define MK_ONE_LAUNCH 1
#endif
extern "C" void kernel_launch(void* const* d_in, const int* in_sizes, int n_in, void* d_out, int out_size, void* d_ws, size_t ws_size, hipStream_t stream) {
    static int grid = 0;
    if (grid == 0) {
        if (n_in != 30 || in_sizes[0] != T * D || out_size != T * D || ws_size < WS_END) {
            fprintf(stderr, "kernel_launch: unexpected problem (n_in %d, in0 %d, out %d, ws %zu, need %zu); nothing launched\n", n_in, n_in > 0 ? in_sizes[0] : -1, out_size, ws_size, (size_t)WS_END); grid = -1; return; }
        int dev = 0, cus = 0, per_cu = 0;
        if (hipGetDevice(&dev) != hipSuccess || hipDeviceGetAttribute(&cus, hipDeviceAttributeMultiprocessorCount, dev) != hipSuccess) { grid = -1; return; }
        if (hipFuncSetAttribute((const void*)mega_fwd, hipFuncAttributeMaxDynamicSharedMemorySize, LDS_BYTES) != hipSuccess) { fprintf(stderr, "kernel_launch: hipFuncSetAttribute failed\n"); grid = -1; return; }
        if (hipOccupancyMaxActiveBlocksPerMultiprocessor(&per_cu, (const void*)mega_fwd, NWAVES * 64, LDS_BYTES) != hipSuccess || per_cu < 1)
            fprintf(stderr, "kernel_launch: note: occupancy query reports %d workgroups per CU\n", per_cu);
        (void)hipGetLastError();
        grid = cus;
    }
    if (grid < 0) return;
    if (hipMemsetAsync((char*)d_ws + WS_CTL, 0, CTL_ZERO_BYTES, stream) != hipSuccess) return;
    Args a{};
    for (int i = 0; i < 30; ++i) a.in[i] = (const float*)d_in[i];
    a.out = (float*)d_out; a.ws = (unsigned char*)d_ws;
#if defined(PROBE_PHASE)
    a.ph_lo = 0; a.ph_hi = PROBE_PHASE + 1; a.bslot = 0;
    hipLaunchKernelGGL(mega_fwd, dim3(grid), dim3(NWAVES * 64), LDS_BYTES, stream, a);
    a.ph_lo = PROBE_PHASE; a.ph_hi = NPHASE; a.bslot = 1;
    hipLaunchKernelGGL(mega_fwd, dim3(grid), dim3(NWAVES * 64), LDS_BYTES, stream, a);
#elif MK_ONE_LAUNCH
    a.ph_lo = 0; a.ph_hi = NPHASE; a.bslot = 0;
    hipLaunchKernelGGL(mega_fwd, dim3(grid), dim3(NWAVES * 64), LDS_BYTES, stream, a);
#else
    for (int p = 0; p < NPHASE; ++p) { a.ph_lo = p; a.ph_hi = p + 1; a.bslot = 0; hipLaunchKernelGGL(mega_fwd, dim3(grid), dim3(NWAVES * 64), LDS_BYTES, stream, a); }
#endif
}
```

```cpp
#include <hip/hip_runtime.h>
#include <cstdio>
#include <cstdint>

namespace pg8 {
#define PG8_LAS __attribute__((address_space(3)))
typedef unsigned short bf16_t;
typedef short bf16x8 __attribute__((ext_vector_type(8)));
typedef float f32x4 __attribute__((ext_vector_type(4)));
typedef unsigned u32x4 __attribute__((ext_vector_type(4)));
constexpr int BM = 256, BK = 64, HALF = 128, HTB = HALF * BK * 2  , STAGE_BYTES = 8 * HTB, NXCD = 8, WGM = 8;

__host__ __device__ __forceinline__ int lds_byte(int r, int c) { const int st = (r >> 4) * 2 + (c >> 5), rr = r & 15, cc = c & 31, ob = rr * 64 + cc * 2; return st * 1024 + (ob ^ (((ob >> 9) & 1) << 5)); }
__host__ __device__ __forceinline__ void stage_rc(int b, int& R, int& C) { const int st = b / 1024, sb = b % 1024, swz = sb ^ (((sb >> 9) & 1) << 5); R = (st >> 1) * 16 + swz / 64; C = (st & 1) * 32 + (swz % 64) / 2; }
__host__ __device__ __forceinline__ int perm32(int rho) { const int n = rho >> 4, i = rho & 15; return 8 * (i >> 2) + 4 * n + (i & 3); }

struct Unit { int pm, pn, e, koff, idx; };
struct Gemm { const bf16_t* A; const bf16_t* Bt; int lda, ldb, K; size_t estride; };

struct StaticOrder {
    int nM, nN, nwg, G, c;
    __device__ __forceinline__ int gather_row(const Unit&, int slot) const { return slot; }
    __host__ __device__ void init(int nM_, int nN_, int G_, int c_) { nM = nM_; nN = nN_; nwg = nM * nN; G = G_; c = c_; }
    __host__ __device__ bool next(int i, Unit& u) const {
        const long L = (long)i * G + c; if (L >= nwg) return false;
        int wgid = (int)L; { const int q = nwg / NXCD, r = nwg % NXCD, xcd = wgid % NXCD, off = wgid / NXCD; wgid = (xcd < r ? xcd * (q + 1) : r * (q + 1) + (xcd - r) * q) + off; }
        const int nig = WGM * nN, gid = wgid / nig, fm = gid * WGM, gsz = (nM - fm) < WGM ? (nM - fm) : WGM;
        u.pm = fm + ((wgid % nig) % gsz); u.pn = (wgid % nig) / gsz; u.e = 0; u.koff = 0; return true;
    }
};
struct MoeOrder : StaticOrder {
    int t0, t1, t2, t3, t4, t5, t6;
    const volatile PG8_LAS int* lay;
    const int* list;
    __device__ __forceinline__ int gather_row(const Unit& u, int slot) const { const int rank = slot - lay[40 + u.e]; return rank < lay[32 + u.e] ? list[(size_t)u.e * 16384 + rank] : 0; }
    __host__ __device__ bool next(int i, Unit& u) const {
        if (!StaticOrder::next(i, u)) return false;
        const int p = u.pm; u.e = (p >= t0) + (p >= t1) + (p >= t2) + (p >= t3) + (p >= t4) + (p >= t5) + (p >= t6); return true;
    }
};

struct MoeTailOrder {
    int pm0, ntail, nN, G, c, khalf; int t0, t1, t2, t3, t4, t5, t6;
    __device__ __forceinline__ int gather_row(const Unit&, int slot) const { return slot; }
    __device__ __forceinline__ bool next(int i, Unit& u) const {
        const int L = i * G + c; if (L >= ntail * nN * 2) return false;
        const int kh = L & 1, q = L >> 1; u.pn = q % nN; u.pm = pm0 + q / nN; u.koff = kh * khalf;
        const int p = u.pm; u.e = (p >= t0) + (p >= t1) + (p >= t2) + (p >= t3) + (p >= t4) + (p >= t5) + (p >= t6); return true;
    }
};
struct MoeTailOrder2 {
    int pm0, ntail, nN, G, c, koff; int t0, t1, t2, t3, t4, t5, t6;
    __device__ __forceinline__ int gather_row(const Unit&, int slot) const { return slot; }
    __device__ __forceinline__ bool next(int i, Unit& u) const {
        const int L = i * G + c; if (L >= ntail * nN) return false;
        u.pn = L % nN; u.pm = pm0 + L / nN; u.koff = koff;
        const int p = u.pm; u.e = (p >= t0) + (p >= t1) + (p >= t2) + (p >= t3) + (p >= t4) + (p >= t5) + (p >= t6); return true;
    }
};
__device__ __forceinline__ unsigned cvt_pk_bf16(float lo, float hi) { unsigned r; asm volatile("v_cvt_pk_bf16_f32 %0, %1, %2" : "=v"(r) : "v"(lo), "v"(hi)); return r; }

typedef int v8i __attribute__((ext_vector_type(8)));
typedef int v4i __attribute__((ext_vector_type(4)));
template <class Epi, class Sched, bool ALIGN_EPI, bool GATHER = false, bool FP8 = false>
__device__ __forceinline__ void gemm_phase(PG8_LAS unsigned char* lds, const Gemm g, const Sched& S, const Epi& E, const int wid) {
    int lane = (int)__builtin_amdgcn_mbcnt_hi(~0u, __builtin_amdgcn_mbcnt_lo(~0u, 0u)); asm volatile("" : "+v"(lane));
    const int tid = wid * 64 + lane, wr = wid >> 2, wc = wid & 3, fr = lane & 15, fq = lane >> 4;
    const int K = g.K, nt = K / BK;
    unsigned cvo[4], nvo[4], voffB[2]; int rowA[2], colA[2];
#pragma unroll
    for (int i = 0; i < 2; ++i) { int R, C; stage_rc(tid * 16 + i * 8192, R, C); const int Rb = (R & ~31) + perm32(R & 31); rowA[i] = R; colA[i] = C;
        voffB[i] = (unsigned)(Rb * g.ldb + C) * 2u; }
    const size_t kstep = (size_t)(BK * 2);
    const size_t hstepB = (size_t)HALF * g.ldb * 2;
    const size_t tstepA = GATHER ? (size_t)0 : (size_t)2 * HALF * g.lda * 2, tstepB = 2 * hstepB;
#define PG8_ROWOFFS(vo, u) do { _Pragma("unroll") for (int _h = 0; _h < 2; ++_h) _Pragma("unroll") for (int _i = 0; _i < 2; ++_i) { \
        const int _r = _h * HALF + rowA[_i]; const unsigned _row = GATHER ? (unsigned)S.gather_row(u, (u).pm * BM + _r) : (unsigned)_r; \
        (vo)[2 * _h + _i] = (_row * (unsigned)g.lda + (unsigned)colA[_i]) * 2u; } } while (0)
    const unsigned ldsw = (unsigned)wid * 1024u;
    const int aoff = lds_byte(wr * 64 + fr, fq * 8), boff = lds_byte(wc * 32 + fr, fq * 8);
#define PG8_SA(b, h) (((b) * 2 + (h)) * HTB)
#define PG8_SB(b, h) ((4 + (b) * 2 + (h)) * HTB)
#define PG8_STAGE(bufoff, gbase, voff) do { _Pragma("unroll") for (int _i = 0; _i < 2; ++_i) \
        __builtin_amdgcn_global_load_lds((const unsigned*)((const char*)(gbase) + (voff)[_i]), (PG8_LAS unsigned*)(lds + (bufoff) + ldsw + _i * 8192), 16, 0, 0); } while (0)
#define PG8_STAGEA(bufoff, gbase, vo, h) do { _Pragma("unroll") for (int _i = 0; _i < 2; ++_i) \
        __builtin_amdgcn_global_load_lds((const unsigned*)((const char*)(gbase) + (vo)[2 * (h) + _i]), (PG8_LAS unsigned*)(lds + (bufoff) + ldsw + _i * 8192), 16, 0, 0); } while (0)
#define PG8_LDA(dst, b, h) do { _Pragma("unroll") for (int m = 0; m < 4; ++m) dst[m] = __builtin_shufflevector(*(const PG8_LAS v4i*)(lds + PG8_SA(b, h) + aoff + m * 2048), *(const PG8_LAS v4i*)(lds + PG8_SA(b, h) + aoff + m * 2048 + 1024), 0, 1, 2, 3, 4, 5, 6, 7); } while (0)
#define PG8_LDB(dst, b, h) do { _Pragma("unroll") for (int n = 0; n < 2; ++n) dst[n] = __builtin_shufflevector(*(const PG8_LAS v4i*)(lds + PG8_SB(b, h) + boff + n * 2048), *(const PG8_LAS v4i*)(lds + PG8_SB(b, h) + boff + n * 2048 + 1024), 0, 1, 2, 3, 4, 5, 6, 7); } while (0)
#define PG8_HALF(x, k) __builtin_bit_cast(bf16x8, __builtin_shufflevector(x, x, 4 * (k), 4 * (k) + 1, 4 * (k) + 2, 4 * (k) + 3))
#define PG8_MMA(ai, bj, At, Bt) do { if constexpr (FP8) __builtin_amdgcn_sched_barrier(0); __builtin_amdgcn_s_setprio(1); _Pragma("unroll") for (int m = 0; m < 4; ++m) _Pragma("unroll") for (int n = 0; n < 2; ++n) { \
        if constexpr (FP8) acc[ai][bj][m][n] = __builtin_amdgcn_mfma_scale_f32_16x16x128_f8f6f4(Bt[n], At[m], acc[ai][bj][m][n], 0, 0, 0, 0x7f7f7f7f, 0, 0x7f7f7f7f); \
        else { acc[ai][bj][m][n] = __builtin_amdgcn_mfma_f32_16x16x32_bf16(PG8_HALF(Bt[n], 0), PG8_HALF(At[m], 0), acc[ai][bj][m][n], 0, 0, 0); \
               acc[ai][bj][m][n] = __builtin_amdgcn_mfma_f32_16x16x32_bf16(PG8_HALF(Bt[n], 1), PG8_HALF(At[m], 1), acc[ai][bj][m][n], 0, 0, 0); } } \
        if constexpr (FP8) { _Pragma("unroll") for (int m = 0; m < 4; ++m) _Pragma("unroll") for (int n = 0; n < 2; ++n) asm volatile("" : "+v"(acc[ai][bj][m][n])); }   \
        __builtin_amdgcn_s_setprio(0); if constexpr (FP8) __builtin_amdgcn_sched_barrier(0); } while (0)
#define PG8_WAIT_V(n) asm volatile("s_waitcnt vmcnt(" #n ")" ::: "memory")
#define PG8_WAIT_L(n) asm volatile("s_waitcnt lgkmcnt(" #n ")" ::: "memory")
#define PG8_BAR __builtin_amdgcn_s_barrier()
#define PG8_SCHED __builtin_amdgcn_sched_barrier(0)
    Unit cur, nxt; int ui = 0;
    if (!S.next(0, cur)) return;
    cur.idx = 0;
    f32x4 acc[2][2][4][2];
#pragma unroll
    for (int a = 0; a < 2; ++a)
#pragma unroll
        for (int b = 0; b < 2; ++b)
#pragma unroll
            for (int m = 0; m < 4; ++m)
#pragma unroll
                for (int n = 0; n < 2; ++n) acc[a][b][m][n] = (f32x4){0.f, 0.f, 0.f, 0.f};
    v8i At[4], B0[2], B1[2];
    const char* cA = (const char*)g.A + (size_t)cur.pm * tstepA + cur.koff; const char* cB = (const char*)g.Bt + (size_t)cur.e * g.estride + (size_t)cur.pn * tstepB + cur.koff;
    PG8_ROWOFFS(cvo, cur);
#pragma unroll
    for (int i = 0; i < 4; ++i) nvo[i] = cvo[i];
    PG8_STAGE(PG8_SB(0, 0), cB, voffB); PG8_STAGE(PG8_SB(0, 1), cB + hstepB, voffB); PG8_STAGEA(PG8_SA(0, 0), cA, cvo, 0); PG8_STAGEA(PG8_SA(0, 1), cA, cvo, 1);
    if (wr == 1) PG8_BAR;
    PG8_WAIT_V(2); PG8_BAR;
    PG8_STAGE(PG8_SB(1, 0), cB + kstep, voffB); PG8_STAGEA(PG8_SA(1, 0), cA + kstep, cvo, 0); PG8_STAGE(PG8_SB(1, 1), cB + hstepB + kstep, voffB);
    PG8_WAIT_V(6); PG8_BAR;
    for (;;) {
        const bool has_next = S.next(ui + 1, nxt); nxt.idx = ui + 1;
        const char* nA = has_next ? (const char*)g.A + (size_t)nxt.pm * tstepA + nxt.koff : cA;
        const char* nB = has_next ? (const char*)g.Bt + (size_t)nxt.e * g.estride + (size_t)nxt.pn * tstepB + nxt.koff : cB;
        if constexpr (GATHER) { if (has_next) PG8_ROWOFFS(nvo, nxt); }
        for (int t = 0; t < nt; t += 2) {
            const bool last = (t == nt - 2);
            const char* a1 = cA + (size_t)(t + 1) * kstep;
            const char* a2 = last ? nA : cA + (size_t)(t + 2) * kstep; const char* b2 = last ? nB : cB + (size_t)(t + 2) * kstep;
            const char* a3 = a2 + kstep; const char* b3 = b2 + kstep;
            unsigned vo2[4];
#pragma unroll
            for (int i = 0; i < 4; ++i) vo2[i] = (GATHER && last) ? nvo[i] : cvo[i];
            PG8_LDB(B0, 0, 0); PG8_LDB(B1, 0, 1); PG8_SCHED; PG8_LDA(At, 0, 0); PG8_STAGEA(PG8_SA(1, 1), a1, cvo, 1);
            PG8_WAIT_V(8); PG8_WAIT_L(0); PG8_BAR; PG8_MMA(0, 0, At, B0); PG8_MMA(0, 1, At, B1); PG8_BAR; PG8_SCHED;
            PG8_LDA(At, 0, 1); PG8_STAGE(PG8_SB(0, 0), b2, voffB); PG8_STAGE(PG8_SB(0, 1), b2 + hstepB, voffB); PG8_STAGEA(PG8_SA(0, 0), a2, vo2, 0);
            PG8_WAIT_V(8); PG8_WAIT_L(0); PG8_BAR; PG8_MMA(1, 0, At, B0); PG8_MMA(1, 1, At, B1); PG8_BAR; PG8_SCHED;
            PG8_LDB(B0, 1, 0); PG8_LDB(B1, 1, 1); PG8_SCHED; PG8_LDA(At, 1, 0); PG8_STAGEA(PG8_SA(0, 1), a2, vo2, 1);
            PG8_WAIT_V(8); PG8_WAIT_L(0); PG8_BAR; PG8_MMA(0, 0, At, B0); PG8_MMA(0, 1, At, B1); PG8_BAR; PG8_SCHED;
            PG8_LDA(At, 1, 1); PG8_STAGE(PG8_SB(1, 0), b3, voffB); PG8_STAGE(PG8_SB(1, 1), b3 + hstepB, voffB); PG8_STAGEA(PG8_SA(1, 0), a3, vo2, 0);
            PG8_WAIT_V(8); PG8_WAIT_L(0); PG8_BAR; PG8_MMA(1, 0, At, B0); PG8_MMA(1, 1, At, B1); PG8_BAR; PG8_SCHED;
        }
        if constexpr (ALIGN_EPI) { if (wr == 0) PG8_BAR; }
        E(acc, cur, wr, wc, fr, fq);
        if (!has_next) break;
#pragma unroll
        for (int a = 0; a < 2; ++a)
#pragma unroll
            for (int b = 0; b < 2; ++b)
#pragma unroll
                for (int m = 0; m < 4; ++m)
#pragma unroll
                    for (int n = 0; n < 2; ++n) acc[a][b][m][n] = (f32x4){0.f, 0.f, 0.f, 0.f};
        cur = nxt; cA = nA; cB = nB; ++ui;
        if constexpr (GATHER) {
#pragma unroll
            for (int i = 0; i < 4; ++i) cvo[i] = nvo[i]; }
        if constexpr (ALIGN_EPI) { if (wr == 1) PG8_BAR; }
    }
    PG8_WAIT_V(0);
    if constexpr (!ALIGN_EPI) { if (wr == 0) PG8_BAR; }
    PG8_BAR;
#undef PG8_SA
#undef PG8_SB
#undef PG8_STAGE
#undef PG8_STAGEA
#undef PG8_ROWOFFS
#undef PG8_LDA
#undef PG8_LDB
#undef PG8_MMA
#undef PG8_HALF
#undef PG8_WAIT_V
#undef PG8_WAIT_L
#undef PG8_BAR
#undef PG8_SCHED
}
}

constexpr int NB = 8, SEQ = 2048, D = 1024, T = NB * SEQ;
constexpr int MEML = 256, TM = NB * MEML;
constexpr int HYC = 512, NZ0 = 2048;
constexpr int FF = 2816, NGU = 2 * FF;
constexpr int ATW = 1536, NQKV = 3 * ATW, NQ1 = NQKV + 512;
constexpr int NE = 8, PMAX = 2 * T + NE * 256;
constexpr float EPS = 1e-6f;
constexpr float MOE_WGU_SCALE = 32.0f, MOE_WD_SCALE = 64.0f;
constexpr int NWAVES = 8;

constexpr size_t MiB = 1u << 20;
constexpr size_t WS_CTL = 0, CTL_ZERO_BYTES = 1 * MiB;
constexpr size_t WS_WGU1 = 1 * MiB;
constexpr size_t WS_WD1 = 89 * MiB;
constexpr size_t WS_SMALL = 133 * MiB;
constexpr size_t WS_RSTD0 = WS_SMALL;
constexpr size_t WS_SSQ16 = WS_SMALL + 64 * 1024;
constexpr size_t WS_LSE = WS_SSQ16 + 1 * MiB;
constexpr size_t WS_TOKE = WS_LSE + 768 * 1024;
constexpr size_t WS_TOKR = WS_TOKE + 128 * 1024;
constexpr size_t WS_TOKG = WS_TOKR + 128 * 1024;
constexpr size_t WS_RSTD3 = WS_TOKG + 128 * 1024;
constexpr size_t WS_LIST = WS_RSTD3 + 64 * 1024;
constexpr size_t WS_RSTDS = WS_LIST + 512 * 1024;
static_assert(WS_RSTDS + PMAX * 4 <= WS_SMALL + 4 * MiB, "small region");
constexpr size_t WS_WO = 137 * MiB;
constexpr size_t WS_WIN1 = 141 * MiB;
constexpr size_t WS_WKV = 151 * MiB;
constexpr size_t WS_WIN0 = 155 * MiB;
constexpr size_t WS_WGU0 = 159 * MiB;
constexpr size_t WS_WD0 = 170 * MiB;
constexpr size_t WS_KV = 176 * MiB;
constexpr size_t WS_XB = 184 * MiB;
constexpr size_t WS_YT = 336 * MiB;
constexpr size_t WS_MIX0 = 216 * MiB;
constexpr size_t WS_MN = 248 * MiB;
constexpr size_t WS_ZT = 256 * MiB;
constexpr size_t WS_XQ0 = 304 * MiB;
constexpr size_t WS_HF = 320 * MiB;
constexpr size_t WS_HID0 = 248 * MiB;
constexpr size_t WS_QKV1 = 248 * MiB;
constexpr size_t WS_XQ1 = 392 * MiB;
constexpr size_t WS_OG12 = 216 * MiB;
constexpr size_t WS_MIX1 = 141 * MiB;
constexpr size_t WS_XB3 = 137 * MiB;
constexpr size_t WS_XS = 137 * MiB;
constexpr size_t WS_HID1 = 205 * MiB;
constexpr size_t WS_Y2 = 392 * MiB;
constexpr size_t WS_END = 408 * MiB;
static_assert(WS_HID1 + (size_t)PMAX * FF * 2 <= WS_END && WS_XQ1 + (size_t)T * 512 * 2 <= WS_END && WS_XS + (size_t)PMAX * 2048 <= WS_HID1, "ws map");

constexpr int CW_CNT = 64;
constexpr int CW_BAR = 4096;

constexpr int SCR_BYTES = 147456;
constexpr int MISC_OFF = SCR_BYTES;
constexpr int LDS_BYTES = SCR_BYTES + 4096;

#define LAS __attribute__((address_space(3)))
typedef unsigned short bf16;
typedef unsigned v4u __attribute__((ext_vector_type(4)));
typedef unsigned v2u __attribute__((ext_vector_type(2)));
typedef float f32x4 __attribute__((ext_vector_type(4)));
typedef float f32x2 __attribute__((ext_vector_type(2)));
#define LDS_WAIT() asm volatile("s_waitcnt lgkmcnt(0)" ::: "memory")
__device__ __forceinline__ unsigned f2bf(float f) { unsigned u = __builtin_bit_cast(unsigned, f); return (u + 0x7fffu + ((u >> 16) & 1u)) >> 16; }
__device__ __forceinline__ unsigned pk2(float lo, float hi) { unsigned r; asm("v_cvt_pk_bf16_f32 %0, %1, %2" : "=v"(r) : "v"(lo), "v"(hi)); return r; }
__device__ __forceinline__ unsigned pk4_fp8(float a, float b, float c, float d) { unsigned w = 0u; w = __builtin_amdgcn_cvt_pk_fp8_f32(a, b, w, false); w = __builtin_amdgcn_cvt_pk_fp8_f32(c, d, w, true); return w; }
__device__ __forceinline__ float bflo(unsigned w) { return __builtin_bit_cast(float, w << 16); }
__device__ __forceinline__ float bfhi(unsigned w) { return __builtin_bit_cast(float, w & 0xffff0000u); }
__device__ __forceinline__ float bf1(bf16 b) { return __builtin_bit_cast(float, ((unsigned)b) << 16); }
__device__ __forceinline__ float wave_sum(float v) {
#pragma unroll
    for (int o = 1; o < 64; o <<= 1) v += __shfl_xor(v, o);
    return v;
}
__device__ __forceinline__ float wave_max(float v) {
#pragma unroll
    for (int o = 1; o < 64; o <<= 1) v = fmaxf(v, __shfl_xor(v, o));
    return v;
}

#define XB_TMO      128
#define XB_XCNT(j)  (256  + 64 * (j))
#define XB_XSUB(j)  (1280 + 64 * (j))
#define XB_XGEN(j)  (2304 + 64 * (j))
#define XB_TOP      3328
#define XB_TOPGEN   3392
#define XCD_BAR_WORDS 3456
#define XB_SPIN_CAP (1u << 18)

__device__ __forceinline__ unsigned xb_ld(unsigned* p)              { return __hip_atomic_load(p, __ATOMIC_RELAXED, __HIP_MEMORY_SCOPE_AGENT); }
__device__ __forceinline__ unsigned xb_add(unsigned* p, unsigned v) { return __hip_atomic_fetch_add(p, v, __ATOMIC_RELAXED, __HIP_MEMORY_SCOPE_AGENT); }
__device__ __forceinline__ unsigned xb_xcc_id() { return (unsigned)__builtin_amdgcn_s_getreg((3 << 11) | 20) & 0xFu; }
#define XB_SPIN(cond, bar) do { unsigned _sp = 0; while (cond) { __builtin_amdgcn_s_sleep(1); \
    if ((++_sp & 255u) == 0u) { if (xb_ld(&(bar)[XB_TMO])) break; if (_sp > XB_SPIN_CAP) { atomicAdd(&(bar)[XB_TMO], 1u); break; } } } } while (0)

struct XcdBarrier {
    unsigned* bar; unsigned x;
    volatile LAS unsigned* st;
};
__device__ __forceinline__ XcdBarrier xcd_barrier_post(unsigned* bar, volatile LAS unsigned* st, int tid) {
    XcdBarrier b; b.bar = bar; b.x = xb_xcc_id(); b.st = st;
    if (tid == 0) (void)xb_add(&bar[XB_XCNT(b.x)], 1u);
    return b;
}
__device__ __forceinline__ void xcd_barrier_complete(unsigned* bar, unsigned x, unsigned& nloc, unsigned& nx) {
    const unsigned G = gridDim.x * gridDim.y * gridDim.z;
    unsigned sum, cnt, mine, sp = 0u;
    for (;;) {
        sum = 0u; cnt = 0u; mine = 0u;
#pragma unroll
        for (unsigned j = 0; j < 16; ++j) { const unsigned c = xb_ld(&bar[XB_XCNT(j)]); sum += c; cnt += (c > 0u) ? 1u : 0u; mine = (j == x) ? c : mine; }
        if (sum == G) break;
        __builtin_amdgcn_s_sleep(1);
        if ((++sp & 255u) == 0u) { if (xb_ld(&bar[XB_TMO])) break; if (sp > XB_SPIN_CAP) { atomicAdd(&bar[XB_TMO], 1u); break; } }
    }
    nloc = mine > 0u ? mine : 1u; nx = cnt > 0u ? cnt : 1u;
}
__device__ __forceinline__ void xcd_barrier(const XcdBarrier& b, int tid) {
    asm volatile("s_waitcnt vmcnt(0)" ::: "memory");
    __syncthreads();
    if (tid == 0) {
        unsigned* bar = b.bar;
        __builtin_amdgcn_s_waitcnt(0);
        unsigned nloc = b.st[0], nx = b.st[1];
        if (nloc == 0u) { xcd_barrier_complete(bar, b.x, nloc, nx); b.st[0] = nloc; b.st[1] = nx; }
        const unsigned old = xb_add(&bar[XB_XSUB(b.x)], 1u);
        const unsigned gen = old / nloc;
        if (old + 1u == (gen + 1u) * nloc) {
            __builtin_amdgcn_fence(__ATOMIC_RELEASE, "agent");
            asm volatile("s_waitcnt vmcnt(0)" ::: "memory");
            const unsigned og = xb_add(&bar[XB_TOP], 1u);
            const unsigned tg = og / nx;
            if (og + 1u == (tg + 1u) * nx) xb_add(&bar[XB_TOPGEN], 1u);
            else XB_SPIN(xb_ld(&bar[XB_TOPGEN]) == tg, bar);
            __builtin_amdgcn_fence(__ATOMIC_ACQUIRE, "agent");
            xb_add(&bar[XB_XGEN(b.x)], 1u);
            asm volatile("s_waitcnt vmcnt(0)" ::: "memory");
        } else {
            XB_SPIN(xb_ld(&bar[XB_XGEN(b.x)]) == gen, bar);
            __builtin_amdgcn_fence(__ATOMIC_ACQUIRE, "agent");
            asm volatile("s_waitcnt vmcnt(0)" ::: "memory");
        }
    }
    __syncthreads();
}

struct Args { const float* in[30]; float* out; unsigned char* ws; int ph_lo, ph_hi, bslot, pad; };
enum { I_X = 0, I_MEM, I_RELB, I_NMIX, I_NMEM, I_NFFN, I_WKV, I_XQN, I_XKN, I_WOUT, I_HYWIN, I_HYCW, I_HYCB, I_FW1, I_FB1, I_FW2, I_FB2, I_FW3, I_FREQ, I_SKIP,
       I_ATWIN, I_ATQN, I_ATKN, I_FFG, I_FFU, I_FFD, I_ROUTER, I_MOEG, I_MOEU, I_MOED };

struct Frame {
    LAS unsigned char* lds;
    unsigned char* ws;
    int tid, lane, wave, G, bid;
};

constexpr int RSL_OFF = 131072;
template <int SCALE> struct EpiB {
    bf16* O; int ldc; const float* sc; int split_tile; bf16* O2; int ldc2; const LAS float* rsl; float kc;
    __device__ __forceinline__ void operator()(const f32x4 (&acc)[2][2][4][2], const pg8::Unit& u, int wr, int wc, int fr, int fq) const {
        const int row0 = u.pm * 256 + wr * 64 + fr;
        bf16* base = O; int ld = ldc; int colt = u.pn * 256;
        if (u.pn >= split_tile) { base = O2; ld = ldc2; colt -= split_tile * 256; }
        if (u.koff != 0) base = O2;
        const int col0 = colt + wc * 32 + 8 * fq;
        float rsv[2][4];
        if (SCALE == 1) {
#pragma unroll
            for (int ai = 0; ai < 2; ++ai)
#pragma unroll
                for (int m = 0; m < 4; ++m) rsv[ai][m] = sc[row0 + ai * 128 + m * 16];
            asm volatile("s_waitcnt vmcnt(0)" ::: "memory");
        }
        f32x4 cs[2][2];
        if (SCALE == 3) {
#pragma unroll
            for (int bj = 0; bj < 2; ++bj)
#pragma unroll
                for (int n = 0; n < 2; ++n) cs[bj][n] = *(const f32x4*)(sc + u.pn * 256 + bj * 128 + wc * 32 + 8 * fq + 4 * n);
            asm volatile("s_waitcnt vmcnt(0)" ::: "memory");
        }
#pragma unroll
        for (int ai = 0; ai < 2; ++ai)
#pragma unroll
            for (int m = 0; m < 4; ++m) {
                const int row = row0 + ai * 128 + m * 16;
                float rs = 1.f;
                if (SCALE == 1) rs = rsv[ai][m];
                if (SCALE == 2) { const f32x4* p = (const f32x4*)(sc + (size_t)row * 16); const f32x4 a = p[0], b = p[1], c = p[2], d = p[3];
                    const float s = ((a.x + a.y) + (a.z + a.w)) + ((b.x + b.y) + (b.z + b.w)) + ((c.x + c.y) + (c.z + c.w)) + ((d.x + d.y) + (d.z + d.w));
                    rs = 1.0f / sqrtf(s * (1.0f / D) + EPS); }
                if (SCALE == 4) rs = rsl[u.idx * 256 + (row - u.pm * 256)];
                if (SCALE == 5) rs = kc;
                bf16* rowp = base + (size_t)row * ld + col0;
#pragma unroll
                for (int bj = 0; bj < 2; ++bj) {
                    f32x4 v0 = acc[ai][bj][m][0], v1 = acc[ai][bj][m][1];
                    if (SCALE == 1 || SCALE == 2 || SCALE == 4 || SCALE == 5) { v0 = v0 * rs; v1 = v1 * rs; }
                    if (SCALE == 3) { v0 = v0 * cs[bj][0]; v1 = v1 * cs[bj][1]; }
                    v4u w; w.x = pk2(v0[0], v0[1]); w.y = pk2(v0[2], v0[3]); w.z = pk2(v1[0], v1[1]); w.w = pk2(v1[2], v1[3]);
                    *(v4u*)(rowp + bj * 128) = w;
                }
            }
    }
};
template <bool XF32, bool SSQ> struct EpiRes {
    const float* xf; const bf16* xi; int ldi; bf16* xo; int ldo; float* ssq16;
    __device__ __forceinline__ void operator()(const f32x4 (&acc)[2][2][4][2], const pg8::Unit& u, int wr, int wc, int fr, int fq) const {
        const int row0 = u.pm * 256 + wr * 64 + fr, col0 = u.pn * 256 + wc * 32 + 8 * fq;
        if constexpr (!XF32) {
            v4u res[2][4][2];
#pragma unroll
            for (int ai = 0; ai < 2; ++ai)
#pragma unroll
                for (int m = 0; m < 4; ++m)
#pragma unroll
                    for (int bj = 0; bj < 2; ++bj) res[ai][m][bj] = *(const v4u*)(xi + (size_t)(row0 + ai * 128 + m * 16) * ldi + col0 + bj * 128);
            asm volatile("s_waitcnt vmcnt(0)" ::: "memory");
#pragma unroll
            for (int ai = 0; ai < 2; ++ai)
#pragma unroll
                for (int m = 0; m < 4; ++m) {
                    const int row = row0 + ai * 128 + m * 16;
                    float ss = 0.f;
#pragma unroll
                    for (int bj = 0; bj < 2; ++bj) {
                        const v4u w0 = res[ai][m][bj];
                        const f32x4 r0 = (f32x4){bflo(w0.x), bfhi(w0.x), bflo(w0.y), bfhi(w0.y)}, r1 = (f32x4){bflo(w0.z), bfhi(w0.z), bflo(w0.w), bfhi(w0.w)};
                        const f32x4 v0 = acc[ai][bj][m][0] + r0, v1 = acc[ai][bj][m][1] + r1;
                        v4u w; w.x = pk2(v0[0], v0[1]); w.y = pk2(v0[2], v0[3]); w.z = pk2(v1[0], v1[1]); w.w = pk2(v1[2], v1[3]);
                        *(v4u*)(xo + (size_t)row * ldo + col0 + bj * 128) = w;
                        if (SSQ) ss += ((v0[0] * v0[0] + v0[1] * v0[1]) + (v0[2] * v0[2] + v0[3] * v0[3])) + ((v1[0] * v1[0] + v1[1] * v1[1]) + (v1[2] * v1[2] + v1[3] * v1[3]));
                    }
                    if (SSQ) { ss += __shfl_xor(ss, 16); ss += __shfl_xor(ss, 32);
                        if (fq == 0) ssq16[(size_t)row * 16 + u.pn * 4 + wc] = ss; }
                }
        } else {
#pragma unroll
            for (int ai = 0; ai < 2; ++ai)
#pragma unroll
                for (int m = 0; m < 4; ++m) {
                    const int row = row0 + ai * 128 + m * 16;
                    float ss = 0.f;
#pragma unroll
                    for (int bj = 0; bj < 2; ++bj) {
                        const size_t off = (size_t)row * D + col0 + bj * 128; const f32x4 r0 = *(const f32x4*)(xf + off), r1 = *(const f32x4*)(xf + off + 4);
                        const f32x4 v0 = acc[ai][bj][m][0] + r0, v1 = acc[ai][bj][m][1] + r1;
                        v4u w; w.x = pk2(v0[0], v0[1]); w.y = pk2(v0[2], v0[3]); w.z = pk2(v1[0], v1[1]); w.w = pk2(v1[2], v1[3]);
                        *(v4u*)(xo + (size_t)row * ldo + col0 + bj * 128) = w;
                        if (SSQ) ss += ((v0[0] * v0[0] + v0[1] * v0[1]) + (v0[2] * v0[2] + v0[3] * v0[3])) + ((v1[0] * v1[0] + v1[1] * v1[1]) + (v1[2] * v1[2] + v1[3] * v1[3]));
                    }
                    if (SSQ) { ss += __shfl_xor(ss, 16); ss += __shfl_xor(ss, 32);
                        if (fq == 0) ssq16[(size_t)row * 16 + u.pn * 4 + wc] = ss; }
                }
        }
    }
};
template <int SCALE, bool OUT8 = false> struct EpiSwiglu {
    bf16* H; int ldh; const float* sc; const LAS float* rsl; float kc;
    __device__ __forceinline__ void operator()(const f32x4 (&acc)[2][2][4][2], const pg8::Unit& u, int wr, int wc, int fr, int fq) const {
        const int row0 = u.pm * 256 + wr * 64 + fr, col0 = u.pn * 128 + wc * 32 + 8 * fq;
#pragma unroll
        for (int ai = 0; ai < 2; ++ai)
#pragma unroll
            for (int m = 0; m < 4; ++m) {
                const int row = row0 + ai * 128 + m * 16;
                float rs = 1.f;
                if (SCALE == 1) rs = sc[row];
                if (SCALE == 2) { const f32x4* p = (const f32x4*)(sc + (size_t)row * 16); const f32x4 a = p[0], b = p[1], c = p[2], d = p[3];
                    const float s = ((a.x + a.y) + (a.z + a.w)) + ((b.x + b.y) + (b.z + b.w)) + ((c.x + c.y) + (c.z + c.w)) + ((d.x + d.y) + (d.z + d.w));
                    rs = 1.0f / sqrtf(s * (1.0f / D) + EPS); }
                if (SCALE == 4) rs = rsl[u.idx * 256 + (row - u.pm * 256)];
                if (SCALE == 5) rs = kc;
                float h[8];
#pragma unroll
                for (int n = 0; n < 2; ++n)
#pragma unroll
                    for (int j = 0; j < 4; ++j) { const float gv = acc[ai][0][m][n][j] * rs, uv = acc[ai][1][m][n][j] * rs;
                        h[n * 4 + j] = gv * uv * __builtin_amdgcn_rcpf(1.0f + __expf(-gv)); }
                if (OUT8) { v2u w; w.x = pk4_fp8(h[0], h[1], h[2], h[3]); w.y = pk4_fp8(h[4], h[5], h[6], h[7]); *(v2u*)((unsigned char*)H + (size_t)row * ldh + col0) = w; }
                else { v4u w; w.x = pk2(h[0], h[1]); w.y = pk2(h[2], h[3]); w.z = pk2(h[4], h[5]); w.w = pk2(h[6], h[7]);
                    *(v4u*)(H + (size_t)row * ldh + col0) = w; }
            }
    }
};

template <class Sched>
__device__ __forceinline__ void fill_rstd_table(LAS unsigned char* lds, const Sched& S, const float* ssq16, int tid) {
    LAS float* rsl = (LAS float*)(lds + RSL_OFF);
    pg8::Unit u;
    for (int ui = 0; ui < 16 && S.next(ui, u); ++ui) {
        if (tid < 256) { const f32x4* p = (const f32x4*)(ssq16 + (size_t)(u.pm * 256 + tid) * 16); const f32x4 a = p[0], b = p[1], c = p[2], d = p[3];
            const float s = ((a.x + a.y) + (a.z + a.w)) + ((b.x + b.y) + (b.z + b.w)) + ((c.x + c.y) + (c.z + c.w)) + ((d.x + d.y) + (d.z + d.w));
            rsl[ui * 256 + tid] = 1.0f / sqrtf(s * (1.0f / D) + EPS); }
    }
    __syncthreads();
}

__device__ __forceinline__ void p0_transpose_item(const float* W, int K, int N, bf16* WT, const float* gain, int mode, LAS float* scr, int item, int lane) {
    const int nblk = N / 64, kb = item / nblk, nb = item % nblk, k0 = 64 * kb, n0 = 64 * nb;
    const int lr = lane >> 4, lc = lane & 15;
    f32x4 v[16];
#pragma unroll
    for (int i = 0; i < 16; ++i) v[i] = *(const f32x4*)(W + (size_t)(k0 + 4 * i + lr) * N + n0 + 4 * lc);
    if (gain) {
#pragma unroll
        for (int i = 0; i < 16; ++i) v[i] = v[i] * gain[k0 + 4 * i + lr];
    }
#pragma unroll
    for (int i = 0; i < 16; ++i) { LAS float* s = scr + (4 * i + lr) * 65 + 4 * lc; s[0] = v[i].x; s[1] = v[i].y; s[2] = v[i].z; s[3] = v[i].w; }
    LDS_WAIT(); asm volatile("" ::: "memory");
    const int c = lane & 7;
    const int d0 = (mode == 0) ? n0 : (256 * (n0 / 128) + (n0 % 128) + (mode == 2 ? 128 : 0));
#pragma unroll
    for (int j = 0; j < 8; ++j) { const int n = (lane >> 3) + 8 * j; const LAS float* s = scr + (8 * c) * 65 + n;
        v4u o; o.x = pk2(s[0 * 65], s[1 * 65]); o.y = pk2(s[2 * 65], s[3 * 65]); o.z = pk2(s[4 * 65], s[5 * 65]); o.w = pk2(s[6 * 65], s[7 * 65]);
        *(v4u*)(WT + (size_t)(d0 + n) * K + k0 + 8 * c) = o; }
    LDS_WAIT(); asm volatile("" ::: "memory");
}
__device__ __forceinline__ void p0_transpose_item8(const float* W, int K, int N, unsigned char* WT8, const float* gain, float s8, int mode, LAS float* scr, int item, int lane) {
    const int nblk = N / 64, kb = item / nblk, nb = item % nblk, k0 = 64 * kb, n0 = 64 * nb;
    const int lr = lane >> 4, lc = lane & 15;
    f32x4 v[16];
#pragma unroll
    for (int i = 0; i < 16; ++i) v[i] = *(const f32x4*)(W + (size_t)(k0 + 4 * i + lr) * N + n0 + 4 * lc);
#pragma unroll
    for (int i = 0; i < 16; ++i) { const float g = gain ? gain[k0 + 4 * i + lr] * s8 : s8; v[i] = v[i] * g; }
#pragma unroll
    for (int i = 0; i < 16; ++i) { LAS float* s = scr + (4 * i + lr) * 65 + 4 * lc; s[0] = v[i].x; s[1] = v[i].y; s[2] = v[i].z; s[3] = v[i].w; }
    LDS_WAIT(); asm volatile("" ::: "memory");
    const int c = lane & 3;
    const int d0 = (mode == 0) ? n0 : (256 * (n0 / 128) + (n0 % 128) + (mode == 2 ? 128 : 0));
#pragma unroll
    for (int j = 0; j < 4; ++j) { const int n = (lane >> 2) + 16 * j; const LAS float* s = scr + (16 * c) * 65 + n;
        v4u o; o.x = pk4_fp8(s[0 * 65], s[1 * 65], s[2 * 65], s[3 * 65]); o.y = pk4_fp8(s[4 * 65], s[5 * 65], s[6 * 65], s[7 * 65]);
        o.z = pk4_fp8(s[8 * 65], s[9 * 65], s[10 * 65], s[11 * 65]); o.w = pk4_fp8(s[12 * 65], s[13 * 65], s[14 * 65], s[15 * 65]);
        *(v4u*)(WT8 + (size_t)(d0 + n) * K + k0 + 16 * c) = o; }
    LDS_WAIT(); asm volatile("" ::: "memory");
}
__device__ __forceinline__ float row_to_bf16(const float* xrow, bf16* orow, const float* gain, bool normalize, int lane) {
    const f32x4* xr = (const f32x4*)xrow + lane;
    f32x4 v[4]; float s = 0.f;
#pragma unroll
    for (int j = 0; j < 4; ++j) { v[j] = xr[64 * j]; s += (v[j].x * v[j].x + v[j].y * v[j].y) + (v[j].z * v[j].z + v[j].w * v[j].w); }
    const float rstd = 1.0f / sqrtf(wave_sum(s) * (1.f / D) + EPS);
    unsigned long long* o8 = (unsigned long long*)orow + lane;
#pragma unroll
    for (int j = 0; j < 4; ++j) {
        f32x4 w = v[j];
        if (normalize) { const f32x4 g = ((const f32x4*)gain)[lane + 64 * j]; w = w * rstd * g; }
        o8[64 * j] = (unsigned long long)pk2(w.x, w.y) | ((unsigned long long)pk2(w.z, w.w) << 32);
    }
    return rstd;
}
__device__ __forceinline__ void p0_filter_block(Frame& F, const Args& a, float* Hf, int jb) {
    const float* w1 = a.in[I_FW1]; const float* b1 = a.in[I_FB1]; const float* w2 = a.in[I_FW2]; const float* b2 = a.in[I_FB2]; const float* w3 = a.in[I_FW3]; const float* fr = a.in[I_FREQ];
    LAS float* h2s = (LAS float*)(F.lds + MISC_OFF + 256);
    const int lane = F.lane, j0 = jb * 8;
    LAS float* W1s = (LAS float*)F.lds; LAS float* W2s = W1s + 33 * 64;
    for (int i = F.tid; i < 33 * 64; i += 512) W1s[i] = w1[i];
    for (int i = F.tid; i < 64 * 64; i += 512) W2s[i] = w2[i];
    __syncthreads();
    {
        const int j = j0 + F.wave;
        const float freq = fr[lane], bb1 = b1[lane], bb2 = b2[lane];
        float feat = 0.f;
        {
            const int fi = (lane >= 17) ? lane - 17 : lane - 1;
            const float f = 1e-4f + (float)fi * ((15.0f - 1e-4f) / 15.0f);
            const float ang = (6.283185307179586f / 2048.0f) * (float)j * f;
            if (lane == 0) feat = (float)j * (1.0f / 2047.0f);
            else if (lane <= 16) feat = cosf(ang);
            else if (lane <= 32) feat = -sinf(ang);
        }
        float s1 = bb1;
#pragma unroll
        for (int i = 0; i < 33; ++i) s1 += __shfl(feat, i) * W1s[i * 64 + lane];
        const float h1 = sinf(freq * s1);
        float s2 = bb2;
#pragma unroll 16
        for (int i = 0; i < 64; ++i) s2 += __shfl(h1, i) * W2s[i * 64 + lane];
        h2s[lane * 8 + F.wave] = sinf(freq * s2);
    }
    __syncthreads();
    const int n0 = F.wave * 256;
    float acc[4][8];
#pragma unroll
    for (int q = 0; q < 4; ++q)
#pragma unroll
        for (int jj = 0; jj < 8; ++jj) acc[q][jj] = 0.f;
#pragma unroll 1
    for (int i0 = 0; i0 < 64; i0 += 8) {
        float w[8][4];
#pragma unroll
        for (int ii = 0; ii < 8; ++ii)
#pragma unroll
            for (int q = 0; q < 4; ++q) w[ii][q] = w3[(size_t)(i0 + ii) * 2048 + n0 + q * 64 + lane];
#pragma unroll
        for (int ii = 0; ii < 8; ++ii) {
            const f32x4 ha = *(const LAS f32x4*)(h2s + (i0 + ii) * 8), hb = *(const LAS f32x4*)(h2s + (i0 + ii) * 8 + 4);
#pragma unroll
            for (int q = 0; q < 4; ++q) {
                acc[q][0] += ha.x * w[ii][q]; acc[q][1] += ha.y * w[ii][q]; acc[q][2] += ha.z * w[ii][q]; acc[q][3] += ha.w * w[ii][q];
                acc[q][4] += hb.x * w[ii][q]; acc[q][5] += hb.y * w[ii][q]; acc[q][6] += hb.z * w[ii][q]; acc[q][7] += hb.w * w[ii][q]; }
        }
    }
    const float da = -3.0701134573253945f, db = -15.350567286626973f;
#pragma unroll
    for (int q = 0; q < 4; ++q) {
        const int n = n0 + q * 64 + lane, c = n & 511;
        const float delta = fabsf(da + (db - da) * ((float)c * (1.0f / 511.0f)));
        float o[8];
#pragma unroll
        for (int jj = 0; jj < 8; ++jj) { const float t = (float)(j0 + jj) * (1.0f / 2047.0f); o[jj] = acc[q][jj] * (expf(-t * delta) + 0.05f); }
        f32x4* dst = (f32x4*)(Hf + (size_t)n * 2048 + j0);
        dst[0] = (f32x4){o[0], o[1], o[2], o[3]}; dst[1] = (f32x4){o[4], o[5], o[6], o[7]};
    }
    __syncthreads();
}
constexpr int IT_MOE = 16 * 44, N_MOE_ITEMS = 24 * IT_MOE;
constexpr int MOE_P1_HI = 5376, MOE_P5_HI = 14336, MOE_P0_LO = MOE_P5_HI;
__device__ __forceinline__ void moe_convert(Frame& F, const Args& a, int lo, int hi, int gwl, int ngw) {
    LAS float* scr = (LAS float*)(F.lds + F.wave * 16640);
    unsigned char* ws = F.ws;
    for (int r = lo + gwl; r < hi; r += ngw) {
        const int mid = r / IT_MOE, li = r % IT_MOE, kind = mid >> 3, e = mid & 7;
        if (kind == 0) p0_transpose_item8(a.in[I_MOEG] + (size_t)e * D * FF, D, FF, ws + WS_WGU1 + (size_t)e * NGU * D, a.in[I_NFFN] + D, MOE_WGU_SCALE, 1, scr, li, F.lane);
        else if (kind == 1) p0_transpose_item8(a.in[I_MOEU] + (size_t)e * D * FF, D, FF, ws + WS_WGU1 + (size_t)e * NGU * D, a.in[I_NFFN] + D, MOE_WGU_SCALE, 2, scr, li, F.lane);
        else p0_transpose_item8(a.in[I_MOED] + (size_t)e * FF * D, FF, D, ws + WS_WD1 + (size_t)e * D * FF, nullptr, MOE_WD_SCALE, 0, scr, li, F.lane);
    }
}
__device__ __forceinline__ void p0_prologue(Frame& F, const Args& a) {
    LAS float* scr = (LAS float*)(F.lds + F.wave * 16640);
    const int gw = F.bid * NWAVES + F.wave, NGW = F.G * NWAVES;
    unsigned char* ws = F.ws;
    if (!(F.bid & 1)) { for (int jb = F.bid; jb < 256; jb += F.G) p0_filter_block(F, a, (float*)(ws + WS_HF), jb); }
    for (int m = gw; m < T; m += NGW) { const float r = row_to_bf16(a.in[I_X] + (size_t)m * D, (bf16*)(ws + WS_XB) + (size_t)m * D, nullptr, false, F.lane); if (F.lane == 0) ((float*)(ws + WS_RSTD0))[m] = r; }
    for (int m = gw; m < 2 * TM; m += NGW) { const int l = m / TM, r = m % TM;
        (void)row_to_bf16(a.in[I_MEM] + (size_t)r * D, (bf16*)(ws + WS_MN) + (size_t)m * D, a.in[I_NMEM] + l * D, true, F.lane); }
    constexpr int IT_A = 16 * 32, IT_SQ = 16 * 16, IT_G = 16 * 44, IT_D = 44 * 16, IT_W1 = 16 * 80;
    constexpr int NSMALL = IT_A + 4 * IT_SQ + 2 * IT_G + IT_D + IT_W1;
    for (int it = gw; it < NSMALL; it += NGW) {
        int r = it;
        if (r < IT_A) { p0_transpose_item(a.in[I_HYWIN], D, NZ0, (bf16*)(ws + WS_WIN0), a.in[I_NMIX], 0, scr, r, F.lane); continue; } r -= IT_A;
        if (r < IT_SQ) { p0_transpose_item(a.in[I_WKV], D, D, (bf16*)(ws + WS_WKV), nullptr, 0, scr, r, F.lane); continue; } r -= IT_SQ;
        if (r < IT_SQ) { p0_transpose_item(a.in[I_WKV] + (size_t)D * D, D, D, (bf16*)(ws + WS_WKV) + (size_t)D * D, nullptr, 0, scr, r, F.lane); continue; } r -= IT_SQ;
        if (r < IT_SQ) { p0_transpose_item(a.in[I_WOUT], D, D, (bf16*)(ws + WS_WO), nullptr, 0, scr, r, F.lane); continue; } r -= IT_SQ;
        if (r < IT_SQ) { p0_transpose_item(a.in[I_WOUT] + (size_t)D * D, D, D, (bf16*)(ws + WS_WO) + (size_t)D * D, nullptr, 0, scr, r, F.lane); continue; } r -= IT_SQ;
        if (r < IT_G) { p0_transpose_item(a.in[I_FFG], D, FF, (bf16*)(ws + WS_WGU0), a.in[I_NFFN], 1, scr, r, F.lane); continue; } r -= IT_G;
        if (r < IT_G) { p0_transpose_item(a.in[I_FFU], D, FF, (bf16*)(ws + WS_WGU0), a.in[I_NFFN], 2, scr, r, F.lane); continue; } r -= IT_G;
        if (r < IT_D) { p0_transpose_item(a.in[I_FFD], FF, D, (bf16*)(ws + WS_WD0), nullptr, 0, scr, r, F.lane); continue; } r -= IT_D;
        p0_transpose_item(a.in[I_ATWIN], D, NQ1, (bf16*)(ws + WS_WIN1), a.in[I_NMIX] + D, 0, scr, r, F.lane);
    }
    moe_convert(F, a, (F.G == 256) ? MOE_P0_LO : 0, N_MOE_ITEMS, gw, NGW);
    if (F.bid & 1) { __syncthreads(); for (int jb = F.bid; jb < 256; jb += F.G) p0_filter_block(F, a, (float*)(ws + WS_HF), jb); }
}
__device__ __forceinline__ float block_sum(Frame& F, float v) {
    LAS float* red = (LAS float*)(F.lds + MISC_OFF + 64);
    v = wave_sum(v);
    __syncthreads();
    if (F.lane == 0) red[F.wave] = v;
    __syncthreads();
    float s = 0.f;
#pragma unroll
    for (int w = 0; w < NWAVES; ++w) s += red[w];
    return s;
}
__device__ __forceinline__ int rel_bucket_dev(int rel) {
    const int n = rel < 0 ? -rel : rel;
    const int large = 8 + (n >= 15) + (n >= 27) + (n >= 50) + (n >= 91) + (n >= 166) + (n >= 305) + (n >= 559);
    return (rel > 0 ? 16 : 0) + (n < 8 ? n : large);
}
__device__ __forceinline__ void merge_token(Frame& F, int token) {
    const bf16* og = (const bf16*)(F.ws + WS_OG12); const float* lse = (const float*)(F.ws + WS_LSE);
    bf16* mix = (bf16*)(F.ws + WS_MIX1);
    const int lane = F.lane, h = lane >> 4;
    const float l0 = lse[(size_t)token * 4 + h], l1 = lse[((size_t)T + token) * 4 + h], l2 = lse[((size_t)2 * T + token) * 4 + h];
    const float mx = fmaxf(l0, fmaxf(l1, l2));
    float w0 = __expf(l0 - mx), w1 = __expf(l1 - mx), w2 = __expf(l2 - mx);
    const float iz = 1.0f / (w0 + w1 + w2); w0 *= iz; w1 *= iz; w2 *= iz;
    const v4u a0 = *(const v4u*)(mix + (size_t)token * D + 8 * lane);
    const v4u a1 = *(const v4u*)(og + (size_t)token * 512 + 8 * lane);
    const v4u a2 = *(const v4u*)(og + ((size_t)T + token) * 512 + 8 * lane);
    v4u o;
    o.x = pk2(w0 * bflo(a0.x) + w1 * bflo(a1.x) + w2 * bflo(a2.x), w0 * bfhi(a0.x) + w1 * bfhi(a1.x) + w2 * bfhi(a2.x));
    o.y = pk2(w0 * bflo(a0.y) + w1 * bflo(a1.y) + w2 * bflo(a2.y), w0 * bfhi(a0.y) + w1 * bfhi(a1.y) + w2 * bfhi(a2.y));
    o.z = pk2(w0 * bflo(a0.z) + w1 * bflo(a1.z) + w2 * bflo(a2.z), w0 * bfhi(a0.z) + w1 * bfhi(a1.z) + w2 * bfhi(a2.z));
    o.w = pk2(w0 * bflo(a0.w) + w1 * bflo(a1.w) + w2 * bflo(a2.w), w0 * bfhi(a0.w) + w1 * bfhi(a1.w) + w2 * bfhi(a2.w));
    *(v4u*)(mix + (size_t)token * D + 8 * lane) = o;
}

constexpr int RT_OFF_R = 0, RT_OFF_REC = 32768, RT_OFF_CNT = 32768 + 64 * 32;
__device__ __forceinline__ void route_block(Frame& F, const Args& a, int blk) {
    LAS float* RL = (LAS float*)(F.lds + RT_OFF_R); volatile LAS int* REC = (volatile LAS int*)(F.lds + RT_OFF_REC); LAS int* CNT = (LAS int*)(F.lds + RT_OFF_CNT);
    const int lane = F.lane;
    const float* g = a.in[I_NFFN] + D; const float* rt = a.in[I_ROUTER];
    __syncthreads();
    for (int i = F.tid; i < 2048; i += 512) { const f32x4 r = ((const f32x4*)rt)[i]; const float gg = g[i >> 1]; ((LAS f32x4*)RL)[i] = r * gg; }
    if (F.tid < 16) CNT[F.tid] = 0;
    __syncthreads();
    for (int q = 0; q < 8; ++q) {
        const int tl = F.wave * 8 + q, token = blk * 64 + tl;
        const bf16* xr = (const bf16*)a.out + (size_t)token * 2048 + 1024;
        f32x4 v[4]; float s = 0.f;
#pragma unroll
        for (int j = 0; j < 4; ++j) { const v2u w = ((const v2u*)xr)[lane + 64 * j]; v[j] = (f32x4){bflo(w.x), bfhi(w.x), bflo(w.y), bfhi(w.y)}; s += (v[j].x * v[j].x + v[j].y * v[j].y) + (v[j].z * v[j].z + v[j].w * v[j].w); }
        const float rstd = 1.0f / sqrtf(wave_sum(s) * (1.f / D) + EPS);
        { unsigned* o4 = (unsigned*)(F.ws + WS_XB3 + (size_t)token * D) + lane;
#pragma unroll
          for (int j = 0; j < 4; ++j) o4[64 * j] = pk4_fp8(v[j].x * rstd, v[j].y * rstd, v[j].z * rstd, v[j].w * rstd); }
        float lg[8];
#pragma unroll
        for (int e = 0; e < 8; ++e) lg[e] = 0.f;
#pragma unroll
        for (int j = 0; j < 4; ++j) {
            const int k0 = 4 * (lane + 64 * j);
#pragma unroll
            for (int qq = 0; qq < 4; ++qq) {
                const float hn = v[j][qq] * rstd;
                const f32x4 r0 = *(const LAS f32x4*)(RL + (k0 + qq) * 8), r1 = *(const LAS f32x4*)(RL + (k0 + qq) * 8 + 4);
                lg[0] += hn * r0.x; lg[1] += hn * r0.y; lg[2] += hn * r0.z; lg[3] += hn * r0.w;
                lg[4] += hn * r1.x; lg[5] += hn * r1.y; lg[6] += hn * r1.z; lg[7] += hn * r1.w;
            }
        }
#pragma unroll
        for (int e = 0; e < 8; ++e) lg[e] = wave_sum(lg[e]);
        int i1 = 0; float v1 = lg[0];
#pragma unroll
        for (int e = 1; e < 8; ++e) if (lg[e] > v1) { v1 = lg[e]; i1 = e; }
        int i2 = -1; float v2 = -3.0e38f;
#pragma unroll
        for (int e = 0; e < 8; ++e) if (e != i1 && lg[e] > v2) { v2 = lg[e]; i2 = e; }
        const float e2 = __expf(v2 - v1), g1 = 1.0f / (1.0f + e2), g2 = e2 * g1;
        if (lane == 0) {
            const int r1 = __hip_atomic_fetch_add(CNT + i1, 1, __ATOMIC_RELAXED, __HIP_MEMORY_SCOPE_WORKGROUP);
            const int r2 = __hip_atomic_fetch_add(CNT + i2, 1, __ATOMIC_RELAXED, __HIP_MEMORY_SCOPE_WORKGROUP);
            REC[tl * 8 + 0] = i1; REC[tl * 8 + 1] = i2; REC[tl * 8 + 2] = r1; REC[tl * 8 + 3] = r2;
            REC[tl * 8 + 4] = __builtin_bit_cast(int, g1); REC[tl * 8 + 5] = __builtin_bit_cast(int, g2); REC[tl * 8 + 6] = __builtin_bit_cast(int, rstd);
        }
    }
    __syncthreads();
    if (F.tid < 8) { unsigned* cnt = (unsigned*)(F.ws + WS_CTL) + CW_CNT; CNT[8 + F.tid] = (int)__hip_atomic_fetch_add(cnt + F.tid, (unsigned)CNT[F.tid], __ATOMIC_RELAXED, __HIP_MEMORY_SCOPE_AGENT); }
    __syncthreads();
    if (F.tid < 64) {
        const int tl = F.tid, token = blk * 64 + tl;
        const int i1 = REC[tl * 8 + 0], i2 = REC[tl * 8 + 1], r1 = CNT[8 + i1] + REC[tl * 8 + 2], r2 = CNT[8 + i2] + REC[tl * 8 + 3];
        int* toke = (int*)(F.ws + WS_TOKE); int* tokr = (int*)(F.ws + WS_TOKR); int* tokg = (int*)(F.ws + WS_TOKG); int* list = (int*)(F.ws + WS_LIST);
        list[(size_t)i1 * T + r1] = token; list[(size_t)i2 * T + r2] = token;
        toke[token * 2] = i1; toke[token * 2 + 1] = i2; tokr[token * 2] = r1; tokr[token * 2 + 1] = r2;
        tokg[token * 2] = REC[tl * 8 + 4]; tokg[token * 2 + 1] = REC[tl * 8 + 5];
        ((int*)(F.ws + WS_RSTD3))[token] = REC[tl * 8 + 6];
    }
}
__device__ __forceinline__ void moe_layout(Frame& F) {
    volatile LAS int* M = (volatile LAS int*)(F.lds + MISC_OFF);
    __syncthreads();
    if (F.tid == 0) {
        const unsigned* cnt = (const unsigned*)(F.ws + WS_CTL) + CW_CNT;
        int acc = 0;
        for (int e = 0; e < 8; ++e) { const int c = (int)__hip_atomic_load(cnt + e, __ATOMIC_RELAXED, __HIP_MEMORY_SCOPE_AGENT); M[32 + e] = c; M[40 + e] = acc; acc += (c + 255) & ~255; }
        M[48] = acc;
    }
    __syncthreads();
}
__device__ __forceinline__ int ml_ps(Frame& F, int e) { return ((volatile LAS int*)(F.lds + MISC_OFF))[40 + e]; }
__device__ __forceinline__ int ml_cnt(Frame& F, int e) { return ((volatile LAS int*)(F.lds + MISC_OFF))[32 + e]; }
__device__ __forceinline__ int ml_total(Frame& F) { return ((volatile LAS int*)(F.lds + MISC_OFF))[48]; }
__device__ __forceinline__ int ml_expert(Frame& F, int slot) { int e = 0;
#pragma unroll
    for (int i = 1; i < 8; ++i) e += (slot >= ml_ps(F, i)) ? 1 : 0;
    return e; }

constexpr int HY_CS = 4168, HY_M0 = 2080, HY_UR = 2592, HY_UP = 256;
constexpr int HY_OFF_CP = 64, HY_OFF_UB = HY_OFF_CP + 8 * HY_CS * 2, HY_OFF_X = HY_OFF_UB + 8 * HY_UR * 2;
static_assert(HY_OFF_X + 8 * 2048 * 2 <= SCR_BYTES, "hyena LDS");
typedef short bf16x8_t __attribute__((ext_vector_type(8)));

struct HyStage { v4u raw[4]; float zm[4], zp[4]; };
struct HyFilt { float f[4], b[4]; };
__device__ __forceinline__ void hy_short_load(HyStage& s, const bf16* zr, int tid) {
#pragma unroll
    for (int k = 0; k < 4; ++k) {
        const int item = tid + 512 * k, b = item >> 8, t8 = (item & 255) * 8;
        const bf16* p = zr + b * SEQ + t8;
        s.raw[k] = *(const v4u*)p;
        s.zm[k] = (t8 > 0) ? bf1(p[-1]) : 0.f; s.zp[k] = (t8 + 8 < SEQ) ? bf1(p[8]) : 0.f;
    }
}
__device__ __forceinline__ void hy_short_store(LAS unsigned char* dst, int stride_el, int pad_el, const HyStage& s, float w0, float w1, float w2, float cb, int tid) {
#pragma unroll
    for (int k = 0; k < 4; ++k) {
        const int item = tid + 512 * k, b = item >> 8, t8 = (item & 255) * 8;
        float z[10];
        z[0] = s.zm[k]; z[1] = bflo(s.raw[k].x); z[2] = bfhi(s.raw[k].x); z[3] = bflo(s.raw[k].y); z[4] = bfhi(s.raw[k].y); z[5] = bflo(s.raw[k].z); z[6] = bfhi(s.raw[k].z); z[7] = bflo(s.raw[k].w); z[8] = bfhi(s.raw[k].w); z[9] = s.zp[k];
        float o[8];
#pragma unroll
        for (int i = 0; i < 8; ++i) o[i] = cb + z[i] * w0 + z[i + 1] * w1 + z[i + 2] * w2;
        v4u w; w.x = pk2(o[0], o[1]); w.y = pk2(o[2], o[3]); w.z = pk2(o[4], o[5]); w.w = pk2(o[6], o[7]);
        *(LAS v4u*)(dst + (size_t)(b * stride_el + pad_el + t8) * 2) = w;
    }
}
__device__ __forceinline__ void hy_filt_load(HyFilt& q, const float* Hf, int o, int c, int tid) {
    const float* fw = Hf + ((size_t)(o * 2 + 0) * 512 + c) * 2048;
    const float* bw = Hf + ((size_t)(o * 2 + 1) * 512 + c) * 2048;
#pragma unroll
    for (int i = 0; i < 4; ++i) { const int j = tid + 512 * i; q.f[i] = fw[j]; q.b[i] = (j >= 1) ? bw[j] : 0.f; }
}
__device__ __forceinline__ void hy_filt_build(Frame& F, const HyFilt& q) {
    LAS float* Kf = (LAS float*)(F.lds + HY_OFF_X);
    float s = 0.f;
#pragma unroll
    for (int i = 0; i < 4; ++i) s += fabsf(q.f[i]) + fabsf(q.b[i]);
    const float tot = block_sum(F, s);
    const float inv = 1.0f / (tot + 1e-6f);
#pragma unroll
    for (int i = 0; i < 4; ++i) { const int j = F.tid + 512 * i; Kf[HY_M0 - j] = q.f[i] * inv; if (j >= 1) Kf[HY_M0 + j] = q.b[i] * inv; }
    if (F.tid < 33) Kf[F.tid] = 0.f;
    if (F.tid < 48) Kf[4128 + F.tid] = 0.f;
    __syncthreads();
    LAS unsigned* cp = (LAS unsigned*)(F.lds + HY_OFF_CP);
    for (int p = F.tid; p < 8 * (HY_CS / 2); p += 512) { const int j = p / (HY_CS / 2), xp = p - j * (HY_CS / 2), x = 2 * xp + j; cp[p] = pk2(Kf[x], Kf[x + 1]); }
    __syncthreads();
}
__device__ __forceinline__ void hy_conv_mfma(Frame& F, f32x4 (&C)[8]) {
    const int lane = F.lane, w = F.wave, r = lane & 15, kq = lane >> 4;
    const int jc = (-r) & 7, cr = (r + 7) >> 3;
    const LAS unsigned char* abase = F.lds + HY_OFF_CP + (size_t)(jc * HY_CS + HY_M0 - 32 * (8 * w - 63) + 8 * kq - 8 * cr) * 2;
    const LAS unsigned char* bbase = F.lds + HY_OFF_UB + (size_t)((r & 7) * HY_UR + HY_UP + 16 * (r >> 3) + 8 * kq) * 2;
#pragma unroll
    for (int i = 0; i < 8; ++i) C[i] = (f32x4){0.f, 0.f, 0.f, 0.f};
    bf16x8_t Bw[9];
#pragma unroll
    for (int i = 0; i < 8; ++i) Bw[i] = *(const LAS bf16x8_t*)(bbase + 64 * (63 + i));
    bf16x8_t An = *(const LAS bf16x8_t*)(abase);
#pragma unroll 1
    for (int Q = 0; Q < 8; ++Q) {
        const LAS unsigned char* ab = abase - 64 * (9 * Q);
        const LAS unsigned char* bb = bbase + 64 * (63 - 9 * Q);
#pragma unroll
        for (int qq = 0; qq < 9; ++qq) {
            const bf16x8_t A = An;
            An = *(const LAS bf16x8_t*)(ab - 64 * (qq + 1));
            Bw[(8 - qq + 9) % 9] = *(const LAS bf16x8_t*)(bb + 64 * (-1 - qq));
#pragma unroll
            for (int i = 7; i >= 0; --i) C[i] = __builtin_amdgcn_mfma_f32_16x16x32_bf16(A, Bw[(i - qq + 9) % 9], C[i], 0, 0, 0);
        }
    }
}
__device__ __forceinline__ void hyena_units(Frame& F, const Args& a) {
    const bf16* zT = (const bf16*)(F.ws + WS_ZT);
    const float* Hf = (const float*)(F.ws + WS_HF);
    const float* cw = a.in[I_HYCW]; const float* cbp = a.in[I_HYCB]; const float* skip = a.in[I_SKIP];
    bf16* yT = (bf16*)(F.ws + WS_YT);
    LAS unsigned char* UB = F.lds + HY_OFF_UB; LAS unsigned char* XB = F.lds + HY_OFF_X;
    int c = F.bid; if (c >= HYC) return;
    HyStage sA, sC, sG; HyFilt fB, fF;
    hy_short_load(sA, zT + (size_t)c * T, F.tid); hy_filt_load(fB, Hf, 0, c, F.tid); hy_short_load(sC, zT + (size_t)(HYC + c) * T, F.tid);
#pragma unroll 1
    for (;;) {
        const int lane = F.lane, w = F.wave, n = lane & 15, bb = n & 7, hh = n >> 3, rq = lane >> 4;
        __syncthreads();
        for (int p = F.tid; p < 8 * 272; p += 512) { const int b = p / 272, q = p - b * 272; const int el = (q < 128) ? 2 * q : (HY_UP + SEQ + 2 * (q - 128)); *(LAS unsigned*)(UB + (size_t)(b * HY_UR + el) * 2) = 0u; }
        { const int ch = c; hy_short_store(UB, HY_UR, HY_UP, sA, cw[ch], cw[1536 + ch], cw[3072 + ch], cbp[ch], F.tid); }
        hy_filt_build(F, fB);
        { const int ch = HYC + c; hy_short_store(XB, SEQ, 0, sC, cw[ch], cw[1536 + ch], cw[3072 + ch], cbp[ch], F.tid); }
        hy_filt_load(fF, Hf, 1, c, F.tid); hy_short_load(sG, zT + (size_t)(2 * HYC + c) * T, F.tid);
        __syncthreads();
        f32x4 C[8];
        hy_conv_mfma(F, C);
        __syncthreads();
        {   const float sk = skip[c];
#pragma unroll
            for (int i = 0; i < 8; ++i) {
                const int t0 = 32 * (8 * w + i) + 16 * hh + 4 * rq;
                LAS v2u* up = (LAS v2u*)(UB + (size_t)(bb * HY_UR + HY_UP + t0) * 2);
                const v2u uu = *up; const v2u xx = *(const LAS v2u*)(XB + (size_t)(bb * SEQ + t0) * 2);
                v2u o;
                o.x = pk2(bflo(xx.x) * (C[i][0] + bflo(uu.x) * sk), bfhi(xx.x) * (C[i][1] + bfhi(uu.x) * sk));
                o.y = pk2(bflo(xx.y) * (C[i][2] + bflo(uu.y) * sk), bfhi(xx.y) * (C[i][3] + bfhi(uu.y) * sk));
                *up = o;
            }
        }
        __syncthreads();
        hy_filt_build(F, fF);
        { const int ch = 2 * HYC + c; hy_short_store(XB, SEQ, 0, sG, cw[ch], cw[1536 + ch], cw[3072 + ch], cbp[ch], F.tid); }
        const int cn = c + F.G; const bool more = cn < HYC;
        if (more) { hy_short_load(sA, zT + (size_t)cn * T, F.tid); hy_filt_load(fB, Hf, 0, cn, F.tid); hy_short_load(sC, zT + (size_t)(HYC + cn) * T, F.tid); }
        __syncthreads();
        hy_conv_mfma(F, C);
        {   const float sk = skip[HYC + c];
#pragma unroll
            for (int i = 0; i < 8; ++i) {
                const int t0 = 32 * (8 * w + i) + 16 * hh + 4 * rq;
                const v2u uu = *(const LAS v2u*)(UB + (size_t)(bb * HY_UR + HY_UP + t0) * 2); const v2u xx = *(const LAS v2u*)(XB + (size_t)(bb * SEQ + t0) * 2);
                v2u o;
                o.x = pk2(bflo(xx.x) * (C[i][0] + bflo(uu.x) * sk), bfhi(xx.x) * (C[i][1] + bfhi(uu.x) * sk));
                o.y = pk2(bflo(xx.y) * (C[i][2] + bflo(uu.y) * sk), bfhi(xx.y) * (C[i][3] + bfhi(uu.y) * sk));
                *(v2u*)(yT + (size_t)c * T + bb * SEQ + t0) = o;
            }
        }
        if (!more) break;
        c = cn;
    }
}
__device__ __forceinline__ void hy_transpose_tile(Frame& F, int tile) {
    const bf16* yT = (const bf16*)(F.ws + WS_YT); bf16* mix = (bf16*)(F.ws + WS_MIX0);
    LAS unsigned* scr = (LAS unsigned*)(F.lds + F.wave * (64 * 36 * 4));
    const int lane = F.lane, ct = tile & 7, tt = tile >> 3, c0 = 64 * ct, tok0 = 64 * tt;
    const int rr = lane >> 3, ch = lane & 7;
    v4u raw[8];
#pragma unroll
    for (int i = 0; i < 8; ++i) raw[i] = *(const v4u*)(yT + (size_t)(c0 + 8 * i + rr) * T + tok0 + 8 * ch);
#pragma unroll
    for (int i = 0; i < 8; ++i) {
        v4u o; o.x = __shfl_xor(raw[i].x, 8); o.y = __shfl_xor(raw[i].y, 8); o.z = __shfl_xor(raw[i].z, 8); o.w = __shfl_xor(raw[i].w, 8);
        const bool odd = rr & 1;
        const unsigned a0 = odd ? o.z : raw[i].x, a1 = odd ? o.w : raw[i].y;
        const unsigned b0 = odd ? raw[i].z : o.x, b1 = odd ? raw[i].w : o.y;
        const int cp = (8 * i + (rr & ~1)) >> 1;
        const int tb = 8 * ch + (odd ? 4 : 0);
        scr[(tb + 0) * 36 + cp] = (a0 & 0xffffu) | (b0 << 16);
        scr[(tb + 1) * 36 + cp] = (a0 >> 16) | (b0 & 0xffff0000u);
        scr[(tb + 2) * 36 + cp] = (a1 & 0xffffu) | (b1 << 16);
        scr[(tb + 3) * 36 + cp] = (a1 >> 16) | (b1 & 0xffff0000u);
    }
    LDS_WAIT(); asm volatile("" ::: "memory");
#pragma unroll
    for (int i = 0; i < 8; ++i) { const int tk = 8 * i + rr; const v4u w = *(const LAS v4u*)(scr + tk * 36 + 4 * ch);
        *(v4u*)(mix + (size_t)(tok0 + tk) * D + c0 + 8 * ch) = w; }
    LDS_WAIT(); asm volatile("" ::: "memory");
}

constexpr int AT_KSTR = 136;
template <int NT, bool DIL>
__device__ __forceinline__ void attn_wave16(const LAS unsigned char* Ks, const LAS unsigned char* VT, int vstr, int k0, const bf16* qrow, const LAS float* bt, int dil, int relbase, int lbase, int L,
                                            bf16* orow, float* lse_out, int lane) {
    const int r = lane & 15, rq = lane >> 4;
    bf16x8_t Qf[4];
    {
        v4u raw[4]; float ss = 0.f;
#pragma unroll
        for (int st = 0; st < 4; ++st) { raw[st] = *(const v4u*)(qrow + 32 * st + 8 * rq);
            const float a0 = bflo(raw[st].x), a1 = bfhi(raw[st].x), a2 = bflo(raw[st].y), a3 = bfhi(raw[st].y), a4 = bflo(raw[st].z), a5 = bfhi(raw[st].z), a6 = bflo(raw[st].w), a7 = bfhi(raw[st].w);
            ss += (a0 * a0 + a1 * a1) + (a2 * a2 + a3 * a3) + (a4 * a4 + a5 * a5) + (a6 * a6 + a7 * a7); }
        ss += __shfl_xor(ss, 16); ss += __shfl_xor(ss, 32);
        const float sc = 0.08838834764831845f / sqrtf(ss * (1.f / 128.f) + EPS);
#pragma unroll
        for (int st = 0; st < 4; ++st) { v4u w;
            w.x = pk2(bflo(raw[st].x) * sc, bfhi(raw[st].x) * sc); w.y = pk2(bflo(raw[st].y) * sc, bfhi(raw[st].y) * sc);
            w.z = pk2(bflo(raw[st].z) * sc, bfhi(raw[st].z) * sc); w.w = pk2(bflo(raw[st].w) * sc, bfhi(raw[st].w) * sc);
            Qf[st] = __builtin_bit_cast(bf16x8_t, w); }
    }
    f32x4 S[NT];
    const LAS unsigned char* kb = Ks + (size_t)(k0 + r) * (AT_KSTR * 2) + 16 * rq;
#pragma unroll
    for (int kt = 0; kt < NT; ++kt) {
        f32x4 acc = (f32x4){0.f, 0.f, 0.f, 0.f};
#pragma unroll
        for (int st = 0; st < 4; ++st) { const bf16x8_t A = *(const LAS bf16x8_t*)(kb + kt * 16 * (AT_KSTR * 2) + 64 * st); acc = __builtin_amdgcn_mfma_f32_16x16x32_bf16(A, Qf[st], acc, 0, 0, 0); }
        S[kt] = acc;
        asm volatile("" ::: "memory");
    }
    float mx = -3.0e38f;
#pragma unroll
    for (int kt = 0; kt < NT; ++kt)
#pragma unroll
        for (int g = 0; g < 4; ++g) {
            float s = S[kt][g];
            if (DIL) { const int rel = relbase + 16 * kt + g, lk = lbase + 16 * kt + g; const bool ok = (lk >= 0) && (lk < L);
                s = ok ? s + bt[rel + 128] : -3.0e38f; S[kt][g] = s; }
            mx = fmaxf(mx, s);
        }
    mx = fmaxf(mx, __shfl_xor(mx, 16)); mx = fmaxf(mx, __shfl_xor(mx, 32));
    float z = 0.f;
#pragma unroll
    for (int kt = 0; kt < NT; ++kt)
#pragma unroll
        for (int g = 0; g < 4; ++g) { const float p = __expf(S[kt][g] - mx); S[kt][g] = p; z += p; }
    z += __shfl_xor(z, 16); z += __shfl_xor(z, 32);
    const float iz = 1.0f / z;
    bf16x8_t Pf[NT / 2];
#pragma unroll
    for (int ks = 0; ks < NT / 2; ++ks) { v4u w; w.x = pk2(S[2 * ks][0], S[2 * ks][1]); w.y = pk2(S[2 * ks][2], S[2 * ks][3]); w.z = pk2(S[2 * ks + 1][0], S[2 * ks + 1][1]); w.w = pk2(S[2 * ks + 1][2], S[2 * ks + 1][3]);
        Pf[ks] = __builtin_bit_cast(bf16x8_t, w); }
    const LAS unsigned char* vb = VT + ((size_t)r * vstr + k0 + 4 * rq) * 2;
#pragma unroll
    for (int dt = 0; dt < 8; ++dt) {
        f32x4 o = (f32x4){0.f, 0.f, 0.f, 0.f};
#pragma unroll
        for (int ks = 0; ks < NT / 2; ++ks) {
            const LAS unsigned char* p = vb + (size_t)dt * 16 * vstr * 2 + 64 * ks;
            const v2u lo = *(const LAS v2u*)p, hi = *(const LAS v2u*)(p + 32);
            v4u w; w.x = lo.x; w.y = lo.y; w.z = hi.x; w.w = hi.y;
            o = __builtin_amdgcn_mfma_f32_16x16x32_bf16(__builtin_bit_cast(bf16x8_t, w), Pf[ks], o, 0, 0, 0);
        }
        v2u ow; ow.x = pk2(o[0] * iz, o[1] * iz); ow.y = pk2(o[2] * iz, o[3] * iz);
        *(v2u*)(orow + 16 * dt + 4 * rq) = ow;
        asm volatile("" ::: "memory");
    }
    if (DIL) { if (rq == 0) *lse_out = mx + logf(z); }
}
template <int NB, int BS, class RowFn>
__device__ __forceinline__ void attn_stage_k(LAS unsigned char* Ks, int nk, const float* qg, const float* kg, const bf16* kbase, RowFn rowoff, int wave, int lane) {
    const int rr = lane >> 4, cc = lane & 15;
    float gf[8];
    { const f32x4 a0 = *(const f32x4*)(qg + 8 * cc), a1 = *(const f32x4*)(qg + 8 * cc + 4), b0 = *(const f32x4*)(kg + 8 * cc), b1 = *(const f32x4*)(kg + 8 * cc + 4);
      gf[0] = a0.x * b0.x; gf[1] = a0.y * b0.y; gf[2] = a0.z * b0.z; gf[3] = a0.w * b0.w; gf[4] = a1.x * b1.x; gf[5] = a1.y * b1.y; gf[6] = a1.z * b1.z; gf[7] = a1.w * b1.w; }
#pragma unroll 1
    for (int bt = 0; bt < NB; ++bt) {
        v4u raw[BS];
#pragma unroll
        for (int i = 0; i < BS; ++i) { const int j = ((bt * BS + i) * 8 + wave) * 4 + rr; const long off = (j < nk) ? rowoff(j) : -1;
            raw[i] = *(const v4u*)(kbase + (off < 0 ? 0 : off) + 8 * cc); if (off < 0) raw[i] = (v4u){0u, 0u, 0u, 0u}; }
#pragma unroll
        for (int i = 0; i < BS; ++i) { const int j = ((bt * BS + i) * 8 + wave) * 4 + rr;
            const float k0 = bflo(raw[i].x), k1 = bfhi(raw[i].x), k2 = bflo(raw[i].y), k3 = bfhi(raw[i].y), k4 = bflo(raw[i].z), k5 = bfhi(raw[i].z), k6 = bflo(raw[i].w), k7 = bfhi(raw[i].w);
            float ss = (k0 * k0 + k1 * k1) + (k2 * k2 + k3 * k3) + (k4 * k4 + k5 * k5) + (k6 * k6 + k7 * k7);
            ss += __shfl_xor(ss, 1); ss += __shfl_xor(ss, 2); ss += __shfl_xor(ss, 4); ss += __shfl_xor(ss, 8);
            const float sc = 1.0f / sqrtf(ss * (1.f / 128.f) + EPS);
            v4u w; w.x = pk2(k0 * sc * gf[0], k1 * sc * gf[1]); w.y = pk2(k2 * sc * gf[2], k3 * sc * gf[3]); w.z = pk2(k4 * sc * gf[4], k5 * sc * gf[5]); w.w = pk2(k6 * sc * gf[6], k7 * sc * gf[7]);
            if (j < nk) *(LAS v4u*)(Ks + (size_t)j * (AT_KSTR * 2) + 16 * cc) = w; }
    }
}
__device__ __forceinline__ void attn_stage_vpair(LAS unsigned char* VT, int vstr, int j0, int dch, const v4u va, const v4u vb) {
    LAS unsigned char* p = VT + ((size_t)(8 * dch) * vstr + j0) * 2;
    const size_t rs = (size_t)vstr * 2;
    *(LAS unsigned*)(p + 0 * rs) = (va.x & 0xffffu) | (vb.x << 16);         *(LAS unsigned*)(p + 1 * rs) = (va.x >> 16) | (vb.x & 0xffff0000u);
    *(LAS unsigned*)(p + 2 * rs) = (va.y & 0xffffu) | (vb.y << 16);         *(LAS unsigned*)(p + 3 * rs) = (va.y >> 16) | (vb.y & 0xffff0000u);
    *(LAS unsigned*)(p + 4 * rs) = (va.z & 0xffffu) | (vb.z << 16);         *(LAS unsigned*)(p + 5 * rs) = (va.z >> 16) | (vb.z & 0xffff0000u);
    *(LAS unsigned*)(p + 6 * rs) = (va.w & 0xffffu) | (vb.w << 16);         *(LAS unsigned*)(p + 7 * rs) = (va.w >> 16) | (vb.w & 0xffff0000u);
}
template <int NB, int BS, int NPR, class RowFn>
__device__ __forceinline__ void attn_stage_v(LAS unsigned char* VT, int vstr, const bf16* vbase, RowFn rowoff, int tid) {
#pragma unroll 1
    for (int bt = 0; bt < NB; ++bt) {
        v4u va[BS], vb[BS];
#pragma unroll
        for (int k = 0; k < BS; ++k) { const int it = tid + 512 * (bt * BS + k), pr = it % NPR, dch = it / NPR;
            const long oa = (it < NPR * 16) ? rowoff(2 * pr) : -1, ob = (it < NPR * 16) ? rowoff(2 * pr + 1) : -1;
            va[k] = *(const v4u*)(vbase + (oa < 0 ? 0 : oa + 8 * dch)); vb[k] = *(const v4u*)(vbase + (ob < 0 ? 0 : ob + 8 * dch));
            if (oa < 0) va[k] = (v4u){0u, 0u, 0u, 0u}; if (ob < 0) vb[k] = (v4u){0u, 0u, 0u, 0u}; }
#pragma unroll
        for (int k = 0; k < BS; ++k) { const int it = tid + 512 * (bt * BS + k), pr = it % NPR, dch = it / NPR; if (it < NPR * 16) attn_stage_vpair(VT, vstr, 2 * pr, dch, va[k], vb[k]); }
    }
}

constexpr int XA_VSTR = 264, XA_OFF_VT = 256 * AT_KSTR * 2;
static_assert(XA_OFF_VT + 128 * XA_VSTR * 2 <= SCR_BYTES, "cross LDS");
__device__ __forceinline__ void cross_unit(Frame& F, const bf16* xq, const bf16* kv, const float* qg, const float* kg, bf16* mix, int unit) {
    int lane = (int)__builtin_amdgcn_mbcnt_hi(~0u, __builtin_amdgcn_mbcnt_lo(~0u, 0u)); asm volatile("" : "+v"(lane)); const int tid = F.wave * 64 + lane;
    const int b = unit >> 5, h = (unit >> 3) & 3, qc = unit & 7;
    LAS unsigned char* Ks = F.lds; LAS unsigned char* VT = F.lds + XA_OFF_VT;
    const bf16* kbase = kv + (size_t)(b * MEML) * 1024 + h * 128;
    __syncthreads();
    attn_stage_k<2, 4>(Ks, MEML, qg, kg, kbase, [=](int j) { return (long)j * 1024; }, F.wave, lane);
    attn_stage_v<2, 2, 128>(VT, XA_VSTR, kbase + 512, [=](int j) { return (long)j * 1024; }, tid);
    __syncthreads();
#pragma unroll 1
    for (int a = F.wave; a < 16; a += NWAVES) {
        const int token = b * SEQ + qc * 256 + 16 * a + (lane & 15);
        attn_wave16<16, false>(Ks, VT, XA_VSTR, 0, xq + (size_t)token * 512 + h * 128, nullptr, 1, 0, 0, 0, mix + (size_t)token * D + 512 + h * 128, nullptr, lane);
    }
}
constexpr int DA_VSTR = 280, DA_NK = 272, DA_OFF_VT = DA_NK * AT_KSTR * 2, DA_OFF_BT = DA_OFF_VT + 128 * DA_VSTR * 2;
static_assert(DA_OFF_BT + 320 * 4 <= SCR_BYTES, "dilated LDS");
__device__ __forceinline__ void dil_unit(Frame& F, const Args& a, int unit) {
    const int bh = unit / 48, sub = unit % 48, b = bh >> 2, h = bh & 3, g = sub >> 4, w16 = sub & 15;
    const int dil = (g == 0) ? 1 : (g == 1 ? 4 : 16), L = SEQ / dil, nch = L / 128;
    const int r = w16 / nch, n128 = w16 % nch;
    int lane = (int)__builtin_amdgcn_mbcnt_hi(~0u, __builtin_amdgcn_mbcnt_lo(~0u, 0u)); asm volatile("" : "+v"(lane)); const int tid = F.wave * 64 + lane;
    const bf16* qkv = (const bf16*)(F.ws + WS_QKV1);
    float* lse = (float*)(F.ws + WS_LSE);
    LAS unsigned char* Ks = F.lds; LAS unsigned char* VT = F.lds + DA_OFF_VT; LAS float* bt = (LAS float*)(F.lds + DA_OFF_BT);
    const int lk0 = 128 * n128 - 64;
    const bf16* base = qkv + (size_t)(b * SEQ + r) * NQKV + g * 512 + h * 128;
    const size_t lstep = (size_t)dil * NQKV;
    __syncthreads();
    if (tid < 320) { const int rel = tid - 128; bt[tid] = (rel >= -64 && rel <= 64) ? a.in[I_RELB][rel_bucket_dev(rel * dil) * 12 + g * 4 + h] : -3.0e38f; }
    attn_stage_k<3, 3>(Ks, DA_NK, a.in[I_ATQN], a.in[I_ATKN], base + ATW, [=](int j) { const int lk = lk0 + j; return (lk >= 0 && lk < L) ? (long)lk * (long)lstep : -1L; }, F.wave, lane);
    attn_stage_v<3, 2, DA_NK / 2>(VT, DA_VSTR, base + 2 * ATW, [=](int j) { const int lk = lk0 + j; return (lk >= 0 && lk < L) ? (long)lk * (long)lstep : -1L; }, tid);
    __syncthreads();
    {
        const int aq = F.wave, i = 16 * aq + (lane & 15), lq = 128 * n128 + i, token = b * SEQ + lq * dil + r, k0 = 16 * aq, rq = lane >> 4;
        attn_wave16<10, true>(Ks, VT, DA_VSTR, k0, base + (size_t)lq * lstep, bt, dil, k0 + 4 * rq - 64 - i, lk0 + k0 + 4 * rq, L,
                              (g == 0) ? (bf16*)(F.ws + WS_MIX1) + (size_t)token * D + h * 128 : (bf16*)(F.ws + WS_OG12) + ((size_t)(g - 1) * T + token) * 512 + h * 128,
                              lse + ((size_t)g * T + token) * 4 + h, lane);
    }
}
__device__ __forceinline__ void combine_phase(Frame& F, const Args& a) {
    moe_layout(F);
    const int gw = F.bid * NWAVES + F.wave, NGW = F.G * NWAVES, lane = F.lane;
    const int* toke = (const int*)(F.ws + WS_TOKE); const int* tokr = (const int*)(F.ws + WS_TOKR); const float* tokg = (const float*)(F.ws + WS_TOKG);
    const bf16* y = (const bf16*)(F.ws + WS_XS); const bf16* y2 = (const bf16*)(F.ws + WS_Y2);
    for (int token = gw; token < T; token += NGW) {
        const int e0 = toke[token * 2], e1 = toke[token * 2 + 1];
        const int s0 = ml_ps(F, e0) + tokr[token * 2], s1 = ml_ps(F, e1) + tokr[token * 2 + 1];
        const float g0 = tokg[token * 2], g1 = tokg[token * 2 + 1];
        f32x4* xo = (f32x4*)(a.out + (size_t)token * D); const v2u* xi = (const v2u*)((const bf16*)a.out + (size_t)token * 2048 + 1024);
        const v2u* y0 = (const v2u*)(y + (size_t)s0 * D); const v2u* y1 = (const v2u*)(y + (size_t)s1 * D);
        v2u xw[4], p0[4], p1[4];
#pragma unroll
        for (int j = 0; j < 4; ++j) { const int q = lane + 64 * j; xw[j] = xi[q]; p0[j] = y0[q]; p1[j] = y1[q]; }
        f32x4 r[4];
#pragma unroll
        for (int j = 0; j < 4; ++j) {
            const int q = lane + 64 * j;
            f32x4 x = (f32x4){bflo(xw[j].x), bfhi(xw[j].x), bflo(xw[j].y), bfhi(xw[j].y)};
            f32x4 a0 = (f32x4){bflo(p0[j].x), bfhi(p0[j].x), bflo(p0[j].y), bfhi(p0[j].y)}, a1 = (f32x4){bflo(p1[j].x), bfhi(p1[j].x), bflo(p1[j].y), bfhi(p1[j].y)};
            if (s0 >= 2 * T) { const v2u t = ((const v2u*)(y2 + (size_t)(s0 - 2 * T) * D))[q]; a0 = a0 + (f32x4){bflo(t.x), bfhi(t.x), bflo(t.y), bfhi(t.y)}; }
            if (s1 >= 2 * T) { const v2u t = ((const v2u*)(y2 + (size_t)(s1 - 2 * T) * D))[q]; a1 = a1 + (f32x4){bflo(t.x), bfhi(t.x), bflo(t.y), bfhi(t.y)}; }
            r[j] = x + g0 * a0 + g1 * a1;
        }
        asm volatile("s_waitcnt vmcnt(0)" ::: "memory");
#pragma unroll
        for (int j = 0; j < 4; ++j) xo[lane + 64 * j] = r[j];
    }
}

constexpr int NPHASE = 15;
__global__ void __launch_bounds__(NWAVES * 64, 2) mega_fwd(Args args) {
    extern __shared__ __attribute__((aligned(16))) unsigned char lds_raw[];
    Frame F;
    F.lds = (LAS unsigned char*)lds_raw; F.ws = args.ws;
    F.wave = __builtin_amdgcn_readfirstlane((int)threadIdx.x >> 6); F.G = gridDim.x; F.bid = blockIdx.x;
#define PH_BEGIN() do { int l_ = (int)__builtin_amdgcn_mbcnt_hi(~0u, __builtin_amdgcn_mbcnt_lo(~0u, 0u)); asm volatile("" : "+v"(l_)); F.lane = l_; F.tid = F.wave * 64 + l_; } while (0)
    PH_BEGIN();
    unsigned char* ws = args.ws;
    volatile LAS unsigned* MISC = (volatile LAS unsigned*)(F.lds + MISC_OFF);
    for (int u = F.tid; u < (LDS_BYTES - MISC_OFF) / 4; u += NWAVES * 64) MISC[u] = 0u;
    __syncthreads();
    const int lo = args.ph_lo, hi = args.ph_hi;
    const bool use_bar = (hi - lo) > 1;
    XcdBarrier bar; bar.bar = (unsigned*)(ws + WS_CTL) + CW_BAR + args.bslot * XCD_BAR_WORDS; bar.x = 0; bar.st = nullptr;
    if (use_bar) bar = xcd_barrier_post((unsigned*)(ws + WS_CTL) + CW_BAR + args.bslot * XCD_BAR_WORDS, MISC + 8, F.tid);
#define IN(k) (lo <= (k) && (k) < hi)
#define SEAM(k) do { if (IN(k) && IN((k) + 1)) { PH_BEGIN(); xcd_barrier(bar, F.tid); } } while (0)
    const int gw = F.bid * NWAVES + F.wave, NGW = F.G * NWAVES;
    LAS unsigned char* ring = F.lds;

    if (IN(0)) { PH_BEGIN(); p0_prologue(F, args); }
    SEAM(0);
    if (IN(1)) { PH_BEGIN();
        {   pg8::Gemm g{(const bf16*)(ws + WS_WIN0), (const bf16*)(ws + WS_XB), D, D, D, 0};
            pg8::StaticOrder S; S.init(ATW / 256, T / 256, F.G, F.bid);
            EpiB<3> E{(bf16*)(ws + WS_ZT), T, (const float*)(ws + WS_RSTD0), 1 << 30, nullptr, 0, nullptr, 1.0f};
            pg8::gemm_phase<EpiB<3>, pg8::StaticOrder, true>(ring, g, S, E, F.wave); }
        {   pg8::Gemm g{(const bf16*)(ws + WS_XB), (const bf16*)(ws + WS_WIN0) + (size_t)ATW * D, D, D, D, 0};
            pg8::StaticOrder S; S.init(T / 256, 2, F.G, (F.bid + 128) % F.G);
            EpiB<1> E{(bf16*)(ws + WS_XQ0), 512, (const float*)(ws + WS_RSTD0), 1 << 30, nullptr, 0, nullptr, 1.0f};
            pg8::gemm_phase<EpiB<1>, pg8::StaticOrder, true>(ring, g, S, E, F.wave); }
        {   pg8::Gemm g{(const bf16*)(ws + WS_MN), (const bf16*)(ws + WS_WKV), D, D, D, (size_t)D * D * 2};
            pg8::MoeOrder S; S.init(2 * TM / 256, 4, F.G, F.bid); S.t0 = TM / 256; S.t1 = S.t2 = S.t3 = S.t4 = S.t5 = S.t6 = 1 << 30; S.lay = nullptr; S.list = nullptr;
            EpiB<0> E{(bf16*)(ws + WS_KV), D, nullptr, 1 << 30, nullptr, 0, nullptr, 1.0f};
            pg8::gemm_phase<EpiB<0>, pg8::MoeOrder, true>(ring, g, S, E, F.wave); }
        if (F.G == 256 && F.bid >= 64) { PH_BEGIN(); moe_convert(F, args, 0, MOE_P1_HI, (F.bid - 64) * NWAVES + F.wave, 192 * NWAVES); }
    }
    SEAM(1);
    if (IN(2)) { PH_BEGIN();
        hyena_units(F, args);
        for (int u = F.bid; u < 256; u += F.G)
            cross_unit(F, (const bf16*)(ws + WS_XQ0), (const bf16*)(ws + WS_KV), args.in[I_XQN], args.in[I_XKN], (bf16*)(ws + WS_MIX0), u);
    }
    SEAM(2);
    if (IN(3)) { PH_BEGIN(); for (int t = gw; t < 2048; t += NGW) hy_transpose_tile(F, t); }
    SEAM(3);
    if (IN(4)) { PH_BEGIN();
        pg8::Gemm g{(const bf16*)(ws + WS_MIX0), (const bf16*)(ws + WS_WO), D, D, D, 0};
        pg8::StaticOrder S; S.init(T / 256, 4, F.G, F.bid);
        EpiRes<false, true> E{nullptr, (const bf16*)(ws + WS_XB), D, (bf16*)(ws + WS_XB), D, (float*)(ws + WS_SSQ16)};
        pg8::gemm_phase<EpiRes<false, true>, pg8::StaticOrder, true>(ring, g, S, E, F.wave);
    }
    SEAM(4);
    if (IN(5)) { PH_BEGIN();
        pg8::Gemm g{(const bf16*)(ws + WS_XB), (const bf16*)(ws + WS_WGU0), D, D, D, 0};
        pg8::StaticOrder S; S.init(T / 256, NGU / 256, F.G, F.bid);
        fill_rstd_table(F.lds, S, (const float*)(ws + WS_SSQ16), F.tid);
        EpiSwiglu<4> E{(bf16*)(ws + WS_HID0), FF, nullptr, (const LAS float*)(F.lds + RSL_OFF), 1.0f};
        pg8::gemm_phase<EpiSwiglu<4>, pg8::StaticOrder, true>(ring, g, S, E, F.wave);
        if (F.G == 256 && F.bid >= 128) { PH_BEGIN(); moe_convert(F, args, MOE_P1_HI, MOE_P5_HI, (F.bid - 128) * NWAVES + F.wave, 128 * NWAVES); }
    }
    SEAM(5);
    if (IN(6)) { PH_BEGIN();
        pg8::Gemm g{(const bf16*)(ws + WS_HID0), (const bf16*)(ws + WS_WD0), FF, FF, FF, 0};
        pg8::StaticOrder S; S.init(T / 256, 4, F.G, F.bid);
        EpiRes<false, true> E{nullptr, (const bf16*)(ws + WS_XB), D, (bf16*)(ws + WS_XB), D, (float*)(ws + WS_SSQ16)};
        pg8::gemm_phase<EpiRes<false, true>, pg8::StaticOrder, true>(ring, g, S, E, F.wave);
    }
    SEAM(6);
    if (IN(7)) { PH_BEGIN();
        pg8::Gemm g{(const bf16*)(ws + WS_XB), (const bf16*)(ws + WS_WIN1), D, D, D, 0};
        pg8::StaticOrder S; S.init(T / 256, NQ1 / 256, F.G, F.bid);
        fill_rstd_table(F.lds, S, (const float*)(ws + WS_SSQ16), F.tid);
        EpiB<4> E{(bf16*)(ws + WS_QKV1), NQKV, nullptr, NQKV / 256, (bf16*)(ws + WS_XQ1), 512, (const LAS float*)(F.lds + RSL_OFF), 1.0f};
        pg8::gemm_phase<EpiB<4>, pg8::StaticOrder, true>(ring, g, S, E, F.wave);
    }
    SEAM(7);
    if (IN(8)) { PH_BEGIN();
        for (int u = F.bid; u < NB * 4 * 48; u += F.G) dil_unit(F, args, u);
        for (int u = F.bid; u < 256; u += F.G)
            cross_unit(F, (const bf16*)(ws + WS_XQ1), (const bf16*)(ws + WS_KV) + (size_t)TM * D, args.in[I_XQN] + 128, args.in[I_XKN] + 128, (bf16*)(ws + WS_MIX1), u);
    }
    SEAM(8);
    if (IN(9)) { PH_BEGIN(); for (int t = gw; t < T; t += NGW) merge_token(F, t); }
    SEAM(9);
    if (IN(10)) { PH_BEGIN();
        pg8::Gemm g{(const bf16*)(ws + WS_MIX1), (const bf16*)(ws + WS_WO) + (size_t)D * D, D, D, D, 0};
        pg8::StaticOrder S; S.init(T / 256, 4, F.G, F.bid);
        EpiRes<false, false> E{nullptr, (const bf16*)(ws + WS_XB), D, (bf16*)args.out + 1024, 2048, nullptr};
        pg8::gemm_phase<EpiRes<false, false>, pg8::StaticOrder, true>(ring, g, S, E, F.wave);
    }
    SEAM(10);
    if (IN(11)) { PH_BEGIN(); for (int blk = F.bid; blk < T / 64; blk += F.G) route_block(F, args, blk); }
    SEAM(11);
    if (IN(12)) { PH_BEGIN();
        moe_layout(F);
        pg8::Gemm g{(const bf16*)(ws + WS_XB3), (const bf16*)(ws + WS_WGU1), D / 2, D / 2, D / 2, (size_t)NGU * D};
        pg8::MoeOrder S; S.init(ml_total(F) / 256, NGU / 256, F.G, F.bid); S.lay = (const volatile LAS int*)(F.lds + MISC_OFF); S.list = (const int*)(ws + WS_LIST);
        S.t0 = ml_ps(F, 1) / 256; S.t1 = ml_ps(F, 2) / 256; S.t2 = ml_ps(F, 3) / 256; S.t3 = ml_ps(F, 4) / 256; S.t4 = ml_ps(F, 5) / 256; S.t5 = ml_ps(F, 6) / 256; S.t6 = ml_ps(F, 7) / 256;
        EpiSwiglu<5, true> E{(bf16*)(ws + WS_HID1), FF, nullptr, nullptr, 1.0f / MOE_WGU_SCALE};
        if (F.bid & 1) { __builtin_amdgcn_s_sleep(127); __builtin_amdgcn_s_sleep(127); }
        pg8::gemm_phase<EpiSwiglu<5, true>, pg8::MoeOrder, true, true, true>(ring, g, S, E, F.wave);
    }
    SEAM(12);
    if (IN(13)) { PH_BEGIN();
        moe_layout(F);
        const int nMt = ml_total(F) / 256;
        const int q1 = ml_ps(F, 1) / 256, q2 = ml_ps(F, 2) / 256, q3 = ml_ps(F, 3) / 256, q4 = ml_ps(F, 4) / 256, q5 = ml_ps(F, 5) / 256, q6 = ml_ps(F, 6) / 256, q7 = ml_ps(F, 7) / 256;
        {   pg8::Gemm g{(const bf16*)(ws + WS_HID1), (const bf16*)(ws + WS_WD1), FF / 2, FF / 2, FF / 2, (size_t)D * FF};
            pg8::MoeOrder S; S.init(nMt < 128 ? nMt : 128, 4, F.G, F.bid); S.lay = nullptr; S.list = nullptr;
            S.t0 = q1; S.t1 = q2; S.t2 = q3; S.t3 = q4; S.t4 = q5; S.t5 = q6; S.t6 = q7;
            EpiB<5> E{(bf16*)(ws + WS_XS), D, nullptr, 1 << 30, nullptr, 0, nullptr, 1.0f / MOE_WD_SCALE};
            pg8::gemm_phase<EpiB<5>, pg8::MoeOrder, true, false, true>(ring, g, S, E, F.wave); }
        if (nMt > 128) {
            const int half = F.G / 2; const bool second = F.bid >= half;
            pg8::Gemm g{(const bf16*)(ws + WS_HID1), (const bf16*)(ws + WS_WD1), FF / 2, FF / 2, second ? 640 : 768, (size_t)D * FF};
            pg8::MoeTailOrder2 S; S.pm0 = 128; S.ntail = nMt - 128; S.nN = 4; S.G = second ? F.G - half : half; S.c = second ? F.bid - half : F.bid; S.koff = second ? 12 * 128 : 0;
            S.t0 = q1; S.t1 = q2; S.t2 = q3; S.t3 = q4; S.t4 = q5; S.t5 = q6; S.t6 = q7;
            EpiB<5> E{(bf16*)(ws + WS_XS), D, nullptr, 1 << 30, (bf16*)(ws + WS_Y2) - (size_t)2 * T * D, D, nullptr, 1.0f / MOE_WD_SCALE};
            pg8::gemm_phase<EpiB<5>, pg8::MoeTailOrder2, true, false, true>(ring, g, S, E, F.wave); }
    }
    SEAM(13);
    if (IN(14)) { PH_BEGIN(); combine_phase(F, args); }
#undef IN
#undef SEAM
}

#ifndef MK_ONE_LAUNCH
#define MK_ONE_LAUNCH 1
#endif
extern "C" void kernel_launch(void* const* d_in, const int* in_sizes, int n_in, void* d_out, int out_size, void* d_ws, size_t ws_size, hipStream_t stream) {
    static int grid = 0;
    if (grid == 0) {
        if (n_in != 30 || in_sizes[0] != T * D || out_size != T * D || ws_size < WS_END) {
            fprintf(stderr, "kernel_launch: unexpected problem (n_in %d, in0 %d, out %d, ws %zu, need %zu); nothing launched\n", n_in, n_in > 0 ? in_sizes[0] : -1, out_size, ws_size, (size_t)WS_END); grid = -1; return; }
        int dev = 0, cus = 0, per_cu = 0;
        if (hipGetDevice(&dev) != hipSuccess || hipDeviceGetAttribute(&cus, hipDeviceAttributeMultiprocessorCount, dev) != hipSuccess) { grid = -1; return; }
        if (hipFuncSetAttribute((const void*)mega_fwd, hipFuncAttributeMaxDynamicSharedMemorySize, LDS_BYTES) != hipSuccess) { fprintf(stderr, "kernel_launch: hipFuncSetAttribute failed\n"); grid = -1; return; }
        if (hipOccupancyMaxActiveBlocksPerMultiprocessor(&per_cu, (const void*)mega_fwd, NWAVES * 64, LDS_BYTES) != hipSuccess || per_cu < 1)
            fprintf(stderr, "kernel_launch: note: occupancy query reports %d workgroups per CU\n", per_cu);
        (void)hipGetLastError();
        grid = cus;
    }
    if (grid < 0) return;
    if (hipMemsetAsync((char*)d_ws + WS_CTL, 0, CTL_ZERO_BYTES, stream) != hipSuccess) return;
    Args a{};
    for (int i = 0; i < 30; ++i) a.in[i] = (const float*)d_in[i];
    a.out = (float*)d_out; a.ws = (unsigned char*)d_ws;
#if defined(PROBE_PHASE)
    a.ph_lo = 0; a.ph_hi = PROBE_PHASE + 1; a.bslot = 0;
    hipLaunchKernelGGL(mega_fwd, dim3(grid), dim3(NWAVES * 64), LDS_BYTES, stream, a);
    a.ph_lo = PROBE_PHASE; a.ph_hi = NPHASE; a.bslot = 1;
    hipLaunchKernelGGL(mega_fwd, dim3(grid), dim3(NWAVES * 64), LDS_BYTES, stream, a);
#elif MK_ONE_LAUNCH
    a.ph_lo = 0; a.ph_hi = NPHASE; a.bslot = 0;
    hipLaunchKernelGGL(mega_fwd, dim3(grid), dim3(NWAVES * 64), LDS_BYTES, stream, a);
#else
    for (int p = 0; p < NPHASE; ++p) { a.ph_lo = p; a.ph_hi = p + 1; a.bslot = 0; hipLaunchKernelGGL(mega_fwd, dim3(grid), dim3(NWAVES * 64), LDS_BYTES, stream, a); }
#endif
}
```

```cpp
#include <hip/hip_runtime.h>
#include <cstdio>
#include <cstdint>

namespace pg8 {
#define PG8_LAS __attribute__((address_space(3)))
typedef unsigned short bf16_t;
typedef short bf16x8 __attribute__((ext_vector_type(8)));
typedef float f32x4 __attribute__((ext_vector_type(4)));
typedef unsigned u32x4 __attribute__((ext_vector_type(4)));
constexpr int BM = 256, BK = 64, HALF = 128, HTB = HALF * BK * 2  , STAGE_BYTES = 8 * HTB, NXCD = 8, WGM = 8;

__host__ __device__ __forceinline__ int lds_byte(int r, int c) { const int st = (r >> 4) * 2 + (c >> 5), rr = r & 15, cc = c & 31, ob = rr * 64 + cc * 2; return st * 1024 + (ob ^ (((ob >> 9) & 1) << 5)); }
__host__ __device__ __forceinline__ void stage_rc(int b, int& R, int& C) { const int st = b / 1024, sb = b % 1024, swz = sb ^ (((sb >> 9) & 1) << 5); R = (st >> 1) * 16 + swz / 64; C = (st & 1) * 32 + (swz % 64) / 2; }
__host__ __device__ __forceinline__ int perm32(int rho) { const int n = rho >> 4, i = rho & 15; return 8 * (i >> 2) + 4 * n + (i & 3); }

struct Unit { int pm, pn, e, koff, idx; };
struct Gemm { const bf16_t* A; const bf16_t* Bt; int lda, ldb, K; size_t estride; };

struct StaticOrder {
    int nM, nN, nwg, G, c;
    __device__ __forceinline__ int gather_row(const Unit&, int slot) const { return slot; }
    __host__ __device__ void init(int nM_, int nN_, int G_, int c_) { nM = nM_; nN = nN_; nwg = nM * nN; G = G_; c = c_; }
    __host__ __device__ bool next(int i, Unit& u) const {
        const long L = (long)i * G + c; if (L >= nwg) return false;
        int wgid = (int)L; { const int q = nwg / NXCD, r = nwg % NXCD, xcd = wgid % NXCD, off = wgid / NXCD; wgid = (xcd < r ? xcd * (q + 1) : r * (q + 1) + (xcd - r) * q) + off; }
        const int nig = WGM * nN, gid = wgid / nig, fm = gid * WGM, gsz = (nM - fm) < WGM ? (nM - fm) : WGM;
        u.pm = fm + ((wgid % nig) % gsz); u.pn = (wgid % nig) / gsz; u.e = 0; u.koff = 0; return true;
    }
};
struct MoeOrder : StaticOrder {
    int t0, t1, t2, t3, t4, t5, t6;
    const volatile PG8_LAS int* lay;
    const int* list;
    __device__ __forceinline__ int gather_row(const Unit& u, int slot) const { const int rank = slot - lay[40 + u.e]; return rank < lay[32 + u.e] ? list[(size_t)u.e * 16384 + rank] : 0; }
    __host__ __device__ bool next(int i, Unit& u) const {
        if (!StaticOrder::next(i, u)) return false;
        const int p = u.pm; u.e = (p >= t0) + (p >= t1) + (p >= t2) + (p >= t3) + (p >= t4) + (p >= t5) + (p >= t6); return true;
    }
};

struct MoeTailOrder {
    int pm0, ntail, nN, G, c, khalf; int t0, t1, t2, t3, t4, t5, t6;
    __device__ __forceinline__ int gather_row(const Unit&, int slot) const { return slot; }
    __device__ __forceinline__ bool next(int i, Unit& u) const {
        const int L = i * G + c; if (L >= ntail * nN * 2) return false;
        const int kh = L & 1, q = L >> 1; u.pn = q % nN; u.pm = pm0 + q / nN; u.koff = kh * khalf;
        const int p = u.pm; u.e = (p >= t0) + (p >= t1) + (p >= t2) + (p >= t3) + (p >= t4) + (p >= t5) + (p >= t6); return true;
    }
};
struct MoeTailOrder2 {
    int pm0, ntail, nN, G, c, koff; int t0, t1, t2, t3, t4, t5, t6;
    __device__ __forceinline__ int gather_row(const Unit&, int slot) const { return slot; }
    __device__ __forceinline__ bool next(int i, Unit& u) const {
        const int L = i * G + c; if (L >= ntail * nN) return false;
        u.pn = L % nN; u.pm = pm0 + L / nN; u.koff = koff;
        const int p = u.pm; u.e = (p >= t0) + (p >= t1) + (p >= t2) + (p >= t3) + (p >= t4) + (p >= t5) + (p >= t6); return true;
    }
};
__device__ __forceinline__ unsigned cvt_pk_bf16(float lo, float hi) { unsigned r; asm volatile("v_cvt_pk_bf16_f32 %0, %1, %2" : "=v"(r) : "v"(lo), "v"(hi)); return r; }

typedef int v8i __attribute__((ext_vector_type(8)));
typedef int v4i __attribute__((ext_vector_type(4)));
template <class Epi, class Sched, bool ALIGN_EPI, bool GATHER = false, bool FP8 = false>
__device__ __forceinline__ void gemm_phase(PG8_LAS unsigned char* lds, const Gemm g, const Sched& S, const Epi& E, const int wid) {
    int lane = (int)__builtin_amdgcn_mbcnt_hi(~0u, __builtin_amdgcn_mbcnt_lo(~0u, 0u)); asm volatile("" : "+v"(lane));
    const int tid = wid * 64 + lane, wr = wid >> 2, wc = wid & 3, fr = lane & 15, fq = lane >> 4;
    const int K = g.K, nt = K / BK;
    unsigned cvo[4], nvo[4], voffB[2]; int rowA[2], colA[2];
#pragma unroll
    for (int i = 0; i < 2; ++i) { int R, C; stage_rc(tid * 16 + i * 8192, R, C); const int Rb = (R & ~31) + perm32(R & 31); rowA[i] = R; colA[i] = C;
        voffB[i] = (unsigned)(Rb * g.ldb + C) * 2u; }
    const size_t kstep = (size_t)(BK * 2);
    const size_t hstepB = (size_t)HALF * g.ldb * 2;
    const size_t tstepA = GATHER ? (size_t)0 : (size_t)2 * HALF * g.lda * 2, tstepB = 2 * hstepB;
#define PG8_ROWOFFS(vo, u) do { _Pragma("unroll") for (int _h = 0; _h < 2; ++_h) _Pragma("unroll") for (int _i = 0; _i < 2; ++_i) { \
        const int _r = _h * HALF + rowA[_i]; const unsigned _row = GATHER ? (unsigned)S.gather_row(u, (u).pm * BM + _r) : (unsigned)_r; \
        (vo)[2 * _h + _i] = (_row * (unsigned)g.lda + (unsigned)colA[_i]) * 2u; } } while (0)
    const unsigned ldsw = (unsigned)wid * 1024u;
    const int aoff = lds_byte(wr * 64 + fr, fq * 8), boff = lds_byte(wc * 32 + fr, fq * 8);
#define PG8_SA(b, h) (((b) * 2 + (h)) * HTB)
#define PG8_SB(b, h) ((4 + (b) * 2 + (h)) * HTB)
#define PG8_STAGE(bufoff, gbase, voff) do { _Pragma("unroll") for (int _i = 0; _i < 2; ++_i) \
        __builtin_amdgcn_global_load_lds((const unsigned*)((const char*)(gbase) + (voff)[_i]), (PG8_LAS unsigned*)(lds + (bufoff) + ldsw + _i * 8192), 16, 0, 0); } while (0)
#define PG8_STAGEA(bufoff, gbase, vo, h) do { _Pragma("unroll") for (int _i = 0; _i < 2; ++_i) \
        __builtin_amdgcn_global_load_lds((const unsigned*)((const char*)(gbase) + (vo)[2 * (h) + _i]), (PG8_LAS unsigned*)(lds + (bufoff) + ldsw + _i * 8192), 16, 0, 0); } while (0)
#define PG8_LDA(dst, b, h) do { _Pragma("unroll") for (int m = 0; m < 4; ++m) dst[m] = __builtin_shufflevector(*(const PG8_LAS v4i*)(lds + PG8_SA(b, h) + aoff + m * 2048), *(const PG8_LAS v4i*)(lds + PG8_SA(b, h) + aoff + m * 2048 + 1024), 0, 1, 2, 3, 4, 5, 6, 7); } while (0)
#define PG8_LDB(dst, b, h) do { _Pragma("unroll") for (int n = 0; n < 2; ++n) dst[n] = __builtin_shufflevector(*(const PG8_LAS v4i*)(lds + PG8_SB(b, h) + boff + n * 2048), *(const PG8_LAS v4i*)(lds + PG8_SB(b, h) + boff + n * 2048 + 1024), 0, 1, 2, 3, 4, 5, 6, 7); } while (0)
#define PG8_HALF(x, k) __builtin_bit_cast(bf16x8, __builtin_shufflevector(x, x, 4 * (k), 4 * (k) + 1, 4 * (k) + 2, 4 * (k) + 3))
#define PG8_MMA(ai, bj, At, Bt) do { if constexpr (FP8) __builtin_amdgcn_sched_barrier(0); __builtin_amdgcn_s_setprio(1); _Pragma("unroll") for (int m = 0; m < 4; ++m) _Pragma("unroll") for (int n = 0; n < 2; ++n) { \
        if constexpr (FP8) acc[ai][bj][m][n] = __builtin_amdgcn_mfma_scale_f32_16x16x128_f8f6f4(Bt[n], At[m], acc[ai][bj][m][n], 0, 0, 0, 0x7f7f7f7f, 0, 0x7f7f7f7f); \
        else { acc[ai][bj][m][n] = __builtin_amdgcn_mfma_f32_16x16x32_bf16(PG8_HALF(Bt[n], 0), PG8_HALF(At[m], 0), acc[ai][bj][m][n], 0, 0, 0); \
               acc[ai][bj][m][n] = __builtin_amdgcn_mfma_f32_16x16x32_bf16(PG8_HALF(Bt[n], 1), PG8_HALF(At[m], 1), acc[ai][bj][m][n], 0, 0, 0); } } \
        if constexpr (FP8) { _Pragma("unroll") for (int m = 0; m < 4; ++m) _Pragma("unroll") for (int n = 0; n < 2; ++n) asm volatile("" : "+v"(acc[ai][bj][m][n])); }   \
        __builtin_amdgcn_s_setprio(0); if constexpr (FP8) __builtin_amdgcn_sched_barrier(0); } while (0)
#define PG8_WAIT_V(n) asm volatile("s_waitcnt vmcnt(" #n ")" ::: "memory")
#define PG8_WAIT_L(n) asm volatile("s_waitcnt lgkmcnt(" #n ")" ::: "memory")
#define PG8_BAR __builtin_amdgcn_s_barrier()
#define PG8_SCHED __builtin_amdgcn_sched_barrier(0)
    Unit cur, nxt; int ui = 0;
    if (!S.next(0, cur)) return;
    cur.idx = 0;
    f32x4 acc[2][2][4][2];
#pragma unroll
    for (int a = 0; a < 2; ++a)
#pragma unroll
        for (int b = 0; b < 2; ++b)
#pragma unroll
            for (int m = 0; m < 4; ++m)
#pragma unroll
                for (int n = 0; n < 2; ++n) acc[a][b][m][n] = (f32x4){0.f, 0.f, 0.f, 0.f};
    v8i At[4], B0[2], B1[2];
    const char* cA = (const char*)g.A + (size_t)cur.pm * tstepA + cur.koff; const char* cB = (const char*)g.Bt + (size_t)cur.e * g.estride + (size_t)cur.pn * tstepB + cur.koff;
    PG8_ROWOFFS(cvo, cur);
#pragma unroll
    for (int i = 0; i < 4; ++i) nvo[i] = cvo[i];
    PG8_STAGE(PG8_SB(0, 0), cB, voffB); PG8_STAGE(PG8_SB(0, 1), cB + hstepB, voffB); PG8_STAGEA(PG8_SA(0, 0), cA, cvo, 0); PG8_STAGEA(PG8_SA(0, 1), cA, cvo, 1);
    if (wr == 1) PG8_BAR;
    PG8_WAIT_V(2); PG8_BAR;
    PG8_STAGE(PG8_SB(1, 0), cB + kstep, voffB); PG8_STAGEA(PG8_SA(1, 0), cA + kstep, cvo, 0); PG8_STAGE(PG8_SB(1, 1), cB + hstepB + kstep, voffB);
    PG8_WAIT_V(6); PG8_BAR;
    for (;;) {
        const bool has_next = S.next(ui + 1, nxt); nxt.idx = ui + 1;
        const char* nA = has_next ? (const char*)g.A + (size_t)nxt.pm * tstepA + nxt.koff : cA;
        const char* nB = has_next ? (const char*)g.Bt + (size_t)nxt.e * g.estride + (size_t)nxt.pn * tstepB + nxt.koff : cB;
        if constexpr (GATHER) { if (has_next) PG8_ROWOFFS(nvo, nxt); }
        for (int t = 0; t < nt; t += 2) {
            const bool last = (t == nt - 2);
            const char* a1 = cA + (size_t)(t + 1) * kstep;
            const char* a2 = last ? nA : cA + (size_t)(t + 2) * kstep; const char* b2 = last ? nB : cB + (size_t)(t + 2) * kstep;
            const char* a3 = a2 + kstep; const char* b3 = b2 + kstep;
            unsigned vo2[4];
#pragma unroll
            for (int i = 0; i < 4; ++i) vo2[i] = (GATHER && last) ? nvo[i] : cvo[i];
            PG8_LDB(B0, 0, 0); PG8_LDB(B1, 0, 1); PG8_SCHED; PG8_LDA(At, 0, 0); PG8_STAGEA(PG8_SA(1, 1), a1, cvo, 1);
            PG8_WAIT_V(8); PG8_WAIT_L(0); PG8_BAR; PG8_MMA(0, 0, At, B0); PG8_MMA(0, 1, At, B1); PG8_BAR; PG8_SCHED;
            PG8_LDA(At, 0, 1); PG8_STAGE(PG8_SB(0, 0), b2, voffB); PG8_STAGE(PG8_SB(0, 1), b2 + hstepB, voffB); PG8_STAGEA(PG8_SA(0, 0), a2, vo2, 0);
            PG8_WAIT_V(8); PG8_WAIT_L(0); PG8_BAR; PG8_MMA(1, 0, At, B0); PG8_MMA(1, 1, At, B1); PG8_BAR; PG8_SCHED;
            PG8_LDB(B0, 1, 0); PG8_LDB(B1, 1, 1); PG8_SCHED; PG8_LDA(At, 1, 0); PG8_STAGEA(PG8_SA(0, 1), a2, vo2, 1);
            PG8_WAIT_V(8); PG8_WAIT_L(0); PG8_BAR; PG8_MMA(0, 0, At, B0); PG8_MMA(0, 1, At, B1); PG8_BAR; PG8_SCHED;
            PG8_LDA(At, 1, 1); PG8_STAGE(PG8_SB(1, 0), b3, voffB); PG8_STAGE(PG8_SB(1, 1), b3 + hstepB, voffB); PG8_STAGEA(PG8_SA(1, 0), a3, vo2, 0);
            PG8_WAIT_V(8); PG8_WAIT_L(0); PG8_BAR; PG8_MMA(1, 0, At, B0); PG8_MMA(1, 1, At, B1); PG8_BAR; PG8_SCHED;
        }
        if constexpr (ALIGN_EPI) { if (wr == 0) PG8_BAR; }
        E(acc, cur, wr, wc, fr, fq);
        if (!has_next) break;
#pragma unroll
        for (int a = 0; a < 2; ++a)
#pragma unroll
            for (int b = 0; b < 2; ++b)
#pragma unroll
                for (int m = 0; m < 4; ++m)
#pragma unroll
                    for (int n = 0; n < 2; ++n) acc[a][b][m][n] = (f32x4){0.f, 0.f, 0.f, 0.f};
        cur = nxt; cA = nA; cB = nB; ++ui;
        if constexpr (GATHER) {
#pragma unroll
            for (int i = 0; i < 4; ++i) cvo[i] = nvo[i]; }
        if constexpr (ALIGN_EPI) { if (wr == 1) PG8_BAR; }
    }
    PG8_WAIT_V(0);
    if constexpr (!ALIGN_EPI) { if (wr == 0) PG8_BAR; }
    PG8_BAR;
#undef PG8_SA
#undef PG8_SB
#undef PG8_STAGE
#undef PG8_STAGEA
#undef PG8_ROWOFFS
#undef PG8_LDA
#undef PG8_LDB
#undef PG8_MMA
#undef PG8_HALF
#undef PG8_WAIT_V
#undef PG8_WAIT_L
#undef PG8_BAR
#undef PG8_SCHED
}
}

constexpr int NB = 8, SEQ = 2048, D = 1024, T = NB * SEQ;
constexpr int MEML = 256, TM = NB * MEML;
constexpr int HYC = 512, NZ0 = 2048;
constexpr int FF = 2816, NGU = 2 * FF;
constexpr int ATW = 1536, NQKV = 3 * ATW, NQ1 = NQKV + 512;
constexpr int NE = 8, PMAX = 2 * T + NE * 256;
constexpr float EPS = 1e-6f;
constexpr float MOE_WGU_SCALE = 32.0f, MOE_WD_SCALE = 64.0f;
constexpr int NWAVES = 8;

constexpr size_t MiB = 1u << 20;
constexpr size_t WS_CTL = 0, CTL_ZERO_BYTES = 1 * MiB;
constexpr size_t WS_WGU1 = 1 * MiB;
constexpr size_t WS_WD1 = 89 * MiB;
constexpr size_t WS_SMALL = 133 * MiB;
constexpr size_t WS_RSTD0 = WS_SMALL;
constexpr size_t WS_SSQ16 = WS_SMALL + 64 * 1024;
constexpr size_t WS_LSE = WS_SSQ16 + 1 * MiB;
constexpr size_t WS_TOKE = WS_LSE + 768 * 1024;
constexpr size_t WS_TOKR = WS_TOKE + 128 * 1024;
constexpr size_t WS_TOKG = WS_TOKR + 128 * 1024;
constexpr size_t WS_RSTD3 = WS_TOKG + 128 * 1024;
constexpr size_t WS_LIST = WS_RSTD3 + 64 * 1024;
constexpr size_t WS_RSTDS = WS_LIST + 512 * 1024;
static_assert(WS_RSTDS + PMAX * 4 <= WS_SMALL + 4 * MiB, "small region");
constexpr size_t WS_WO = 137 * MiB;
constexpr size_t WS_WIN1 = 141 * MiB;
constexpr size_t WS_WKV = 151 * MiB;
constexpr size_t WS_WIN0 = 155 * MiB;
constexpr size_t WS_WGU0 = 159 * MiB;
constexpr size_t WS_WD0 = 170 * MiB;
constexpr size_t WS_KV = 176 * MiB;
constexpr size_t WS_XB = 184 * MiB;
constexpr size_t WS_YT = 336 * MiB;
constexpr size_t WS_MIX0 = 216 * MiB;
constexpr size_t WS_MN = 248 * MiB;
constexpr size_t WS_ZT = 256 * MiB;
constexpr size_t WS_XQ0 = 304 * MiB;
constexpr size_t WS_HF = 320 * MiB;
constexpr size_t WS_HID0 = 248 * MiB;
constexpr size_t WS_QKV1 = 248 * MiB;
constexpr size_t WS_XQ1 = 392 * MiB;
constexpr size_t WS_OG12 = 216 * MiB;
constexpr size_t WS_MIX1 = 141 * MiB;
constexpr size_t WS_XB3 = 137 * MiB;
constexpr size_t WS_XS = 137 * MiB;
constexpr size_t WS_HID1 = 205 * MiB;
constexpr size_t WS_Y2 = 392 * MiB;
constexpr size_t WS_END = 408 * MiB;
static_assert(WS_HID1 + (size_t)PMAX * FF * 2 <= WS_END && WS_XQ1 + (size_t)T * 512 * 2 <= WS_END && WS_XS + (size_t)PMAX * 2048 <= WS_HID1, "ws map");

constexpr int CW_CNT = 64;
constexpr int CW_BAR = 4096;

constexpr int SCR_BYTES = 147456;
constexpr int MISC_OFF = SCR_BYTES;
constexpr int LDS_BYTES = SCR_BYTES + 4096;

#define LAS __attribute__((address_space(3)))
typedef unsigned short bf16;
typedef unsigned v4u __attribute__((ext_vector_type(4)));
typedef unsigned v2u __attribute__((ext_vector_type(2)));
typedef float f32x4 __attribute__((ext_vector_type(4)));
typedef float f32x2 __attribute__((ext_vector_type(2)));
#define LDS_WAIT() asm volatile("s_waitcnt lgkmcnt(0)" ::: "memory")
__device__ __forceinline__ unsigned f2bf(float f) { unsigned u = __builtin_bit_cast(unsigned, f); return (u + 0x7fffu + ((u >> 16) & 1u)) >> 16; }
__device__ __forceinline__ unsigned pk2(float lo, float hi) { unsigned r; asm("v_cvt_pk_bf16_f32 %0, %1, %2" : "=v"(r) : "v"(lo), "v"(hi)); return r; }
__device__ __forceinline__ unsigned pk4_fp8(float a, float b, float c, float d) { unsigned w = 0u; w = __builtin_amdgcn_cvt_pk_fp8_f32(a, b, w, false); w = __builtin_amdgcn_cvt_pk_fp8_f32(c, d, w, true); return w; }
__device__ __forceinline__ float bflo(unsigned w) { return __builtin_bit_cast(float, w << 16); }
__device__ __forceinline__ float bfhi(unsigned w) { return __builtin_bit_cast(float, w & 0xffff0000u); }
__device__ __forceinline__ float bf1(bf16 b) { return __builtin_bit_cast(float, ((unsigned)b) << 16); }
__device__ __forceinline__ float wave_sum(float v) {
#pragma unroll
    for (int o = 1; o < 64; o <<= 1) v += __shfl_xor(v, o);
    return v;
}
__device__ __forceinline__ float wave_max(float v) {
#pragma unroll
    for (int o = 1; o < 64; o <<= 1) v = fmaxf(v, __shfl_xor(v, o));
    return v;
}

#define XB_TMO      128
#define XB_XCNT(j)  (256  + 64 * (j))
#define XB_XSUB(j)  (1280 + 64 * (j))
#define XB_XGEN(j)  (2304 + 64 * (j))
#define XB_TOP      3328
#define XB_TOPGEN   3392
#define XCD_BAR_WORDS 3456
#define XB_SPIN_CAP (1u << 18)

__device__ __forceinline__ unsigned xb_ld(unsigned* p)              { return __hip_atomic_load(p, __ATOMIC_RELAXED, __HIP_MEMORY_SCOPE_AGENT); }
__device__ __forceinline__ unsigned xb_add(unsigned* p, unsigned v) { return __hip_atomic_fetch_add(p, v, __ATOMIC_RELAXED, __HIP_MEMORY_SCOPE_AGENT); }
__device__ __forceinline__ unsigned xb_xcc_id() { return (unsigned)__builtin_amdgcn_s_getreg((3 << 11) | 20) & 0xFu; }
#define XB_SPIN(cond, bar) do { unsigned _sp = 0; while (cond) { __builtin_amdgcn_s_sleep(1); \
    if ((++_sp & 255u) == 0u) { if (xb_ld(&(bar)[XB_TMO])) break; if (_sp > XB_SPIN_CAP) { atomicAdd(&(bar)[XB_TMO], 1u); break; } } } } while (0)

struct XcdBarrier {
    unsigned* bar; unsigned x;
    volatile LAS unsigned* st;
};
__device__ __forceinline__ XcdBarrier xcd_barrier_post(unsigned* bar, volatile LAS unsigned* st, int tid) {
    XcdBarrier b; b.bar = bar; b.x = xb_xcc_id(); b.st = st;
    if (tid == 0) (void)xb_add(&bar[XB_XCNT(b.x)], 1u);
    return b;
}
__device__ __forceinline__ void xcd_barrier_complete(unsigned* bar, unsigned x, unsigned& nloc, unsigned& nx) {
    const unsigned G = gridDim.x * gridDim.y * gridDim.z;
    unsigned sum, cnt, mine, sp = 0u;
    for (;;) {
        sum = 0u; cnt = 0u; mine = 0u;
#pragma unroll
        for (unsigned j = 0; j < 16; ++j) { const unsigned c = xb_ld(&bar[XB_XCNT(j)]); sum += c; cnt += (c > 0u) ? 1u : 0u; mine = (j == x) ? c : mine; }
        if (sum == G) break;
        __builtin_amdgcn_s_sleep(1);
        if ((++sp & 255u) == 0u) { if (xb_ld(&bar[XB_TMO])) break; if (sp > XB_SPIN_CAP) { atomicAdd(&bar[XB_TMO], 1u); break; } }
    }
    nloc = mine > 0u ? mine : 1u; nx = cnt > 0u ? cnt : 1u;
}
__device__ __forceinline__ void xcd_barrier(const XcdBarrier& b, int tid) {
    asm volatile("s_waitcnt vmcnt(0)" ::: "memory");
    __syncthreads();
    if (tid == 0) {
        unsigned* bar = b.bar;
        __builtin_amdgcn_s_waitcnt(0);
        unsigned nloc = b.st[0], nx = b.st[1];
        if (nloc == 0u) { xcd_barrier_complete(bar, b.x, nloc, nx); b.st[0] = nloc; b.st[1] = nx; }
        const unsigned old = xb_add(&bar[XB_XSUB(b.x)], 1u);
        const unsigned gen = old / nloc;
        if (old + 1u == (gen + 1u) * nloc) {
            __builtin_amdgcn_fence(__ATOMIC_RELEASE, "agent");
            asm volatile("s_waitcnt vmcnt(0)" ::: "memory");
            const unsigned og = xb_add(&bar[XB_TOP], 1u);
            const unsigned tg = og / nx;
            if (og + 1u == (tg + 1u) * nx) xb_add(&bar[XB_TOPGEN], 1u);
            else XB_SPIN(xb_ld(&bar[XB_TOPGEN]) == tg, bar);
            __builtin_amdgcn_fence(__ATOMIC_ACQUIRE, "agent");
            xb_add(&bar[XB_XGEN(b.x)], 1u);
            asm volatile("s_waitcnt vmcnt(0)" ::: "memory");
        } else {
            XB_SPIN(xb_ld(&bar[XB_XGEN(b.x)]) == gen, bar);
            __builtin_amdgcn_fence(__ATOMIC_ACQUIRE, "agent");
            asm volatile("s_waitcnt vmcnt(0)" ::: "memory");
        }
    }
    __syncthreads();
}

struct Args { const float* in[30]; float* out; unsigned char* ws; int ph_lo, ph_hi, bslot, pad; };
enum { I_X = 0, I_MEM, I_RELB, I_NMIX, I_NMEM, I_NFFN, I_WKV, I_XQN, I_XKN, I_WOUT, I_HYWIN, I_HYCW, I_HYCB, I_FW1, I_FB1, I_FW2, I_FB2, I_FW3, I_FREQ, I_SKIP,
       I_ATWIN, I_ATQN, I_ATKN, I_FFG, I_FFU, I_FFD, I_ROUTER, I_MOEG, I_MOEU, I_MOED };

struct Frame {
    LAS unsigned char* lds;
    unsigned char* ws;
    int tid, lane, wave, G, bid;
};

constexpr int RSL_OFF = 131072;
template <int SCALE> struct EpiB {
    bf16* O; int ldc; const float* sc; int split_tile; bf16* O2; int ldc2; const LAS float* rsl; float kc;
    __device__ __forceinline__ void operator()(const f32x4 (&acc)[2][2][4][2], const pg8::Unit& u, int wr, int wc, int fr, int fq) const {
        const int row0 = u.pm * 256 + wr * 64 + fr;
        bf16* base = O; int ld = ldc; int colt = u.pn * 256;
        if (u.pn >= split_tile) { base = O2; ld = ldc2; colt -= split_tile * 256; }
        if (u.koff != 0) base = O2;
        const int col0 = colt + wc * 32 + 8 * fq;
        float rsv[2][4];
        if (SCALE == 1) {
#pragma unroll
            for (int ai = 0; ai < 2; ++ai)
#pragma unroll
                for (int m = 0; m < 4; ++m) rsv[ai][m] = sc[row0 + ai * 128 + m * 16];
            asm volatile("s_waitcnt vmcnt(0)" ::: "memory");
        }
        f32x4 cs[2][2];
        if (SCALE == 3) {
#pragma unroll
            for (int bj = 0; bj < 2; ++bj)
#pragma unroll
                for (int n = 0; n < 2; ++n) cs[bj][n] = *(const f32x4*)(sc + u.pn * 256 + bj * 128 + wc * 32 + 8 * fq + 4 * n);
            asm volatile("s_waitcnt vmcnt(0)" ::: "memory");
        }
#pragma unroll
        for (int ai = 0; ai < 2; ++ai)
#pragma unroll
            for (int m = 0; m < 4; ++m) {
                const int row = row0 + ai * 128 + m * 16;
                float rs = 1.f;
                if (SCALE == 1) rs = rsv[ai][m];
                if (SCALE == 2) { const f32x4* p = (const f32x4*)(sc + (size_t)row * 16); const f32x4 a = p[0], b = p[1], c = p[2], d = p[3];
                    const float s = ((a.x + a.y) + (a.z + a.w)) + ((b.x + b.y) + (b.z + b.w)) + ((c.x + c.y) + (c.z + c.w)) + ((d.x + d.y) + (d.z + d.w));
                    rs = 1.0f / sqrtf(s * (1.0f / D) + EPS); }
                if (SCALE == 4) rs = rsl[u.idx * 256 + (row - u.pm * 256)];
                if (SCALE == 5) rs = kc;
                bf16* rowp = base + (size_t)row * ld + col0;
#pragma unroll
                for (int bj = 0; bj < 2; ++bj) {
                    f32x4 v0 = acc[ai][bj][m][0], v1 = acc[ai][bj][m][1];
                    if (SCALE == 1 || SCALE == 2 || SCALE == 4 || SCALE == 5) { v0 = v0 * rs; v1 = v1 * rs; }
                    if (SCALE == 3) { v0 = v0 * cs[bj][0]; v1 = v1 * cs[bj][1]; }
                    v4u w; w.x = pk2(v0[0], v0[1]); w.y = pk2(v0[2], v0[3]); w.z = pk2(v1[0], v1[1]); w.w = pk2(v1[2], v1[3]);
                    *(v4u*)(rowp + bj * 128) = w;
                }
            }
    }
};
template <bool XF32, bool SSQ> struct EpiRes {
    const float* xf; const bf16* xi; int ldi; bf16* xo; int ldo; float* ssq16;
    __device__ __forceinline__ void operator()(const f32x4 (&acc)[2][2][4][2], const pg8::Unit& u, int wr, int wc, int fr, int fq) const {
        const int row0 = u.pm * 256 + wr * 64 + fr, col0 = u.pn * 256 + wc * 32 + 8 * fq;
        if constexpr (!XF32) {
            v4u res[2][4][2];
#pragma unroll
            for (int ai = 0; ai < 2; ++ai)
#pragma unroll
                for (int m = 0; m < 4; ++m)
#pragma unroll
                    for (int bj = 0; bj < 2; ++bj) res[ai][m][bj] = *(const v4u*)(xi + (size_t)(row0 + ai * 128 + m * 16) * ldi + col0 + bj * 128);
            asm volatile("s_waitcnt vmcnt(0)" ::: "memory");
#pragma unroll
            for (int ai = 0; ai < 2; ++ai)
#pragma unroll
                for (int m = 0; m < 4; ++m) {
                    const int row = row0 + ai * 128 + m * 16;
                    float ss = 0.f;
#pragma unroll
                    for (int bj = 0; bj < 2; ++bj) {
                        const v4u w0 = res[ai][m][bj];
                        const f32x4 r0 = (f32x4){bflo(w0.x), bfhi(w0.x), bflo(w0.y), bfhi(w0.y)}, r1 = (f32x4){bflo(w0.z), bfhi(w0.z), bflo(w0.w), bfhi(w0.w)};
                        const f32x4 v0 = acc[ai][bj][m][0] + r0, v1 = acc[ai][bj][m][1] + r1;
                        v4u w; w.x = pk2(v0[0], v0[1]); w.y = pk2(v0[2], v0[3]); w.z = pk2(v1[0], v1[1]); w.w = pk2(v1[2], v1[3]);
                        *(v4u*)(xo + (size_t)row * ldo + col0 + bj * 128) = w;
                        if (SSQ) ss += ((v0[0] * v0[0] + v0[1] * v0[1]) + (v0[2] * v0[2] + v0[3] * v0[3])) + ((v1[0] * v1[0] + v1[1] * v1[1]) + (v1[2] * v1[2] + v1[3] * v1[3]));
                    }
                    if (SSQ) { ss += __shfl_xor(ss, 16); ss += __shfl_xor(ss, 32);
                        if (fq == 0) ssq16[(size_t)row * 16 + u.pn * 4 + wc] = ss; }
                }
        } else {
#pragma unroll
            for (int ai = 0; ai < 2; ++ai)
#pragma unroll
                for (int m = 0; m < 4; ++m) {
                    const int row = row0 + ai * 128 + m * 16;
                    float ss = 0.f;
#pragma unroll
                    for (int bj = 0; bj < 2; ++bj) {
                        const size_t off = (size_t)row * D + col0 + bj * 128; const f32x4 r0 = *(const f32x4*)(xf + off), r1 = *(const f32x4*)(xf + off + 4);
                        const f32x4 v0 = acc[ai][bj][m][0] + r0, v1 = acc[ai][bj][m][1] + r1;
                        v4u w; w.x = pk2(v0[0], v0[1]); w.y = pk2(v0[2], v0[3]); w.z = pk2(v1[0], v1[1]); w.w = pk2(v1[2], v1[3]);
                        *(v4u*)(xo + (size_t)row * ldo + col0 + bj * 128) = w;
                        if (SSQ) ss += ((v0[0] * v0[0] + v0[1] * v0[1]) + (v0[2] * v0[2] + v0[3] * v0[3])) + ((v1[0] * v1[0] + v1[1] * v1[1]) + (v1[2] * v1[2] + v1[3] * v1[3]));
                    }
                    if (SSQ) { ss += __shfl_xor(ss, 16); ss += __shfl_xor(ss, 32);
                        if (fq == 0) ssq16[(size_t)row * 16 + u.pn * 4 + wc] = ss; }
                }
        }
    }
};
template <int SCALE, bool OUT8 = false> struct EpiSwiglu {
    bf16* H; int ldh; const float* sc; const LAS float* rsl; float kc;
    __device__ __forceinline__ void operator()(const f32x4 (&acc)[2][2][4][2], const pg8::Unit& u, int wr, int wc, int fr, int fq) const {
        const int row0 = u.pm * 256 + wr * 64 + fr, col0 = u.pn * 128 + wc * 32 + 8 * fq;
#pragma unroll
        for (int ai = 0; ai < 2; ++ai)
#pragma unroll
            for (int m = 0; m < 4; ++m) {
                const int row = row0 + ai * 128 + m * 16;
                float rs = 1.f;
                if (SCALE == 1) rs = sc[row];
                if (SCALE == 2) { const f32x4* p = (const f32x4*)(sc + (size_t)row * 16); const f32x4 a = p[0], b = p[1], c = p[2], d = p[3];
                    const float s = ((a.x + a.y) + (a.z + a.w)) + ((b.x + b.y) + (b.z + b.w)) + ((c.x + c.y) + (c.z + c.w)) + ((d.x + d.y) + (d.z + d.w));
                    rs = 1.0f / sqrtf(s * (1.0f / D) + EPS); }
                if (SCALE == 4) rs = rsl[u.idx * 256 + (row - u.pm * 256)];
                if (SCALE == 5) rs = kc;
                float h[8];
#pragma unroll
                for (int n = 0; n < 2; ++n)
#pragma unroll
                    for (int j = 0; j < 4; ++j) { const float gv = acc[ai][0][m][n][j] * rs, uv = acc[ai][1][m][n][j] * rs;
                        h[n * 4 + j] = gv * uv * __builtin_amdgcn_rcpf(1.0f + __expf(-gv)); }
                if (OUT8) { v2u w; w.x = pk4_fp8(h[0], h[1], h[2], h[3]); w.y = pk4_fp8(h[4], h[5], h[6], h[7]); *(v2u*)((unsigned char*)H + (size_t)row * ldh + col0) = w; }
                else { v4u w; w.x = pk2(h[0], h[1]); w.y = pk2(h[2], h[3]); w.z = pk2(h[4], h[5]); w.w = pk2(h[6], h[7]);
                    *(v4u*)(H + (size_t)row * ldh + col0) = w; }
            }
    }
};

template <class Sched>
__device__ __forceinline__ void fill_rstd_table(LAS unsigned char* lds, const Sched& S, const float* ssq16, int tid) {
    LAS float* rsl = (LAS float*)(lds + RSL_OFF);
    pg8::Unit u;
    for (int ui = 0; ui < 16 && S.next(ui, u); ++ui) {
        if (tid < 256) { const f32x4* p = (const f32x4*)(ssq16 + (size_t)(u.pm * 256 + tid) * 16); const f32x4 a = p[0], b = p[1], c = p[2], d = p[3];
            const float s = ((a.x + a.y) + (a.z + a.w)) + ((b.x + b.y) + (b.z + b.w)) + ((c.x + c.y) + (c.z + c.w)) + ((d.x + d.y) + (d.z + d.w));
            rsl[ui * 256 + tid] = 1.0f / sqrtf(s * (1.0f / D) + EPS); }
    }
    __syncthreads();
}

__device__ __forceinline__ void p0_transpose_item(const float* W, int K, int N, bf16* WT, const float* gain, int mode, LAS float* scr, int item, int lane) {
    const int nblk = N / 64, kb = item / nblk, nb = item % nblk, k0 = 64 * kb, n0 = 64 * nb;
    const int lr = lane >> 4, lc = lane & 15;
    f32x4 v[16];
#pragma unroll
    for (int i = 0; i < 16; ++i) v[i] = *(const f32x4*)(W + (size_t)(k0 + 4 * i + lr) * N + n0 + 4 * lc);
    if (gain) {
#pragma unroll
        for (int i = 0; i < 16; ++i) v[i] = v[i] * gain[k0 + 4 * i + lr];
    }
#pragma unroll
    for (int i = 0; i < 16; ++i) { LAS float* s = scr + (4 * i + lr) * 65 + 4 * lc; s[0] = v[i].x; s[1] = v[i].y; s[2] = v[i].z; s[3] = v[i].w; }
    LDS_WAIT(); asm volatile("" ::: "memory");
    const int c = lane & 7;
    const int d0 = (mode == 0) ? n0 : (256 * (n0 / 128) + (n0 % 128) + (mode == 2 ? 128 : 0));
#pragma unroll
    for (int j = 0; j < 8; ++j) { const int n = (lane >> 3) + 8 * j; const LAS float* s = scr + (8 * c) * 65 + n;
        v4u o; o.x = pk2(s[0 * 65], s[1 * 65]); o.y = pk2(s[2 * 65], s[3 * 65]); o.z = pk2(s[4 * 65], s[5 * 65]); o.w = pk2(s[6 * 65], s[7 * 65]);
        *(v4u*)(WT + (size_t)(d0 + n) * K + k0 + 8 * c) = o; }
    LDS_WAIT(); asm volatile("" ::: "memory");
}
__device__ __forceinline__ void p0_transpose_item8(const float* W, int K, int N, unsigned char* WT8, const float* gain, float s8, int mode, LAS float* scr, int item, int lane) {
    const int nblk = N / 64, kb = item / nblk, nb = item % nblk, k0 = 64 * kb, n0 = 64 * nb;
    const int lr = lane >> 4, lc = lane & 15;
    f32x4 v[16];
#pragma unroll
    for (int i = 0; i < 16; ++i) v[i] = *(const f32x4*)(W + (size_t)(k0 + 4 * i + lr) * N + n0 + 4 * lc);
#pragma unroll
    for (int i = 0; i < 16; ++i) { const float g = gain ? gain[k0 + 4 * i + lr] * s8 : s8; v[i] = v[i] * g; }
#pragma unroll
    for (int i = 0; i < 16; ++i) { LAS float* s = scr + (4 * i + lr) * 65 + 4 * lc; s[0] = v[i].x; s[1] = v[i].y; s[2] = v[i].z; s[3] = v[i].w; }
    LDS_WAIT(); asm volatile("" ::: "memory");
    const int c = lane & 3;
    const int d0 = (mode == 0) ? n0 : (256 * (n0 / 128) + (n0 % 128) + (mode == 2 ? 128 : 0));
#pragma unroll
    for (int j = 0; j < 4; ++j) { const int n = (lane >> 2) + 16 * j; const LAS float* s = scr + (16 * c) * 65 + n;
        v4u o; o.x = pk4_fp8(s[0 * 65], s[1 * 65], s[2 * 65], s[3 * 65]); o.y = pk4_fp8(s[4 * 65], s[5 * 65], s[6 * 65], s[7 * 65]);
        o.z = pk4_fp8(s[8 * 65], s[9 * 65], s[10 * 65], s[11 * 65]); o.w = pk4_fp8(s[12 * 65], s[13 * 65], s[14 * 65], s[15 * 65]);
        *(v4u*)(WT8 + (size_t)(d0 + n) * K + k0 + 16 * c) = o; }
    LDS_WAIT(); asm volatile("" ::: "memory");
}
__device__ __forceinline__ float row_to_bf16(const float* xrow, bf16* orow, const float* gain, bool normalize, int lane) {
    const f32x4* xr = (const f32x4*)xrow + lane;
    f32x4 v[4]; float s = 0.f;
#pragma unroll
    for (int j = 0; j < 4; ++j) { v[j] = xr[64 * j]; s += (v[j].x * v[j].x + v[j].y * v[j].y) + (v[j].z * v[j].z + v[j].w * v[j].w); }
    const float rstd = 1.0f / sqrtf(wave_sum(s) * (1.f / D) + EPS);
    unsigned long long* o8 = (unsigned long long*)orow + lane;
#pragma unroll
    for (int j = 0; j < 4; ++j) {
        f32x4 w = v[j];
        if (normalize) { const f32x4 g = ((const f32x4*)gain)[lane + 64 * j]; w = w * rstd * g; }
        o8[64 * j] = (unsigned long long)pk2(w.x, w.y) | ((unsigned long long)pk2(w.z, w.w) << 32);
    }
    return rstd;
}
__device__ __forceinline__ void p0_filter_block(Frame& F, const Args& a, float* Hf, int jb) {
    const float* w1 = a.in[I_FW1]; const float* b1 = a.in[I_FB1]; const float* w2 = a.in[I_FW2]; const float* b2 = a.in[I_FB2]; const float* w3 = a.in[I_FW3]; const float* fr = a.in[I_FREQ];
    LAS float* h2s = (LAS float*)(F.lds + MISC_OFF + 256);
    const int lane = F.lane, j0 = jb * 8;
    LAS float* W1s = (LAS float*)F.lds; LAS float* W2s = W1s + 33 * 64;
    for (int i = F.tid; i < 33 * 64; i += 512) W1s[i] = w1[i];
    for (int i = F.tid; i < 64 * 64; i += 512) W2s[i] = w2[i];
    __syncthreads();
    {
        const int j = j0 + F.wave;
        const float freq = fr[lane], bb1 = b1[lane], bb2 = b2[lane];
        float feat = 0.f;
        {
            const int fi = (lane >= 17) ? lane - 17 : lane - 1;
            const float f = 1e-4f + (float)fi * ((15.0f - 1e-4f) / 15.0f);
            const float ang = (6.283185307179586f / 2048.0f) * (float)j * f;
            if (lane == 0) feat = (float)j * (1.0f / 2047.0f);
            else if (lane <= 16) feat = cosf(ang);
            else if (lane <= 32) feat = -sinf(ang);
        }
        float s1 = bb1;
#pragma unroll
        for (int i = 0; i < 33; ++i) s1 += __shfl(feat, i) * W1s[i * 64 + lane];
        const float h1 = sinf(freq * s1);
        float s2 = bb2;
#pragma unroll 16
        for (int i = 0; i < 64; ++i) s2 += __shfl(h1, i) * W2s[i * 64 + lane];
        h2s[lane * 8 + F.wave] = sinf(freq * s2);
    }
    __syncthreads();
    const int n0 = F.wave * 256;
    float acc[4][8];
#pragma unroll
    for (int q = 0; q < 4; ++q)
#pragma unroll
        for (int jj = 0; jj < 8; ++jj) acc[q][jj] = 0.f;
#pragma unroll 1
    for (int i0 = 0; i0 < 64; i0 += 8) {
        float w[8][4];
#pragma unroll
        for (int ii = 0; ii < 8; ++ii)
#pragma unroll
            for (int q = 0; q < 4; ++q) w[ii][q] = w3[(size_t)(i0 + ii) * 2048 + n0 + q * 64 + lane];
#pragma unroll
        for (int ii = 0; ii < 8; ++ii) {
            const f32x4 ha = *(const LAS f32x4*)(h2s + (i0 + ii) * 8), hb = *(const LAS f32x4*)(h2s + (i0 + ii) * 8 + 4);
#pragma unroll
            for (int q = 0; q < 4; ++q) {
                acc[q][0] += ha.x * w[ii][q]; acc[q][1] += ha.y * w[ii][q]; acc[q][2] += ha.z * w[ii][q]; acc[q][3] += ha.w * w[ii][q];
                acc[q][4] += hb.x * w[ii][q]; acc[q][5] += hb.y * w[ii][q]; acc[q][6] += hb.z * w[ii][q]; acc[q][7] += hb.w * w[ii][q]; }
        }
    }
    const float da = -3.0701134573253945f, db = -15.350567286626973f;
#pragma unroll
    for (int q = 0; q < 4; ++q) {
        const int n = n0 + q * 64 + lane, c = n & 511;
        const float delta = fabsf(da + (db - da) * ((float)c * (1.0f / 511.0f)));
        float o[8];
#pragma unroll
        for (int jj = 0; jj < 8; ++jj) { const float t = (float)(j0 + jj) * (1.0f / 2047.0f); o[jj] = acc[q][jj] * (expf(-t * delta) + 0.05f); }
        f32x4* dst = (f32x4*)(Hf + (size_t)n * 2048 + j0);
        dst[0] = (f32x4){o[0], o[1], o[2], o[3]}; dst[1] = (f32x4){o[4], o[5], o[6], o[7]};
    }
    __syncthreads();
}
constexpr int IT_MOE = 16 * 44, N_MOE_ITEMS = 24 * IT_MOE;
constexpr int MOE_P1_HI = 5376, MOE_P5_HI = 14336, MOE_P0_LO = MOE_P5_HI;
__device__ __forceinline__ void moe_convert(Frame& F, const Args& a, int lo, int hi, int gwl, int ngw) {
    LAS float* scr = (LAS float*)(F.lds + F.wave * 16640);
    unsigned char* ws = F.ws;
    for (int r = lo + gwl; r < hi; r += ngw) {
        const int mid = r / IT_MOE, li = r % IT_MOE, kind = mid >> 3, e = mid & 7;
        if (kind == 0) p0_transpose_item8(a.in[I_MOEG] + (size_t)e * D * FF, D, FF, ws + WS_WGU1 + (size_t)e * NGU * D, a.in[I_NFFN] + D, MOE_WGU_SCALE, 1, scr, li, F.lane);
        else if (kind == 1) p0_transpose_item8(a.in[I_MOEU] + (size_t)e * D * FF, D, FF, ws + WS_WGU1 + (size_t)e * NGU * D, a.in[I_NFFN] + D, MOE_WGU_SCALE, 2, scr, li, F.lane);
        else p0_transpose_item8(a.in[I_MOED] + (size_t)e * FF * D, FF, D, ws + WS_WD1 + (size_t)e * D * FF, nullptr, MOE_WD_SCALE, 0, scr, li, F.lane);
    }
}
__device__ __forceinline__ void p0_prologue(Frame& F, const Args& a) {
    LAS float* scr = (LAS float*)(F.lds + F.wave * 16640);
    const int gw = F.bid * NWAVES + F.wave, NGW = F.G * NWAVES;
    unsigned char* ws = F.ws;
    if (!(F.bid & 1)) { for (int jb = F.bid; jb < 256; jb += F.G) p0_filter_block(F, a, (float*)(ws + WS_HF), jb); }
    for (int m = gw; m < T; m += NGW) { const float r = row_to_bf16(a.in[I_X] + (size_t)m * D, (bf16*)(ws + WS_XB) + (size_t)m * D, nullptr, false, F.lane); if (F.lane == 0) ((float*)(ws + WS_RSTD0))[m] = r; }
    for (int m = gw; m < 2 * TM; m += NGW) { const int l = m / TM, r = m % TM;
        (void)row_to_bf16(a.in[I_MEM] + (size_t)r * D, (bf16*)(ws + WS_MN) + (size_t)m * D, a.in[I_NMEM] + l * D, true, F.lane); }
    constexpr int IT_A = 16 * 32, IT_SQ = 16 * 16, IT_G = 16 * 44, IT_D = 44 * 16, IT_W1 = 16 * 80;
    constexpr int NSMALL = IT_A + 4 * IT_SQ + 2 * IT_G + IT_D + IT_W1;
    for (int it = gw; it < NSMALL; it += NGW) {
        int r = it;
        if (r < IT_A) { p0_transpose_item(a.in[I_HYWIN], D, NZ0, (bf16*)(ws + WS_WIN0), a.in[I_NMIX], 0, scr, r, F.lane); continue; } r -= IT_A;
        if (r < IT_SQ) { p0_transpose_item(a.in[I_WKV], D, D, (bf16*)(ws + WS_WKV), nullptr, 0, scr, r, F.lane); continue; } r -= IT_SQ;
        if (r < IT_SQ) { p0_transpose_item(a.in[I_WKV] + (size_t)D * D, D, D, (bf16*)(ws + WS_WKV) + (size_t)D * D, nullptr, 0, scr, r, F.lane); continue; } r -= IT_SQ;
        if (r < IT_SQ) { p0_transpose_item(a.in[I_WOUT], D, D, (bf16*)(ws + WS_WO), nullptr, 0, scr, r, F.lane); continue; } r -= IT_SQ;
        if (r < IT_SQ) { p0_transpose_item(a.in[I_WOUT] + (size_t)D * D, D, D, (bf16*)(ws + WS_WO) + (size_t)D * D, nullptr, 0, scr, r, F.lane); continue; } r -= IT_SQ;
        if (r < IT_G) { p0_transpose_item(a.in[I_FFG], D, FF, (bf16*)(ws + WS_WGU0), a.in[I_NFFN], 1, scr, r, F.lane); continue; } r -= IT_G;
        if (r < IT_G) { p0_transpose_item(a.in[I_FFU], D, FF, (bf16*)(ws + WS_WGU0), a.in[I_NFFN], 2, scr, r, F.lane); continue; } r -= IT_G;
        if (r < IT_D) { p0_transpose_item(a.in[I_FFD], FF, D, (bf16*)(ws + WS_WD0), nullptr, 0, scr, r, F.lane); continue; } r -= IT_D;
        p0_transpose_item(a.in[I_ATWIN], D, NQ1, (bf16*)(ws + WS_WIN1), a.in[I_NMIX] + D, 0, scr, r, F.lane);
    }
    moe_convert(F, a, (F.G == 256) ? MOE_P0_LO : 0, N_MOE_ITEMS, gw, NGW);
    if (F.bid & 1) { __syncthreads(); for (int jb = F.bid; jb < 256; jb += F.G) p0_filter_block(F, a, (float*)(ws + WS_HF), jb); }
}
__device__ __forceinline__ float block_sum(Frame& F, float v) {
    LAS float* red = (LAS float*)(F.lds + MISC_OFF + 64);
    v = wave_sum(v);
    __syncthreads();
    if (F.lane == 0) red[F.wave] = v;
    __syncthreads();
    float s = 0.f;
#pragma unroll
    for (int w = 0; w < NWAVES; ++w) s += red[w];
    return s;
}
__device__ __forceinline__ int rel_bucket_dev(int rel) {
    const int n = rel < 0 ? -rel : rel;
    const int large = 8 + (n >= 15) + (n >= 27) + (n >= 50) + (n >= 91) + (n >= 166) + (n >= 305) + (n >= 559);
    return (rel > 0 ? 16 : 0) + (n < 8 ? n : large);
}
__device__ __forceinline__ void merge_token(Frame& F, int token) {
    const bf16* og = (const bf16*)(F.ws + WS_OG12); const float* lse = (const float*)(F.ws + WS_LSE);
    bf16* mix = (bf16*)(F.ws + WS_MIX1);
    const int lane = F.lane, h = lane >> 4;
    const float l0 = lse[(size_t)token * 4 + h], l1 = lse[((size_t)T + token) * 4 + h], l2 = lse[((size_t)2 * T + token) * 4 + h];
    const float mx = fmaxf(l0, fmaxf(l1, l2));
    float w0 = __expf(l0 - mx), w1 = __expf(l1 - mx), w2 = __expf(l2 - mx);
    const float iz = 1.0f / (w0 + w1 + w2); w0 *= iz; w1 *= iz; w2 *= iz;
    const v4u a0 = *(const v4u*)(mix + (size_t)token * D + 8 * lane);
    const v4u a1 = *(const v4u*)(og + (size_t)token * 512 + 8 * lane);
    const v4u a2 = *(const v4u*)(og + ((size_t)T + token) * 512 + 8 * lane);
    v4u o;
    o.x = pk2(w0 * bflo(a0.x) + w1 * bflo(a1.x) + w2 * bflo(a2.x), w0 * bfhi(a0.x) + w1 * bfhi(a1.x) + w2 * bfhi(a2.x));
    o.y = pk2(w0 * bflo(a0.y) + w1 * bflo(a1.y) + w2 * bflo(a2.y), w0 * bfhi(a0.y) + w1 * bfhi(a1.y) + w2 * bfhi(a2.y));
    o.z = pk2(w0 * bflo(a0.z) + w1 * bflo(a1.z) + w2 * bflo(a2.z), w0 * bfhi(a0.z) + w1 * bfhi(a1.z) + w2 * bfhi(a2.z));
    o.w = pk2(w0 * bflo(a0.w) + w1 * bflo(a1.w) + w2 * bflo(a2.w), w0 * bfhi(a0.w) + w1 * bfhi(a1.w) + w2 * bfhi(a2.w));
    *(v4u*)(mix + (size_t)token * D + 8 * lane) = o;
}

constexpr int RT_OFF_R = 0, RT_OFF_REC = 32768, RT_OFF_CNT = 32768 + 64 * 32;
__device__ __forceinline__ void route_block(Frame& F, const Args& a, int blk) {
    LAS float* RL = (LAS float*)(F.lds + RT_OFF_R); volatile LAS int* REC = (volatile LAS int*)(F.lds + RT_OFF_REC); LAS int* CNT = (LAS int*)(F.lds + RT_OFF_CNT);
    const int lane = F.lane;
    const float* g = a.in[I_NFFN] + D; const float* rt = a.in[I_ROUTER];
    __syncthreads();
    for (int i = F.tid; i < 2048; i += 512) { const f32x4 r = ((const f32x4*)rt)[i]; const float gg = g[i >> 1]; ((LAS f32x4*)RL)[i] = r * gg; }
    if (F.tid < 16) CNT[F.tid] = 0;
    __syncthreads();
    for (int q = 0; q < 8; ++q) {
        const int tl = F.wave * 8 + q, token = blk * 64 + tl;
        const bf16* xr = (const bf16*)a.out + (size_t)token * 2048 + 1024;
        f32x4 v[4]; float s = 0.f;
#pragma unroll
        for (int j = 0; j < 4; ++j) { const v2u w = ((const v2u*)xr)[lane + 64 * j]; v[j] = (f32x4){bflo(w.x), bfhi(w.x), bflo(w.y), bfhi(w.y)}; s += (v[j].x * v[j].x + v[j].y * v[j].y) + (v[j].z * v[j].z + v[j].w * v[j].w); }
        const float rstd = 1.0f / sqrtf(wave_sum(s) * (1.f / D) + EPS);
        { unsigned* o4 = (unsigned*)(F.ws + WS_XB3 + (size_t)token * D) + lane;
#pragma unroll
          for (int j = 0; j < 4; ++j) o4[64 * j] = pk4_fp8(v[j].x * rstd, v[j].y * rstd, v[j].z * rstd, v[j].w * rstd); }
        float lg[8];
#pragma unroll
        for (int e = 0; e < 8; ++e) lg[e] = 0.f;
#pragma unroll
        for (int j = 0; j < 4; ++j) {
            const int k0 = 4 * (lane + 64 * j);
#pragma unroll
            for (int qq = 0; qq < 4; ++qq) {
                const float hn = v[j][qq] * rstd;
                const f32x4 r0 = *(const LAS f32x4*)(RL + (k0 + qq) * 8), r1 = *(const LAS f32x4*)(RL + (k0 + qq) * 8 + 4);
                lg[0] += hn * r0.x; lg[1] += hn * r0.y; lg[2] += hn * r0.z; lg[3] += hn * r0.w;
                lg[4] += hn * r1.x; lg[5] += hn * r1.y; lg[6] += hn * r1.z; lg[7] += hn * r1.w;
            }
        }
#pragma unroll
        for (int e = 0; e < 8; ++e) lg[e] = wave_sum(lg[e]);
        int i1 = 0; float v1 = lg[0];
#pragma unroll
        for (int e = 1; e < 8; ++e) if (lg[e] > v1) { v1 = lg[e]; i1 = e; }
        int i2 = -1; float v2 = -3.0e38f;
#pragma unroll
        for (int e = 0; e < 8; ++e) if (e != i1 && lg[e] > v2) { v2 = lg[e]; i2 = e; }
        const float e2 = __expf(v2 - v1), g1 = 1.0f / (1.0f + e2), g2 = e2 * g1;
        if (lane == 0) {
            const int r1 = __hip_atomic_fetch_add(CNT + i1, 1, __ATOMIC_RELAXED, __HIP_MEMORY_SCOPE_WORKGROUP);
            const int r2 = __hip_atomic_fetch_add(CNT + i2, 1, __ATOMIC_RELAXED, __HIP_MEMORY_SCOPE_WORKGROUP);
            REC[tl * 8 + 0] = i1; REC[tl * 8 + 1] = i2; REC[tl * 8 + 2] = r1; REC[tl * 8 + 3] = r2;
            REC[tl * 8 + 4] = __builtin_bit_cast(int, g1); REC[tl * 8 + 5] = __builtin_bit_cast(int, g2); REC[tl * 8 + 6] = __builtin_bit_cast(int, rstd);
        }
    }
    __syncthreads();
    if (F.tid < 8) { unsigned* cnt = (unsigned*)(F.ws + WS_CTL) + CW_CNT; CNT[8 + F.tid] = (int)__hip_atomic_fetch_add(cnt + F.tid, (unsigned)CNT[F.tid], __ATOMIC_RELAXED, __HIP_MEMORY_SCOPE_AGENT); }
    __syncthreads();
    if (F.tid < 64) {
        const int tl = F.tid, token = blk * 64 + tl;
        const int i1 = REC[tl * 8 + 0], i2 = REC[tl * 8 + 1], r1 = CNT[8 + i1] + REC[tl * 8 + 2], r2 = CNT[8 + i2] + REC[tl * 8 + 3];
        int* toke = (int*)(F.ws + WS_TOKE); int* tokr = (int*)(F.ws + WS_TOKR); int* tokg = (int*)(F.ws + WS_TOKG); int* list = (int*)(F.ws + WS_LIST);
        list[(size_t)i1 * T + r1] = token; list[(size_t)i2 * T + r2] = token;
        toke[token * 2] = i1; toke[token * 2 + 1] = i2; tokr[token * 2] = r1; tokr[token * 2 + 1] = r2;
        tokg[token * 2] = REC[tl * 8 + 4]; tokg[token * 2 + 1] = REC[tl * 8 + 5];
        ((int*)(F.ws + WS_RSTD3))[token] = REC[tl * 8 + 6];
    }
}
__device__ __forceinline__ void moe_layout(Frame& F) {
    volatile LAS int* M = (volatile LAS int*)(F.lds + MISC_OFF);
    __syncthreads();
    if (F.tid == 0) {
        const unsigned* cnt = (const unsigned*)(F.ws + WS_CTL) + CW_CNT;
        int acc = 0;
        for (int e = 0; e < 8; ++e) { const int c = (int)__hip_atomic_load(cnt + e, __ATOMIC_RELAXED, __HIP_MEMORY_SCOPE_AGENT); M[32 + e] = c; M[40 + e] = acc; acc += (c + 255) & ~255; }
        M[48] = acc;
    }
    __syncthreads();
}
__device__ __forceinline__ int ml_ps(Frame& F, int e) { return ((volatile LAS int*)(F.lds + MISC_OFF))[40 + e]; }
__device__ __forceinline__ int ml_cnt(Frame& F, int e) { return ((volatile LAS int*)(F.lds + MISC_OFF))[32 + e]; }
__device__ __forceinline__ int ml_total(Frame& F) { return ((volatile LAS int*)(F.lds + MISC_OFF))[48]; }
__device__ __forceinline__ int ml_expert(Frame& F, int slot) { int e = 0;
#pragma unroll
    for (int i = 1; i < 8; ++i) e += (slot >= ml_ps(F, i)) ? 1 : 0;
    return e; }

constexpr int HY_CS = 4168, HY_M0 = 2080, HY_UR = 2592, HY_UP = 256;
constexpr int HY_OFF_CP = 64, HY_OFF_UB = HY_OFF_CP + 8 * HY_CS * 2, HY_OFF_X = HY_OFF_UB + 8 * HY_UR * 2;
static_assert(HY_OFF_X + 8 * 2048 * 2 <= SCR_BYTES, "hyena LDS");
typedef short bf16x8_t __attribute__((ext_vector_type(8)));

struct HyStage { v4u raw[4]; float zm[4], zp[4]; };
struct HyFilt { float f[4], b[4]; };
__device__ __forceinline__ void hy_short_load(HyStage& s, const bf16* zr, int tid) {
#pragma unroll
    for (int k = 0; k < 4; ++k) {
        const int item = tid + 512 * k, b = item >> 8, t8 = (item & 255) * 8;
        const bf16* p = zr + b * SEQ + t8;
        s.raw[k] = *(const v4u*)p;
        s.zm[k] = (t8 > 0) ? bf1(p[-1]) : 0.f; s.zp[k] = (t8 + 8 < SEQ) ? bf1(p[8]) : 0.f;
    }
}
__device__ __forceinline__ void hy_short_store(LAS unsigned char* dst, int stride_el, int pad_el, const HyStage& s, float w0, float w1, float w2, float cb, int tid) {
#pragma unroll
    for (int k = 0; k < 4; ++k) {
        const int item = tid + 512 * k, b = item >> 8, t8 = (item & 255) * 8;
        float z[10];
        z[0] = s.zm[k]; z[1] = bflo(s.raw[k].x); z[2] = bfhi(s.raw[k].x); z[3] = bflo(s.raw[k].y); z[4] = bfhi(s.raw[k].y); z[5] = bflo(s.raw[k].z); z[6] = bfhi(s.raw[k].z); z[7] = bflo(s.raw[k].w); z[8] = bfhi(s.raw[k].w); z[9] = s.zp[k];
        float o[8];
#pragma unroll
        for (int i = 0; i < 8; ++i) o[i] = cb + z[i] * w0 + z[i + 1] * w1 + z[i + 2] * w2;
        v4u w; w.x = pk2(o[0], o[1]); w.y = pk2(o[2], o[3]); w.z = pk2(o[4], o[5]); w.w = pk2(o[6], o[7]);
        *(LAS v4u*)(dst + (size_t)(b * stride_el + pad_el + t8) * 2) = w;
    }
}
__device__ __forceinline__ void hy_filt_load(HyFilt& q, const float* Hf, int o, int c, int tid) {
    const float* fw = Hf + ((size_t)(o * 2 + 0) * 512 + c) * 2048;
    const float* bw = Hf + ((size_t)(o * 2 + 1) * 512 + c) * 2048;
#pragma unroll
    for (int i = 0; i < 4; ++i) { const int j = tid + 512 * i; q.f[i] = fw[j]; q.b[i] = (j >= 1) ? bw[j] : 0.f; }
}
__device__ __forceinline__ void hy_filt_build(Frame& F, const HyFilt& q) {
    LAS float* Kf = (LAS float*)(F.lds + HY_OFF_X);
    float s = 0.f;
#pragma unroll
    for (int i = 0; i < 4; ++i) s += fabsf(q.f[i]) + fabsf(q.b[i]);
    const float tot = block_sum(F, s);
    const float inv = 1.0f / (tot + 1e-6f);
#pragma unroll
    for (int i = 0; i < 4; ++i) { const int j = F.tid + 512 * i; Kf[HY_M0 - j] = q.f[i] * inv; if (j >= 1) Kf[HY_M0 + j] = q.b[i] * inv; }
    if (F.tid < 33) Kf[F.tid] = 0.f;
    if (F.tid < 48) Kf[4128 + F.tid] = 0.f;
    __syncthreads();
    LAS unsigned* cp = (LAS unsigned*)(F.lds + HY_OFF_CP);
    for (int p = F.tid; p < 8 * (HY_CS / 2); p += 512) { const int j = p / (HY_CS / 2), xp = p - j * (HY_CS / 2), x = 2 * xp + j; cp[p] = pk2(Kf[x], Kf[x + 1]); }
    __syncthreads();
}
__device__ __forceinline__ void hy_conv_mfma(Frame& F, f32x4 (&C)[8]) {
    const int lane = F.lane, w = F.wave, r = lane & 15, kq = lane >> 4;
    const int jc = (-r) & 7, cr = (r + 7) >> 3;
    const LAS unsigned char* abase = F.lds + HY_OFF_CP + (size_t)(jc * HY_CS + HY_M0 - 32 * (8 * w - 63) + 8 * kq - 8 * cr) * 2;
    const LAS unsigned char* bbase = F.lds + HY_OFF_UB + (size_t)((r & 7) * HY_UR + HY_UP + 16 * (r >> 3) + 8 * kq) * 2;
#pragma unroll
    for (int i = 0; i < 8; ++i) C[i] = (f32x4){0.f, 0.f, 0.f, 0.f};
    bf16x8_t Bw[9];
#pragma unroll
    for (int i = 0; i < 8; ++i) Bw[i] = *(const LAS bf16x8_t*)(bbase + 64 * (63 + i));
    bf16x8_t An = *(const LAS bf16x8_t*)(abase);
#pragma unroll 1
    for (int Q = 0; Q < 8; ++Q) {
        const LAS unsigned char* ab = abase - 64 * (9 * Q);
        const LAS unsigned char* bb = bbase + 64 * (63 - 9 * Q);
#pragma unroll
        for (int qq = 0; qq < 9; ++qq) {
            const bf16x8_t A = An;
            An = *(const LAS bf16x8_t*)(ab - 64 * (qq + 1));
            Bw[(8 - qq + 9) % 9] = *(const LAS bf16x8_t*)(bb + 64 * (-1 - qq));
#pragma unroll
            for (int i = 7; i >= 0; --i) C[i] = __builtin_amdgcn_mfma_f32_16x16x32_bf16(A, Bw[(i - qq + 9) % 9], C[i], 0, 0, 0);
        }
    }
}
__device__ __forceinline__ void hyena_units(Frame& F, const Args& a) {
    const bf16* zT = (const bf16*)(F.ws + WS_ZT);
    const float* Hf = (const float*)(F.ws + WS_HF);
    const float* cw = a.in[I_HYCW]; const float* cbp = a.in[I_HYCB]; const float* skip = a.in[I_SKIP];
    bf16* yT = (bf16*)(F.ws + WS_YT);
    LAS unsigned char* UB = F.lds + HY_OFF_UB; LAS unsigned char* XB = F.lds + HY_OFF_X;
    int c = F.bid; if (c >= HYC) return;
    HyStage sA, sC, sG; HyFilt fB, fF;
    hy_short_load(sA, zT + (size_t)c * T, F.tid); hy_filt_load(fB, Hf, 0, c, F.tid); hy_short_load(sC, zT + (size_t)(HYC + c) * T, F.tid);
#pragma unroll 1
    for (;;) {
        const int lane = F.lane, w = F.wave, n = lane & 15, bb = n & 7, hh = n >> 3, rq = lane >> 4;
        __syncthreads();
        for (int p = F.tid; p < 8 * 272; p += 512) { const int b = p / 272, q = p - b * 272; const int el = (q < 128) ? 2 * q : (HY_UP + SEQ + 2 * (q - 128)); *(LAS unsigned*)(UB + (size_t)(b * HY_UR + el) * 2) = 0u; }
        { const int ch = c; hy_short_store(UB, HY_UR, HY_UP, sA, cw[ch], cw[1536 + ch], cw[3072 + ch], cbp[ch], F.tid); }
        hy_filt_build(F, fB);
        { const int ch = HYC + c; hy_short_store(XB, SEQ, 0, sC, cw[ch], cw[1536 + ch], cw[3072 + ch], cbp[ch], F.tid); }
        hy_filt_load(fF, Hf, 1, c, F.tid); hy_short_load(sG, zT + (size_t)(2 * HYC + c) * T, F.tid);
        __syncthreads();
        f32x4 C[8];
        hy_conv_mfma(F, C);
        __syncthreads();
        {   const float sk = skip[c];
#pragma unroll
            for (int i = 0; i < 8; ++i) {
                const int t0 = 32 * (8 * w + i) + 16 * hh + 4 * rq;
                LAS v2u* up = (LAS v2u*)(UB + (size_t)(bb * HY_UR + HY_UP + t0) * 2);
                const v2u uu = *up; const v2u xx = *(const LAS v2u*)(XB + (size_t)(bb * SEQ + t0) * 2);
                v2u o;
                o.x = pk2(bflo(xx.x) * (C[i][0] + bflo(uu.x) * sk), bfhi(xx.x) * (C[i][1] + bfhi(uu.x) * sk));
                o.y = pk2(bflo(xx.y) * (C[i][2] + bflo(uu.y) * sk), bfhi(xx.y) * (C[i][3] + bfhi(uu.y) * sk));
                *up = o;
            }
        }
        __syncthreads();
        hy_filt_build(F, fF);
        { const int ch = 2 * HYC + c; hy_short_store(XB, SEQ, 0, sG, cw[ch], cw[1536 + ch], cw[3072 + ch], cbp[ch], F.tid); }
        const int cn = c + F.G; const bool more = cn < HYC;
        if (more) { hy_short_load(sA, zT + (size_t)cn * T, F.tid); hy_filt_load(fB, Hf, 0, cn, F.tid); hy_short_load(sC, zT + (size_t)(HYC + cn) * T, F.tid); }
        __syncthreads();
        hy_conv_mfma(F, C);
        {   const float sk = skip[HYC + c];
#pragma unroll
            for (int i = 0; i < 8; ++i) {
                const int t0 = 32 * (8 * w + i) + 16 * hh + 4 * rq;
                const v2u uu = *(const LAS v2u*)(UB + (size_t)(bb * HY_UR + HY_UP + t0) * 2); const v2u xx = *(const LAS v2u*)(XB + (size_t)(bb * SEQ + t0) * 2);
                v2u o;
                o.x = pk2(bflo(xx.x) * (C[i][0] + bflo(uu.x) * sk), bfhi(xx.x) * (C[i][1] + bfhi(uu.x) * sk));
                o.y = pk2(bflo(xx.y) * (C[i][2] + bflo(uu.y) * sk), bfhi(xx.y) * (C[i][3] + bfhi(uu.y) * sk));
                *(v2u*)(yT + (size_t)c * T + bb * SEQ + t0) = o;
            }
        }
        if (!more) break;
        c = cn;
    }
}
__device__ __forceinline__ void hy_transpose_tile(Frame& F, int tile) {
    const bf16* yT = (const bf16*)(F.ws + WS_YT); bf16* mix = (bf16*)(F.ws + WS_MIX0);
    LAS unsigned* scr = (LAS unsigned*)(F.lds + F.wave * (64 * 36 * 4));
    const int lane = F.lane, ct = tile & 7, tt = tile >> 3, c0 = 64 * ct, tok0 = 64 * tt;
    const int rr = lane >> 3, ch = lane & 7;
    v4u raw[8];
#pragma unroll
    for (int i = 0; i < 8; ++i) raw[i] = *(const v4u*)(yT + (size_t)(c0 + 8 * i + rr) * T + tok0 + 8 * ch);
#pragma unroll
    for (int i = 0; i < 8; ++i) {
        v4u o; o.x = __shfl_xor(raw[i].x, 8); o.y = __shfl_xor(raw[i].y, 8); o.z = __shfl_xor(raw[i].z, 8); o.w = __shfl_xor(raw[i].w, 8);
        const bool odd = rr & 1;
        const unsigned a0 = odd ? o.z : raw[i].x, a1 = odd ? o.w : raw[i].y;
        const unsigned b0 = odd ? raw[i].z : o.x, b1 = odd ? raw[i].w : o.y;
        const int cp = (8 * i + (rr & ~1)) >> 1;
        const int tb = 8 * ch + (odd ? 4 : 0);
        scr[(tb + 0) * 36 + cp] = (a0 & 0xffffu) | (b0 << 16);
        scr[(tb + 1) * 36 + cp] = (a0 >> 16) | (b0 & 0xffff0000u);
        scr[(tb + 2) * 36 + cp] = (a1 & 0xffffu) | (b1 << 16);
        scr[(tb + 3) * 36 + cp] = (a1 >> 16) | (b1 & 0xffff0000u);
    }
    LDS_WAIT(); asm volatile("" ::: "memory");
#pragma unroll
    for (int i = 0; i < 8; ++i) { const int tk = 8 * i + rr; const v4u w = *(const LAS v4u*)(scr + tk * 36 + 4 * ch);
        *(v4u*)(mix + (size_t)(tok0 + tk) * D + c0 + 8 * ch) = w; }
    LDS_WAIT(); asm volatile("" ::: "memory");
}

constexpr int AT_KSTR = 136;
template <int NT, bool DIL>
__device__ __forceinline__ void attn_wave16(const LAS unsigned char* Ks, const LAS unsigned char* VT, int vstr, int k0, const bf16* qrow, const LAS float* bt, int dil, int relbase, int lbase, int L,
                                            bf16* orow, float* lse_out, int lane) {
    const int r = lane & 15, rq = lane >> 4;
    bf16x8_t Qf[4];
    {
        v4u raw[4]; float ss = 0.f;
#pragma unroll
        for (int st = 0; st < 4; ++st) { raw[st] = *(const v4u*)(qrow + 32 * st + 8 * rq);
            const float a0 = bflo(raw[st].x), a1 = bfhi(raw[st].x), a2 = bflo(raw[st].y), a3 = bfhi(raw[st].y), a4 = bflo(raw[st].z), a5 = bfhi(raw[st].z), a6 = bflo(raw[st].w), a7 = bfhi(raw[st].w);
            ss += (a0 * a0 + a1 * a1) + (a2 * a2 + a3 * a3) + (a4 * a4 + a5 * a5) + (a6 * a6 + a7 * a7); }
        ss += __shfl_xor(ss, 16); ss += __shfl_xor(ss, 32);
        const float sc = 0.08838834764831845f / sqrtf(ss * (1.f / 128.f) + EPS);
#pragma unroll
        for (int st = 0; st < 4; ++st) { v4u w;
            w.x = pk2(bflo(raw[st].x) * sc, bfhi(raw[st].x) * sc); w.y = pk2(bflo(raw[st].y) * sc, bfhi(raw[st].y) * sc);
            w.z = pk2(bflo(raw[st].z) * sc, bfhi(raw[st].z) * sc); w.w = pk2(bflo(raw[st].w) * sc, bfhi(raw[st].w) * sc);
            Qf[st] = __builtin_bit_cast(bf16x8_t, w); }
    }
    f32x4 S[NT];
    const LAS unsigned char* kb = Ks + (size_t)(k0 + r) * (AT_KSTR * 2) + 16 * rq;
#pragma unroll
    for (int kt = 0; kt < NT; ++kt) {
        f32x4 acc = (f32x4){0.f, 0.f, 0.f, 0.f};
#pragma unroll
        for (int st = 0; st < 4; ++st) { const bf16x8_t A = *(const LAS bf16x8_t*)(kb + kt * 16 * (AT_KSTR * 2) + 64 * st); acc = __builtin_amdgcn_mfma_f32_16x16x32_bf16(A, Qf[st], acc, 0, 0, 0); }
        S[kt] = acc;
        asm volatile("" ::: "memory");
    }
    float mx = -3.0e38f;
#pragma unroll
    for (int kt = 0; kt < NT; ++kt)
#pragma unroll
        for (int g = 0; g < 4; ++g) {
            float s = S[kt][g];
            if (DIL) { const int rel = relbase + 16 * kt + g, lk = lbase + 16 * kt + g; const bool ok = (lk >= 0) && (lk < L);
                s = ok ? s + bt[rel + 128] : -3.0e38f; S[kt][g] = s; }
            mx = fmaxf(mx, s);
        }
    mx = fmaxf(mx, __shfl_xor(mx, 16)); mx = fmaxf(mx, __shfl_xor(mx, 32));
    float z = 0.f;
#pragma unroll
    for (int kt = 0; kt < NT; ++kt)
#pragma unroll
        for (int g = 0; g < 4; ++g) { const float p = __expf(S[kt][g] - mx); S[kt][g] = p; z += p; }
    z += __shfl_xor(z, 16); z += __shfl_xor(z, 32);
    const float iz = 1.0f / z;
    bf16x8_t Pf[NT / 2];
#pragma unroll
    for (int ks = 0; ks < NT / 2; ++ks) { v4u w; w.x = pk2(S[2 * ks][0], S[2 * ks][1]); w.y = pk2(S[2 * ks][2], S[2 * ks][3]); w.z = pk2(S[2 * ks + 1][0], S[2 * ks + 1][1]); w.w = pk2(S[2 * ks + 1][2], S[2 * ks + 1][3]);
        Pf[ks] = __builtin_bit_cast(bf16x8_t, w); }
    const LAS unsigned char* vb = VT + ((size_t)r * vstr + k0 + 4 * rq) * 2;
#pragma unroll
    for (int dt = 0; dt < 8; ++dt) {
        f32x4 o = (f32x4){0.f, 0.f, 0.f, 0.f};
#pragma unroll
        for (int ks = 0; ks < NT / 2; ++ks) {
            const LAS unsigned char* p = vb + (size_t)dt * 16 * vstr * 2 + 64 * ks;
            const v2u lo = *(const LAS v2u*)p, hi = *(const LAS v2u*)(p + 32);
            v4u w; w.x = lo.x; w.y = lo.y; w.z = hi.x; w.w = hi.y;
            o = __builtin_amdgcn_mfma_f32_16x16x32_bf16(__builtin_bit_cast(bf16x8_t, w), Pf[ks], o, 0, 0, 0);
        }
        v2u ow; ow.x = pk2(o[0] * iz, o[1] * iz); ow.y = pk2(o[2] * iz, o[3] * iz);
        *(v2u*)(orow + 16 * dt + 4 * rq) = ow;
        asm volatile("" ::: "memory");
    }
    if (DIL) { if (rq == 0) *lse_out = mx + logf(z); }
}
template <int NB, int BS, class RowFn>
__device__ __forceinline__ void attn_stage_k(LAS unsigned char* Ks, int nk, const float* qg, const float* kg, const bf16* kbase, RowFn rowoff, int wave, int lane) {
    const int rr = lane >> 4, cc = lane & 15;
    float gf[8];
    { const f32x4 a0 = *(const f32x4*)(qg + 8 * cc), a1 = *(const f32x4*)(qg + 8 * cc + 4), b0 = *(const f32x4*)(kg + 8 * cc), b1 = *(const f32x4*)(kg + 8 * cc + 4);
      gf[0] = a0.x * b0.x; gf[1] = a0.y * b0.y; gf[2] = a0.z * b0.z; gf[3] = a0.w * b0.w; gf[4] = a1.x * b1.x; gf[5] = a1.y * b1.y; gf[6] = a1.z * b1.z; gf[7] = a1.w * b1.w; }
#pragma unroll 1
    for (int bt = 0; bt < NB; ++bt) {
        v4u raw[BS];
#pragma unroll
        for (int i = 0; i < BS; ++i) { const int j = ((bt * BS + i) * 8 + wave) * 4 + rr; const long off = (j < nk) ? rowoff(j) : -1;
            raw[i] = *(const v4u*)(kbase + (off < 0 ? 0 : off) + 8 * cc); if (off < 0) raw[i] = (v4u){0u, 0u, 0u, 0u}; }
#pragma unroll
        for (int i = 0; i < BS; ++i) { const int j = ((bt * BS + i) * 8 + wave) * 4 + rr;
            const float k0 = bflo(raw[i].x), k1 = bfhi(raw[i].x), k2 = bflo(raw[i].y), k3 = bfhi(raw[i].y), k4 = bflo(raw[i].z), k5 = bfhi(raw[i].z), k6 = bflo(raw[i].w), k7 = bfhi(raw[i].w);
            float ss = (k0 * k0 + k1 * k1) + (k2 * k2 + k3 * k3) + (k4 * k4 + k5 * k5) + (k6 * k6 + k7 * k7);
            ss += __shfl_xor(ss, 1); ss += __shfl_xor(ss, 2); ss += __shfl_xor(ss, 4); ss += __shfl_xor(ss, 8);
            const float sc = 1.0f / sqrtf(ss * (1.f / 128.f) + EPS);
            v4u w; w.x = pk2(k0 * sc * gf[0], k1 * sc * gf[1]); w.y = pk2(k2 * sc * gf[2], k3 * sc * gf[3]); w.z = pk2(k4 * sc * gf[4], k5 * sc * gf[5]); w.w = pk2(k6 * sc * gf[6], k7 * sc * gf[7]);
            if (j < nk) *(LAS v4u*)(Ks + (size_t)j * (AT_KSTR * 2) + 16 * cc) = w; }
    }
}
__device__ __forceinline__ void attn_stage_vpair(LAS unsigned char* VT, int vstr, int j0, int dch, const v4u va, const v4u vb) {
    LAS unsigned char* p = VT + ((size_t)(8 * dch) * vstr + j0) * 2;
    const size_t rs = (size_t)vstr * 2;
    *(LAS unsigned*)(p + 0 * rs) = (va.x & 0xffffu) | (vb.x << 16);         *(LAS unsigned*)(p + 1 * rs) = (va.x >> 16) | (vb.x & 0xffff0000u);
    *(LAS unsigned*)(p + 2 * rs) = (va.y & 0xffffu) | (vb.y << 16);         *(LAS unsigned*)(p + 3 * rs) = (va.y >> 16) | (vb.y & 0xffff0000u);
    *(LAS unsigned*)(p + 4 * rs) = (va.z & 0xffffu) | (vb.z << 16);         *(LAS unsigned*)(p + 5 * rs) = (va.z >> 16) | (vb.z & 0xffff0000u);
    *(LAS unsigned*)(p + 6 * rs) = (va.w & 0xffffu) | (vb.w << 16);         *(LAS unsigned*)(p + 7 * rs) = (va.w >> 16) | (vb.w & 0xffff0000u);
}
template <int NB, int BS, int NPR, class RowFn>
__device__ __forceinline__ void attn_stage_v(LAS unsigned char* VT, int vstr, const bf16* vbase, RowFn rowoff, int tid) {
#pragma unroll 1
    for (int bt = 0; bt < NB; ++bt) {
        v4u va[BS], vb[BS];
#pragma unroll
        for (int k = 0; k < BS; ++k) { const int it = tid + 512 * (bt * BS + k), pr = it % NPR, dch = it / NPR;
            const long oa = (it < NPR * 16) ? rowoff(2 * pr) : -1, ob = (it < NPR * 16) ? rowoff(2 * pr + 1) : -1;
            va[k] = *(const v4u*)(vbase + (oa < 0 ? 0 : oa + 8 * dch)); vb[k] = *(const v4u*)(vbase + (ob < 0 ? 0 : ob + 8 * dch));
            if (oa < 0) va[k] = (v4u){0u, 0u, 0u, 0u}; if (ob < 0) vb[k] = (v4u){0u, 0u, 0u, 0u}; }
#pragma unroll
        for (int k = 0; k < BS; ++k) { const int it = tid + 512 * (bt * BS + k), pr = it % NPR, dch = it / NPR; if (it < NPR * 16) attn_stage_vpair(VT, vstr, 2 * pr, dch, va[k], vb[k]); }
    }
}

constexpr int XA_VSTR = 264, XA_OFF_VT = 256 * AT_KSTR * 2;
static_assert(XA_OFF_VT + 128 * XA_VSTR * 2 <= SCR_BYTES, "cross LDS");
__device__ __forceinline__ void cross_unit(Frame& F, const bf16* xq, const bf16* kv, const float* qg, const float* kg, bf16* mix, int unit) {
    int lane = (int)__builtin_amdgcn_mbcnt_hi(~0u, __builtin_amdgcn_mbcnt_lo(~0u, 0u)); asm volatile("" : "+v"(lane)); const int tid = F.wave * 64 + lane;
    const int b = unit >> 5, h = (unit >> 3) & 3, qc = unit & 7;
    LAS unsigned char* Ks = F.lds; LAS unsigned char* VT = F.lds + XA_OFF_VT;
    const bf16* kbase = kv + (size_t)(b * MEML) * 1024 + h * 128;
    __syncthreads();
    attn_stage_k<2, 4>(Ks, MEML, qg, kg, kbase, [=](int j) { return (long)j * 1024; }, F.wave, lane);
    attn_stage_v<2, 2, 128>(VT, XA_VSTR, kbase + 512, [=](int j) { return (long)j * 1024; }, tid);
    __syncthreads();
#pragma unroll 1
    for (int a = F.wave; a < 16; a += NWAVES) {
        const int token = b * SEQ + qc * 256 + 16 * a + (lane & 15);
        attn_wave16<16, false>(Ks, VT, XA_VSTR, 0, xq + (size_t)token * 512 + h * 128, nullptr, 1, 0, 0, 0, mix + (size_t)token * D + 512 + h * 128, nullptr, lane);
    }
}
constexpr int DA_VSTR = 280, DA_NK = 272, DA_OFF_VT = DA_NK * AT_KSTR * 2, DA_OFF_BT = DA_OFF_VT + 128 * DA_VSTR * 2;
static_assert(DA_OFF_BT + 320 * 4 <= SCR_BYTES, "dilated LDS");
__device__ __forceinline__ void dil_unit(Frame& F, const Args& a, int unit) {
    const int bh = unit / 48, sub = unit % 48, b = bh >> 2, h = bh & 3, g = sub >> 4, w16 = sub & 15;
    const int dil = (g == 0) ? 1 : (g == 1 ? 4 : 16), L = SEQ / dil, nch = L / 128;
    const int r = w16 / nch, n128 = w16 % nch;
    int lane = (int)__builtin_amdgcn_mbcnt_hi(~0u, __builtin_amdgcn_mbcnt_lo(~0u, 0u)); asm volatile("" : "+v"(lane)); const int tid = F.wave * 64 + lane;
    const bf16* qkv = (const bf16*)(F.ws + WS_QKV1);
    float* lse = (float*)(F.ws + WS_LSE);
    LAS unsigned char* Ks = F.lds; LAS unsigned char* VT = F.lds + DA_OFF_VT; LAS float* bt = (LAS float*)(F.lds + DA_OFF_BT);
    const int lk0 = 128 * n128 - 64;
    const bf16* base = qkv + (size_t)(b * SEQ + r) * NQKV + g * 512 + h * 128;
    const size_t lstep = (size_t)dil * NQKV;
    __syncthreads();
    if (tid < 320) { const int rel = tid - 128; bt[tid] = (rel >= -64 && rel <= 64) ? a.in[I_RELB][rel_bucket_dev(rel * dil) * 12 + g * 4 + h] : -3.0e38f; }
    attn_stage_k<3, 3>(Ks, DA_NK, a.in[I_ATQN], a.in[I_ATKN], base + ATW, [=](int j) { const int lk = lk0 + j; return (lk >= 0 && lk < L) ? (long)lk * (long)lstep : -1L; }, F.wave, lane);
    attn_stage_v<3, 2, DA_NK / 2>(VT, DA_VSTR, base + 2 * ATW, [=](int j) { const int lk = lk0 + j; return (lk >= 0 && lk < L) ? (long)lk * (long)lstep : -1L; }, tid);
    __syncthreads();
    {
        const int aq = F.wave, i = 16 * aq + (lane & 15), lq = 128 * n128 + i, token = b * SEQ + lq * dil + r, k0 = 16 * aq, rq = lane >> 4;
        attn_wave16<10, true>(Ks, VT, DA_VSTR, k0, base + (size_t)lq * lstep, bt, dil, k0 + 4 * rq - 64 - i, lk0 + k0 + 4 * rq, L,
                              (g == 0) ? (bf16*)(F.ws + WS_MIX1) + (size_t)token * D + h * 128 : (bf16*)(F.ws + WS_OG12) + ((size_t)(g - 1) * T + token) * 512 + h * 128,
                              lse + ((size_t)g * T + token) * 4 + h, lane);
    }
}
__device__ __forceinline__ void combine_phase(Frame& F, const Args& a) {
    moe_layout(F);
    const int gw = F.bid * NWAVES + F.wave, NGW = F.G * NWAVES, lane = F.lane;
    const int* toke = (const int*)(F.ws + WS_TOKE); const int* tokr = (const int*)(F.ws + WS_TOKR); const float* tokg = (const float*)(F.ws + WS_TOKG);
    const bf16* y = (const bf16*)(F.ws + WS_XS); const bf16* y2 = (const bf16*)(F.ws + WS_Y2);
    for (int token = gw; token < T; token += NGW) {
        const int e0 = toke[token * 2], e1 = toke[token * 2 + 1];
        const int s0 = ml_ps(F, e0) + tokr[token * 2], s1 = ml_ps(F, e1) + tokr[token * 2 + 1];
        const float g0 = tokg[token * 2], g1 = tokg[token * 2 + 1];
        f32x4* xo = (f32x4*)(a.out + (size_t)token * D); const v2u* xi = (const v2u*)((const bf16*)a.out + (size_t)token * 2048 + 1024);
        const v2u* y0 = (const v2u*)(y + (size_t)s0 * D); const v2u* y1 = (const v2u*)(y + (size_t)s1 * D);
        v2u xw[4], p0[4], p1[4];
#pragma unroll
        for (int j = 0; j < 4; ++j) { const int q = lane + 64 * j; xw[j] = xi[q]; p0[j] = y0[q]; p1[j] = y1[q]; }
        f32x4 r[4];
#pragma unroll
        for (int j = 0; j < 4; ++j) {
            const int q = lane + 64 * j;
            f32x4 x = (f32x4){bflo(xw[j].x), bfhi(xw[j].x), bflo(xw[j].y), bfhi(xw[j].y)};
            f32x4 a0 = (f32x4){bflo(p0[j].x), bfhi(p0[j].x), bflo(p0[j].y), bfhi(p0[j].y)}, a1 = (f32x4){bflo(p1[j].x), bfhi(p1[j].x), bflo(p1[j].y), bfhi(p1[j].y)};
            if (s0 >= 2 * T) { const v2u t = ((const v2u*)(y2 + (size_t)(s0 - 2 * T) * D))[q]; a0 = a0 + (f32x4){bflo(t.x), bfhi(t.x), bflo(t.y), bfhi(t.y)}; }
            if (s1 >= 2 * T) { const v2u t = ((const v2u*)(y2 + (size_t)(s1 - 2 * T) * D))[q]; a1 = a1 + (f32x4){bflo(t.x), bfhi(t.x), bflo(t.y), bfhi(t.y)}; }
            r[j] = x + g0 * a0 + g1 * a1;
        }
        asm volatile("s_waitcnt vmcnt(0)" ::: "memory");
#pragma unroll
        for (int j = 0; j < 4; ++j) xo[lane + 64 * j] = r[j];
    }
}

constexpr int NPHASE = 15;
__global__ void __launch_bounds__(NWAVES * 64, 2) mega_fwd(Args args) {
    extern __shared__ __attribute__((aligned(16))) unsigned char lds_raw[];
    Frame F;
    F.lds = (LAS unsigned char*)lds_raw; F.ws = args.ws;
    F.wave = __builtin_amdgcn_readfirstlane((int)threadIdx.x >> 6); F.G = gridDim.x; F.bid = blockIdx.x;
#define PH_BEGIN() do { int l_ = (int)__builtin_amdgcn_mbcnt_hi(~0u, __builtin_amdgcn_mbcnt_lo(~0u, 0u)); asm volatile("" : "+v"(l_)); F.lane = l_; F.tid = F.wave * 64 + l_; } while (0)
    PH_BEGIN();
    unsigned char* ws = args.ws;
    volatile LAS unsigned* MISC = (volatile LAS unsigned*)(F.lds + MISC_OFF);
    for (int u = F.tid; u < (LDS_BYTES - MISC_OFF) / 4; u += NWAVES * 64) MISC[u] = 0u;
    __syncthreads();
    const int lo = args.ph_lo, hi = args.ph_hi;
    const bool use_bar = (hi - lo) > 1;
    XcdBarrier bar; bar.bar = (unsigned*)(ws + WS_CTL) + CW_BAR + args.bslot * XCD_BAR_WORDS; bar.x = 0; bar.st = nullptr;
    if (use_bar) bar = xcd_barrier_post((unsigned*)(ws + WS_CTL) + CW_BAR + args.bslot * XCD_BAR_WORDS, MISC + 8, F.tid);
#define IN(k) (lo <= (k) && (k) < hi)
#define SEAM(k) do { if (IN(k) && IN((k) + 1)) { PH_BEGIN(); xcd_barrier(bar, F.tid); } } while (0)
    const int gw = F.bid * NWAVES + F.wave, NGW = F.G * NWAVES;
    LAS unsigned char* ring = F.lds;

    if (IN(0)) { PH_BEGIN(); p0_prologue(F, args); }
    SEAM(0);
    if (IN(1)) { PH_BEGIN();
        {   pg8::Gemm g{(const bf16*)(ws + WS_WIN0), (const bf16*)(ws + WS_XB), D, D, D, 0};
            pg8::StaticOrder S; S.init(ATW / 256, T / 256, F.G, F.bid);
            EpiB<3> E{(bf16*)(ws + WS_ZT), T, (const float*)(ws + WS_RSTD0), 1 << 30, nullptr, 0, nullptr, 1.0f};
            pg8::gemm_phase<EpiB<3>, pg8::StaticOrder, true>(ring, g, S, E, F.wave); }
        {   pg8::Gemm g{(const bf16*)(ws + WS_XB), (const bf16*)(ws + WS_WIN0) + (size_t)ATW * D, D, D, D, 0};
            pg8::StaticOrder S; S.init(T / 256, 2, F.G, (F.bid + 128) % F.G);
            EpiB<1> E{(bf16*)(ws + WS_XQ0), 512, (const float*)(ws + WS_RSTD0), 1 << 30, nullptr, 0, nullptr, 1.0f};
            pg8::gemm_phase<EpiB<1>, pg8::StaticOrder, true>(ring, g, S, E, F.wave); }
        {   pg8::Gemm g{(const bf16*)(ws + WS_MN), (const bf16*)(ws + WS_WKV), D, D, D, (size_t)D * D * 2};
            pg8::MoeOrder S; S.init(2 * TM / 256, 4, F.G, F.bid); S.t0 = TM / 256; S.t1 = S.t2 = S.t3 = S.t4 = S.t5 = S.t6 = 1 << 30; S.lay = nullptr; S.list = nullptr;
            EpiB<0> E{(bf16*)(ws + WS_KV), D, nullptr, 1 << 30, nullptr, 0, nullptr, 1.0f};
            pg8::gemm_phase<EpiB<0>, pg8::MoeOrder, true>(ring, g, S, E, F.wave); }
        if (F.G == 256 && F.bid >= 64) { PH_BEGIN(); moe_convert(F, args, 0, MOE_P1_HI, (F.bid - 64) * NWAVES + F.wave, 192 * NWAVES); }
    }
    SEAM(1);
    if (IN(2)) { PH_BEGIN();
        hyena_units(F, args);
        for (int u = F.bid; u < 256; u += F.G)
            cross_unit(F, (const bf16*)(ws + WS_XQ0), (const bf16*)(ws + WS_KV), args.in[I_XQN], args.in[I_XKN], (bf16*)(ws + WS_MIX0), u);
    }
    SEAM(2);
    if (IN(3)) { PH_BEGIN(); for (int t = gw; t < 2048; t += NGW) hy_transpose_tile(F, t); }
    SEAM(3);
    if (IN(4)) { PH_BEGIN();
        pg8::Gemm g{(const bf16*)(ws + WS_MIX0), (const bf16*)(ws + WS_WO), D, D, D, 0};
        pg8::StaticOrder S; S.init(T / 256, 4, F.G, F.bid);
        EpiRes<false, true> E{nullptr, (const bf16*)(ws + WS_XB), D, (bf16*)(ws + WS_XB), D, (float*)(ws + WS_SSQ16)};
        pg8::gemm_phase<EpiRes<false, true>, pg8::StaticOrder, true>(ring, g, S, E, F.wave);
    }
    SEAM(4);
    if (IN(5)) { PH_BEGIN();
        pg8::Gemm g{(const bf16*)(ws + WS_XB), (const bf16*)(ws + WS_WGU0), D, D, D, 0};
        pg8::StaticOrder S; S.init(T / 256, NGU / 256, F.G, F.bid);
        fill_rstd_table(F.lds, S, (const float*)(ws + WS_SSQ16), F.tid);
        EpiSwiglu<4> E{(bf16*)(ws + WS_HID0), FF, nullptr, (const LAS float*)(F.lds + RSL_OFF), 1.0f};
        pg8::gemm_phase<EpiSwiglu<4>, pg8::StaticOrder, true>(ring, g, S, E, F.wave);
        if (F.G == 256 && F.bid >= 128) { PH_BEGIN(); moe_convert(F, args, MOE_P1_HI, MOE_P5_HI, (F.bid - 128) * NWAVES + F.wave, 128 * NWAVES); }
    }
    SEAM(5);
    if (IN(6)) { PH_BEGIN();
        pg8::Gemm g{(const bf16*)(ws + WS_HID0), (const bf16*)(ws + WS_WD0), FF, FF, FF, 0};
        pg8::StaticOrder S; S.init(T / 256, 4, F.G, F.bid);
        EpiRes<false, true> E{nullptr, (const bf16*)(ws + WS_XB), D, (bf16*)(ws + WS_XB), D, (float*)(ws + WS_SSQ16)};
        pg8::gemm_phase<EpiRes<false, true>, pg8::StaticOrder, true>(ring, g, S, E, F.wave);
    }
    SEAM(6);
    if (IN(7)) { PH_BEGIN();
        pg8::Gemm g{(const bf16*)(ws + WS_XB), (const bf16*)(ws + WS_WIN1), D, D, D, 0};
        pg8::StaticOrder S; S.init(T / 256, NQ1 / 256, F.G, F.bid);
        fill_rstd_table(F.lds, S, (const float*)(ws + WS_SSQ16), F.tid);
        EpiB<4> E{(bf16*)(ws + WS_QKV1), NQKV, nullptr, NQKV / 256, (bf16*)(ws + WS_XQ1), 512, (const LAS float*)(F.lds + RSL_OFF), 1.0f};
        pg8::gemm_phase<EpiB<4>, pg8::StaticOrder, true>(ring, g, S, E, F.wave);
    }
    SEAM(7);
    if (IN(8)) { PH_BEGIN();
        for (int u = F.bid; u < NB * 4 * 48; u += F.G) dil_unit(F, args, u);
        for (int u = F.bid; u < 256; u += F.G)
            cross_unit(F, (const bf16*)(ws + WS_XQ1), (const bf16*)(ws + WS_KV) + (size_t)TM * D, args.in[I_XQN] + 128, args.in[I_XKN] + 128, (bf16*)(ws + WS_MIX1), u);
    }
    SEAM(8);
    if (IN(9)) { PH_BEGIN(); for (int t = gw; t < T; t += NGW) merge_token(F, t); }
    SEAM(9);
    if (IN(10)) { PH_BEGIN();
        pg8::Gemm g{(const bf16*)(ws + WS_MIX1), (const bf16*)(ws + WS_WO) + (size_t)D * D, D, D, D, 0};
        pg8::StaticOrder S; S.init(T / 256, 4, F.G, F.bid);
        EpiRes<false, false> E{nullptr, (const bf16*)(ws + WS_XB), D, (bf16*)args.out + 1024, 2048, nullptr};
        pg8::gemm_phase<EpiRes<false, false>, pg8::StaticOrder, true>(ring, g, S, E, F.wave);
    }
    SEAM(10);
    if (IN(11)) { PH_BEGIN(); for (int blk = F.bid; blk < T / 64; blk += F.G) route_block(F, args, blk); }
    SEAM(11);
    if (IN(12)) { PH_BEGIN();
        moe_layout(F);
        pg8::Gemm g{(const bf16*)(ws + WS_XB3), (const bf16*)(ws + WS_WGU1), D / 2, D / 2, D / 2, (size_t)NGU * D};
        pg8::MoeOrder S; S.init(ml_total(F) / 256, NGU / 256, F.G, F.bid); S.lay = (const volatile LAS int*)(F.lds + MISC_OFF); S.list = (const int*)(ws + WS_LIST);
        S.t0 = ml_ps(F, 1) / 256; S.t1 = ml_ps(F, 2) / 256; S.t2 = ml_ps(F, 3) / 256; S.t3 = ml_ps(F, 4) / 256; S.t4 = ml_ps(F, 5) / 256; S.t5 = ml_ps(F, 6) / 256; S.t6 = ml_ps(F, 7) / 256;
        EpiSwiglu<5, true> E{(bf16*)(ws + WS_HID1), FF, nullptr, nullptr, 1.0f / MOE_WGU_SCALE};
        pg8::gemm_phase<EpiSwiglu<5, true>, pg8::MoeOrder, true, true, true>(ring, g, S, E, F.wave);
    }
    SEAM(12);
    if (IN(13)) { PH_BEGIN();
        moe_layout(F);
        const int nMt = ml_total(F) / 256;
        const int q1 = ml_ps(F, 1) / 256, q2 = ml_ps(F, 2) / 256, q3 = ml_ps(F, 3) / 256, q4 = ml_ps(F, 4) / 256, q5 = ml_ps(F, 5) / 256, q6 = ml_ps(F, 6) / 256, q7 = ml_ps(F, 7) / 256;
        {   pg8::Gemm g{(const bf16*)(ws + WS_HID1), (const bf16*)(ws + WS_WD1), FF / 2, FF / 2, FF / 2, (size_t)D * FF};
            pg8::MoeOrder S; S.init(nMt < 128 ? nMt : 128, 4, F.G, F.bid); S.lay = nullptr; S.list = nullptr;
            S.t0 = q1; S.t1 = q2; S.t2 = q3; S.t3 = q4; S.t4 = q5; S.t5 = q6; S.t6 = q7;
            EpiB<5> E{(bf16*)(ws + WS_XS), D, nullptr, 1 << 30, nullptr, 0, nullptr, 1.0f / MOE_WD_SCALE};
            pg8::gemm_phase<EpiB<5>, pg8::MoeOrder, true, false, true>(ring, g, S, E, F.wave); }
        if (nMt > 128) {
            const int half = F.G / 2; const bool second = F.bid >= half;
            pg8::Gemm g{(const bf16*)(ws + WS_HID1), (const bf16*)(ws + WS_WD1), FF / 2, FF / 2, second ? 640 : 768, (size_t)D * FF};
            pg8::MoeTailOrder2 S; S.pm0 = 128; S.ntail = nMt - 128; S.nN = 4; S.G = second ? F.G - half : half; S.c = second ? F.bid - half : F.bid; S.koff = second ? 12 * 128 : 0;
            S.t0 = q1; S.t1 = q2; S.t2 = q3; S.t3 = q4; S.t4 = q5; S.t5 = q6; S.t6 = q7;
            EpiB<5> E{(bf16*)(ws + WS_XS), D, nullptr, 1 << 30, (bf16*)(ws + WS_Y2) - (size_t)2 * T * D, D, nullptr, 1.0f / MOE_WD_SCALE};
            pg8::gemm_phase<EpiB<5>, pg8::MoeTailOrder2, true, false, true>(ring, g, S, E, F.wave); }
    }
    SEAM(13);
    if (IN(14)) { PH_BEGIN(); combine_phase(F, args); }
#undef IN
#undef SEAM
}

#ifndef MK_ONE_LAUNCH
#define MK_ONE_LAUNCH 1
#endif
extern "C" void kernel_launch(void* const* d_in, const int* in_sizes, int n_in, void* d_out, int out_size, void* d_ws, size_t ws_size, hipStream_t stream) {
    static int grid = 0;
    if (grid == 0) {
        if (n_in != 30 || in_sizes[0] != T * D || out_size != T * D || ws_size < WS_END) {
            fprintf(stderr, "kernel_launch: unexpected problem (n_in %d, in0 %d, out %d, ws %zu, need %zu); nothing launched\n", n_in, n_in > 0 ? in_sizes[0] : -1, out_size, ws_size, (size_t)WS_END); grid = -1; return; }
        int dev = 0, cus = 0, per_cu = 0;
        if (hipGetDevice(&dev) != hipSuccess || hipDeviceGetAttribute(&cus, hipDeviceAttributeMultiprocessorCount, dev) != hipSuccess) { grid = -1; return; }
        if (hipFuncSetAttribute((const void*)mega_fwd, hipFuncAttributeMaxDynamicSharedMemorySize, LDS_BYTES) != hipSuccess) { fprintf(stderr, "kernel_launch: hipFuncSetAttribute failed\n"); grid = -1; return; }
        if (hipOccupancyMaxActiveBlocksPerMultiprocessor(&per_cu, (const void*)mega_fwd, NWAVES * 64, LDS_BYTES) != hipSuccess || per_cu < 1)
            fprintf(stderr, "kernel_launch: note: occupancy query reports %d workgroups per CU\n", per_cu);
        (void)hipGetLastError();
        grid = cus;
    }
    if (grid < 0) return;
    if (hipMemsetAsync((char*)d_ws + WS_CTL, 0, CTL_ZERO_BYTES, stream) != hipSuccess) return;
    Args a{};
    for (int i = 0; i < 30; ++i) a.in[i] = (const float*)d_in[i];
    a.out = (float*)d_out; a.ws = (unsigned char*)d_ws;
#if defined(PROBE_PHASE)
    a.ph_lo = 0; a.ph_hi = PROBE_PHASE + 1; a.bslot = 0;
    hipLaunchKernelGGL(mega_fwd, dim3(grid), dim3(NWAVES * 64), LDS_BYTES, stream, a);
    a.ph_lo = PROBE_PHASE; a.ph_hi = NPHASE; a.bslot = 1;
    hipLaunchKernelGGL(mega_fwd, dim3(grid), dim3(NWAVES * 64), LDS_BYTES, stream, a);
#elif MK_ONE_LAUNCH
    a.ph_lo = 0; a.ph_hi = NPHASE; a.bslot = 0;
    hipLaunchKernelGGL(mega_fwd, dim3(grid), dim3(NWAVES * 64), LDS_BYTES, stream, a);
#else
    for (int p = 0; p < NPHASE; ++p) { a.ph_lo = p; a.ph_hi = p + 1; a.bslot = 0; hipLaunchKernelGGL(mega_fwd, dim3(grid), dim3(NWAVES * 64), LDS_BYTES, stream, a); }
#endif
}
```

```cpp
#include <hip/hip_runtime.h>
#include <cstdio>
#include <cstdint>

namespace pg8 {
#define PG8_LAS __attribute__((address_space(3)))
typedef unsigned short bf16_t;
typedef short bf16x8 __attribute__((ext_vector_type(8)));
typedef float f32x4 __attribute__((ext_vector_type(4)));
typedef unsigned u32x4 __attribute__((ext_vector_type(4)));
constexpr int BM = 256, BK = 64, HALF = 128, HTB = HALF * BK * 2  , STAGE_BYTES = 8 * HTB, NXCD = 8, WGM = 8;

__host__ __device__ __forceinline__ int lds_byte(int r, int c) { const int st = (r >> 4) * 2 + (c >> 5), rr = r & 15, cc = c & 31, ob = rr * 64 + cc * 2; return st * 1024 + (ob ^ (((ob >> 9) & 1) << 5)); }
__host__ __device__ __forceinline__ void stage_rc(int b, int& R, int& C) { const int st = b / 1024, sb = b % 1024, swz = sb ^ (((sb >> 9) & 1) << 5); R = (st >> 1) * 16 + swz / 64; C = (st & 1) * 32 + (swz % 64) / 2; }
__host__ __device__ __forceinline__ int perm32(int rho) { const int n = rho >> 4, i = rho & 15; return 8 * (i >> 2) + 4 * n + (i & 3); }

struct Unit { int pm, pn, e, koff, idx; };
struct Gemm { const bf16_t* A; const bf16_t* Bt; int lda, ldb, K; size_t estride; };

struct StaticOrder {
    int nM, nN, nwg, G, c;
    __device__ __forceinline__ int gather_row(const Unit&, int slot) const { return slot; }
    __host__ __device__ void init(int nM_, int nN_, int G_, int c_) { nM = nM_; nN = nN_; nwg = nM * nN; G = G_; c = c_; }
    __host__ __device__ bool next(int i, Unit& u) const {
        const long L = (long)i * G + c; if (L >= nwg) return false;
        int wgid = (int)L; { const int q = nwg / NXCD, r = nwg % NXCD, xcd = wgid % NXCD, off = wgid / NXCD; wgid = (xcd < r ? xcd * (q + 1) : r * (q + 1) + (xcd - r) * q) + off; }
        const int nig = WGM * nN, gid = wgid / nig, fm = gid * WGM, gsz = (nM - fm) < WGM ? (nM - fm) : WGM;
        u.pm = fm + ((wgid % nig) % gsz); u.pn = (wgid % nig) / gsz; u.e = 0; u.koff = 0; return true;
    }
};
struct MoeOrder : StaticOrder {
    int t0, t1, t2, t3, t4, t5, t6;
    const volatile PG8_LAS int* lay;
    const int* list;
    __device__ __forceinline__ int gather_row(const Unit& u, int slot) const { const int rank = slot - lay[40 + u.e]; return rank < lay[32 + u.e] ? list[(size_t)u.e * 16384 + rank] : 0; }
    __host__ __device__ bool next(int i, Unit& u) const {
        if (!StaticOrder::next(i, u)) return false;
        const int p = u.pm; u.e = (p >= t0) + (p >= t1) + (p >= t2) + (p >= t3) + (p >= t4) + (p >= t5) + (p >= t6); return true;
    }
};

struct MoeTailOrder {
    int pm0, ntail, nN, G, c, khalf; int t0, t1, t2, t3, t4, t5, t6;
    __device__ __forceinline__ int gather_row(const Unit&, int slot) const { return slot; }
    __device__ __forceinline__ bool next(int i, Unit& u) const {
        const int L = i * G + c; if (L >= ntail * nN * 2) return false;
        const int kh = L & 1, q = L >> 1; u.pn = q % nN; u.pm = pm0 + q / nN; u.koff = kh * khalf;
        const int p = u.pm; u.e = (p >= t0) + (p >= t1) + (p >= t2) + (p >= t3) + (p >= t4) + (p >= t5) + (p >= t6); return true;
    }
};
struct MoeTailOrder2 {
    int pm0, ntail, nN, G, c, koff; int t0, t1, t2, t3, t4, t5, t6;
    __device__ __forceinline__ int gather_row(const Unit&, int slot) const { return slot; }
    __device__ __forceinline__ bool next(int i, Unit& u) const {
        const int L = i * G + c; if (L >= ntail * nN) return false;
        u.pn = L % nN; u.pm = pm0 + L / nN; u.koff = koff;
        const int p = u.pm; u.e = (p >= t0) + (p >= t1) + (p >= t2) + (p >= t3) + (p >= t4) + (p >= t5) + (p >= t6); return true;
    }
};
__device__ __forceinline__ unsigned cvt_pk_bf16(float lo, float hi) { unsigned r; asm volatile("v_cvt_pk_bf16_f32 %0, %1, %2" : "=v"(r) : "v"(lo), "v"(hi)); return r; }

typedef int v8i __attribute__((ext_vector_type(8)));
typedef int v4i __attribute__((ext_vector_type(4)));
template <class Epi, class Sched, bool ALIGN_EPI, bool GATHER = false, bool FP8 = false>
__device__ __forceinline__ void gemm_phase(PG8_LAS unsigned char* lds, const Gemm g, const Sched& S, const Epi& E, const int wid) {
    int lane = (int)__builtin_amdgcn_mbcnt_hi(~0u, __builtin_amdgcn_mbcnt_lo(~0u, 0u)); asm volatile("" : "+v"(lane));
    const int tid = wid * 64 + lane, wr = wid >> 2, wc = wid & 3, fr = lane & 15, fq = lane >> 4;
    const int K = g.K, nt = K / BK;
    unsigned cvo[4], nvo[4], voffB[2]; int rowA[2], colA[2];
#pragma unroll
    for (int i = 0; i < 2; ++i) { int R, C; stage_rc(tid * 16 + i * 8192, R, C); const int Rb = (R & ~31) + perm32(R & 31); rowA[i] = R; colA[i] = C;
        voffB[i] = (unsigned)(Rb * g.ldb + C) * 2u; }
    const size_t kstep = (size_t)(BK * 2);
    const size_t hstepB = (size_t)HALF * g.ldb * 2;
    const size_t tstepA = GATHER ? (size_t)0 : (size_t)2 * HALF * g.lda * 2, tstepB = 2 * hstepB;
#define PG8_ROWOFFS(vo, u) do { _Pragma("unroll") for (int _h = 0; _h < 2; ++_h) _Pragma("unroll") for (int _i = 0; _i < 2; ++_i) { \
        const int _r = _h * HALF + rowA[_i]; const unsigned _row = GATHER ? (unsigned)S.gather_row(u, (u).pm * BM + _r) : (unsigned)_r; \
        (vo)[2 * _h + _i] = (_row * (unsigned)g.lda + (unsigned)colA[_i]) * 2u; } } while (0)
    const unsigned ldsw = (unsigned)wid * 1024u;
    const int aoff = lds_byte(wr * 64 + fr, fq * 8), boff = lds_byte(wc * 32 + fr, fq * 8);
#define PG8_SA(b, h) (((b) * 2 + (h)) * HTB)
#define PG8_SB(b, h) ((4 + (b) * 2 + (h)) * HTB)
#define PG8_STAGE(bufoff, gbase, voff) do { _Pragma("unroll") for (int _i = 0; _i < 2; ++_i) \
        __builtin_amdgcn_global_load_lds((const unsigned*)((const char*)(gbase) + (voff)[_i]), (PG8_LAS unsigned*)(lds + (bufoff) + ldsw + _i * 8192), 16, 0, 0); } while (0)
#define PG8_STAGEA(bufoff, gbase, vo, h) do { _Pragma("unroll") for (int _i = 0; _i < 2; ++_i) \
        __builtin_amdgcn_global_load_lds((const unsigned*)((const char*)(gbase) + (vo)[2 * (h) + _i]), (PG8_LAS unsigned*)(lds + (bufoff) + ldsw + _i * 8192), 16, 0, 0); } while (0)
#define PG8_LDA(dst, b, h) do { _Pragma("unroll") for (int m = 0; m < 4; ++m) dst[m] = __builtin_shufflevector(*(const PG8_LAS v4i*)(lds + PG8_SA(b, h) + aoff + m * 2048), *(const PG8_LAS v4i*)(lds + PG8_SA(b, h) + aoff + m * 2048 + 1024), 0, 1, 2, 3, 4, 5, 6, 7); } while (0)
#define PG8_LDB(dst, b, h) do { _Pragma("unroll") for (int n = 0; n < 2; ++n) dst[n] = __builtin_shufflevector(*(const PG8_LAS v4i*)(lds + PG8_SB(b, h) + boff + n * 2048), *(const PG8_LAS v4i*)(lds + PG8_SB(b, h) + boff + n * 2048 + 1024), 0, 1, 2, 3, 4, 5, 6, 7); } while (0)
#define PG8_HALF(x, k) __builtin_bit_cast(bf16x8, __builtin_shufflevector(x, x, 4 * (k), 4 * (k) + 1, 4 * (k) + 2, 4 * (k) + 3))
#define PG8_MMA(ai, bj, At, Bt) do { if constexpr (FP8) __builtin_amdgcn_sched_barrier(0); __builtin_amdgcn_s_setprio(1); _Pragma("unroll") for (int m = 0; m < 4; ++m) _Pragma("unroll") for (int n = 0; n < 2; ++n) { \
        if constexpr (FP8) acc[ai][bj][m][n] = __builtin_amdgcn_mfma_scale_f32_16x16x128_f8f6f4(Bt[n], At[m], acc[ai][bj][m][n], 0, 0, 0, 0x7f7f7f7f, 0, 0x7f7f7f7f); \
        else { acc[ai][bj][m][n] = __builtin_amdgcn_mfma_f32_16x16x32_bf16(PG8_HALF(Bt[n], 0), PG8_HALF(At[m], 0), acc[ai][bj][m][n], 0, 0, 0); \
               acc[ai][bj][m][n] = __builtin_amdgcn_mfma_f32_16x16x32_bf16(PG8_HALF(Bt[n], 1), PG8_HALF(At[m], 1), acc[ai][bj][m][n], 0, 0, 0); } } \
        if constexpr (FP8) { _Pragma("unroll") for (int m = 0; m < 4; ++m) _Pragma("unroll") for (int n = 0; n < 2; ++n) asm volatile("" : "+v"(acc[ai][bj][m][n])); }   \
        __builtin_amdgcn_s_setprio(0); if constexpr (FP8) __builtin_amdgcn_sched_barrier(0); } while (0)
#define PG8_WAIT_V(n) asm volatile("s_waitcnt vmcnt(" #n ")" ::: "memory")
#define PG8_WAIT_L(n) asm volatile("s_waitcnt lgkmcnt(" #n ")" ::: "memory")
#define PG8_BAR __builtin_amdgcn_s_barrier()
#define PG8_SCHED __builtin_amdgcn_sched_barrier(0)
    Unit cur, nxt; int ui = 0;
    if (!S.next(0, cur)) return;
    cur.idx = 0;
    f32x4 acc[2][2][4][2];
#pragma unroll
    for (int a = 0; a < 2; ++a)
#pragma unroll
        for (int b = 0; b < 2; ++b)
#pragma unroll
            for (int m = 0; m < 4; ++m)
#pragma unroll
                for (int n = 0; n < 2; ++n) acc[a][b][m][n] = (f32x4){0.f, 0.f, 0.f, 0.f};
    v8i At[4], B0[2], B1[2];
    const char* cA = (const char*)g.A + (size_t)cur.pm * tstepA + cur.koff; const char* cB = (const char*)g.Bt + (size_t)cur.e * g.estride + (size_t)cur.pn * tstepB + cur.koff;
    PG8_ROWOFFS(cvo, cur);
#pragma unroll
    for (int i = 0; i < 4; ++i) nvo[i] = cvo[i];
    PG8_STAGE(PG8_SB(0, 0), cB, voffB); PG8_STAGE(PG8_SB(0, 1), cB + hstepB, voffB); PG8_STAGEA(PG8_SA(0, 0), cA, cvo, 0); PG8_STAGEA(PG8_SA(0, 1), cA, cvo, 1);
    if (wr == 1) PG8_BAR;
    PG8_WAIT_V(2); PG8_BAR;
    PG8_STAGE(PG8_SB(1, 0), cB + kstep, voffB); PG8_STAGEA(PG8_SA(1, 0), cA + kstep, cvo, 0); PG8_STAGE(PG8_SB(1, 1), cB + hstepB + kstep, voffB);
    PG8_WAIT_V(6); PG8_BAR;
    for (;;) {
        const bool has_next = S.next(ui + 1, nxt); nxt.idx = ui + 1;
        const char* nA = has_next ? (const char*)g.A + (size_t)nxt.pm * tstepA + nxt.koff : cA;
        const char* nB = has_next ? (const char*)g.Bt + (size_t)nxt.e * g.estride + (size_t)nxt.pn * tstepB + nxt.koff : cB;
        if constexpr (GATHER) { if (has_next) PG8_ROWOFFS(nvo, nxt); }
        for (int t = 0; t < nt; t += 2) {
            const bool last = (t == nt - 2);
            const char* a1 = cA + (size_t)(t + 1) * kstep;
            const char* a2 = last ? nA : cA + (size_t)(t + 2) * kstep; const char* b2 = last ? nB : cB + (size_t)(t + 2) * kstep;
            const char* a3 = a2 + kstep; const char* b3 = b2 + kstep;
            unsigned vo2[4];
#pragma unroll
            for (int i = 0; i < 4; ++i) vo2[i] = (GATHER && last) ? nvo[i] : cvo[i];
            PG8_LDB(B0, 0, 0); PG8_LDB(B1, 0, 1); PG8_SCHED; PG8_LDA(At, 0, 0); PG8_STAGEA(PG8_SA(1, 1), a1, cvo, 1);
            PG8_WAIT_V(8); PG8_WAIT_L(0); PG8_BAR; PG8_MMA(0, 0, At, B0); PG8_MMA(0, 1, At, B1); PG8_BAR; PG8_SCHED;
            PG8_LDA(At, 0, 1); PG8_STAGE(PG8_SB(0, 0), b2, voffB); PG8_STAGE(PG8_SB(0, 1), b2 + hstepB, voffB); PG8_STAGEA(PG8_SA(0, 0), a2, vo2, 0);
            PG8_WAIT_V(8); PG8_WAIT_L(0); PG8_BAR; PG8_MMA(1, 0, At, B0); PG8_MMA(1, 1, At, B1); PG8_BAR; PG8_SCHED;
            PG8_LDB(B0, 1, 0); PG8_LDB(B1, 1, 1); PG8_SCHED; PG8_LDA(At, 1, 0); PG8_STAGEA(PG8_SA(0, 1), a2, vo2, 1);
            PG8_WAIT_V(8); PG8_WAIT_L(0); PG8_BAR; PG8_MMA(0, 0, At, B0); PG8_MMA(0, 1, At, B1); PG8_BAR; PG8_SCHED;
            PG8_LDA(At, 1, 1); PG8_STAGE(PG8_SB(1, 0), b3, voffB); PG8_STAGE(PG8_SB(1, 1), b3 + hstepB, voffB); PG8_STAGEA(PG8_SA(1, 0), a3, vo2, 0);
            PG8_WAIT_V(8); PG8_WAIT_L(0); PG8_BAR; PG8_MMA(1, 0, At, B0); PG8_MMA(1, 1, At, B1); PG8_BAR; PG8_SCHED;
        }
        if constexpr (ALIGN_EPI) { if (wr == 0) PG8_BAR; }
        E(acc, cur, wr, wc, fr, fq);
        if (!has_next) break;
#pragma unroll
        for (int a = 0; a < 2; ++a)
#pragma unroll
            for (int b = 0; b < 2; ++b)
#pragma unroll
                for (int m = 0; m < 4; ++m)
#pragma unroll
                    for (int n = 0; n < 2; ++n) acc[a][b][m][n] = (f32x4){0.f, 0.f, 0.f, 0.f};
        cur = nxt; cA = nA; cB = nB; ++ui;
        if constexpr (GATHER) {
#pragma unroll
            for (int i = 0; i < 4; ++i) cvo[i] = nvo[i]; }
        if constexpr (ALIGN_EPI) { if (wr == 1) PG8_BAR; }
    }
    PG8_WAIT_V(0);
    if constexpr (!ALIGN_EPI) { if (wr == 0) PG8_BAR; }
    PG8_BAR;
#undef PG8_SA
#undef PG8_SB
#undef PG8_STAGE
#undef PG8_STAGEA
#undef PG8_ROWOFFS
#undef PG8_LDA
#undef PG8_LDB
#undef PG8_MMA
#undef PG8_HALF
#undef PG8_WAIT_V
#undef PG8_WAIT_L
#undef PG8_BAR
#undef PG8_SCHED
}
}

constexpr int NB = 8, SEQ = 2048, D = 1024, T = NB * SEQ;
constexpr int MEML = 256, TM = NB * MEML;
constexpr int HYC = 512, NZ0 = 2048;
constexpr int FF = 2816, NGU = 2 * FF;
constexpr int ATW = 1536, NQKV = 3 * ATW, NQ1 = NQKV + 512;
constexpr int NE = 8, PMAX = 2 * T + NE * 256;
constexpr float EPS = 1e-6f;
constexpr float MOE_WGU_SCALE = 32.0f, MOE_WD_SCALE = 64.0f;
constexpr int NWAVES = 8;

constexpr size_t MiB = 1u << 20;
constexpr size_t WS_CTL = 0, CTL_ZERO_BYTES = 1 * MiB;
constexpr size_t WS_WGU1 = 1 * MiB;
constexpr size_t WS_WD1 = 89 * MiB;
constexpr size_t WS_SMALL = 133 * MiB;
constexpr size_t WS_RSTD0 = WS_SMALL;
constexpr size_t WS_SSQ16 = WS_SMALL + 64 * 1024;
constexpr size_t WS_LSE = WS_SSQ16 + 1 * MiB;
constexpr size_t WS_TOKE = WS_LSE + 768 * 1024;
constexpr size_t WS_TOKR = WS_TOKE + 128 * 1024;
constexpr size_t WS_TOKG = WS_TOKR + 128 * 1024;
constexpr size_t WS_RSTD3 = WS_TOKG + 128 * 1024;
constexpr size_t WS_LIST = WS_RSTD3 + 64 * 1024;
constexpr size_t WS_RSTDS = WS_LIST + 512 * 1024;
static_assert(WS_RSTDS + PMAX * 4 <= WS_SMALL + 4 * MiB, "small region");
constexpr size_t WS_WO = 137 * MiB;
constexpr size_t WS_WIN1 = 141 * MiB;
constexpr size_t WS_WKV = 151 * MiB;
constexpr size_t WS_WIN0 = 155 * MiB;
constexpr size_t WS_WGU0 = 159 * MiB;
constexpr size_t WS_WD0 = 170 * MiB;
constexpr size_t WS_KV = 176 * MiB;
constexpr size_t WS_XB = 184 * MiB;
constexpr size_t WS_YT = 336 * MiB;
constexpr size_t WS_MIX0 = 216 * MiB;
constexpr size_t WS_MN = 248 * MiB;
constexpr size_t WS_ZT = 256 * MiB;
constexpr size_t WS_XQ0 = 304 * MiB;
constexpr size_t WS_HF = 320 * MiB;
constexpr size_t WS_HID0 = 248 * MiB;
constexpr size_t WS_QKV1 = 248 * MiB;
constexpr size_t WS_XQ1 = 392 * MiB;
constexpr size_t WS_OG12 = 216 * MiB;
constexpr size_t WS_MIX1 = 141 * MiB;
constexpr size_t WS_XB3 = 137 * MiB;
constexpr size_t WS_XS = 137 * MiB;
constexpr size_t WS_HID1 = 205 * MiB;
constexpr size_t WS_Y2 = 392 * MiB;
constexpr size_t WS_END = 408 * MiB;
static_assert(WS_HID1 + (size_t)PMAX * FF * 2 <= WS_END && WS_XQ1 + (size_t)T * 512 * 2 <= WS_END && WS_XS + (size_t)PMAX * 2048 <= WS_HID1, "ws map");

constexpr int CW_CNT = 64;
constexpr int CW_BAR = 4096;

constexpr int SCR_BYTES = 147456;
constexpr int MISC_OFF = SCR_BYTES;
constexpr int LDS_BYTES = SCR_BYTES + 4096;

#define LAS __attribute__((address_space(3)))
typedef unsigned short bf16;
typedef unsigned v4u __attribute__((ext_vector_type(4)));
typedef unsigned v2u __attribute__((ext_vector_type(2)));
typedef float f32x4 __attribute__((ext_vector_type(4)));
typedef float f32x2 __attribute__((ext_vector_type(2)));
#define LDS_WAIT() asm volatile("s_waitcnt lgkmcnt(0)" ::: "memory")
__device__ __forceinline__ unsigned f2bf(float f) { unsigned u = __builtin_bit_cast(unsigned, f); return (u + 0x7fffu + ((u >> 16) & 1u)) >> 16; }
__device__ __forceinline__ unsigned pk2(float lo, float hi) { unsigned r; asm("v_cvt_pk_bf16_f32 %0, %1, %2" : "=v"(r) : "v"(lo), "v"(hi)); return r; }
__device__ __forceinline__ unsigned pk4_fp8(float a, float b, float c, float d) { unsigned w = 0u; w = __builtin_amdgcn_cvt_pk_fp8_f32(a, b, w, false); w = __builtin_amdgcn_cvt_pk_fp8_f32(c, d, w, true); return w; }
__device__ __forceinline__ float bflo(unsigned w) { return __builtin_bit_cast(float, w << 16); }
__device__ __forceinline__ float bfhi(unsigned w) { return __builtin_bit_cast(float, w & 0xffff0000u); }
__device__ __forceinline__ float bf1(bf16 b) { return __builtin_bit_cast(float, ((unsigned)b) << 16); }
__device__ __forceinline__ float wave_sum(float v) {
#pragma unroll
    for (int o = 1; o < 64; o <<= 1) v += __shfl_xor(v, o);
    return v;
}
__device__ __forceinline__ float wave_max(float v) {
#pragma unroll
    for (int o = 1; o < 64; o <<= 1) v = fmaxf(v, __shfl_xor(v, o));
    return v;
}

#define XB_TMO      128
#define XB_XCNT(j)  (256  + 64 * (j))
#define XB_XSUB(j)  (1280 + 64 * (j))
#define XB_XGEN(j)  (2304 + 64 * (j))
#define XB_TOP      3328
#define XB_TOPGEN   3392
#define XCD_BAR_WORDS 3456
#define XB_SPIN_CAP (1u << 18)

__device__ __forceinline__ unsigned xb_ld(unsigned* p)              { return __hip_atomic_load(p, __ATOMIC_RELAXED, __HIP_MEMORY_SCOPE_AGENT); }
__device__ __forceinline__ unsigned xb_add(unsigned* p, unsigned v) { return __hip_atomic_fetch_add(p, v, __ATOMIC_RELAXED, __HIP_MEMORY_SCOPE_AGENT); }
__device__ __forceinline__ unsigned xb_xcc_id() { return (unsigned)__builtin_amdgcn_s_getreg((3 << 11) | 20) & 0xFu; }
#define XB_SPIN(cond, bar) do { unsigned _sp = 0; while (cond) { __builtin_amdgcn_s_sleep(1); \
    if ((++_sp & 255u) == 0u) { if (xb_ld(&(bar)[XB_TMO])) break; if (_sp > XB_SPIN_CAP) { atomicAdd(&(bar)[XB_TMO], 1u); break; } } } } while (0)

struct XcdBarrier {
    unsigned* bar; unsigned x;
    volatile LAS unsigned* st;
};
__device__ __forceinline__ XcdBarrier xcd_barrier_post(unsigned* bar, volatile LAS unsigned* st, int tid) {
    XcdBarrier b; b.bar = bar; b.x = xb_xcc_id(); b.st = st;
    if (tid == 0) (void)xb_add(&bar[XB_XCNT(b.x)], 1u);
    return b;
}
__device__ __forceinline__ void xcd_barrier_complete(unsigned* bar, unsigned x, unsigned& nloc, unsigned& nx) {
    const unsigned G = gridDim.x * gridDim.y * gridDim.z;
    unsigned sum, cnt, mine, sp = 0u;
    for (;;) {
        sum = 0u; cnt = 0u; mine = 0u;
#pragma unroll
        for (unsigned j = 0; j < 16; ++j) { const unsigned c = xb_ld(&bar[XB_XCNT(j)]); sum += c; cnt += (c > 0u) ? 1u : 0u; mine = (j == x) ? c : mine; }
        if (sum == G) break;
        __builtin_amdgcn_s_sleep(1);
        if ((++sp & 255u) == 0u) { if (xb_ld(&bar[XB_TMO])) break; if (sp > XB_SPIN_CAP) { atomicAdd(&bar[XB_TMO], 1u); break; } }
    }
    nloc = mine > 0u ? mine : 1u; nx = cnt > 0u ? cnt : 1u;
}
__device__ __forceinline__ void xcd_barrier(const XcdBarrier& b, int tid) {
    asm volatile("s_waitcnt vmcnt(0)" ::: "memory");
    __syncthreads();
    if (tid == 0) {
        unsigned* bar = b.bar;
        __builtin_amdgcn_s_waitcnt(0);
        unsigned nloc = b.st[0], nx = b.st[1];
        if (nloc == 0u) { xcd_barrier_complete(bar, b.x, nloc, nx); b.st[0] = nloc; b.st[1] = nx; }
        const unsigned old = xb_add(&bar[XB_XSUB(b.x)], 1u);
        const unsigned gen = old / nloc;
        if (old + 1u == (gen + 1u) * nloc) {
            __builtin_amdgcn_fence(__ATOMIC_RELEASE, "agent");
            asm volatile("s_waitcnt vmcnt(0)" ::: "memory");
            const unsigned og = xb_add(&bar[XB_TOP], 1u);
            const unsigned tg = og / nx;
            if (og + 1u == (tg + 1u) * nx) xb_add(&bar[XB_TOPGEN], 1u);
            else XB_SPIN(xb_ld(&bar[XB_TOPGEN]) == tg, bar);
            __builtin_amdgcn_fence(__ATOMIC_ACQUIRE, "agent");
            xb_add(&bar[XB_XGEN(b.x)], 1u);
            asm volatile("s_waitcnt vmcnt(0)" ::: "memory");
        } else {
            XB_SPIN(xb_ld(&bar[XB_XGEN(b.x)]) == gen, bar);
            __builtin_amdgcn_fence(__ATOMIC_ACQUIRE, "agent");
            asm volatile("s_waitcnt vmcnt(0)" ::: "memory");
        }
    }
    __syncthreads();
}

struct Args { const float* in[30]; float* out; unsigned char* ws; int ph_lo, ph_hi, bslot, pad; };
enum { I_X = 0, I_MEM, I_RELB, I_NMIX, I_NMEM, I_NFFN, I_WKV, I_XQN, I_XKN, I_WOUT, I_HYWIN, I_HYCW, I_HYCB, I_FW1, I_FB1, I_FW2, I_FB2, I_FW3, I_FREQ, I_SKIP,
       I_ATWIN, I_ATQN, I_ATKN, I_FFG, I_FFU, I_FFD, I_ROUTER, I_MOEG, I_MOEU, I_MOED };

struct Frame {
    LAS unsigned char* lds;
    unsigned char* ws;
    int tid, lane, wave, G, bid;
};

constexpr int RSL_OFF = 131072;
template <int SCALE> struct EpiB {
    bf16* O; int ldc; const float* sc; int split_tile; bf16* O2; int ldc2; const LAS float* rsl; float kc;
    __device__ __forceinline__ void operator()(const f32x4 (&acc)[2][2][4][2], const pg8::Unit& u, int wr, int wc, int fr, int fq) const {
        const int row0 = u.pm * 256 + wr * 64 + fr;
        bf16* base = O; int ld = ldc; int colt = u.pn * 256;
        if (u.pn >= split_tile) { base = O2; ld = ldc2; colt -= split_tile * 256; }
        if (u.koff != 0) base = O2;
        const int col0 = colt + wc * 32 + 8 * fq;
        float rsv[2][4];
        if (SCALE == 1) {
#pragma unroll
            for (int ai = 0; ai < 2; ++ai)
#pragma unroll
                for (int m = 0; m < 4; ++m) rsv[ai][m] = sc[row0 + ai * 128 + m * 16];
            asm volatile("s_waitcnt vmcnt(0)" ::: "memory");
        }
        f32x4 cs[2][2];
        if (SCALE == 3) {
#pragma unroll
            for (int bj = 0; bj < 2; ++bj)
#pragma unroll
                for (int n = 0; n < 2; ++n) cs[bj][n] = *(const f32x4*)(sc + u.pn * 256 + bj * 128 + wc * 32 + 8 * fq + 4 * n);
            asm volatile("s_waitcnt vmcnt(0)" ::: "memory");
        }
#pragma unroll
        for (int ai = 0; ai < 2; ++ai)
#pragma unroll
            for (int m = 0; m < 4; ++m) {
                const int row = row0 + ai * 128 + m * 16;
                float rs = 1.f;
                if (SCALE == 1) rs = rsv[ai][m];
                if (SCALE == 2) { const f32x4* p = (const f32x4*)(sc + (size_t)row * 16); const f32x4 a = p[0], b = p[1], c = p[2], d = p[3];
                    const float s = ((a.x + a.y) + (a.z + a.w)) + ((b.x + b.y) + (b.z + b.w)) + ((c.x + c.y) + (c.z + c.w)) + ((d.x + d.y) + (d.z + d.w));
                    rs = 1.0f / sqrtf(s * (1.0f / D) + EPS); }
                if (SCALE == 4) rs = rsl[u.idx * 256 + (row - u.pm * 256)];
                if (SCALE == 5) rs = kc;
                bf16* rowp = base + (size_t)row * ld + col0;
#pragma unroll
                for (int bj = 0; bj < 2; ++bj) {
                    f32x4 v0 = acc[ai][bj][m][0], v1 = acc[ai][bj][m][1];
                    if (SCALE == 1 || SCALE == 2 || SCALE == 4 || SCALE == 5) { v0 = v0 * rs; v1 = v1 * rs; }
                    if (SCALE == 3) { v0 = v0 * cs[bj][0]; v1 = v1 * cs[bj][1]; }
                    v4u w; w.x = pk2(v0[0], v0[1]); w.y = pk2(v0[2], v0[3]); w.z = pk2(v1[0], v1[1]); w.w = pk2(v1[2], v1[3]);
                    *(v4u*)(rowp + bj * 128) = w;
                }
            }
    }
};
template <bool XF32, bool SSQ> struct EpiRes {
    const float* xf; const bf16* xi; int ldi; bf16* xo; int ldo; float* ssq16;
    __device__ __forceinline__ void operator()(const f32x4 (&acc)[2][2][4][2], const pg8::Unit& u, int wr, int wc, int fr, int fq) const {
        const int row0 = u.pm * 256 + wr * 64 + fr, col0 = u.pn * 256 + wc * 32 + 8 * fq;
        if constexpr (!XF32) {
            v4u res[2][4][2];
#pragma unroll
            for (int ai = 0; ai < 2; ++ai)
#pragma unroll
                for (int m = 0; m < 4; ++m)
#pragma unroll
                    for (int bj = 0; bj < 2; ++bj) res[ai][m][bj] = *(const v4u*)(xi + (size_t)(row0 + ai * 128 + m * 16) * ldi + col0 + bj * 128);
            asm volatile("s_waitcnt vmcnt(0)" ::: "memory");
#pragma unroll
            for (int ai = 0; ai < 2; ++ai)
#pragma unroll
                for (int m = 0; m < 4; ++m) {
                    const int row = row0 + ai * 128 + m * 16;
                    float ss = 0.f;
#pragma unroll
                    for (int bj = 0; bj < 2; ++bj) {
                        const v4u w0 = res[ai][m][bj];
                        const f32x4 r0 = (f32x4){bflo(w0.x), bfhi(w0.x), bflo(w0.y), bfhi(w0.y)}, r1 = (f32x4){bflo(w0.z), bfhi(w0.z), bflo(w0.w), bfhi(w0.w)};
                        const f32x4 v0 = acc[ai][bj][m][0] + r0, v1 = acc[ai][bj][m][1] + r1;
                        v4u w; w.x = pk2(v0[0], v0[1]); w.y = pk2(v0[2], v0[3]); w.z = pk2(v1[0], v1[1]); w.w = pk2(v1[2], v1[3]);
                        *(v4u*)(xo + (size_t)row * ldo + col0 + bj * 128) = w;
                        if (SSQ) ss += ((v0[0] * v0[0] + v0[1] * v0[1]) + (v0[2] * v0[2] + v0[3] * v0[3])) + ((v1[0] * v1[0] + v1[1] * v1[1]) + (v1[2] * v1[2] + v1[3] * v1[3]));
                    }
                    if (SSQ) { ss += __shfl_xor(ss, 16); ss += __shfl_xor(ss, 32);
                        if (fq == 0) ssq16[(size_t)row * 16 + u.pn * 4 + wc] = ss; }
                }
        } else {
#pragma unroll
            for (int ai = 0; ai < 2; ++ai)
#pragma unroll
                for (int m = 0; m < 4; ++m) {
                    const int row = row0 + ai * 128 + m * 16;
                    float ss = 0.f;
#pragma unroll
                    for (int bj = 0; bj < 2; ++bj) {
                        const size_t off = (size_t)row * D + col0 + bj * 128; const f32x4 r0 = *(const f32x4*)(xf + off), r1 = *(const f32x4*)(xf + off + 4);
                        const f32x4 v0 = acc[ai][bj][m][0] + r0, v1 = acc[ai][bj][m][1] + r1;
                        v4u w; w.x = pk2(v0[0], v0[1]); w.y = pk2(v0[2], v0[3]); w.z = pk2(v1[0], v1[1]); w.w = pk2(v1[2], v1[3]);
                        *(v4u*)(xo + (size_t)row * ldo + col0 + bj * 128) = w;
                        if (SSQ) ss += ((v0[0] * v0[0] + v0[1] * v0[1]) + (v0[2] * v0[2] + v0[3] * v0[3])) + ((v1[0] * v1[0] + v1[1] * v1[1]) + (v1[2] * v1[2] + v1[3] * v1[3]));
                    }
                    if (SSQ) { ss += __shfl_xor(ss, 16); ss += __shfl_xor(ss, 32);
                        if (fq == 0) ssq16[(size_t)row * 16 + u.pn * 4 + wc] = ss; }
                }
        }
    }
};
template <int SCALE, bool OUT8 = false> struct EpiSwiglu {
    bf16* H; int ldh; const float* sc; const LAS float* rsl; float kc;
    __device__ __forceinline__ void operator()(const f32x4 (&acc)[2][2][4][2], const pg8::Unit& u, int wr, int wc, int fr, int fq) const {
        const int row0 = u.pm * 256 + wr * 64 + fr, col0 = u.pn * 128 + wc * 32 + 8 * fq;
#pragma unroll
        for (int ai = 0; ai < 2; ++ai)
#pragma unroll
            for (int m = 0; m < 4; ++m) {
                const int row = row0 + ai * 128 + m * 16;
                float rs = 1.f;
                if (SCALE == 1) rs = sc[row];
                if (SCALE == 2) { const f32x4* p = (const f32x4*)(sc + (size_t)row * 16); const f32x4 a = p[0], b = p[1], c = p[2], d = p[3];
                    const float s = ((a.x + a.y) + (a.z + a.w)) + ((b.x + b.y) + (b.z + b.w)) + ((c.x + c.y) + (c.z + c.w)) + ((d.x + d.y) + (d.z + d.w));
                    rs = 1.0f / sqrtf(s * (1.0f / D) + EPS); }
                if (SCALE == 4) rs = rsl[u.idx * 256 + (row - u.pm * 256)];
                if (SCALE == 5) rs = kc;
                float h[8];
#pragma unroll
                for (int n = 0; n < 2; ++n)
#pragma unroll
                    for (int j = 0; j < 4; ++j) { const float gv = acc[ai][0][m][n][j] * rs, uv = acc[ai][1][m][n][j] * rs;
                        h[n * 4 + j] = gv * uv * __builtin_amdgcn_rcpf(1.0f + __expf(-gv)); }
                if (OUT8) { v2u w; w.x = pk4_fp8(h[0], h[1], h[2], h[3]); w.y = pk4_fp8(h[4], h[5], h[6], h[7]); *(v2u*)((unsigned char*)H + (size_t)row * ldh + col0) = w; }
                else { v4u w; w.x = pk2(h[0], h[1]); w.y = pk2(h[2], h[3]); w.z = pk2(h[4], h[5]); w.w = pk2(h[6], h[7]);
                    *(v4u*)(H + (size_t)row * ldh + col0) = w; }
            }
    }
};

template <class Sched>
__device__ __forceinline__ void fill_rstd_table(LAS unsigned char* lds, const Sched& S, const float* ssq16, int tid) {
    LAS float* rsl = (LAS float*)(lds + RSL_OFF);
    pg8::Unit u;
    for (int ui = 0; ui < 16 && S.next(ui, u); ++ui) {
        if (tid < 256) { const f32x4* p = (const f32x4*)(ssq16 + (size_t)(u.pm * 256 + tid) * 16); const f32x4 a = p[0], b = p[1], c = p[2], d = p[3];
            const float s = ((a.x + a.y) + (a.z + a.w)) + ((b.x + b.y) + (b.z + b.w)) + ((c.x + c.y) + (c.z + c.w)) + ((d.x + d.y) + (d.z + d.w));
            rsl[ui * 256 + tid] = 1.0f / sqrtf(s * (1.0f / D) + EPS); }
    }
    __syncthreads();
}

__device__ __forceinline__ void p0_transpose_item(const float* W, int K, int N, bf16* WT, const float* gain, int mode, LAS float* scr, int item, int lane) {
    const int nblk = N / 64, kb = item / nblk, nb = item % nblk, k0 = 64 * kb, n0 = 64 * nb;
    const int lr = lane >> 4, lc = lane & 15;
    f32x4 v[16];
#pragma unroll
    for (int i = 0; i < 16; ++i) v[i] = __builtin_nontemporal_load((const f32x4*)(W + (size_t)(k0 + 4 * i + lr) * N + n0 + 4 * lc));
    if (gain) {
#pragma unroll
        for (int i = 0; i < 16; ++i) v[i] = v[i] * gain[k0 + 4 * i + lr];
    }
#pragma unroll
    for (int i = 0; i < 16; ++i) { LAS float* s = scr + (4 * i + lr) * 65 + 4 * lc; s[0] = v[i].x; s[1] = v[i].y; s[2] = v[i].z; s[3] = v[i].w; }
    LDS_WAIT(); asm volatile("" ::: "memory");
    const int c = lane & 7;
    const int d0 = (mode == 0) ? n0 : (256 * (n0 / 128) + (n0 % 128) + (mode == 2 ? 128 : 0));
#pragma unroll
    for (int j = 0; j < 8; ++j) { const int n = (lane >> 3) + 8 * j; const LAS float* s = scr + (8 * c) * 65 + n;
        v4u o; o.x = pk2(s[0 * 65], s[1 * 65]); o.y = pk2(s[2 * 65], s[3 * 65]); o.z = pk2(s[4 * 65], s[5 * 65]); o.w = pk2(s[6 * 65], s[7 * 65]);
        *(v4u*)(WT + (size_t)(d0 + n) * K + k0 + 8 * c) = o; }
    LDS_WAIT(); asm volatile("" ::: "memory");
}
__device__ __forceinline__ void p0_transpose_item8(const float* W, int K, int N, unsigned char* WT8, const float* gain, float s8, int mode, LAS float* scr, int item, int lane) {
    const int nblk = N / 64, kb = item / nblk, nb = item % nblk, k0 = 64 * kb, n0 = 64 * nb;
    const int lr = lane >> 4, lc = lane & 15;
    f32x4 v[16];
#pragma unroll
    for (int i = 0; i < 16; ++i) v[i] = __builtin_nontemporal_load((const f32x4*)(W + (size_t)(k0 + 4 * i + lr) * N + n0 + 4 * lc));
#pragma unroll
    for (int i = 0; i < 16; ++i) { const float g = gain ? gain[k0 + 4 * i + lr] * s8 : s8; v[i] = v[i] * g; }
#pragma unroll
    for (int i = 0; i < 16; ++i) { LAS float* s = scr + (4 * i + lr) * 65 + 4 * lc; s[0] = v[i].x; s[1] = v[i].y; s[2] = v[i].z; s[3] = v[i].w; }
    LDS_WAIT(); asm volatile("" ::: "memory");
    const int c = lane & 3;
    const int d0 = (mode == 0) ? n0 : (256 * (n0 / 128) + (n0 % 128) + (mode == 2 ? 128 : 0));
#pragma unroll
    for (int j = 0; j < 4; ++j) { const int n = (lane >> 2) + 16 * j; const LAS float* s = scr + (16 * c) * 65 + n;
        v4u o; o.x = pk4_fp8(s[0 * 65], s[1 * 65], s[2 * 65], s[3 * 65]); o.y = pk4_fp8(s[4 * 65], s[5 * 65], s[6 * 65], s[7 * 65]);
        o.z = pk4_fp8(s[8 * 65], s[9 * 65], s[10 * 65], s[11 * 65]); o.w = pk4_fp8(s[12 * 65], s[13 * 65], s[14 * 65], s[15 * 65]);
        __builtin_nontemporal_store(o, (v4u*)(WT8 + (size_t)(d0 + n) * K + k0 + 16 * c)); }
    LDS_WAIT(); asm volatile("" ::: "memory");
}
__device__ __forceinline__ float row_to_bf16(const float* xrow, bf16* orow, const float* gain, bool normalize, int lane) {
    const f32x4* xr = (const f32x4*)xrow + lane;
    f32x4 v[4]; float s = 0.f;
#pragma unroll
    for (int j = 0; j < 4; ++j) { v[j] = __builtin_nontemporal_load(xr + 64 * j); s += (v[j].x * v[j].x + v[j].y * v[j].y) + (v[j].z * v[j].z + v[j].w * v[j].w); }
    const float rstd = 1.0f / sqrtf(wave_sum(s) * (1.f / D) + EPS);
    unsigned long long* o8 = (unsigned long long*)orow + lane;
#pragma unroll
    for (int j = 0; j < 4; ++j) {
        f32x4 w = v[j];
        if (normalize) { const f32x4 g = ((const f32x4*)gain)[lane + 64 * j]; w = w * rstd * g; }
        o8[64 * j] = (unsigned long long)pk2(w.x, w.y) | ((unsigned long long)pk2(w.z, w.w) << 32);
    }
    return rstd;
}
__device__ __forceinline__ void p0_filter_block(Frame& F, const Args& a, float* Hf, int jb) {
    const float* w1 = a.in[I_FW1]; const float* b1 = a.in[I_FB1]; const float* w2 = a.in[I_FW2]; const float* b2 = a.in[I_FB2]; const float* w3 = a.in[I_FW3]; const float* fr = a.in[I_FREQ];
    LAS float* h2s = (LAS float*)(F.lds + MISC_OFF + 256);
    const int lane = F.lane, j0 = jb * 8;
    LAS float* W1s = (LAS float*)F.lds; LAS float* W2s = W1s + 33 * 64;
    for (int i = F.tid; i < 33 * 64; i += 512) W1s[i] = w1[i];
    for (int i = F.tid; i < 64 * 64; i += 512) W2s[i] = w2[i];
    __syncthreads();
    {
        const int j = j0 + F.wave;
        const float freq = fr[lane], bb1 = b1[lane], bb2 = b2[lane];
        float feat = 0.f;
        {
            const int fi = (lane >= 17) ? lane - 17 : lane - 1;
            const float f = 1e-4f + (float)fi * ((15.0f - 1e-4f) / 15.0f);
            const float ang = (6.283185307179586f / 2048.0f) * (float)j * f;
            if (lane == 0) feat = (float)j * (1.0f / 2047.0f);
            else if (lane <= 16) feat = cosf(ang);
            else if (lane <= 32) feat = -sinf(ang);
        }
        float s1 = bb1;
#pragma unroll
        for (int i = 0; i < 33; ++i) s1 += __shfl(feat, i) * W1s[i * 64 + lane];
        const float h1 = sinf(freq * s1);
        float s2 = bb2;
#pragma unroll 16
        for (int i = 0; i < 64; ++i) s2 += __shfl(h1, i) * W2s[i * 64 + lane];
        h2s[lane * 8 + F.wave] = sinf(freq * s2);
    }
    __syncthreads();
    const int n0 = F.wave * 256;
    float acc[4][8];
#pragma unroll
    for (int q = 0; q < 4; ++q)
#pragma unroll
        for (int jj = 0; jj < 8; ++jj) acc[q][jj] = 0.f;
#pragma unroll 1
    for (int i0 = 0; i0 < 64; i0 += 8) {
        float w[8][4];
#pragma unroll
        for (int ii = 0; ii < 8; ++ii)
#pragma unroll
            for (int q = 0; q < 4; ++q) w[ii][q] = w3[(size_t)(i0 + ii) * 2048 + n0 + q * 64 + lane];
#pragma unroll
        for (int ii = 0; ii < 8; ++ii) {
            const f32x4 ha = *(const LAS f32x4*)(h2s + (i0 + ii) * 8), hb = *(const LAS f32x4*)(h2s + (i0 + ii) * 8 + 4);
#pragma unroll
            for (int q = 0; q < 4; ++q) {
                acc[q][0] += ha.x * w[ii][q]; acc[q][1] += ha.y * w[ii][q]; acc[q][2] += ha.z * w[ii][q]; acc[q][3] += ha.w * w[ii][q];
                acc[q][4] += hb.x * w[ii][q]; acc[q][5] += hb.y * w[ii][q]; acc[q][6] += hb.z * w[ii][q]; acc[q][7] += hb.w * w[ii][q]; }
        }
    }
    const float da = -3.0701134573253945f, db = -15.350567286626973f;
#pragma unroll
    for (int q = 0; q < 4; ++q) {
        const int n = n0 + q * 64 + lane, c = n & 511;
        const float delta = fabsf(da + (db - da) * ((float)c * (1.0f / 511.0f)));
        float o[8];
#pragma unroll
        for (int jj = 0; jj < 8; ++jj) { const float t = (float)(j0 + jj) * (1.0f / 2047.0f); o[jj] = acc[q][jj] * (expf(-t * delta) + 0.05f); }
        f32x4* dst = (f32x4*)(Hf + (size_t)n * 2048 + j0);
        dst[0] = (f32x4){o[0], o[1], o[2], o[3]}; dst[1] = (f32x4){o[4], o[5], o[6], o[7]};
    }
    __syncthreads();
}
constexpr int IT_MOE = 16 * 44, N_MOE_ITEMS = 24 * IT_MOE;
constexpr int MOE_P1_HI = 5376, MOE_P5_HI = 16896, MOE_P0_LO = MOE_P5_HI;
__device__ __forceinline__ void moe_convert(Frame& F, const Args& a, int lo, int hi, int gwl, int ngw) {
    LAS float* scr = (LAS float*)(F.lds + F.wave * 16640);
    unsigned char* ws = F.ws;
    for (int r = lo + gwl; r < hi; r += ngw) {
        const int mid = r / IT_MOE, li = r % IT_MOE, kind = mid >> 3, e = mid & 7;
        if (kind == 0) p0_transpose_item8(a.in[I_MOEG] + (size_t)e * D * FF, D, FF, ws + WS_WGU1 + (size_t)e * NGU * D, a.in[I_NFFN] + D, MOE_WGU_SCALE, 1, scr, li, F.lane);
        else if (kind == 1) p0_transpose_item8(a.in[I_MOEU] + (size_t)e * D * FF, D, FF, ws + WS_WGU1 + (size_t)e * NGU * D, a.in[I_NFFN] + D, MOE_WGU_SCALE, 2, scr, li, F.lane);
        else p0_transpose_item8(a.in[I_MOED] + (size_t)e * FF * D, FF, D, ws + WS_WD1 + (size_t)e * D * FF, nullptr, MOE_WD_SCALE, 0, scr, li, F.lane);
    }
}
__device__ __forceinline__ void p0_prologue(Frame& F, const Args& a) {
    LAS float* scr = (LAS float*)(F.lds + F.wave * 16640);
    const int gw = F.bid * NWAVES + F.wave, NGW = F.G * NWAVES;
    unsigned char* ws = F.ws;
    if (!(F.bid & 1)) { for (int jb = F.bid; jb < 256; jb += F.G) p0_filter_block(F, a, (float*)(ws + WS_HF), jb); }
    for (int m = gw; m < T; m += NGW) { const float r = row_to_bf16(a.in[I_X] + (size_t)m * D, (bf16*)(ws + WS_XB) + (size_t)m * D, nullptr, false, F.lane); if (F.lane == 0) ((float*)(ws + WS_RSTD0))[m] = r; }
    for (int m = gw; m < 2 * TM; m += NGW) { const int l = m / TM, r = m % TM;
        (void)row_to_bf16(a.in[I_MEM] + (size_t)r * D, (bf16*)(ws + WS_MN) + (size_t)m * D, a.in[I_NMEM] + l * D, true, F.lane); }
    constexpr int IT_A = 16 * 32, IT_SQ = 16 * 16, IT_G = 16 * 44, IT_D = 44 * 16, IT_W1 = 16 * 80;
    constexpr int NSMALL = IT_A + 4 * IT_SQ + 2 * IT_G + IT_D + IT_W1;
    for (int it = gw; it < NSMALL; it += NGW) {
        int r = it;
        if (r < IT_A) { p0_transpose_item(a.in[I_HYWIN], D, NZ0, (bf16*)(ws + WS_WIN0), a.in[I_NMIX], 0, scr, r, F.lane); continue; } r -= IT_A;
        if (r < IT_SQ) { p0_transpose_item(a.in[I_WKV], D, D, (bf16*)(ws + WS_WKV), nullptr, 0, scr, r, F.lane); continue; } r -= IT_SQ;
        if (r < IT_SQ) { p0_transpose_item(a.in[I_WKV] + (size_t)D * D, D, D, (bf16*)(ws + WS_WKV) + (size_t)D * D, nullptr, 0, scr, r, F.lane); continue; } r -= IT_SQ;
        if (r < IT_SQ) { p0_transpose_item(a.in[I_WOUT], D, D, (bf16*)(ws + WS_WO), nullptr, 0, scr, r, F.lane); continue; } r -= IT_SQ;
        if (r < IT_SQ) { p0_transpose_item(a.in[I_WOUT] + (size_t)D * D, D, D, (bf16*)(ws + WS_WO) + (size_t)D * D, nullptr, 0, scr, r, F.lane); continue; } r -= IT_SQ;
        if (r < IT_G) { p0_transpose_item(a.in[I_FFG], D, FF, (bf16*)(ws + WS_WGU0), a.in[I_NFFN], 1, scr, r, F.lane); continue; } r -= IT_G;
        if (r < IT_G) { p0_transpose_item(a.in[I_FFU], D, FF, (bf16*)(ws + WS_WGU0), a.in[I_NFFN], 2, scr, r, F.lane); continue; } r -= IT_G;
        if (r < IT_D) { p0_transpose_item(a.in[I_FFD], FF, D, (bf16*)(ws + WS_WD0), nullptr, 0, scr, r, F.lane); continue; } r -= IT_D;
        p0_transpose_item(a.in[I_ATWIN], D, NQ1, (bf16*)(ws + WS_WIN1), a.in[I_NMIX] + D, 0, scr, r, F.lane);
    }
    moe_convert(F, a, (F.G == 256) ? MOE_P0_LO : 0, N_MOE_ITEMS, gw, NGW);
    if (F.bid & 1) { __syncthreads(); for (int jb = F.bid; jb < 256; jb += F.G) p0_filter_block(F, a, (float*)(ws + WS_HF), jb); }
}
__device__ __forceinline__ float block_sum(Frame& F, float v) {
    LAS float* red = (LAS float*)(F.lds + MISC_OFF + 64);
    v = wave_sum(v);
    __syncthreads();
    if (F.lane == 0) red[F.wave] = v;
    __syncthreads();
    float s = 0.f;
#pragma unroll
    for (int w = 0; w < NWAVES; ++w) s += red[w];
    return s;
}
__device__ __forceinline__ int rel_bucket_dev(int rel) {
    const int n = rel < 0 ? -rel : rel;
    const int large = 8 + (n >= 15) + (n >= 27) + (n >= 50) + (n >= 91) + (n >= 166) + (n >= 305) + (n >= 559);
    return (rel > 0 ? 16 : 0) + (n < 8 ? n : large);
}
__device__ __forceinline__ void merge_token(Frame& F, int token) {
    const bf16* og = (const bf16*)(F.ws + WS_OG12); const float* lse = (const float*)(F.ws + WS_LSE);
    bf16* mix = (bf16*)(F.ws + WS_MIX1);
    const int lane = F.lane, h = lane >> 4;
    const float l0 = lse[(size_t)token * 4 + h], l1 = lse[((size_t)T + token) * 4 + h], l2 = lse[((size_t)2 * T + token) * 4 + h];
    const float mx = fmaxf(l0, fmaxf(l1, l2));
    float w0 = __expf(l0 - mx), w1 = __expf(l1 - mx), w2 = __expf(l2 - mx);
    const float iz = 1.0f / (w0 + w1 + w2); w0 *= iz; w1 *= iz; w2 *= iz;
    const v4u a0 = *(const v4u*)(mix + (size_t)token * D + 8 * lane);
    const v4u a1 = __builtin_nontemporal_load((const v4u*)(og + (size_t)token * 512 + 8 * lane));
    const v4u a2 = __builtin_nontemporal_load((const v4u*)(og + ((size_t)T + token) * 512 + 8 * lane));
    v4u o;
    o.x = pk2(w0 * bflo(a0.x) + w1 * bflo(a1.x) + w2 * bflo(a2.x), w0 * bfhi(a0.x) + w1 * bfhi(a1.x) + w2 * bfhi(a2.x));
    o.y = pk2(w0 * bflo(a0.y) + w1 * bflo(a1.y) + w2 * bflo(a2.y), w0 * bfhi(a0.y) + w1 * bfhi(a1.y) + w2 * bfhi(a2.y));
    o.z = pk2(w0 * bflo(a0.z) + w1 * bflo(a1.z) + w2 * bflo(a2.z), w0 * bfhi(a0.z) + w1 * bfhi(a1.z) + w2 * bfhi(a2.z));
    o.w = pk2(w0 * bflo(a0.w) + w1 * bflo(a1.w) + w2 * bflo(a2.w), w0 * bfhi(a0.w) + w1 * bfhi(a1.w) + w2 * bfhi(a2.w));
    *(v4u*)(mix + (size_t)token * D + 8 * lane) = o;
}

constexpr int RT_OFF_R = 0, RT_OFF_REC = 32768, RT_OFF_CNT = 32768 + 64 * 32;
__device__ __forceinline__ void route_block(Frame& F, const Args& a, int blk) {
    LAS float* RL = (LAS float*)(F.lds + RT_OFF_R); volatile LAS int* REC = (volatile LAS int*)(F.lds + RT_OFF_REC); LAS int* CNT = (LAS int*)(F.lds + RT_OFF_CNT);
    const int lane = F.lane;
    const float* g = a.in[I_NFFN] + D; const float* rt = a.in[I_ROUTER];
    __syncthreads();
    for (int i = F.tid; i < 2048; i += 512) { const f32x4 r = ((const f32x4*)rt)[i]; const float gg = g[i >> 1]; ((LAS f32x4*)RL)[i] = r * gg; }
    if (F.tid < 16) CNT[F.tid] = 0;
    __syncthreads();
    for (int q = 0; q < 8; ++q) {
        const int tl = F.wave * 8 + q, token = blk * 64 + tl;
        const bf16* xr = (const bf16*)a.out + (size_t)token * 2048 + 1024;
        f32x4 v[4]; float s = 0.f;
#pragma unroll
        for (int j = 0; j < 4; ++j) { const v2u w = __builtin_nontemporal_load((const v2u*)xr + lane + 64 * j); v[j] = (f32x4){bflo(w.x), bfhi(w.x), bflo(w.y), bfhi(w.y)}; s += (v[j].x * v[j].x + v[j].y * v[j].y) + (v[j].z * v[j].z + v[j].w * v[j].w); }
        const float rstd = 1.0f / sqrtf(wave_sum(s) * (1.f / D) + EPS);
        { unsigned* o4 = (unsigned*)(F.ws + WS_XB3 + (size_t)token * D) + lane;
#pragma unroll
          for (int j = 0; j < 4; ++j) o4[64 * j] = pk4_fp8(v[j].x * rstd, v[j].y * rstd, v[j].z * rstd, v[j].w * rstd); }
        float lg[8];
#pragma unroll
        for (int e = 0; e < 8; ++e) lg[e] = 0.f;
#pragma unroll
        for (int j = 0; j < 4; ++j) {
            const int k0 = 4 * (lane + 64 * j);
#pragma unroll
            for (int qq = 0; qq < 4; ++qq) {
                const float hn = v[j][qq] * rstd;
                const f32x4 r0 = *(const LAS f32x4*)(RL + (k0 + qq) * 8), r1 = *(const LAS f32x4*)(RL + (k0 + qq) * 8 + 4);
                lg[0] += hn * r0.x; lg[1] += hn * r0.y; lg[2] += hn * r0.z; lg[3] += hn * r0.w;
                lg[4] += hn * r1.x; lg[5] += hn * r1.y; lg[6] += hn * r1.z; lg[7] += hn * r1.w;
            }
        }
#pragma unroll
        for (int e = 0; e < 8; ++e) lg[e] = wave_sum(lg[e]);
        int i1 = 0; float v1 = lg[0];
#pragma unroll
        for (int e = 1; e < 8; ++e) if (lg[e] > v1) { v1 = lg[e]; i1 = e; }
        int i2 = -1; float v2 = -3.0e38f;
#pragma unroll
        for (int e = 0; e < 8; ++e) if (e != i1 && lg[e] > v2) { v2 = lg[e]; i2 = e; }
        const float e2 = __expf(v2 - v1), g1 = 1.0f / (1.0f + e2), g2 = e2 * g1;
        if (lane == 0) {
            const int r1 = __hip_atomic_fetch_add(CNT + i1, 1, __ATOMIC_RELAXED, __HIP_MEMORY_SCOPE_WORKGROUP);
            const int r2 = __hip_atomic_fetch_add(CNT + i2, 1, __ATOMIC_RELAXED, __HIP_MEMORY_SCOPE_WORKGROUP);
            REC[tl * 8 + 0] = i1; REC[tl * 8 + 1] = i2; REC[tl * 8 + 2] = r1; REC[tl * 8 + 3] = r2;
            REC[tl * 8 + 4] = __builtin_bit_cast(int, g1); REC[tl * 8 + 5] = __builtin_bit_cast(int, g2); REC[tl * 8 + 6] = __builtin_bit_cast(int, rstd);
        }
    }
    __syncthreads();
    if (F.tid < 8) { unsigned* cnt = (unsigned*)(F.ws + WS_CTL) + CW_CNT; CNT[8 + F.tid] = (int)__hip_atomic_fetch_add(cnt + F.tid, (unsigned)CNT[F.tid], __ATOMIC_RELAXED, __HIP_MEMORY_SCOPE_AGENT); }
    __syncthreads();
    if (F.tid < 64) {
        const int tl = F.tid, token = blk * 64 + tl;
        const int i1 = REC[tl * 8 + 0], i2 = REC[tl * 8 + 1], r1 = CNT[8 + i1] + REC[tl * 8 + 2], r2 = CNT[8 + i2] + REC[tl * 8 + 3];
        int* toke = (int*)(F.ws + WS_TOKE); int* tokr = (int*)(F.ws + WS_TOKR); int* tokg = (int*)(F.ws + WS_TOKG); int* list = (int*)(F.ws + WS_LIST);
        list[(size_t)i1 * T + r1] = token; list[(size_t)i2 * T + r2] = token;
        toke[token * 2] = i1; toke[token * 2 + 1] = i2; tokr[token * 2] = r1; tokr[token * 2 + 1] = r2;
        tokg[token * 2] = REC[tl * 8 + 4]; tokg[token * 2 + 1] = REC[tl * 8 + 5];
        ((int*)(F.ws + WS_RSTD3))[token] = REC[tl * 8 + 6];
    }
}
__device__ __forceinline__ void moe_layout(Frame& F) {
    volatile LAS int* M = (volatile LAS int*)(F.lds + MISC_OFF);
    __syncthreads();
    if (F.tid == 0) {
        const unsigned* cnt = (const unsigned*)(F.ws + WS_CTL) + CW_CNT;
        int acc = 0;
        for (int e = 0; e < 8; ++e) { const int c = (int)__hip_atomic_load(cnt + e, __ATOMIC_RELAXED, __HIP_MEMORY_SCOPE_AGENT); M[32 + e] = c; M[40 + e] = acc; acc += (c + 255) & ~255; }
        M[48] = acc;
    }
    __syncthreads();
}
__device__ __forceinline__ int ml_ps(Frame& F, int e) { return ((volatile LAS int*)(F.lds + MISC_OFF))[40 + e]; }
__device__ __forceinline__ int ml_cnt(Frame& F, int e) { return ((volatile LAS int*)(F.lds + MISC_OFF))[32 + e]; }
__device__ __forceinline__ int ml_total(Frame& F) { return ((volatile LAS int*)(F.lds + MISC_OFF))[48]; }
__device__ __forceinline__ int ml_expert(Frame& F, int slot) { int e = 0;
#pragma unroll
    for (int i = 1; i < 8; ++i) e += (slot >= ml_ps(F, i)) ? 1 : 0;
    return e; }

constexpr int HY_CS = 4168, HY_M0 = 2080, HY_UR = 2592, HY_UP = 256;
constexpr int HY_OFF_CP = 64, HY_OFF_UB = HY_OFF_CP + 8 * HY_CS * 2, HY_OFF_X = HY_OFF_UB + 8 * HY_UR * 2;
static_assert(HY_OFF_X + 8 * 2048 * 2 <= SCR_BYTES, "hyena LDS");
typedef short bf16x8_t __attribute__((ext_vector_type(8)));

struct HyStage { v4u raw[4]; float zm[4], zp[4]; };
struct HyFilt { float f[4], b[4]; };
__device__ __forceinline__ void hy_short_load(HyStage& s, const bf16* zr, int tid) {
#pragma unroll
    for (int k = 0; k < 4; ++k) {
        const int item = tid + 512 * k, b = item >> 8, t8 = (item & 255) * 8;
        const bf16* p = zr + b * SEQ + t8;
        s.raw[k] = __builtin_nontemporal_load((const v4u*)p);
        s.zm[k] = (t8 > 0) ? bf1(p[-1]) : 0.f; s.zp[k] = (t8 + 8 < SEQ) ? bf1(p[8]) : 0.f;
    }
}
__device__ __forceinline__ void hy_short_store(LAS unsigned char* dst, int stride_el, int pad_el, const HyStage& s, float w0, float w1, float w2, float cb, int tid) {
#pragma unroll
    for (int k = 0; k < 4; ++k) {
        const int item = tid + 512 * k, b = item >> 8, t8 = (item & 255) * 8;
        float z[10];
        z[0] = s.zm[k]; z[1] = bflo(s.raw[k].x); z[2] = bfhi(s.raw[k].x); z[3] = bflo(s.raw[k].y); z[4] = bfhi(s.raw[k].y); z[5] = bflo(s.raw[k].z); z[6] = bfhi(s.raw[k].z); z[7] = bflo(s.raw[k].w); z[8] = bfhi(s.raw[k].w); z[9] = s.zp[k];
        float o[8];
#pragma unroll
        for (int i = 0; i < 8; ++i) o[i] = cb + z[i] * w0 + z[i + 1] * w1 + z[i + 2] * w2;
        v4u w; w.x = pk2(o[0], o[1]); w.y = pk2(o[2], o[3]); w.z = pk2(o[4], o[5]); w.w = pk2(o[6], o[7]);
        *(LAS v4u*)(dst + (size_t)(b * stride_el + pad_el + t8) * 2) = w;
    }
}
__device__ __forceinline__ void hy_filt_load(HyFilt& q, const float* Hf, int o, int c, int tid) {
    const float* fw = Hf + ((size_t)(o * 2 + 0) * 512 + c) * 2048;
    const float* bw = Hf + ((size_t)(o * 2 + 1) * 512 + c) * 2048;
#pragma unroll
    for (int i = 0; i < 4; ++i) { const int j = tid + 512 * i; q.f[i] = __builtin_nontemporal_load(fw + j); q.b[i] = (j >= 1) ? __builtin_nontemporal_load(bw + j) : 0.f; }
}
__device__ __forceinline__ void hy_filt_build(Frame& F, const HyFilt& q) {
    LAS float* Kf = (LAS float*)(F.lds + HY_OFF_X);
    float s = 0.f;
#pragma unroll
    for (int i = 0; i < 4; ++i) s += fabsf(q.f[i]) + fabsf(q.b[i]);
    const float tot = block_sum(F, s);
    const float inv = 1.0f / (tot + 1e-6f);
#pragma unroll
    for (int i = 0; i < 4; ++i) { const int j = F.tid + 512 * i; Kf[HY_M0 - j] = q.f[i] * inv; if (j >= 1) Kf[HY_M0 + j] = q.b[i] * inv; }
    if (F.tid < 33) Kf[F.tid] = 0.f;
    if (F.tid < 48) Kf[4128 + F.tid] = 0.f;
    __syncthreads();
    LAS unsigned* cp = (LAS unsigned*)(F.lds + HY_OFF_CP);
    for (int p = F.tid; p < 8 * (HY_CS / 2); p += 512) { const int j = p / (HY_CS / 2), xp = p - j * (HY_CS / 2), x = 2 * xp + j; cp[p] = pk2(Kf[x], Kf[x + 1]); }
    __syncthreads();
}
__device__ __forceinline__ void hy_conv_mfma(Frame& F, f32x4 (&C)[8]) {
    const int lane = F.lane, w = F.wave, r = lane & 15, kq = lane >> 4;
    const int jc = (-r) & 7, cr = (r + 7) >> 3;
    const LAS unsigned char* abase = F.lds + HY_OFF_CP + (size_t)(jc * HY_CS + HY_M0 - 32 * (8 * w - 63) + 8 * kq - 8 * cr) * 2;
    const LAS unsigned char* bbase = F.lds + HY_OFF_UB + (size_t)((r & 7) * HY_UR + HY_UP + 16 * (r >> 3) + 8 * kq) * 2;
#pragma unroll
    for (int i = 0; i < 8; ++i) C[i] = (f32x4){0.f, 0.f, 0.f, 0.f};
    bf16x8_t Bw[9];
#pragma unroll
    for (int i = 0; i < 8; ++i) Bw[i] = *(const LAS bf16x8_t*)(bbase + 64 * (63 + i));
    bf16x8_t An = *(const LAS bf16x8_t*)(abase);
#pragma unroll 1
    for (int Q = 0; Q < 8; ++Q) {
        const LAS unsigned char* ab = abase - 64 * (9 * Q);
        const LAS unsigned char* bb = bbase + 64 * (63 - 9 * Q);
#pragma unroll
        for (int qq = 0; qq < 9; ++qq) {
            const bf16x8_t A = An;
            An = *(const LAS bf16x8_t*)(ab - 64 * (qq + 1));
            Bw[(8 - qq + 9) % 9] = *(const LAS bf16x8_t*)(bb + 64 * (-1 - qq));
#pragma unroll
            for (int i = 7; i >= 0; --i) C[i] = __builtin_amdgcn_mfma_f32_16x16x32_bf16(A, Bw[(i - qq + 9) % 9], C[i], 0, 0, 0);
        }
    }
}
__device__ __forceinline__ void hyena_units(Frame& F, const Args& a) {
    const bf16* zT = (const bf16*)(F.ws + WS_ZT);
    const float* Hf = (const float*)(F.ws + WS_HF);
    const float* cw = a.in[I_HYCW]; const float* cbp = a.in[I_HYCB]; const float* skip = a.in[I_SKIP];
    bf16* yT = (bf16*)(F.ws + WS_YT);
    LAS unsigned char* UB = F.lds + HY_OFF_UB; LAS unsigned char* XB = F.lds + HY_OFF_X;
    int c = F.bid; if (c >= HYC) return;
    HyStage sA, sC, sG; HyFilt fB, fF;
    hy_short_load(sA, zT + (size_t)c * T, F.tid); hy_filt_load(fB, Hf, 0, c, F.tid); hy_short_load(sC, zT + (size_t)(HYC + c) * T, F.tid);
#pragma unroll 1
    for (;;) {
        const int lane = F.lane, w = F.wave, n = lane & 15, bb = n & 7, hh = n >> 3, rq = lane >> 4;
        __syncthreads();
        for (int p = F.tid; p < 8 * 272; p += 512) { const int b = p / 272, q = p - b * 272; const int el = (q < 128) ? 2 * q : (HY_UP + SEQ + 2 * (q - 128)); *(LAS unsigned*)(UB + (size_t)(b * HY_UR + el) * 2) = 0u; }
        { const int ch = c; hy_short_store(UB, HY_UR, HY_UP, sA, cw[ch], cw[1536 + ch], cw[3072 + ch], cbp[ch], F.tid); }
        hy_filt_build(F, fB);
        { const int ch = HYC + c; hy_short_store(XB, SEQ, 0, sC, cw[ch], cw[1536 + ch], cw[3072 + ch], cbp[ch], F.tid); }
        hy_filt_load(fF, Hf, 1, c, F.tid); hy_short_load(sG, zT + (size_t)(2 * HYC + c) * T, F.tid);
        __syncthreads();
        f32x4 C[8];
        hy_conv_mfma(F, C);
        __syncthreads();
        {   const float sk = skip[c];
#pragma unroll
            for (int i = 0; i < 8; ++i) {
                const int t0 = 32 * (8 * w + i) + 16 * hh + 4 * rq;
                LAS v2u* up = (LAS v2u*)(UB + (size_t)(bb * HY_UR + HY_UP + t0) * 2);
                const v2u uu = *up; const v2u xx = *(const LAS v2u*)(XB + (size_t)(bb * SEQ + t0) * 2);
                v2u o;
                o.x = pk2(bflo(xx.x) * (C[i][0] + bflo(uu.x) * sk), bfhi(xx.x) * (C[i][1] + bfhi(uu.x) * sk));
                o.y = pk2(bflo(xx.y) * (C[i][2] + bflo(uu.y) * sk), bfhi(xx.y) * (C[i][3] + bfhi(uu.y) * sk));
                *up = o;
            }
        }
        __syncthreads();
        hy_filt_build(F, fF);
        { const int ch = 2 * HYC + c; hy_short_store(XB, SEQ, 0, sG, cw[ch], cw[1536 + ch], cw[3072 + ch], cbp[ch], F.tid); }
        const int cn = c + F.G; const bool more = cn < HYC;
        if (more) { hy_short_load(sA, zT + (size_t)cn * T, F.tid); hy_filt_load(fB, Hf, 0, cn, F.tid); hy_short_load(sC, zT + (size_t)(HYC + cn) * T, F.tid); }
        __syncthreads();
        hy_conv_mfma(F, C);
        {   const float sk = skip[HYC + c];
#pragma unroll
            for (int i = 0; i < 8; ++i) {
                const int t0 = 32 * (8 * w + i) + 16 * hh + 4 * rq;
                const v2u uu = *(const LAS v2u*)(UB + (size_t)(bb * HY_UR + HY_UP + t0) * 2); const v2u xx = *(const LAS v2u*)(XB + (size_t)(bb * SEQ + t0) * 2);
                v2u o;
                o.x = pk2(bflo(xx.x) * (C[i][0] + bflo(uu.x) * sk), bfhi(xx.x) * (C[i][1] + bfhi(uu.x) * sk));
                o.y = pk2(bflo(xx.y) * (C[i][2] + bflo(uu.y) * sk), bfhi(xx.y) * (C[i][3] + bfhi(uu.y) * sk));
                *(v2u*)(yT + (size_t)c * T + bb * SEQ + t0) = o;
            }
        }
        if (!more) break;
        c = cn;
    }
}
__device__ __forceinline__ void hy_transpose_tile(Frame& F, int tile) {
    const bf16* yT = (const bf16*)(F.ws + WS_YT); bf16* mix = (bf16*)(F.ws + WS_MIX0);
    LAS unsigned* scr = (LAS unsigned*)(F.lds + F.wave * (64 * 36 * 4));
    const int lane = F.lane, ct = tile & 7, tt = tile >> 3, c0 = 64 * ct, tok0 = 64 * tt;
    const int rr = lane >> 3, ch = lane & 7;
    v4u raw[8];
#pragma unroll
    for (int i = 0; i < 8; ++i) raw[i] = __builtin_nontemporal_load((const v4u*)(yT + (size_t)(c0 + 8 * i + rr) * T + tok0 + 8 * ch));
#pragma unroll
    for (int i = 0; i < 8; ++i) {
        v4u o; o.x = __shfl_xor(raw[i].x, 8); o.y = __shfl_xor(raw[i].y, 8); o.z = __shfl_xor(raw[i].z, 8); o.w = __shfl_xor(raw[i].w, 8);
        const bool odd = rr & 1;
        const unsigned a0 = odd ? o.z : raw[i].x, a1 = odd ? o.w : raw[i].y;
        const unsigned b0 = odd ? raw[i].z : o.x, b1 = odd ? raw[i].w : o.y;
        const int cp = (8 * i + (rr & ~1)) >> 1;
        const int tb = 8 * ch + (odd ? 4 : 0);
        scr[(tb + 0) * 36 + cp] = (a0 & 0xffffu) | (b0 << 16);
        scr[(tb + 1) * 36 + cp] = (a0 >> 16) | (b0 & 0xffff0000u);
        scr[(tb + 2) * 36 + cp] = (a1 & 0xffffu) | (b1 << 16);
        scr[(tb + 3) * 36 + cp] = (a1 >> 16) | (b1 & 0xffff0000u);
    }
    LDS_WAIT(); asm volatile("" ::: "memory");
#pragma unroll
    for (int i = 0; i < 8; ++i) { const int tk = 8 * i + rr; const v4u w = *(const LAS v4u*)(scr + tk * 36 + 4 * ch);
        *(v4u*)(mix + (size_t)(tok0 + tk) * D + c0 + 8 * ch) = w; }
    LDS_WAIT(); asm volatile("" ::: "memory");
}

constexpr int AT_KSTR = 136;
template <int NT, bool DIL>
__device__ __forceinline__ void attn_wave16(const LAS unsigned char* Ks, const LAS unsigned char* VT, int vstr, int k0, const bf16* qrow, const LAS float* bt, int dil, int relbase, int lbase, int L,
                                            bf16* orow, float* lse_out, int lane) {
    const int r = lane & 15, rq = lane >> 4;
    bf16x8_t Qf[4];
    {
        v4u raw[4]; float ss = 0.f;
#pragma unroll
        for (int st = 0; st < 4; ++st) { raw[st] = *(const v4u*)(qrow + 32 * st + 8 * rq);
            const float a0 = bflo(raw[st].x), a1 = bfhi(raw[st].x), a2 = bflo(raw[st].y), a3 = bfhi(raw[st].y), a4 = bflo(raw[st].z), a5 = bfhi(raw[st].z), a6 = bflo(raw[st].w), a7 = bfhi(raw[st].w);
            ss += (a0 * a0 + a1 * a1) + (a2 * a2 + a3 * a3) + (a4 * a4 + a5 * a5) + (a6 * a6 + a7 * a7); }
        ss += __shfl_xor(ss, 16); ss += __shfl_xor(ss, 32);
        const float sc = 0.08838834764831845f / sqrtf(ss * (1.f / 128.f) + EPS);
#pragma unroll
        for (int st = 0; st < 4; ++st) { v4u w;
            w.x = pk2(bflo(raw[st].x) * sc, bfhi(raw[st].x) * sc); w.y = pk2(bflo(raw[st].y) * sc, bfhi(raw[st].y) * sc);
            w.z = pk2(bflo(raw[st].z) * sc, bfhi(raw[st].z) * sc); w.w = pk2(bflo(raw[st].w) * sc, bfhi(raw[st].w) * sc);
            Qf[st] = __builtin_bit_cast(bf16x8_t, w); }
    }
    f32x4 S[NT];
    const LAS unsigned char* kb = Ks + (size_t)(k0 + r) * (AT_KSTR * 2) + 16 * rq;
#pragma unroll
    for (int kt = 0; kt < NT; ++kt) {
        f32x4 acc = (f32x4){0.f, 0.f, 0.f, 0.f};
#pragma unroll
        for (int st = 0; st < 4; ++st) { const bf16x8_t A = *(const LAS bf16x8_t*)(kb + kt * 16 * (AT_KSTR * 2) + 64 * st); acc = __builtin_amdgcn_mfma_f32_16x16x32_bf16(A, Qf[st], acc, 0, 0, 0); }
        S[kt] = acc;
        asm volatile("" ::: "memory");
    }
    float mx = -3.0e38f;
#pragma unroll
    for (int kt = 0; kt < NT; ++kt)
#pragma unroll
        for (int g = 0; g < 4; ++g) {
            float s = S[kt][g];
            if (DIL) { const int rel = relbase + 16 * kt + g, lk = lbase + 16 * kt + g; const bool ok = (lk >= 0) && (lk < L);
                s = ok ? s + bt[rel + 128] : -3.0e38f; S[kt][g] = s; }
            mx = fmaxf(mx, s);
        }
    mx = fmaxf(mx, __shfl_xor(mx, 16)); mx = fmaxf(mx, __shfl_xor(mx, 32));
    float z = 0.f;
#pragma unroll
    for (int kt = 0; kt < NT; ++kt)
#pragma unroll
        for (int g = 0; g < 4; ++g) { const float p = __expf(S[kt][g] - mx); S[kt][g] = p; z += p; }
    z += __shfl_xor(z, 16); z += __shfl_xor(z, 32);
    const float iz = 1.0f / z;
    bf16x8_t Pf[NT / 2];
#pragma unroll
    for (int ks = 0; ks < NT / 2; ++ks) { v4u w; w.x = pk2(S[2 * ks][0], S[2 * ks][1]); w.y = pk2(S[2 * ks][2], S[2 * ks][3]); w.z = pk2(S[2 * ks + 1][0], S[2 * ks + 1][1]); w.w = pk2(S[2 * ks + 1][2], S[2 * ks + 1][3]);
        Pf[ks] = __builtin_bit_cast(bf16x8_t, w); }
    const LAS unsigned char* vb = VT + ((size_t)r * vstr + k0 + 4 * rq) * 2;
#pragma unroll
    for (int dt = 0; dt < 8; ++dt) {
        f32x4 o = (f32x4){0.f, 0.f, 0.f, 0.f};
#pragma unroll
        for (int ks = 0; ks < NT / 2; ++ks) {
            const LAS unsigned char* p = vb + (size_t)dt * 16 * vstr * 2 + 64 * ks;
            const v2u lo = *(const LAS v2u*)p, hi = *(const LAS v2u*)(p + 32);
            v4u w; w.x = lo.x; w.y = lo.y; w.z = hi.x; w.w = hi.y;
            o = __builtin_amdgcn_mfma_f32_16x16x32_bf16(__builtin_bit_cast(bf16x8_t, w), Pf[ks], o, 0, 0, 0);
        }
        v2u ow; ow.x = pk2(o[0] * iz, o[1] * iz); ow.y = pk2(o[2] * iz, o[3] * iz);
        *(v2u*)(orow + 16 * dt + 4 * rq) = ow;
        asm volatile("" ::: "memory");
    }
    if (DIL) { if (rq == 0) *lse_out = mx + logf(z); }
}
template <int NB, int BS, class RowFn>
__device__ __forceinline__ void attn_stage_k(LAS unsigned char* Ks, int nk, const float* qg, const float* kg, const bf16* kbase, RowFn rowoff, int wave, int lane) {
    const int rr = lane >> 4, cc = lane & 15;
    float gf[8];
    { const f32x4 a0 = *(const f32x4*)(qg + 8 * cc), a1 = *(const f32x4*)(qg + 8 * cc + 4), b0 = *(const f32x4*)(kg + 8 * cc), b1 = *(const f32x4*)(kg + 8 * cc + 4);
      gf[0] = a0.x * b0.x; gf[1] = a0.y * b0.y; gf[2] = a0.z * b0.z; gf[3] = a0.w * b0.w; gf[4] = a1.x * b1.x; gf[5] = a1.y * b1.y; gf[6] = a1.z * b1.z; gf[7] = a1.w * b1.w; }
#pragma unroll 1
    for (int bt = 0; bt < NB; ++bt) {
        v4u raw[BS];
#pragma unroll
        for (int i = 0; i < BS; ++i) { const int j = ((bt * BS + i) * 8 + wave) * 4 + rr; const long off = (j < nk) ? rowoff(j) : -1;
            raw[i] = *(const v4u*)(kbase + (off < 0 ? 0 : off) + 8 * cc); if (off < 0) raw[i] = (v4u){0u, 0u, 0u, 0u}; }
#pragma unroll
        for (int i = 0; i < BS; ++i) { const int j = ((bt * BS + i) * 8 + wave) * 4 + rr;
            const float k0 = bflo(raw[i].x), k1 = bfhi(raw[i].x), k2 = bflo(raw[i].y), k3 = bfhi(raw[i].y), k4 = bflo(raw[i].z), k5 = bfhi(raw[i].z), k6 = bflo(raw[i].w), k7 = bfhi(raw[i].w);
            float ss = (k0 * k0 + k1 * k1) + (k2 * k2 + k3 * k3) + (k4 * k4 + k5 * k5) + (k6 * k6 + k7 * k7);
            ss += __shfl_xor(ss, 1); ss += __shfl_xor(ss, 2); ss += __shfl_xor(ss, 4); ss += __shfl_xor(ss, 8);
            const float sc = 1.0f / sqrtf(ss * (1.f / 128.f) + EPS);
            v4u w; w.x = pk2(k0 * sc * gf[0], k1 * sc * gf[1]); w.y = pk2(k2 * sc * gf[2], k3 * sc * gf[3]); w.z = pk2(k4 * sc * gf[4], k5 * sc * gf[5]); w.w = pk2(k6 * sc * gf[6], k7 * sc * gf[7]);
            if (j < nk) *(LAS v4u*)(Ks + (size_t)j * (AT_KSTR * 2) + 16 * cc) = w; }
    }
}
__device__ __forceinline__ void attn_stage_vpair(LAS unsigned char* VT, int vstr, int j0, int dch, const v4u va, const v4u vb) {
    LAS unsigned char* p = VT + ((size_t)(8 * dch) * vstr + j0) * 2;
    const size_t rs = (size_t)vstr * 2;
    *(LAS unsigned*)(p + 0 * rs) = (va.x & 0xffffu) | (vb.x << 16);         *(LAS unsigned*)(p + 1 * rs) = (va.x >> 16) | (vb.x & 0xffff0000u);
    *(LAS unsigned*)(p + 2 * rs) = (va.y & 0xffffu) | (vb.y << 16);         *(LAS unsigned*)(p + 3 * rs) = (va.y >> 16) | (vb.y & 0xffff0000u);
    *(LAS unsigned*)(p + 4 * rs) = (va.z & 0xffffu) | (vb.z << 16);         *(LAS unsigned*)(p + 5 * rs) = (va.z >> 16) | (vb.z & 0xffff0000u);
    *(LAS unsigned*)(p + 6 * rs) = (va.w & 0xffffu) | (vb.w << 16);         *(LAS unsigned*)(p + 7 * rs) = (va.w >> 16) | (vb.w & 0xffff0000u);
}
template <int NB, int BS, int NPR, class RowFn>
__device__ __forceinline__ void attn_stage_v(LAS unsigned char* VT, int vstr, const bf16* vbase, RowFn rowoff, int tid) {
#pragma unroll 1
    for (int bt = 0; bt < NB; ++bt) {
        v4u va[BS], vb[BS];
#pragma unroll
        for (int k = 0; k < BS; ++k) { const int it = tid + 512 * (bt * BS + k), pr = it % NPR, dch = it / NPR;
            const long oa = (it < NPR * 16) ? rowoff(2 * pr) : -1, ob = (it < NPR * 16) ? rowoff(2 * pr + 1) : -1;
            va[k] = *(const v4u*)(vbase + (oa < 0 ? 0 : oa + 8 * dch)); vb[k] = *(const v4u*)(vbase + (ob < 0 ? 0 : ob + 8 * dch));
            if (oa < 0) va[k] = (v4u){0u, 0u, 0u, 0u}; if (ob < 0) vb[k] = (v4u){0u, 0u, 0u, 0u}; }
#pragma unroll
        for (int k = 0; k < BS; ++k) { const int it = tid + 512 * (bt * BS + k), pr = it % NPR, dch = it / NPR; if (it < NPR * 16) attn_stage_vpair(VT, vstr, 2 * pr, dch, va[k], vb[k]); }
    }
}

constexpr int XA_VSTR = 264, XA_OFF_VT = 256 * AT_KSTR * 2;
static_assert(XA_OFF_VT + 128 * XA_VSTR * 2 <= SCR_BYTES, "cross LDS");
__device__ __forceinline__ void cross_unit(Frame& F, const bf16* xq, const bf16* kv, const float* qg, const float* kg, bf16* mix, int unit) {
    int lane = (int)__builtin_amdgcn_mbcnt_hi(~0u, __builtin_amdgcn_mbcnt_lo(~0u, 0u)); asm volatile("" : "+v"(lane)); const int tid = F.wave * 64 + lane;
    const int b = unit >> 5, h = (unit >> 3) & 3, qc = unit & 7;
    LAS unsigned char* Ks = F.lds; LAS unsigned char* VT = F.lds + XA_OFF_VT;
    const bf16* kbase = kv + (size_t)(b * MEML) * 1024 + h * 128;
    __syncthreads();
    attn_stage_k<2, 4>(Ks, MEML, qg, kg, kbase, [=](int j) { return (long)j * 1024; }, F.wave, lane);
    attn_stage_v<2, 2, 128>(VT, XA_VSTR, kbase + 512, [=](int j) { return (long)j * 1024; }, tid);
    __syncthreads();
#pragma unroll 1
    for (int a = F.wave; a < 16; a += NWAVES) {
        const int token = b * SEQ + qc * 256 + 16 * a + (lane & 15);
        attn_wave16<16, false>(Ks, VT, XA_VSTR, 0, xq + (size_t)token * 512 + h * 128, nullptr, 1, 0, 0, 0, mix + (size_t)token * D + 512 + h * 128, nullptr, lane);
    }
}
constexpr int DA_VSTR = 280, DA_NK = 272, DA_OFF_VT = DA_NK * AT_KSTR * 2, DA_OFF_BT = DA_OFF_VT + 128 * DA_VSTR * 2;
static_assert(DA_OFF_BT + 320 * 4 <= SCR_BYTES, "dilated LDS");
__device__ __forceinline__ void dil_unit(Frame& F, const Args& a, int unit) {
    const int bh = unit / 48, sub = unit % 48, b = bh >> 2, h = bh & 3, g = sub >> 4, w16 = sub & 15;
    const int dil = (g == 0) ? 1 : (g == 1 ? 4 : 16), L = SEQ / dil, nch = L / 128;
    const int r = w16 / nch, n128 = w16 % nch;
    int lane = (int)__builtin_amdgcn_mbcnt_hi(~0u, __builtin_amdgcn_mbcnt_lo(~0u, 0u)); asm volatile("" : "+v"(lane)); const int tid = F.wave * 64 + lane;
    const bf16* qkv = (const bf16*)(F.ws + WS_QKV1);
    float* lse = (float*)(F.ws + WS_LSE);
    LAS unsigned char* Ks = F.lds; LAS unsigned char* VT = F.lds + DA_OFF_VT; LAS float* bt = (LAS float*)(F.lds + DA_OFF_BT);
    const int lk0 = 128 * n128 - 64;
    const bf16* base = qkv + (size_t)(b * SEQ + r) * NQKV + g * 512 + h * 128;
    const size_t lstep = (size_t)dil * NQKV;
    __syncthreads();
    if (tid < 320) { const int rel = tid - 128; bt[tid] = (rel >= -64 && rel <= 64) ? a.in[I_RELB][rel_bucket_dev(rel * dil) * 12 + g * 4 + h] : -3.0e38f; }
    attn_stage_k<3, 3>(Ks, DA_NK, a.in[I_ATQN], a.in[I_ATKN], base + ATW, [=](int j) { const int lk = lk0 + j; return (lk >= 0 && lk < L) ? (long)lk * (long)lstep : -1L; }, F.wave, lane);
    attn_stage_v<3, 2, DA_NK / 2>(VT, DA_VSTR, base + 2 * ATW, [=](int j) { const int lk = lk0 + j; return (lk >= 0 && lk < L) ? (long)lk * (long)lstep : -1L; }, tid);
    __syncthreads();
    {
        const int aq = F.wave, i = 16 * aq + (lane & 15), lq = 128 * n128 + i, token = b * SEQ + lq * dil + r, k0 = 16 * aq, rq = lane >> 4;
        attn_wave16<10, true>(Ks, VT, DA_VSTR, k0, base + (size_t)lq * lstep, bt, dil, k0 + 4 * rq - 64 - i, lk0 + k0 + 4 * rq, L,
                              (g == 0) ? (bf16*)(F.ws + WS_MIX1) + (size_t)token * D + h * 128 : (bf16*)(F.ws + WS_OG12) + ((size_t)(g - 1) * T + token) * 512 + h * 128,
                              lse + ((size_t)g * T + token) * 4 + h, lane);
    }
}
__device__ __forceinline__ void combine_phase(Frame& F, const Args& a) {
    moe_layout(F);
    const int gw = F.bid * NWAVES + F.wave, NGW = F.G * NWAVES, lane = F.lane;
    const int* toke = (const int*)(F.ws + WS_TOKE); const int* tokr = (const int*)(F.ws + WS_TOKR); const float* tokg = (const float*)(F.ws + WS_TOKG);
    const bf16* y = (const bf16*)(F.ws + WS_XS); const bf16* y2 = (const bf16*)(F.ws + WS_Y2);
    for (int token = gw; token < T; token += NGW) {
        const int e0 = toke[token * 2], e1 = toke[token * 2 + 1];
        const int s0 = ml_ps(F, e0) + tokr[token * 2], s1 = ml_ps(F, e1) + tokr[token * 2 + 1];
        const float g0 = tokg[token * 2], g1 = tokg[token * 2 + 1];
        f32x4* xo = (f32x4*)(a.out + (size_t)token * D); const v2u* xi = (const v2u*)((const bf16*)a.out + (size_t)token * 2048 + 1024);
        const v2u* y0 = (const v2u*)(y + (size_t)s0 * D); const v2u* y1 = (const v2u*)(y + (size_t)s1 * D);
        v2u xw[4], p0[4], p1[4];
#pragma unroll
        for (int j = 0; j < 4; ++j) { const int q = lane + 64 * j; xw[j] = __builtin_nontemporal_load(xi + q); p0[j] = __builtin_nontemporal_load(y0 + q); p1[j] = __builtin_nontemporal_load(y1 + q); }
        f32x4 r[4];
#pragma unroll
        for (int j = 0; j < 4; ++j) {
            const int q = lane + 64 * j;
            f32x4 x = (f32x4){bflo(xw[j].x), bfhi(xw[j].x), bflo(xw[j].y), bfhi(xw[j].y)};
            f32x4 a0 = (f32x4){bflo(p0[j].x), bfhi(p0[j].x), bflo(p0[j].y), bfhi(p0[j].y)}, a1 = (f32x4){bflo(p1[j].x), bfhi(p1[j].x), bflo(p1[j].y), bfhi(p1[j].y)};
            if (s0 >= 2 * T) { const v2u t = ((const v2u*)(y2 + (size_t)(s0 - 2 * T) * D))[q]; a0 = a0 + (f32x4){bflo(t.x), bfhi(t.x), bflo(t.y), bfhi(t.y)}; }
            if (s1 >= 2 * T) { const v2u t = ((const v2u*)(y2 + (size_t)(s1 - 2 * T) * D))[q]; a1 = a1 + (f32x4){bflo(t.x), bfhi(t.x), bflo(t.y), bfhi(t.y)}; }
            r[j] = x + g0 * a0 + g1 * a1;
        }
        asm volatile("s_waitcnt vmcnt(0)" ::: "memory");
#pragma unroll
        for (int j = 0; j < 4; ++j) __builtin_nontemporal_store(r[j], xo + lane + 64 * j);
    }
}

constexpr int NPHASE = 15;
__global__ void __launch_bounds__(NWAVES * 64, 2) mega_fwd(Args args) {
    extern __shared__ __attribute__((aligned(16))) unsigned char lds_raw[];
    Frame F;
    F.lds = (LAS unsigned char*)lds_raw; F.ws = args.ws;
    F.wave = __builtin_amdgcn_readfirstlane((int)threadIdx.x >> 6); F.G = gridDim.x; F.bid = blockIdx.x;
#define PH_BEGIN() do { int l_ = (int)__builtin_amdgcn_mbcnt_hi(~0u, __builtin_amdgcn_mbcnt_lo(~0u, 0u)); asm volatile("" : "+v"(l_)); F.lane = l_; F.tid = F.wave * 64 + l_; } while (0)
    PH_BEGIN();
    unsigned char* ws = args.ws;
    volatile LAS unsigned* MISC = (volatile LAS unsigned*)(F.lds + MISC_OFF);
    for (int u = F.tid; u < (LDS_BYTES - MISC_OFF) / 4; u += NWAVES * 64) MISC[u] = 0u;
    __syncthreads();
    const int lo = args.ph_lo, hi = args.ph_hi;
    const bool use_bar = (hi - lo) > 1;
    XcdBarrier bar; bar.bar = (unsigned*)(ws + WS_CTL) + CW_BAR + args.bslot * XCD_BAR_WORDS; bar.x = 0; bar.st = nullptr;
    if (use_bar) bar = xcd_barrier_post((unsigned*)(ws + WS_CTL) + CW_BAR + args.bslot * XCD_BAR_WORDS, MISC + 8, F.tid);
#define IN(k) (lo <= (k) && (k) < hi)
#define SEAM(k) do { if (IN(k) && IN((k) + 1)) { PH_BEGIN(); xcd_barrier(bar, F.tid); } } while (0)
    const int gw = F.bid * NWAVES + F.wave, NGW = F.G * NWAVES;
    LAS unsigned char* ring = F.lds;

    if (IN(0)) { PH_BEGIN(); p0_prologue(F, args); }
    SEAM(0);
    if (IN(1)) { PH_BEGIN();
        {   pg8::Gemm g{(const bf16*)(ws + WS_WIN0), (const bf16*)(ws + WS_XB), D, D, D, 0};
            pg8::StaticOrder S; S.init(ATW / 256, T / 256, F.G, F.bid);
            EpiB<3> E{(bf16*)(ws + WS_ZT), T, (const float*)(ws + WS_RSTD0), 1 << 30, nullptr, 0, nullptr, 1.0f};
            pg8::gemm_phase<EpiB<3>, pg8::StaticOrder, true>(ring, g, S, E, F.wave); }
        {   pg8::Gemm g{(const bf16*)(ws + WS_XB), (const bf16*)(ws + WS_WIN0) + (size_t)ATW * D, D, D, D, 0};
            pg8::StaticOrder S; S.init(T / 256, 2, F.G, (F.bid + 128) % F.G);
            EpiB<1> E{(bf16*)(ws + WS_XQ0), 512, (const float*)(ws + WS_RSTD0), 1 << 30, nullptr, 0, nullptr, 1.0f};
            pg8::gemm_phase<EpiB<1>, pg8::StaticOrder, true>(ring, g, S, E, F.wave); }
        {   pg8::Gemm g{(const bf16*)(ws + WS_MN), (const bf16*)(ws + WS_WKV), D, D, D, (size_t)D * D * 2};
            pg8::MoeOrder S; S.init(2 * TM / 256, 4, F.G, F.bid); S.t0 = TM / 256; S.t1 = S.t2 = S.t3 = S.t4 = S.t5 = S.t6 = 1 << 30; S.lay = nullptr; S.list = nullptr;
            EpiB<0> E{(bf16*)(ws + WS_KV), D, nullptr, 1 << 30, nullptr, 0, nullptr, 1.0f};
            pg8::gemm_phase<EpiB<0>, pg8::MoeOrder, true>(ring, g, S, E, F.wave); }
        if (F.G == 256 && F.bid >= 64) { PH_BEGIN(); moe_convert(F, args, 0, MOE_P1_HI, (F.bid - 64) * NWAVES + F.wave, 192 * NWAVES); }
    }
    SEAM(1);
    if (IN(2)) { PH_BEGIN();
        hyena_units(F, args);
        for (int u = F.bid; u < 256; u += F.G)
            cross_unit(F, (const bf16*)(ws + WS_XQ0), (const bf16*)(ws + WS_KV), args.in[I_XQN], args.in[I_XKN], (bf16*)(ws + WS_MIX0), u);
    }
    SEAM(2);
    if (IN(3)) { PH_BEGIN(); for (int t = gw; t < 2048; t += NGW) hy_transpose_tile(F, t); }
    SEAM(3);
    if (IN(4)) { PH_BEGIN();
        pg8::Gemm g{(const bf16*)(ws + WS_MIX0), (const bf16*)(ws + WS_WO), D, D, D, 0};
        pg8::StaticOrder S; S.init(T / 256, 4, F.G, F.bid);
        EpiRes<false, true> E{nullptr, (const bf16*)(ws + WS_XB), D, (bf16*)(ws + WS_XB), D, (float*)(ws + WS_SSQ16)};
        pg8::gemm_phase<EpiRes<false, true>, pg8::StaticOrder, true>(ring, g, S, E, F.wave);
    }
    SEAM(4);
    if (IN(5)) { PH_BEGIN();
        pg8::Gemm g{(const bf16*)(ws + WS_XB), (const bf16*)(ws + WS_WGU0), D, D, D, 0};
        pg8::StaticOrder S; S.init(T / 256, NGU / 256, F.G, F.bid);
        fill_rstd_table(F.lds, S, (const float*)(ws + WS_SSQ16), F.tid);
        EpiSwiglu<4> E{(bf16*)(ws + WS_HID0), FF, nullptr, (const LAS float*)(F.lds + RSL_OFF), 1.0f};
        pg8::gemm_phase<EpiSwiglu<4>, pg8::StaticOrder, true>(ring, g, S, E, F.wave);
        if (F.G == 256 && F.bid >= 128) { PH_BEGIN(); moe_convert(F, args, MOE_P1_HI, MOE_P5_HI, (F.bid - 128) * NWAVES + F.wave, 128 * NWAVES); }
    }
    SEAM(5);
    if (IN(6)) { PH_BEGIN();
        pg8::Gemm g{(const bf16*)(ws + WS_HID0), (const bf16*)(ws + WS_WD0), FF, FF, FF, 0};
        pg8::StaticOrder S; S.init(T / 256, 4, F.G, F.bid);
        EpiRes<false, true> E{nullptr, (const bf16*)(ws + WS_XB), D, (bf16*)(ws + WS_XB), D, (float*)(ws + WS_SSQ16)};
        pg8::gemm_phase<EpiRes<false, true>, pg8::StaticOrder, true>(ring, g, S, E, F.wave);
    }
    SEAM(6);
    if (IN(7)) { PH_BEGIN();
        pg8::Gemm g{(const bf16*)(ws + WS_XB), (const bf16*)(ws + WS_WIN1), D, D, D, 0};
        pg8::StaticOrder S; S.init(T / 256, NQ1 / 256, F.G, F.bid);
        fill_rstd_table(F.lds, S, (const float*)(ws + WS_SSQ16), F.tid);
        EpiB<4> E{(bf16*)(ws + WS_QKV1), NQKV, nullptr, NQKV / 256, (bf16*)(ws + WS_XQ1), 512, (const LAS float*)(F.lds + RSL_OFF), 1.0f};
        pg8::gemm_phase<EpiB<4>, pg8::StaticOrder, true>(ring, g, S, E, F.wave);
    }
    SEAM(7);
    if (IN(8)) { PH_BEGIN();
        for (int u = F.bid; u < NB * 4 * 48; u += F.G) dil_unit(F, args, u);
        for (int u = F.bid; u < 256; u += F.G)
            cross_unit(F, (const bf16*)(ws + WS_XQ1), (const bf16*)(ws + WS_KV) + (size_t)TM * D, args.in[I_XQN] + 128, args.in[I_XKN] + 128, (bf16*)(ws + WS_MIX1), u);
    }
    SEAM(8);
    if (IN(9)) { PH_BEGIN(); for (int t = gw; t < T; t += NGW) merge_token(F, t); }
    SEAM(9);
    if (IN(10)) { PH_BEGIN();
        pg8::Gemm g{(const bf16*)(ws + WS_MIX1), (const bf16*)(ws + WS_WO) + (size_t)D * D, D, D, D, 0};
        pg8::StaticOrder S; S.init(T / 256, 4, F.G, F.bid);
        EpiRes<false, false> E{nullptr, (const bf16*)(ws + WS_XB), D, (bf16*)args.out + 1024, 2048, nullptr};
        pg8::gemm_phase<EpiRes<false, false>, pg8::StaticOrder, true>(ring, g, S, E, F.wave);
    }
    SEAM(10);
    if (IN(11)) { PH_BEGIN(); for (int blk = F.bid; blk < T / 64; blk += F.G) route_block(F, args, blk); }
    SEAM(11);
    if (IN(12)) { PH_BEGIN();
        moe_layout(F);
        pg8::Gemm g{(const bf16*)(ws + WS_XB3), (const bf16*)(ws + WS_WGU1), D / 2, D / 2, D / 2, (size_t)NGU * D};
        pg8::MoeOrder S; S.init(ml_total(F) / 256, NGU / 256, F.G, F.bid); S.lay = (const volatile LAS int*)(F.lds + MISC_OFF); S.list = (const int*)(ws + WS_LIST);
        S.t0 = ml_ps(F, 1) / 256; S.t1 = ml_ps(F, 2) / 256; S.t2 = ml_ps(F, 3) / 256; S.t3 = ml_ps(F, 4) / 256; S.t4 = ml_ps(F, 5) / 256; S.t5 = ml_ps(F, 6) / 256; S.t6 = ml_ps(F, 7) / 256;
        EpiSwiglu<5, true> E{(bf16*)(ws + WS_HID1), FF, nullptr, nullptr, 1.0f / MOE_WGU_SCALE};
        pg8::gemm_phase<EpiSwiglu<5, true>, pg8::MoeOrder, true, true, true>(ring, g, S, E, F.wave);
    }
    SEAM(12);
    if (IN(13)) { PH_BEGIN();
        moe_layout(F);
        const int nMt = ml_total(F) / 256;
        const int q1 = ml_ps(F, 1) / 256, q2 = ml_ps(F, 2) / 256, q3 = ml_ps(F, 3) / 256, q4 = ml_ps(F, 4) / 256, q5 = ml_ps(F, 5) / 256, q6 = ml_ps(F, 6) / 256, q7 = ml_ps(F, 7) / 256;
        {   pg8::Gemm g{(const bf16*)(ws + WS_HID1), (const bf16*)(ws + WS_WD1), FF / 2, FF / 2, FF / 2, (size_t)D * FF};
            pg8::MoeOrder S; S.init(nMt < 128 ? nMt : 128, 4, F.G, F.bid); S.lay = nullptr; S.list = nullptr;
            S.t0 = q1; S.t1 = q2; S.t2 = q3; S.t3 = q4; S.t4 = q5; S.t5 = q6; S.t6 = q7;
            EpiB<5> E{(bf16*)(ws + WS_XS), D, nullptr, 1 << 30, nullptr, 0, nullptr, 1.0f / MOE_WD_SCALE};
            pg8::gemm_phase<EpiB<5>, pg8::MoeOrder, true, false, true>(ring, g, S, E, F.wave); }
        if (nMt > 128) {
            const int half = F.G / 2; const bool second = F.bid >= half;
            pg8::Gemm g{(const bf16*)(ws + WS_HID1), (const bf16*)(ws + WS_WD1), FF / 2, FF / 2, second ? 640 : 768, (size_t)D * FF};
            pg8::MoeTailOrder2 S; S.pm0 = 128; S.ntail = nMt - 128; S.nN = 4; S.G = second ? F.G - half : half; S.c = second ? F.bid - half : F.bid; S.koff = second ? 12 * 128 : 0;
            S.t0 = q1; S.t1 = q2; S.t2 = q3; S.t3 = q4; S.t4 = q5; S.t5 = q6; S.t6 = q7;
            EpiB<5> E{(bf16*)(ws + WS_XS), D, nullptr, 1 << 30, (bf16*)(ws + WS_Y2) - (size_t)2 * T * D, D, nullptr, 1.0f / MOE_WD_SCALE};
            pg8::gemm_phase<EpiB<5>, pg8::MoeTailOrder2, true, false, true>(ring, g, S, E, F.wave); }
    }
    SEAM(13);
    if (IN(14)) { PH_BEGIN(); combine_phase(F, args); }
#undef IN
#undef SEAM
}

#ifndef MK_ONE_LAUNCH
#define MK_ONE_LAUNCH 1
#endif
extern "C" void kernel_launch(void* const* d_in, const int* in_sizes, int n_in, void* d_out, int out_size, void* d_ws, size_t ws_size, hipStream_t stream) {
    static int grid = 0;
    if (grid == 0) {
        if (n_in != 30 || in_sizes[0] != T * D || out_size != T * D || ws_size < WS_END) {
            fprintf(stderr, "kernel_launch: unexpected problem (n_in %d, in0 %d, out %d, ws %zu, need %zu); nothing launched\n", n_in, n_in > 0 ? in_sizes[0] : -1, out_size, ws_size, (size_t)WS_END); grid = -1; return; }
        int dev = 0, cus = 0, per_cu = 0;
        if (hipGetDevice(&dev) != hipSuccess || hipDeviceGetAttribute(&cus, hipDeviceAttributeMultiprocessorCount, dev) != hipSuccess) { grid = -1; return; }
        if (hipFuncSetAttribute((const void*)mega_fwd, hipFuncAttributeMaxDynamicSharedMemorySize, LDS_BYTES) != hipSuccess) { fprintf(stderr, "kernel_launch: hipFuncSetAttribute failed\n"); grid = -1; return; }
        if (hipOccupancyMaxActiveBlocksPerMultiprocessor(&per_cu, (const void*)mega_fwd, NWAVES * 64, LDS_BYTES) != hipSuccess || per_cu < 1)
            fprintf(stderr, "kernel_launch: note: occupancy query reports %d workgroups per CU\n", per_cu);
        (void)hipGetLastError();
        grid = cus;
    }
    if (grid < 0) return;
    if (hipMemsetAsync((char*)d_ws + WS_CTL, 0, CTL_ZERO_BYTES, stream) != hipSuccess) return;
    Args a{};
    for (int i = 0; i < 30; ++i) a.in[i] = (const float*)d_in[i];
    a.out = (float*)d_out; a.ws = (unsigned char*)d_ws;
#if defined(PROBE_PHASE)
    a.ph_lo = 0; a.ph_hi = PROBE_PHASE + 1; a.bslot = 0;
    hipLaunchKernelGGL(mega_fwd, dim3(grid), dim3(NWAVES * 64), LDS_BYTES, stream, a);
    a.ph_lo = PROBE_PHASE; a.ph_hi = NPHASE; a.bslot = 1;
    hipLaunchKernelGGL(mega_fwd, dim3(grid), dim3(NWAVES * 64), LDS_BYTES, stream, a);
#elif MK_ONE_LAUNCH
    a.ph_lo = 0; a.ph_hi = NPHASE; a.bslot = 0;
    hipLaunchKernelGGL(mega_fwd, dim3(grid), dim3(NWAVES * 64), LDS_BYTES, stream, a);
#else
    for (int p = 0; p < NPHASE; ++p) { a.ph_lo = p; a.ph_hi = p + 1; a.bslot = 0; hipLaunchKernelGGL(mega_fwd, dim3(grid), dim3(NWAVES * 64), LDS_BYTES, stream, a); }
#endif
}
```

```cpp
#include <hip/hip_runtime.h>
#include <cstdio>
#include <cstdint>

namespace pg8 {
#define PG8_LAS __attribute__((address_space(3)))
typedef unsigned short bf16_t;
typedef short bf16x8 __attribute__((ext_vector_type(8)));
typedef float f32x4 __attribute__((ext_vector_type(4)));
typedef unsigned u32x4 __attribute__((ext_vector_type(4)));
constexpr int BM = 256, BK = 64, HALF = 128, HTB = HALF * BK * 2  , STAGE_BYTES = 8 * HTB, NXCD = 8, WGM = 8;

__host__ __device__ __forceinline__ int lds_byte(int r, int c) { const int st = (r >> 4) * 2 + (c >> 5), rr = r & 15, cc = c & 31, ob = rr * 64 + cc * 2; return st * 1024 + (ob ^ (((ob >> 9) & 1) << 5)); }
__host__ __device__ __forceinline__ void stage_rc(int b, int& R, int& C) { const int st = b / 1024, sb = b % 1024, swz = sb ^ (((sb >> 9) & 1) << 5); R = (st >> 1) * 16 + swz / 64; C = (st & 1) * 32 + (swz % 64) / 2; }
__host__ __device__ __forceinline__ int perm32(int rho) { const int n = rho >> 4, i = rho & 15; return 8 * (i >> 2) + 4 * n + (i & 3); }

struct Unit { int pm, pn, e, koff, idx; };
struct Gemm { const bf16_t* A; const bf16_t* Bt; int lda, ldb, K; size_t estride; };

struct StaticOrder {
    int nM, nN, nwg, G, c;
    __device__ __forceinline__ int gather_row(const Unit&, int slot) const { return slot; }
    __host__ __device__ void init(int nM_, int nN_, int G_, int c_) { nM = nM_; nN = nN_; nwg = nM * nN; G = G_; c = c_; }
    __host__ __device__ bool next(int i, Unit& u) const {
        const long L = (long)i * G + c; if (L >= nwg) return false;
        int wgid = (int)L; { const int q = nwg / NXCD, r = nwg % NXCD, xcd = wgid % NXCD, off = wgid / NXCD; wgid = (xcd < r ? xcd * (q + 1) : r * (q + 1) + (xcd - r) * q) + off; }
        const int nig = WGM * nN, gid = wgid / nig, fm = gid * WGM, gsz = (nM - fm) < WGM ? (nM - fm) : WGM;
        u.pm = fm + ((wgid % nig) % gsz); u.pn = (wgid % nig) / gsz; u.e = 0; u.koff = 0; return true;
    }
};
struct MoeOrder : StaticOrder {
    int t0, t1, t2, t3, t4, t5, t6;
    const volatile PG8_LAS int* lay;
    const int* list;
    __device__ __forceinline__ int gather_row(const Unit& u, int slot) const { const int rank = slot - lay[40 + u.e]; return rank < lay[32 + u.e] ? list[(size_t)u.e * 16384 + rank] : 0; }
    __host__ __device__ bool next(int i, Unit& u) const {
        if (!StaticOrder::next(i, u)) return false;
        const int p = u.pm; u.e = (p >= t0) + (p >= t1) + (p >= t2) + (p >= t3) + (p >= t4) + (p >= t5) + (p >= t6); return true;
    }
};

struct MoeTailOrder {
    int pm0, ntail, nN, G, c, khalf; int t0, t1, t2, t3, t4, t5, t6;
    __device__ __forceinline__ int gather_row(const Unit&, int slot) const { return slot; }
    __device__ __forceinline__ bool next(int i, Unit& u) const {
        const int L = i * G + c; if (L >= ntail * nN * 2) return false;
        const int kh = L & 1, q = L >> 1; u.pn = q % nN; u.pm = pm0 + q / nN; u.koff = kh * khalf;
        const int p = u.pm; u.e = (p >= t0) + (p >= t1) + (p >= t2) + (p >= t3) + (p >= t4) + (p >= t5) + (p >= t6); return true;
    }
};
struct MoeTailOrder2 {
    int pm0, ntail, nN, G, c, koff; int t0, t1, t2, t3, t4, t5, t6;
    __device__ __forceinline__ int gather_row(const Unit&, int slot) const { return slot; }
    __device__ __forceinline__ bool next(int i, Unit& u) const {
        const int L = i * G + c; if (L >= ntail * nN) return false;
        u.pn = L % nN; u.pm = pm0 + L / nN; u.koff = koff;
        const int p = u.pm; u.e = (p >= t0) + (p >= t1) + (p >= t2) + (p >= t3) + (p >= t4) + (p >= t5) + (p >= t6); return true;
    }
};
__device__ __forceinline__ unsigned cvt_pk_bf16(float lo, float hi) { unsigned r; asm volatile("v_cvt_pk_bf16_f32 %0, %1, %2" : "=v"(r) : "v"(lo), "v"(hi)); return r; }

typedef int v8i __attribute__((ext_vector_type(8)));
typedef int v4i __attribute__((ext_vector_type(4)));
template <class Epi, class Sched, bool ALIGN_EPI, bool GATHER = false, bool FP8 = false>
__device__ __forceinline__ void gemm_phase(PG8_LAS unsigned char* lds, const Gemm g, const Sched& S, const Epi& E, const int wid) {
    int lane = (int)__builtin_amdgcn_mbcnt_hi(~0u, __builtin_amdgcn_mbcnt_lo(~0u, 0u)); asm volatile("" : "+v"(lane));
    const int tid = wid * 64 + lane, wr = wid >> 2, wc = wid & 3, fr = lane & 15, fq = lane >> 4;
    const int K = g.K, nt = K / BK;
    unsigned cvo[4], nvo[4], voffB[2]; int rowA[2], colA[2];
#pragma unroll
    for (int i = 0; i < 2; ++i) { int R, C; stage_rc(tid * 16 + i * 8192, R, C); const int Rb = (R & ~31) + perm32(R & 31); rowA[i] = R; colA[i] = C;
        voffB[i] = (unsigned)(Rb * g.ldb + C) * 2u; }
    const size_t kstep = (size_t)(BK * 2);
    const size_t hstepB = (size_t)HALF * g.ldb * 2;
    const size_t tstepA = GATHER ? (size_t)0 : (size_t)2 * HALF * g.lda * 2, tstepB = 2 * hstepB;
#define PG8_ROWOFFS(vo, u) do { _Pragma("unroll") for (int _h = 0; _h < 2; ++_h) _Pragma("unroll") for (int _i = 0; _i < 2; ++_i) { \
        const int _r = _h * HALF + rowA[_i]; const unsigned _row = GATHER ? (unsigned)S.gather_row(u, (u).pm * BM + _r) : (unsigned)_r; \
        (vo)[2 * _h + _i] = (_row * (unsigned)g.lda + (unsigned)colA[_i]) * 2u; } } while (0)
    const unsigned ldsw = (unsigned)wid * 1024u;
    const int aoff = lds_byte(wr * 64 + fr, fq * 8), boff = lds_byte(wc * 32 + fr, fq * 8);
#define PG8_SA(b, h) (((b) * 2 + (h)) * HTB)
#define PG8_SB(b, h) ((4 + (b) * 2 + (h)) * HTB)
#define PG8_STAGE(bufoff, gbase, voff) do { _Pragma("unroll") for (int _i = 0; _i < 2; ++_i) \
        __builtin_amdgcn_global_load_lds((const unsigned*)((const char*)(gbase) + (voff)[_i]), (PG8_LAS unsigned*)(lds + (bufoff) + ldsw + _i * 8192), 16, 0, 0); } while (0)
#define PG8_STAGEA(bufoff, gbase, vo, h) do { _Pragma("unroll") for (int _i = 0; _i < 2; ++_i) \
        __builtin_amdgcn_global_load_lds((const unsigned*)((const char*)(gbase) + (vo)[2 * (h) + _i]), (PG8_LAS unsigned*)(lds + (bufoff) + ldsw + _i * 8192), 16, 0, 0); } while (0)
#define PG8_LDA(dst, b, h) do { _Pragma("unroll") for (int m = 0; m < 4; ++m) dst[m] = __builtin_shufflevector(*(const PG8_LAS v4i*)(lds + PG8_SA(b, h) + aoff + m * 2048), *(const PG8_LAS v4i*)(lds + PG8_SA(b, h) + aoff + m * 2048 + 1024), 0, 1, 2, 3, 4, 5, 6, 7); } while (0)
#define PG8_LDB(dst, b, h) do { _Pragma("unroll") for (int n = 0; n < 2; ++n) dst[n] = __builtin_shufflevector(*(const PG8_LAS v4i*)(lds + PG8_SB(b, h) + boff + n * 2048), *(const PG8_LAS v4i*)(lds + PG8_SB(b, h) + boff + n * 2048 + 1024), 0, 1, 2, 3, 4, 5, 6, 7); } while (0)
#define PG8_HALF(x, k) __builtin_bit_cast(bf16x8, __builtin_shufflevector(x, x, 4 * (k), 4 * (k) + 1, 4 * (k) + 2, 4 * (k) + 3))
#define PG8_MMA(ai, bj, At, Bt) do { if constexpr (FP8) __builtin_amdgcn_sched_barrier(0); __builtin_amdgcn_s_setprio(1); _Pragma("unroll") for (int m = 0; m < 4; ++m) _Pragma("unroll") for (int n = 0; n < 2; ++n) { \
        if constexpr (FP8) acc[ai][bj][m][n] = __builtin_amdgcn_mfma_scale_f32_16x16x128_f8f6f4(Bt[n], At[m], acc[ai][bj][m][n], 0, 0, 0, 0x7f7f7f7f, 0, 0x7f7f7f7f); \
        else { acc[ai][bj][m][n] = __builtin_amdgcn_mfma_f32_16x16x32_bf16(PG8_HALF(Bt[n], 0), PG8_HALF(At[m], 0), acc[ai][bj][m][n], 0, 0, 0); \
               acc[ai][bj][m][n] = __builtin_amdgcn_mfma_f32_16x16x32_bf16(PG8_HALF(Bt[n], 1), PG8_HALF(At[m], 1), acc[ai][bj][m][n], 0, 0, 0); } } \
        if constexpr (FP8) { _Pragma("unroll") for (int m = 0; m < 4; ++m) _Pragma("unroll") for (int n = 0; n < 2; ++n) asm volatile("" : "+v"(acc[ai][bj][m][n])); }   \
        __builtin_amdgcn_s_setprio(0); if constexpr (FP8) __builtin_amdgcn_sched_barrier(0); } while (0)
#define PG8_WAIT_V(n) asm volatile("s_waitcnt vmcnt(" #n ")" ::: "memory")
#define PG8_WAIT_L(n) asm volatile("s_waitcnt lgkmcnt(" #n ")" ::: "memory")
#define PG8_BAR __builtin_amdgcn_s_barrier()
#define PG8_SCHED __builtin_amdgcn_sched_barrier(0)
    Unit cur, nxt; int ui = 0;
    if (!S.next(0, cur)) return;
    cur.idx = 0;
    f32x4 acc[2][2][4][2];
#pragma unroll
    for (int a = 0; a < 2; ++a)
#pragma unroll
        for (int b = 0; b < 2; ++b)
#pragma unroll
            for (int m = 0; m < 4; ++m)
#pragma unroll
                for (int n = 0; n < 2; ++n) acc[a][b][m][n] = (f32x4){0.f, 0.f, 0.f, 0.f};
    v8i At[4], B0[2], B1[2];
    const char* cA = (const char*)g.A + (size_t)cur.pm * tstepA + cur.koff; const char* cB = (const char*)g.Bt + (size_t)cur.e * g.estride + (size_t)cur.pn * tstepB + cur.koff;
    PG8_ROWOFFS(cvo, cur);
#pragma unroll
    for (int i = 0; i < 4; ++i) nvo[i] = cvo[i];
    PG8_STAGE(PG8_SB(0, 0), cB, voffB); PG8_STAGE(PG8_SB(0, 1), cB + hstepB, voffB); PG8_STAGEA(PG8_SA(0, 0), cA, cvo, 0); PG8_STAGEA(PG8_SA(0, 1), cA, cvo, 1);
    if (wr == 1) PG8_BAR;
    PG8_WAIT_V(2); PG8_BAR;
    PG8_STAGE(PG8_SB(1, 0), cB + kstep, voffB); PG8_STAGEA(PG8_SA(1, 0), cA + kstep, cvo, 0); PG8_STAGE(PG8_SB(1, 1), cB + hstepB + kstep, voffB);
    PG8_WAIT_V(6); PG8_BAR;
    for (;;) {
        const bool has_next = S.next(ui + 1, nxt); nxt.idx = ui + 1;
        const char* nA = has_next ? (const char*)g.A + (size_t)nxt.pm * tstepA + nxt.koff : cA;
        const char* nB = has_next ? (const char*)g.Bt + (size_t)nxt.e * g.estride + (size_t)nxt.pn * tstepB + nxt.koff : cB;
        if constexpr (GATHER) { if (has_next) PG8_ROWOFFS(nvo, nxt); }
        for (int t = 0; t < nt; t += 2) {
            const bool last = (t == nt - 2);
            const char* a1 = cA + (size_t)(t + 1) * kstep;
            const char* a2 = last ? nA : cA + (size_t)(t + 2) * kstep; const char* b2 = last ? nB : cB + (size_t)(t + 2) * kstep;
            const char* a3 = a2 + kstep; const char* b3 = b2 + kstep;
            unsigned vo2[4];
#pragma unroll
            for (int i = 0; i < 4; ++i) vo2[i] = (GATHER && last) ? nvo[i] : cvo[i];
            PG8_LDB(B0, 0, 0); PG8_LDB(B1, 0, 1); PG8_SCHED; PG8_LDA(At, 0, 0); PG8_STAGEA(PG8_SA(1, 1), a1, cvo, 1);
            PG8_WAIT_V(8); PG8_WAIT_L(0); PG8_BAR; PG8_MMA(0, 0, At, B0); PG8_MMA(0, 1, At, B1); PG8_BAR; PG8_SCHED;
            PG8_LDA(At, 0, 1); PG8_STAGE(PG8_SB(0, 0), b2, voffB); PG8_STAGE(PG8_SB(0, 1), b2 + hstepB, voffB); PG8_STAGEA(PG8_SA(0, 0), a2, vo2, 0);
            PG8_WAIT_V(8); PG8_WAIT_L(0); PG8_BAR; PG8_MMA(1, 0, At, B0); PG8_MMA(1, 1, At, B1); PG8_BAR; PG8_SCHED;
            PG8_LDB(B0, 1, 0); PG8_LDB(B1, 1, 1); PG8_SCHED; PG8_LDA(At, 1, 0); PG8_STAGEA(PG8_SA(0, 1), a2, vo2, 1);
            PG8_WAIT_V(8); PG8_WAIT_L(0); PG8_BAR; PG8_MMA(0, 0, At, B0); PG8_MMA(0, 1, At, B1); PG8_BAR; PG8_SCHED;
            PG8_LDA(At, 1, 1); PG8_STAGE(PG8_SB(1, 0), b3, voffB); PG8_STAGE(PG8_SB(1, 1), b3 + hstepB, voffB); PG8_STAGEA(PG8_SA(1, 0), a3, vo2, 0);
            PG8_WAIT_V(8); PG8_WAIT_L(0); PG8_BAR; PG8_MMA(1, 0, At, B0); PG8_MMA(1, 1, At, B1); PG8_BAR; PG8_SCHED;
        }
        if constexpr (ALIGN_EPI) { if (wr == 0) PG8_BAR; }
        E(acc, cur, wr, wc, fr, fq);
        if (!has_next) break;
#pragma unroll
        for (int a = 0; a < 2; ++a)
#pragma unroll
            for (int b = 0; b < 2; ++b)
#pragma unroll
                for (int m = 0; m < 4; ++m)
#pragma unroll
                    for (int n = 0; n < 2; ++n) acc[a][b][m][n] = (f32x4){0.f, 0.f, 0.f, 0.f};
        cur = nxt; cA = nA; cB = nB; ++ui;
        if constexpr (GATHER) {
#pragma unroll
            for (int i = 0; i < 4; ++i) cvo[i] = nvo[i]; }
        if constexpr (ALIGN_EPI) { if (wr == 1) PG8_BAR; }
    }
    PG8_WAIT_V(0);
    if constexpr (!ALIGN_EPI) { if (wr == 0) PG8_BAR; }
    PG8_BAR;
#undef PG8_SA
#undef PG8_SB
#undef PG8_STAGE
#undef PG8_STAGEA
#undef PG8_ROWOFFS
#undef PG8_LDA
#undef PG8_LDB
#undef PG8_MMA
#undef PG8_HALF
#undef PG8_WAIT_V
#undef PG8_WAIT_L
#undef PG8_BAR
#undef PG8_SCHED
}
}

constexpr int NB = 8, SEQ = 2048, D = 1024, T = NB * SEQ;
constexpr int MEML = 256, TM = NB * MEML;
constexpr int HYC = 512, NZ0 = 2048;
constexpr int FF = 2816, NGU = 2 * FF;
constexpr int ATW = 1536, NQKV = 3 * ATW, NQ1 = NQKV + 512;
constexpr int NE = 8, PMAX = 2 * T + NE * 256;
constexpr float EPS = 1e-6f;
constexpr float MOE_WGU_SCALE = 32.0f, MOE_WD_SCALE = 64.0f;
constexpr int NWAVES = 8;

constexpr size_t MiB = 1u << 20;
constexpr size_t WS_CTL = 0, CTL_ZERO_BYTES = 1 * MiB;
constexpr size_t WS_WGU1 = 1 * MiB;
constexpr size_t WS_WD1 = 89 * MiB;
constexpr size_t WS_SMALL = 133 * MiB;
constexpr size_t WS_RSTD0 = WS_SMALL;
constexpr size_t WS_SSQ16 = WS_SMALL + 64 * 1024;
constexpr size_t WS_LSE = WS_SSQ16 + 1 * MiB;
constexpr size_t WS_TOKE = WS_LSE + 768 * 1024;
constexpr size_t WS_TOKR = WS_TOKE + 128 * 1024;
constexpr size_t WS_TOKG = WS_TOKR + 128 * 1024;
constexpr size_t WS_RSTD3 = WS_TOKG + 128 * 1024;
constexpr size_t WS_LIST = WS_RSTD3 + 64 * 1024;
constexpr size_t WS_RSTDS = WS_LIST + 512 * 1024;
static_assert(WS_RSTDS + PMAX * 4 <= WS_SMALL + 4 * MiB, "small region");
constexpr size_t WS_WO = 137 * MiB;
constexpr size_t WS_WIN1 = 141 * MiB;
constexpr size_t WS_WKV = 151 * MiB;
constexpr size_t WS_WIN0 = 155 * MiB;
constexpr size_t WS_WGU0 = 159 * MiB;
constexpr size_t WS_WD0 = 170 * MiB;
constexpr size_t WS_KV = 176 * MiB;
constexpr size_t WS_XB = 184 * MiB;
constexpr size_t WS_YT = 336 * MiB;
constexpr size_t WS_MIX0 = 216 * MiB;
constexpr size_t WS_MN = 248 * MiB;
constexpr size_t WS_ZT = 256 * MiB;
constexpr size_t WS_XQ0 = 304 * MiB;
constexpr size_t WS_HF = 320 * MiB;
constexpr size_t WS_HID0 = 248 * MiB;
constexpr size_t WS_QKV1 = 248 * MiB;
constexpr size_t WS_XQ1 = 392 * MiB;
constexpr size_t WS_OG12 = 216 * MiB;
constexpr size_t WS_MIX1 = 141 * MiB;
constexpr size_t WS_XB3 = 137 * MiB;
constexpr size_t WS_XS = 137 * MiB;
constexpr size_t WS_HID1 = 205 * MiB;
constexpr size_t WS_Y2 = 392 * MiB;
constexpr size_t WS_END = 408 * MiB;
static_assert(WS_HID1 + (size_t)PMAX * FF * 2 <= WS_END && WS_XQ1 + (size_t)T * 512 * 2 <= WS_END && WS_XS + (size_t)PMAX * 2048 <= WS_HID1, "ws map");

constexpr int CW_CNT = 64;
constexpr int CW_BAR = 4096;

constexpr int SCR_BYTES = 147456;
constexpr int MISC_OFF = SCR_BYTES;
constexpr int LDS_BYTES = SCR_BYTES + 4096;

#define LAS __attribute__((address_space(3)))
typedef unsigned short bf16;
typedef unsigned v4u __attribute__((ext_vector_type(4)));
typedef unsigned v2u __attribute__((ext_vector_type(2)));
typedef float f32x4 __attribute__((ext_vector_type(4)));
typedef float f32x2 __attribute__((ext_vector_type(2)));
#define LDS_WAIT() asm volatile("s_waitcnt lgkmcnt(0)" ::: "memory")
__device__ __forceinline__ unsigned f2bf(float f) { unsigned u = __builtin_bit_cast(unsigned, f); return (u + 0x7fffu + ((u >> 16) & 1u)) >> 16; }
__device__ __forceinline__ unsigned pk2(float lo, float hi) { unsigned r; asm("v_cvt_pk_bf16_f32 %0, %1, %2" : "=v"(r) : "v"(lo), "v"(hi)); return r; }
__device__ __forceinline__ unsigned pk4_fp8(float a, float b, float c, float d) { unsigned w = 0u; w = __builtin_amdgcn_cvt_pk_fp8_f32(a, b, w, false); w = __builtin_amdgcn_cvt_pk_fp8_f32(c, d, w, true); return w; }
__device__ __forceinline__ float bflo(unsigned w) { return __builtin_bit_cast(float, w << 16); }
__device__ __forceinline__ float bfhi(unsigned w) { return __builtin_bit_cast(float, w & 0xffff0000u); }
__device__ __forceinline__ float bf1(bf16 b) { return __builtin_bit_cast(float, ((unsigned)b) << 16); }
__device__ __forceinline__ float wave_sum(float v) {
#pragma unroll
    for (int o = 1; o < 64; o <<= 1) v += __shfl_xor(v, o);
    return v;
}
__device__ __forceinline__ float wave_max(float v) {
#pragma unroll
    for (int o = 1; o < 64; o <<= 1) v = fmaxf(v, __shfl_xor(v, o));
    return v;
}

#define XB_TMO      128
#define XB_XCNT(j)  (256  + 64 * (j))
#define XB_XSUB(j)  (1280 + 64 * (j))
#define XB_XGEN(j)  (2304 + 64 * (j))
#define XB_TOP      3328
#define XB_TOPGEN   3392
#define XCD_BAR_WORDS 3456
#define XB_SPIN_CAP (1u << 18)

__device__ __forceinline__ unsigned xb_ld(unsigned* p)              { return __hip_atomic_load(p, __ATOMIC_RELAXED, __HIP_MEMORY_SCOPE_AGENT); }
__device__ __forceinline__ unsigned xb_add(unsigned* p, unsigned v) { return __hip_atomic_fetch_add(p, v, __ATOMIC_RELAXED, __HIP_MEMORY_SCOPE_AGENT); }
__device__ __forceinline__ unsigned xb_xcc_id() { return (unsigned)__builtin_amdgcn_s_getreg((3 << 11) | 20) & 0xFu; }
#define XB_SPIN(cond, bar) do { unsigned _sp = 0; while (cond) { __builtin_amdgcn_s_sleep(1); \
    if ((++_sp & 255u) == 0u) { if (xb_ld(&(bar)[XB_TMO])) break; if (_sp > XB_SPIN_CAP) { atomicAdd(&(bar)[XB_TMO], 1u); break; } } } } while (0)

struct XcdBarrier {
    unsigned* bar; unsigned x;
    volatile LAS unsigned* st;
};
__device__ __forceinline__ XcdBarrier xcd_barrier_post(unsigned* bar, volatile LAS unsigned* st, int tid) {
    XcdBarrier b; b.bar = bar; b.x = xb_xcc_id(); b.st = st;
    if (tid == 0) (void)xb_add(&bar[XB_XCNT(b.x)], 1u);
    return b;
}
__device__ __forceinline__ void xcd_barrier_complete(unsigned* bar, unsigned x, unsigned& nloc, unsigned& nx) {
    const unsigned G = gridDim.x * gridDim.y * gridDim.z;
    unsigned sum, cnt, mine, sp = 0u;
    for (;;) {
        sum = 0u; cnt = 0u; mine = 0u;
#pragma unroll
        for (unsigned j = 0; j < 16; ++j) { const unsigned c = xb_ld(&bar[XB_XCNT(j)]); sum += c; cnt += (c > 0u) ? 1u : 0u; mine = (j == x) ? c : mine; }
        if (sum == G) break;
        __builtin_amdgcn_s_sleep(1);
        if ((++sp & 255u) == 0u) { if (xb_ld(&bar[XB_TMO])) break; if (sp > XB_SPIN_CAP) { atomicAdd(&bar[XB_TMO], 1u); break; } }
    }
    nloc = mine > 0u ? mine : 1u; nx = cnt > 0u ? cnt : 1u;
}
__device__ __forceinline__ void xcd_barrier(const XcdBarrier& b, int tid) {
    asm volatile("s_waitcnt vmcnt(0)" ::: "memory");
    __syncthreads();
    if (tid == 0) {
        unsigned* bar = b.bar;
        __builtin_amdgcn_s_waitcnt(0);
        unsigned nloc = b.st[0], nx = b.st[1];
        if (nloc == 0u) { xcd_barrier_complete(bar, b.x, nloc, nx); b.st[0] = nloc; b.st[1] = nx; }
        const unsigned old = xb_add(&bar[XB_XSUB(b.x)], 1u);
        const unsigned gen = old / nloc;
        if (old + 1u == (gen + 1u) * nloc) {
            __builtin_amdgcn_fence(__ATOMIC_RELEASE, "agent");
            asm volatile("s_waitcnt vmcnt(0)" ::: "memory");
            const unsigned og = xb_add(&bar[XB_TOP], 1u);
            const unsigned tg = og / nx;
            if (og + 1u == (tg + 1u) * nx) xb_add(&bar[XB_TOPGEN], 1u);
            else XB_SPIN(xb_ld(&bar[XB_TOPGEN]) == tg, bar);
            __builtin_amdgcn_fence(__ATOMIC_ACQUIRE, "agent");
            xb_add(&bar[XB_XGEN(b.x)], 1u);
            asm volatile("s_waitcnt vmcnt(0)" ::: "memory");
        } else {
            XB_SPIN(xb_ld(&bar[XB_XGEN(b.x)]) == gen, bar);
            __builtin_amdgcn_fence(__ATOMIC_ACQUIRE, "agent");
            asm volatile("s_waitcnt vmcnt(0)" ::: "memory");
        }
    }
    __syncthreads();
}

struct Args { const float* in[30]; float* out; unsigned char* ws; int ph_lo, ph_hi, bslot, pad; };
enum { I_X = 0, I_MEM, I_RELB, I_NMIX, I_NMEM, I_NFFN, I_WKV, I_XQN, I_XKN, I_WOUT, I_HYWIN, I_HYCW, I_HYCB, I_FW1, I_FB1, I_FW2, I_FB2, I_FW3, I_FREQ, I_SKIP,
       I_ATWIN, I_ATQN, I_ATKN, I_FFG, I_FFU, I_FFD, I_ROUTER, I_MOEG, I_MOEU, I_MOED };

struct Frame {
    LAS unsigned char* lds;
    unsigned char* ws;
    int tid, lane, wave, G, bid;
};

constexpr int RSL_OFF = 131072;
template <int SCALE> struct EpiB {
    bf16* O; int ldc; const float* sc; int split_tile; bf16* O2; int ldc2; const LAS float* rsl; float kc;
    __device__ __forceinline__ void operator()(const f32x4 (&acc)[2][2][4][2], const pg8::Unit& u, int wr, int wc, int fr, int fq) const {
        const int row0 = u.pm * 256 + wr * 64 + fr;
        bf16* base = O; int ld = ldc; int colt = u.pn * 256;
        if (u.pn >= split_tile) { base = O2; ld = ldc2; colt -= split_tile * 256; }
        if (u.koff != 0) base = O2;
        const int col0 = colt + wc * 32 + 8 * fq;
        float rsv[2][4];
        if (SCALE == 1) {
#pragma unroll
            for (int ai = 0; ai < 2; ++ai)
#pragma unroll
                for (int m = 0; m < 4; ++m) rsv[ai][m] = sc[row0 + ai * 128 + m * 16];
            asm volatile("s_waitcnt vmcnt(0)" ::: "memory");
        }
        f32x4 cs[2][2];
        if (SCALE == 3) {
#pragma unroll
            for (int bj = 0; bj < 2; ++bj)
#pragma unroll
                for (int n = 0; n < 2; ++n) cs[bj][n] = *(const f32x4*)(sc + u.pn * 256 + bj * 128 + wc * 32 + 8 * fq + 4 * n);
            asm volatile("s_waitcnt vmcnt(0)" ::: "memory");
        }
#pragma unroll
        for (int ai = 0; ai < 2; ++ai)
#pragma unroll
            for (int m = 0; m < 4; ++m) {
                const int row = row0 + ai * 128 + m * 16;
                float rs = 1.f;
                if (SCALE == 1) rs = rsv[ai][m];
                if (SCALE == 2) { const f32x4* p = (const f32x4*)(sc + (size_t)row * 16); const f32x4 a = p[0], b = p[1], c = p[2], d = p[3];
                    const float s = ((a.x + a.y) + (a.z + a.w)) + ((b.x + b.y) + (b.z + b.w)) + ((c.x + c.y) + (c.z + c.w)) + ((d.x + d.y) + (d.z + d.w));
                    rs = 1.0f / sqrtf(s * (1.0f / D) + EPS); }
                if (SCALE == 4) rs = rsl[u.idx * 256 + (row - u.pm * 256)];
                if (SCALE == 5) rs = kc;
                bf16* rowp = base + (size_t)row * ld + col0;
#pragma unroll
                for (int bj = 0; bj < 2; ++bj) {
                    f32x4 v0 = acc[ai][bj][m][0], v1 = acc[ai][bj][m][1];
                    if (SCALE == 1 || SCALE == 2 || SCALE == 4 || SCALE == 5) { v0 = v0 * rs; v1 = v1 * rs; }
                    if (SCALE == 3) { v0 = v0 * cs[bj][0]; v1 = v1 * cs[bj][1]; }
                    v4u w; w.x = pk2(v0[0], v0[1]); w.y = pk2(v0[2], v0[3]); w.z = pk2(v1[0], v1[1]); w.w = pk2(v1[2], v1[3]);
                    *(v4u*)(rowp + bj * 128) = w;
                }
            }
    }
};
template <bool XF32, bool SSQ> struct EpiRes {
    const float* xf; const bf16* xi; int ldi; bf16* xo; int ldo; float* ssq16;
    __device__ __forceinline__ void operator()(const f32x4 (&acc)[2][2][4][2], const pg8::Unit& u, int wr, int wc, int fr, int fq) const {
        const int row0 = u.pm * 256 + wr * 64 + fr, col0 = u.pn * 256 + wc * 32 + 8 * fq;
        if constexpr (!XF32) {
            v4u res[2][4][2];
#pragma unroll
            for (int ai = 0; ai < 2; ++ai)
#pragma unroll
                for (int m = 0; m < 4; ++m)
#pragma unroll
                    for (int bj = 0; bj < 2; ++bj) res[ai][m][bj] = *(const v4u*)(xi + (size_t)(row0 + ai * 128 + m * 16) * ldi + col0 + bj * 128);
            asm volatile("s_waitcnt vmcnt(0)" ::: "memory");
#pragma unroll
            for (int ai = 0; ai < 2; ++ai)
#pragma unroll
                for (int m = 0; m < 4; ++m) {
                    const int row = row0 + ai * 128 + m * 16;
                    float ss = 0.f;
#pragma unroll
                    for (int bj = 0; bj < 2; ++bj) {
                        const v4u w0 = res[ai][m][bj];
                        const f32x4 r0 = (f32x4){bflo(w0.x), bfhi(w0.x), bflo(w0.y), bfhi(w0.y)}, r1 = (f32x4){bflo(w0.z), bfhi(w0.z), bflo(w0.w), bfhi(w0.w)};
                        const f32x4 v0 = acc[ai][bj][m][0] + r0, v1 = acc[ai][bj][m][1] + r1;
                        v4u w; w.x = pk2(v0[0], v0[1]); w.y = pk2(v0[2], v0[3]); w.z = pk2(v1[0], v1[1]); w.w = pk2(v1[2], v1[3]);
                        *(v4u*)(xo + (size_t)row * ldo + col0 + bj * 128) = w;
                        if (SSQ) ss += ((v0[0] * v0[0] + v0[1] * v0[1]) + (v0[2] * v0[2] + v0[3] * v0[3])) + ((v1[0] * v1[0] + v1[1] * v1[1]) + (v1[2] * v1[2] + v1[3] * v1[3]));
                    }
                    if (SSQ) { ss += __shfl_xor(ss, 16); ss += __shfl_xor(ss, 32);
                        if (fq == 0) ssq16[(size_t)row * 16 + u.pn * 4 + wc] = ss; }
                }
        } else {
#pragma unroll
            for (int ai = 0; ai < 2; ++ai)
#pragma unroll
                for (int m = 0; m < 4; ++m) {
                    const int row = row0 + ai * 128 + m * 16;
                    float ss = 0.f;
#pragma unroll
                    for (int bj = 0; bj < 2; ++bj) {
                        const size_t off = (size_t)row * D + col0 + bj * 128; const f32x4 r0 = *(const f32x4*)(xf + off), r1 = *(const f32x4*)(xf + off + 4);
                        const f32x4 v0 = acc[ai][bj][m][0] + r0, v1 = acc[ai][bj][m][1] + r1;
                        v4u w; w.x = pk2(v0[0], v0[1]); w.y = pk2(v0[2], v0[3]); w.z = pk2(v1[0], v1[1]); w.w = pk2(v1[2], v1[3]);
                        *(v4u*)(xo + (size_t)row * ldo + col0 + bj * 128) = w;
                        if (SSQ) ss += ((v0[0] * v0[0] + v0[1] * v0[1]) + (v0[2] * v0[2] + v0[3] * v0[3])) + ((v1[0] * v1[0] + v1[1] * v1[1]) + (v1[2] * v1[2] + v1[3] * v1[3]));
                    }
                    if (SSQ) { ss += __shfl_xor(ss, 16); ss += __shfl_xor(ss, 32);
                        if (fq == 0) ssq16[(size_t)row * 16 + u.pn * 4 + wc] = ss; }
                }
        }
    }
};
template <int SCALE, bool OUT8 = false> struct EpiSwiglu {
    bf16* H; int ldh; const float* sc; const LAS float* rsl; float kc;
    __device__ __forceinline__ void operator()(const f32x4 (&acc)[2][2][4][2], const pg8::Unit& u, int wr, int wc, int fr, int fq) const {
        const int row0 = u.pm * 256 + wr * 64 + fr, col0 = u.pn * 128 + wc * 32 + 8 * fq;
#pragma unroll
        for (int ai = 0; ai < 2; ++ai)
#pragma unroll
            for (int m = 0; m < 4; ++m) {
                const int row = row0 + ai * 128 + m * 16;
                float rs = 1.f;
                if (SCALE == 1) rs = sc[row];
                if (SCALE == 2) { const f32x4* p = (const f32x4*)(sc + (size_t)row * 16); const f32x4 a = p[0], b = p[1], c = p[2], d = p[3];
                    const float s = ((a.x + a.y) + (a.z + a.w)) + ((b.x + b.y) + (b.z + b.w)) + ((c.x + c.y) + (c.z + c.w)) + ((d.x + d.y) + (d.z + d.w));
                    rs = 1.0f / sqrtf(s * (1.0f / D) + EPS); }
                if (SCALE == 4) rs = rsl[u.idx * 256 + (row - u.pm * 256)];
                if (SCALE == 5) rs = kc;
                float h[8];
#pragma unroll
                for (int n = 0; n < 2; ++n)
#pragma unroll
                    for (int j = 0; j < 4; ++j) { const float gv = acc[ai][0][m][n][j] * rs, uv = acc[ai][1][m][n][j] * rs;
                        h[n * 4 + j] = gv * uv * __builtin_amdgcn_rcpf(1.0f + __expf(-gv)); }
                if (OUT8) { v2u w; w.x = pk4_fp8(h[0], h[1], h[2], h[3]); w.y = pk4_fp8(h[4], h[5], h[6], h[7]); *(v2u*)((unsigned char*)H + (size_t)row * ldh + col0) = w; }
                else { v4u w; w.x = pk2(h[0], h[1]); w.y = pk2(h[2], h[3]); w.z = pk2(h[4], h[5]); w.w = pk2(h[6], h[7]);
                    *(v4u*)(H + (size_t)row * ldh + col0) = w; }
            }
    }
};

template <class Sched>
__device__ __forceinline__ void fill_rstd_table(LAS unsigned char* lds, const Sched& S, const float* ssq16, int tid) {
    LAS float* rsl = (LAS float*)(lds + RSL_OFF);
    pg8::Unit u;
    for (int ui = 0; ui < 16 && S.next(ui, u); ++ui) {
        if (tid < 256) { const f32x4* p = (const f32x4*)(ssq16 + (size_t)(u.pm * 256 + tid) * 16); const f32x4 a = p[0], b = p[1], c = p[2], d = p[3];
            const float s = ((a.x + a.y) + (a.z + a.w)) + ((b.x + b.y) + (b.z + b.w)) + ((c.x + c.y) + (c.z + c.w)) + ((d.x + d.y) + (d.z + d.w));
            rsl[ui * 256 + tid] = 1.0f / sqrtf(s * (1.0f / D) + EPS); }
    }
    __syncthreads();
}

__device__ __forceinline__ void p0_transpose_item(const float* W, int K, int N, bf16* WT, const float* gain, int mode, LAS float* scr, int item, int lane) {
    const int nblk = N / 64, kb = item / nblk, nb = item % nblk, k0 = 64 * kb, n0 = 64 * nb;
    const int lr = lane >> 4, lc = lane & 15;
    f32x4 v[16];
#pragma unroll
    for (int i = 0; i < 16; ++i) v[i] = __builtin_nontemporal_load((const f32x4*)(W + (size_t)(k0 + 4 * i + lr) * N + n0 + 4 * lc));
    if (gain) {
#pragma unroll
        for (int i = 0; i < 16; ++i) v[i] = v[i] * gain[k0 + 4 * i + lr];
    }
#pragma unroll
    for (int i = 0; i < 16; ++i) { LAS float* s = scr + (4 * i + lr) * 65 + 4 * lc; s[0] = v[i].x; s[1] = v[i].y; s[2] = v[i].z; s[3] = v[i].w; }
    LDS_WAIT(); asm volatile("" ::: "memory");
    const int c = lane & 7;
    const int d0 = (mode == 0) ? n0 : (256 * (n0 / 128) + (n0 % 128) + (mode == 2 ? 128 : 0));
#pragma unroll
    for (int j = 0; j < 8; ++j) { const int n = (lane >> 3) + 8 * j; const LAS float* s = scr + (8 * c) * 65 + n;
        v4u o; o.x = pk2(s[0 * 65], s[1 * 65]); o.y = pk2(s[2 * 65], s[3 * 65]); o.z = pk2(s[4 * 65], s[5 * 65]); o.w = pk2(s[6 * 65], s[7 * 65]);
        *(v4u*)(WT + (size_t)(d0 + n) * K + k0 + 8 * c) = o; }
    LDS_WAIT(); asm volatile("" ::: "memory");
}
__device__ __forceinline__ void p0_transpose_item8(const float* W, int K, int N, unsigned char* WT8, const float* gain, float s8, int mode, LAS float* scr, int item, int lane) {
    const int nblk = N / 64, kb = item / nblk, nb = item % nblk, k0 = 64 * kb, n0 = 64 * nb;
    const int lr = lane >> 4, lc = lane & 15;
    f32x4 v[16];
#pragma unroll
    for (int i = 0; i < 16; ++i) v[i] = __builtin_nontemporal_load((const f32x4*)(W + (size_t)(k0 + 4 * i + lr) * N + n0 + 4 * lc));
#pragma unroll
    for (int i = 0; i < 16; ++i) { const float g = gain ? gain[k0 + 4 * i + lr] * s8 : s8; v[i] = v[i] * g; }
#pragma unroll
    for (int i = 0; i < 16; ++i) { LAS float* s = scr + (4 * i + lr) * 65 + 4 * lc; s[0] = v[i].x; s[1] = v[i].y; s[2] = v[i].z; s[3] = v[i].w; }
    LDS_WAIT(); asm volatile("" ::: "memory");
    const int c = lane & 3;
    const int d0 = (mode == 0) ? n0 : (256 * (n0 / 128) + (n0 % 128) + (mode == 2 ? 128 : 0));
#pragma unroll
    for (int j = 0; j < 4; ++j) { const int n = (lane >> 2) + 16 * j; const LAS float* s = scr + (16 * c) * 65 + n;
        v4u o; o.x = pk4_fp8(s[0 * 65], s[1 * 65], s[2 * 65], s[3 * 65]); o.y = pk4_fp8(s[4 * 65], s[5 * 65], s[6 * 65], s[7 * 65]);
        o.z = pk4_fp8(s[8 * 65], s[9 * 65], s[10 * 65], s[11 * 65]); o.w = pk4_fp8(s[12 * 65], s[13 * 65], s[14 * 65], s[15 * 65]);
        __builtin_nontemporal_store(o, (v4u*)(WT8 + (size_t)(d0 + n) * K + k0 + 16 * c)); }
    LDS_WAIT(); asm volatile("" ::: "memory");
}
__device__ __forceinline__ float row_to_bf16(const float* xrow, bf16* orow, const float* gain, bool normalize, int lane) {
    const f32x4* xr = (const f32x4*)xrow + lane;
    f32x4 v[4]; float s = 0.f;
#pragma unroll
    for (int j = 0; j < 4; ++j) { v[j] = __builtin_nontemporal_load(xr + 64 * j); s += (v[j].x * v[j].x + v[j].y * v[j].y) + (v[j].z * v[j].z + v[j].w * v[j].w); }
    const float rstd = 1.0f / sqrtf(wave_sum(s) * (1.f / D) + EPS);
    unsigned long long* o8 = (unsigned long long*)orow + lane;
#pragma unroll
    for (int j = 0; j < 4; ++j) {
        f32x4 w = v[j];
        if (normalize) { const f32x4 g = ((const f32x4*)gain)[lane + 64 * j]; w = w * rstd * g; }
        o8[64 * j] = (unsigned long long)pk2(w.x, w.y) | ((unsigned long long)pk2(w.z, w.w) << 32);
    }
    return rstd;
}
__device__ __forceinline__ void p0_filter_block(Frame& F, const Args& a, float* Hf, int jb) {
    const float* w1 = a.in[I_FW1]; const float* b1 = a.in[I_FB1]; const float* w2 = a.in[I_FW2]; const float* b2 = a.in[I_FB2]; const float* w3 = a.in[I_FW3]; const float* fr = a.in[I_FREQ];
    LAS float* h2s = (LAS float*)(F.lds + MISC_OFF + 256);
    const int lane = F.lane, j0 = jb * 8;
    LAS float* W1s = (LAS float*)F.lds; LAS float* W2s = W1s + 33 * 64;
    for (int i = F.tid; i < 33 * 64; i += 512) W1s[i] = w1[i];
    for (int i = F.tid; i < 64 * 64; i += 512) W2s[i] = w2[i];
    __syncthreads();
    {
        const int j = j0 + F.wave;
        const float freq = fr[lane], bb1 = b1[lane], bb2 = b2[lane];
        float feat = 0.f;
        {
            const int fi = (lane >= 17) ? lane - 17 : lane - 1;
            const float f = 1e-4f + (float)fi * ((15.0f - 1e-4f) / 15.0f);
            const float ang = (6.283185307179586f / 2048.0f) * (float)j * f;
            if (lane == 0) feat = (float)j * (1.0f / 2047.0f);
            else if (lane <= 16) feat = cosf(ang);
            else if (lane <= 32) feat = -sinf(ang);
        }
        float s1 = bb1;
#pragma unroll
        for (int i = 0; i < 33; ++i) s1 += __shfl(feat, i) * W1s[i * 64 + lane];
        const float h1 = sinf(freq * s1);
        float s2 = bb2;
#pragma unroll 16
        for (int i = 0; i < 64; ++i) s2 += __shfl(h1, i) * W2s[i * 64 + lane];
        h2s[lane * 8 + F.wave] = sinf(freq * s2);
    }
    __syncthreads();
    const int n0 = F.wave * 256;
    float acc[4][8];
#pragma unroll
    for (int q = 0; q < 4; ++q)
#pragma unroll
        for (int jj = 0; jj < 8; ++jj) acc[q][jj] = 0.f;
#pragma unroll 1
    for (int i0 = 0; i0 < 64; i0 += 8) {
        float w[8][4];
#pragma unroll
        for (int ii = 0; ii < 8; ++ii)
#pragma unroll
            for (int q = 0; q < 4; ++q) w[ii][q] = w3[(size_t)(i0 + ii) * 2048 + n0 + q * 64 + lane];
#pragma unroll
        for (int ii = 0; ii < 8; ++ii) {
            const f32x4 ha = *(const LAS f32x4*)(h2s + (i0 + ii) * 8), hb = *(const LAS f32x4*)(h2s + (i0 + ii) * 8 + 4);
#pragma unroll
            for (int q = 0; q < 4; ++q) {
                acc[q][0] += ha.x * w[ii][q]; acc[q][1] += ha.y * w[ii][q]; acc[q][2] += ha.z * w[ii][q]; acc[q][3] += ha.w * w[ii][q];
                acc[q][4] += hb.x * w[ii][q]; acc[q][5] += hb.y * w[ii][q]; acc[q][6] += hb.z * w[ii][q]; acc[q][7] += hb.w * w[ii][q]; }
        }
    }
    const float da = -3.0701134573253945f, db = -15.350567286626973f;
#pragma unroll
    for (int q = 0; q < 4; ++q) {
        const int n = n0 + q * 64 + lane, c = n & 511;
        const float delta = fabsf(da + (db - da) * ((float)c * (1.0f / 511.0f)));
        float o[8];
#pragma unroll
        for (int jj = 0; jj < 8; ++jj) { const float t = (float)(j0 + jj) * (1.0f / 2047.0f); o[jj] = acc[q][jj] * (expf(-t * delta) + 0.05f); }
        f32x4* dst = (f32x4*)(Hf + (size_t)n * 2048 + j0);
        dst[0] = (f32x4){o[0], o[1], o[2], o[3]}; dst[1] = (f32x4){o[4], o[5], o[6], o[7]};
    }
    __syncthreads();
}
constexpr int IT_MOE = 16 * 44, N_MOE_ITEMS = 24 * IT_MOE;
constexpr int MOE_P1_HI = 5376, MOE_P5_HI = 16896, MOE_P0_LO = MOE_P5_HI;
__device__ __forceinline__ void moe_convert(Frame& F, const Args& a, int lo, int hi, int gwl, int ngw) {
    LAS float* scr = (LAS float*)(F.lds + F.wave * 16640);
    unsigned char* ws = F.ws;
    for (int r = lo + gwl; r < hi; r += ngw) {
        const int mid = r / IT_MOE, li = r % IT_MOE, kind = mid >> 3, e = mid & 7;
        if (kind == 0) p0_transpose_item8(a.in[I_MOEG] + (size_t)e * D * FF, D, FF, ws + WS_WGU1 + (size_t)e * NGU * D, a.in[I_NFFN] + D, MOE_WGU_SCALE, 1, scr, li, F.lane);
        else if (kind == 1) p0_transpose_item8(a.in[I_MOEU] + (size_t)e * D * FF, D, FF, ws + WS_WGU1 + (size_t)e * NGU * D, a.in[I_NFFN] + D, MOE_WGU_SCALE, 2, scr, li, F.lane);
        else p0_transpose_item8(a.in[I_MOED] + (size_t)e * FF * D, FF, D, ws + WS_WD1 + (size_t)e * D * FF, nullptr, MOE_WD_SCALE, 0, scr, li, F.lane);
    }
}
__device__ __forceinline__ void p0_prologue(Frame& F, const Args& a) {
    LAS float* scr = (LAS float*)(F.lds + F.wave * 16640);
    const int gw = F.bid * NWAVES + F.wave, NGW = F.G * NWAVES;
    unsigned char* ws = F.ws;
    if (!(F.bid & 1)) { for (int jb = F.bid; jb < 256; jb += F.G) p0_filter_block(F, a, (float*)(ws + WS_HF), jb); }
    for (int m = gw; m < T; m += NGW) { const float r = row_to_bf16(a.in[I_X] + (size_t)m * D, (bf16*)(ws + WS_XB) + (size_t)m * D, nullptr, false, F.lane); if (F.lane == 0) ((float*)(ws + WS_RSTD0))[m] = r; }
    for (int m = gw; m < 2 * TM; m += NGW) { const int l = m / TM, r = m % TM;
        (void)row_to_bf16(a.in[I_MEM] + (size_t)r * D, (bf16*)(ws + WS_MN) + (size_t)m * D, a.in[I_NMEM] + l * D, true, F.lane); }
    constexpr int IT_A = 16 * 32, IT_SQ = 16 * 16, IT_G = 16 * 44, IT_D = 44 * 16, IT_W1 = 16 * 80;
    constexpr int NSMALL = IT_A + 4 * IT_SQ + 2 * IT_G + IT_D + IT_W1;
    for (int it = gw; it < NSMALL; it += NGW) {
        int r = it;
        if (r < IT_A) { p0_transpose_item(a.in[I_HYWIN], D, NZ0, (bf16*)(ws + WS_WIN0), a.in[I_NMIX], 0, scr, r, F.lane); continue; } r -= IT_A;
        if (r < IT_SQ) { p0_transpose_item(a.in[I_WKV], D, D, (bf16*)(ws + WS_WKV), nullptr, 0, scr, r, F.lane); continue; } r -= IT_SQ;
        if (r < IT_SQ) { p0_transpose_item(a.in[I_WKV] + (size_t)D * D, D, D, (bf16*)(ws + WS_WKV) + (size_t)D * D, nullptr, 0, scr, r, F.lane); continue; } r -= IT_SQ;
        if (r < IT_SQ) { p0_transpose_item(a.in[I_WOUT], D, D, (bf16*)(ws + WS_WO), nullptr, 0, scr, r, F.lane); continue; } r -= IT_SQ;
        if (r < IT_SQ) { p0_transpose_item(a.in[I_WOUT] + (size_t)D * D, D, D, (bf16*)(ws + WS_WO) + (size_t)D * D, nullptr, 0, scr, r, F.lane); continue; } r -= IT_SQ;
        if (r < IT_G) { p0_transpose_item(a.in[I_FFG], D, FF, (bf16*)(ws + WS_WGU0), a.in[I_NFFN], 1, scr, r, F.lane); continue; } r -= IT_G;
        if (r < IT_G) { p0_transpose_item(a.in[I_FFU], D, FF, (bf16*)(ws + WS_WGU0), a.in[I_NFFN], 2, scr, r, F.lane); continue; } r -= IT_G;
        if (r < IT_D) { p0_transpose_item(a.in[I_FFD], FF, D, (bf16*)(ws + WS_WD0), nullptr, 0, scr, r, F.lane); continue; } r -= IT_D;
        p0_transpose_item(a.in[I_ATWIN], D, NQ1, (bf16*)(ws + WS_WIN1), a.in[I_NMIX] + D, 0, scr, r, F.lane);
    }
    moe_convert(F, a, (F.G == 256) ? MOE_P0_LO : 0, N_MOE_ITEMS, gw, NGW);
    if (F.bid & 1) { __syncthreads(); for (int jb = F.bid; jb < 256; jb += F.G) p0_filter_block(F, a, (float*)(ws + WS_HF), jb); }
}
__device__ __forceinline__ float block_sum(Frame& F, float v) {
    LAS float* red = (LAS float*)(F.lds + MISC_OFF + 64);
    v = wave_sum(v);
    __syncthreads();
    if (F.lane == 0) red[F.wave] = v;
    __syncthreads();
    float s = 0.f;
#pragma unroll
    for (int w = 0; w < NWAVES; ++w) s += red[w];
    return s;
}
__device__ __forceinline__ int rel_bucket_dev(int rel) {
    const int n = rel < 0 ? -rel : rel;
    const int large = 8 + (n >= 15) + (n >= 27) + (n >= 50) + (n >= 91) + (n >= 166) + (n >= 305) + (n >= 559);
    return (rel > 0 ? 16 : 0) + (n < 8 ? n : large);
}
__device__ __forceinline__ void merge_token(Frame& F, int token) {
    const bf16* og = (const bf16*)(F.ws + WS_OG12); const float* lse = (const float*)(F.ws + WS_LSE);
    bf16* mix = (bf16*)(F.ws + WS_MIX1);
    const int lane = F.lane, h = lane >> 4;
    const float l0 = lse[(size_t)token * 4 + h], l1 = lse[((size_t)T + token) * 4 + h], l2 = lse[((size_t)2 * T + token) * 4 + h];
    const float mx = fmaxf(l0, fmaxf(l1, l2));
    float w0 = __expf(l0 - mx), w1 = __expf(l1 - mx), w2 = __expf(l2 - mx);
    const float iz = 1.0f / (w0 + w1 + w2); w0 *= iz; w1 *= iz; w2 *= iz;
    const v4u a0 = *(const v4u*)(mix + (size_t)token * D + 8 * lane);
    const v4u a1 = __builtin_nontemporal_load((const v4u*)(og + (size_t)token * 512 + 8 * lane));
    const v4u a2 = __builtin_nontemporal_load((const v4u*)(og + ((size_t)T + token) * 512 + 8 * lane));
    v4u o;
    o.x = pk2(w0 * bflo(a0.x) + w1 * bflo(a1.x) + w2 * bflo(a2.x), w0 * bfhi(a0.x) + w1 * bfhi(a1.x) + w2 * bfhi(a2.x));
    o.y = pk2(w0 * bflo(a0.y) + w1 * bflo(a1.y) + w2 * bflo(a2.y), w0 * bfhi(a0.y) + w1 * bfhi(a1.y) + w2 * bfhi(a2.y));
    o.z = pk2(w0 * bflo(a0.z) + w1 * bflo(a1.z) + w2 * bflo(a2.z), w0 * bfhi(a0.z) + w1 * bfhi(a1.z) + w2 * bfhi(a2.z));
    o.w = pk2(w0 * bflo(a0.w) + w1 * bflo(a1.w) + w2 * bflo(a2.w), w0 * bfhi(a0.w) + w1 * bfhi(a1.w) + w2 * bfhi(a2.w));
    *(v4u*)(mix + (size_t)token * D + 8 * lane) = o;
}

constexpr int RT_OFF_R = 0, RT_OFF_REC = 32768, RT_OFF_CNT = 32768 + 64 * 32;
__device__ __forceinline__ void route_block(Frame& F, const Args& a, int blk) {
    LAS float* RL = (LAS float*)(F.lds + RT_OFF_R); volatile LAS int* REC = (volatile LAS int*)(F.lds + RT_OFF_REC); LAS int* CNT = (LAS int*)(F.lds + RT_OFF_CNT);
    const int lane = F.lane;
    const float* g = a.in[I_NFFN] + D; const float* rt = a.in[I_ROUTER];
    __syncthreads();
    for (int i = F.tid; i < 2048; i += 512) { const f32x4 r = ((const f32x4*)rt)[i]; const float gg = g[i >> 1]; ((LAS f32x4*)RL)[i] = r * gg; }
    if (F.tid < 16) CNT[F.tid] = 0;
    __syncthreads();
    for (int q = 0; q < 8; ++q) {
        const int tl = F.wave * 8 + q, token = blk * 64 + tl;
        const bf16* xr = (const bf16*)a.out + (size_t)token * 2048 + 1024;
        f32x4 v[4]; float s = 0.f;
#pragma unroll
        for (int j = 0; j < 4; ++j) { const v2u w = __builtin_nontemporal_load((const v2u*)xr + lane + 64 * j); v[j] = (f32x4){bflo(w.x), bfhi(w.x), bflo(w.y), bfhi(w.y)}; s += (v[j].x * v[j].x + v[j].y * v[j].y) + (v[j].z * v[j].z + v[j].w * v[j].w); }
        const float rstd = 1.0f / sqrtf(wave_sum(s) * (1.f / D) + EPS);
        { unsigned* o4 = (unsigned*)(F.ws + WS_XB3 + (size_t)token * D) + lane;
#pragma unroll
          for (int j = 0; j < 4; ++j) o4[64 * j] = pk4_fp8(v[j].x * rstd, v[j].y * rstd, v[j].z * rstd, v[j].w * rstd); }
        float lg[8];
#pragma unroll
        for (int e = 0; e < 8; ++e) lg[e] = 0.f;
#pragma unroll
        for (int j = 0; j < 4; ++j) {
            const int k0 = 4 * (lane + 64 * j);
#pragma unroll
            for (int qq = 0; qq < 4; ++qq) {
                const float hn = v[j][qq] * rstd;
                const f32x4 r0 = *(const LAS f32x4*)(RL + (k0 + qq) * 8), r1 = *(const LAS f32x4*)(RL + (k0 + qq) * 8 + 4);
                lg[0] += hn * r0.x; lg[1] += hn * r0.y; lg[2] += hn * r0.z; lg[3] += hn * r0.w;
                lg[4] += hn * r1.x; lg[5] += hn * r1.y; lg[6] += hn * r1.z; lg[7] += hn * r1.w;
            }
        }
#pragma unroll
        for (int e = 0; e < 8; ++e) lg[e] = wave_sum(lg[e]);
        int i1 = 0; float v1 = lg[0];
#pragma unroll
        for (int e = 1; e < 8; ++e) if (lg[e] > v1) { v1 = lg[e]; i1 = e; }
        int i2 = -1; float v2 = -3.0e38f;
#pragma unroll
        for (int e = 0; e < 8; ++e) if (e != i1 && lg[e] > v2) { v2 = lg[e]; i2 = e; }
        const float e2 = __expf(v2 - v1), g1 = 1.0f / (1.0f + e2), g2 = e2 * g1;
        if (lane == 0) {
            const int r1 = __hip_atomic_fetch_add(CNT + i1, 1, __ATOMIC_RELAXED, __HIP_MEMORY_SCOPE_WORKGROUP);
            const int r2 = __hip_atomic_fetch_add(CNT + i2, 1, __ATOMIC_RELAXED, __HIP_MEMORY_SCOPE_WORKGROUP);
            REC[tl * 8 + 0] = i1; REC[tl * 8 + 1] = i2; REC[tl * 8 + 2] = r1; REC[tl * 8 + 3] = r2;
            REC[tl * 8 + 4] = __builtin_bit_cast(int, g1); REC[tl * 8 + 5] = __builtin_bit_cast(int, g2); REC[tl * 8 + 6] = __builtin_bit_cast(int, rstd);
        }
    }
    __syncthreads();
    if (F.tid < 8) { unsigned* cnt = (unsigned*)(F.ws + WS_CTL) + CW_CNT; CNT[8 + F.tid] = (int)__hip_atomic_fetch_add(cnt + F.tid, (unsigned)CNT[F.tid], __ATOMIC_RELAXED, __HIP_MEMORY_SCOPE_AGENT); }
    __syncthreads();
    if (F.tid < 64) {
        const int tl = F.tid, token = blk * 64 + tl;
        const int i1 = REC[tl * 8 + 0], i2 = REC[tl * 8 + 1], r1 = CNT[8 + i1] + REC[tl * 8 + 2], r2 = CNT[8 + i2] + REC[tl * 8 + 3];
        int* toke = (int*)(F.ws + WS_TOKE); int* tokr = (int*)(F.ws + WS_TOKR); int* tokg = (int*)(F.ws + WS_TOKG); int* list = (int*)(F.ws + WS_LIST);
        list[(size_t)i1 * T + r1] = token; list[(size_t)i2 * T + r2] = token;
        toke[token * 2] = i1; toke[token * 2 + 1] = i2; tokr[token * 2] = r1; tokr[token * 2 + 1] = r2;
        tokg[token * 2] = REC[tl * 8 + 4]; tokg[token * 2 + 1] = REC[tl * 8 + 5];
        ((int*)(F.ws + WS_RSTD3))[token] = REC[tl * 8 + 6];
    }
}
__device__ __forceinline__ void moe_layout(Frame& F) {
    volatile LAS int* M = (volatile LAS int*)(F.lds + MISC_OFF);
    __syncthreads();
    if (F.tid == 0) {
        const unsigned* cnt = (const unsigned*)(F.ws + WS_CTL) + CW_CNT;
        int acc = 0;
        for (int e = 0; e < 8; ++e) { const int c = (int)__hip_atomic_load(cnt + e, __ATOMIC_RELAXED, __HIP_MEMORY_SCOPE_AGENT); M[32 + e] = c; M[40 + e] = acc; acc += (c + 255) & ~255; }
        M[48] = acc;
    }
    __syncthreads();
}
__device__ __forceinline__ int ml_ps(Frame& F, int e) { return ((volatile LAS int*)(F.lds + MISC_OFF))[40 + e]; }
__device__ __forceinline__ int ml_cnt(Frame& F, int e) { return ((volatile LAS int*)(F.lds + MISC_OFF))[32 + e]; }
__device__ __forceinline__ int ml_total(Frame& F) { return ((volatile LAS int*)(F.lds + MISC_OFF))[48]; }
__device__ __forceinline__ int ml_expert(Frame& F, int slot) { int e = 0;
#pragma unroll
    for (int i = 1; i < 8; ++i) e += (slot >= ml_ps(F, i)) ? 1 : 0;
    return e; }

constexpr int HY_CS = 4168, HY_M0 = 2080, HY_UR = 2592, HY_UP = 256;
constexpr int HY_OFF_CP = 64, HY_OFF_UB = HY_OFF_CP + 8 * HY_CS * 2, HY_OFF_X = HY_OFF_UB + 8 * HY_UR * 2;
static_assert(HY_OFF_X + 8 * 2048 * 2 <= SCR_BYTES, "hyena LDS");
typedef short bf16x8_t __attribute__((ext_vector_type(8)));

struct HyStage { v4u raw[4]; float zm[4], zp[4]; };
struct HyFilt { float f[4], b[4]; };
__device__ __forceinline__ void hy_short_load(HyStage& s, const bf16* zr, int tid) {
#pragma unroll
    for (int k = 0; k < 4; ++k) {
        const int item = tid + 512 * k, b = item >> 8, t8 = (item & 255) * 8;
        const bf16* p = zr + b * SEQ + t8;
        s.raw[k] = __builtin_nontemporal_load((const v4u*)p);
        s.zm[k] = (t8 > 0) ? bf1(p[-1]) : 0.f; s.zp[k] = (t8 + 8 < SEQ) ? bf1(p[8]) : 0.f;
    }
}
__device__ __forceinline__ void hy_short_store(LAS unsigned char* dst, int stride_el, int pad_el, const HyStage& s, float w0, float w1, float w2, float cb, int tid) {
#pragma unroll
    for (int k = 0; k < 4; ++k) {
        const int item = tid + 512 * k, b = item >> 8, t8 = (item & 255) * 8;
        float z[10];
        z[0] = s.zm[k]; z[1] = bflo(s.raw[k].x); z[2] = bfhi(s.raw[k].x); z[3] = bflo(s.raw[k].y); z[4] = bfhi(s.raw[k].y); z[5] = bflo(s.raw[k].z); z[6] = bfhi(s.raw[k].z); z[7] = bflo(s.raw[k].w); z[8] = bfhi(s.raw[k].w); z[9] = s.zp[k];
        float o[8];
#pragma unroll
        for (int i = 0; i < 8; ++i) o[i] = cb + z[i] * w0 + z[i + 1] * w1 + z[i + 2] * w2;
        v4u w; w.x = pk2(o[0], o[1]); w.y = pk2(o[2], o[3]); w.z = pk2(o[4], o[5]); w.w = pk2(o[6], o[7]);
        *(LAS v4u*)(dst + (size_t)(b * stride_el + pad_el + t8) * 2) = w;
    }
}
__device__ __forceinline__ void hy_filt_load(HyFilt& q, const float* Hf, int o, int c, int tid) {
    const float* fw = Hf + ((size_t)(o * 2 + 0) * 512 + c) * 2048;
    const float* bw = Hf + ((size_t)(o * 2 + 1) * 512 + c) * 2048;
#pragma unroll
    for (int i = 0; i < 4; ++i) { const int j = tid + 512 * i; q.f[i] = __builtin_nontemporal_load(fw + j); q.b[i] = (j >= 1) ? __builtin_nontemporal_load(bw + j) : 0.f; }
}
__device__ __forceinline__ void hy_filt_build(Frame& F, const HyFilt& q) {
    LAS float* Kf = (LAS float*)(F.lds + HY_OFF_X);
    float s = 0.f;
#pragma unroll
    for (int i = 0; i < 4; ++i) s += fabsf(q.f[i]) + fabsf(q.b[i]);
    const float tot = block_sum(F, s);
    const float inv = 1.0f / (tot + 1e-6f);
#pragma unroll
    for (int i = 0; i < 4; ++i) { const int j = F.tid + 512 * i; Kf[HY_M0 - j] = q.f[i] * inv; if (j >= 1) Kf[HY_M0 + j] = q.b[i] * inv; }
    if (F.tid < 33) Kf[F.tid] = 0.f;
    if (F.tid < 48) Kf[4128 + F.tid] = 0.f;
    __syncthreads();
    LAS unsigned* cp = (LAS unsigned*)(F.lds + HY_OFF_CP);
    for (int p = F.tid; p < 8 * (HY_CS / 2); p += 512) { const int j = p / (HY_CS / 2), xp = p - j * (HY_CS / 2), x = 2 * xp + j; cp[p] = pk2(Kf[x], Kf[x + 1]); }
    __syncthreads();
}
__device__ __forceinline__ void hy_conv_mfma(Frame& F, f32x4 (&C)[8]) {
    const int lane = F.lane, w = F.wave, r = lane & 15, kq = lane >> 4;
    const int jc = (-r) & 7, cr = (r + 7) >> 3;
    const LAS unsigned char* abase = F.lds + HY_OFF_CP + (size_t)(jc * HY_CS + HY_M0 - 32 * (8 * w - 63) + 8 * kq - 8 * cr) * 2;
    const LAS unsigned char* bbase = F.lds + HY_OFF_UB + (size_t)((r & 7) * HY_UR + HY_UP + 16 * (r >> 3) + 8 * kq) * 2;
#pragma unroll
    for (int i = 0; i < 8; ++i) C[i] = (f32x4){0.f, 0.f, 0.f, 0.f};
    bf16x8_t Bw[9];
#pragma unroll
    for (int i = 0; i < 8; ++i) Bw[i] = *(const LAS bf16x8_t*)(bbase + 64 * (63 + i));
    bf16x8_t An = *(const LAS bf16x8_t*)(abase);
#pragma unroll 1
    for (int Q = 0; Q < 8; ++Q) {
        const LAS unsigned char* ab = abase - 64 * (9 * Q);
        const LAS unsigned char* bb = bbase + 64 * (63 - 9 * Q);
#pragma unroll
        for (int qq = 0; qq < 9; ++qq) {
            const bf16x8_t A = An;
            An = *(const LAS bf16x8_t*)(ab - 64 * (qq + 1));
            Bw[(8 - qq + 9) % 9] = *(const LAS bf16x8_t*)(bb + 64 * (-1 - qq));
#pragma unroll
            for (int i = 7; i >= 0; --i) C[i] = __builtin_amdgcn_mfma_f32_16x16x32_bf16(A, Bw[(i - qq + 9) % 9], C[i], 0, 0, 0);
        }
    }
}
__device__ __forceinline__ void hyena_units(Frame& F, const Args& a) {
    const bf16* zT = (const bf16*)(F.ws + WS_ZT);
    const float* Hf = (const float*)(F.ws + WS_HF);
    const float* cw = a.in[I_HYCW]; const float* cbp = a.in[I_HYCB]; const float* skip = a.in[I_SKIP];
    bf16* yT = (bf16*)(F.ws + WS_YT);
    LAS unsigned char* UB = F.lds + HY_OFF_UB; LAS unsigned char* XB = F.lds + HY_OFF_X;
    int c = F.bid; if (c >= HYC) return;
    HyStage sA, sC, sG; HyFilt fB, fF;
    hy_short_load(sA, zT + (size_t)c * T, F.tid); hy_filt_load(fB, Hf, 0, c, F.tid); hy_short_load(sC, zT + (size_t)(HYC + c) * T, F.tid);
#pragma unroll 1
    for (;;) {
        const int lane = F.lane, w = F.wave, n = lane & 15, bb = n & 7, hh = n >> 3, rq = lane >> 4;
        __syncthreads();
        for (int p = F.tid; p < 8 * 272; p += 512) { const int b = p / 272, q = p - b * 272; const int el = (q < 128) ? 2 * q : (HY_UP + SEQ + 2 * (q - 128)); *(LAS unsigned*)(UB + (size_t)(b * HY_UR + el) * 2) = 0u; }
        { const int ch = c; hy_short_store(UB, HY_UR, HY_UP, sA, cw[ch], cw[1536 + ch], cw[3072 + ch], cbp[ch], F.tid); }
        hy_filt_build(F, fB);
        { const int ch = HYC + c; hy_short_store(XB, SEQ, 0, sC, cw[ch], cw[1536 + ch], cw[3072 + ch], cbp[ch], F.tid); }
        hy_filt_load(fF, Hf, 1, c, F.tid); hy_short_load(sG, zT + (size_t)(2 * HYC + c) * T, F.tid);
        __syncthreads();
        f32x4 C[8];
        hy_conv_mfma(F, C);
        __syncthreads();
        {   const float sk = skip[c];
#pragma unroll
            for (int i = 0; i < 8; ++i) {
                const int t0 = 32 * (8 * w + i) + 16 * hh + 4 * rq;
                LAS v2u* up = (LAS v2u*)(UB + (size_t)(bb * HY_UR + HY_UP + t0) * 2);
                const v2u uu = *up; const v2u xx = *(const LAS v2u*)(XB + (size_t)(bb * SEQ + t0) * 2);
                v2u o;
                o.x = pk2(bflo(xx.x) * (C[i][0] + bflo(uu.x) * sk), bfhi(xx.x) * (C[i][1] + bfhi(uu.x) * sk));
                o.y = pk2(bflo(xx.y) * (C[i][2] + bflo(uu.y) * sk), bfhi(xx.y) * (C[i][3] + bfhi(uu.y) * sk));
                *up = o;
            }
        }
        __syncthreads();
        hy_filt_build(F, fF);
        { const int ch = 2 * HYC + c; hy_short_store(XB, SEQ, 0, sG, cw[ch], cw[1536 + ch], cw[3072 + ch], cbp[ch], F.tid); }
        const int cn = c + F.G; const bool more = cn < HYC;
        if (more) { hy_short_load(sA, zT + (size_t)cn * T, F.tid); hy_filt_load(fB, Hf, 0, cn, F.tid); hy_short_load(sC, zT + (size_t)(HYC + cn) * T, F.tid); }
        __syncthreads();
        hy_conv_mfma(F, C);
        {   const float sk = skip[HYC + c];
#pragma unroll
            for (int i = 0; i < 8; ++i) {
                const int t0 = 32 * (8 * w + i) + 16 * hh + 4 * rq;
                const v2u uu = *(const LAS v2u*)(UB + (size_t)(bb * HY_UR + HY_UP + t0) * 2); const v2u xx = *(const LAS v2u*)(XB + (size_t)(bb * SEQ + t0) * 2);
                v2u o;
                o.x = pk2(bflo(xx.x) * (C[i][0] + bflo(uu.x) * sk), bfhi(xx.x) * (C[i][1] + bfhi(uu.x) * sk));
                o.y = pk2(bflo(xx.y) * (C[i][2] + bflo(uu.y) * sk), bfhi(xx.y) * (C[i][3] + bfhi(uu.y) * sk));
                *(v2u*)(yT + (size_t)c * T + bb * SEQ + t0) = o;
            }
        }
        if (!more) break;
        c = cn;
    }
}
__device__ __forceinline__ void hy_transpose_tile(Frame& F, int tile) {
    const bf16* yT = (const bf16*)(F.ws + WS_YT); bf16* mix = (bf16*)(F.ws + WS_MIX0);
    LAS unsigned* scr = (LAS unsigned*)(F.lds + F.wave * (64 * 36 * 4));
    const int lane = F.lane, ct = tile & 7, tt = tile >> 3, c0 = 64 * ct, tok0 = 64 * tt;
    const int rr = lane >> 3, ch = lane & 7;
    v4u raw[8];
#pragma unroll
    for (int i = 0; i < 8; ++i) raw[i] = __builtin_nontemporal_load((const v4u*)(yT + (size_t)(c0 + 8 * i + rr) * T + tok0 + 8 * ch));
#pragma unroll
    for (int i = 0; i < 8; ++i) {
        v4u o; o.x = __shfl_xor(raw[i].x, 8); o.y = __shfl_xor(raw[i].y, 8); o.z = __shfl_xor(raw[i].z, 8); o.w = __shfl_xor(raw[i].w, 8);
        const bool odd = rr & 1;
        const unsigned a0 = odd ? o.z : raw[i].x, a1 = odd ? o.w : raw[i].y;
        const unsigned b0 = odd ? raw[i].z : o.x, b1 = odd ? raw[i].w : o.y;
        const int cp = (8 * i + (rr & ~1)) >> 1;
        const int tb = 8 * ch + (odd ? 4 : 0);
        scr[(tb + 0) * 36 + cp] = (a0 & 0xffffu) | (b0 << 16);
        scr[(tb + 1) * 36 + cp] = (a0 >> 16) | (b0 & 0xffff0000u);
        scr[(tb + 2) * 36 + cp] = (a1 & 0xffffu) | (b1 << 16);
        scr[(tb + 3) * 36 + cp] = (a1 >> 16) | (b1 & 0xffff0000u);
    }
    LDS_WAIT(); asm volatile("" ::: "memory");
#pragma unroll
    for (int i = 0; i < 8; ++i) { const int tk = 8 * i + rr; const v4u w = *(const LAS v4u*)(scr + tk * 36 + 4 * ch);
        *(v4u*)(mix + (size_t)(tok0 + tk) * D + c0 + 8 * ch) = w; }
    LDS_WAIT(); asm volatile("" ::: "memory");
}

constexpr int AT_KSTR = 136;
template <int NT, bool DIL>
__device__ __forceinline__ void attn_wave16(const LAS unsigned char* Ks, const LAS unsigned char* VT, int vstr, int k0, const bf16* qrow, const LAS float* bt, int dil, int relbase, int lbase, int L,
                                            bf16* orow, float* lse_out, int lane) {
    const int r = lane & 15, rq = lane >> 4;
    bf16x8_t Qf[4];
    {
        v4u raw[4]; float ss = 0.f;
#pragma unroll
        for (int st = 0; st < 4; ++st) { raw[st] = *(const v4u*)(qrow + 32 * st + 8 * rq);
            const float a0 = bflo(raw[st].x), a1 = bfhi(raw[st].x), a2 = bflo(raw[st].y), a3 = bfhi(raw[st].y), a4 = bflo(raw[st].z), a5 = bfhi(raw[st].z), a6 = bflo(raw[st].w), a7 = bfhi(raw[st].w);
            ss += (a0 * a0 + a1 * a1) + (a2 * a2 + a3 * a3) + (a4 * a4 + a5 * a5) + (a6 * a6 + a7 * a7); }
        ss += __shfl_xor(ss, 16); ss += __shfl_xor(ss, 32);
        const float sc = 0.08838834764831845f / sqrtf(ss * (1.f / 128.f) + EPS);
#pragma unroll
        for (int st = 0; st < 4; ++st) { v4u w;
            w.x = pk2(bflo(raw[st].x) * sc, bfhi(raw[st].x) * sc); w.y = pk2(bflo(raw[st].y) * sc, bfhi(raw[st].y) * sc);
            w.z = pk2(bflo(raw[st].z) * sc, bfhi(raw[st].z) * sc); w.w = pk2(bflo(raw[st].w) * sc, bfhi(raw[st].w) * sc);
            Qf[st] = __builtin_bit_cast(bf16x8_t, w); }
    }
    float bv[DIL ? NT : 1][4];
    if (DIL) {
#pragma unroll
        for (int kt = 0; kt < NT; ++kt)
#pragma unroll
            for (int g = 0; g < 4; ++g) bv[kt][g] = bt[relbase + 16 * kt + g + 128];
    }
    f32x4 S[NT];
    const LAS unsigned char* kb = Ks + (size_t)(k0 + r) * (AT_KSTR * 2) + 16 * rq;
    bf16x8_t Af[2][4];
#pragma unroll
    for (int st = 0; st < 4; ++st) Af[0][st] = *(const LAS bf16x8_t*)(kb + 64 * st);
#pragma unroll
    for (int kt = 0; kt < NT; ++kt) {
        if (kt + 1 < NT) {
#pragma unroll
            for (int st = 0; st < 4; ++st) Af[(kt + 1) & 1][st] = *(const LAS bf16x8_t*)(kb + (kt + 1) * 16 * (AT_KSTR * 2) + 64 * st);
        }
        f32x4 acc = (f32x4){0.f, 0.f, 0.f, 0.f};
#pragma unroll
        for (int st = 0; st < 4; ++st) acc = __builtin_amdgcn_mfma_f32_16x16x32_bf16(Af[kt & 1][st], Qf[st], acc, 0, 0, 0);
        S[kt] = acc;
        asm volatile("" ::: "memory");
    }
    float mx = -3.0e38f;
#pragma unroll
    for (int kt = 0; kt < NT; ++kt)
#pragma unroll
        for (int g = 0; g < 4; ++g) {
            float s = S[kt][g];
            if (DIL) { const int lk = lbase + 16 * kt + g; const bool ok = (lk >= 0) && (lk < L);
                s = ok ? s + bv[kt][g] : -3.0e38f; S[kt][g] = s; }
            mx = fmaxf(mx, s);
        }
    mx = fmaxf(mx, __shfl_xor(mx, 16)); mx = fmaxf(mx, __shfl_xor(mx, 32));
    float z = 0.f;
#pragma unroll
    for (int kt = 0; kt < NT; ++kt)
#pragma unroll
        for (int g = 0; g < 4; ++g) { const float p = __expf(S[kt][g] - mx); S[kt][g] = p; z += p; }
    z += __shfl_xor(z, 16); z += __shfl_xor(z, 32);
    const float iz = 1.0f / z;
    bf16x8_t Pf[NT / 2];
#pragma unroll
    for (int ks = 0; ks < NT / 2; ++ks) { v4u w; w.x = pk2(S[2 * ks][0], S[2 * ks][1]); w.y = pk2(S[2 * ks][2], S[2 * ks][3]); w.z = pk2(S[2 * ks + 1][0], S[2 * ks + 1][1]); w.w = pk2(S[2 * ks + 1][2], S[2 * ks + 1][3]);
        Pf[ks] = __builtin_bit_cast(bf16x8_t, w); }
    const LAS unsigned char* vb = VT + ((size_t)r * vstr + k0 + 4 * rq) * 2;
    v4u Vf[2][NT / 2];
#pragma unroll
    for (int ks = 0; ks < NT / 2; ++ks) { const LAS unsigned char* p = vb + 64 * ks; const v2u lo = *(const LAS v2u*)p, hi = *(const LAS v2u*)(p + 32); Vf[0][ks] = (v4u){lo.x, lo.y, hi.x, hi.y}; }
#pragma unroll
    for (int dt = 0; dt < 8; ++dt) {
        if (dt + 1 < 8) {
#pragma unroll
            for (int ks = 0; ks < NT / 2; ++ks) { const LAS unsigned char* p = vb + (size_t)(dt + 1) * 16 * vstr * 2 + 64 * ks; const v2u lo = *(const LAS v2u*)p, hi = *(const LAS v2u*)(p + 32); Vf[(dt + 1) & 1][ks] = (v4u){lo.x, lo.y, hi.x, hi.y}; }
        }
        f32x4 o = (f32x4){0.f, 0.f, 0.f, 0.f};
#pragma unroll
        for (int ks = 0; ks < NT / 2; ++ks) o = __builtin_amdgcn_mfma_f32_16x16x32_bf16(__builtin_bit_cast(bf16x8_t, Vf[dt & 1][ks]), Pf[ks], o, 0, 0, 0);
        v2u ow; ow.x = pk2(o[0] * iz, o[1] * iz); ow.y = pk2(o[2] * iz, o[3] * iz);
        *(v2u*)(orow + 16 * dt + 4 * rq) = ow;
        asm volatile("" ::: "memory");
    }
    if (DIL) { if (rq == 0) *lse_out = mx + logf(z); }
}
template <int NB, int BS, class RowFn>
__device__ __forceinline__ void attn_stage_k(LAS unsigned char* Ks, int nk, const float* qg, const float* kg, const bf16* kbase, RowFn rowoff, int wave, int lane) {
    const int rr = lane >> 4, cc = lane & 15;
    float gf[8];
    { const f32x4 a0 = *(const f32x4*)(qg + 8 * cc), a1 = *(const f32x4*)(qg + 8 * cc + 4), b0 = *(const f32x4*)(kg + 8 * cc), b1 = *(const f32x4*)(kg + 8 * cc + 4);
      gf[0] = a0.x * b0.x; gf[1] = a0.y * b0.y; gf[2] = a0.z * b0.z; gf[3] = a0.w * b0.w; gf[4] = a1.x * b1.x; gf[5] = a1.y * b1.y; gf[6] = a1.z * b1.z; gf[7] = a1.w * b1.w; }
#pragma unroll 1
    for (int bt = 0; bt < NB; ++bt) {
        v4u raw[BS];
#pragma unroll
        for (int i = 0; i < BS; ++i) { const int j = ((bt * BS + i) * 8 + wave) * 4 + rr; const long off = (j < nk) ? rowoff(j) : -1;
            raw[i] = *(const v4u*)(kbase + (off < 0 ? 0 : off) + 8 * cc); if (off < 0) raw[i] = (v4u){0u, 0u, 0u, 0u}; }
#pragma unroll
        for (int i = 0; i < BS; ++i) { const int j = ((bt * BS + i) * 8 + wave) * 4 + rr;
            const float k0 = bflo(raw[i].x), k1 = bfhi(raw[i].x), k2 = bflo(raw[i].y), k3 = bfhi(raw[i].y), k4 = bflo(raw[i].z), k5 = bfhi(raw[i].z), k6 = bflo(raw[i].w), k7 = bfhi(raw[i].w);
            float ss = (k0 * k0 + k1 * k1) + (k2 * k2 + k3 * k3) + (k4 * k4 + k5 * k5) + (k6 * k6 + k7 * k7);
            ss += __shfl_xor(ss, 1); ss += __shfl_xor(ss, 2); ss += __shfl_xor(ss, 4); ss += __shfl_xor(ss, 8);
            const float sc = 1.0f / sqrtf(ss * (1.f / 128.f) + EPS);
            v4u w; w.x = pk2(k0 * sc * gf[0], k1 * sc * gf[1]); w.y = pk2(k2 * sc * gf[2], k3 * sc * gf[3]); w.z = pk2(k4 * sc * gf[4], k5 * sc * gf[5]); w.w = pk2(k6 * sc * gf[6], k7 * sc * gf[7]);
            if (j < nk) *(LAS v4u*)(Ks + (size_t)j * (AT_KSTR * 2) + 16 * cc) = w; }
    }
}
__device__ __forceinline__ void attn_stage_vpair(LAS unsigned char* VT, int vstr, int j0, int dch, const v4u va, const v4u vb) {
    LAS unsigned char* p = VT + ((size_t)(8 * dch) * vstr + j0) * 2;
    const size_t rs = (size_t)vstr * 2;
    *(LAS unsigned*)(p + 0 * rs) = (va.x & 0xffffu) | (vb.x << 16);         *(LAS unsigned*)(p + 1 * rs) = (va.x >> 16) | (vb.x & 0xffff0000u);
    *(LAS unsigned*)(p + 2 * rs) = (va.y & 0xffffu) | (vb.y << 16);         *(LAS unsigned*)(p + 3 * rs) = (va.y >> 16) | (vb.y & 0xffff0000u);
    *(LAS unsigned*)(p + 4 * rs) = (va.z & 0xffffu) | (vb.z << 16);         *(LAS unsigned*)(p + 5 * rs) = (va.z >> 16) | (vb.z & 0xffff0000u);
    *(LAS unsigned*)(p + 6 * rs) = (va.w & 0xffffu) | (vb.w << 16);         *(LAS unsigned*)(p + 7 * rs) = (va.w >> 16) | (vb.w & 0xffff0000u);
}
template <int NB, int BS, int NPR, class RowFn>
__device__ __forceinline__ void attn_stage_v(LAS unsigned char* VT, int vstr, const bf16* vbase, RowFn rowoff, int tid) {
#pragma unroll 1
    for (int bt = 0; bt < NB; ++bt) {
        v4u va[BS], vb[BS];
#pragma unroll
        for (int k = 0; k < BS; ++k) { const int it = tid + 512 * (bt * BS + k), pr = it % NPR, dch = it / NPR;
            const long oa = (it < NPR * 16) ? rowoff(2 * pr) : -1, ob = (it < NPR * 16) ? rowoff(2 * pr + 1) : -1;
            va[k] = *(const v4u*)(vbase + (oa < 0 ? 0 : oa + 8 * dch)); vb[k] = *(const v4u*)(vbase + (ob < 0 ? 0 : ob + 8 * dch));
            if (oa < 0) va[k] = (v4u){0u, 0u, 0u, 0u}; if (ob < 0) vb[k] = (v4u){0u, 0u, 0u, 0u}; }
#pragma unroll
        for (int k = 0; k < BS; ++k) { const int it = tid + 512 * (bt * BS + k), pr = it % NPR, dch = it / NPR; if (it < NPR * 16) attn_stage_vpair(VT, vstr, 2 * pr, dch, va[k], vb[k]); }
    }
}

constexpr int XA_VSTR = 264, XA_OFF_VT = 256 * AT_KSTR * 2;
static_assert(XA_OFF_VT + 128 * XA_VSTR * 2 <= SCR_BYTES, "cross LDS");
__device__ __forceinline__ void cross_unit(Frame& F, const bf16* xq, const bf16* kv, const float* qg, const float* kg, bf16* mix, int unit) {
    int lane = (int)__builtin_amdgcn_mbcnt_hi(~0u, __builtin_amdgcn_mbcnt_lo(~0u, 0u)); asm volatile("" : "+v"(lane)); const int tid = F.wave * 64 + lane;
    const int b = unit >> 5, h = (unit >> 3) & 3, qc = unit & 7;
    LAS unsigned char* Ks = F.lds; LAS unsigned char* VT = F.lds + XA_OFF_VT;
    const bf16* kbase = kv + (size_t)(b * MEML) * 1024 + h * 128;
    __syncthreads();
    attn_stage_k<2, 4>(Ks, MEML, qg, kg, kbase, [=](int j) { return (long)j * 1024; }, F.wave, lane);
    attn_stage_v<2, 2, 128>(VT, XA_VSTR, kbase + 512, [=](int j) { return (long)j * 1024; }, tid);
    __syncthreads();
#pragma unroll 1
    for (int a = F.wave; a < 16; a += NWAVES) {
        const int token = b * SEQ + qc * 256 + 16 * a + (lane & 15);
        attn_wave16<16, false>(Ks, VT, XA_VSTR, 0, xq + (size_t)token * 512 + h * 128, nullptr, 1, 0, 0, 0, mix + (size_t)token * D + 512 + h * 128, nullptr, lane);
    }
}
constexpr int DA_VSTR = 280, DA_NK = 272, DA_OFF_VT = DA_NK * AT_KSTR * 2, DA_OFF_BT = DA_OFF_VT + 128 * DA_VSTR * 2;
static_assert(DA_OFF_BT + 320 * 4 <= SCR_BYTES, "dilated LDS");
__device__ __forceinline__ void dil_unit(Frame& F, const Args& a, int unit) {
    const int bh = unit / 48, sub = unit % 48, b = bh >> 2, h = bh & 3, g = sub >> 4, w16 = sub & 15;
    const int dil = (g == 0) ? 1 : (g == 1 ? 4 : 16), L = SEQ / dil, nch = L / 128;
    const int r = w16 / nch, n128 = w16 % nch;
    int lane = (int)__builtin_amdgcn_mbcnt_hi(~0u, __builtin_amdgcn_mbcnt_lo(~0u, 0u)); asm volatile("" : "+v"(lane)); const int tid = F.wave * 64 + lane;
    const bf16* qkv = (const bf16*)(F.ws + WS_QKV1);
    float* lse = (float*)(F.ws + WS_LSE);
    LAS unsigned char* Ks = F.lds; LAS unsigned char* VT = F.lds + DA_OFF_VT; LAS float* bt = (LAS float*)(F.lds + DA_OFF_BT);
    const int lk0 = 128 * n128 - 64;
    const bf16* base = qkv + (size_t)(b * SEQ + r) * NQKV + g * 512 + h * 128;
    const size_t lstep = (size_t)dil * NQKV;
    __syncthreads();
    if (tid < 320) { const int rel = tid - 128; bt[tid] = (rel >= -64 && rel <= 64) ? a.in[I_RELB][rel_bucket_dev(rel * dil) * 12 + g * 4 + h] : -3.0e38f; }
    attn_stage_k<3, 3>(Ks, DA_NK, a.in[I_ATQN], a.in[I_ATKN], base + ATW, [=](int j) { const int lk = lk0 + j; return (lk >= 0 && lk < L) ? (long)lk * (long)lstep : -1L; }, F.wave, lane);
    attn_stage_v<3, 2, DA_NK / 2>(VT, DA_VSTR, base + 2 * ATW, [=](int j) { const int lk = lk0 + j; return (lk >= 0 && lk < L) ? (long)lk * (long)lstep : -1L; }, tid);
    __syncthreads();
    {
        const int aq = F.wave, i = 16 * aq + (lane & 15), lq = 128 * n128 + i, token = b * SEQ + lq * dil + r, k0 = 16 * aq, rq = lane >> 4;
        attn_wave16<10, true>(Ks, VT, DA_VSTR, k0, base + (size_t)lq * lstep, bt, dil, k0 + 4 * rq - 64 - i, lk0 + k0 + 4 * rq, L,
                              (g == 0) ? (bf16*)(F.ws + WS_MIX1) + (size_t)token * D + h * 128 : (bf16*)(F.ws + WS_OG12) + ((size_t)(g - 1) * T + token) * 512 + h * 128,
                              lse + ((size_t)g * T + token) * 4 + h, lane);
    }
}
__device__ __forceinline__ void combine_phase(Frame& F, const Args& a) {
    moe_layout(F);
    const int gw = F.bid * NWAVES + F.wave, NGW = F.G * NWAVES, lane = F.lane;
    const int* toke = (const int*)(F.ws + WS_TOKE); const int* tokr = (const int*)(F.ws + WS_TOKR); const float* tokg = (const float*)(F.ws + WS_TOKG);
    const bf16* y = (const bf16*)(F.ws + WS_XS); const bf16* y2 = (const bf16*)(F.ws + WS_Y2);
    for (int token = gw; token < T; token += NGW) {
        const int e0 = toke[token * 2], e1 = toke[token * 2 + 1];
        const int s0 = ml_ps(F, e0) + tokr[token * 2], s1 = ml_ps(F, e1) + tokr[token * 2 + 1];
        const float g0 = tokg[token * 2], g1 = tokg[token * 2 + 1];
        f32x4* xo = (f32x4*)(a.out + (size_t)token * D); const v2u* xi = (const v2u*)((const bf16*)a.out + (size_t)token * 2048 + 1024);
        const v2u* y0 = (const v2u*)(y + (size_t)s0 * D); const v2u* y1 = (const v2u*)(y + (size_t)s1 * D);
        v2u xw[4], p0[4], p1[4];
#pragma unroll
        for (int j = 0; j < 4; ++j) { const int q = lane + 64 * j; xw[j] = __builtin_nontemporal_load(xi + q); p0[j] = __builtin_nontemporal_load(y0 + q); p1[j] = __builtin_nontemporal_load(y1 + q); }
        f32x4 r[4];
#pragma unroll
        for (int j = 0; j < 4; ++j) {
            const int q = lane + 64 * j;
            f32x4 x = (f32x4){bflo(xw[j].x), bfhi(xw[j].x), bflo(xw[j].y), bfhi(xw[j].y)};
            f32x4 a0 = (f32x4){bflo(p0[j].x), bfhi(p0[j].x), bflo(p0[j].y), bfhi(p0[j].y)}, a1 = (f32x4){bflo(p1[j].x), bfhi(p1[j].x), bflo(p1[j].y), bfhi(p1[j].y)};
            if (s0 >= 2 * T) { const v2u t = ((const v2u*)(y2 + (size_t)(s0 - 2 * T) * D))[q]; a0 = a0 + (f32x4){bflo(t.x), bfhi(t.x), bflo(t.y), bfhi(t.y)}; }
            if (s1 >= 2 * T) { const v2u t = ((const v2u*)(y2 + (size_t)(s1 - 2 * T) * D))[q]; a1 = a1 + (f32x4){bflo(t.x), bfhi(t.x), bflo(t.y), bfhi(t.y)}; }
            r[j] = x + g0 * a0 + g1 * a1;
        }
        asm volatile("s_waitcnt vmcnt(0)" ::: "memory");
#pragma unroll
        for (int j = 0; j < 4; ++j) __builtin_nontemporal_store(r[j], xo + lane + 64 * j);
    }
}

constexpr int NPHASE = 15;
__global__ void __launch_bounds__(NWAVES * 64, 2) mega_fwd(Args args) {
    extern __shared__ __attribute__((aligned(16))) unsigned char lds_raw[];
    Frame F;
    F.lds = (LAS unsigned char*)lds_raw; F.ws = args.ws;
    F.wave = __builtin_amdgcn_readfirstlane((int)threadIdx.x >> 6); F.G = gridDim.x; F.bid = blockIdx.x;
#define PH_BEGIN() do { int l_ = (int)__builtin_amdgcn_mbcnt_hi(~0u, __builtin_amdgcn_mbcnt_lo(~0u, 0u)); asm volatile("" : "+v"(l_)); F.lane = l_; F.tid = F.wave * 64 + l_; } while (0)
    PH_BEGIN();
    unsigned char* ws = args.ws;
    volatile LAS unsigned* MISC = (volatile LAS unsigned*)(F.lds + MISC_OFF);
    for (int u = F.tid; u < (LDS_BYTES - MISC_OFF) / 4; u += NWAVES * 64) MISC[u] = 0u;
    __syncthreads();
    const int lo = args.ph_lo, hi = args.ph_hi;
    const bool use_bar = (hi - lo) > 1;
    XcdBarrier bar; bar.bar = (unsigned*)(ws + WS_CTL) + CW_BAR + args.bslot * XCD_BAR_WORDS; bar.x = 0; bar.st = nullptr;
    if (use_bar) bar = xcd_barrier_post((unsigned*)(ws + WS_CTL) + CW_BAR + args.bslot * XCD_BAR_WORDS, MISC + 8, F.tid);
#define IN(k) (lo <= (k) && (k) < hi)
#define SEAM(k) do { if (IN(k) && IN((k) + 1)) { PH_BEGIN(); xcd_barrier(bar, F.tid); } } while (0)
    const int gw = F.bid * NWAVES + F.wave, NGW = F.G * NWAVES;
    LAS unsigned char* ring = F.lds;

    if (IN(0)) { PH_BEGIN(); p0_prologue(F, args); }
    SEAM(0);
    if (IN(1)) { PH_BEGIN();
        {   pg8::Gemm g{(const bf16*)(ws + WS_WIN0), (const bf16*)(ws + WS_XB), D, D, D, 0};
            pg8::StaticOrder S; S.init(ATW / 256, T / 256, F.G, F.bid);
            EpiB<3> E{(bf16*)(ws + WS_ZT), T, (const float*)(ws + WS_RSTD0), 1 << 30, nullptr, 0, nullptr, 1.0f};
            pg8::gemm_phase<EpiB<3>, pg8::StaticOrder, true>(ring, g, S, E, F.wave); }
        {   pg8::Gemm g{(const bf16*)(ws + WS_XB), (const bf16*)(ws + WS_WIN0) + (size_t)ATW * D, D, D, D, 0};
            pg8::StaticOrder S; S.init(T / 256, 2, F.G, (F.bid + 128) % F.G);
            EpiB<1> E{(bf16*)(ws + WS_XQ0), 512, (const float*)(ws + WS_RSTD0), 1 << 30, nullptr, 0, nullptr, 1.0f};
            pg8::gemm_phase<EpiB<1>, pg8::StaticOrder, true>(ring, g, S, E, F.wave); }
        {   pg8::Gemm g{(const bf16*)(ws + WS_MN), (const bf16*)(ws + WS_WKV), D, D, D, (size_t)D * D * 2};
            pg8::MoeOrder S; S.init(2 * TM / 256, 4, F.G, F.bid); S.t0 = TM / 256; S.t1 = S.t2 = S.t3 = S.t4 = S.t5 = S.t6 = 1 << 30; S.lay = nullptr; S.list = nullptr;
            EpiB<0> E{(bf16*)(ws + WS_KV), D, nullptr, 1 << 30, nullptr, 0, nullptr, 1.0f};
            pg8::gemm_phase<EpiB<0>, pg8::MoeOrder, true>(ring, g, S, E, F.wave); }
        if (F.G == 256 && F.bid >= 64) { PH_BEGIN(); moe_convert(F, args, 0, MOE_P1_HI, (F.bid - 64) * NWAVES + F.wave, 192 * NWAVES); }
    }
    SEAM(1);
    if (IN(2)) { PH_BEGIN();
        hyena_units(F, args);
        for (int u = F.bid; u < 256; u += F.G)
            cross_unit(F, (const bf16*)(ws + WS_XQ0), (const bf16*)(ws + WS_KV), args.in[I_XQN], args.in[I_XKN], (bf16*)(ws + WS_MIX0), u);
    }
    SEAM(2);
    if (IN(3)) { PH_BEGIN(); for (int t = gw; t < 2048; t += NGW) hy_transpose_tile(F, t); }
    SEAM(3);
    if (IN(4)) { PH_BEGIN();
        pg8::Gemm g{(const bf16*)(ws + WS_MIX0), (const bf16*)(ws + WS_WO), D, D, D, 0};
        pg8::StaticOrder S; S.init(T / 256, 4, F.G, F.bid);
        EpiRes<false, true> E{nullptr, (const bf16*)(ws + WS_XB), D, (bf16*)(ws + WS_XB), D, (float*)(ws + WS_SSQ16)};
        pg8::gemm_phase<EpiRes<false, true>, pg8::StaticOrder, true>(ring, g, S, E, F.wave);
    }
    SEAM(4);
    if (IN(5)) { PH_BEGIN();
        pg8::Gemm g{(const bf16*)(ws + WS_XB), (const bf16*)(ws + WS_WGU0), D, D, D, 0};
        pg8::StaticOrder S; S.init(T / 256, NGU / 256, F.G, F.bid);
        fill_rstd_table(F.lds, S, (const float*)(ws + WS_SSQ16), F.tid);
        EpiSwiglu<4> E{(bf16*)(ws + WS_HID0), FF, nullptr, (const LAS float*)(F.lds + RSL_OFF), 1.0f};
        pg8::gemm_phase<EpiSwiglu<4>, pg8::StaticOrder, true>(ring, g, S, E, F.wave);
        if (F.G == 256 && F.bid >= 128) { PH_BEGIN(); moe_convert(F, args, MOE_P1_HI, MOE_P5_HI, (F.bid - 128) * NWAVES + F.wave, 128 * NWAVES); }
    }
    SEAM(5);
    if (IN(6)) { PH_BEGIN();
        pg8::Gemm g{(const bf16*)(ws + WS_HID0), (const bf16*)(ws + WS_WD0), FF, FF, FF, 0};
        pg8::StaticOrder S; S.init(T / 256, 4, F.G, F.bid);
        EpiRes<false, true> E{nullptr, (const bf16*)(ws + WS_XB), D, (bf16*)(ws + WS_XB), D, (float*)(ws + WS_SSQ16)};
        pg8::gemm_phase<EpiRes<false, true>, pg8::StaticOrder, true>(ring, g, S, E, F.wave);
    }
    SEAM(6);
    if (IN(7)) { PH_BEGIN();
        pg8::Gemm g{(const bf16*)(ws + WS_XB), (const bf16*)(ws + WS_WIN1), D, D, D, 0};
        pg8::StaticOrder S; S.init(T / 256, NQ1 / 256, F.G, F.bid);
        fill_rstd_table(F.lds, S, (const float*)(ws + WS_SSQ16), F.tid);
        EpiB<4> E{(bf16*)(ws + WS_QKV1), NQKV, nullptr, NQKV / 256, (bf16*)(ws + WS_XQ1), 512, (const LAS float*)(F.lds + RSL_OFF), 1.0f};
        pg8::gemm_phase<EpiB<4>, pg8::StaticOrder, true>(ring, g, S, E, F.wave);
    }
    SEAM(7);
    if (IN(8)) { PH_BEGIN();
        for (int u = F.bid; u < NB * 4 * 48; u += F.G) dil_unit(F, args, u);
        for (int u = F.bid; u < 256; u += F.G)
            cross_unit(F, (const bf16*)(ws + WS_XQ1), (const bf16*)(ws + WS_KV) + (size_t)TM * D, args.in[I_XQN] + 128, args.in[I_XKN] + 128, (bf16*)(ws + WS_MIX1), u);
    }
    SEAM(8);
    if (IN(9)) { PH_BEGIN(); for (int t = gw; t < T; t += NGW) merge_token(F, t); }
    SEAM(9);
    if (IN(10)) { PH_BEGIN();
        pg8::Gemm g{(const bf16*)(ws + WS_MIX1), (const bf16*)(ws + WS_WO) + (size_t)D * D, D, D, D, 0};
        pg8::StaticOrder S; S.init(T / 256, 4, F.G, F.bid);
        EpiRes<false, false> E{nullptr, (const bf16*)(ws + WS_XB), D, (bf16*)args.out + 1024, 2048, nullptr};
        pg8::gemm_phase<EpiRes<false, false>, pg8::StaticOrder, true>(ring, g, S, E, F.wave);
    }
    SEAM(10);
    if (IN(11)) { PH_BEGIN(); for (int blk = F.bid; blk < T / 64; blk += F.G) route_block(F, args, blk); }
    SEAM(11);
    if (IN(12)) { PH_BEGIN();
        moe_layout(F);
        pg8::Gemm g{(const bf16*)(ws + WS_XB3), (const bf16*)(ws + WS_WGU1), D / 2, D / 2, D / 2, (size_t)NGU * D};
        pg8::MoeOrder S; S.init(ml_total(F) / 256, NGU / 256, F.G, F.bid); S.lay = (const volatile LAS int*)(F.lds + MISC_OFF); S.list = (const int*)(ws + WS_LIST);
        S.t0 = ml_ps(F, 1) / 256; S.t1 = ml_ps(F, 2) / 256; S.t2 = ml_ps(F, 3) / 256; S.t3 = ml_ps(F, 4) / 256; S.t4 = ml_ps(F, 5) / 256; S.t5 = ml_ps(F, 6) / 256; S.t6 = ml_ps(F, 7) / 256;
        EpiSwiglu<5, true> E{(bf16*)(ws + WS_HID1), FF, nullptr, nullptr, 1.0f / MOE_WGU_SCALE};
        pg8::gemm_phase<EpiSwiglu<5, true>, pg8::MoeOrder, true, true, true>(ring, g, S, E, F.wave);
    }
    SEAM(12);
    if (IN(13)) { PH_BEGIN();
        moe_layout(F);
        const int nMt = ml_total(F) / 256;
        const int q1 = ml_ps(F, 1) / 256, q2 = ml_ps(F, 2) / 256, q3 = ml_ps(F, 3) / 256, q4 = ml_ps(F, 4) / 256, q5 = ml_ps(F, 5) / 256, q6 = ml_ps(F, 6) / 256, q7 = ml_ps(F, 7) / 256;
        {   pg8::Gemm g{(const bf16*)(ws + WS_HID1), (const bf16*)(ws + WS_WD1), FF / 2, FF / 2, FF / 2, (size_t)D * FF};
            pg8::MoeOrder S; S.init(nMt < 128 ? nMt : 128, 4, F.G, F.bid); S.lay = nullptr; S.list = nullptr;
            S.t0 = q1; S.t1 = q2; S.t2 = q3; S.t3 = q4; S.t4 = q5; S.t5 = q6; S.t6 = q7;
            EpiB<5> E{(bf16*)(ws + WS_XS), D, nullptr, 1 << 30, nullptr, 0, nullptr, 1.0f / MOE_WD_SCALE};
            pg8::gemm_phase<EpiB<5>, pg8::MoeOrder, true, false, true>(ring, g, S, E, F.wave); }
        if (nMt > 128) {
            const int half = F.G / 2; const bool second = F.bid >= half;
            pg8::Gemm g{(const bf16*)(ws + WS_HID1), (const bf16*)(ws + WS_WD1), FF / 2, FF / 2, second ? 640 : 768, (size_t)D * FF};
            pg8::MoeTailOrder2 S; S.pm0 = 128; S.ntail = nMt - 128; S.nN = 4; S.G = second ? F.G - half : half; S.c = second ? F.bid - half : F.bid; S.koff = second ? 12 * 128 : 0;
            S.t0 = q1; S.t1 = q2; S.t2 = q3; S.t3 = q4; S.t4 = q5; S.t5 = q6; S.t6 = q7;
            EpiB<5> E{(bf16*)(ws + WS_XS), D, nullptr, 1 << 30, (bf16*)(ws + WS_Y2) - (size_t)2 * T * D, D, nullptr, 1.0f / MOE_WD_SCALE};
            pg8::gemm_phase<EpiB<5>, pg8::MoeTailOrder2, true, false, true>(ring, g, S, E, F.wave); }
    }
    SEAM(13);
    if (IN(14)) { PH_BEGIN(); combine_phase(F, args); }
#undef IN
#undef SEAM
}

#ifndef MK_ONE_LAUNCH
#define MK_ONE_LAUNCH 1
#endif
extern "C" void kernel_launch(void* const* d_in, const int* in_sizes, int n_in, void* d_out, int out_size, void* d_ws, size_t ws_size, hipStream_t stream) {
    static int grid = 0;
    if (grid == 0) {
        if (n_in != 30 || in_sizes[0] != T * D || out_size != T * D || ws_size < WS_END) {
            fprintf(stderr, "kernel_launch: unexpected problem (n_in %d, in0 %d, out %d, ws %zu, need %zu); nothing launched\n", n_in, n_in > 0 ? in_sizes[0] : -1, out_size, ws_size, (size_t)WS_END); grid = -1; return; }
        int dev = 0, cus = 0, per_cu = 0;
        if (hipGetDevice(&dev) != hipSuccess || hipDeviceGetAttribute(&cus, hipDeviceAttributeMultiprocessorCount, dev) != hipSuccess) { grid = -1; return; }
        if (hipFuncSetAttribute((const void*)mega_fwd, hipFuncAttributeMaxDynamicSharedMemorySize, LDS_BYTES) != hipSuccess) { fprintf(stderr, "kernel_launch: hipFuncSetAttribute failed\n"); grid = -1; return; }
        if (hipOccupancyMaxActiveBlocksPerMultiprocessor(&per_cu, (const void*)mega_fwd, NWAVES * 64, LDS_BYTES) != hipSuccess || per_cu < 1)
            fprintf(stderr, "kernel_launch: note: occupancy query reports %d workgroups per CU\n", per_cu);
        (void)hipGetLastError();
        grid = cus;
    }
    if (grid < 0) return;
    if (hipMemsetAsync((char*)d_ws + WS_CTL, 0, CTL_ZERO_BYTES, stream) != hipSuccess) return;
    Args a{};
    for (int i = 0; i < 30; ++i) a.in[i] = (const float*)d_in[i];
    a.out = (float*)d_out; a.ws = (unsigned char*)d_ws;
#if defined(PROBE_PHASE)
    a.ph_lo = 0; a.ph_hi = PROBE_PHASE + 1; a.bslot = 0;
    hipLaunchKernelGGL(mega_fwd, dim3(grid), dim3(NWAVES * 64), LDS_BYTES, stream, a);
    a.ph_lo = PROBE_PHASE; a.ph_hi = NPHASE; a.bslot = 1;
    hipLaunchKernelGGL(mega_fwd, dim3(grid), dim3(NWAVES * 64), LDS_BYTES, stream, a);
#elif MK_ONE_LAUNCH
    a.ph_lo = 0; a.ph_hi = NPHASE; a.bslot = 0;
    hipLaunchKernelGGL(mega_fwd, dim3(grid), dim3(NWAVES * 64), LDS_BYTES, stream, a);
#else
    for (int p = 0; p < NPHASE; ++p) { a.ph_lo = p; a.ph_hi = p + 1; a.bslot = 0; hipLaunchKernelGGL(mega_fwd, dim3(grid), dim3(NWAVES * 64), LDS_BYTES, stream, a); }
#endif
}
```

```cpp
#include <hip/hip_runtime.h>
#include <cstdio>
#include <cstdint>

namespace pg8 {
#define PG8_LAS __attribute__((address_space(3)))
typedef unsigned short bf16_t;
typedef short bf16x8 __attribute__((ext_vector_type(8)));
typedef float f32x4 __attribute__((ext_vector_type(4)));
typedef unsigned u32x4 __attribute__((ext_vector_type(4)));
constexpr int BM = 256, BK = 64, HALF = 128, HTB = HALF * BK * 2  , STAGE_BYTES = 8 * HTB, NXCD = 8, WGM = 8;

__host__ __device__ __forceinline__ int lds_byte(int r, int c) { const int st = (r >> 4) * 2 + (c >> 5), rr = r & 15, cc = c & 31, ob = rr * 64 + cc * 2; return st * 1024 + (ob ^ (((ob >> 9) & 1) << 5)); }
__host__ __device__ __forceinline__ void stage_rc(int b, int& R, int& C) { const int st = b / 1024, sb = b % 1024, swz = sb ^ (((sb >> 9) & 1) << 5); R = (st >> 1) * 16 + swz / 64; C = (st & 1) * 32 + (swz % 64) / 2; }
__host__ __device__ __forceinline__ int perm32(int rho) { const int n = rho >> 4, i = rho & 15; return 8 * (i >> 2) + 4 * n + (i & 3); }

struct Unit { int pm, pn, e, koff, idx; };
struct Gemm { const bf16_t* A; const bf16_t* Bt; int lda, ldb, K; size_t estride; };

struct StaticOrder {
    int nM, nN, nwg, G, c;
    __device__ __forceinline__ int gather_row(const Unit&, int slot) const { return slot; }
    __host__ __device__ void init(int nM_, int nN_, int G_, int c_) { nM = nM_; nN = nN_; nwg = nM * nN; G = G_; c = c_; }
    __host__ __device__ bool next(int i, Unit& u) const {
        const long L = (long)i * G + c; if (L >= nwg) return false;
        int wgid = (int)L; { const int q = nwg / NXCD, r = nwg % NXCD, xcd = wgid % NXCD, off = wgid / NXCD; wgid = (xcd < r ? xcd * (q + 1) : r * (q + 1) + (xcd - r) * q) + off; }
        const int nig = WGM * nN, gid = wgid / nig, fm = gid * WGM, gsz = (nM - fm) < WGM ? (nM - fm) : WGM;
        u.pm = fm + ((wgid % nig) % gsz); u.pn = (wgid % nig) / gsz; u.e = 0; u.koff = 0; return true;
    }
};
struct MoeOrder : StaticOrder {
    int t0, t1, t2, t3, t4, t5, t6;
    const volatile PG8_LAS int* lay;
    const int* list;
    __device__ __forceinline__ int gather_row(const Unit& u, int slot) const { const int rank = slot - lay[40 + u.e]; return rank < lay[32 + u.e] ? list[(size_t)u.e * 16384 + rank] : 0; }
    __host__ __device__ bool next(int i, Unit& u) const {
        if (!StaticOrder::next(i, u)) return false;
        const int p = u.pm; u.e = (p >= t0) + (p >= t1) + (p >= t2) + (p >= t3) + (p >= t4) + (p >= t5) + (p >= t6); return true;
    }
};

struct MoeTailOrder {
    int pm0, ntail, nN, G, c, khalf; int t0, t1, t2, t3, t4, t5, t6;
    __device__ __forceinline__ int gather_row(const Unit&, int slot) const { return slot; }
    __device__ __forceinline__ bool next(int i, Unit& u) const {
        const int L = i * G + c; if (L >= ntail * nN * 2) return false;
        const int kh = L & 1, q = L >> 1; u.pn = q % nN; u.pm = pm0 + q / nN; u.koff = kh * khalf;
        const int p = u.pm; u.e = (p >= t0) + (p >= t1) + (p >= t2) + (p >= t3) + (p >= t4) + (p >= t5) + (p >= t6); return true;
    }
};
struct MoeTailOrder2 {
    int pm0, ntail, nN, G, c, koff; int t0, t1, t2, t3, t4, t5, t6;
    __device__ __forceinline__ int gather_row(const Unit&, int slot) const { return slot; }
    __device__ __forceinline__ bool next(int i, Unit& u) const {
        const int L = i * G + c; if (L >= ntail * nN) return false;
        u.pn = L % nN; u.pm = pm0 + L / nN; u.koff = koff;
        const int p = u.pm; u.e = (p >= t0) + (p >= t1) + (p >= t2) + (p >= t3) + (p >= t4) + (p >= t5) + (p >= t6); return true;
    }
};
__device__ __forceinline__ unsigned cvt_pk_bf16(float lo, float hi) { unsigned r; asm volatile("v_cvt_pk_bf16_f32 %0, %1, %2" : "=v"(r) : "v"(lo), "v"(hi)); return r; }

typedef int v8i __attribute__((ext_vector_type(8)));
typedef int v4i __attribute__((ext_vector_type(4)));
template <class Epi, class Sched, bool ALIGN_EPI, bool GATHER = false, bool FP8 = false>
__device__ __forceinline__ void gemm_phase(PG8_LAS unsigned char* lds, const Gemm g, const Sched& S, const Epi& E, const int wid) {
    int lane = (int)__builtin_amdgcn_mbcnt_hi(~0u, __builtin_amdgcn_mbcnt_lo(~0u, 0u)); asm volatile("" : "+v"(lane));
    const int tid = wid * 64 + lane, wr = wid >> 2, wc = wid & 3, fr = lane & 15, fq = lane >> 4;
    const int K = g.K, nt = K / BK;
    unsigned cvo[4], nvo[4], voffB[2]; int rowA[2], colA[2];
#pragma unroll
    for (int i = 0; i < 2; ++i) { int R, C; stage_rc(tid * 16 + i * 8192, R, C); const int Rb = (R & ~31) + perm32(R & 31); rowA[i] = R; colA[i] = C;
        voffB[i] = (unsigned)(Rb * g.ldb + C) * 2u; }
    const size_t kstep = (size_t)(BK * 2);
    const size_t hstepB = (size_t)HALF * g.ldb * 2;
    const size_t tstepA = GATHER ? (size_t)0 : (size_t)2 * HALF * g.lda * 2, tstepB = 2 * hstepB;
#define PG8_ROWOFFS(vo, u) do { _Pragma("unroll") for (int _h = 0; _h < 2; ++_h) _Pragma("unroll") for (int _i = 0; _i < 2; ++_i) { \
        const int _r = _h * HALF + rowA[_i]; const unsigned _row = GATHER ? (unsigned)S.gather_row(u, (u).pm * BM + _r) : (unsigned)_r; \
        (vo)[2 * _h + _i] = (_row * (unsigned)g.lda + (unsigned)colA[_i]) * 2u; } } while (0)
    const unsigned ldsw = (unsigned)wid * 1024u;
    const int aoff = lds_byte(wr * 64 + fr, fq * 8), boff = lds_byte(wc * 32 + fr, fq * 8);
#define PG8_SA(b, h) (((b) * 2 + (h)) * HTB)
#define PG8_SB(b, h) ((4 + (b) * 2 + (h)) * HTB)
#define PG8_STAGE(bufoff, gbase, voff) do { _Pragma("unroll") for (int _i = 0; _i < 2; ++_i) \
        __builtin_amdgcn_global_load_lds((const unsigned*)((const char*)(gbase) + (voff)[_i]), (PG8_LAS unsigned*)(lds + (bufoff) + ldsw + _i * 8192), 16, 0, 0); } while (0)
#define PG8_STAGEA(bufoff, gbase, vo, h) do { _Pragma("unroll") for (int _i = 0; _i < 2; ++_i) \
        __builtin_amdgcn_global_load_lds((const unsigned*)((const char*)(gbase) + (vo)[2 * (h) + _i]), (PG8_LAS unsigned*)(lds + (bufoff) + ldsw + _i * 8192), 16, 0, 0); } while (0)
#define PG8_LDA(dst, b, h) do { _Pragma("unroll") for (int m = 0; m < 4; ++m) dst[m] = __builtin_shufflevector(*(const PG8_LAS v4i*)(lds + PG8_SA(b, h) + aoff + m * 2048), *(const PG8_LAS v4i*)(lds + PG8_SA(b, h) + aoff + m * 2048 + 1024), 0, 1, 2, 3, 4, 5, 6, 7); } while (0)
#define PG8_LDB(dst, b, h) do { _Pragma("unroll") for (int n = 0; n < 2; ++n) dst[n] = __builtin_shufflevector(*(const PG8_LAS v4i*)(lds + PG8_SB(b, h) + boff + n * 2048), *(const PG8_LAS v4i*)(lds + PG8_SB(b, h) + boff + n * 2048 + 1024), 0, 1, 2, 3, 4, 5, 6, 7); } while (0)
#define PG8_HALF(x, k) __builtin_bit_cast(bf16x8, __builtin_shufflevector(x, x, 4 * (k), 4 * (k) + 1, 4 * (k) + 2, 4 * (k) + 3))
#define PG8_MMA(ai, bj, At, Bt) do { if constexpr (FP8) __builtin_amdgcn_sched_barrier(0); __builtin_amdgcn_s_setprio(1); _Pragma("unroll") for (int m = 0; m < 4; ++m) _Pragma("unroll") for (int n = 0; n < 2; ++n) { \
        if constexpr (FP8) acc[ai][bj][m][n] = __builtin_amdgcn_mfma_scale_f32_16x16x128_f8f6f4(Bt[n], At[m], acc[ai][bj][m][n], 0, 0, 0, 0x7f7f7f7f, 0, 0x7f7f7f7f); \
        else { acc[ai][bj][m][n] = __builtin_amdgcn_mfma_f32_16x16x32_bf16(PG8_HALF(Bt[n], 0), PG8_HALF(At[m], 0), acc[ai][bj][m][n], 0, 0, 0); \
               acc[ai][bj][m][n] = __builtin_amdgcn_mfma_f32_16x16x32_bf16(PG8_HALF(Bt[n], 1), PG8_HALF(At[m], 1), acc[ai][bj][m][n], 0, 0, 0); } } \
        if constexpr (FP8) { _Pragma("unroll") for (int m = 0; m < 4; ++m) _Pragma("unroll") for (int n = 0; n < 2; ++n) asm volatile("" : "+v"(acc[ai][bj][m][n])); }   \
        __builtin_amdgcn_s_setprio(0); if constexpr (FP8) __builtin_amdgcn_sched_barrier(0); } while (0)
#define PG8_WAIT_V(n) asm volatile("s_waitcnt vmcnt(" #n ")" ::: "memory")
#define PG8_WAIT_L(n) asm volatile("s_waitcnt lgkmcnt(" #n ")" ::: "memory")
#define PG8_BAR __builtin_amdgcn_s_barrier()
#define PG8_SCHED __builtin_amdgcn_sched_barrier(0)
    Unit cur, nxt; int ui = 0;
    if (!S.next(0, cur)) return;
    cur.idx = 0;
    f32x4 acc[2][2][4][2];
#pragma unroll
    for (int a = 0; a < 2; ++a)
#pragma unroll
        for (int b = 0; b < 2; ++b)
#pragma unroll
            for (int m = 0; m < 4; ++m)
#pragma unroll
                for (int n = 0; n < 2; ++n) acc[a][b][m][n] = (f32x4){0.f, 0.f, 0.f, 0.f};
    v8i At[4], B0[2], B1[2];
    const char* cA = (const char*)g.A + (size_t)cur.pm * tstepA + cur.koff; const char* cB = (const char*)g.Bt + (size_t)cur.e * g.estride + (size_t)cur.pn * tstepB + cur.koff;
    PG8_ROWOFFS(cvo, cur);
#pragma unroll
    for (int i = 0; i < 4; ++i) nvo[i] = cvo[i];
    PG8_STAGE(PG8_SB(0, 0), cB, voffB); PG8_STAGE(PG8_SB(0, 1), cB + hstepB, voffB); PG8_STAGEA(PG8_SA(0, 0), cA, cvo, 0); PG8_STAGEA(PG8_SA(0, 1), cA, cvo, 1);
    if (wr == 1) PG8_BAR;
    PG8_WAIT_V(2); PG8_BAR;
    PG8_STAGE(PG8_SB(1, 0), cB + kstep, voffB); PG8_STAGEA(PG8_SA(1, 0), cA + kstep, cvo, 0); PG8_STAGE(PG8_SB(1, 1), cB + hstepB + kstep, voffB);
    PG8_WAIT_V(6); PG8_BAR;
    for (;;) {
        const bool has_next = S.next(ui + 1, nxt); nxt.idx = ui + 1;
        const char* nA = has_next ? (const char*)g.A + (size_t)nxt.pm * tstepA + nxt.koff : cA;
        const char* nB = has_next ? (const char*)g.Bt + (size_t)nxt.e * g.estride + (size_t)nxt.pn * tstepB + nxt.koff : cB;
        if constexpr (GATHER) { if (has_next) PG8_ROWOFFS(nvo, nxt); }
        for (int t = 0; t < nt; t += 2) {
            const bool last = (t == nt - 2);
            const char* a1 = cA + (size_t)(t + 1) * kstep;
            const char* a2 = last ? nA : cA + (size_t)(t + 2) * kstep; const char* b2 = last ? nB : cB + (size_t)(t + 2) * kstep;
            const char* a3 = a2 + kstep; const char* b3 = b2 + kstep;
            unsigned vo2[4];
#pragma unroll
            for (int i = 0; i < 4; ++i) vo2[i] = (GATHER && last) ? nvo[i] : cvo[i];
            PG8_LDB(B0, 0, 0); PG8_LDB(B1, 0, 1); PG8_SCHED; PG8_LDA(At, 0, 0); PG8_STAGEA(PG8_SA(1, 1), a1, cvo, 1);
            PG8_WAIT_V(8); PG8_WAIT_L(0); PG8_BAR; PG8_MMA(0, 0, At, B0); PG8_MMA(0, 1, At, B1); PG8_BAR; PG8_SCHED;
            PG8_LDA(At, 0, 1); PG8_STAGE(PG8_SB(0, 0), b2, voffB); PG8_STAGE(PG8_SB(0, 1), b2 + hstepB, voffB); PG8_STAGEA(PG8_SA(0, 0), a2, vo2, 0);
            PG8_WAIT_V(8); PG8_WAIT_L(0); PG8_BAR; PG8_MMA(1, 0, At, B0); PG8_MMA(1, 1, At, B1); PG8_BAR; PG8_SCHED;
            PG8_LDB(B0, 1, 0); PG8_LDB(B1, 1, 1); PG8_SCHED; PG8_LDA(At, 1, 0); PG8_STAGEA(PG8_SA(0, 1), a2, vo2, 1);
            PG8_WAIT_V(8); PG8_WAIT_L(0); PG8_BAR; PG8_MMA(0, 0, At, B0); PG8_MMA(0, 1, At, B1); PG8_BAR; PG8_SCHED;
            PG8_LDA(At, 1, 1); PG8_STAGE(PG8_SB(1, 0), b3, voffB); PG8_STAGE(PG8_SB(1, 1), b3 + hstepB, voffB); PG8_STAGEA(PG8_SA(1, 0), a3, vo2, 0);
            PG8_WAIT_V(8); PG8_WAIT_L(0); PG8_BAR; PG8_MMA(1, 0, At, B0); PG8_MMA(1, 1, At, B1); PG8_BAR; PG8_SCHED;
        }
        if constexpr (ALIGN_EPI) { if (wr == 0) PG8_BAR; }
        E(acc, cur, wr, wc, fr, fq);
        if (!has_next) break;
#pragma unroll
        for (int a = 0; a < 2; ++a)
#pragma unroll
            for (int b = 0; b < 2; ++b)
#pragma unroll
                for (int m = 0; m < 4; ++m)
#pragma unroll
                    for (int n = 0; n < 2; ++n) acc[a][b][m][n] = (f32x4){0.f, 0.f, 0.f, 0.f};
        cur = nxt; cA = nA; cB = nB; ++ui;
        if constexpr (GATHER) {
#pragma unroll
            for (int i = 0; i < 4; ++i) cvo[i] = nvo[i]; }
        if constexpr (ALIGN_EPI) { if (wr == 1) PG8_BAR; }
    }
    PG8_WAIT_V(0);
    if constexpr (!ALIGN_EPI) { if (wr == 0) PG8_BAR; }
    PG8_BAR;
#undef PG8_SA
#undef PG8_SB
#undef PG8_STAGE
#undef PG8_STAGEA
#undef PG8_ROWOFFS
#undef PG8_LDA
#undef PG8_LDB
#undef PG8_MMA
#undef PG8_HALF
#undef PG8_WAIT_V
#undef PG8_WAIT_L
#undef PG8_BAR
#undef PG8_SCHED
}
}

constexpr int NB = 8, SEQ = 2048, D = 1024, T = NB * SEQ;
constexpr int MEML = 256, TM = NB * MEML;
constexpr int HYC = 512, NZ0 = 2048;
constexpr int FF = 2816, NGU = 2 * FF;
constexpr int ATW = 1536, NQKV = 3 * ATW, NQ1 = NQKV + 512;
constexpr int NE = 8, PMAX = 2 * T + NE * 256;
constexpr float EPS = 1e-6f;
constexpr float MOE_WGU_SCALE = 32.0f, MOE_WD_SCALE = 64.0f;
constexpr int NWAVES = 8;

constexpr size_t MiB = 1u << 20;
constexpr size_t WS_CTL = 0, CTL_ZERO_BYTES = 1 * MiB;
constexpr size_t WS_WGU1 = 1 * MiB;
constexpr size_t WS_WD1 = 89 * MiB;
constexpr size_t WS_SMALL = 133 * MiB;
constexpr size_t WS_RSTD0 = WS_SMALL;
constexpr size_t WS_SSQ16 = WS_SMALL + 64 * 1024;
constexpr size_t WS_LSE = WS_SSQ16 + 1 * MiB;
constexpr size_t WS_TOKE = WS_LSE + 768 * 1024;
constexpr size_t WS_TOKR = WS_TOKE + 128 * 1024;
constexpr size_t WS_TOKG = WS_TOKR + 128 * 1024;
constexpr size_t WS_RSTD3 = WS_TOKG + 128 * 1024;
constexpr size_t WS_LIST = WS_RSTD3 + 64 * 1024;
constexpr size_t WS_RSTDS = WS_LIST + 512 * 1024;
static_assert(WS_RSTDS + PMAX * 4 <= WS_SMALL + 4 * MiB, "small region");
constexpr size_t WS_WO = 137 * MiB;
constexpr size_t WS_WIN1 = 141 * MiB;
constexpr size_t WS_WKV = 151 * MiB;
constexpr size_t WS_WIN0 = 155 * MiB;
constexpr size_t WS_WGU0 = 159 * MiB;
constexpr size_t WS_WD0 = 170 * MiB;
constexpr size_t WS_KV = 176 * MiB;
constexpr size_t WS_XB = 184 * MiB;
constexpr size_t WS_YT = 336 * MiB;
constexpr size_t WS_MIX0 = 216 * MiB;
constexpr size_t WS_MN = 248 * MiB;
constexpr size_t WS_ZT = 256 * MiB;
constexpr size_t WS_XQ0 = 304 * MiB;
constexpr size_t WS_HF = 320 * MiB;
constexpr size_t WS_HID0 = 248 * MiB;
constexpr size_t WS_QKV1 = 248 * MiB;
constexpr size_t WS_XQ1 = 392 * MiB;
constexpr size_t WS_OG12 = 216 * MiB;
constexpr size_t WS_MIX1 = 141 * MiB;
constexpr size_t WS_XB3 = 137 * MiB;
constexpr size_t WS_XS = 137 * MiB;
constexpr size_t WS_HID1 = 205 * MiB;
constexpr size_t WS_Y2 = 392 * MiB;
constexpr size_t WS_END = 408 * MiB;
static_assert(WS_HID1 + (size_t)PMAX * FF * 2 <= WS_END && WS_XQ1 + (size_t)T * 512 * 2 <= WS_END && WS_XS + (size_t)PMAX * 2048 <= WS_HID1, "ws map");

constexpr int CW_CNT = 64;
constexpr int CW_BAR = 4096;

constexpr int SCR_BYTES = 155648;
constexpr int MISC_OFF = SCR_BYTES;
constexpr int LDS_BYTES = SCR_BYTES + 4096;

#define LAS __attribute__((address_space(3)))
typedef unsigned short bf16;
typedef unsigned v4u __attribute__((ext_vector_type(4)));
typedef unsigned v2u __attribute__((ext_vector_type(2)));
typedef float f32x4 __attribute__((ext_vector_type(4)));
typedef float f32x2 __attribute__((ext_vector_type(2)));
#define LDS_WAIT() asm volatile("s_waitcnt lgkmcnt(0)" ::: "memory")
__device__ __forceinline__ unsigned f2bf(float f) { unsigned u = __builtin_bit_cast(unsigned, f); return (u + 0x7fffu + ((u >> 16) & 1u)) >> 16; }
__device__ __forceinline__ unsigned pk2(float lo, float hi) { unsigned r; asm("v_cvt_pk_bf16_f32 %0, %1, %2" : "=v"(r) : "v"(lo), "v"(hi)); return r; }
__device__ __forceinline__ unsigned pk4_fp8(float a, float b, float c, float d) { unsigned w = 0u; w = __builtin_amdgcn_cvt_pk_fp8_f32(a, b, w, false); w = __builtin_amdgcn_cvt_pk_fp8_f32(c, d, w, true); return w; }
__device__ __forceinline__ float bflo(unsigned w) { return __builtin_bit_cast(float, w << 16); }
__device__ __forceinline__ float bfhi(unsigned w) { return __builtin_bit_cast(float, w & 0xffff0000u); }
__device__ __forceinline__ float bf1(bf16 b) { return __builtin_bit_cast(float, ((unsigned)b) << 16); }
__device__ __forceinline__ float wave_sum(float v) {
#pragma unroll
    for (int o = 1; o < 64; o <<= 1) v += __shfl_xor(v, o);
    return v;
}
__device__ __forceinline__ float wave_max(float v) {
#pragma unroll
    for (int o = 1; o < 64; o <<= 1) v = fmaxf(v, __shfl_xor(v, o));
    return v;
}

#define XB_TMO      128
#define XB_XCNT(j)  (256  + 64 * (j))
#define XB_XSUB(j)  (1280 + 64 * (j))
#define XB_XGEN(j)  (2304 + 64 * (j))
#define XB_TOP      3328
#define XB_TOPGEN   3392
#define XCD_BAR_WORDS 3456
#define XB_SPIN_CAP (1u << 18)

__device__ __forceinline__ unsigned xb_ld(unsigned* p)              { return __hip_atomic_load(p, __ATOMIC_RELAXED, __HIP_MEMORY_SCOPE_AGENT); }
__device__ __forceinline__ unsigned xb_add(unsigned* p, unsigned v) { return __hip_atomic_fetch_add(p, v, __ATOMIC_RELAXED, __HIP_MEMORY_SCOPE_AGENT); }
__device__ __forceinline__ unsigned xb_xcc_id() { return (unsigned)__builtin_amdgcn_s_getreg((3 << 11) | 20) & 0xFu; }
#define XB_SPIN(cond, bar) do { unsigned _sp = 0; while (cond) { __builtin_amdgcn_s_sleep(1); \
    if ((++_sp & 255u) == 0u) { if (xb_ld(&(bar)[XB_TMO])) break; if (_sp > XB_SPIN_CAP) { atomicAdd(&(bar)[XB_TMO], 1u); break; } } } } while (0)

struct XcdBarrier {
    unsigned* bar; unsigned x;
    volatile LAS unsigned* st;
};
__device__ __forceinline__ XcdBarrier xcd_barrier_post(unsigned* bar, volatile LAS unsigned* st, int tid) {
    XcdBarrier b; b.bar = bar; b.x = xb_xcc_id(); b.st = st;
    if (tid == 0) (void)xb_add(&bar[XB_XCNT(b.x)], 1u);
    return b;
}
__device__ __forceinline__ void xcd_barrier_complete(unsigned* bar, unsigned x, unsigned& nloc, unsigned& nx) {
    const unsigned G = gridDim.x * gridDim.y * gridDim.z;
    unsigned sum, cnt, mine, sp = 0u;
    for (;;) {
        sum = 0u; cnt = 0u; mine = 0u;
#pragma unroll
        for (unsigned j = 0; j < 16; ++j) { const unsigned c = xb_ld(&bar[XB_XCNT(j)]); sum += c; cnt += (c > 0u) ? 1u : 0u; mine = (j == x) ? c : mine; }
        if (sum == G) break;
        __builtin_amdgcn_s_sleep(1);
        if ((++sp & 255u) == 0u) { if (xb_ld(&bar[XB_TMO])) break; if (sp > XB_SPIN_CAP) { atomicAdd(&bar[XB_TMO], 1u); break; } }
    }
    nloc = mine > 0u ? mine : 1u; nx = cnt > 0u ? cnt : 1u;
}
__device__ __forceinline__ void xcd_barrier(const XcdBarrier& b, int tid) {
    asm volatile("s_waitcnt vmcnt(0)" ::: "memory");
    __syncthreads();
    if (tid == 0) {
        unsigned* bar = b.bar;
        __builtin_amdgcn_s_waitcnt(0);
        unsigned nloc = b.st[0], nx = b.st[1];
        if (nloc == 0u) { xcd_barrier_complete(bar, b.x, nloc, nx); b.st[0] = nloc; b.st[1] = nx; }
        const unsigned old = xb_add(&bar[XB_XSUB(b.x)], 1u);
        const unsigned gen = old / nloc;
        if (old + 1u == (gen + 1u) * nloc) {
            __builtin_amdgcn_fence(__ATOMIC_RELEASE, "agent");
            asm volatile("s_waitcnt vmcnt(0)" ::: "memory");
            const unsigned og = xb_add(&bar[XB_TOP], 1u);
            const unsigned tg = og / nx;
            if (og + 1u == (tg + 1u) * nx) xb_add(&bar[XB_TOPGEN], 1u);
            else XB_SPIN(xb_ld(&bar[XB_TOPGEN]) == tg, bar);
            __builtin_amdgcn_fence(__ATOMIC_ACQUIRE, "agent");
            xb_add(&bar[XB_XGEN(b.x)], 1u);
            asm volatile("s_waitcnt vmcnt(0)" ::: "memory");
        } else {
            XB_SPIN(xb_ld(&bar[XB_XGEN(b.x)]) == gen, bar);
            __builtin_amdgcn_fence(__ATOMIC_ACQUIRE, "agent");
            asm volatile("s_waitcnt vmcnt(0)" ::: "memory");
        }
    }
    __syncthreads();
}

struct Args { const float* in[30]; float* out; unsigned char* ws; int ph_lo, ph_hi, bslot, pad; };
enum { I_X = 0, I_MEM, I_RELB, I_NMIX, I_NMEM, I_NFFN, I_WKV, I_XQN, I_XKN, I_WOUT, I_HYWIN, I_HYCW, I_HYCB, I_FW1, I_FB1, I_FW2, I_FB2, I_FW3, I_FREQ, I_SKIP,
       I_ATWIN, I_ATQN, I_ATKN, I_FFG, I_FFU, I_FFD, I_ROUTER, I_MOEG, I_MOEU, I_MOED };

struct Frame {
    LAS unsigned char* lds;
    unsigned char* ws;
    int tid, lane, wave, G, bid;
};

constexpr int RSL_OFF = 131072;
template <int SCALE> struct EpiB {
    bf16* O; int ldc; const float* sc; int split_tile; bf16* O2; int ldc2; const LAS float* rsl; float kc;
    __device__ __forceinline__ void operator()(const f32x4 (&acc)[2][2][4][2], const pg8::Unit& u, int wr, int wc, int fr, int fq) const {
        const int row0 = u.pm * 256 + wr * 64 + fr;
        bf16* base = O; int ld = ldc; int colt = u.pn * 256;
        if (u.pn >= split_tile) { base = O2; ld = ldc2; colt -= split_tile * 256; }
        if (u.koff != 0) base = O2;
        const int col0 = colt + wc * 32 + 8 * fq;
        float rsv[2][4];
        if (SCALE == 1) {
#pragma unroll
            for (int ai = 0; ai < 2; ++ai)
#pragma unroll
                for (int m = 0; m < 4; ++m) rsv[ai][m] = sc[row0 + ai * 128 + m * 16];
            asm volatile("s_waitcnt vmcnt(0)" ::: "memory");
        }
        f32x4 cs[2][2];
        if (SCALE == 3) {
#pragma unroll
            for (int bj = 0; bj < 2; ++bj)
#pragma unroll
                for (int n = 0; n < 2; ++n) cs[bj][n] = *(const f32x4*)(sc + u.pn * 256 + bj * 128 + wc * 32 + 8 * fq + 4 * n);
            asm volatile("s_waitcnt vmcnt(0)" ::: "memory");
        }
#pragma unroll
        for (int ai = 0; ai < 2; ++ai)
#pragma unroll
            for (int m = 0; m < 4; ++m) {
                const int row = row0 + ai * 128 + m * 16;
                float rs = 1.f;
                if (SCALE == 1) rs = rsv[ai][m];
                if (SCALE == 2) { const f32x4* p = (const f32x4*)(sc + (size_t)row * 16); const f32x4 a = p[0], b = p[1], c = p[2], d = p[3];
                    const float s = ((a.x + a.y) + (a.z + a.w)) + ((b.x + b.y) + (b.z + b.w)) + ((c.x + c.y) + (c.z + c.w)) + ((d.x + d.y) + (d.z + d.w));
                    rs = 1.0f / sqrtf(s * (1.0f / D) + EPS); }
                if (SCALE == 4) rs = rsl[u.idx * 256 + (row - u.pm * 256)];
                if (SCALE == 5) rs = kc;
                bf16* rowp = base + (size_t)row * ld + col0;
#pragma unroll
                for (int bj = 0; bj < 2; ++bj) {
                    f32x4 v0 = acc[ai][bj][m][0], v1 = acc[ai][bj][m][1];
                    if (SCALE == 1 || SCALE == 2 || SCALE == 4 || SCALE == 5) { v0 = v0 * rs; v1 = v1 * rs; }
                    if (SCALE == 3) { v0 = v0 * cs[bj][0]; v1 = v1 * cs[bj][1]; }
                    v4u w; w.x = pk2(v0[0], v0[1]); w.y = pk2(v0[2], v0[3]); w.z = pk2(v1[0], v1[1]); w.w = pk2(v1[2], v1[3]);
                    *(v4u*)(rowp + bj * 128) = w;
                }
            }
    }
};
template <bool XF32, bool SSQ> struct EpiRes {
    const float* xf; const bf16* xi; int ldi; bf16* xo; int ldo; float* ssq16;
    __device__ __forceinline__ void operator()(const f32x4 (&acc)[2][2][4][2], const pg8::Unit& u, int wr, int wc, int fr, int fq) const {
        const int row0 = u.pm * 256 + wr * 64 + fr, col0 = u.pn * 256 + wc * 32 + 8 * fq;
        if constexpr (!XF32) {
            v4u res[2][4][2];
#pragma unroll
            for (int ai = 0; ai < 2; ++ai)
#pragma unroll
                for (int m = 0; m < 4; ++m)
#pragma unroll
                    for (int bj = 0; bj < 2; ++bj) res[ai][m][bj] = *(const v4u*)(xi + (size_t)(row0 + ai * 128 + m * 16) * ldi + col0 + bj * 128);
            asm volatile("s_waitcnt vmcnt(0)" ::: "memory");
#pragma unroll
            for (int ai = 0; ai < 2; ++ai)
#pragma unroll
                for (int m = 0; m < 4; ++m) {
                    const int row = row0 + ai * 128 + m * 16;
                    float ss = 0.f;
#pragma unroll
                    for (int bj = 0; bj < 2; ++bj) {
                        const v4u w0 = res[ai][m][bj];
                        const f32x4 r0 = (f32x4){bflo(w0.x), bfhi(w0.x), bflo(w0.y), bfhi(w0.y)}, r1 = (f32x4){bflo(w0.z), bfhi(w0.z), bflo(w0.w), bfhi(w0.w)};
                        const f32x4 v0 = acc[ai][bj][m][0] + r0, v1 = acc[ai][bj][m][1] + r1;
                        v4u w; w.x = pk2(v0[0], v0[1]); w.y = pk2(v0[2], v0[3]); w.z = pk2(v1[0], v1[1]); w.w = pk2(v1[2], v1[3]);
                        *(v4u*)(xo + (size_t)row * ldo + col0 + bj * 128) = w;
                        if (SSQ) ss += ((v0[0] * v0[0] + v0[1] * v0[1]) + (v0[2] * v0[2] + v0[3] * v0[3])) + ((v1[0] * v1[0] + v1[1] * v1[1]) + (v1[2] * v1[2] + v1[3] * v1[3]));
                    }
                    if (SSQ) { ss += __shfl_xor(ss, 16); ss += __shfl_xor(ss, 32);
                        if (fq == 0) ssq16[(size_t)row * 16 + u.pn * 4 + wc] = ss; }
                }
        } else {
#pragma unroll
            for (int ai = 0; ai < 2; ++ai)
#pragma unroll
                for (int m = 0; m < 4; ++m) {
                    const int row = row0 + ai * 128 + m * 16;
                    float ss = 0.f;
#pragma unroll
                    for (int bj = 0; bj < 2; ++bj) {
                        const size_t off = (size_t)row * D + col0 + bj * 128; const f32x4 r0 = *(const f32x4*)(xf + off), r1 = *(const f32x4*)(xf + off + 4);
                        const f32x4 v0 = acc[ai][bj][m][0] + r0, v1 = acc[ai][bj][m][1] + r1;
                        v4u w; w.x = pk2(v0[0], v0[1]); w.y = pk2(v0[2], v0[3]); w.z = pk2(v1[0], v1[1]); w.w = pk2(v1[2], v1[3]);
                        *(v4u*)(xo + (size_t)row * ldo + col0 + bj * 128) = w;
                        if (SSQ) ss += ((v0[0] * v0[0] + v0[1] * v0[1]) + (v0[2] * v0[2] + v0[3] * v0[3])) + ((v1[0] * v1[0] + v1[1] * v1[1]) + (v1[2] * v1[2] + v1[3] * v1[3]));
                    }
                    if (SSQ) { ss += __shfl_xor(ss, 16); ss += __shfl_xor(ss, 32);
                        if (fq == 0) ssq16[(size_t)row * 16 + u.pn * 4 + wc] = ss; }
                }
        }
    }
};
template <int SCALE, bool OUT8 = false> struct EpiSwiglu {
    bf16* H; int ldh; const float* sc; const LAS float* rsl; float kc;
    __device__ __forceinline__ void operator()(const f32x4 (&acc)[2][2][4][2], const pg8::Unit& u, int wr, int wc, int fr, int fq) const {
        const int row0 = u.pm * 256 + wr * 64 + fr, col0 = u.pn * 128 + wc * 32 + 8 * fq;
#pragma unroll
        for (int ai = 0; ai < 2; ++ai)
#pragma unroll
            for (int m = 0; m < 4; ++m) {
                const int row = row0 + ai * 128 + m * 16;
                float rs = 1.f;
                if (SCALE == 1) rs = sc[row];
                if (SCALE == 2) { const f32x4* p = (const f32x4*)(sc + (size_t)row * 16); const f32x4 a = p[0], b = p[1], c = p[2], d = p[3];
                    const float s = ((a.x + a.y) + (a.z + a.w)) + ((b.x + b.y) + (b.z + b.w)) + ((c.x + c.y) + (c.z + c.w)) + ((d.x + d.y) + (d.z + d.w));
                    rs = 1.0f / sqrtf(s * (1.0f / D) + EPS); }
                if (SCALE == 4) rs = rsl[u.idx * 256 + (row - u.pm * 256)];
                if (SCALE == 5) rs = kc;
                float h[8];
#pragma unroll
                for (int n = 0; n < 2; ++n)
#pragma unroll
                    for (int j = 0; j < 4; ++j) { const float gv = acc[ai][0][m][n][j] * rs, uv = acc[ai][1][m][n][j] * rs;
                        h[n * 4 + j] = gv * uv * __builtin_amdgcn_rcpf(1.0f + __expf(-gv)); }
                if (OUT8) { v2u w; w.x = pk4_fp8(h[0], h[1], h[2], h[3]); w.y = pk4_fp8(h[4], h[5], h[6], h[7]); *(v2u*)((unsigned char*)H + (size_t)row * ldh + col0) = w; }
                else { v4u w; w.x = pk2(h[0], h[1]); w.y = pk2(h[2], h[3]); w.z = pk2(h[4], h[5]); w.w = pk2(h[6], h[7]);
                    *(v4u*)(H + (size_t)row * ldh + col0) = w; }
            }
    }
};

template <class Sched>
__device__ __forceinline__ void fill_rstd_table(LAS unsigned char* lds, const Sched& S, const float* ssq16, int tid) {
    LAS float* rsl = (LAS float*)(lds + RSL_OFF);
    pg8::Unit u;
    for (int ui = 0; ui < 16 && S.next(ui, u); ++ui) {
        if (tid < 256) { const f32x4* p = (const f32x4*)(ssq16 + (size_t)(u.pm * 256 + tid) * 16); const f32x4 a = p[0], b = p[1], c = p[2], d = p[3];
            const float s = ((a.x + a.y) + (a.z + a.w)) + ((b.x + b.y) + (b.z + b.w)) + ((c.x + c.y) + (c.z + c.w)) + ((d.x + d.y) + (d.z + d.w));
            rsl[ui * 256 + tid] = 1.0f / sqrtf(s * (1.0f / D) + EPS); }
    }
    __syncthreads();
}

__device__ __forceinline__ void p0_transpose_item(const float* W, int K, int N, bf16* WT, const float* gain, int mode, LAS float* scr, int item, int lane) {
    const int nblk = N / 64, kb = item / nblk, nb = item % nblk, k0 = 64 * kb, n0 = 64 * nb;
    const int lr = lane >> 4, lc = lane & 15;
    f32x4 v[16];
#pragma unroll
    for (int i = 0; i < 16; ++i) v[i] = __builtin_nontemporal_load((const f32x4*)(W + (size_t)(k0 + 4 * i + lr) * N + n0 + 4 * lc));
    if (gain) {
#pragma unroll
        for (int i = 0; i < 16; ++i) v[i] = v[i] * gain[k0 + 4 * i + lr];
    }
#pragma unroll
    for (int i = 0; i < 16; ++i) { LAS float* s = scr + (4 * i + lr) * 65 + 4 * lc; s[0] = v[i].x; s[1] = v[i].y; s[2] = v[i].z; s[3] = v[i].w; }
    LDS_WAIT(); asm volatile("" ::: "memory");
    const int c = lane & 7;
    const int d0 = (mode == 0) ? n0 : (256 * (n0 / 128) + (n0 % 128) + (mode == 2 ? 128 : 0));
#pragma unroll
    for (int j = 0; j < 8; ++j) { const int n = (lane >> 3) + 8 * j; const LAS float* s = scr + (8 * c) * 65 + n;
        v4u o; o.x = pk2(s[0 * 65], s[1 * 65]); o.y = pk2(s[2 * 65], s[3 * 65]); o.z = pk2(s[4 * 65], s[5 * 65]); o.w = pk2(s[6 * 65], s[7 * 65]);
        *(v4u*)(WT + (size_t)(d0 + n) * K + k0 + 8 * c) = o; }
    LDS_WAIT(); asm volatile("" ::: "memory");
}
__device__ __forceinline__ void p0_transpose_item8(const float* W, int K, int N, unsigned char* WT8, const float* gain, float s8, int mode, LAS float* scr, int item, int lane) {
    const int nblk = N / 64, kb = item / nblk, nb = item % nblk, k0 = 64 * kb, n0 = 64 * nb;
    const int lr = lane >> 4, lc = lane & 15;
    f32x4 v[16];
#pragma unroll
    for (int i = 0; i < 16; ++i) v[i] = __builtin_nontemporal_load((const f32x4*)(W + (size_t)(k0 + 4 * i + lr) * N + n0 + 4 * lc));
#pragma unroll
    for (int i = 0; i < 16; ++i) { const float g = gain ? gain[k0 + 4 * i + lr] * s8 : s8; v[i] = v[i] * g; }
#pragma unroll
    for (int i = 0; i < 16; ++i) { LAS float* s = scr + (4 * i + lr) * 65 + 4 * lc; s[0] = v[i].x; s[1] = v[i].y; s[2] = v[i].z; s[3] = v[i].w; }
    LDS_WAIT(); asm volatile("" ::: "memory");
    const int c = lane & 3;
    const int d0 = (mode == 0) ? n0 : (256 * (n0 / 128) + (n0 % 128) + (mode == 2 ? 128 : 0));
#pragma unroll
    for (int j = 0; j < 4; ++j) { const int n = (lane >> 2) + 16 * j; const LAS float* s = scr + (16 * c) * 65 + n;
        v4u o; o.x = pk4_fp8(s[0 * 65], s[1 * 65], s[2 * 65], s[3 * 65]); o.y = pk4_fp8(s[4 * 65], s[5 * 65], s[6 * 65], s[7 * 65]);
        o.z = pk4_fp8(s[8 * 65], s[9 * 65], s[10 * 65], s[11 * 65]); o.w = pk4_fp8(s[12 * 65], s[13 * 65], s[14 * 65], s[15 * 65]);
        __builtin_nontemporal_store(o, (v4u*)(WT8 + (size_t)(d0 + n) * K + k0 + 16 * c)); }
    LDS_WAIT(); asm volatile("" ::: "memory");
}
__device__ __forceinline__ float row_to_bf16(const float* xrow, bf16* orow, const float* gain, bool normalize, int lane) {
    const f32x4* xr = (const f32x4*)xrow + lane;
    f32x4 v[4]; float s = 0.f;
#pragma unroll
    for (int j = 0; j < 4; ++j) { v[j] = __builtin_nontemporal_load(xr + 64 * j); s += (v[j].x * v[j].x + v[j].y * v[j].y) + (v[j].z * v[j].z + v[j].w * v[j].w); }
    const float rstd = 1.0f / sqrtf(wave_sum(s) * (1.f / D) + EPS);
    unsigned long long* o8 = (unsigned long long*)orow + lane;
#pragma unroll
    for (int j = 0; j < 4; ++j) {
        f32x4 w = v[j];
        if (normalize) { const f32x4 g = ((const f32x4*)gain)[lane + 64 * j]; w = w * rstd * g; }
        o8[64 * j] = (unsigned long long)pk2(w.x, w.y) | ((unsigned long long)pk2(w.z, w.w) << 32);
    }
    return rstd;
}
__device__ __forceinline__ void p0_filter_block(Frame& F, const Args& a, float* Hf, int jb) {
    const float* w1 = a.in[I_FW1]; const float* b1 = a.in[I_FB1]; const float* w2 = a.in[I_FW2]; const float* b2 = a.in[I_FB2]; const float* w3 = a.in[I_FW3]; const float* fr = a.in[I_FREQ];
    LAS float* h2s = (LAS float*)(F.lds + MISC_OFF + 256);
    const int lane = F.lane, j0 = jb * 8;
    LAS float* W1s = (LAS float*)F.lds; LAS float* W2s = W1s + 33 * 64;
    for (int i = F.tid; i < 33 * 64; i += 512) W1s[i] = w1[i];
    for (int i = F.tid; i < 64 * 64; i += 512) W2s[i] = w2[i];
    __syncthreads();
    {
        const int j = j0 + F.wave;
        const float freq = fr[lane], bb1 = b1[lane], bb2 = b2[lane];
        float feat = 0.f;
        {
            const int fi = (lane >= 17) ? lane - 17 : lane - 1;
            const float f = 1e-4f + (float)fi * ((15.0f - 1e-4f) / 15.0f);
            const float ang = (6.283185307179586f / 2048.0f) * (float)j * f;
            if (lane == 0) feat = (float)j * (1.0f / 2047.0f);
            else if (lane <= 16) feat = cosf(ang);
            else if (lane <= 32) feat = -sinf(ang);
        }
        float s1 = bb1;
#pragma unroll
        for (int i = 0; i < 33; ++i) s1 += __shfl(feat, i) * W1s[i * 64 + lane];
        const float h1 = sinf(freq * s1);
        float s2 = bb2;
#pragma unroll 16
        for (int i = 0; i < 64; ++i) s2 += __shfl(h1, i) * W2s[i * 64 + lane];
        h2s[lane * 8 + F.wave] = sinf(freq * s2);
    }
    __syncthreads();
    const int n0 = F.wave * 256;
    float acc[4][8];
#pragma unroll
    for (int q = 0; q < 4; ++q)
#pragma unroll
        for (int jj = 0; jj < 8; ++jj) acc[q][jj] = 0.f;
#pragma unroll 1
    for (int i0 = 0; i0 < 64; i0 += 8) {
        float w[8][4];
#pragma unroll
        for (int ii = 0; ii < 8; ++ii)
#pragma unroll
            for (int q = 0; q < 4; ++q) w[ii][q] = w3[(size_t)(i0 + ii) * 2048 + n0 + q * 64 + lane];
#pragma unroll
        for (int ii = 0; ii < 8; ++ii) {
            const f32x4 ha = *(const LAS f32x4*)(h2s + (i0 + ii) * 8), hb = *(const LAS f32x4*)(h2s + (i0 + ii) * 8 + 4);
#pragma unroll
            for (int q = 0; q < 4; ++q) {
                acc[q][0] += ha.x * w[ii][q]; acc[q][1] += ha.y * w[ii][q]; acc[q][2] += ha.z * w[ii][q]; acc[q][3] += ha.w * w[ii][q];
                acc[q][4] += hb.x * w[ii][q]; acc[q][5] += hb.y * w[ii][q]; acc[q][6] += hb.z * w[ii][q]; acc[q][7] += hb.w * w[ii][q]; }
        }
    }
    const float da = -3.0701134573253945f, db = -15.350567286626973f;
#pragma unroll
    for (int q = 0; q < 4; ++q) {
        const int n = n0 + q * 64 + lane, c = n & 511;
        const float delta = fabsf(da + (db - da) * ((float)c * (1.0f / 511.0f)));
        float o[8];
#pragma unroll
        for (int jj = 0; jj < 8; ++jj) { const float t = (float)(j0 + jj) * (1.0f / 2047.0f); o[jj] = acc[q][jj] * (expf(-t * delta) + 0.05f); }
        f32x4* dst = (f32x4*)(Hf + (size_t)n * 2048 + j0);
        dst[0] = (f32x4){o[0], o[1], o[2], o[3]}; dst[1] = (f32x4){o[4], o[5], o[6], o[7]};
    }
    __syncthreads();
}
constexpr int IT_MOE = 16 * 44, N_MOE_ITEMS = 24 * IT_MOE;
constexpr int MOE_P1_HI = 5376, MOE_P5_HI = 16896, MOE_P0_LO = MOE_P5_HI;
__device__ __forceinline__ void moe_convert(Frame& F, const Args& a, int lo, int hi, int gwl, int ngw) {
    LAS float* scr = (LAS float*)(F.lds + F.wave * 16640);
    unsigned char* ws = F.ws;
    for (int r = lo + gwl; r < hi; r += ngw) {
        const int mid = r / IT_MOE, li = r % IT_MOE, kind = mid >> 3, e = mid & 7;
        if (kind == 0) p0_transpose_item8(a.in[I_MOEG] + (size_t)e * D * FF, D, FF, ws + WS_WGU1 + (size_t)e * NGU * D, a.in[I_NFFN] + D, MOE_WGU_SCALE, 1, scr, li, F.lane);
        else if (kind == 1) p0_transpose_item8(a.in[I_MOEU] + (size_t)e * D * FF, D, FF, ws + WS_WGU1 + (size_t)e * NGU * D, a.in[I_NFFN] + D, MOE_WGU_SCALE, 2, scr, li, F.lane);
        else p0_transpose_item8(a.in[I_MOED] + (size_t)e * FF * D, FF, D, ws + WS_WD1 + (size_t)e * D * FF, nullptr, MOE_WD_SCALE, 0, scr, li, F.lane);
    }
}
__device__ __forceinline__ void p0_prologue(Frame& F, const Args& a) {
    LAS float* scr = (LAS float*)(F.lds + F.wave * 16640);
    const int gw = F.bid * NWAVES + F.wave, NGW = F.G * NWAVES;
    unsigned char* ws = F.ws;
    if (!(F.bid & 1)) { for (int jb = F.bid; jb < 256; jb += F.G) p0_filter_block(F, a, (float*)(ws + WS_HF), jb); }
    for (int m = gw; m < T; m += NGW) { const float r = row_to_bf16(a.in[I_X] + (size_t)m * D, (bf16*)(ws + WS_XB) + (size_t)m * D, nullptr, false, F.lane); if (F.lane == 0) ((float*)(ws + WS_RSTD0))[m] = r; }
    for (int m = gw; m < 2 * TM; m += NGW) { const int l = m / TM, r = m % TM;
        (void)row_to_bf16(a.in[I_MEM] + (size_t)r * D, (bf16*)(ws + WS_MN) + (size_t)m * D, a.in[I_NMEM] + l * D, true, F.lane); }
    constexpr int IT_A = 16 * 32, IT_SQ = 16 * 16, IT_G = 16 * 44, IT_D = 44 * 16, IT_W1 = 16 * 80;
    constexpr int NSMALL = IT_A + 4 * IT_SQ + 2 * IT_G + IT_D + IT_W1;
    for (int it = gw; it < NSMALL; it += NGW) {
        int r = it;
        if (r < IT_A) { p0_transpose_item(a.in[I_HYWIN], D, NZ0, (bf16*)(ws + WS_WIN0), a.in[I_NMIX], 0, scr, r, F.lane); continue; } r -= IT_A;
        if (r < IT_SQ) { p0_transpose_item(a.in[I_WKV], D, D, (bf16*)(ws + WS_WKV), nullptr, 0, scr, r, F.lane); continue; } r -= IT_SQ;
        if (r < IT_SQ) { p0_transpose_item(a.in[I_WKV] + (size_t)D * D, D, D, (bf16*)(ws + WS_WKV) + (size_t)D * D, nullptr, 0, scr, r, F.lane); continue; } r -= IT_SQ;
        if (r < IT_SQ) { p0_transpose_item(a.in[I_WOUT], D, D, (bf16*)(ws + WS_WO), nullptr, 0, scr, r, F.lane); continue; } r -= IT_SQ;
        if (r < IT_SQ) { p0_transpose_item(a.in[I_WOUT] + (size_t)D * D, D, D, (bf16*)(ws + WS_WO) + (size_t)D * D, nullptr, 0, scr, r, F.lane); continue; } r -= IT_SQ;
        if (r < IT_G) { p0_transpose_item(a.in[I_FFG], D, FF, (bf16*)(ws + WS_WGU0), a.in[I_NFFN], 1, scr, r, F.lane); continue; } r -= IT_G;
        if (r < IT_G) { p0_transpose_item(a.in[I_FFU], D, FF, (bf16*)(ws + WS_WGU0), a.in[I_NFFN], 2, scr, r, F.lane); continue; } r -= IT_G;
        if (r < IT_D) { p0_transpose_item(a.in[I_FFD], FF, D, (bf16*)(ws + WS_WD0), nullptr, 0, scr, r, F.lane); continue; } r -= IT_D;
        p0_transpose_item(a.in[I_ATWIN], D, NQ1, (bf16*)(ws + WS_WIN1), a.in[I_NMIX] + D, 0, scr, r, F.lane);
    }
    moe_convert(F, a, (F.G == 256) ? MOE_P0_LO : 0, N_MOE_ITEMS, gw, NGW);
    if (F.bid & 1) { __syncthreads(); for (int jb = F.bid; jb < 256; jb += F.G) p0_filter_block(F, a, (float*)(ws + WS_HF), jb); }
}
__device__ __forceinline__ float block_sum(Frame& F, float v) {
    LAS float* red = (LAS float*)(F.lds + MISC_OFF + 64);
    v = wave_sum(v);
    __syncthreads();
    if (F.lane == 0) red[F.wave] = v;
    __syncthreads();
    float s = 0.f;
#pragma unroll
    for (int w = 0; w < NWAVES; ++w) s += red[w];
    return s;
}
__device__ __forceinline__ int rel_bucket_dev(int rel) {
    const int n = rel < 0 ? -rel : rel;
    const int large = 8 + (n >= 15) + (n >= 27) + (n >= 50) + (n >= 91) + (n >= 166) + (n >= 305) + (n >= 559);
    return (rel > 0 ? 16 : 0) + (n < 8 ? n : large);
}
__device__ __forceinline__ void merge_token(Frame& F, int token) {
    const bf16* og = (const bf16*)(F.ws + WS_OG12); const float* lse = (const float*)(F.ws + WS_LSE);
    bf16* mix = (bf16*)(F.ws + WS_MIX1);
    const int lane = F.lane, h = lane >> 4;
    const float l0 = lse[(size_t)token * 4 + h], l1 = lse[((size_t)T + token) * 4 + h], l2 = lse[((size_t)2 * T + token) * 4 + h];
    const float mx = fmaxf(l0, fmaxf(l1, l2));
    float w0 = __expf(l0 - mx), w1 = __expf(l1 - mx), w2 = __expf(l2 - mx);
    const float iz = 1.0f / (w0 + w1 + w2); w0 *= iz; w1 *= iz; w2 *= iz;
    const v4u a0 = *(const v4u*)(mix + (size_t)token * D + 8 * lane);
    const v4u a1 = __builtin_nontemporal_load((const v4u*)(og + (size_t)token * 512 + 8 * lane));
    const v4u a2 = __builtin_nontemporal_load((const v4u*)(og + ((size_t)T + token) * 512 + 8 * lane));
    v4u o;
    o.x = pk2(w0 * bflo(a0.x) + w1 * bflo(a1.x) + w2 * bflo(a2.x), w0 * bfhi(a0.x) + w1 * bfhi(a1.x) + w2 * bfhi(a2.x));
    o.y = pk2(w0 * bflo(a0.y) + w1 * bflo(a1.y) + w2 * bflo(a2.y), w0 * bfhi(a0.y) + w1 * bfhi(a1.y) + w2 * bfhi(a2.y));
    o.z = pk2(w0 * bflo(a0.z) + w1 * bflo(a1.z) + w2 * bflo(a2.z), w0 * bfhi(a0.z) + w1 * bfhi(a1.z) + w2 * bfhi(a2.z));
    o.w = pk2(w0 * bflo(a0.w) + w1 * bflo(a1.w) + w2 * bflo(a2.w), w0 * bfhi(a0.w) + w1 * bfhi(a1.w) + w2 * bfhi(a2.w));
    *(v4u*)(mix + (size_t)token * D + 8 * lane) = o;
}

constexpr int RT_OFF_R = 0, RT_OFF_REC = 32768, RT_OFF_CNT = 32768 + 64 * 32;
__device__ __forceinline__ void route_block(Frame& F, const Args& a, int blk) {
    LAS float* RL = (LAS float*)(F.lds + RT_OFF_R); volatile LAS int* REC = (volatile LAS int*)(F.lds + RT_OFF_REC); LAS int* CNT = (LAS int*)(F.lds + RT_OFF_CNT);
    const int lane = F.lane;
    const float* g = a.in[I_NFFN] + D; const float* rt = a.in[I_ROUTER];
    __syncthreads();
    for (int i = F.tid; i < 2048; i += 512) { const f32x4 r = ((const f32x4*)rt)[i]; const float gg = g[i >> 1]; ((LAS f32x4*)RL)[i] = r * gg; }
    if (F.tid < 16) CNT[F.tid] = 0;
    __syncthreads();
    for (int q = 0; q < 8; ++q) {
        const int tl = F.wave * 8 + q, token = blk * 64 + tl;
        const bf16* xr = (const bf16*)a.out + (size_t)token * 2048 + 1024;
        f32x4 v[4]; float s = 0.f;
#pragma unroll
        for (int j = 0; j < 4; ++j) { const v2u w = __builtin_nontemporal_load((const v2u*)xr + lane + 64 * j); v[j] = (f32x4){bflo(w.x), bfhi(w.x), bflo(w.y), bfhi(w.y)}; s += (v[j].x * v[j].x + v[j].y * v[j].y) + (v[j].z * v[j].z + v[j].w * v[j].w); }
        const float rstd = 1.0f / sqrtf(wave_sum(s) * (1.f / D) + EPS);
        { unsigned* o4 = (unsigned*)(F.ws + WS_XB3 + (size_t)token * D) + lane;
#pragma unroll
          for (int j = 0; j < 4; ++j) o4[64 * j] = pk4_fp8(v[j].x * rstd, v[j].y * rstd, v[j].z * rstd, v[j].w * rstd); }
        float lg[8];
#pragma unroll
        for (int e = 0; e < 8; ++e) lg[e] = 0.f;
#pragma unroll
        for (int j = 0; j < 4; ++j) {
            const int k0 = 4 * (lane + 64 * j);
#pragma unroll
            for (int qq = 0; qq < 4; ++qq) {
                const float hn = v[j][qq] * rstd;
                const f32x4 r0 = *(const LAS f32x4*)(RL + (k0 + qq) * 8), r1 = *(const LAS f32x4*)(RL + (k0 + qq) * 8 + 4);
                lg[0] += hn * r0.x; lg[1] += hn * r0.y; lg[2] += hn * r0.z; lg[3] += hn * r0.w;
                lg[4] += hn * r1.x; lg[5] += hn * r1.y; lg[6] += hn * r1.z; lg[7] += hn * r1.w;
            }
        }
#pragma unroll
        for (int e = 0; e < 8; ++e) lg[e] = wave_sum(lg[e]);
        int i1 = 0; float v1 = lg[0];
#pragma unroll
        for (int e = 1; e < 8; ++e) if (lg[e] > v1) { v1 = lg[e]; i1 = e; }
        int i2 = -1; float v2 = -3.0e38f;
#pragma unroll
        for (int e = 0; e < 8; ++e) if (e != i1 && lg[e] > v2) { v2 = lg[e]; i2 = e; }
        const float e2 = __expf(v2 - v1), g1 = 1.0f / (1.0f + e2), g2 = e2 * g1;
        if (lane == 0) {
            const int r1 = __hip_atomic_fetch_add(CNT + i1, 1, __ATOMIC_RELAXED, __HIP_MEMORY_SCOPE_WORKGROUP);
            const int r2 = __hip_atomic_fetch_add(CNT + i2, 1, __ATOMIC_RELAXED, __HIP_MEMORY_SCOPE_WORKGROUP);
            REC[tl * 8 + 0] = i1; REC[tl * 8 + 1] = i2; REC[tl * 8 + 2] = r1; REC[tl * 8 + 3] = r2;
            REC[tl * 8 + 4] = __builtin_bit_cast(int, g1); REC[tl * 8 + 5] = __builtin_bit_cast(int, g2); REC[tl * 8 + 6] = __builtin_bit_cast(int, rstd);
        }
    }
    __syncthreads();
    if (F.tid < 8) { unsigned* cnt = (unsigned*)(F.ws + WS_CTL) + CW_CNT; CNT[8 + F.tid] = (int)__hip_atomic_fetch_add(cnt + F.tid, (unsigned)CNT[F.tid], __ATOMIC_RELAXED, __HIP_MEMORY_SCOPE_AGENT); }
    __syncthreads();
    if (F.tid < 64) {
        const int tl = F.tid, token = blk * 64 + tl;
        const int i1 = REC[tl * 8 + 0], i2 = REC[tl * 8 + 1], r1 = CNT[8 + i1] + REC[tl * 8 + 2], r2 = CNT[8 + i2] + REC[tl * 8 + 3];
        int* toke = (int*)(F.ws + WS_TOKE); int* tokr = (int*)(F.ws + WS_TOKR); int* tokg = (int*)(F.ws + WS_TOKG); int* list = (int*)(F.ws + WS_LIST);
        list[(size_t)i1 * T + r1] = token; list[(size_t)i2 * T + r2] = token;
        toke[token * 2] = i1; toke[token * 2 + 1] = i2; tokr[token * 2] = r1; tokr[token * 2 + 1] = r2;
        tokg[token * 2] = REC[tl * 8 + 4]; tokg[token * 2 + 1] = REC[tl * 8 + 5];
        ((int*)(F.ws + WS_RSTD3))[token] = REC[tl * 8 + 6];
    }
}
__device__ __forceinline__ void moe_layout(Frame& F) {
    volatile LAS int* M = (volatile LAS int*)(F.lds + MISC_OFF);
    __syncthreads();
    if (F.tid == 0) {
        const unsigned* cnt = (const unsigned*)(F.ws + WS_CTL) + CW_CNT;
        int acc = 0;
        for (int e = 0; e < 8; ++e) { const int c = (int)__hip_atomic_load(cnt + e, __ATOMIC_RELAXED, __HIP_MEMORY_SCOPE_AGENT); M[32 + e] = c; M[40 + e] = acc; acc += (c + 255) & ~255; }
        M[48] = acc;
    }
    __syncthreads();
}
__device__ __forceinline__ int ml_ps(Frame& F, int e) { return ((volatile LAS int*)(F.lds + MISC_OFF))[40 + e]; }
__device__ __forceinline__ int ml_cnt(Frame& F, int e) { return ((volatile LAS int*)(F.lds + MISC_OFF))[32 + e]; }
__device__ __forceinline__ int ml_total(Frame& F) { return ((volatile LAS int*)(F.lds + MISC_OFF))[48]; }
__device__ __forceinline__ int ml_expert(Frame& F, int slot) { int e = 0;
#pragma unroll
    for (int i = 1; i < 8; ++i) e += (slot >= ml_ps(F, i)) ? 1 : 0;
    return e; }

constexpr int HY_CS = 4168, HY_M0 = 2080, HY_UR = 2592, HY_UP = 256;
constexpr int HY_OFF_CP = 64, HY_OFF_UB = HY_OFF_CP + 8 * HY_CS * 2, HY_OFF_X = HY_OFF_UB + 8 * HY_UR * 2;
static_assert(HY_OFF_X + 8 * 2048 * 2 <= SCR_BYTES, "hyena LDS");
typedef short bf16x8_t __attribute__((ext_vector_type(8)));

struct HyStage { v4u raw[4]; float zm[4], zp[4]; };
struct HyFilt { float f[4], b[4]; };
__device__ __forceinline__ void hy_short_load(HyStage& s, const bf16* zr, int tid) {
#pragma unroll
    for (int k = 0; k < 4; ++k) {
        const int item = tid + 512 * k, b = item >> 8, t8 = (item & 255) * 8;
        const bf16* p = zr + b * SEQ + t8;
        s.raw[k] = __builtin_nontemporal_load((const v4u*)p);
        s.zm[k] = (t8 > 0) ? bf1(p[-1]) : 0.f; s.zp[k] = (t8 + 8 < SEQ) ? bf1(p[8]) : 0.f;
    }
}
__device__ __forceinline__ void hy_short_store(LAS unsigned char* dst, int stride_el, int pad_el, const HyStage& s, float w0, float w1, float w2, float cb, int tid) {
#pragma unroll
    for (int k = 0; k < 4; ++k) {
        const int item = tid + 512 * k, b = item >> 8, t8 = (item & 255) * 8;
        float z[10];
        z[0] = s.zm[k]; z[1] = bflo(s.raw[k].x); z[2] = bfhi(s.raw[k].x); z[3] = bflo(s.raw[k].y); z[4] = bfhi(s.raw[k].y); z[5] = bflo(s.raw[k].z); z[6] = bfhi(s.raw[k].z); z[7] = bflo(s.raw[k].w); z[8] = bfhi(s.raw[k].w); z[9] = s.zp[k];
        float o[8];
#pragma unroll
        for (int i = 0; i < 8; ++i) o[i] = cb + z[i] * w0 + z[i + 1] * w1 + z[i + 2] * w2;
        v4u w; w.x = pk2(o[0], o[1]); w.y = pk2(o[2], o[3]); w.z = pk2(o[4], o[5]); w.w = pk2(o[6], o[7]);
        *(LAS v4u*)(dst + (size_t)(b * stride_el + pad_el + t8) * 2) = w;
    }
}
__device__ __forceinline__ void hy_filt_load(HyFilt& q, const float* Hf, int o, int c, int tid) {
    const float* fw = Hf + ((size_t)(o * 2 + 0) * 512 + c) * 2048;
    const float* bw = Hf + ((size_t)(o * 2 + 1) * 512 + c) * 2048;
#pragma unroll
    for (int i = 0; i < 4; ++i) { const int j = tid + 512 * i; q.f[i] = __builtin_nontemporal_load(fw + j); q.b[i] = (j >= 1) ? __builtin_nontemporal_load(bw + j) : 0.f; }
}
__device__ __forceinline__ void hy_filt_build(Frame& F, const HyFilt& q) {
    LAS float* Kf = (LAS float*)(F.lds + HY_OFF_X);
    float s = 0.f;
#pragma unroll
    for (int i = 0; i < 4; ++i) s += fabsf(q.f[i]) + fabsf(q.b[i]);
    const float tot = block_sum(F, s);
    const float inv = 1.0f / (tot + 1e-6f);
#pragma unroll
    for (int i = 0; i < 4; ++i) { const int j = F.tid + 512 * i; Kf[HY_M0 - j] = q.f[i] * inv; if (j >= 1) Kf[HY_M0 + j] = q.b[i] * inv; }
    if (F.tid < 33) Kf[F.tid] = 0.f;
    if (F.tid < 48) Kf[4128 + F.tid] = 0.f;
    __syncthreads();
    LAS unsigned* cp = (LAS unsigned*)(F.lds + HY_OFF_CP);
    for (int p = F.tid; p < 8 * (HY_CS / 2); p += 512) { const int j = p / (HY_CS / 2), xp = p - j * (HY_CS / 2), x = 2 * xp + j; cp[p] = pk2(Kf[x], Kf[x + 1]); }
    __syncthreads();
}
__device__ __forceinline__ void hy_conv_mfma(Frame& F, f32x4 (&C)[8]) {
    const int lane = F.lane, w = F.wave, r = lane & 15, kq = lane >> 4;
    const int jc = (-r) & 7, cr = (r + 7) >> 3;
    const LAS unsigned char* abase = F.lds + HY_OFF_CP + (size_t)(jc * HY_CS + HY_M0 - 32 * (8 * w - 63) + 8 * kq - 8 * cr) * 2;
    const LAS unsigned char* bbase = F.lds + HY_OFF_UB + (size_t)((r & 7) * HY_UR + HY_UP + 16 * (r >> 3) + 8 * kq) * 2;
#pragma unroll
    for (int i = 0; i < 8; ++i) C[i] = (f32x4){0.f, 0.f, 0.f, 0.f};
    bf16x8_t Bw[9];
#pragma unroll
    for (int i = 0; i < 8; ++i) Bw[i] = *(const LAS bf16x8_t*)(bbase + 64 * (63 + i));
    bf16x8_t An = *(const LAS bf16x8_t*)(abase);
#pragma unroll 1
    for (int Q = 0; Q < 8; ++Q) {
        const LAS unsigned char* ab = abase - 64 * (9 * Q);
        const LAS unsigned char* bb = bbase + 64 * (63 - 9 * Q);
#pragma unroll
        for (int qq = 0; qq < 9; ++qq) {
            const bf16x8_t A = An;
            An = *(const LAS bf16x8_t*)(ab - 64 * (qq + 1));
            Bw[(8 - qq + 9) % 9] = *(const LAS bf16x8_t*)(bb + 64 * (-1 - qq));
#pragma unroll
            for (int i = 7; i >= 0; --i) C[i] = __builtin_amdgcn_mfma_f32_16x16x32_bf16(A, Bw[(i - qq + 9) % 9], C[i], 0, 0, 0);
        }
    }
}
__device__ __forceinline__ void hyena_units(Frame& F, const Args& a) {
    const bf16* zT = (const bf16*)(F.ws + WS_ZT);
    const float* Hf = (const float*)(F.ws + WS_HF);
    const float* cw = a.in[I_HYCW]; const float* cbp = a.in[I_HYCB]; const float* skip = a.in[I_SKIP];
    bf16* yT = (bf16*)(F.ws + WS_YT);
    LAS unsigned char* UB = F.lds + HY_OFF_UB; LAS unsigned char* XB = F.lds + HY_OFF_X;
    int c = F.bid; if (c >= HYC) return;
    HyStage sA, sC, sG; HyFilt fB, fF;
    hy_short_load(sA, zT + (size_t)c * T, F.tid); hy_filt_load(fB, Hf, 0, c, F.tid); hy_short_load(sC, zT + (size_t)(HYC + c) * T, F.tid);
#pragma unroll 1
    for (;;) {
        const int lane = F.lane, w = F.wave, n = lane & 15, bb = n & 7, hh = n >> 3, rq = lane >> 4;
        __syncthreads();
        for (int p = F.tid; p < 8 * 272; p += 512) { const int b = p / 272, q = p - b * 272; const int el = (q < 128) ? 2 * q : (HY_UP + SEQ + 2 * (q - 128)); *(LAS unsigned*)(UB + (size_t)(b * HY_UR + el) * 2) = 0u; }
        { const int ch = c; hy_short_store(UB, HY_UR, HY_UP, sA, cw[ch], cw[1536 + ch], cw[3072 + ch], cbp[ch], F.tid); }
        hy_filt_build(F, fB);
        { const int ch = HYC + c; hy_short_store(XB, SEQ, 0, sC, cw[ch], cw[1536 + ch], cw[3072 + ch], cbp[ch], F.tid); }
        hy_filt_load(fF, Hf, 1, c, F.tid); hy_short_load(sG, zT + (size_t)(2 * HYC + c) * T, F.tid);
        __syncthreads();
        f32x4 C[8];
        hy_conv_mfma(F, C);
        __syncthreads();
        {   const float sk = skip[c];
#pragma unroll
            for (int i = 0; i < 8; ++i) {
                const int t0 = 32 * (8 * w + i) + 16 * hh + 4 * rq;
                LAS v2u* up = (LAS v2u*)(UB + (size_t)(bb * HY_UR + HY_UP + t0) * 2);
                const v2u uu = *up; const v2u xx = *(const LAS v2u*)(XB + (size_t)(bb * SEQ + t0) * 2);
                v2u o;
                o.x = pk2(bflo(xx.x) * (C[i][0] + bflo(uu.x) * sk), bfhi(xx.x) * (C[i][1] + bfhi(uu.x) * sk));
                o.y = pk2(bflo(xx.y) * (C[i][2] + bflo(uu.y) * sk), bfhi(xx.y) * (C[i][3] + bfhi(uu.y) * sk));
                *up = o;
            }
        }
        __syncthreads();
        hy_filt_build(F, fF);
        { const int ch = 2 * HYC + c; hy_short_store(XB, SEQ, 0, sG, cw[ch], cw[1536 + ch], cw[3072 + ch], cbp[ch], F.tid); }
        const int cn = c + F.G; const bool more = cn < HYC;
        if (more) { hy_short_load(sA, zT + (size_t)cn * T, F.tid); hy_filt_load(fB, Hf, 0, cn, F.tid); hy_short_load(sC, zT + (size_t)(HYC + cn) * T, F.tid); }
        __syncthreads();
        hy_conv_mfma(F, C);
        {   const float sk = skip[HYC + c];
#pragma unroll
            for (int i = 0; i < 8; ++i) {
                const int t0 = 32 * (8 * w + i) + 16 * hh + 4 * rq;
                const v2u uu = *(const LAS v2u*)(UB + (size_t)(bb * HY_UR + HY_UP + t0) * 2); const v2u xx = *(const LAS v2u*)(XB + (size_t)(bb * SEQ + t0) * 2);
                v2u o;
                o.x = pk2(bflo(xx.x) * (C[i][0] + bflo(uu.x) * sk), bfhi(xx.x) * (C[i][1] + bfhi(uu.x) * sk));
                o.y = pk2(bflo(xx.y) * (C[i][2] + bflo(uu.y) * sk), bfhi(xx.y) * (C[i][3] + bfhi(uu.y) * sk));
                *(v2u*)(yT + (size_t)c * T + bb * SEQ + t0) = o;
            }
        }
        if (!more) break;
        c = cn;
    }
}
__device__ __forceinline__ void hy_transpose_tile(Frame& F, int tile) {
    const bf16* yT = (const bf16*)(F.ws + WS_YT); bf16* mix = (bf16*)(F.ws + WS_MIX0);
    LAS unsigned* scr = (LAS unsigned*)(F.lds + F.wave * (64 * 36 * 4));
    const int lane = F.lane, ct = tile & 7, tt = tile >> 3, c0 = 64 * ct, tok0 = 64 * tt;
    const int rr = lane >> 3, ch = lane & 7;
    v4u raw[8];
#pragma unroll
    for (int i = 0; i < 8; ++i) raw[i] = __builtin_nontemporal_load((const v4u*)(yT + (size_t)(c0 + 8 * i + rr) * T + tok0 + 8 * ch));
#pragma unroll
    for (int i = 0; i < 8; ++i) {
        v4u o; o.x = __shfl_xor(raw[i].x, 8); o.y = __shfl_xor(raw[i].y, 8); o.z = __shfl_xor(raw[i].z, 8); o.w = __shfl_xor(raw[i].w, 8);
        const bool odd = rr & 1;
        const unsigned a0 = odd ? o.z : raw[i].x, a1 = odd ? o.w : raw[i].y;
        const unsigned b0 = odd ? raw[i].z : o.x, b1 = odd ? raw[i].w : o.y;
        const int cp = (8 * i + (rr & ~1)) >> 1;
        const int tb = 8 * ch + (odd ? 4 : 0);
        scr[(tb + 0) * 36 + cp] = (a0 & 0xffffu) | (b0 << 16);
        scr[(tb + 1) * 36 + cp] = (a0 >> 16) | (b0 & 0xffff0000u);
        scr[(tb + 2) * 36 + cp] = (a1 & 0xffffu) | (b1 << 16);
        scr[(tb + 3) * 36 + cp] = (a1 >> 16) | (b1 & 0xffff0000u);
    }
    LDS_WAIT(); asm volatile("" ::: "memory");
#pragma unroll
    for (int i = 0; i < 8; ++i) { const int tk = 8 * i + rr; const v4u w = *(const LAS v4u*)(scr + tk * 36 + 4 * ch);
        *(v4u*)(mix + (size_t)(tok0 + tk) * D + c0 + 8 * ch) = w; }
    LDS_WAIT(); asm volatile("" ::: "memory");
}

constexpr int AT_KSTR = 136, AT_VSTR = 144;
template <int OFF> __device__ __forceinline__ v2u ds_tr16(unsigned addr) { v2u r; asm volatile("ds_read_b64_tr_b16 %0, %1 offset:%2" : "=v"(r) : "v"(addr), "n"(OFF)); return r; }
template <int NT, int DT, int I = 0>
__device__ __forceinline__ void pv_issue(unsigned vb, unsigned vb2, v2u (&t)[NT]) {
    if constexpr (I < NT) {
        constexpr int off = (I >> 1) * 32 * AT_VSTR * 2 + (I & 1) * 16 * AT_VSTR * 2 + 32 * DT;
        if constexpr (off < 65536) t[I] = ds_tr16<off>(vb); else t[I] = ds_tr16<off - 32768>(vb2);
        pv_issue<NT, DT, I + 1>(vb, vb2, t);
    }
}
template <int N> __device__ __forceinline__ void lgkm_wait() { asm volatile("s_waitcnt lgkmcnt(%0)" :: "n"(N)); }
template <int NT, bool DIL>
__device__ __forceinline__ void attn_wave16(const LAS unsigned char* Ks, const LAS unsigned char* Vs, int k0, const bf16* qrow, const LAS float* bt, int dil, int relbase, int lbase, int L,
                                            bf16* orow, float* lse_out, int lane) {
    const int r = lane & 15, rq = lane >> 4;
    bf16x8_t Qf[4];
    {
        v4u raw[4]; float ss = 0.f;
#pragma unroll
        for (int st = 0; st < 4; ++st) { raw[st] = *(const v4u*)(qrow + 32 * st + 8 * rq);
            const float a0 = bflo(raw[st].x), a1 = bfhi(raw[st].x), a2 = bflo(raw[st].y), a3 = bfhi(raw[st].y), a4 = bflo(raw[st].z), a5 = bfhi(raw[st].z), a6 = bflo(raw[st].w), a7 = bfhi(raw[st].w);
            ss += (a0 * a0 + a1 * a1) + (a2 * a2 + a3 * a3) + (a4 * a4 + a5 * a5) + (a6 * a6 + a7 * a7); }
        ss += __shfl_xor(ss, 16); ss += __shfl_xor(ss, 32);
        const float sc = 0.08838834764831845f / sqrtf(ss * (1.f / 128.f) + EPS);
#pragma unroll
        for (int st = 0; st < 4; ++st) { v4u w;
            w.x = pk2(bflo(raw[st].x) * sc, bfhi(raw[st].x) * sc); w.y = pk2(bflo(raw[st].y) * sc, bfhi(raw[st].y) * sc);
            w.z = pk2(bflo(raw[st].z) * sc, bfhi(raw[st].z) * sc); w.w = pk2(bflo(raw[st].w) * sc, bfhi(raw[st].w) * sc);
            Qf[st] = __builtin_bit_cast(bf16x8_t, w); }
    }
    float bv[DIL ? NT : 1][4];
    if (DIL) {
#pragma unroll
        for (int kt = 0; kt < NT; ++kt)
#pragma unroll
            for (int g = 0; g < 4; ++g) bv[kt][g] = bt[relbase + 16 * kt + g + 128];
    }
    f32x4 S[NT];
    const LAS unsigned char* kb = Ks + (size_t)(k0 + r) * (AT_KSTR * 2) + 16 * rq;
    bf16x8_t Af[2][4];
#pragma unroll
    for (int st = 0; st < 4; ++st) Af[0][st] = *(const LAS bf16x8_t*)(kb + 64 * st);
#pragma unroll
    for (int kt = 0; kt < NT; ++kt) {
        if (kt + 1 < NT) {
#pragma unroll
            for (int st = 0; st < 4; ++st) Af[(kt + 1) & 1][st] = *(const LAS bf16x8_t*)(kb + (kt + 1) * 16 * (AT_KSTR * 2) + 64 * st);
        }
        f32x4 acc = (f32x4){0.f, 0.f, 0.f, 0.f};
#pragma unroll
        for (int st = 0; st < 4; ++st) acc = __builtin_amdgcn_mfma_f32_16x16x32_bf16(Af[kt & 1][st], Qf[st], acc, 0, 0, 0);
        S[kt] = acc;
        asm volatile("" ::: "memory");
    }
    float mx = -3.0e38f;
#pragma unroll
    for (int kt = 0; kt < NT; ++kt)
#pragma unroll
        for (int g = 0; g < 4; ++g) {
            float s = S[kt][g];
            if (DIL) { const int lk = lbase + 16 * kt + g; const bool ok = (lk >= 0) && (lk < L);
                s = ok ? s + bv[kt][g] : -3.0e38f; S[kt][g] = s; }
            mx = fmaxf(mx, s);
        }
    mx = fmaxf(mx, __shfl_xor(mx, 16)); mx = fmaxf(mx, __shfl_xor(mx, 32));
    float z = 0.f;
#pragma unroll
    for (int kt = 0; kt < NT; ++kt)
#pragma unroll
        for (int g = 0; g < 4; ++g) { const float p = __expf(S[kt][g] - mx); S[kt][g] = p; z += p; }
    z += __shfl_xor(z, 16); z += __shfl_xor(z, 32);
    const float iz = 1.0f / z;
    bf16x8_t Pf[NT / 2];
#pragma unroll
    for (int ks = 0; ks < NT / 2; ++ks) { v4u w; w.x = pk2(S[2 * ks][0], S[2 * ks][1]); w.y = pk2(S[2 * ks][2], S[2 * ks][3]); w.z = pk2(S[2 * ks + 1][0], S[2 * ks + 1][1]); w.w = pk2(S[2 * ks + 1][2], S[2 * ks + 1][3]);
        Pf[ks] = __builtin_bit_cast(bf16x8_t, w); }
    const unsigned vb = (unsigned)(size_t)Vs + (unsigned)(k0 + 4 * rq + (r >> 2)) * (AT_VSTR * 2) + 8 * (lane & 3), vb2 = vb + 32768;
    constexpr int WN = NT < 15 ? NT : 15;
    v2u Vt[2][NT];
    pv_issue<NT, 0>(vb, vb2, Vt[0]);
#define PV_STEP(DT) { \
        if (DT + 1 < 8) { pv_issue<NT, (DT + 1) & 7>(vb, vb2, Vt[(DT + 1) & 1]); lgkm_wait<WN>(); } else lgkm_wait<0>(); \
        _Pragma("unroll") for (int i = 0; i < NT; ++i) asm volatile("" : "+v"(Vt[DT & 1][i])); \
        f32x4 o = (f32x4){0.f, 0.f, 0.f, 0.f}; \
        _Pragma("unroll") for (int ks = 0; ks < NT / 2; ++ks) { const v2u lo = Vt[DT & 1][2 * ks], hi = Vt[DT & 1][2 * ks + 1]; \
            o = __builtin_amdgcn_mfma_f32_16x16x32_bf16(__builtin_bit_cast(bf16x8_t, ((v4u){lo.x, lo.y, hi.x, hi.y})), Pf[ks], o, 0, 0, 0); } \
        v2u ow; ow.x = pk2(o[0] * iz, o[1] * iz); ow.y = pk2(o[2] * iz, o[3] * iz); \
        *(v2u*)(orow + 16 * DT + 4 * rq) = ow; }
    PV_STEP(0) PV_STEP(1) PV_STEP(2) PV_STEP(3) PV_STEP(4) PV_STEP(5) PV_STEP(6) PV_STEP(7)
#undef PV_STEP
    if (DIL) { if (rq == 0) *lse_out = mx + logf(z); }
}
template <int NB, int BS, class RowFn>
__device__ __forceinline__ void attn_stage_k(LAS unsigned char* Ks, int nk, const float* qg, const float* kg, const bf16* kbase, RowFn rowoff, int wave, int lane) {
    const int rr = lane >> 4, cc = lane & 15;
    float gf[8];
    { const f32x4 a0 = *(const f32x4*)(qg + 8 * cc), a1 = *(const f32x4*)(qg + 8 * cc + 4), b0 = *(const f32x4*)(kg + 8 * cc), b1 = *(const f32x4*)(kg + 8 * cc + 4);
      gf[0] = a0.x * b0.x; gf[1] = a0.y * b0.y; gf[2] = a0.z * b0.z; gf[3] = a0.w * b0.w; gf[4] = a1.x * b1.x; gf[5] = a1.y * b1.y; gf[6] = a1.z * b1.z; gf[7] = a1.w * b1.w; }
#pragma unroll 1
    for (int bt = 0; bt < NB; ++bt) {
        v4u raw[BS];
#pragma unroll
        for (int i = 0; i < BS; ++i) { const int j = ((bt * BS + i) * 8 + wave) * 4 + rr; const long off = (j < nk) ? rowoff(j) : -1;
            raw[i] = *(const v4u*)(kbase + (off < 0 ? 0 : off) + 8 * cc); if (off < 0) raw[i] = (v4u){0u, 0u, 0u, 0u}; }
#pragma unroll
        for (int i = 0; i < BS; ++i) { const int j = ((bt * BS + i) * 8 + wave) * 4 + rr;
            const float k0 = bflo(raw[i].x), k1 = bfhi(raw[i].x), k2 = bflo(raw[i].y), k3 = bfhi(raw[i].y), k4 = bflo(raw[i].z), k5 = bfhi(raw[i].z), k6 = bflo(raw[i].w), k7 = bfhi(raw[i].w);
            float ss = (k0 * k0 + k1 * k1) + (k2 * k2 + k3 * k3) + (k4 * k4 + k5 * k5) + (k6 * k6 + k7 * k7);
            ss += __shfl_xor(ss, 1); ss += __shfl_xor(ss, 2); ss += __shfl_xor(ss, 4); ss += __shfl_xor(ss, 8);
            const float sc = 1.0f / sqrtf(ss * (1.f / 128.f) + EPS);
            v4u w; w.x = pk2(k0 * sc * gf[0], k1 * sc * gf[1]); w.y = pk2(k2 * sc * gf[2], k3 * sc * gf[3]); w.z = pk2(k4 * sc * gf[4], k5 * sc * gf[5]); w.w = pk2(k6 * sc * gf[6], k7 * sc * gf[7]);
            if (j < nk) *(LAS v4u*)(Ks + (size_t)j * (AT_KSTR * 2) + 16 * cc) = w; }
    }
}
template <int NB, int BS, class RowFn>
__device__ __forceinline__ void attn_stage_v(LAS unsigned char* Vs, int nk, const bf16* vbase, RowFn rowoff, int wave, int lane) {
    const int rr = lane >> 4, cc = lane & 15;
#pragma unroll 1
    for (int bt = 0; bt < NB; ++bt) {
        v4u raw[BS];
#pragma unroll
        for (int i = 0; i < BS; ++i) { const int j = ((bt * BS + i) * 8 + wave) * 4 + rr; const long off = (j < nk) ? rowoff(j) : -1;
            raw[i] = *(const v4u*)(vbase + (off < 0 ? 0 : off) + 8 * cc); if (off < 0) raw[i] = (v4u){0u, 0u, 0u, 0u}; }
#pragma unroll
        for (int i = 0; i < BS; ++i) { const int j = ((bt * BS + i) * 8 + wave) * 4 + rr; if (j < nk) *(LAS v4u*)(Vs + (size_t)j * (AT_VSTR * 2) + 16 * cc) = raw[i]; }
    }
}

constexpr int XA_OFF_V = 256 * AT_KSTR * 2;
static_assert(XA_OFF_V + 256 * AT_VSTR * 2 <= SCR_BYTES, "cross LDS");
__device__ __forceinline__ void cross_unit(Frame& F, const bf16* xq, const bf16* kv, const float* qg, const float* kg, bf16* mix, int unit) {
    int lane = (int)__builtin_amdgcn_mbcnt_hi(~0u, __builtin_amdgcn_mbcnt_lo(~0u, 0u)); asm volatile("" : "+v"(lane)); const int tid = F.wave * 64 + lane;
    const int b = unit >> 5, h = (unit >> 3) & 3, qc = unit & 7;
    LAS unsigned char* Ks = F.lds; LAS unsigned char* Vs = F.lds + XA_OFF_V;
    const bf16* kbase = kv + (size_t)(b * MEML) * 1024 + h * 128;
    __syncthreads();
    attn_stage_k<2, 4>(Ks, MEML, qg, kg, kbase, [=](int j) { return (long)j * 1024; }, F.wave, lane);
    attn_stage_v<2, 4>(Vs, MEML, kbase + 512, [=](int j) { return (long)j * 1024; }, F.wave, lane);
    __syncthreads();
#pragma unroll 1
    for (int a = F.wave; a < 16; a += NWAVES) {
        const int token = b * SEQ + qc * 256 + 16 * a + (lane & 15);
        attn_wave16<16, false>(Ks, Vs, 0, xq + (size_t)token * 512 + h * 128, nullptr, 1, 0, 0, 0, mix + (size_t)token * D + 512 + h * 128, nullptr, lane);
    }
}
constexpr int DA_NK = 272, DA_OFF_V = DA_NK * AT_KSTR * 2, DA_OFF_BT = DA_OFF_V + DA_NK * AT_VSTR * 2;
static_assert(DA_OFF_BT + 320 * 4 <= SCR_BYTES, "dilated LDS");
__device__ __forceinline__ void dil_unit(Frame& F, const Args& a, int unit) {
    const int bh = unit / 48, sub = unit % 48, b = bh >> 2, h = bh & 3, g = sub >> 4, w16 = sub & 15;
    const int dil = (g == 0) ? 1 : (g == 1 ? 4 : 16), L = SEQ / dil, nch = L / 128;
    const int r = w16 / nch, n128 = w16 % nch;
    int lane = (int)__builtin_amdgcn_mbcnt_hi(~0u, __builtin_amdgcn_mbcnt_lo(~0u, 0u)); asm volatile("" : "+v"(lane)); const int tid = F.wave * 64 + lane;
    const bf16* qkv = (const bf16*)(F.ws + WS_QKV1);
    float* lse = (float*)(F.ws + WS_LSE);
    LAS unsigned char* Ks = F.lds; LAS unsigned char* Vs = F.lds + DA_OFF_V; LAS float* bt = (LAS float*)(F.lds + DA_OFF_BT);
    const int lk0 = 128 * n128 - 64;
    const bf16* base = qkv + (size_t)(b * SEQ + r) * NQKV + g * 512 + h * 128;
    const size_t lstep = (size_t)dil * NQKV;
    __syncthreads();
    if (tid < 320) { const int rel = tid - 128; bt[tid] = (rel >= -64 && rel <= 64) ? a.in[I_RELB][rel_bucket_dev(rel * dil) * 12 + g * 4 + h] : -3.0e38f; }
    attn_stage_k<3, 3>(Ks, DA_NK, a.in[I_ATQN], a.in[I_ATKN], base + ATW, [=](int j) { const int lk = lk0 + j; return (lk >= 0 && lk < L) ? (long)lk * (long)lstep : -1L; }, F.wave, lane);
    attn_stage_v<3, 3>(Vs, DA_NK, base + 2 * ATW, [=](int j) { const int lk = lk0 + j; return (lk >= 0 && lk < L) ? (long)lk * (long)lstep : -1L; }, F.wave, lane);
    __syncthreads();
    {
        const int aq = F.wave, i = 16 * aq + (lane & 15), lq = 128 * n128 + i, token = b * SEQ + lq * dil + r, k0 = 16 * aq, rq = lane >> 4;
        attn_wave16<10, true>(Ks, Vs, k0, base + (size_t)lq * lstep, bt, dil, k0 + 4 * rq - 64 - i, lk0 + k0 + 4 * rq, L,
                              (g == 0) ? (bf16*)(F.ws + WS_MIX1) + (size_t)token * D + h * 128 : (bf16*)(F.ws + WS_OG12) + ((size_t)(g - 1) * T + token) * 512 + h * 128,
                              lse + ((size_t)g * T + token) * 4 + h, lane);
    }
}
__device__ __forceinline__ void combine_phase(Frame& F, const Args& a) {
    moe_layout(F);
    const int gw = F.bid * NWAVES + F.wave, NGW = F.G * NWAVES, lane = F.lane;
    const int* toke = (const int*)(F.ws + WS_TOKE); const int* tokr = (const int*)(F.ws + WS_TOKR); const float* tokg = (const float*)(F.ws + WS_TOKG);
    const bf16* y = (const bf16*)(F.ws + WS_XS); const bf16* y2 = (const bf16*)(F.ws + WS_Y2);
    for (int token = gw; token < T; token += NGW) {
        const int e0 = toke[token * 2], e1 = toke[token * 2 + 1];
        const int s0 = ml_ps(F, e0) + tokr[token * 2], s1 = ml_ps(F, e1) + tokr[token * 2 + 1];
        const float g0 = tokg[token * 2], g1 = tokg[token * 2 + 1];
        f32x4* xo = (f32x4*)(a.out + (size_t)token * D); const v2u* xi = (const v2u*)((const bf16*)a.out + (size_t)token * 2048 + 1024);
        const v2u* y0 = (const v2u*)(y + (size_t)s0 * D); const v2u* y1 = (const v2u*)(y + (size_t)s1 * D);
        v2u xw[4], p0[4], p1[4];
#pragma unroll
        for (int j = 0; j < 4; ++j) { const int q = lane + 64 * j; xw[j] = __builtin_nontemporal_load(xi + q); p0[j] = __builtin_nontemporal_load(y0 + q); p1[j] = __builtin_nontemporal_load(y1 + q); }
        f32x4 r[4];
#pragma unroll
        for (int j = 0; j < 4; ++j) {
            const int q = lane + 64 * j;
            f32x4 x = (f32x4){bflo(xw[j].x), bfhi(xw[j].x), bflo(xw[j].y), bfhi(xw[j].y)};
            f32x4 a0 = (f32x4){bflo(p0[j].x), bfhi(p0[j].x), bflo(p0[j].y), bfhi(p0[j].y)}, a1 = (f32x4){bflo(p1[j].x), bfhi(p1[j].x), bflo(p1[j].y), bfhi(p1[j].y)};
            if (s0 >= 2 * T) { const v2u t = ((const v2u*)(y2 + (size_t)(s0 - 2 * T) * D))[q]; a0 = a0 + (f32x4){bflo(t.x), bfhi(t.x), bflo(t.y), bfhi(t.y)}; }
            if (s1 >= 2 * T) { const v2u t = ((const v2u*)(y2 + (size_t)(s1 - 2 * T) * D))[q]; a1 = a1 + (f32x4){bflo(t.x), bfhi(t.x), bflo(t.y), bfhi(t.y)}; }
            r[j] = x + g0 * a0 + g1 * a1;
        }
        asm volatile("s_waitcnt vmcnt(0)" ::: "memory");
#pragma unroll
        for (int j = 0; j < 4; ++j) __builtin_nontemporal_store(r[j], xo + lane + 64 * j);
    }
}

constexpr int NPHASE = 15;
__global__ void __launch_bounds__(NWAVES * 64, 2) mega_fwd(Args args) {
    extern __shared__ __attribute__((aligned(16))) unsigned char lds_raw[];
    Frame F;
    F.lds = (LAS unsigned char*)lds_raw; F.ws = args.ws;
    F.wave = __builtin_amdgcn_readfirstlane((int)threadIdx.x >> 6); F.G = gridDim.x; F.bid = blockIdx.x;
#define PH_BEGIN() do { int l_ = (int)__builtin_amdgcn_mbcnt_hi(~0u, __builtin_amdgcn_mbcnt_lo(~0u, 0u)); asm volatile("" : "+v"(l_)); F.lane = l_; F.tid = F.wave * 64 + l_; } while (0)
    PH_BEGIN();
    unsigned char* ws = args.ws;
    volatile LAS unsigned* MISC = (volatile LAS unsigned*)(F.lds + MISC_OFF);
    for (int u = F.tid; u < (LDS_BYTES - MISC_OFF) / 4; u += NWAVES * 64) MISC[u] = 0u;
    __syncthreads();
    const int lo = args.ph_lo, hi = args.ph_hi;
    const bool use_bar = (hi - lo) > 1;
    XcdBarrier bar; bar.bar = (unsigned*)(ws + WS_CTL) + CW_BAR + args.bslot * XCD_BAR_WORDS; bar.x = 0; bar.st = nullptr;
    if (use_bar) bar = xcd_barrier_post((unsigned*)(ws + WS_CTL) + CW_BAR + args.bslot * XCD_BAR_WORDS, MISC + 8, F.tid);
#define IN(k) (lo <= (k) && (k) < hi)
#define SEAM(k) do { if (IN(k) && IN((k) + 1)) { PH_BEGIN(); xcd_barrier(bar, F.tid); } } while (0)
    const int gw = F.bid * NWAVES + F.wave, NGW = F.G * NWAVES;
    LAS unsigned char* ring = F.lds;

    if (IN(0)) { PH_BEGIN(); p0_prologue(F, args); }
    SEAM(0);
    if (IN(1)) { PH_BEGIN();
        {   pg8::Gemm g{(const bf16*)(ws + WS_WIN0), (const bf16*)(ws + WS_XB), D, D, D, 0};
            pg8::StaticOrder S; S.init(ATW / 256, T / 256, F.G, F.bid);
            EpiB<3> E{(bf16*)(ws + WS_ZT), T, (const float*)(ws + WS_RSTD0), 1 << 30, nullptr, 0, nullptr, 1.0f};
            pg8::gemm_phase<EpiB<3>, pg8::StaticOrder, true>(ring, g, S, E, F.wave); }
        {   pg8::Gemm g{(const bf16*)(ws + WS_XB), (const bf16*)(ws + WS_WIN0) + (size_t)ATW * D, D, D, D, 0};
            pg8::StaticOrder S; S.init(T / 256, 2, F.G, (F.bid + 128) % F.G);
            EpiB<1> E{(bf16*)(ws + WS_XQ0), 512, (const float*)(ws + WS_RSTD0), 1 << 30, nullptr, 0, nullptr, 1.0f};
            pg8::gemm_phase<EpiB<1>, pg8::StaticOrder, true>(ring, g, S, E, F.wave); }
        {   pg8::Gemm g{(const bf16*)(ws + WS_MN), (const bf16*)(ws + WS_WKV), D, D, D, (size_t)D * D * 2};
            pg8::MoeOrder S; S.init(2 * TM / 256, 4, F.G, F.bid); S.t0 = TM / 256; S.t1 = S.t2 = S.t3 = S.t4 = S.t5 = S.t6 = 1 << 30; S.lay = nullptr; S.list = nullptr;
            EpiB<0> E{(bf16*)(ws + WS_KV), D, nullptr, 1 << 30, nullptr, 0, nullptr, 1.0f};
            pg8::gemm_phase<EpiB<0>, pg8::MoeOrder, true>(ring, g, S, E, F.wave); }
        if (F.G == 256 && F.bid >= 64) { PH_BEGIN(); moe_convert(F, args, 0, MOE_P1_HI, (F.bid - 64) * NWAVES + F.wave, 192 * NWAVES); }
    }
    SEAM(1);
    if (IN(2)) { PH_BEGIN();
        hyena_units(F, args);
        for (int u = F.bid; u < 256; u += F.G)
            cross_unit(F, (const bf16*)(ws + WS_XQ0), (const bf16*)(ws + WS_KV), args.in[I_XQN], args.in[I_XKN], (bf16*)(ws + WS_MIX0), u);
    }
    SEAM(2);
    if (IN(3)) { PH_BEGIN(); for (int t = gw; t < 2048; t += NGW) hy_transpose_tile(F, t); }
    SEAM(3);
    if (IN(4)) { PH_BEGIN();
        pg8::Gemm g{(const bf16*)(ws + WS_MIX0), (const bf16*)(ws + WS_WO), D, D, D, 0};
        pg8::StaticOrder S; S.init(T / 256, 4, F.G, F.bid);
        EpiRes<false, true> E{nullptr, (const bf16*)(ws + WS_XB), D, (bf16*)(ws + WS_XB), D, (float*)(ws + WS_SSQ16)};
        pg8::gemm_phase<EpiRes<false, true>, pg8::StaticOrder, true>(ring, g, S, E, F.wave);
    }
    SEAM(4);
    if (IN(5)) { PH_BEGIN();
        pg8::Gemm g{(const bf16*)(ws + WS_XB), (const bf16*)(ws + WS_WGU0), D, D, D, 0};
        pg8::StaticOrder S; S.init(T / 256, NGU / 256, F.G, F.bid);
        fill_rstd_table(F.lds, S, (const float*)(ws + WS_SSQ16), F.tid);
        EpiSwiglu<4> E{(bf16*)(ws + WS_HID0), FF, nullptr, (const LAS float*)(F.lds + RSL_OFF), 1.0f};
        pg8::gemm_phase<EpiSwiglu<4>, pg8::StaticOrder, true>(ring, g, S, E, F.wave);
        if (F.G == 256 && F.bid >= 128) { PH_BEGIN(); moe_convert(F, args, MOE_P1_HI, MOE_P5_HI, (F.bid - 128) * NWAVES + F.wave, 128 * NWAVES); }
    }
    SEAM(5);
    if (IN(6)) { PH_BEGIN();
        pg8::Gemm g{(const bf16*)(ws + WS_HID0), (const bf16*)(ws + WS_WD0), FF, FF, FF, 0};
        pg8::StaticOrder S; S.init(T / 256, 4, F.G, F.bid);
        EpiRes<false, true> E{nullptr, (const bf16*)(ws + WS_XB), D, (bf16*)(ws + WS_XB), D, (float*)(ws + WS_SSQ16)};
        pg8::gemm_phase<EpiRes<false, true>, pg8::StaticOrder, true>(ring, g, S, E, F.wave);
    }
    SEAM(6);
    if (IN(7)) { PH_BEGIN();
        pg8::Gemm g{(const bf16*)(ws + WS_XB), (const bf16*)(ws + WS_WIN1), D, D, D, 0};
        pg8::StaticOrder S; S.init(T / 256, NQ1 / 256, F.G, F.bid);
        fill_rstd_table(F.lds, S, (const float*)(ws + WS_SSQ16), F.tid);
        EpiB<4> E{(bf16*)(ws + WS_QKV1), NQKV, nullptr, NQKV / 256, (bf16*)(ws + WS_XQ1), 512, (const LAS float*)(F.lds + RSL_OFF), 1.0f};
        pg8::gemm_phase<EpiB<4>, pg8::StaticOrder, true>(ring, g, S, E, F.wave);
    }
    SEAM(7);
    if (IN(8)) { PH_BEGIN();
        for (int u = F.bid; u < NB * 4 * 48; u += F.G) dil_unit(F, args, u);
        for (int u = F.bid; u < 256; u += F.G)
            cross_unit(F, (const bf16*)(ws + WS_XQ1), (const bf16*)(ws + WS_KV) + (size_t)TM * D, args.in[I_XQN] + 128, args.in[I_XKN] + 128, (bf16*)(ws + WS_MIX1), u);
    }
    SEAM(8);
    if (IN(9)) { PH_BEGIN(); for (int t = gw; t < T; t += NGW) merge_token(F, t); }
    SEAM(9);
    if (IN(10)) { PH_BEGIN();
        pg8::Gemm g{(const bf16*)(ws + WS_MIX1), (const bf16*)(ws + WS_WO) + (size_t)D * D, D, D, D, 0};
        pg8::StaticOrder S; S.init(T / 256, 4, F.G, F.bid);
        EpiRes<false, false> E{nullptr, (const bf16*)(ws + WS_XB), D, (bf16*)args.out + 1024, 2048, nullptr};
        pg8::gemm_phase<EpiRes<false, false>, pg8::StaticOrder, true>(ring, g, S, E, F.wave);
    }
    SEAM(10);
    if (IN(11)) { PH_BEGIN(); for (int blk = F.bid; blk < T / 64; blk += F.G) route_block(F, args, blk); }
    SEAM(11);
    if (IN(12)) { PH_BEGIN();
        moe_layout(F);
        pg8::Gemm g{(const bf16*)(ws + WS_XB3), (const bf16*)(ws + WS_WGU1), D / 2, D / 2, D / 2, (size_t)NGU * D};
        pg8::MoeOrder S; S.init(ml_total(F) / 256, NGU / 256, F.G, F.bid); S.lay = (const volatile LAS int*)(F.lds + MISC_OFF); S.list = (const int*)(ws + WS_LIST);
        S.t0 = ml_ps(F, 1) / 256; S.t1 = ml_ps(F, 2) / 256; S.t2 = ml_ps(F, 3) / 256; S.t3 = ml_ps(F, 4) / 256; S.t4 = ml_ps(F, 5) / 256; S.t5 = ml_ps(F, 6) / 256; S.t6 = ml_ps(F, 7) / 256;
        EpiSwiglu<5, true> E{(bf16*)(ws + WS_HID1), FF, nullptr, nullptr, 1.0f / MOE_WGU_SCALE};
        pg8::gemm_phase<EpiSwiglu<5, true>, pg8::MoeOrder, true, true, true>(ring, g, S, E, F.wave);
    }
    SEAM(12);
    if (IN(13)) { PH_BEGIN();
        moe_layout(F);
        const int nMt = ml_total(F) / 256;
        const int q1 = ml_ps(F, 1) / 256, q2 = ml_ps(F, 2) / 256, q3 = ml_ps(F, 3) / 256, q4 = ml_ps(F, 4) / 256, q5 = ml_ps(F, 5) / 256, q6 = ml_ps(F, 6) / 256, q7 = ml_ps(F, 7) / 256;
        {   pg8::Gemm g{(const bf16*)(ws + WS_HID1), (const bf16*)(ws + WS_WD1), FF / 2, FF / 2, FF / 2, (size_t)D * FF};
            pg8::MoeOrder S; S.init(nMt < 128 ? nMt : 128, 4, F.G, F.bid); S.lay = nullptr; S.list = nullptr;
            S.t0 = q1; S.t1 = q2; S.t2 = q3; S.t3 = q4; S.t4 = q5; S.t5 = q6; S.t6 = q7;
            EpiB<5> E{(bf16*)(ws + WS_XS), D, nullptr, 1 << 30, nullptr, 0, nullptr, 1.0f / MOE_WD_SCALE};
            pg8::gemm_phase<EpiB<5>, pg8::MoeOrder, true, false, true>(ring, g, S, E, F.wave); }
        if (nMt > 128) {
            const int half = F.G / 2; const bool second = F.bid >= half;
            pg8::Gemm g{(const bf16*)(ws + WS_HID1), (const bf16*)(ws + WS_WD1), FF / 2, FF / 2, second ? 640 : 768, (size_t)D * FF};
            pg8::MoeTailOrder2 S; S.pm0 = 128; S.ntail = nMt - 128; S.nN = 4; S.G = second ? F.G - half : half; S.c = second ? F.bid - half : F.bid; S.koff = second ? 12 * 128 : 0;
            S.t0 = q1; S.t1 = q2; S.t2 = q3; S.t3 = q4; S.t4 = q5; S.t5 = q6; S.t6 = q7;
            EpiB<5> E{(bf16*)(ws + WS_XS), D, nullptr, 1 << 30, (bf16*)(ws + WS_Y2) - (size_t)2 * T * D, D, nullptr, 1.0f / MOE_WD_SCALE};
            pg8::gemm_phase<EpiB<5>, pg8::MoeTailOrder2, true, false, true>(ring, g, S, E, F.wave); }
    }
    SEAM(13);
    if (IN(14)) { PH_BEGIN(); combine_phase(F, args); }
#undef IN
#undef SEAM
}

#ifndef MK_ONE_LAUNCH
#define MK_ONE_LAUNCH 1
#endif
extern "C" void kernel_launch(void* const* d_in, const int* in_sizes, int n_in, void* d_out, int out_size, void* d_ws, size_t ws_size, hipStream_t stream) {
    static int grid = 0;
    if (grid == 0) {
        if (n_in != 30 || in_sizes[0] != T * D || out_size != T * D || ws_size < WS_END) {
            fprintf(stderr, "kernel_launch: unexpected problem (n_in %d, in0 %d, out %d, ws %zu, need %zu); nothing launched\n", n_in, n_in > 0 ? in_sizes[0] : -1, out_size, ws_size, (size_t)WS_END); grid = -1; return; }
        int dev = 0, cus = 0, per_cu = 0;
        if (hipGetDevice(&dev) != hipSuccess || hipDeviceGetAttribute(&cus, hipDeviceAttributeMultiprocessorCount, dev) != hipSuccess) { grid = -1; return; }
        if (hipFuncSetAttribute((const void*)mega_fwd, hipFuncAttributeMaxDynamicSharedMemorySize, LDS_BYTES) != hipSuccess) { fprintf(stderr, "kernel_launch: hipFuncSetAttribute failed\n"); grid = -1; return; }
        if (hipOccupancyMaxActiveBlocksPerMultiprocessor(&per_cu, (const void*)mega_fwd, NWAVES * 64, LDS_BYTES) != hipSuccess || per_cu < 1)
            fprintf(stderr, "kernel_launch: note: occupancy query reports %d workgroups per CU\n", per_cu);
        (void)hipGetLastError();
        grid = cus;
    }
    if (grid < 0) return;
    if (hipMemsetAsync((char*)d_ws + WS_CTL, 0, CTL_ZERO_BYTES, stream) != hipSuccess) return;
    Args a{};
    for (int i = 0; i < 30; ++i) a.in[i] = (const float*)d_in[i];
    a.out = (float*)d_out; a.ws = (unsigned char*)d_ws;
#if defined(PROBE_PHASE)
    a.ph_lo = 0; a.ph_hi = PROBE_PHASE + 1; a.bslot = 0;
    hipLaunchKernelGGL(mega_fwd, dim3(grid), dim3(NWAVES * 64), LDS_BYTES, stream, a);
    a.ph_lo = PROBE_PHASE; a.ph_hi = NPHASE; a.bslot = 1;
    hipLaunchKernelGGL(mega_fwd, dim3(grid), dim3(NWAVES * 64), LDS_BYTES, stream, a);
#elif MK_ONE_LAUNCH
    a.ph_lo = 0; a.ph_hi = NPHASE; a.bslot = 0;
    hipLaunchKernelGGL(mega_fwd, dim3(grid), dim3(NWAVES * 64), LDS_BYTES, stream, a);
#else
    for (int p = 0; p < NPHASE; ++p) { a.ph_lo = p; a.ph_hi = p + 1; a.bslot = 0; hipLaunchKernelGGL(mega_fwd, dim3(grid), dim3(NWAVES * 64), LDS_BYTES, stream, a); }
#endif
}
```

```cpp
#include <hip/hip_runtime.h>
#include <cstdio>
#include <cstdint>

namespace pg8 {
#define PG8_LAS __attribute__((address_space(3)))
typedef unsigned short bf16_t;
typedef short bf16x8 __attribute__((ext_vector_type(8)));
typedef float f32x4 __attribute__((ext_vector_type(4)));
typedef unsigned u32x4 __attribute__((ext_vector_type(4)));
constexpr int BM = 256, BK = 64, HALF = 128, HTB = HALF * BK * 2  , STAGE_BYTES = 8 * HTB, NXCD = 8, WGM = 8;

__host__ __device__ __forceinline__ int lds_byte(int r, int c) { const int st = (r >> 4) * 2 + (c >> 5), rr = r & 15, cc = c & 31, ob = rr * 64 + cc * 2; return st * 1024 + (ob ^ (((ob >> 9) & 1) << 5)); }
__host__ __device__ __forceinline__ void stage_rc(int b, int& R, int& C) { const int st = b / 1024, sb = b % 1024, swz = sb ^ (((sb >> 9) & 1) << 5); R = (st >> 1) * 16 + swz / 64; C = (st & 1) * 32 + (swz % 64) / 2; }
__host__ __device__ __forceinline__ int perm32(int rho) { const int n = rho >> 4, i = rho & 15; return 8 * (i >> 2) + 4 * n + (i & 3); }

struct Unit { int pm, pn, e, koff, idx; };
struct Gemm { const bf16_t* A; const bf16_t* Bt; int lda, ldb, K; size_t estride; };

struct StaticOrder {
    int nM, nN, nwg, G, c;
    __device__ __forceinline__ int gather_row(const Unit&, int slot) const { return slot; }
    __host__ __device__ void init(int nM_, int nN_, int G_, int c_) { nM = nM_; nN = nN_; nwg = nM * nN; G = G_; c = c_; }
    __host__ __device__ bool next(int i, Unit& u) const {
        const long L = (long)i * G + c; if (L >= nwg) return false;
        int wgid = (int)L; { const int q = nwg / NXCD, r = nwg % NXCD, xcd = wgid % NXCD, off = wgid / NXCD; wgid = (xcd < r ? xcd * (q + 1) : r * (q + 1) + (xcd - r) * q) + off; }
        const int nig = WGM * nN, gid = wgid / nig, fm = gid * WGM, gsz = (nM - fm) < WGM ? (nM - fm) : WGM;
        u.pm = fm + ((wgid % nig) % gsz); u.pn = (wgid % nig) / gsz; u.e = 0; u.koff = 0; return true;
    }
};
struct MoeOrder : StaticOrder {
    int t0, t1, t2, t3, t4, t5, t6;
    const volatile PG8_LAS int* lay;
    const int* list;
    __device__ __forceinline__ int gather_row(const Unit& u, int slot) const { const int rank = slot - lay[40 + u.e]; return rank < lay[32 + u.e] ? list[(size_t)u.e * 16384 + rank] : 0; }
    __host__ __device__ bool next(int i, Unit& u) const {
        if (!StaticOrder::next(i, u)) return false;
        const int p = u.pm; u.e = (p >= t0) + (p >= t1) + (p >= t2) + (p >= t3) + (p >= t4) + (p >= t5) + (p >= t6); return true;
    }
};

struct MoeTailOrder {
    int pm0, ntail, nN, G, c, khalf; int t0, t1, t2, t3, t4, t5, t6;
    __device__ __forceinline__ int gather_row(const Unit&, int slot) const { return slot; }
    __device__ __forceinline__ bool next(int i, Unit& u) const {
        const int L = i * G + c; if (L >= ntail * nN * 2) return false;
        const int kh = L & 1, q = L >> 1; u.pn = q % nN; u.pm = pm0 + q / nN; u.koff = kh * khalf;
        const int p = u.pm; u.e = (p >= t0) + (p >= t1) + (p >= t2) + (p >= t3) + (p >= t4) + (p >= t5) + (p >= t6); return true;
    }
};
struct MoeTailOrder2 {
    int pm0, ntail, nN, G, c, koff; int t0, t1, t2, t3, t4, t5, t6;
    __device__ __forceinline__ int gather_row(const Unit&, int slot) const { return slot; }
    __device__ __forceinline__ bool next(int i, Unit& u) const {
        const int L = i * G + c; if (L >= ntail * nN) return false;
        u.pn = L % nN; u.pm = pm0 + L / nN; u.koff = koff;
        const int p = u.pm; u.e = (p >= t0) + (p >= t1) + (p >= t2) + (p >= t3) + (p >= t4) + (p >= t5) + (p >= t6); return true;
    }
};
__device__ __forceinline__ unsigned cvt_pk_bf16(float lo, float hi) { unsigned r; asm volatile("v_cvt_pk_bf16_f32 %0, %1, %2" : "=v"(r) : "v"(lo), "v"(hi)); return r; }

typedef int v8i __attribute__((ext_vector_type(8)));
typedef int v4i __attribute__((ext_vector_type(4)));
template <class Epi, class Sched, bool ALIGN_EPI, bool GATHER = false, bool FP8 = false>
__device__ __forceinline__ void gemm_phase(PG8_LAS unsigned char* lds, const Gemm g, const Sched& S, const Epi& E, const int wid) {
    int lane = (int)__builtin_amdgcn_mbcnt_hi(~0u, __builtin_amdgcn_mbcnt_lo(~0u, 0u)); asm volatile("" : "+v"(lane));
    const int tid = wid * 64 + lane, wr = wid >> 2, wc = wid & 3, fr = lane & 15, fq = lane >> 4;
    const int K = g.K, nt = K / BK;
    unsigned cvo[4], nvo[4], voffB[2]; int rowA[2], colA[2];
#pragma unroll
    for (int i = 0; i < 2; ++i) { int R, C; stage_rc(tid * 16 + i * 8192, R, C); const int Rb = (R & ~31) + perm32(R & 31); rowA[i] = R; colA[i] = C;
        voffB[i] = (unsigned)(Rb * g.ldb + C) * 2u; }
    const size_t kstep = (size_t)(BK * 2);
    const size_t hstepB = (size_t)HALF * g.ldb * 2;
    const size_t tstepA = GATHER ? (size_t)0 : (size_t)2 * HALF * g.lda * 2, tstepB = 2 * hstepB;
#define PG8_ROWOFFS(vo, u) do { _Pragma("unroll") for (int _h = 0; _h < 2; ++_h) _Pragma("unroll") for (int _i = 0; _i < 2; ++_i) { \
        const int _r = _h * HALF + rowA[_i]; const unsigned _row = GATHER ? (unsigned)S.gather_row(u, (u).pm * BM + _r) : (unsigned)_r; \
        (vo)[2 * _h + _i] = (_row * (unsigned)g.lda + (unsigned)colA[_i]) * 2u; } } while (0)
    const unsigned ldsw = (unsigned)wid * 1024u;
    const int aoff = lds_byte(wr * 64 + fr, fq * 8), boff = lds_byte(wc * 32 + fr, fq * 8);
#define PG8_SA(b, h) (((b) * 2 + (h)) * HTB)
#define PG8_SB(b, h) ((4 + (b) * 2 + (h)) * HTB)
#define PG8_STAGE(bufoff, gbase, voff) do { _Pragma("unroll") for (int _i = 0; _i < 2; ++_i) \
        __builtin_amdgcn_global_load_lds((const unsigned*)((const char*)(gbase) + (voff)[_i]), (PG8_LAS unsigned*)(lds + (bufoff) + ldsw + _i * 8192), 16, 0, 0); } while (0)
#define PG8_STAGEA(bufoff, gbase, vo, h) do { _Pragma("unroll") for (int _i = 0; _i < 2; ++_i) \
        __builtin_amdgcn_global_load_lds((const unsigned*)((const char*)(gbase) + (vo)[2 * (h) + _i]), (PG8_LAS unsigned*)(lds + (bufoff) + ldsw + _i * 8192), 16, 0, 0); } while (0)
#define PG8_LDA(dst, b, h) do { _Pragma("unroll") for (int m = 0; m < 4; ++m) dst[m] = __builtin_shufflevector(*(const PG8_LAS v4i*)(lds + PG8_SA(b, h) + aoff + m * 2048), *(const PG8_LAS v4i*)(lds + PG8_SA(b, h) + aoff + m * 2048 + 1024), 0, 1, 2, 3, 4, 5, 6, 7); } while (0)
#define PG8_LDB(dst, b, h) do { _Pragma("unroll") for (int n = 0; n < 2; ++n) dst[n] = __builtin_shufflevector(*(const PG8_LAS v4i*)(lds + PG8_SB(b, h) + boff + n * 2048), *(const PG8_LAS v4i*)(lds + PG8_SB(b, h) + boff + n * 2048 + 1024), 0, 1, 2, 3, 4, 5, 6, 7); } while (0)
#define PG8_HALF(x, k) __builtin_bit_cast(bf16x8, __builtin_shufflevector(x, x, 4 * (k), 4 * (k) + 1, 4 * (k) + 2, 4 * (k) + 3))
#define PG8_MMA(ai, bj, At, Bt) do { if constexpr (FP8) __builtin_amdgcn_sched_barrier(0); __builtin_amdgcn_s_setprio(1); _Pragma("unroll") for (int m = 0; m < 4; ++m) _Pragma("unroll") for (int n = 0; n < 2; ++n) { \
        if constexpr (FP8) acc[ai][bj][m][n] = __builtin_amdgcn_mfma_scale_f32_16x16x128_f8f6f4(Bt[n], At[m], acc[ai][bj][m][n], 0, 0, 0, 0x7f7f7f7f, 0, 0x7f7f7f7f); \
        else { acc[ai][bj][m][n] = __builtin_amdgcn_mfma_f32_16x16x32_bf16(PG8_HALF(Bt[n], 0), PG8_HALF(At[m], 0), acc[ai][bj][m][n], 0, 0, 0); \
               acc[ai][bj][m][n] = __builtin_amdgcn_mfma_f32_16x16x32_bf16(PG8_HALF(Bt[n], 1), PG8_HALF(At[m], 1), acc[ai][bj][m][n], 0, 0, 0); } } \
        if constexpr (FP8) { _Pragma("unroll") for (int m = 0; m < 4; ++m) _Pragma("unroll") for (int n = 0; n < 2; ++n) asm volatile("" : "+v"(acc[ai][bj][m][n])); }   \
        __builtin_amdgcn_s_setprio(0); if constexpr (FP8) __builtin_amdgcn_sched_barrier(0); } while (0)
#define PG8_WAIT_V(n) asm volatile("s_waitcnt vmcnt(" #n ")" ::: "memory")
#define PG8_WAIT_L(n) asm volatile("s_waitcnt lgkmcnt(" #n ")" ::: "memory")
#define PG8_BAR __builtin_amdgcn_s_barrier()
#define PG8_SCHED __builtin_amdgcn_sched_barrier(0)
    Unit cur, nxt; int ui = 0;
    if (!S.next(0, cur)) return;
    cur.idx = 0;
    f32x4 acc[2][2][4][2];
#pragma unroll
    for (int a = 0; a < 2; ++a)
#pragma unroll
        for (int b = 0; b < 2; ++b)
#pragma unroll
            for (int m = 0; m < 4; ++m)
#pragma unroll
                for (int n = 0; n < 2; ++n) acc[a][b][m][n] = (f32x4){0.f, 0.f, 0.f, 0.f};
    v8i At[4], B0[2], B1[2];
    const char* cA = (const char*)g.A + (size_t)cur.pm * tstepA + cur.koff; const char* cB = (const char*)g.Bt + (size_t)cur.e * g.estride + (size_t)cur.pn * tstepB + cur.koff;
    PG8_ROWOFFS(cvo, cur);
#pragma unroll
    for (int i = 0; i < 4; ++i) nvo[i] = cvo[i];
    PG8_STAGE(PG8_SB(0, 0), cB, voffB); PG8_STAGE(PG8_SB(0, 1), cB + hstepB, voffB); PG8_STAGEA(PG8_SA(0, 0), cA, cvo, 0); PG8_STAGEA(PG8_SA(0, 1), cA, cvo, 1);
    if (wr == 1) PG8_BAR;
    PG8_WAIT_V(2); PG8_BAR;
    PG8_STAGE(PG8_SB(1, 0), cB + kstep, voffB); PG8_STAGEA(PG8_SA(1, 0), cA + kstep, cvo, 0); PG8_STAGE(PG8_SB(1, 1), cB + hstepB + kstep, voffB);
    PG8_WAIT_V(6); PG8_BAR;
    for (;;) {
        const bool has_next = S.next(ui + 1, nxt); nxt.idx = ui + 1;
        const char* nA = has_next ? (const char*)g.A + (size_t)nxt.pm * tstepA + nxt.koff : cA;
        const char* nB = has_next ? (const char*)g.Bt + (size_t)nxt.e * g.estride + (size_t)nxt.pn * tstepB + nxt.koff : cB;
        if constexpr (GATHER) { if (has_next) PG8_ROWOFFS(nvo, nxt); }
        for (int t = 0; t < nt; t += 2) {
            const bool last = (t == nt - 2);
            const char* a1 = cA + (size_t)(t + 1) * kstep;
            const char* a2 = last ? nA : cA + (size_t)(t + 2) * kstep; const char* b2 = last ? nB : cB + (size_t)(t + 2) * kstep;
            const char* a3 = a2 + kstep; const char* b3 = b2 + kstep;
            unsigned vo2[4];
#pragma unroll
            for (int i = 0; i < 4; ++i) vo2[i] = (GATHER && last) ? nvo[i] : cvo[i];
            PG8_LDB(B0, 0, 0); PG8_LDB(B1, 0, 1); PG8_SCHED; PG8_LDA(At, 0, 0); PG8_STAGEA(PG8_SA(1, 1), a1, cvo, 1);
            PG8_WAIT_V(8); PG8_WAIT_L(0); PG8_BAR; PG8_MMA(0, 0, At, B0); PG8_MMA(0, 1, At, B1); PG8_BAR; PG8_SCHED;
            PG8_LDA(At, 0, 1); PG8_STAGE(PG8_SB(0, 0), b2, voffB); PG8_STAGE(PG8_SB(0, 1), b2 + hstepB, voffB); PG8_STAGEA(PG8_SA(0, 0), a2, vo2, 0);
            PG8_WAIT_V(8); PG8_WAIT_L(0); PG8_BAR; PG8_MMA(1, 0, At, B0); PG8_MMA(1, 1, At, B1); PG8_BAR; PG8_SCHED;
            PG8_LDB(B0, 1, 0); PG8_LDB(B1, 1, 1); PG8_SCHED; PG8_LDA(At, 1, 0); PG8_STAGEA(PG8_SA(0, 1), a2, vo2, 1);
            PG8_WAIT_V(8); PG8_WAIT_L(0); PG8_BAR; PG8_MMA(0, 0, At, B0); PG8_MMA(0, 1, At, B1); PG8_BAR; PG8_SCHED;
            PG8_LDA(At, 1, 1); PG8_STAGE(PG8_SB(1, 0), b3, voffB); PG8_STAGE(PG8_SB(1, 1), b3 + hstepB, voffB); PG8_STAGEA(PG8_SA(1, 0), a3, vo2, 0);
            PG8_WAIT_V(8); PG8_WAIT_L(0); PG8_BAR; PG8_MMA(1, 0, At, B0); PG8_MMA(1, 1, At, B1); PG8_BAR; PG8_SCHED;
        }
        if constexpr (ALIGN_EPI) { if (wr == 0) PG8_BAR; }
        E(acc, cur, wr, wc, fr, fq);
        if (!has_next) break;
#pragma unroll
        for (int a = 0; a < 2; ++a)
#pragma unroll
            for (int b = 0; b < 2; ++b)
#pragma unroll
                for (int m = 0; m < 4; ++m)
#pragma unroll
                    for (int n = 0; n < 2; ++n) acc[a][b][m][n] = (f32x4){0.f, 0.f, 0.f, 0.f};
        cur = nxt; cA = nA; cB = nB; ++ui;
        if constexpr (GATHER) {
#pragma unroll
            for (int i = 0; i < 4; ++i) cvo[i] = nvo[i]; }
        if constexpr (ALIGN_EPI) { if (wr == 1) PG8_BAR; }
    }
    PG8_WAIT_V(0);
    if constexpr (!ALIGN_EPI) { if (wr == 0) PG8_BAR; }
    PG8_BAR;
#undef PG8_SA
#undef PG8_SB
#undef PG8_STAGE
#undef PG8_STAGEA
#undef PG8_ROWOFFS
#undef PG8_LDA
#undef PG8_LDB
#undef PG8_MMA
#undef PG8_HALF
#undef PG8_WAIT_V
#undef PG8_WAIT_L
#undef PG8_BAR
#undef PG8_SCHED
}
}

constexpr int NB = 8, SEQ = 2048, D = 1024, T = NB * SEQ;
constexpr int MEML = 256, TM = NB * MEML;
constexpr int HYC = 512, NZ0 = 2048;
constexpr int FF = 2816, NGU = 2 * FF;
constexpr int ATW = 1536, NQKV = 3 * ATW, NQ1 = NQKV + 512;
constexpr int NE = 8, PMAX = 2 * T + NE * 256;
constexpr float EPS = 1e-6f;
constexpr float MOE_WGU_SCALE = 32.0f, MOE_WD_SCALE = 64.0f;
constexpr int NWAVES = 8;

constexpr size_t MiB = 1u << 20;
constexpr size_t WS_CTL = 0, CTL_ZERO_BYTES = 1 * MiB;
constexpr size_t WS_WGU1 = 1 * MiB;
constexpr size_t WS_WD1 = 89 * MiB;
constexpr size_t WS_SMALL = 133 * MiB;
constexpr size_t WS_RSTD0 = WS_SMALL;
constexpr size_t WS_SSQ16 = WS_SMALL + 64 * 1024;
constexpr size_t WS_LSE = WS_SSQ16 + 1 * MiB;
constexpr size_t WS_TOKE = WS_LSE + 768 * 1024;
constexpr size_t WS_TOKR = WS_TOKE + 128 * 1024;
constexpr size_t WS_TOKG = WS_TOKR + 128 * 1024;
constexpr size_t WS_RSTD3 = WS_TOKG + 128 * 1024;
constexpr size_t WS_LIST = WS_RSTD3 + 64 * 1024;
constexpr size_t WS_RSTDS = WS_LIST + 512 * 1024;
static_assert(WS_RSTDS + PMAX * 4 <= WS_SMALL + 4 * MiB, "small region");
constexpr size_t WS_WO = 137 * MiB;
constexpr size_t WS_WIN1 = 141 * MiB;
constexpr size_t WS_WKV = 151 * MiB;
constexpr size_t WS_WIN0 = 155 * MiB;
constexpr size_t WS_WGU0 = 159 * MiB;
constexpr size_t WS_WD0 = 170 * MiB;
constexpr size_t WS_KV = 176 * MiB;
constexpr size_t WS_XB = 184 * MiB;
constexpr size_t WS_YT = 336 * MiB;
constexpr size_t WS_MIX0 = 216 * MiB;
constexpr size_t WS_MN = 248 * MiB;
constexpr size_t WS_ZT = 256 * MiB;
constexpr size_t WS_XQ0 = 304 * MiB;
constexpr size_t WS_HF = 320 * MiB;
constexpr size_t WS_HID0 = 248 * MiB;
constexpr size_t WS_QKV1 = 248 * MiB;
constexpr size_t WS_XQ1 = 392 * MiB;
constexpr size_t WS_OG12 = 216 * MiB;
constexpr size_t WS_MIX1 = 141 * MiB;
constexpr size_t WS_XB3 = 137 * MiB;
constexpr size_t WS_XS = 137 * MiB;
constexpr size_t WS_HID1 = 205 * MiB;
constexpr size_t WS_Y2 = 392 * MiB;
constexpr size_t WS_END = 408 * MiB;
static_assert(WS_HID1 + (size_t)PMAX * FF * 2 <= WS_END && WS_XQ1 + (size_t)T * 512 * 2 <= WS_END && WS_XS + (size_t)PMAX * 2048 <= WS_HID1, "ws map");

constexpr int CW_CNT = 64;
constexpr int CW_BAR = 4096;

constexpr int SCR_BYTES = 155648;
constexpr int MISC_OFF = SCR_BYTES;
constexpr int LDS_BYTES = SCR_BYTES + 4096;

#define LAS __attribute__((address_space(3)))
typedef unsigned short bf16;
typedef unsigned v4u __attribute__((ext_vector_type(4)));
typedef unsigned v2u __attribute__((ext_vector_type(2)));
typedef float f32x4 __attribute__((ext_vector_type(4)));
typedef float f32x2 __attribute__((ext_vector_type(2)));
#define LDS_WAIT() asm volatile("s_waitcnt lgkmcnt(0)" ::: "memory")
__device__ __forceinline__ unsigned f2bf(float f) { unsigned u = __builtin_bit_cast(unsigned, f); return (u + 0x7fffu + ((u >> 16) & 1u)) >> 16; }
__device__ __forceinline__ unsigned pk2(float lo, float hi) { unsigned r; asm("v_cvt_pk_bf16_f32 %0, %1, %2" : "=v"(r) : "v"(lo), "v"(hi)); return r; }
__device__ __forceinline__ unsigned pk4_fp8(float a, float b, float c, float d) { unsigned w = 0u; w = __builtin_amdgcn_cvt_pk_fp8_f32(a, b, w, false); w = __builtin_amdgcn_cvt_pk_fp8_f32(c, d, w, true); return w; }
__device__ __forceinline__ float bflo(unsigned w) { return __builtin_bit_cast(float, w << 16); }
__device__ __forceinline__ float bfhi(unsigned w) { return __builtin_bit_cast(float, w & 0xffff0000u); }
__device__ __forceinline__ float bf1(bf16 b) { return __builtin_bit_cast(float, ((unsigned)b) << 16); }
__device__ __forceinline__ float wave_sum(float v) {
#pragma unroll
    for (int o = 1; o < 64; o <<= 1) v += __shfl_xor(v, o);
    return v;
}
__device__ __forceinline__ float wave_max(float v) {
#pragma unroll
    for (int o = 1; o < 64; o <<= 1) v = fmaxf(v, __shfl_xor(v, o));
    return v;
}

#define XB_TMO      128
#define XB_XCNT(j)  (256  + 64 * (j))
#define XB_XSUB(j)  (1280 + 64 * (j))
#define XB_XGEN(j)  (2304 + 64 * (j))
#define XB_TOP      3328
#define XB_TOPGEN   3392
#define XCD_BAR_WORDS 3456
#define XB_SPIN_CAP (1u << 18)

__device__ __forceinline__ unsigned xb_ld(unsigned* p)              { return __hip_atomic_load(p, __ATOMIC_RELAXED, __HIP_MEMORY_SCOPE_AGENT); }
__device__ __forceinline__ unsigned xb_add(unsigned* p, unsigned v) { return __hip_atomic_fetch_add(p, v, __ATOMIC_RELAXED, __HIP_MEMORY_SCOPE_AGENT); }
__device__ __forceinline__ unsigned xb_xcc_id() { return (unsigned)__builtin_amdgcn_s_getreg((3 << 11) | 20) & 0xFu; }
#define XB_SPIN(cond, bar) do { unsigned _sp = 0; while (cond) { __builtin_amdgcn_s_sleep(1); \
    if ((++_sp & 255u) == 0u) { if (xb_ld(&(bar)[XB_TMO])) break; if (_sp > XB_SPIN_CAP) { atomicAdd(&(bar)[XB_TMO], 1u); break; } } } } while (0)

struct XcdBarrier {
    unsigned* bar; unsigned x;
    volatile LAS unsigned* st;
};
__device__ __forceinline__ XcdBarrier xcd_barrier_post(unsigned* bar, volatile LAS unsigned* st, int tid) {
    XcdBarrier b; b.bar = bar; b.x = xb_xcc_id(); b.st = st;
    if (tid == 0) (void)xb_add(&bar[XB_XCNT(b.x)], 1u);
    return b;
}
__device__ __forceinline__ void xcd_barrier_complete(unsigned* bar, unsigned x, unsigned& nloc, unsigned& nx) {
    const unsigned G = gridDim.x * gridDim.y * gridDim.z;
    unsigned sum, cnt, mine, sp = 0u;
    for (;;) {
        sum = 0u; cnt = 0u; mine = 0u;
#pragma unroll
        for (unsigned j = 0; j < 16; ++j) { const unsigned c = xb_ld(&bar[XB_XCNT(j)]); sum += c; cnt += (c > 0u) ? 1u : 0u; mine = (j == x) ? c : mine; }
        if (sum == G) break;
        __builtin_amdgcn_s_sleep(1);
        if ((++sp & 255u) == 0u) { if (xb_ld(&bar[XB_TMO])) break; if (sp > XB_SPIN_CAP) { atomicAdd(&bar[XB_TMO], 1u); break; } }
    }
    nloc = mine > 0u ? mine : 1u; nx = cnt > 0u ? cnt : 1u;
}
__device__ __forceinline__ void xcd_barrier(const XcdBarrier& b, int tid) {
    asm volatile("s_waitcnt vmcnt(0)" ::: "memory");
    __syncthreads();
    if (tid == 0) {
        unsigned* bar = b.bar;
        __builtin_amdgcn_s_waitcnt(0);
        unsigned nloc = b.st[0], nx = b.st[1];
        if (nloc == 0u) { xcd_barrier_complete(bar, b.x, nloc, nx); b.st[0] = nloc; b.st[1] = nx; }
        const unsigned old = xb_add(&bar[XB_XSUB(b.x)], 1u);
        const unsigned gen = old / nloc;
        if (old + 1u == (gen + 1u) * nloc) {
            __builtin_amdgcn_fence(__ATOMIC_RELEASE, "agent");
            asm volatile("s_waitcnt vmcnt(0)" ::: "memory");
            const unsigned og = xb_add(&bar[XB_TOP], 1u);
            const unsigned tg = og / nx;
            if (og + 1u == (tg + 1u) * nx) xb_add(&bar[XB_TOPGEN], 1u);
            else XB_SPIN(xb_ld(&bar[XB_TOPGEN]) == tg, bar);
            __builtin_amdgcn_fence(__ATOMIC_ACQUIRE, "agent");
            xb_add(&bar[XB_XGEN(b.x)], 1u);
            asm volatile("s_waitcnt vmcnt(0)" ::: "memory");
        } else {
            XB_SPIN(xb_ld(&bar[XB_XGEN(b.x)]) == gen, bar);
            __builtin_amdgcn_fence(__ATOMIC_ACQUIRE, "agent");
            asm volatile("s_waitcnt vmcnt(0)" ::: "memory");
        }
    }
    __syncthreads();
}

struct Args { const float* in[30]; float* out; unsigned char* ws; int ph_lo, ph_hi, bslot, pad; };
enum { I_X = 0, I_MEM, I_RELB, I_NMIX, I_NMEM, I_NFFN, I_WKV, I_XQN, I_XKN, I_WOUT, I_HYWIN, I_HYCW, I_HYCB, I_FW1, I_FB1, I_FW2, I_FB2, I_FW3, I_FREQ, I_SKIP,
       I_ATWIN, I_ATQN, I_ATKN, I_FFG, I_FFU, I_FFD, I_ROUTER, I_MOEG, I_MOEU, I_MOED };

struct Frame {
    LAS unsigned char* lds;
    unsigned char* ws;
    int tid, lane, wave, G, bid;
};

constexpr int RSL_OFF = 131072;
template <int SCALE> struct EpiB {
    bf16* O; int ldc; const float* sc; int split_tile; bf16* O2; int ldc2; const LAS float* rsl; float kc;
    __device__ __forceinline__ void operator()(const f32x4 (&acc)[2][2][4][2], const pg8::Unit& u, int wr, int wc, int fr, int fq) const {
        const int row0 = u.pm * 256 + wr * 64 + fr;
        bf16* base = O; int ld = ldc; int colt = u.pn * 256;
        if (u.pn >= split_tile) { base = O2; ld = ldc2; colt -= split_tile * 256; }
        if (u.koff != 0) base = O2;
        const int col0 = colt + wc * 32 + 8 * fq;
        float rsv[2][4];
        if (SCALE == 1) {
#pragma unroll
            for (int ai = 0; ai < 2; ++ai)
#pragma unroll
                for (int m = 0; m < 4; ++m) rsv[ai][m] = sc[row0 + ai * 128 + m * 16];
            asm volatile("s_waitcnt vmcnt(0)" ::: "memory");
        }
        f32x4 cs[2][2];
        if (SCALE == 3) {
#pragma unroll
            for (int bj = 0; bj < 2; ++bj)
#pragma unroll
                for (int n = 0; n < 2; ++n) cs[bj][n] = *(const f32x4*)(sc + u.pn * 256 + bj * 128 + wc * 32 + 8 * fq + 4 * n);
            asm volatile("s_waitcnt vmcnt(0)" ::: "memory");
        }
#pragma unroll
        for (int ai = 0; ai < 2; ++ai)
#pragma unroll
            for (int m = 0; m < 4; ++m) {
                const int row = row0 + ai * 128 + m * 16;
                float rs = 1.f;
                if (SCALE == 1) rs = rsv[ai][m];
                if (SCALE == 2) { const f32x4* p = (const f32x4*)(sc + (size_t)row * 16); const f32x4 a = p[0], b = p[1], c = p[2], d = p[3];
                    const float s = ((a.x + a.y) + (a.z + a.w)) + ((b.x + b.y) + (b.z + b.w)) + ((c.x + c.y) + (c.z + c.w)) + ((d.x + d.y) + (d.z + d.w));
                    rs = 1.0f / sqrtf(s * (1.0f / D) + EPS); }
                if (SCALE == 4) rs = rsl[u.idx * 256 + (row - u.pm * 256)];
                if (SCALE == 5) rs = kc;
                bf16* rowp = base + (size_t)row * ld + col0;
#pragma unroll
                for (int bj = 0; bj < 2; ++bj) {
                    f32x4 v0 = acc[ai][bj][m][0], v1 = acc[ai][bj][m][1];
                    if (SCALE == 1 || SCALE == 2 || SCALE == 4 || SCALE == 5) { v0 = v0 * rs; v1 = v1 * rs; }
                    if (SCALE == 3) { v0 = v0 * cs[bj][0]; v1 = v1 * cs[bj][1]; }
                    v4u w; w.x = pk2(v0[0], v0[1]); w.y = pk2(v0[2], v0[3]); w.z = pk2(v1[0], v1[1]); w.w = pk2(v1[2], v1[3]);
                    *(v4u*)(rowp + bj * 128) = w;
                }
            }
    }
};
template <bool XF32, bool SSQ> struct EpiRes {
    const float* xf; const bf16* xi; int ldi; bf16* xo; int ldo; float* ssq16;
    __device__ __forceinline__ void operator()(const f32x4 (&acc)[2][2][4][2], const pg8::Unit& u, int wr, int wc, int fr, int fq) const {
        const int row0 = u.pm * 256 + wr * 64 + fr, col0 = u.pn * 256 + wc * 32 + 8 * fq;
        if constexpr (!XF32) {
            v4u res[2][4][2];
#pragma unroll
            for (int ai = 0; ai < 2; ++ai)
#pragma unroll
                for (int m = 0; m < 4; ++m)
#pragma unroll
                    for (int bj = 0; bj < 2; ++bj) res[ai][m][bj] = *(const v4u*)(xi + (size_t)(row0 + ai * 128 + m * 16) * ldi + col0 + bj * 128);
            asm volatile("s_waitcnt vmcnt(0)" ::: "memory");
#pragma unroll
            for (int ai = 0; ai < 2; ++ai)
#pragma unroll
                for (int m = 0; m < 4; ++m) {
                    const int row = row0 + ai * 128 + m * 16;
                    float ss = 0.f;
#pragma unroll
                    for (int bj = 0; bj < 2; ++bj) {
                        const v4u w0 = res[ai][m][bj];
                        const f32x4 r0 = (f32x4){bflo(w0.x), bfhi(w0.x), bflo(w0.y), bfhi(w0.y)}, r1 = (f32x4){bflo(w0.z), bfhi(w0.z), bflo(w0.w), bfhi(w0.w)};
                        const f32x4 v0 = acc[ai][bj][m][0] + r0, v1 = acc[ai][bj][m][1] + r1;
                        v4u w; w.x = pk2(v0[0], v0[1]); w.y = pk2(v0[2], v0[3]); w.z = pk2(v1[0], v1[1]); w.w = pk2(v1[2], v1[3]);
                        *(v4u*)(xo + (size_t)row * ldo + col0 + bj * 128) = w;
                        if (SSQ) ss += ((v0[0] * v0[0] + v0[1] * v0[1]) + (v0[2] * v0[2] + v0[3] * v0[3])) + ((v1[0] * v1[0] + v1[1] * v1[1]) + (v1[2] * v1[2] + v1[3] * v1[3]));
                    }
                    if (SSQ) { ss += __shfl_xor(ss, 16); ss += __shfl_xor(ss, 32);
                        if (fq == 0) ssq16[(size_t)row * 16 + u.pn * 4 + wc] = ss; }
                }
        } else {
#pragma unroll
            for (int ai = 0; ai < 2; ++ai)
#pragma unroll
                for (int m = 0; m < 4; ++m) {
                    const int row = row0 + ai * 128 + m * 16;
                    float ss = 0.f;
#pragma unroll
                    for (int bj = 0; bj < 2; ++bj) {
                        const size_t off = (size_t)row * D + col0 + bj * 128; const f32x4 r0 = *(const f32x4*)(xf + off), r1 = *(const f32x4*)(xf + off + 4);
                        const f32x4 v0 = acc[ai][bj][m][0] + r0, v1 = acc[ai][bj][m][1] + r1;
                        v4u w; w.x = pk2(v0[0], v0[1]); w.y = pk2(v0[2], v0[3]); w.z = pk2(v1[0], v1[1]); w.w = pk2(v1[2], v1[3]);
                        *(v4u*)(xo + (size_t)row * ldo + col0 + bj * 128) = w;
                        if (SSQ) ss += ((v0[0] * v0[0] + v0[1] * v0[1]) + (v0[2] * v0[2] + v0[3] * v0[3])) + ((v1[0] * v1[0] + v1[1] * v1[1]) + (v1[2] * v1[2] + v1[3] * v1[3]));
                    }
                    if (SSQ) { ss += __shfl_xor(ss, 16); ss += __shfl_xor(ss, 32);
                        if (fq == 0) ssq16[(size_t)row * 16 + u.pn * 4 + wc] = ss; }
                }
        }
    }
};
template <int SCALE, bool OUT8 = false> struct EpiSwiglu {
    bf16* H; int ldh; const float* sc; const LAS float* rsl; float kc;
    __device__ __forceinline__ void operator()(const f32x4 (&acc)[2][2][4][2], const pg8::Unit& u, int wr, int wc, int fr, int fq) const {
        const int row0 = u.pm * 256 + wr * 64 + fr, col0 = u.pn * 128 + wc * 32 + 8 * fq;
#pragma unroll
        for (int ai = 0; ai < 2; ++ai)
#pragma unroll
            for (int m = 0; m < 4; ++m) {
                const int row = row0 + ai * 128 + m * 16;
                float rs = 1.f;
                if (SCALE == 1) rs = sc[row];
                if (SCALE == 2) { const f32x4* p = (const f32x4*)(sc + (size_t)row * 16); const f32x4 a = p[0], b = p[1], c = p[2], d = p[3];
                    const float s = ((a.x + a.y) + (a.z + a.w)) + ((b.x + b.y) + (b.z + b.w)) + ((c.x + c.y) + (c.z + c.w)) + ((d.x + d.y) + (d.z + d.w));
                    rs = 1.0f / sqrtf(s * (1.0f / D) + EPS); }
                if (SCALE == 4) rs = rsl[u.idx * 256 + (row - u.pm * 256)];
                if (SCALE == 5) rs = kc;
                float h[8];
#pragma unroll
                for (int n = 0; n < 2; ++n)
#pragma unroll
                    for (int j = 0; j < 4; ++j) { const float gv = acc[ai][0][m][n][j] * rs, uv = acc[ai][1][m][n][j] * rs;
                        h[n * 4 + j] = gv * uv * __builtin_amdgcn_rcpf(1.0f + __expf(-gv)); }
                if (OUT8) { v2u w; w.x = pk4_fp8(h[0], h[1], h[2], h[3]); w.y = pk4_fp8(h[4], h[5], h[6], h[7]); *(v2u*)((unsigned char*)H + (size_t)row * ldh + col0) = w; }
                else { v4u w; w.x = pk2(h[0], h[1]); w.y = pk2(h[2], h[3]); w.z = pk2(h[4], h[5]); w.w = pk2(h[6], h[7]);
                    *(v4u*)(H + (size_t)row * ldh + col0) = w; }
            }
    }
};

template <class Sched>
__device__ __forceinline__ void fill_rstd_table(LAS unsigned char* lds, const Sched& S, const float* ssq16, int tid) {
    LAS float* rsl = (LAS float*)(lds + RSL_OFF);
    pg8::Unit u;
    for (int ui = 0; ui < 16 && S.next(ui, u); ++ui) {
        if (tid < 256) { const f32x4* p = (const f32x4*)(ssq16 + (size_t)(u.pm * 256 + tid) * 16); const f32x4 a = p[0], b = p[1], c = p[2], d = p[3];
            const float s = ((a.x + a.y) + (a.z + a.w)) + ((b.x + b.y) + (b.z + b.w)) + ((c.x + c.y) + (c.z + c.w)) + ((d.x + d.y) + (d.z + d.w));
            rsl[ui * 256 + tid] = 1.0f / sqrtf(s * (1.0f / D) + EPS); }
    }
    __syncthreads();
}

__device__ __forceinline__ void p0_transpose_item(const float* W, int K, int N, bf16* WT, const float* gain, int mode, LAS float* scr, int item, int lane) {
    const int nblk = N / 64, kb = item / nblk, nb = item % nblk, k0 = 64 * kb, n0 = 64 * nb;
    const int lr = lane >> 4, lc = lane & 15;
    f32x4 v[16];
#pragma unroll
    for (int i = 0; i < 16; ++i) v[i] = __builtin_nontemporal_load((const f32x4*)(W + (size_t)(k0 + 4 * i + lr) * N + n0 + 4 * lc));
    if (gain) {
#pragma unroll
        for (int i = 0; i < 16; ++i) v[i] = v[i] * gain[k0 + 4 * i + lr];
    }
#pragma unroll
    for (int i = 0; i < 16; ++i) { LAS float* s = scr + (4 * i + lr) * 65 + 4 * lc; s[0] = v[i].x; s[1] = v[i].y; s[2] = v[i].z; s[3] = v[i].w; }
    LDS_WAIT(); asm volatile("" ::: "memory");
    const int c = lane & 7;
    const int d0 = (mode == 0) ? n0 : (256 * (n0 / 128) + (n0 % 128) + (mode == 2 ? 128 : 0));
#pragma unroll
    for (int j = 0; j < 8; ++j) { const int n = (lane >> 3) + 8 * j; const LAS float* s = scr + (8 * c) * 65 + n;
        v4u o; o.x = pk2(s[0 * 65], s[1 * 65]); o.y = pk2(s[2 * 65], s[3 * 65]); o.z = pk2(s[4 * 65], s[5 * 65]); o.w = pk2(s[6 * 65], s[7 * 65]);
        *(v4u*)(WT + (size_t)(d0 + n) * K + k0 + 8 * c) = o; }
    LDS_WAIT(); asm volatile("" ::: "memory");
}
__device__ __forceinline__ void p0_transpose_item8(const float* W, int K, int N, unsigned char* WT8, const float* gain, float s8, int mode, LAS float* scr, int item, int lane) {
    const int nblk = N / 64, kb = item / nblk, nb = item % nblk, k0 = 64 * kb, n0 = 64 * nb;
    const int lr = lane >> 4, lc = lane & 15;
    f32x4 v[16];
#pragma unroll
    for (int i = 0; i < 16; ++i) v[i] = __builtin_nontemporal_load((const f32x4*)(W + (size_t)(k0 + 4 * i + lr) * N + n0 + 4 * lc));
#pragma unroll
    for (int i = 0; i < 16; ++i) { const float g = gain ? gain[k0 + 4 * i + lr] * s8 : s8; v[i] = v[i] * g; }
#pragma unroll
    for (int i = 0; i < 16; ++i) { LAS float* s = scr + (4 * i + lr) * 65 + 4 * lc; s[0] = v[i].x; s[1] = v[i].y; s[2] = v[i].z; s[3] = v[i].w; }
    LDS_WAIT(); asm volatile("" ::: "memory");
    const int c = lane & 3;
    const int d0 = (mode == 0) ? n0 : (256 * (n0 / 128) + (n0 % 128) + (mode == 2 ? 128 : 0));
#pragma unroll
    for (int j = 0; j < 4; ++j) { const int n = (lane >> 2) + 16 * j; const LAS float* s = scr + (16 * c) * 65 + n;
        v4u o; o.x = pk4_fp8(s[0 * 65], s[1 * 65], s[2 * 65], s[3 * 65]); o.y = pk4_fp8(s[4 * 65], s[5 * 65], s[6 * 65], s[7 * 65]);
        o.z = pk4_fp8(s[8 * 65], s[9 * 65], s[10 * 65], s[11 * 65]); o.w = pk4_fp8(s[12 * 65], s[13 * 65], s[14 * 65], s[15 * 65]);
        __builtin_nontemporal_store(o, (v4u*)(WT8 + (size_t)(d0 + n) * K + k0 + 16 * c)); }
    LDS_WAIT(); asm volatile("" ::: "memory");
}
__device__ __forceinline__ float row_to_bf16(const float* xrow, bf16* orow, const float* gain, bool normalize, int lane) {
    const f32x4* xr = (const f32x4*)xrow + lane;
    f32x4 v[4]; float s = 0.f;
#pragma unroll
    for (int j = 0; j < 4; ++j) { v[j] = __builtin_nontemporal_load(xr + 64 * j); s += (v[j].x * v[j].x + v[j].y * v[j].y) + (v[j].z * v[j].z + v[j].w * v[j].w); }
    const float rstd = 1.0f / sqrtf(wave_sum(s) * (1.f / D) + EPS);
    unsigned long long* o8 = (unsigned long long*)orow + lane;
#pragma unroll
    for (int j = 0; j < 4; ++j) {
        f32x4 w = v[j];
        if (normalize) { const f32x4 g = ((const f32x4*)gain)[lane + 64 * j]; w = w * rstd * g; }
        o8[64 * j] = (unsigned long long)pk2(w.x, w.y) | ((unsigned long long)pk2(w.z, w.w) << 32);
    }
    return rstd;
}
__device__ __forceinline__ void p0_filter_block(Frame& F, const Args& a, float* Hf, int jb) {
    const float* w1 = a.in[I_FW1]; const float* b1 = a.in[I_FB1]; const float* w2 = a.in[I_FW2]; const float* b2 = a.in[I_FB2]; const float* w3 = a.in[I_FW3]; const float* fr = a.in[I_FREQ];
    LAS float* h2s = (LAS float*)(F.lds + MISC_OFF + 256);
    const int lane = F.lane, j0 = jb * 8;
    LAS float* W1s = (LAS float*)F.lds; LAS float* W2s = W1s + 33 * 64;
    for (int i = F.tid; i < 33 * 64; i += 512) W1s[i] = w1[i];
    for (int i = F.tid; i < 64 * 64; i += 512) W2s[i] = w2[i];
    __syncthreads();
    {
        const int j = j0 + F.wave;
        const float freq = fr[lane], bb1 = b1[lane], bb2 = b2[lane];
        float feat = 0.f;
        {
            const int fi = (lane >= 17) ? lane - 17 : lane - 1;
            const float f = 1e-4f + (float)fi * ((15.0f - 1e-4f) / 15.0f);
            const float ang = (6.283185307179586f / 2048.0f) * (float)j * f;
            if (lane == 0) feat = (float)j * (1.0f / 2047.0f);
            else if (lane <= 16) feat = cosf(ang);
            else if (lane <= 32) feat = -sinf(ang);
        }
        float s1 = bb1;
#pragma unroll
        for (int i = 0; i < 33; ++i) s1 += __shfl(feat, i) * W1s[i * 64 + lane];
        const float h1 = sinf(freq * s1);
        float s2 = bb2;
#pragma unroll 16
        for (int i = 0; i < 64; ++i) s2 += __shfl(h1, i) * W2s[i * 64 + lane];
        h2s[lane * 8 + F.wave] = sinf(freq * s2);
    }
    __syncthreads();
    const int n0 = F.wave * 256;
    float acc[4][8];
#pragma unroll
    for (int q = 0; q < 4; ++q)
#pragma unroll
        for (int jj = 0; jj < 8; ++jj) acc[q][jj] = 0.f;
#pragma unroll 1
    for (int i0 = 0; i0 < 64; i0 += 8) {
        float w[8][4];
#pragma unroll
        for (int ii = 0; ii < 8; ++ii)
#pragma unroll
            for (int q = 0; q < 4; ++q) w[ii][q] = w3[(size_t)(i0 + ii) * 2048 + n0 + q * 64 + lane];
#pragma unroll
        for (int ii = 0; ii < 8; ++ii) {
            const f32x4 ha = *(const LAS f32x4*)(h2s + (i0 + ii) * 8), hb = *(const LAS f32x4*)(h2s + (i0 + ii) * 8 + 4);
#pragma unroll
            for (int q = 0; q < 4; ++q) {
                acc[q][0] += ha.x * w[ii][q]; acc[q][1] += ha.y * w[ii][q]; acc[q][2] += ha.z * w[ii][q]; acc[q][3] += ha.w * w[ii][q];
                acc[q][4] += hb.x * w[ii][q]; acc[q][5] += hb.y * w[ii][q]; acc[q][6] += hb.z * w[ii][q]; acc[q][7] += hb.w * w[ii][q]; }
        }
    }
    const float da = -3.0701134573253945f, db = -15.350567286626973f;
#pragma unroll
    for (int q = 0; q < 4; ++q) {
        const int n = n0 + q * 64 + lane, c = n & 511;
        const float delta = fabsf(da + (db - da) * ((float)c * (1.0f / 511.0f)));
        float o[8];
#pragma unroll
        for (int jj = 0; jj < 8; ++jj) { const float t = (float)(j0 + jj) * (1.0f / 2047.0f); o[jj] = acc[q][jj] * (expf(-t * delta) + 0.05f); }
        f32x4* dst = (f32x4*)(Hf + (size_t)n * 2048 + j0);
        dst[0] = (f32x4){o[0], o[1], o[2], o[3]}; dst[1] = (f32x4){o[4], o[5], o[6], o[7]};
    }
    __syncthreads();
}
constexpr int IT_MOE = 16 * 44, N_MOE_ITEMS = 24 * IT_MOE;
constexpr int MOE_P1_HI = 5376, MOE_P5_MID = MOE_P1_HI + 4096, MOE_P5_HI = 16896, MOE_P0_LO = MOE_P5_HI;
__device__ __forceinline__ void moe_convert(Frame& F, const Args& a, int lo, int hi, int gwl, int ngw) {
    LAS float* scr = (LAS float*)(F.lds + F.wave * 16640);
    unsigned char* ws = F.ws;
    for (int r = lo + gwl; r < hi; r += ngw) {
        const int mid = r / IT_MOE, li = r % IT_MOE, kind = mid >> 3, e = mid & 7;
        if (kind == 0) p0_transpose_item8(a.in[I_MOEG] + (size_t)e * D * FF, D, FF, ws + WS_WGU1 + (size_t)e * NGU * D, a.in[I_NFFN] + D, MOE_WGU_SCALE, 1, scr, li, F.lane);
        else if (kind == 1) p0_transpose_item8(a.in[I_MOEU] + (size_t)e * D * FF, D, FF, ws + WS_WGU1 + (size_t)e * NGU * D, a.in[I_NFFN] + D, MOE_WGU_SCALE, 2, scr, li, F.lane);
        else p0_transpose_item8(a.in[I_MOED] + (size_t)e * FF * D, FF, D, ws + WS_WD1 + (size_t)e * D * FF, nullptr, MOE_WD_SCALE, 0, scr, li, F.lane);
    }
}
__device__ __forceinline__ void p0_prologue(Frame& F, const Args& a) {
    LAS float* scr = (LAS float*)(F.lds + F.wave * 16640);
    const int gw = F.bid * NWAVES + F.wave, NGW = F.G * NWAVES;
    unsigned char* ws = F.ws;
    if (!(F.bid & 1)) { for (int jb = F.bid; jb < 256; jb += F.G) p0_filter_block(F, a, (float*)(ws + WS_HF), jb); }
    for (int m = gw; m < T; m += NGW) { const float r = row_to_bf16(a.in[I_X] + (size_t)m * D, (bf16*)(ws + WS_XB) + (size_t)m * D, nullptr, false, F.lane); if (F.lane == 0) ((float*)(ws + WS_RSTD0))[m] = r; }
    for (int m = gw; m < 2 * TM; m += NGW) { const int l = m / TM, r = m % TM;
        (void)row_to_bf16(a.in[I_MEM] + (size_t)r * D, (bf16*)(ws + WS_MN) + (size_t)m * D, a.in[I_NMEM] + l * D, true, F.lane); }
    constexpr int IT_A = 16 * 32, IT_SQ = 16 * 16, IT_G = 16 * 44, IT_D = 44 * 16, IT_W1 = 16 * 80;
    constexpr int NSMALL = IT_A + 4 * IT_SQ + 2 * IT_G + IT_D + IT_W1;
    for (int it = gw; it < NSMALL; it += NGW) {
        int r = it;
        if (r < IT_A) { p0_transpose_item(a.in[I_HYWIN], D, NZ0, (bf16*)(ws + WS_WIN0), a.in[I_NMIX], 0, scr, r, F.lane); continue; } r -= IT_A;
        if (r < IT_SQ) { p0_transpose_item(a.in[I_WKV], D, D, (bf16*)(ws + WS_WKV), nullptr, 0, scr, r, F.lane); continue; } r -= IT_SQ;
        if (r < IT_SQ) { p0_transpose_item(a.in[I_WKV] + (size_t)D * D, D, D, (bf16*)(ws + WS_WKV) + (size_t)D * D, nullptr, 0, scr, r, F.lane); continue; } r -= IT_SQ;
        if (r < IT_SQ) { p0_transpose_item(a.in[I_WOUT], D, D, (bf16*)(ws + WS_WO), nullptr, 0, scr, r, F.lane); continue; } r -= IT_SQ;
        if (r < IT_SQ) { p0_transpose_item(a.in[I_WOUT] + (size_t)D * D, D, D, (bf16*)(ws + WS_WO) + (size_t)D * D, nullptr, 0, scr, r, F.lane); continue; } r -= IT_SQ;
        if (r < IT_G) { p0_transpose_item(a.in[I_FFG], D, FF, (bf16*)(ws + WS_WGU0), a.in[I_NFFN], 1, scr, r, F.lane); continue; } r -= IT_G;
        if (r < IT_G) { p0_transpose_item(a.in[I_FFU], D, FF, (bf16*)(ws + WS_WGU0), a.in[I_NFFN], 2, scr, r, F.lane); continue; } r -= IT_G;
        if (r < IT_D) { p0_transpose_item(a.in[I_FFD], FF, D, (bf16*)(ws + WS_WD0), nullptr, 0, scr, r, F.lane); continue; } r -= IT_D;
        p0_transpose_item(a.in[I_ATWIN], D, NQ1, (bf16*)(ws + WS_WIN1), a.in[I_NMIX] + D, 0, scr, r, F.lane);
    }
    moe_convert(F, a, (F.G == 256) ? MOE_P0_LO : 0, N_MOE_ITEMS, gw, NGW);
    if (F.bid & 1) { __syncthreads(); for (int jb = F.bid; jb < 256; jb += F.G) p0_filter_block(F, a, (float*)(ws + WS_HF), jb); }
}
__device__ __forceinline__ float block_sum(Frame& F, float v) {
    LAS float* red = (LAS float*)(F.lds + MISC_OFF + 64);
    v = wave_sum(v);
    __syncthreads();
    if (F.lane == 0) red[F.wave] = v;
    __syncthreads();
    float s = 0.f;
#pragma unroll
    for (int w = 0; w < NWAVES; ++w) s += red[w];
    return s;
}
__device__ __forceinline__ int rel_bucket_dev(int rel) {
    const int n = rel < 0 ? -rel : rel;
    const int large = 8 + (n >= 15) + (n >= 27) + (n >= 50) + (n >= 91) + (n >= 166) + (n >= 305) + (n >= 559);
    return (rel > 0 ? 16 : 0) + (n < 8 ? n : large);
}
__device__ __forceinline__ void merge_token(Frame& F, int token) {
    const bf16* og = (const bf16*)(F.ws + WS_OG12); const float* lse = (const float*)(F.ws + WS_LSE);
    bf16* mix = (bf16*)(F.ws + WS_MIX1);
    const int lane = F.lane, h = lane >> 4;
    const float l0 = lse[(size_t)token * 4 + h], l1 = lse[((size_t)T + token) * 4 + h], l2 = lse[((size_t)2 * T + token) * 4 + h];
    const float mx = fmaxf(l0, fmaxf(l1, l2));
    float w0 = __expf(l0 - mx), w1 = __expf(l1 - mx), w2 = __expf(l2 - mx);
    const float iz = 1.0f / (w0 + w1 + w2); w0 *= iz; w1 *= iz; w2 *= iz;
    const v4u a0 = *(const v4u*)(mix + (size_t)token * D + 8 * lane);
    const v4u a1 = __builtin_nontemporal_load((const v4u*)(og + (size_t)token * 512 + 8 * lane));
    const v4u a2 = __builtin_nontemporal_load((const v4u*)(og + ((size_t)T + token) * 512 + 8 * lane));
    v4u o;
    o.x = pk2(w0 * bflo(a0.x) + w1 * bflo(a1.x) + w2 * bflo(a2.x), w0 * bfhi(a0.x) + w1 * bfhi(a1.x) + w2 * bfhi(a2.x));
    o.y = pk2(w0 * bflo(a0.y) + w1 * bflo(a1.y) + w2 * bflo(a2.y), w0 * bfhi(a0.y) + w1 * bfhi(a1.y) + w2 * bfhi(a2.y));
    o.z = pk2(w0 * bflo(a0.z) + w1 * bflo(a1.z) + w2 * bflo(a2.z), w0 * bfhi(a0.z) + w1 * bfhi(a1.z) + w2 * bfhi(a2.z));
    o.w = pk2(w0 * bflo(a0.w) + w1 * bflo(a1.w) + w2 * bflo(a2.w), w0 * bfhi(a0.w) + w1 * bfhi(a1.w) + w2 * bfhi(a2.w));
    *(v4u*)(mix + (size_t)token * D + 8 * lane) = o;
}

constexpr int RT_OFF_R = 0, RT_OFF_REC = 32768, RT_OFF_CNT = 32768 + 64 * 32;
__device__ __forceinline__ void route_block(Frame& F, const Args& a, int blk) {
    LAS float* RL = (LAS float*)(F.lds + RT_OFF_R); volatile LAS int* REC = (volatile LAS int*)(F.lds + RT_OFF_REC); LAS int* CNT = (LAS int*)(F.lds + RT_OFF_CNT);
    const int lane = F.lane;
    const float* g = a.in[I_NFFN] + D; const float* rt = a.in[I_ROUTER];
    __syncthreads();
    for (int i = F.tid; i < 2048; i += 512) { const f32x4 r = ((const f32x4*)rt)[i]; const float gg = g[i >> 1]; ((LAS f32x4*)RL)[i] = r * gg; }
    if (F.tid < 16) CNT[F.tid] = 0;
    __syncthreads();
    for (int q = 0; q < 8; ++q) {
        const int tl = F.wave * 8 + q, token = blk * 64 + tl;
        const bf16* xr = (const bf16*)a.out + (size_t)token * 2048 + 1024;
        f32x4 v[4]; float s = 0.f;
#pragma unroll
        for (int j = 0; j < 4; ++j) { const v2u w = __builtin_nontemporal_load((const v2u*)xr + lane + 64 * j); v[j] = (f32x4){bflo(w.x), bfhi(w.x), bflo(w.y), bfhi(w.y)}; s += (v[j].x * v[j].x + v[j].y * v[j].y) + (v[j].z * v[j].z + v[j].w * v[j].w); }
        const float rstd = 1.0f / sqrtf(wave_sum(s) * (1.f / D) + EPS);
        { unsigned* o4 = (unsigned*)(F.ws + WS_XB3 + (size_t)token * D) + lane;
#pragma unroll
          for (int j = 0; j < 4; ++j) o4[64 * j] = pk4_fp8(v[j].x * rstd, v[j].y * rstd, v[j].z * rstd, v[j].w * rstd); }
        float lg[8];
#pragma unroll
        for (int e = 0; e < 8; ++e) lg[e] = 0.f;
#pragma unroll
        for (int j = 0; j < 4; ++j) {
            const int k0 = 4 * (lane + 64 * j);
#pragma unroll
            for (int qq = 0; qq < 4; ++qq) {
                const float hn = v[j][qq] * rstd;
                const f32x4 r0 = *(const LAS f32x4*)(RL + (k0 + qq) * 8), r1 = *(const LAS f32x4*)(RL + (k0 + qq) * 8 + 4);
                lg[0] += hn * r0.x; lg[1] += hn * r0.y; lg[2] += hn * r0.z; lg[3] += hn * r0.w;
                lg[4] += hn * r1.x; lg[5] += hn * r1.y; lg[6] += hn * r1.z; lg[7] += hn * r1.w;
            }
        }
#pragma unroll
        for (int e = 0; e < 8; ++e) lg[e] = wave_sum(lg[e]);
        int i1 = 0; float v1 = lg[0];
#pragma unroll
        for (int e = 1; e < 8; ++e) if (lg[e] > v1) { v1 = lg[e]; i1 = e; }
        int i2 = -1; float v2 = -3.0e38f;
#pragma unroll
        for (int e = 0; e < 8; ++e) if (e != i1 && lg[e] > v2) { v2 = lg[e]; i2 = e; }
        const float e2 = __expf(v2 - v1), g1 = 1.0f / (1.0f + e2), g2 = e2 * g1;
        if (lane == 0) {
            const int r1 = __hip_atomic_fetch_add(CNT + i1, 1, __ATOMIC_RELAXED, __HIP_MEMORY_SCOPE_WORKGROUP);
            const int r2 = __hip_atomic_fetch_add(CNT + i2, 1, __ATOMIC_RELAXED, __HIP_MEMORY_SCOPE_WORKGROUP);
            REC[tl * 8 + 0] = i1; REC[tl * 8 + 1] = i2; REC[tl * 8 + 2] = r1; REC[tl * 8 + 3] = r2;
            REC[tl * 8 + 4] = __builtin_bit_cast(int, g1); REC[tl * 8 + 5] = __builtin_bit_cast(int, g2); REC[tl * 8 + 6] = __builtin_bit_cast(int, rstd);
        }
    }
    __syncthreads();
    if (F.tid < 8) { unsigned* cnt = (unsigned*)(F.ws + WS_CTL) + CW_CNT; CNT[8 + F.tid] = (int)__hip_atomic_fetch_add(cnt + F.tid, (unsigned)CNT[F.tid], __ATOMIC_RELAXED, __HIP_MEMORY_SCOPE_AGENT); }
    __syncthreads();
    if (F.tid < 64) {
        const int tl = F.tid, token = blk * 64 + tl;
        const int i1 = REC[tl * 8 + 0], i2 = REC[tl * 8 + 1], r1 = CNT[8 + i1] + REC[tl * 8 + 2], r2 = CNT[8 + i2] + REC[tl * 8 + 3];
        int* toke = (int*)(F.ws + WS_TOKE); int* tokr = (int*)(F.ws + WS_TOKR); int* tokg = (int*)(F.ws + WS_TOKG); int* list = (int*)(F.ws + WS_LIST);
        list[(size_t)i1 * T + r1] = token; list[(size_t)i2 * T + r2] = token;
        toke[token * 2] = i1; toke[token * 2 + 1] = i2; tokr[token * 2] = r1; tokr[token * 2 + 1] = r2;
        tokg[token * 2] = REC[tl * 8 + 4]; tokg[token * 2 + 1] = REC[tl * 8 + 5];
        ((int*)(F.ws + WS_RSTD3))[token] = REC[tl * 8 + 6];
    }
}
__device__ __forceinline__ void moe_layout(Frame& F) {
    volatile LAS int* M = (volatile LAS int*)(F.lds + MISC_OFF);
    __syncthreads();
    if (F.tid == 0) {
        const unsigned* cnt = (const unsigned*)(F.ws + WS_CTL) + CW_CNT;
        int acc = 0;
        for (int e = 0; e < 8; ++e) { const int c = (int)__hip_atomic_load(cnt + e, __ATOMIC_RELAXED, __HIP_MEMORY_SCOPE_AGENT); M[32 + e] = c; M[40 + e] = acc; acc += (c + 255) & ~255; }
        M[48] = acc;
    }
    __syncthreads();
}
__device__ __forceinline__ int ml_ps(Frame& F, int e) { return ((volatile LAS int*)(F.lds + MISC_OFF))[40 + e]; }
__device__ __forceinline__ int ml_cnt(Frame& F, int e) { return ((volatile LAS int*)(F.lds + MISC_OFF))[32 + e]; }
__device__ __forceinline__ int ml_total(Frame& F) { return ((volatile LAS int*)(F.lds + MISC_OFF))[48]; }
__device__ __forceinline__ int ml_expert(Frame& F, int slot) { int e = 0;
#pragma unroll
    for (int i = 1; i < 8; ++i) e += (slot >= ml_ps(F, i)) ? 1 : 0;
    return e; }

constexpr int HY_CS = 4168, HY_M0 = 2080, HY_UR = 2592, HY_UP = 256;
constexpr int HY_OFF_CP = 64, HY_OFF_UB = HY_OFF_CP + 8 * HY_CS * 2, HY_OFF_X = HY_OFF_UB + 8 * HY_UR * 2;
static_assert(HY_OFF_X + 8 * 2048 * 2 <= SCR_BYTES, "hyena LDS");
typedef short bf16x8_t __attribute__((ext_vector_type(8)));

struct HyStage { v4u raw[4]; float zm[4], zp[4]; };
struct HyFilt { float f[4], b[4]; };
__device__ __forceinline__ void hy_short_load(HyStage& s, const bf16* zr, int tid) {
#pragma unroll
    for (int k = 0; k < 4; ++k) {
        const int item = tid + 512 * k, b = item >> 8, t8 = (item & 255) * 8;
        const bf16* p = zr + b * SEQ + t8;
        s.raw[k] = __builtin_nontemporal_load((const v4u*)p);
        s.zm[k] = (t8 > 0) ? bf1(p[-1]) : 0.f; s.zp[k] = (t8 + 8 < SEQ) ? bf1(p[8]) : 0.f;
    }
}
__device__ __forceinline__ void hy_short_store(LAS unsigned char* dst, int stride_el, int pad_el, const HyStage& s, float w0, float w1, float w2, float cb, int tid) {
#pragma unroll
    for (int k = 0; k < 4; ++k) {
        const int item = tid + 512 * k, b = item >> 8, t8 = (item & 255) * 8;
        float z[10];
        z[0] = s.zm[k]; z[1] = bflo(s.raw[k].x); z[2] = bfhi(s.raw[k].x); z[3] = bflo(s.raw[k].y); z[4] = bfhi(s.raw[k].y); z[5] = bflo(s.raw[k].z); z[6] = bfhi(s.raw[k].z); z[7] = bflo(s.raw[k].w); z[8] = bfhi(s.raw[k].w); z[9] = s.zp[k];
        float o[8];
#pragma unroll
        for (int i = 0; i < 8; ++i) o[i] = cb + z[i] * w0 + z[i + 1] * w1 + z[i + 2] * w2;
        v4u w; w.x = pk2(o[0], o[1]); w.y = pk2(o[2], o[3]); w.z = pk2(o[4], o[5]); w.w = pk2(o[6], o[7]);
        *(LAS v4u*)(dst + (size_t)(b * stride_el + pad_el + t8) * 2) = w;
    }
}
__device__ __forceinline__ void hy_filt_load(HyFilt& q, const float* Hf, int o, int c, int tid) {
    const float* fw = Hf + ((size_t)(o * 2 + 0) * 512 + c) * 2048;
    const float* bw = Hf + ((size_t)(o * 2 + 1) * 512 + c) * 2048;
#pragma unroll
    for (int i = 0; i < 4; ++i) { const int j = tid + 512 * i; q.f[i] = __builtin_nontemporal_load(fw + j); q.b[i] = (j >= 1) ? __builtin_nontemporal_load(bw + j) : 0.f; }
}
__device__ __forceinline__ void hy_filt_build(Frame& F, const HyFilt& q) {
    LAS float* Kf = (LAS float*)(F.lds + HY_OFF_X);
    float s = 0.f;
#pragma unroll
    for (int i = 0; i < 4; ++i) s += fabsf(q.f[i]) + fabsf(q.b[i]);
    const float tot = block_sum(F, s);
    const float inv = 1.0f / (tot + 1e-6f);
#pragma unroll
    for (int i = 0; i < 4; ++i) { const int j = F.tid + 512 * i; Kf[HY_M0 - j] = q.f[i] * inv; if (j >= 1) Kf[HY_M0 + j] = q.b[i] * inv; }
    if (F.tid < 33) Kf[F.tid] = 0.f;
    if (F.tid < 48) Kf[4128 + F.tid] = 0.f;
    __syncthreads();
    LAS unsigned* cp = (LAS unsigned*)(F.lds + HY_OFF_CP);
    for (int p = F.tid; p < 8 * (HY_CS / 2); p += 512) { const int j = p / (HY_CS / 2), xp = p - j * (HY_CS / 2), x = 2 * xp + j; cp[p] = pk2(Kf[x], Kf[x + 1]); }
    __syncthreads();
}
__device__ __forceinline__ void hy_conv_mfma(Frame& F, f32x4 (&C)[8]) {
    const int lane = F.lane, w = F.wave, r = lane & 15, kq = lane >> 4;
    const int jc = (-r) & 7, cr = (r + 7) >> 3;
    const LAS unsigned char* abase = F.lds + HY_OFF_CP + (size_t)(jc * HY_CS + HY_M0 - 32 * (8 * w - 63) + 8 * kq - 8 * cr) * 2;
    const LAS unsigned char* bbase = F.lds + HY_OFF_UB + (size_t)((r & 7) * HY_UR + HY_UP + 16 * (r >> 3) + 8 * kq) * 2;
#pragma unroll
    for (int i = 0; i < 8; ++i) C[i] = (f32x4){0.f, 0.f, 0.f, 0.f};
    bf16x8_t Bw[9];
#pragma unroll
    for (int i = 0; i < 8; ++i) Bw[i] = *(const LAS bf16x8_t*)(bbase + 64 * (63 + i));
    bf16x8_t An = *(const LAS bf16x8_t*)(abase);
#pragma unroll 1
    for (int Q = 0; Q < 8; ++Q) {
        const LAS unsigned char* ab = abase - 64 * (9 * Q);
        const LAS unsigned char* bb = bbase + 64 * (63 - 9 * Q);
#pragma unroll
        for (int qq = 0; qq < 9; ++qq) {
            const bf16x8_t A = An;
            An = *(const LAS bf16x8_t*)(ab - 64 * (qq + 1));
            Bw[(8 - qq + 9) % 9] = *(const LAS bf16x8_t*)(bb + 64 * (-1 - qq));
#pragma unroll
            for (int i = 7; i >= 0; --i) C[i] = __builtin_amdgcn_mfma_f32_16x16x32_bf16(A, Bw[(i - qq + 9) % 9], C[i], 0, 0, 0);
        }
    }
}
__device__ __forceinline__ void hyena_units(Frame& F, const Args& a) {
    const bf16* zT = (const bf16*)(F.ws + WS_ZT);
    const float* Hf = (const float*)(F.ws + WS_HF);
    const float* cw = a.in[I_HYCW]; const float* cbp = a.in[I_HYCB]; const float* skip = a.in[I_SKIP];
    bf16* yT = (bf16*)(F.ws + WS_YT);
    LAS unsigned char* UB = F.lds + HY_OFF_UB; LAS unsigned char* XB = F.lds + HY_OFF_X;
    int c = F.bid; if (c >= HYC) return;
    HyStage sA, sC, sG; HyFilt fB, fF;
    hy_short_load(sA, zT + (size_t)c * T, F.tid); hy_filt_load(fB, Hf, 0, c, F.tid); hy_short_load(sC, zT + (size_t)(HYC + c) * T, F.tid);
#pragma unroll 1
    for (;;) {
        const int lane = F.lane, w = F.wave, n = lane & 15, bb = n & 7, hh = n >> 3, rq = lane >> 4;
        __syncthreads();
        for (int p = F.tid; p < 8 * 272; p += 512) { const int b = p / 272, q = p - b * 272; const int el = (q < 128) ? 2 * q : (HY_UP + SEQ + 2 * (q - 128)); *(LAS unsigned*)(UB + (size_t)(b * HY_UR + el) * 2) = 0u; }
        { const int ch = c; hy_short_store(UB, HY_UR, HY_UP, sA, cw[ch], cw[1536 + ch], cw[3072 + ch], cbp[ch], F.tid); }
        hy_filt_build(F, fB);
        { const int ch = HYC + c; hy_short_store(XB, SEQ, 0, sC, cw[ch], cw[1536 + ch], cw[3072 + ch], cbp[ch], F.tid); }
        hy_filt_load(fF, Hf, 1, c, F.tid); hy_short_load(sG, zT + (size_t)(2 * HYC + c) * T, F.tid);
        __syncthreads();
        f32x4 C[8];
        hy_conv_mfma(F, C);
        __syncthreads();
        {   const float sk = skip[c];
#pragma unroll
            for (int i = 0; i < 8; ++i) {
                const int t0 = 32 * (8 * w + i) + 16 * hh + 4 * rq;
                LAS v2u* up = (LAS v2u*)(UB + (size_t)(bb * HY_UR + HY_UP + t0) * 2);
                const v2u uu = *up; const v2u xx = *(const LAS v2u*)(XB + (size_t)(bb * SEQ + t0) * 2);
                v2u o;
                o.x = pk2(bflo(xx.x) * (C[i][0] + bflo(uu.x) * sk), bfhi(xx.x) * (C[i][1] + bfhi(uu.x) * sk));
                o.y = pk2(bflo(xx.y) * (C[i][2] + bflo(uu.y) * sk), bfhi(xx.y) * (C[i][3] + bfhi(uu.y) * sk));
                *up = o;
            }
        }
        __syncthreads();
        hy_filt_build(F, fF);
        { const int ch = 2 * HYC + c; hy_short_store(XB, SEQ, 0, sG, cw[ch], cw[1536 + ch], cw[3072 + ch], cbp[ch], F.tid); }
        const int cn = c + F.G; const bool more = cn < HYC;
        if (more) { hy_short_load(sA, zT + (size_t)cn * T, F.tid); hy_filt_load(fB, Hf, 0, cn, F.tid); hy_short_load(sC, zT + (size_t)(HYC + cn) * T, F.tid); }
        __syncthreads();
        hy_conv_mfma(F, C);
        {   const float sk = skip[HYC + c];
#pragma unroll
            for (int i = 0; i < 8; ++i) {
                const int t0 = 32 * (8 * w + i) + 16 * hh + 4 * rq;
                const v2u uu = *(const LAS v2u*)(UB + (size_t)(bb * HY_UR + HY_UP + t0) * 2); const v2u xx = *(const LAS v2u*)(XB + (size_t)(bb * SEQ + t0) * 2);
                v2u o;
                o.x = pk2(bflo(xx.x) * (C[i][0] + bflo(uu.x) * sk), bfhi(xx.x) * (C[i][1] + bfhi(uu.x) * sk));
                o.y = pk2(bflo(xx.y) * (C[i][2] + bflo(uu.y) * sk), bfhi(xx.y) * (C[i][3] + bfhi(uu.y) * sk));
                *(v2u*)(yT + (size_t)c * T + bb * SEQ + t0) = o;
            }
        }
        if (!more) break;
        c = cn;
    }
}
__device__ __forceinline__ void hy_transpose_tile(Frame& F, int tile) {
    const bf16* yT = (const bf16*)(F.ws + WS_YT); bf16* mix = (bf16*)(F.ws + WS_MIX0);
    LAS unsigned* scr = (LAS unsigned*)(F.lds + F.wave * (64 * 36 * 4));
    const int lane = F.lane, ct = tile & 7, tt = tile >> 3, c0 = 64 * ct, tok0 = 64 * tt;
    const int rr = lane >> 3, ch = lane & 7;
    v4u raw[8];
#pragma unroll
    for (int i = 0; i < 8; ++i) raw[i] = __builtin_nontemporal_load((const v4u*)(yT + (size_t)(c0 + 8 * i + rr) * T + tok0 + 8 * ch));
#pragma unroll
    for (int i = 0; i < 8; ++i) {
        v4u o; o.x = __shfl_xor(raw[i].x, 8); o.y = __shfl_xor(raw[i].y, 8); o.z = __shfl_xor(raw[i].z, 8); o.w = __shfl_xor(raw[i].w, 8);
        const bool odd = rr & 1;
        const unsigned a0 = odd ? o.z : raw[i].x, a1 = odd ? o.w : raw[i].y;
        const unsigned b0 = odd ? raw[i].z : o.x, b1 = odd ? raw[i].w : o.y;
        const int cp = (8 * i + (rr & ~1)) >> 1;
        const int tb = 8 * ch + (odd ? 4 : 0);
        scr[(tb + 0) * 36 + cp] = (a0 & 0xffffu) | (b0 << 16);
        scr[(tb + 1) * 36 + cp] = (a0 >> 16) | (b0 & 0xffff0000u);
        scr[(tb + 2) * 36 + cp] = (a1 & 0xffffu) | (b1 << 16);
        scr[(tb + 3) * 36 + cp] = (a1 >> 16) | (b1 & 0xffff0000u);
    }
    LDS_WAIT(); asm volatile("" ::: "memory");
#pragma unroll
    for (int i = 0; i < 8; ++i) { const int tk = 8 * i + rr; const v4u w = *(const LAS v4u*)(scr + tk * 36 + 4 * ch);
        *(v4u*)(mix + (size_t)(tok0 + tk) * D + c0 + 8 * ch) = w; }
    LDS_WAIT(); asm volatile("" ::: "memory");
}

constexpr int AT_KSTR = 136, AT_VSTR = 144;
template <int OFF> __device__ __forceinline__ v2u ds_tr16(unsigned addr) { v2u r; asm volatile("ds_read_b64_tr_b16 %0, %1 offset:%2" : "=v"(r) : "v"(addr), "n"(OFF)); return r; }
template <int NT, int DT, int I = 0>
__device__ __forceinline__ void pv_issue(unsigned vb, unsigned vb2, v2u (&t)[NT]) {
    if constexpr (I < NT) {
        constexpr int off = (I >> 1) * 32 * AT_VSTR * 2 + (I & 1) * 16 * AT_VSTR * 2 + 32 * DT;
        if constexpr (off < 65536) t[I] = ds_tr16<off>(vb); else t[I] = ds_tr16<off - 32768>(vb2);
        pv_issue<NT, DT, I + 1>(vb, vb2, t);
    }
}
template <int N> __device__ __forceinline__ void lgkm_wait() { asm volatile("s_waitcnt lgkmcnt(%0)" :: "n"(N)); }
template <int NT, bool DIL>
__device__ __forceinline__ void attn_wave16(const LAS unsigned char* Ks, const LAS unsigned char* Vs, int k0, const bf16* qrow, const LAS float* bt, int dil, int relbase, int lbase, int L,
                                            bf16* orow, float* lse_out, int lane) {
    const int r = lane & 15, rq = lane >> 4;
    bf16x8_t Qf[4];
    {
        v4u raw[4]; float ss = 0.f;
#pragma unroll
        for (int st = 0; st < 4; ++st) { raw[st] = *(const v4u*)(qrow + 32 * st + 8 * rq);
            const float a0 = bflo(raw[st].x), a1 = bfhi(raw[st].x), a2 = bflo(raw[st].y), a3 = bfhi(raw[st].y), a4 = bflo(raw[st].z), a5 = bfhi(raw[st].z), a6 = bflo(raw[st].w), a7 = bfhi(raw[st].w);
            ss += (a0 * a0 + a1 * a1) + (a2 * a2 + a3 * a3) + (a4 * a4 + a5 * a5) + (a6 * a6 + a7 * a7); }
        ss += __shfl_xor(ss, 16); ss += __shfl_xor(ss, 32);
        const float sc = 0.08838834764831845f / sqrtf(ss * (1.f / 128.f) + EPS);
#pragma unroll
        for (int st = 0; st < 4; ++st) { v4u w;
            w.x = pk2(bflo(raw[st].x) * sc, bfhi(raw[st].x) * sc); w.y = pk2(bflo(raw[st].y) * sc, bfhi(raw[st].y) * sc);
            w.z = pk2(bflo(raw[st].z) * sc, bfhi(raw[st].z) * sc); w.w = pk2(bflo(raw[st].w) * sc, bfhi(raw[st].w) * sc);
            Qf[st] = __builtin_bit_cast(bf16x8_t, w); }
    }
    float bv[DIL ? NT : 1][4];
    if (DIL) {
#pragma unroll
        for (int kt = 0; kt < NT; ++kt)
#pragma unroll
            for (int g = 0; g < 4; ++g) bv[kt][g] = bt[relbase + 16 * kt + g + 128];
    }
    f32x4 S[NT];
    const LAS unsigned char* kb = Ks + (size_t)(k0 + r) * (AT_KSTR * 2) + 16 * rq;
    bf16x8_t Af[2][4];
#pragma unroll
    for (int st = 0; st < 4; ++st) Af[0][st] = *(const LAS bf16x8_t*)(kb + 64 * st);
#pragma unroll
    for (int kt = 0; kt < NT; ++kt) {
        if (kt + 1 < NT) {
#pragma unroll
            for (int st = 0; st < 4; ++st) Af[(kt + 1) & 1][st] = *(const LAS bf16x8_t*)(kb + (kt + 1) * 16 * (AT_KSTR * 2) + 64 * st);
        }
        f32x4 acc = (f32x4){0.f, 0.f, 0.f, 0.f};
#pragma unroll
        for (int st = 0; st < 4; ++st) acc = __builtin_amdgcn_mfma_f32_16x16x32_bf16(Af[kt & 1][st], Qf[st], acc, 0, 0, 0);
        S[kt] = acc;
        asm volatile("" ::: "memory");
    }
    float mx = -3.0e38f;
#pragma unroll
    for (int kt = 0; kt < NT; ++kt)
#pragma unroll
        for (int g = 0; g < 4; ++g) {
            float s = S[kt][g];
            if (DIL) { const int lk = lbase + 16 * kt + g; const bool ok = (lk >= 0) && (lk < L);
                s = ok ? s + bv[kt][g] : -3.0e38f; S[kt][g] = s; }
            mx = fmaxf(mx, s);
        }
    mx = fmaxf(mx, __shfl_xor(mx, 16)); mx = fmaxf(mx, __shfl_xor(mx, 32));
    float z = 0.f;
#pragma unroll
    for (int kt = 0; kt < NT; ++kt)
#pragma unroll
        for (int g = 0; g < 4; ++g) { const float p = __expf(S[kt][g] - mx); S[kt][g] = p; z += p; }
    z += __shfl_xor(z, 16); z += __shfl_xor(z, 32);
    const float iz = 1.0f / z;
    bf16x8_t Pf[NT / 2];
#pragma unroll
    for (int ks = 0; ks < NT / 2; ++ks) { v4u w; w.x = pk2(S[2 * ks][0], S[2 * ks][1]); w.y = pk2(S[2 * ks][2], S[2 * ks][3]); w.z = pk2(S[2 * ks + 1][0], S[2 * ks + 1][1]); w.w = pk2(S[2 * ks + 1][2], S[2 * ks + 1][3]);
        Pf[ks] = __builtin_bit_cast(bf16x8_t, w); }
    const unsigned vb = (unsigned)(size_t)Vs + (unsigned)(k0 + 4 * rq + (r >> 2)) * (AT_VSTR * 2) + 8 * (lane & 3), vb2 = vb + 32768;
    constexpr int WN = NT < 15 ? NT : 15;
    v2u Vt[2][NT];
    pv_issue<NT, 0>(vb, vb2, Vt[0]);
#define PV_STEP(DT) { \
        if (DT + 1 < 8) { pv_issue<NT, (DT + 1) & 7>(vb, vb2, Vt[(DT + 1) & 1]); lgkm_wait<WN>(); } else lgkm_wait<0>(); \
        _Pragma("unroll") for (int i = 0; i < NT; ++i) asm volatile("" : "+v"(Vt[DT & 1][i])); \
        f32x4 o = (f32x4){0.f, 0.f, 0.f, 0.f}; \
        _Pragma("unroll") for (int ks = 0; ks < NT / 2; ++ks) { const v2u lo = Vt[DT & 1][2 * ks], hi = Vt[DT & 1][2 * ks + 1]; \
            o = __builtin_amdgcn_mfma_f32_16x16x32_bf16(__builtin_bit_cast(bf16x8_t, ((v4u){lo.x, lo.y, hi.x, hi.y})), Pf[ks], o, 0, 0, 0); } \
        v2u ow; ow.x = pk2(o[0] * iz, o[1] * iz); ow.y = pk2(o[2] * iz, o[3] * iz); \
        *(v2u*)(orow + 16 * DT + 4 * rq) = ow; }
    PV_STEP(0) PV_STEP(1) PV_STEP(2) PV_STEP(3) PV_STEP(4) PV_STEP(5) PV_STEP(6) PV_STEP(7)
#undef PV_STEP
    if (DIL) { if (rq == 0) *lse_out = mx + logf(z); }
}
template <int NB, int BS, class RowFn>
__device__ __forceinline__ void attn_stage_k(LAS unsigned char* Ks, int nk, const float* qg, const float* kg, const bf16* kbase, RowFn rowoff, int wave, int lane) {
    const int rr = lane >> 4, cc = lane & 15;
    float gf[8];
    { const f32x4 a0 = *(const f32x4*)(qg + 8 * cc), a1 = *(const f32x4*)(qg + 8 * cc + 4), b0 = *(const f32x4*)(kg + 8 * cc), b1 = *(const f32x4*)(kg + 8 * cc + 4);
      gf[0] = a0.x * b0.x; gf[1] = a0.y * b0.y; gf[2] = a0.z * b0.z; gf[3] = a0.w * b0.w; gf[4] = a1.x * b1.x; gf[5] = a1.y * b1.y; gf[6] = a1.z * b1.z; gf[7] = a1.w * b1.w; }
#pragma unroll 1
    for (int bt = 0; bt < NB; ++bt) {
        v4u raw[BS];
#pragma unroll
        for (int i = 0; i < BS; ++i) { const int j = ((bt * BS + i) * 8 + wave) * 4 + rr; const long off = (j < nk) ? rowoff(j) : -1;
            raw[i] = *(const v4u*)(kbase + (off < 0 ? 0 : off) + 8 * cc); if (off < 0) raw[i] = (v4u){0u, 0u, 0u, 0u}; }
#pragma unroll
        for (int i = 0; i < BS; ++i) { const int j = ((bt * BS + i) * 8 + wave) * 4 + rr;
            const float k0 = bflo(raw[i].x), k1 = bfhi(raw[i].x), k2 = bflo(raw[i].y), k3 = bfhi(raw[i].y), k4 = bflo(raw[i].z), k5 = bfhi(raw[i].z), k6 = bflo(raw[i].w), k7 = bfhi(raw[i].w);
            float ss = (k0 * k0 + k1 * k1) + (k2 * k2 + k3 * k3) + (k4 * k4 + k5 * k5) + (k6 * k6 + k7 * k7);
            ss += __shfl_xor(ss, 1); ss += __shfl_xor(ss, 2); ss += __shfl_xor(ss, 4); ss += __shfl_xor(ss, 8);
            const float sc = 1.0f / sqrtf(ss * (1.f / 128.f) + EPS);
            v4u w; w.x = pk2(k0 * sc * gf[0], k1 * sc * gf[1]); w.y = pk2(k2 * sc * gf[2], k3 * sc * gf[3]); w.z = pk2(k4 * sc * gf[4], k5 * sc * gf[5]); w.w = pk2(k6 * sc * gf[6], k7 * sc * gf[7]);
            if (j < nk) *(LAS v4u*)(Ks + (size_t)j * (AT_KSTR * 2) + 16 * cc) = w; }
    }
}
template <int NB, int BS, class RowFn>
__device__ __forceinline__ void attn_stage_v(LAS unsigned char* Vs, int nk, const bf16* vbase, RowFn rowoff, int wave, int lane) {
    const int rr = lane >> 4, cc = lane & 15;
#pragma unroll 1
    for (int bt = 0; bt < NB; ++bt) {
        v4u raw[BS];
#pragma unroll
        for (int i = 0; i < BS; ++i) { const int j = ((bt * BS + i) * 8 + wave) * 4 + rr; const long off = (j < nk) ? rowoff(j) : -1;
            raw[i] = *(const v4u*)(vbase + (off < 0 ? 0 : off) + 8 * cc); if (off < 0) raw[i] = (v4u){0u, 0u, 0u, 0u}; }
#pragma unroll
        for (int i = 0; i < BS; ++i) { const int j = ((bt * BS + i) * 8 + wave) * 4 + rr; if (j < nk) *(LAS v4u*)(Vs + (size_t)j * (AT_VSTR * 2) + 16 * cc) = raw[i]; }
    }
}

constexpr int XA_OFF_V = 256 * AT_KSTR * 2;
static_assert(XA_OFF_V + 256 * AT_VSTR * 2 <= SCR_BYTES, "cross LDS");
__device__ __forceinline__ void cross_unit(Frame& F, const bf16* xq, const bf16* kv, const float* qg, const float* kg, bf16* mix, int unit) {
    int lane = (int)__builtin_amdgcn_mbcnt_hi(~0u, __builtin_amdgcn_mbcnt_lo(~0u, 0u)); asm volatile("" : "+v"(lane)); const int tid = F.wave * 64 + lane;
    const int b = unit >> 5, h = (unit >> 3) & 3, qc = unit & 7;
    LAS unsigned char* Ks = F.lds; LAS unsigned char* Vs = F.lds + XA_OFF_V;
    const bf16* kbase = kv + (size_t)(b * MEML) * 1024 + h * 128;
    __syncthreads();
    attn_stage_k<2, 4>(Ks, MEML, qg, kg, kbase, [=](int j) { return (long)j * 1024; }, F.wave, lane);
    attn_stage_v<2, 4>(Vs, MEML, kbase + 512, [=](int j) { return (long)j * 1024; }, F.wave, lane);
    __syncthreads();
#pragma unroll 1
    for (int a = F.wave; a < 16; a += NWAVES) {
        const int token = b * SEQ + qc * 256 + 16 * a + (lane & 15);
        attn_wave16<16, false>(Ks, Vs, 0, xq + (size_t)token * 512 + h * 128, nullptr, 1, 0, 0, 0, mix + (size_t)token * D + 512 + h * 128, nullptr, lane);
    }
}
constexpr int DA_NK = 272, DA_OFF_V = DA_NK * AT_KSTR * 2, DA_OFF_BT = DA_OFF_V + DA_NK * AT_VSTR * 2;
static_assert(DA_OFF_BT + 320 * 4 <= SCR_BYTES, "dilated LDS");
__device__ __forceinline__ void dil_unit(Frame& F, const Args& a, int unit) {
    const int bh = unit / 48, sub = unit % 48, b = bh >> 2, h = bh & 3, g = sub >> 4, w16 = sub & 15;
    const int dil = (g == 0) ? 1 : (g == 1 ? 4 : 16), L = SEQ / dil, nch = L / 128;
    const int r = w16 / nch, n128 = w16 % nch;
    int lane = (int)__builtin_amdgcn_mbcnt_hi(~0u, __builtin_amdgcn_mbcnt_lo(~0u, 0u)); asm volatile("" : "+v"(lane)); const int tid = F.wave * 64 + lane;
    const bf16* qkv = (const bf16*)(F.ws + WS_QKV1);
    float* lse = (float*)(F.ws + WS_LSE);
    LAS unsigned char* Ks = F.lds; LAS unsigned char* Vs = F.lds + DA_OFF_V; LAS float* bt = (LAS float*)(F.lds + DA_OFF_BT);
    const int lk0 = 128 * n128 - 64;
    const bf16* base = qkv + (size_t)(b * SEQ + r) * NQKV + g * 512 + h * 128;
    const size_t lstep = (size_t)dil * NQKV;
    __syncthreads();
    if (tid < 320) { const int rel = tid - 128; bt[tid] = (rel >= -64 && rel <= 64) ? a.in[I_RELB][rel_bucket_dev(rel * dil) * 12 + g * 4 + h] : -3.0e38f; }
    attn_stage_k<3, 3>(Ks, DA_NK, a.in[I_ATQN], a.in[I_ATKN], base + ATW, [=](int j) { const int lk = lk0 + j; return (lk >= 0 && lk < L) ? (long)lk * (long)lstep : -1L; }, F.wave, lane);
    attn_stage_v<3, 3>(Vs, DA_NK, base + 2 * ATW, [=](int j) { const int lk = lk0 + j; return (lk >= 0 && lk < L) ? (long)lk * (long)lstep : -1L; }, F.wave, lane);
    __syncthreads();
    {
        const int aq = F.wave, i = 16 * aq + (lane & 15), lq = 128 * n128 + i, token = b * SEQ + lq * dil + r, k0 = 16 * aq, rq = lane >> 4;
        attn_wave16<10, true>(Ks, Vs, k0, base + (size_t)lq * lstep, bt, dil, k0 + 4 * rq - 64 - i, lk0 + k0 + 4 * rq, L,
                              (g == 0) ? (bf16*)(F.ws + WS_MIX1) + (size_t)token * D + h * 128 : (bf16*)(F.ws + WS_OG12) + ((size_t)(g - 1) * T + token) * 512 + h * 128,
                              lse + ((size_t)g * T + token) * 4 + h, lane);
    }
}
__device__ __forceinline__ void combine_phase(Frame& F, const Args& a) {
    moe_layout(F);
    const int gw = F.bid * NWAVES + F.wave, NGW = F.G * NWAVES, lane = F.lane;
    const int* toke = (const int*)(F.ws + WS_TOKE); const int* tokr = (const int*)(F.ws + WS_TOKR); const float* tokg = (const float*)(F.ws + WS_TOKG);
    const bf16* y = (const bf16*)(F.ws + WS_XS); const bf16* y2 = (const bf16*)(F.ws + WS_Y2);
    for (int token = gw; token < T; token += NGW) {
        const int e0 = toke[token * 2], e1 = toke[token * 2 + 1];
        const int s0 = ml_ps(F, e0) + tokr[token * 2], s1 = ml_ps(F, e1) + tokr[token * 2 + 1];
        const float g0 = tokg[token * 2], g1 = tokg[token * 2 + 1];
        f32x4* xo = (f32x4*)(a.out + (size_t)token * D); const v2u* xi = (const v2u*)((const bf16*)a.out + (size_t)token * 2048 + 1024);
        const v2u* y0 = (const v2u*)(y + (size_t)s0 * D); const v2u* y1 = (const v2u*)(y + (size_t)s1 * D);
        v2u xw[4], p0[4], p1[4];
#pragma unroll
        for (int j = 0; j < 4; ++j) { const int q = lane + 64 * j; xw[j] = __builtin_nontemporal_load(xi + q); p0[j] = __builtin_nontemporal_load(y0 + q); p1[j] = __builtin_nontemporal_load(y1 + q); }
        f32x4 r[4];
#pragma unroll
        for (int j = 0; j < 4; ++j) {
            const int q = lane + 64 * j;
            f32x4 x = (f32x4){bflo(xw[j].x), bfhi(xw[j].x), bflo(xw[j].y), bfhi(xw[j].y)};
            f32x4 a0 = (f32x4){bflo(p0[j].x), bfhi(p0[j].x), bflo(p0[j].y), bfhi(p0[j].y)}, a1 = (f32x4){bflo(p1[j].x), bfhi(p1[j].x), bflo(p1[j].y), bfhi(p1[j].y)};
            if (s0 >= 2 * T) { const v2u t = ((const v2u*)(y2 + (size_t)(s0 - 2 * T) * D))[q]; a0 = a0 + (f32x4){bflo(t.x), bfhi(t.x), bflo(t.y), bfhi(t.y)}; }
            if (s1 >= 2 * T) { const v2u t = ((const v2u*)(y2 + (size_t)(s1 - 2 * T) * D))[q]; a1 = a1 + (f32x4){bflo(t.x), bfhi(t.x), bflo(t.y), bfhi(t.y)}; }
            r[j] = x + g0 * a0 + g1 * a1;
        }
        asm volatile("s_waitcnt vmcnt(0)" ::: "memory");
#pragma unroll
        for (int j = 0; j < 4; ++j) __builtin_nontemporal_store(r[j], xo + lane + 64 * j);
    }
}

constexpr int NPHASE = 15;
__global__ void __launch_bounds__(NWAVES * 64, 2) mega_fwd(Args args) {
    extern __shared__ __attribute__((aligned(16))) unsigned char lds_raw[];
    Frame F;
    F.lds = (LAS unsigned char*)lds_raw; F.ws = args.ws;
    F.wave = __builtin_amdgcn_readfirstlane((int)threadIdx.x >> 6); F.G = gridDim.x; F.bid = blockIdx.x;
#define PH_BEGIN() do { int l_ = (int)__builtin_amdgcn_mbcnt_hi(~0u, __builtin_amdgcn_mbcnt_lo(~0u, 0u)); asm volatile("" : "+v"(l_)); F.lane = l_; F.tid = F.wave * 64 + l_; } while (0)
    PH_BEGIN();
    unsigned char* ws = args.ws;
    volatile LAS unsigned* MISC = (volatile LAS unsigned*)(F.lds + MISC_OFF);
    for (int u = F.tid; u < (LDS_BYTES - MISC_OFF) / 4; u += NWAVES * 64) MISC[u] = 0u;
    __syncthreads();
    const int lo = args.ph_lo, hi = args.ph_hi;
    const bool use_bar = (hi - lo) > 1;
    XcdBarrier bar; bar.bar = (unsigned*)(ws + WS_CTL) + CW_BAR + args.bslot * XCD_BAR_WORDS; bar.x = 0; bar.st = nullptr;
    if (use_bar) bar = xcd_barrier_post((unsigned*)(ws + WS_CTL) + CW_BAR + args.bslot * XCD_BAR_WORDS, MISC + 8, F.tid);
#define IN(k) (lo <= (k) && (k) < hi)
#define SEAM(k) do { if (IN(k) && IN((k) + 1)) { PH_BEGIN(); xcd_barrier(bar, F.tid); } } while (0)
    const int gw = F.bid * NWAVES + F.wave, NGW = F.G * NWAVES;
    LAS unsigned char* ring = F.lds;

    if (IN(0)) { PH_BEGIN(); p0_prologue(F, args); }
    SEAM(0);
    if (IN(1)) { PH_BEGIN();
        {   pg8::Gemm g{(const bf16*)(ws + WS_WIN0), (const bf16*)(ws + WS_XB), D, D, D, 0};
            pg8::StaticOrder S; S.init(ATW / 256, T / 256, F.G, F.bid);
            EpiB<3> E{(bf16*)(ws + WS_ZT), T, (const float*)(ws + WS_RSTD0), 1 << 30, nullptr, 0, nullptr, 1.0f};
            pg8::gemm_phase<EpiB<3>, pg8::StaticOrder, true>(ring, g, S, E, F.wave); }
        {   pg8::Gemm g{(const bf16*)(ws + WS_XB), (const bf16*)(ws + WS_WIN0) + (size_t)ATW * D, D, D, D, 0};
            pg8::StaticOrder S; S.init(T / 256, 2, F.G, (F.bid + 128) % F.G);
            EpiB<1> E{(bf16*)(ws + WS_XQ0), 512, (const float*)(ws + WS_RSTD0), 1 << 30, nullptr, 0, nullptr, 1.0f};
            pg8::gemm_phase<EpiB<1>, pg8::StaticOrder, true>(ring, g, S, E, F.wave); }
        {   pg8::Gemm g{(const bf16*)(ws + WS_MN), (const bf16*)(ws + WS_WKV), D, D, D, (size_t)D * D * 2};
            pg8::MoeOrder S; S.init(2 * TM / 256, 4, F.G, F.bid); S.t0 = TM / 256; S.t1 = S.t2 = S.t3 = S.t4 = S.t5 = S.t6 = 1 << 30; S.lay = nullptr; S.list = nullptr;
            EpiB<0> E{(bf16*)(ws + WS_KV), D, nullptr, 1 << 30, nullptr, 0, nullptr, 1.0f};
            pg8::gemm_phase<EpiB<0>, pg8::MoeOrder, true>(ring, g, S, E, F.wave); }
        if (F.G == 256 && F.bid >= 64) { PH_BEGIN(); moe_convert(F, args, 0, MOE_P1_HI, (F.bid - 64) * NWAVES + F.wave, 192 * NWAVES); }
    }
    SEAM(1);
    if (IN(2)) { PH_BEGIN();
        hyena_units(F, args);
        for (int u = F.bid; u < 256; u += F.G)
            cross_unit(F, (const bf16*)(ws + WS_XQ0), (const bf16*)(ws + WS_KV), args.in[I_XQN], args.in[I_XKN], (bf16*)(ws + WS_MIX0), u);
    }
    SEAM(2);
    if (IN(3)) { PH_BEGIN(); for (int t = gw; t < 2048; t += NGW) hy_transpose_tile(F, t); }
    SEAM(3);
    if (IN(4)) { PH_BEGIN();
        pg8::Gemm g{(const bf16*)(ws + WS_MIX0), (const bf16*)(ws + WS_WO), D, D, D, 0};
        pg8::StaticOrder S; S.init(T / 256, 4, F.G, F.bid);
        EpiRes<false, true> E{nullptr, (const bf16*)(ws + WS_XB), D, (bf16*)(ws + WS_XB), D, (float*)(ws + WS_SSQ16)};
        pg8::gemm_phase<EpiRes<false, true>, pg8::StaticOrder, true>(ring, g, S, E, F.wave);
    }
    SEAM(4);
    if (IN(5)) { PH_BEGIN();
        pg8::Gemm g{(const bf16*)(ws + WS_XB), (const bf16*)(ws + WS_WGU0), D, D, D, 0};
        pg8::StaticOrder S; S.init(T / 256, NGU / 256, F.G, F.bid);
        fill_rstd_table(F.lds, S, (const float*)(ws + WS_SSQ16), F.tid);
        EpiSwiglu<4> E{(bf16*)(ws + WS_HID0), FF, nullptr, (const LAS float*)(F.lds + RSL_OFF), 1.0f};
        pg8::gemm_phase<EpiSwiglu<4>, pg8::StaticOrder, true>(ring, g, S, E, F.wave);
        if (F.G == 256) { PH_BEGIN();
            if (F.bid >= 128) moe_convert(F, args, MOE_P1_HI, MOE_P5_MID, (F.bid - 128) * NWAVES + F.wave, 128 * NWAVES);
            moe_convert(F, args, MOE_P5_MID, MOE_P5_HI, F.bid * NWAVES + F.wave, 256 * NWAVES); }
    }
    SEAM(5);
    if (IN(6)) { PH_BEGIN();
        pg8::Gemm g{(const bf16*)(ws + WS_HID0), (const bf16*)(ws + WS_WD0), FF, FF, FF, 0};
        pg8::StaticOrder S; S.init(T / 256, 4, F.G, F.bid);
        EpiRes<false, true> E{nullptr, (const bf16*)(ws + WS_XB), D, (bf16*)(ws + WS_XB), D, (float*)(ws + WS_SSQ16)};
        pg8::gemm_phase<EpiRes<false, true>, pg8::StaticOrder, true>(ring, g, S, E, F.wave);
    }
    SEAM(6);
    if (IN(7)) { PH_BEGIN();
        pg8::Gemm g{(const bf16*)(ws + WS_XB), (const bf16*)(ws + WS_WIN1), D, D, D, 0};
        pg8::StaticOrder S; S.init(T / 256, NQ1 / 256, F.G, F.bid);
        fill_rstd_table(F.lds, S, (const float*)(ws + WS_SSQ16), F.tid);
        EpiB<4> E{(bf16*)(ws + WS_QKV1), NQKV, nullptr, NQKV / 256, (bf16*)(ws + WS_XQ1), 512, (const LAS float*)(F.lds + RSL_OFF), 1.0f};
        pg8::gemm_phase<EpiB<4>, pg8::StaticOrder, true>(ring, g, S, E, F.wave);
    }
    SEAM(7);
    if (IN(8)) { PH_BEGIN();
        for (int u = F.bid; u < NB * 4 * 48; u += F.G) dil_unit(F, args, u);
        for (int u = F.bid; u < 256; u += F.G)
            cross_unit(F, (const bf16*)(ws + WS_XQ1), (const bf16*)(ws + WS_KV) + (size_t)TM * D, args.in[I_XQN] + 128, args.in[I_XKN] + 128, (bf16*)(ws + WS_MIX1), u);
    }
    SEAM(8);
    if (IN(9)) { PH_BEGIN(); for (int t = gw; t < T; t += NGW) merge_token(F, t); }
    SEAM(9);
    if (IN(10)) { PH_BEGIN();
        pg8::Gemm g{(const bf16*)(ws + WS_MIX1), (const bf16*)(ws + WS_WO) + (size_t)D * D, D, D, D, 0};
        pg8::StaticOrder S; S.init(T / 256, 4, F.G, F.bid);
        EpiRes<false, false> E{nullptr, (const bf16*)(ws + WS_XB), D, (bf16*)args.out + 1024, 2048, nullptr};
        pg8::gemm_phase<EpiRes<false, false>, pg8::StaticOrder, true>(ring, g, S, E, F.wave);
    }
    SEAM(10);
    if (IN(11)) { PH_BEGIN(); for (int blk = F.bid; blk < T / 64; blk += F.G) route_block(F, args, blk); }
    SEAM(11);
    if (IN(12)) { PH_BEGIN();
        moe_layout(F);
        pg8::Gemm g{(const bf16*)(ws + WS_XB3), (const bf16*)(ws + WS_WGU1), D / 2, D / 2, D / 2, (size_t)NGU * D};
        pg8::MoeOrder S; S.init(ml_total(F) / 256, NGU / 256, F.G, F.bid); S.lay = (const volatile LAS int*)(F.lds + MISC_OFF); S.list = (const int*)(ws + WS_LIST);
        S.t0 = ml_ps(F, 1) / 256; S.t1 = ml_ps(F, 2) / 256; S.t2 = ml_ps(F, 3) / 256; S.t3 = ml_ps(F, 4) / 256; S.t4 = ml_ps(F, 5) / 256; S.t5 = ml_ps(F, 6) / 256; S.t6 = ml_ps(F, 7) / 256;
        EpiSwiglu<5, true> E{(bf16*)(ws + WS_HID1), FF, nullptr, nullptr, 1.0f / MOE_WGU_SCALE};
        pg8::gemm_phase<EpiSwiglu<5, true>, pg8::MoeOrder, true, true, true>(ring, g, S, E, F.wave);
    }
    SEAM(12);
    if (IN(13)) { PH_BEGIN();
        moe_layout(F);
        const int nMt = ml_total(F) / 256;
        const int q1 = ml_ps(F, 1) / 256, q2 = ml_ps(F, 2) / 256, q3 = ml_ps(F, 3) / 256, q4 = ml_ps(F, 4) / 256, q5 = ml_ps(F, 5) / 256, q6 = ml_ps(F, 6) / 256, q7 = ml_ps(F, 7) / 256;
        {   pg8::Gemm g{(const bf16*)(ws + WS_HID1), (const bf16*)(ws + WS_WD1), FF / 2, FF / 2, FF / 2, (size_t)D * FF};
            pg8::MoeOrder S; S.init(nMt < 128 ? nMt : 128, 4, F.G, F.bid); S.lay = nullptr; S.list = nullptr;
            S.t0 = q1; S.t1 = q2; S.t2 = q3; S.t3 = q4; S.t4 = q5; S.t5 = q6; S.t6 = q7;
            EpiB<5> E{(bf16*)(ws + WS_XS), D, nullptr, 1 << 30, nullptr, 0, nullptr, 1.0f / MOE_WD_SCALE};
            pg8::gemm_phase<EpiB<5>, pg8::MoeOrder, true, false, true>(ring, g, S, E, F.wave); }
        if (nMt > 128) {
            const int half = F.G / 2; const bool second = F.bid >= half;
            pg8::Gemm g{(const bf16*)(ws + WS_HID1), (const bf16*)(ws + WS_WD1), FF / 2, FF / 2, second ? 640 : 768, (size_t)D * FF};
            pg8::MoeTailOrder2 S; S.pm0 = 128; S.ntail = nMt - 128; S.nN = 4; S.G = second ? F.G - half : half; S.c = second ? F.bid - half : F.bid; S.koff = second ? 12 * 128 : 0;
            S.t0 = q1; S.t1 = q2; S.t2 = q3; S.t3 = q4; S.t4 = q5; S.t5 = q6; S.t6 = q7;
            EpiB<5> E{(bf16*)(ws + WS_XS), D, nullptr, 1 << 30, (bf16*)(ws + WS_Y2) - (size_t)2 * T * D, D, nullptr, 1.0f / MOE_WD_SCALE};
            pg8::gemm_phase<EpiB<5>, pg8::MoeTailOrder2, true, false, true>(ring, g, S, E, F.wave); }
    }
    SEAM(13);
    if (IN(14)) { PH_BEGIN(); combine_phase(F, args); }
#undef IN
#undef SEAM
}

#ifndef MK_ONE_LAUNCH
#define MK_ONE_LAUNCH 1
#endif
extern "C" void kernel_launch(void* const* d_in, const int* in_sizes, int n_in, void* d_out, int out_size, void* d_ws, size_t ws_size, hipStream_t stream) {
    static int grid = 0;
    if (grid == 0) {
        if (n_in != 30 || in_sizes[0] != T * D || out_size != T * D || ws_size < WS_END) {
            fprintf(stderr, "kernel_launch: unexpected problem (n_in %d, in0 %d, out %d, ws %zu, need %zu); nothing launched\n", n_in, n_in > 0 ? in_sizes[0] : -1, out_size, ws_size, (size_t)WS_END); grid = -1; return; }
        int dev = 0, cus = 0, per_cu = 0;
        if (hipGetDevice(&dev) != hipSuccess || hipDeviceGetAttribute(&cus, hipDeviceAttributeMultiprocessorCount, dev) != hipSuccess) { grid = -1; return; }
        if (hipFuncSetAttribute((const void*)mega_fwd, hipFuncAttributeMaxDynamicSharedMemorySize, LDS_BYTES) != hipSuccess) { fprintf(stderr, "kernel_launch: hipFuncSetAttribute failed\n"); grid = -1; return; }
        if (hipOccupancyMaxActiveBlocksPerMultiprocessor(&per_cu, (const void*)mega_fwd, NWAVES * 64, LDS_BYTES) != hipSuccess || per_cu < 1)
            fprintf(stderr, "kernel_launch: note: occupancy query reports %d workgroups per CU\n", per_cu);
        (void)hipGetLastError();
        grid = cus;
    }
    if (grid < 0) return;
    if (hipMemsetAsync((char*)d_ws + WS_CTL, 0, CTL_ZERO_BYTES, stream) != hipSuccess) return;
    Args a{};
    for (int i = 0; i < 30; ++i) a.in[i] = (const float*)d_in[i];
    a.out = (float*)d_out; a.ws = (unsigned char*)d_ws;
#if defined(PROBE_PHASE)
    a.ph_lo = 0; a.ph_hi = PROBE_PHASE + 1; a.bslot = 0;
    hipLaunchKernelGGL(mega_fwd, dim3(grid), dim3(NWAVES * 64), LDS_BYTES, stream, a);
    a.ph_lo = PROBE_PHASE; a.ph_hi = NPHASE; a.bslot = 1;
    hipLaunchKernelGGL(mega_fwd, dim3(grid), dim3(NWAVES * 64), LDS_BYTES, stream, a);
#elif MK_ONE_LAUNCH
    a.ph_lo = 0; a.ph_hi = NPHASE; a.bslot = 0;
    hipLaunchKernelGGL(mega_fwd, dim3(grid), dim3(NWAVES * 64), LDS_BYTES, stream, a);
#else
    for (int p = 0; p < NPHASE; ++p) { a.ph_lo = p; a.ph_hi = p + 1; a.bslot = 0; hipLaunchKernelGGL(mega_fwd, dim3(grid), dim3(NWAVES * 64), LDS_BYTES, stream, a); }
#endif
}
```

```cpp
#include <hip/hip_runtime.h>
#include <cstdio>
#include <cstdint>

namespace pg8 {
#define PG8_LAS __attribute__((address_space(3)))
typedef unsigned short bf16_t;
typedef short bf16x8 __attribute__((ext_vector_type(8)));
typedef float f32x4 __attribute__((ext_vector_type(4)));
typedef unsigned u32x4 __attribute__((ext_vector_type(4)));
constexpr int BM = 256, BK = 64, HALF = 128, HTB = HALF * BK * 2  , STAGE_BYTES = 8 * HTB, NXCD = 8, WGM = 8;

__host__ __device__ __forceinline__ int lds_byte(int r, int c) { const int st = (r >> 4) * 2 + (c >> 5), rr = r & 15, cc = c & 31, ob = rr * 64 + cc * 2; return st * 1024 + (ob ^ (((ob >> 9) & 1) << 5)); }
__host__ __device__ __forceinline__ void stage_rc(int b, int& R, int& C) { const int st = b / 1024, sb = b % 1024, swz = sb ^ (((sb >> 9) & 1) << 5); R = (st >> 1) * 16 + swz / 64; C = (st & 1) * 32 + (swz % 64) / 2; }
__host__ __device__ __forceinline__ int perm32(int rho) { const int n = rho >> 4, i = rho & 15; return 8 * (i >> 2) + 4 * n + (i & 3); }

struct Unit { int pm, pn, e, koff, idx; };
struct Gemm { const bf16_t* A; const bf16_t* Bt; int lda, ldb, K; size_t estride; };

struct StaticOrder {
    int nM, nN, nwg, G, c;
    __device__ __forceinline__ int gather_row(const Unit&, int slot) const { return slot; }
    __host__ __device__ void init(int nM_, int nN_, int G_, int c_) { nM = nM_; nN = nN_; nwg = nM * nN; G = G_; c = c_; }
    __host__ __device__ bool next(int i, Unit& u) const {
        const long L = (long)i * G + c; if (L >= nwg) return false;
        int wgid = (int)L; { const int q = nwg / NXCD, r = nwg % NXCD, xcd = wgid % NXCD, off = wgid / NXCD; wgid = (xcd < r ? xcd * (q + 1) : r * (q + 1) + (xcd - r) * q) + off; }
        const int nig = WGM * nN, gid = wgid / nig, fm = gid * WGM, gsz = (nM - fm) < WGM ? (nM - fm) : WGM;
        u.pm = fm + ((wgid % nig) % gsz); u.pn = (wgid % nig) / gsz; u.e = 0; u.koff = 0; return true;
    }
};
struct MoeOrder : StaticOrder {
    int t0, t1, t2, t3, t4, t5, t6;
    const volatile PG8_LAS int* lay;
    const int* list;
    __device__ __forceinline__ int gather_row(const Unit& u, int slot) const { const int rank = slot - lay[40 + u.e]; return rank < lay[32 + u.e] ? list[(size_t)u.e * 16384 + rank] : 0; }
    __host__ __device__ bool next(int i, Unit& u) const {
        if (!StaticOrder::next(i, u)) return false;
        const int p = u.pm; u.e = (p >= t0) + (p >= t1) + (p >= t2) + (p >= t3) + (p >= t4) + (p >= t5) + (p >= t6); return true;
    }
};

struct MoeTailOrder {
    int pm0, ntail, nN, G, c, khalf; int t0, t1, t2, t3, t4, t5, t6;
    __device__ __forceinline__ int gather_row(const Unit&, int slot) const { return slot; }
    __device__ __forceinline__ bool next(int i, Unit& u) const {
        const int L = i * G + c; if (L >= ntail * nN * 2) return false;
        const int kh = L & 1, q = L >> 1; u.pn = q % nN; u.pm = pm0 + q / nN; u.koff = kh * khalf;
        const int p = u.pm; u.e = (p >= t0) + (p >= t1) + (p >= t2) + (p >= t3) + (p >= t4) + (p >= t5) + (p >= t6); return true;
    }
};
struct MoeTailOrder2 {
    int pm0, ntail, nN, G, c, koff; int t0, t1, t2, t3, t4, t5, t6;
    __device__ __forceinline__ int gather_row(const Unit&, int slot) const { return slot; }
    __device__ __forceinline__ bool next(int i, Unit& u) const {
        const int L = i * G + c; if (L >= ntail * nN) return false;
        u.pn = L % nN; u.pm = pm0 + L / nN; u.koff = koff;
        const int p = u.pm; u.e = (p >= t0) + (p >= t1) + (p >= t2) + (p >= t3) + (p >= t4) + (p >= t5) + (p >= t6); return true;
    }
};
__device__ __forceinline__ unsigned cvt_pk_bf16(float lo, float hi) { unsigned r; asm volatile("v_cvt_pk_bf16_f32 %0, %1, %2" : "=v"(r) : "v"(lo), "v"(hi)); return r; }

typedef int v8i __attribute__((ext_vector_type(8)));
typedef int v4i __attribute__((ext_vector_type(4)));
template <class Epi, class Sched, bool ALIGN_EPI, bool GATHER = false, bool FP8 = false>
__device__ __forceinline__ void gemm_phase(PG8_LAS unsigned char* lds, const Gemm g, const Sched& S, const Epi& E, const int wid) {
    int lane = (int)__builtin_amdgcn_mbcnt_hi(~0u, __builtin_amdgcn_mbcnt_lo(~0u, 0u)); asm volatile("" : "+v"(lane));
    const int tid = wid * 64 + lane, wr = wid >> 2, wc = wid & 3, fr = lane & 15, fq = lane >> 4;
    const int K = g.K, nt = K / BK;
    unsigned cvo[4], nvo[4], voffB[2]; int rowA[2], colA[2];
#pragma unroll
    for (int i = 0; i < 2; ++i) { int R, C; stage_rc(tid * 16 + i * 8192, R, C); const int Rb = (R & ~31) + perm32(R & 31); rowA[i] = R; colA[i] = C;
        voffB[i] = (unsigned)(Rb * g.ldb + C) * 2u; }
    const size_t kstep = (size_t)(BK * 2);
    const size_t hstepB = (size_t)HALF * g.ldb * 2;
    const size_t tstepA = GATHER ? (size_t)0 : (size_t)2 * HALF * g.lda * 2, tstepB = 2 * hstepB;
#define PG8_ROWOFFS(vo, u) do { _Pragma("unroll") for (int _h = 0; _h < 2; ++_h) _Pragma("unroll") for (int _i = 0; _i < 2; ++_i) { \
        const int _r = _h * HALF + rowA[_i]; const unsigned _row = GATHER ? (unsigned)S.gather_row(u, (u).pm * BM + _r) : (unsigned)_r; \
        (vo)[2 * _h + _i] = (_row * (unsigned)g.lda + (unsigned)colA[_i]) * 2u; } } while (0)
    const unsigned ldsw = (unsigned)wid * 1024u;
    const int aoff = lds_byte(wr * 64 + fr, fq * 8), boff = lds_byte(wc * 32 + fr, fq * 8);
#define PG8_SA(b, h) (((b) * 2 + (h)) * HTB)
#define PG8_SB(b, h) ((4 + (b) * 2 + (h)) * HTB)
#define PG8_STAGE(bufoff, gbase, voff) do { _Pragma("unroll") for (int _i = 0; _i < 2; ++_i) \
        __builtin_amdgcn_global_load_lds((const unsigned*)((const char*)(gbase) + (voff)[_i]), (PG8_LAS unsigned*)(lds + (bufoff) + ldsw + _i * 8192), 16, 0, 0); } while (0)
#define PG8_STAGEA(bufoff, gbase, vo, h) do { _Pragma("unroll") for (int _i = 0; _i < 2; ++_i) \
        __builtin_amdgcn_global_load_lds((const unsigned*)((const char*)(gbase) + (vo)[2 * (h) + _i]), (PG8_LAS unsigned*)(lds + (bufoff) + ldsw + _i * 8192), 16, 0, 0); } while (0)
#define PG8_LDA(dst, b, h) do { _Pragma("unroll") for (int m = 0; m < 4; ++m) dst[m] = __builtin_shufflevector(*(const PG8_LAS v4i*)(lds + PG8_SA(b, h) + aoff + m * 2048), *(const PG8_LAS v4i*)(lds + PG8_SA(b, h) + aoff + m * 2048 + 1024), 0, 1, 2, 3, 4, 5, 6, 7); } while (0)
#define PG8_LDB(dst, b, h) do { _Pragma("unroll") for (int n = 0; n < 2; ++n) dst[n] = __builtin_shufflevector(*(const PG8_LAS v4i*)(lds + PG8_SB(b, h) + boff + n * 2048), *(const PG8_LAS v4i*)(lds + PG8_SB(b, h) + boff + n * 2048 + 1024), 0, 1, 2, 3, 4, 5, 6, 7); } while (0)
#define PG8_HALF(x, k) __builtin_bit_cast(bf16x8, __builtin_shufflevector(x, x, 4 * (k), 4 * (k) + 1, 4 * (k) + 2, 4 * (k) + 3))
#define PG8_MMA(ai, bj, At, Bt) do { if constexpr (FP8) __builtin_amdgcn_sched_barrier(0); __builtin_amdgcn_s_setprio(1); _Pragma("unroll") for (int m = 0; m < 4; ++m) _Pragma("unroll") for (int n = 0; n < 2; ++n) { \
        if constexpr (FP8) acc[ai][bj][m][n] = __builtin_amdgcn_mfma_scale_f32_16x16x128_f8f6f4(Bt[n], At[m], acc[ai][bj][m][n], 0, 0, 0, 0x7f7f7f7f, 0, 0x7f7f7f7f); \
        else { acc[ai][bj][m][n] = __builtin_amdgcn_mfma_f32_16x16x32_bf16(PG8_HALF(Bt[n], 0), PG8_HALF(At[m], 0), acc[ai][bj][m][n], 0, 0, 0); \
               acc[ai][bj][m][n] = __builtin_amdgcn_mfma_f32_16x16x32_bf16(PG8_HALF(Bt[n], 1), PG8_HALF(At[m], 1), acc[ai][bj][m][n], 0, 0, 0); } } \
        if constexpr (FP8) { _Pragma("unroll") for (int m = 0; m < 4; ++m) _Pragma("unroll") for (int n = 0; n < 2; ++n) asm volatile("" : "+v"(acc[ai][bj][m][n])); }   \
        __builtin_amdgcn_s_setprio(0); if constexpr (FP8) __builtin_amdgcn_sched_barrier(0); } while (0)
#define PG8_WAIT_V(n) asm volatile("s_waitcnt vmcnt(" #n ")" ::: "memory")
#define PG8_WAIT_L(n) asm volatile("s_waitcnt lgkmcnt(" #n ")" ::: "memory")
#define PG8_BAR __builtin_amdgcn_s_barrier()
#define PG8_SCHED __builtin_amdgcn_sched_barrier(0)
    Unit cur, nxt; int ui = 0;
    if (!S.next(0, cur)) return;
    cur.idx = 0;
    f32x4 acc[2][2][4][2];
#pragma unroll
    for (int a = 0; a < 2; ++a)
#pragma unroll
        for (int b = 0; b < 2; ++b)
#pragma unroll
            for (int m = 0; m < 4; ++m)
#pragma unroll
                for (int n = 0; n < 2; ++n) acc[a][b][m][n] = (f32x4){0.f, 0.f, 0.f, 0.f};
    v8i At[4], B0[2], B1[2];
    const char* cA = (const char*)g.A + (size_t)cur.pm * tstepA + cur.koff; const char* cB = (const char*)g.Bt + (size_t)cur.e * g.estride + (size_t)cur.pn * tstepB + cur.koff;
    PG8_ROWOFFS(cvo, cur);
#pragma unroll
    for (int i = 0; i < 4; ++i) nvo[i] = cvo[i];
    PG8_STAGE(PG8_SB(0, 0), cB, voffB); PG8_STAGE(PG8_SB(0, 1), cB + hstepB, voffB); PG8_STAGEA(PG8_SA(0, 0), cA, cvo, 0); PG8_STAGEA(PG8_SA(0, 1), cA, cvo, 1);
    if (wr == 1) PG8_BAR;
    PG8_WAIT_V(2); PG8_BAR;
    PG8_STAGE(PG8_SB(1, 0), cB + kstep, voffB); PG8_STAGEA(PG8_SA(1, 0), cA + kstep, cvo, 0); PG8_STAGE(PG8_SB(1, 1), cB + hstepB + kstep, voffB);
    PG8_WAIT_V(6); PG8_BAR;
    for (;;) {
        const bool has_next = S.next(ui + 1, nxt); nxt.idx = ui + 1;
        const char* nA = has_next ? (const char*)g.A + (size_t)nxt.pm * tstepA + nxt.koff : cA;
        const char* nB = has_next ? (const char*)g.Bt + (size_t)nxt.e * g.estride + (size_t)nxt.pn * tstepB + nxt.koff : cB;
        if constexpr (GATHER) { if (has_next) PG8_ROWOFFS(nvo, nxt); }
        for (int t = 0; t < nt; t += 2) {
            const bool last = (t == nt - 2);
            const char* a1 = cA + (size_t)(t + 1) * kstep;
            const char* a2 = last ? nA : cA + (size_t)(t + 2) * kstep; const char* b2 = last ? nB : cB + (size_t)(t + 2) * kstep;
            const char* a3 = a2 + kstep; const char* b3 = b2 + kstep;
            unsigned vo2[4];
#pragma unroll
            for (int i = 0; i < 4; ++i) vo2[i] = (GATHER && last) ? nvo[i] : cvo[i];
            PG8_LDB(B0, 0, 0); PG8_LDB(B1, 0, 1); PG8_SCHED; PG8_LDA(At, 0, 0); PG8_STAGEA(PG8_SA(1, 1), a1, cvo, 1);
            PG8_WAIT_V(8); PG8_WAIT_L(0); PG8_BAR; PG8_MMA(0, 0, At, B0); PG8_MMA(0, 1, At, B1); PG8_BAR; PG8_SCHED;
            PG8_LDA(At, 0, 1); PG8_STAGE(PG8_SB(0, 0), b2, voffB); PG8_STAGE(PG8_SB(0, 1), b2 + hstepB, voffB); PG8_STAGEA(PG8_SA(0, 0), a2, vo2, 0);
            PG8_WAIT_V(8); PG8_WAIT_L(0); PG8_BAR; PG8_MMA(1, 0, At, B0); PG8_MMA(1, 1, At, B1); PG8_BAR; PG8_SCHED;
            PG8_LDB(B0, 1, 0); PG8_LDB(B1, 1, 1); PG8_SCHED; PG8_LDA(At, 1, 0); PG8_STAGEA(PG8_SA(0, 1), a2, vo2, 1);
            PG8_WAIT_V(8); PG8_WAIT_L(0); PG8_BAR; PG8_MMA(0, 0, At, B0); PG8_MMA(0, 1, At, B1); PG8_BAR; PG8_SCHED;
            PG8_LDA(At, 1, 1); PG8_STAGE(PG8_SB(1, 0), b3, voffB); PG8_STAGE(PG8_SB(1, 1), b3 + hstepB, voffB); PG8_STAGEA(PG8_SA(1, 0), a3, vo2, 0);
            PG8_WAIT_V(8); PG8_WAIT_L(0); PG8_BAR; PG8_MMA(1, 0, At, B0); PG8_MMA(1, 1, At, B1); PG8_BAR; PG8_SCHED;
        }
        if constexpr (ALIGN_EPI) { if (wr == 0) PG8_BAR; }
        E(acc, cur, wr, wc, fr, fq);
        if (!has_next) break;
#pragma unroll
        for (int a = 0; a < 2; ++a)
#pragma unroll
            for (int b = 0; b < 2; ++b)
#pragma unroll
                for (int m = 0; m < 4; ++m)
#pragma unroll
                    for (int n = 0; n < 2; ++n) acc[a][b][m][n] = (f32x4){0.f, 0.f, 0.f, 0.f};
        cur = nxt; cA = nA; cB = nB; ++ui;
        if constexpr (GATHER) {
#pragma unroll
            for (int i = 0; i < 4; ++i) cvo[i] = nvo[i]; }
        if constexpr (ALIGN_EPI) { if (wr == 1) PG8_BAR; }
    }
    PG8_WAIT_V(0);
    if constexpr (!ALIGN_EPI) { if (wr == 0) PG8_BAR; }
    PG8_BAR;
#undef PG8_SA
#undef PG8_SB
#undef PG8_STAGE
#undef PG8_STAGEA
#undef PG8_ROWOFFS
#undef PG8_LDA
#undef PG8_LDB
#undef PG8_MMA
#undef PG8_HALF
#undef PG8_WAIT_V
#undef PG8_WAIT_L
#undef PG8_BAR
#undef PG8_SCHED
}
}

constexpr int NB = 8, SEQ = 2048, D = 1024, T = NB * SEQ;
constexpr int MEML = 256, TM = NB * MEML;
constexpr int HYC = 512, NZ0 = 2048;
constexpr int FF = 2816, NGU = 2 * FF;
constexpr int ATW = 1536, NQKV = 3 * ATW, NQ1 = NQKV + 512;
constexpr int NE = 8, PMAX = 2 * T + NE * 256;
constexpr float EPS = 1e-6f;
constexpr float MOE_WGU_SCALE = 32.0f, MOE_WD_SCALE = 64.0f;
constexpr int NWAVES = 8;

constexpr size_t MiB = 1u << 20;
constexpr size_t WS_CTL = 0, CTL_ZERO_BYTES = 1 * MiB;
constexpr size_t WS_WGU1 = 1 * MiB;
constexpr size_t WS_WD1 = 89 * MiB;
constexpr size_t WS_SMALL = 133 * MiB;
constexpr size_t WS_RSTD0 = WS_SMALL;
constexpr size_t WS_SSQ16 = WS_SMALL + 64 * 1024;
constexpr size_t WS_LSE = WS_SSQ16 + 1 * MiB;
constexpr size_t WS_TOKE = WS_LSE + 768 * 1024;
constexpr size_t WS_TOKR = WS_TOKE + 128 * 1024;
constexpr size_t WS_TOKG = WS_TOKR + 128 * 1024;
constexpr size_t WS_RSTD3 = WS_TOKG + 128 * 1024;
constexpr size_t WS_LIST = WS_RSTD3 + 64 * 1024;
constexpr size_t WS_RSTDS = WS_LIST + 512 * 1024;
static_assert(WS_RSTDS + PMAX * 4 <= WS_SMALL + 4 * MiB, "small region");
constexpr size_t WS_WO = 137 * MiB;
constexpr size_t WS_WIN1 = 141 * MiB;
constexpr size_t WS_WKV = 151 * MiB;
constexpr size_t WS_WIN0 = 155 * MiB;
constexpr size_t WS_WGU0 = 159 * MiB;
constexpr size_t WS_WD0 = 170 * MiB;
constexpr size_t WS_KV = 176 * MiB;
constexpr size_t WS_XB = 184 * MiB;
constexpr size_t WS_YT = 336 * MiB;
constexpr size_t WS_MIX0 = 216 * MiB;
constexpr size_t WS_MN = 248 * MiB;
constexpr size_t WS_ZT = 256 * MiB;
constexpr size_t WS_XQ0 = 304 * MiB;
constexpr size_t WS_HF = 320 * MiB;
constexpr size_t WS_HID0 = 248 * MiB;
constexpr size_t WS_QKV1 = 248 * MiB;
constexpr size_t WS_XQ1 = 392 * MiB;
constexpr size_t WS_OG12 = 216 * MiB;
constexpr size_t WS_MIX1 = 141 * MiB;
constexpr size_t WS_XB3 = 137 * MiB;
constexpr size_t WS_XS = 137 * MiB;
constexpr size_t WS_HID1 = 205 * MiB;
constexpr size_t WS_Y2 = 392 * MiB;
constexpr size_t WS_END = 408 * MiB;
static_assert(WS_HID1 + (size_t)PMAX * FF * 2 <= WS_END && WS_XQ1 + (size_t)T * 512 * 2 <= WS_END && WS_XS + (size_t)PMAX * 2048 <= WS_HID1, "ws map");

constexpr int CW_CNT = 64;
constexpr int CW_BAR = 4096;

constexpr int SCR_BYTES = 155648;
constexpr int MISC_OFF = SCR_BYTES;
constexpr int LDS_BYTES = SCR_BYTES + 4096;

#define LAS __attribute__((address_space(3)))
typedef unsigned short bf16;
typedef unsigned v4u __attribute__((ext_vector_type(4)));
typedef unsigned v2u __attribute__((ext_vector_type(2)));
typedef float f32x4 __attribute__((ext_vector_type(4)));
typedef float f32x2 __attribute__((ext_vector_type(2)));
#define LDS_WAIT() asm volatile("s_waitcnt lgkmcnt(0)" ::: "memory")
__device__ __forceinline__ unsigned f2bf(float f) { unsigned u = __builtin_bit_cast(unsigned, f); return (u + 0x7fffu + ((u >> 16) & 1u)) >> 16; }
__device__ __forceinline__ unsigned pk2(float lo, float hi) { unsigned r; asm("v_cvt_pk_bf16_f32 %0, %1, %2" : "=v"(r) : "v"(lo), "v"(hi)); return r; }
__device__ __forceinline__ unsigned pk4_fp8(float a, float b, float c, float d) { unsigned w = 0u; w = __builtin_amdgcn_cvt_pk_fp8_f32(a, b, w, false); w = __builtin_amdgcn_cvt_pk_fp8_f32(c, d, w, true); return w; }
__device__ __forceinline__ float bflo(unsigned w) { return __builtin_bit_cast(float, w << 16); }
__device__ __forceinline__ float bfhi(unsigned w) { return __builtin_bit_cast(float, w & 0xffff0000u); }
__device__ __forceinline__ float bf1(bf16 b) { return __builtin_bit_cast(float, ((unsigned)b) << 16); }
__device__ __forceinline__ float wave_sum(float v) {
#pragma unroll
    for (int o = 1; o < 64; o <<= 1) v += __shfl_xor(v, o);
    return v;
}
__device__ __forceinline__ float wave_max(float v) {
#pragma unroll
    for (int o = 1; o < 64; o <<= 1) v = fmaxf(v, __shfl_xor(v, o));
    return v;
}

#define XB_TMO      128
#define XB_XCNT(j)  (256  + 64 * (j))
#define XB_XSUB(j)  (1280 + 64 * (j))
#define XB_XGEN(j)  (2304 + 64 * (j))
#define XB_TOP      3328
#define XB_TOPGEN   3392
#define XCD_BAR_WORDS 3456
#define XB_SPIN_CAP (1u << 18)

__device__ __forceinline__ unsigned xb_ld(unsigned* p)              { return __hip_atomic_load(p, __ATOMIC_RELAXED, __HIP_MEMORY_SCOPE_AGENT); }
__device__ __forceinline__ unsigned xb_add(unsigned* p, unsigned v) { return __hip_atomic_fetch_add(p, v, __ATOMIC_RELAXED, __HIP_MEMORY_SCOPE_AGENT); }
__device__ __forceinline__ unsigned xb_xcc_id() { return (unsigned)__builtin_amdgcn_s_getreg((3 << 11) | 20) & 0xFu; }
#define XB_SPIN(cond, bar) do { unsigned _sp = 0; while (cond) { __builtin_amdgcn_s_sleep(1); \
    if ((++_sp & 255u) == 0u) { if (xb_ld(&(bar)[XB_TMO])) break; if (_sp > XB_SPIN_CAP) { atomicAdd(&(bar)[XB_TMO], 1u); break; } } } } while (0)

struct XcdBarrier {
    unsigned* bar; unsigned x;
    volatile LAS unsigned* st;
};
__device__ __forceinline__ XcdBarrier xcd_barrier_post(unsigned* bar, volatile LAS unsigned* st, int tid) {
    XcdBarrier b; b.bar = bar; b.x = xb_xcc_id(); b.st = st;
    if (tid == 0) (void)xb_add(&bar[XB_XCNT(b.x)], 1u);
    return b;
}
__device__ __forceinline__ void xcd_barrier_complete(unsigned* bar, unsigned x, unsigned& nloc, unsigned& nx) {
    const unsigned G = gridDim.x * gridDim.y * gridDim.z;
    unsigned sum, cnt, mine, sp = 0u;
    for (;;) {
        sum = 0u; cnt = 0u; mine = 0u;
#pragma unroll
        for (unsigned j = 0; j < 16; ++j) { const unsigned c = xb_ld(&bar[XB_XCNT(j)]); sum += c; cnt += (c > 0u) ? 1u : 0u; mine = (j == x) ? c : mine; }
        if (sum == G) break;
        __builtin_amdgcn_s_sleep(1);
        if ((++sp & 255u) == 0u) { if (xb_ld(&bar[XB_TMO])) break; if (sp > XB_SPIN_CAP) { atomicAdd(&bar[XB_TMO], 1u); break; } }
    }
    nloc = mine > 0u ? mine : 1u; nx = cnt > 0u ? cnt : 1u;
}
__device__ __forceinline__ void xcd_barrier(const XcdBarrier& b, int tid) {
    asm volatile("s_waitcnt vmcnt(0)" ::: "memory");
    __syncthreads();
    if (tid == 0) {
        unsigned* bar = b.bar;
        __builtin_amdgcn_s_waitcnt(0);
        unsigned nloc = b.st[0], nx = b.st[1];
        if (nloc == 0u) { xcd_barrier_complete(bar, b.x, nloc, nx); b.st[0] = nloc; b.st[1] = nx; }
        const unsigned old = xb_add(&bar[XB_XSUB(b.x)], 1u);
        const unsigned gen = old / nloc;
        if (old + 1u == (gen + 1u) * nloc) {
            __builtin_amdgcn_fence(__ATOMIC_RELEASE, "agent");
            asm volatile("s_waitcnt vmcnt(0)" ::: "memory");
            const unsigned og = xb_add(&bar[XB_TOP], 1u);
            const unsigned tg = og / nx;
            if (og + 1u == (tg + 1u) * nx) xb_add(&bar[XB_TOPGEN], 1u);
            else XB_SPIN(xb_ld(&bar[XB_TOPGEN]) == tg, bar);
            __builtin_amdgcn_fence(__ATOMIC_ACQUIRE, "agent");
            xb_add(&bar[XB_XGEN(b.x)], 1u);
            asm volatile("s_waitcnt vmcnt(0)" ::: "memory");
        } else {
            XB_SPIN(xb_ld(&bar[XB_XGEN(b.x)]) == gen, bar);
            __builtin_amdgcn_fence(__ATOMIC_ACQUIRE, "agent");
            asm volatile("s_waitcnt vmcnt(0)" ::: "memory");
        }
    }
    __syncthreads();
}

struct Args { const float* in[30]; float* out; unsigned char* ws; int ph_lo, ph_hi, bslot, pad; };
enum { I_X = 0, I_MEM, I_RELB, I_NMIX, I_NMEM, I_NFFN, I_WKV, I_XQN, I_XKN, I_WOUT, I_HYWIN, I_HYCW, I_HYCB, I_FW1, I_FB1, I_FW2, I_FB2, I_FW3, I_FREQ, I_SKIP,
       I_ATWIN, I_ATQN, I_ATKN, I_FFG, I_FFU, I_FFD, I_ROUTER, I_MOEG, I_MOEU, I_MOED };

struct Frame {
    LAS unsigned char* lds;
    unsigned char* ws;
    int tid, lane, wave, G, bid;
};

constexpr int RSL_OFF = 131072;
template <int SCALE> struct EpiB {
    bf16* O; int ldc; const float* sc; int split_tile; bf16* O2; int ldc2; const LAS float* rsl; float kc;
    __device__ __forceinline__ void operator()(const f32x4 (&acc)[2][2][4][2], const pg8::Unit& u, int wr, int wc, int fr, int fq) const {
        const int row0 = u.pm * 256 + wr * 64 + fr;
        bf16* base = O; int ld = ldc; int colt = u.pn * 256;
        if (u.pn >= split_tile) { base = O2; ld = ldc2; colt -= split_tile * 256; }
        if (u.koff != 0) base = O2;
        const int col0 = colt + wc * 32 + 8 * fq;
        float rsv[2][4];
        if (SCALE == 1) {
#pragma unroll
            for (int ai = 0; ai < 2; ++ai)
#pragma unroll
                for (int m = 0; m < 4; ++m) rsv[ai][m] = sc[row0 + ai * 128 + m * 16];
            asm volatile("s_waitcnt vmcnt(0)" ::: "memory");
        }
        f32x4 cs[2][2];
        if (SCALE == 3) {
#pragma unroll
            for (int bj = 0; bj < 2; ++bj)
#pragma unroll
                for (int n = 0; n < 2; ++n) cs[bj][n] = *(const f32x4*)(sc + u.pn * 256 + bj * 128 + wc * 32 + 8 * fq + 4 * n);
            asm volatile("s_waitcnt vmcnt(0)" ::: "memory");
        }
#pragma unroll
        for (int ai = 0; ai < 2; ++ai)
#pragma unroll
            for (int m = 0; m < 4; ++m) {
                const int row = row0 + ai * 128 + m * 16;
                float rs = 1.f;
                if (SCALE == 1) rs = rsv[ai][m];
                if (SCALE == 2) { const f32x4* p = (const f32x4*)(sc + (size_t)row * 16); const f32x4 a = p[0], b = p[1], c = p[2], d = p[3];
                    const float s = ((a.x + a.y) + (a.z + a.w)) + ((b.x + b.y) + (b.z + b.w)) + ((c.x + c.y) + (c.z + c.w)) + ((d.x + d.y) + (d.z + d.w));
                    rs = 1.0f / sqrtf(s * (1.0f / D) + EPS); }
                if (SCALE == 4) rs = rsl[u.idx * 256 + (row - u.pm * 256)];
                if (SCALE == 5) rs = kc;
                bf16* rowp = base + (size_t)row * ld + col0;
#pragma unroll
                for (int bj = 0; bj < 2; ++bj) {
                    f32x4 v0 = acc[ai][bj][m][0], v1 = acc[ai][bj][m][1];
                    if (SCALE == 1 || SCALE == 2 || SCALE == 4 || SCALE == 5) { v0 = v0 * rs; v1 = v1 * rs; }
                    if (SCALE == 3) { v0 = v0 * cs[bj][0]; v1 = v1 * cs[bj][1]; }
                    v4u w; w.x = pk2(v0[0], v0[1]); w.y = pk2(v0[2], v0[3]); w.z = pk2(v1[0], v1[1]); w.w = pk2(v1[2], v1[3]);
                    *(v4u*)(rowp + bj * 128) = w;
                }
            }
    }
};
template <bool XF32, bool SSQ> struct EpiRes {
    const float* xf; const bf16* xi; int ldi; bf16* xo; int ldo; float* ssq16;
    __device__ __forceinline__ void operator()(const f32x4 (&acc)[2][2][4][2], const pg8::Unit& u, int wr, int wc, int fr, int fq) const {
        const int row0 = u.pm * 256 + wr * 64 + fr, col0 = u.pn * 256 + wc * 32 + 8 * fq;
        if constexpr (!XF32) {
            v4u res[2][4][2];
#pragma unroll
            for (int ai = 0; ai < 2; ++ai)
#pragma unroll
                for (int m = 0; m < 4; ++m)
#pragma unroll
                    for (int bj = 0; bj < 2; ++bj) res[ai][m][bj] = *(const v4u*)(xi + (size_t)(row0 + ai * 128 + m * 16) * ldi + col0 + bj * 128);
            asm volatile("s_waitcnt vmcnt(0)" ::: "memory");
#pragma unroll
            for (int ai = 0; ai < 2; ++ai)
#pragma unroll
                for (int m = 0; m < 4; ++m) {
                    const int row = row0 + ai * 128 + m * 16;
                    float ss = 0.f;
#pragma unroll
                    for (int bj = 0; bj < 2; ++bj) {
                        const v4u w0 = res[ai][m][bj];
                        const f32x4 r0 = (f32x4){bflo(w0.x), bfhi(w0.x), bflo(w0.y), bfhi(w0.y)}, r1 = (f32x4){bflo(w0.z), bfhi(w0.z), bflo(w0.w), bfhi(w0.w)};
                        const f32x4 v0 = acc[ai][bj][m][0] + r0, v1 = acc[ai][bj][m][1] + r1;
                        v4u w; w.x = pk2(v0[0], v0[1]); w.y = pk2(v0[2], v0[3]); w.z = pk2(v1[0], v1[1]); w.w = pk2(v1[2], v1[3]);
                        *(v4u*)(xo + (size_t)row * ldo + col0 + bj * 128) = w;
                        if (SSQ) ss += ((v0[0] * v0[0] + v0[1] * v0[1]) + (v0[2] * v0[2] + v0[3] * v0[3])) + ((v1[0] * v1[0] + v1[1] * v1[1]) + (v1[2] * v1[2] + v1[3] * v1[3]));
                    }
                    if (SSQ) { ss += __shfl_xor(ss, 16); ss += __shfl_xor(ss, 32);
                        if (fq == 0) ssq16[(size_t)row * 16 + u.pn * 4 + wc] = ss; }
                }
        } else {
#pragma unroll
            for (int ai = 0; ai < 2; ++ai)
#pragma unroll
                for (int m = 0; m < 4; ++m) {
                    const int row = row0 + ai * 128 + m * 16;
                    float ss = 0.f;
#pragma unroll
                    for (int bj = 0; bj < 2; ++bj) {
                        const size_t off = (size_t)row * D + col0 + bj * 128; const f32x4 r0 = *(const f32x4*)(xf + off), r1 = *(const f32x4*)(xf + off + 4);
                        const f32x4 v0 = acc[ai][bj][m][0] + r0, v1 = acc[ai][bj][m][1] + r1;
                        v4u w; w.x = pk2(v0[0], v0[1]); w.y = pk2(v0[2], v0[3]); w.z = pk2(v1[0], v1[1]); w.w = pk2(v1[2], v1[3]);
                        *(v4u*)(xo + (size_t)row * ldo + col0 + bj * 128) = w;
                        if (SSQ) ss += ((v0[0] * v0[0] + v0[1] * v0[1]) + (v0[2] * v0[2] + v0[3] * v0[3])) + ((v1[0] * v1[0] + v1[1] * v1[1]) + (v1[2] * v1[2] + v1[3] * v1[3]));
                    }
                    if (SSQ) { ss += __shfl_xor(ss, 16); ss += __shfl_xor(ss, 32);
                        if (fq == 0) ssq16[(size_t)row * 16 + u.pn * 4 + wc] = ss; }
                }
        }
    }
};
template <int SCALE, bool OUT8 = false> struct EpiSwiglu {
    bf16* H; int ldh; const float* sc; const LAS float* rsl; float kc;
    __device__ __forceinline__ void operator()(const f32x4 (&acc)[2][2][4][2], const pg8::Unit& u, int wr, int wc, int fr, int fq) const {
        const int row0 = u.pm * 256 + wr * 64 + fr, col0 = u.pn * 128 + wc * 32 + 8 * fq;
#pragma unroll
        for (int ai = 0; ai < 2; ++ai)
#pragma unroll
            for (int m = 0; m < 4; ++m) {
                const int row = row0 + ai * 128 + m * 16;
                float rs = 1.f;
                if (SCALE == 1) rs = sc[row];
                if (SCALE == 2) { const f32x4* p = (const f32x4*)(sc + (size_t)row * 16); const f32x4 a = p[0], b = p[1], c = p[2], d = p[3];
                    const float s = ((a.x + a.y) + (a.z + a.w)) + ((b.x + b.y) + (b.z + b.w)) + ((c.x + c.y) + (c.z + c.w)) + ((d.x + d.y) + (d.z + d.w));
                    rs = 1.0f / sqrtf(s * (1.0f / D) + EPS); }
                if (SCALE == 4) rs = rsl[u.idx * 256 + (row - u.pm * 256)];
                if (SCALE == 5) rs = kc;
                float h[8];
#pragma unroll
                for (int n = 0; n < 2; ++n)
#pragma unroll
                    for (int j = 0; j < 4; ++j) { const float gv = acc[ai][0][m][n][j] * rs, uv = acc[ai][1][m][n][j] * rs;
                        h[n * 4 + j] = gv * uv * __builtin_amdgcn_rcpf(1.0f + __expf(-gv)); }
                if (OUT8) { v2u w; w.x = pk4_fp8(h[0], h[1], h[2], h[3]); w.y = pk4_fp8(h[4], h[5], h[6], h[7]); *(v2u*)((unsigned char*)H + (size_t)row * ldh + col0) = w; }
                else { v4u w; w.x = pk2(h[0], h[1]); w.y = pk2(h[2], h[3]); w.z = pk2(h[4], h[5]); w.w = pk2(h[6], h[7]);
                    *(v4u*)(H + (size_t)row * ldh + col0) = w; }
            }
    }
};

template <class Sched>
__device__ __forceinline__ void fill_rstd_table(LAS unsigned char* lds, const Sched& S, const float* ssq16, int tid) {
    LAS float* rsl = (LAS float*)(lds + RSL_OFF);
    pg8::Unit u;
    for (int ui = 0; ui < 16 && S.next(ui, u); ++ui) {
        if (tid < 256) { const f32x4* p = (const f32x4*)(ssq16 + (size_t)(u.pm * 256 + tid) * 16); const f32x4 a = p[0], b = p[1], c = p[2], d = p[3];
            const float s = ((a.x + a.y) + (a.z + a.w)) + ((b.x + b.y) + (b.z + b.w)) + ((c.x + c.y) + (c.z + c.w)) + ((d.x + d.y) + (d.z + d.w));
            rsl[ui * 256 + tid] = 1.0f / sqrtf(s * (1.0f / D) + EPS); }
    }
    __syncthreads();
}

__device__ __forceinline__ void p0_transpose_item(const float* W, int K, int N, bf16* WT, const float* gain, int mode, LAS float* scr, int item, int lane) {
    const int nblk = N / 64, kb = item / nblk, nb = item % nblk, k0 = 64 * kb, n0 = 64 * nb;
    const int lr = lane >> 4, lc = lane & 15;
    f32x4 v[16];
#pragma unroll
    for (int i = 0; i < 16; ++i) v[i] = __builtin_nontemporal_load((const f32x4*)(W + (size_t)(k0 + 4 * i + lr) * N + n0 + 4 * lc));
    if (gain) {
#pragma unroll
        for (int i = 0; i < 16; ++i) v[i] = v[i] * gain[k0 + 4 * i + lr];
    }
#pragma unroll
    for (int i = 0; i < 16; ++i) { LAS float* s = scr + (4 * i + lr) * 65 + 4 * lc; s[0] = v[i].x; s[1] = v[i].y; s[2] = v[i].z; s[3] = v[i].w; }
    LDS_WAIT(); asm volatile("" ::: "memory");
    const int c = lane & 7;
    const int d0 = (mode == 0) ? n0 : (256 * (n0 / 128) + (n0 % 128) + (mode == 2 ? 128 : 0));
#pragma unroll
    for (int j = 0; j < 8; ++j) { const int n = (lane >> 3) + 8 * j; const LAS float* s = scr + (8 * c) * 65 + n;
        v4u o; o.x = pk2(s[0 * 65], s[1 * 65]); o.y = pk2(s[2 * 65], s[3 * 65]); o.z = pk2(s[4 * 65], s[5 * 65]); o.w = pk2(s[6 * 65], s[7 * 65]);
        *(v4u*)(WT + (size_t)(d0 + n) * K + k0 + 8 * c) = o; }
    LDS_WAIT(); asm volatile("" ::: "memory");
}
__device__ __forceinline__ void p0_transpose_item8(const float* W, int K, int N, unsigned char* WT8, const float* gain, float s8, int mode, LAS float* scr, int item, int lane) {
    const int nblk = N / 64, kb = item / nblk, nb = item % nblk, k0 = 64 * kb, n0 = 64 * nb;
    const int lr = lane >> 4, lc = lane & 15;
    f32x4 v[16];
#pragma unroll
    for (int i = 0; i < 16; ++i) v[i] = __builtin_nontemporal_load((const f32x4*)(W + (size_t)(k0 + 4 * i + lr) * N + n0 + 4 * lc));
#pragma unroll
    for (int i = 0; i < 16; ++i) { const float g = gain ? gain[k0 + 4 * i + lr] * s8 : s8; v[i] = v[i] * g; }
#pragma unroll
    for (int i = 0; i < 16; ++i) { LAS float* s = scr + (4 * i + lr) * 65 + 4 * lc; s[0] = v[i].x; s[1] = v[i].y; s[2] = v[i].z; s[3] = v[i].w; }
    LDS_WAIT(); asm volatile("" ::: "memory");
    const int c = lane & 3;
    const int d0 = (mode == 0) ? n0 : (256 * (n0 / 128) + (n0 % 128) + (mode == 2 ? 128 : 0));
#pragma unroll
    for (int j = 0; j < 4; ++j) { const int n = (lane >> 2) + 16 * j; const LAS float* s = scr + (16 * c) * 65 + n;
        v4u o; o.x = pk4_fp8(s[0 * 65], s[1 * 65], s[2 * 65], s[3 * 65]); o.y = pk4_fp8(s[4 * 65], s[5 * 65], s[6 * 65], s[7 * 65]);
        o.z = pk4_fp8(s[8 * 65], s[9 * 65], s[10 * 65], s[11 * 65]); o.w = pk4_fp8(s[12 * 65], s[13 * 65], s[14 * 65], s[15 * 65]);
        __builtin_nontemporal_store(o, (v4u*)(WT8 + (size_t)(d0 + n) * K + k0 + 16 * c)); }
    LDS_WAIT(); asm volatile("" ::: "memory");
}
__device__ __forceinline__ float row_to_bf16(const float* xrow, bf16* orow, const float* gain, bool normalize, int lane) {
    const f32x4* xr = (const f32x4*)xrow + lane;
    f32x4 v[4]; float s = 0.f;
#pragma unroll
    for (int j = 0; j < 4; ++j) { v[j] = __builtin_nontemporal_load(xr + 64 * j); s += (v[j].x * v[j].x + v[j].y * v[j].y) + (v[j].z * v[j].z + v[j].w * v[j].w); }
    const float rstd = 1.0f / sqrtf(wave_sum(s) * (1.f / D) + EPS);
    unsigned long long* o8 = (unsigned long long*)orow + lane;
#pragma unroll
    for (int j = 0; j < 4; ++j) {
        f32x4 w = v[j];
        if (normalize) { const f32x4 g = ((const f32x4*)gain)[lane + 64 * j]; w = w * rstd * g; }
        o8[64 * j] = (unsigned long long)pk2(w.x, w.y) | ((unsigned long long)pk2(w.z, w.w) << 32);
    }
    return rstd;
}
__device__ __forceinline__ void p0_filter_block(Frame& F, const Args& a, float* Hf, int jb) {
    const float* w1 = a.in[I_FW1]; const float* b1 = a.in[I_FB1]; const float* w2 = a.in[I_FW2]; const float* b2 = a.in[I_FB2]; const float* w3 = a.in[I_FW3]; const float* fr = a.in[I_FREQ];
    LAS float* h2s = (LAS float*)(F.lds + MISC_OFF + 256);
    const int lane = F.lane, j0 = jb * 8;
    LAS float* W1s = (LAS float*)F.lds; LAS float* W2s = W1s + 33 * 64;
    for (int i = F.tid; i < 33 * 64; i += 512) W1s[i] = w1[i];
    for (int i = F.tid; i < 64 * 64; i += 512) W2s[i] = w2[i];
    __syncthreads();
    {
        const int j = j0 + F.wave;
        const float freq = fr[lane], bb1 = b1[lane], bb2 = b2[lane];
        float feat = 0.f;
        {
            const int fi = (lane >= 17) ? lane - 17 : lane - 1;
            const float f = 1e-4f + (float)fi * ((15.0f - 1e-4f) / 15.0f);
            const float ang = (6.283185307179586f / 2048.0f) * (float)j * f;
            if (lane == 0) feat = (float)j * (1.0f / 2047.0f);
            else if (lane <= 16) feat = cosf(ang);
            else if (lane <= 32) feat = -sinf(ang);
        }
        float s1 = bb1;
#pragma unroll
        for (int i = 0; i < 33; ++i) s1 += __shfl(feat, i) * W1s[i * 64 + lane];
        const float h1 = sinf(freq * s1);
        float s2 = bb2;
#pragma unroll 16
        for (int i = 0; i < 64; ++i) s2 += __shfl(h1, i) * W2s[i * 64 + lane];
        h2s[lane * 8 + F.wave] = sinf(freq * s2);
    }
    __syncthreads();
    const int n0 = F.wave * 256;
    float acc[4][8];
#pragma unroll
    for (int q = 0; q < 4; ++q)
#pragma unroll
        for (int jj = 0; jj < 8; ++jj) acc[q][jj] = 0.f;
#pragma unroll 1
    for (int i0 = 0; i0 < 64; i0 += 8) {
        float w[8][4];
#pragma unroll
        for (int ii = 0; ii < 8; ++ii)
#pragma unroll
            for (int q = 0; q < 4; ++q) w[ii][q] = w3[(size_t)(i0 + ii) * 2048 + n0 + q * 64 + lane];
#pragma unroll
        for (int ii = 0; ii < 8; ++ii) {
            const f32x4 ha = *(const LAS f32x4*)(h2s + (i0 + ii) * 8), hb = *(const LAS f32x4*)(h2s + (i0 + ii) * 8 + 4);
#pragma unroll
            for (int q = 0; q < 4; ++q) {
                acc[q][0] += ha.x * w[ii][q]; acc[q][1] += ha.y * w[ii][q]; acc[q][2] += ha.z * w[ii][q]; acc[q][3] += ha.w * w[ii][q];
                acc[q][4] += hb.x * w[ii][q]; acc[q][5] += hb.y * w[ii][q]; acc[q][6] += hb.z * w[ii][q]; acc[q][7] += hb.w * w[ii][q]; }
        }
    }
    const float da = -3.0701134573253945f, db = -15.350567286626973f;
#pragma unroll
    for (int q = 0; q < 4; ++q) {
        const int n = n0 + q * 64 + lane, c = n & 511;
        const float delta = fabsf(da + (db - da) * ((float)c * (1.0f / 511.0f)));
        float o[8];
#pragma unroll
        for (int jj = 0; jj < 8; ++jj) { const float t = (float)(j0 + jj) * (1.0f / 2047.0f); o[jj] = acc[q][jj] * (expf(-t * delta) + 0.05f); }
        f32x4* dst = (f32x4*)(Hf + (size_t)n * 2048 + j0);
        dst[0] = (f32x4){o[0], o[1], o[2], o[3]}; dst[1] = (f32x4){o[4], o[5], o[6], o[7]};
    }
    __syncthreads();
}
constexpr int IT_MOE = 16 * 44, N_MOE_ITEMS = 24 * IT_MOE;
constexpr int MOE_P1_HI = 5376, MOE_P5_MID = MOE_P1_HI + 4096, MOE_P5_HI = 16896, MOE_P0_LO = MOE_P5_HI;
__device__ __forceinline__ void moe_convert(Frame& F, const Args& a, int lo, int hi, int gwl, int ngw) {
    LAS float* scr = (LAS float*)(F.lds + F.wave * 16640);
    unsigned char* ws = F.ws;
    for (int r = lo + gwl; r < hi; r += ngw) {
        const int mid = r / IT_MOE, li = r % IT_MOE, kind = mid >> 3, e = mid & 7;
        if (kind == 0) p0_transpose_item8(a.in[I_MOEG] + (size_t)e * D * FF, D, FF, ws + WS_WGU1 + (size_t)e * NGU * D, a.in[I_NFFN] + D, MOE_WGU_SCALE, 1, scr, li, F.lane);
        else if (kind == 1) p0_transpose_item8(a.in[I_MOEU] + (size_t)e * D * FF, D, FF, ws + WS_WGU1 + (size_t)e * NGU * D, a.in[I_NFFN] + D, MOE_WGU_SCALE, 2, scr, li, F.lane);
        else p0_transpose_item8(a.in[I_MOED] + (size_t)e * FF * D, FF, D, ws + WS_WD1 + (size_t)e * D * FF, nullptr, MOE_WD_SCALE, 0, scr, li, F.lane);
    }
}
__device__ __forceinline__ void p0_prologue(Frame& F, const Args& a) {
    LAS float* scr = (LAS float*)(F.lds + F.wave * 16640);
    const int gw = F.bid * NWAVES + F.wave, NGW = F.G * NWAVES;
    unsigned char* ws = F.ws;
    if (!(F.bid & 1)) { for (int jb = F.bid; jb < 256; jb += F.G) p0_filter_block(F, a, (float*)(ws + WS_HF), jb); }
    for (int m = gw; m < T; m += NGW) { const float r = row_to_bf16(a.in[I_X] + (size_t)m * D, (bf16*)(ws + WS_XB) + (size_t)m * D, nullptr, false, F.lane); if (F.lane == 0) ((float*)(ws + WS_RSTD0))[m] = r; }
    for (int m = gw; m < 2 * TM; m += NGW) { const int l = m / TM, r = m % TM;
        (void)row_to_bf16(a.in[I_MEM] + (size_t)r * D, (bf16*)(ws + WS_MN) + (size_t)m * D, a.in[I_NMEM] + l * D, true, F.lane); }
    constexpr int IT_A = 16 * 32, IT_SQ = 16 * 16, IT_G = 16 * 44, IT_D = 44 * 16, IT_W1 = 16 * 80;
    constexpr int NSMALL = IT_A + 4 * IT_SQ + 2 * IT_G + IT_D + IT_W1;
    for (int it = gw; it < NSMALL; it += NGW) {
        int r = it;
        if (r < IT_A) { p0_transpose_item(a.in[I_HYWIN], D, NZ0, (bf16*)(ws + WS_WIN0), a.in[I_NMIX], 0, scr, r, F.lane); continue; } r -= IT_A;
        if (r < IT_SQ) { p0_transpose_item(a.in[I_WKV], D, D, (bf16*)(ws + WS_WKV), nullptr, 0, scr, r, F.lane); continue; } r -= IT_SQ;
        if (r < IT_SQ) { p0_transpose_item(a.in[I_WKV] + (size_t)D * D, D, D, (bf16*)(ws + WS_WKV) + (size_t)D * D, nullptr, 0, scr, r, F.lane); continue; } r -= IT_SQ;
        if (r < IT_SQ) { p0_transpose_item(a.in[I_WOUT], D, D, (bf16*)(ws + WS_WO), nullptr, 0, scr, r, F.lane); continue; } r -= IT_SQ;
        if (r < IT_SQ) { p0_transpose_item(a.in[I_WOUT] + (size_t)D * D, D, D, (bf16*)(ws + WS_WO) + (size_t)D * D, nullptr, 0, scr, r, F.lane); continue; } r -= IT_SQ;
        if (r < IT_G) { p0_transpose_item(a.in[I_FFG], D, FF, (bf16*)(ws + WS_WGU0), a.in[I_NFFN], 1, scr, r, F.lane); continue; } r -= IT_G;
        if (r < IT_G) { p0_transpose_item(a.in[I_FFU], D, FF, (bf16*)(ws + WS_WGU0), a.in[I_NFFN], 2, scr, r, F.lane); continue; } r -= IT_G;
        if (r < IT_D) { p0_transpose_item(a.in[I_FFD], FF, D, (bf16*)(ws + WS_WD0), nullptr, 0, scr, r, F.lane); continue; } r -= IT_D;
        p0_transpose_item(a.in[I_ATWIN], D, NQ1, (bf16*)(ws + WS_WIN1), a.in[I_NMIX] + D, 0, scr, r, F.lane);
    }
    moe_convert(F, a, (F.G == 256) ? MOE_P0_LO : 0, N_MOE_ITEMS, gw, NGW);
    if (F.bid & 1) { __syncthreads(); for (int jb = F.bid; jb < 256; jb += F.G) p0_filter_block(F, a, (float*)(ws + WS_HF), jb); }
}
__device__ __forceinline__ float block_sum(Frame& F, float v) {
    LAS float* red = (LAS float*)(F.lds + MISC_OFF + 64);
    v = wave_sum(v);
    __syncthreads();
    if (F.lane == 0) red[F.wave] = v;
    __syncthreads();
    float s = 0.f;
#pragma unroll
    for (int w = 0; w < NWAVES; ++w) s += red[w];
    return s;
}
__device__ __forceinline__ int rel_bucket_dev(int rel) {
    const int n = rel < 0 ? -rel : rel;
    const int large = 8 + (n >= 15) + (n >= 27) + (n >= 50) + (n >= 91) + (n >= 166) + (n >= 305) + (n >= 559);
    return (rel > 0 ? 16 : 0) + (n < 8 ? n : large);
}
__device__ __forceinline__ void merge_token(Frame& F, int token) {
    const bf16* og = (const bf16*)(F.ws + WS_OG12); const float* lse = (const float*)(F.ws + WS_LSE);
    bf16* mix = (bf16*)(F.ws + WS_MIX1);
    const int lane = F.lane, h = lane >> 4;
    const float l0 = lse[(size_t)token * 4 + h], l1 = lse[((size_t)T + token) * 4 + h], l2 = lse[((size_t)2 * T + token) * 4 + h];
    const float mx = fmaxf(l0, fmaxf(l1, l2));
    float w0 = __expf(l0 - mx), w1 = __expf(l1 - mx), w2 = __expf(l2 - mx);
    const float iz = 1.0f / (w0 + w1 + w2); w0 *= iz; w1 *= iz; w2 *= iz;
    const v4u a0 = *(const v4u*)(mix + (size_t)token * D + 8 * lane);
    const v4u a1 = __builtin_nontemporal_load((const v4u*)(og + (size_t)token * 512 + 8 * lane));
    const v4u a2 = __builtin_nontemporal_load((const v4u*)(og + ((size_t)T + token) * 512 + 8 * lane));
    v4u o;
    o.x = pk2(w0 * bflo(a0.x) + w1 * bflo(a1.x) + w2 * bflo(a2.x), w0 * bfhi(a0.x) + w1 * bfhi(a1.x) + w2 * bfhi(a2.x));
    o.y = pk2(w0 * bflo(a0.y) + w1 * bflo(a1.y) + w2 * bflo(a2.y), w0 * bfhi(a0.y) + w1 * bfhi(a1.y) + w2 * bfhi(a2.y));
    o.z = pk2(w0 * bflo(a0.z) + w1 * bflo(a1.z) + w2 * bflo(a2.z), w0 * bfhi(a0.z) + w1 * bfhi(a1.z) + w2 * bfhi(a2.z));
    o.w = pk2(w0 * bflo(a0.w) + w1 * bflo(a1.w) + w2 * bflo(a2.w), w0 * bfhi(a0.w) + w1 * bfhi(a1.w) + w2 * bfhi(a2.w));
    *(v4u*)(mix + (size_t)token * D + 8 * lane) = o;
}

constexpr int RT_OFF_R = 0, RT_OFF_REC = 32768, RT_OFF_CNT = 32768 + 64 * 32;
__device__ __forceinline__ void route_block(Frame& F, const Args& a, int blk) {
    LAS float* RL = (LAS float*)(F.lds + RT_OFF_R); volatile LAS int* REC = (volatile LAS int*)(F.lds + RT_OFF_REC); LAS int* CNT = (LAS int*)(F.lds + RT_OFF_CNT);
    const int lane = F.lane;
    const float* g = a.in[I_NFFN] + D; const float* rt = a.in[I_ROUTER];
    __syncthreads();
    for (int i = F.tid; i < 2048; i += 512) { const f32x4 r = ((const f32x4*)rt)[i]; const float gg = g[i >> 1]; ((LAS f32x4*)RL)[i] = r * gg; }
    if (F.tid < 16) CNT[F.tid] = 0;
    __syncthreads();
    for (int q = 0; q < 8; ++q) {
        const int tl = F.wave * 8 + q, token = blk * 64 + tl;
        const bf16* xr = (const bf16*)a.out + (size_t)token * 2048 + 1024;
        f32x4 v[4]; float s = 0.f;
#pragma unroll
        for (int j = 0; j < 4; ++j) { const v2u w = __builtin_nontemporal_load((const v2u*)xr + lane + 64 * j); v[j] = (f32x4){bflo(w.x), bfhi(w.x), bflo(w.y), bfhi(w.y)}; s += (v[j].x * v[j].x + v[j].y * v[j].y) + (v[j].z * v[j].z + v[j].w * v[j].w); }
        const float rstd = 1.0f / sqrtf(wave_sum(s) * (1.f / D) + EPS);
        { unsigned* o4 = (unsigned*)(F.ws + WS_XB3 + (size_t)token * D) + lane;
#pragma unroll
          for (int j = 0; j < 4; ++j) o4[64 * j] = pk4_fp8(v[j].x * rstd, v[j].y * rstd, v[j].z * rstd, v[j].w * rstd); }
        float lg[8];
#pragma unroll
        for (int e = 0; e < 8; ++e) lg[e] = 0.f;
#pragma unroll
        for (int j = 0; j < 4; ++j) {
            const int k0 = 4 * (lane + 64 * j);
#pragma unroll
            for (int qq = 0; qq < 4; ++qq) {
                const float hn = v[j][qq] * rstd;
                const f32x4 r0 = *(const LAS f32x4*)(RL + (k0 + qq) * 8), r1 = *(const LAS f32x4*)(RL + (k0 + qq) * 8 + 4);
                lg[0] += hn * r0.x; lg[1] += hn * r0.y; lg[2] += hn * r0.z; lg[3] += hn * r0.w;
                lg[4] += hn * r1.x; lg[5] += hn * r1.y; lg[6] += hn * r1.z; lg[7] += hn * r1.w;
            }
        }
#pragma unroll
        for (int e = 0; e < 8; ++e) lg[e] = wave_sum(lg[e]);
        int i1 = 0; float v1 = lg[0];
#pragma unroll
        for (int e = 1; e < 8; ++e) if (lg[e] > v1) { v1 = lg[e]; i1 = e; }
        int i2 = -1; float v2 = -3.0e38f;
#pragma unroll
        for (int e = 0; e < 8; ++e) if (e != i1 && lg[e] > v2) { v2 = lg[e]; i2 = e; }
        const float e2 = __expf(v2 - v1), g1 = 1.0f / (1.0f + e2), g2 = e2 * g1;
        if (lane == 0) {
            const int r1 = __hip_atomic_fetch_add(CNT + i1, 1, __ATOMIC_RELAXED, __HIP_MEMORY_SCOPE_WORKGROUP);
            const int r2 = __hip_atomic_fetch_add(CNT + i2, 1, __ATOMIC_RELAXED, __HIP_MEMORY_SCOPE_WORKGROUP);
            REC[tl * 8 + 0] = i1; REC[tl * 8 + 1] = i2; REC[tl * 8 + 2] = r1; REC[tl * 8 + 3] = r2;
            REC[tl * 8 + 4] = __builtin_bit_cast(int, g1); REC[tl * 8 + 5] = __builtin_bit_cast(int, g2); REC[tl * 8 + 6] = __builtin_bit_cast(int, rstd);
        }
    }
    __syncthreads();
    if (F.tid < 8) { unsigned* cnt = (unsigned*)(F.ws + WS_CTL) + CW_CNT; CNT[8 + F.tid] = (int)__hip_atomic_fetch_add(cnt + F.tid, (unsigned)CNT[F.tid], __ATOMIC_RELAXED, __HIP_MEMORY_SCOPE_AGENT); }
    __syncthreads();
    if (F.tid < 64) {
        const int tl = F.tid, token = blk * 64 + tl;
        const int i1 = REC[tl * 8 + 0], i2 = REC[tl * 8 + 1], r1 = CNT[8 + i1] + REC[tl * 8 + 2], r2 = CNT[8 + i2] + REC[tl * 8 + 3];
        int* toke = (int*)(F.ws + WS_TOKE); int* tokr = (int*)(F.ws + WS_TOKR); int* tokg = (int*)(F.ws + WS_TOKG); int* list = (int*)(F.ws + WS_LIST);
        list[(size_t)i1 * T + r1] = token; list[(size_t)i2 * T + r2] = token;
        toke[token * 2] = i1; toke[token * 2 + 1] = i2; tokr[token * 2] = r1; tokr[token * 2 + 1] = r2;
        tokg[token * 2] = REC[tl * 8 + 4]; tokg[token * 2 + 1] = REC[tl * 8 + 5];
        ((int*)(F.ws + WS_RSTD3))[token] = REC[tl * 8 + 6];
    }
}
__device__ __forceinline__ void moe_layout(Frame& F) {
    volatile LAS int* M = (volatile LAS int*)(F.lds + MISC_OFF);
    __syncthreads();
    if (F.tid == 0) {
        const unsigned* cnt = (const unsigned*)(F.ws + WS_CTL) + CW_CNT;
        int acc = 0;
        for (int e = 0; e < 8; ++e) { const int c = (int)__hip_atomic_load(cnt + e, __ATOMIC_RELAXED, __HIP_MEMORY_SCOPE_AGENT); M[32 + e] = c; M[40 + e] = acc; acc += (c + 255) & ~255; }
        M[48] = acc;
    }
    __syncthreads();
}
__device__ __forceinline__ int ml_ps(Frame& F, int e) { return ((volatile LAS int*)(F.lds + MISC_OFF))[40 + e]; }
__device__ __forceinline__ int ml_cnt(Frame& F, int e) { return ((volatile LAS int*)(F.lds + MISC_OFF))[32 + e]; }
__device__ __forceinline__ int ml_total(Frame& F) { return ((volatile LAS int*)(F.lds + MISC_OFF))[48]; }
__device__ __forceinline__ int ml_expert(Frame& F, int slot) { int e = 0;
#pragma unroll
    for (int i = 1; i < 8; ++i) e += (slot >= ml_ps(F, i)) ? 1 : 0;
    return e; }

constexpr int HY_CS = 4168, HY_M0 = 2080, HY_UR = 2592, HY_UP = 256;
constexpr int HY_OFF_CP = 64, HY_OFF_UB = HY_OFF_CP + 8 * HY_CS * 2, HY_OFF_X = HY_OFF_UB + 8 * HY_UR * 2;
static_assert(HY_OFF_X + 8 * 2048 * 2 <= SCR_BYTES, "hyena LDS");
typedef short bf16x8_t __attribute__((ext_vector_type(8)));

struct HyStage { v4u raw[4]; float zm[4], zp[4]; };
struct HyFilt { float f[4], b[4]; };
__device__ __forceinline__ void hy_short_load(HyStage& s, const bf16* zr, int tid) {
#pragma unroll
    for (int k = 0; k < 4; ++k) {
        const int item = tid + 512 * k, b = item >> 8, t8 = (item & 255) * 8;
        const bf16* p = zr + b * SEQ + t8;
        s.raw[k] = __builtin_nontemporal_load((const v4u*)p);
        s.zm[k] = (t8 > 0) ? bf1(p[-1]) : 0.f; s.zp[k] = (t8 + 8 < SEQ) ? bf1(p[8]) : 0.f;
    }
}
__device__ __forceinline__ void hy_short_store(LAS unsigned char* dst, int stride_el, int pad_el, const HyStage& s, float w0, float w1, float w2, float cb, int tid) {
#pragma unroll
    for (int k = 0; k < 4; ++k) {
        const int item = tid + 512 * k, b = item >> 8, t8 = (item & 255) * 8;
        float z[10];
        z[0] = s.zm[k]; z[1] = bflo(s.raw[k].x); z[2] = bfhi(s.raw[k].x); z[3] = bflo(s.raw[k].y); z[4] = bfhi(s.raw[k].y); z[5] = bflo(s.raw[k].z); z[6] = bfhi(s.raw[k].z); z[7] = bflo(s.raw[k].w); z[8] = bfhi(s.raw[k].w); z[9] = s.zp[k];
        float o[8];
#pragma unroll
        for (int i = 0; i < 8; ++i) o[i] = cb + z[i] * w0 + z[i + 1] * w1 + z[i + 2] * w2;
        v4u w; w.x = pk2(o[0], o[1]); w.y = pk2(o[2], o[3]); w.z = pk2(o[4], o[5]); w.w = pk2(o[6], o[7]);
        *(LAS v4u*)(dst + (size_t)(b * stride_el + pad_el + t8) * 2) = w;
    }
}
__device__ __forceinline__ void hy_filt_load(HyFilt& q, const float* Hf, int o, int c, int tid) {
    const float* fw = Hf + ((size_t)(o * 2 + 0) * 512 + c) * 2048;
    const float* bw = Hf + ((size_t)(o * 2 + 1) * 512 + c) * 2048;
#pragma unroll
    for (int i = 0; i < 4; ++i) { const int j = tid + 512 * i; q.f[i] = __builtin_nontemporal_load(fw + j); q.b[i] = (j >= 1) ? __builtin_nontemporal_load(bw + j) : 0.f; }
}
__device__ __forceinline__ void hy_filt_build(Frame& F, const HyFilt& q) {
    LAS float* Kf = (LAS float*)(F.lds + HY_OFF_X);
    float s = 0.f;
#pragma unroll
    for (int i = 0; i < 4; ++i) s += fabsf(q.f[i]) + fabsf(q.b[i]);
    const float tot = block_sum(F, s);
    const float inv = 1.0f / (tot + 1e-6f);
#pragma unroll
    for (int i = 0; i < 4; ++i) { const int j = F.tid + 512 * i; Kf[HY_M0 - j] = q.f[i] * inv; if (j >= 1) Kf[HY_M0 + j] = q.b[i] * inv; }
    if (F.tid < 33) Kf[F.tid] = 0.f;
    if (F.tid < 48) Kf[4128 + F.tid] = 0.f;
    __syncthreads();
    LAS unsigned* cp = (LAS unsigned*)(F.lds + HY_OFF_CP);
    for (int p = F.tid; p < 8 * (HY_CS / 2); p += 512) { const int j = p / (HY_CS / 2), xp = p - j * (HY_CS / 2), x = 2 * xp + j; cp[p] = pk2(Kf[x], Kf[x + 1]); }
    __syncthreads();
}
__device__ __forceinline__ void hy_conv_mfma(Frame& F, f32x4 (&C)[8]) {
    const int lane = F.lane, w = F.wave, r = lane & 15, kq = lane >> 4;
    const int jc = (-r) & 7, cr = (r + 7) >> 3;
    const LAS unsigned char* abase = F.lds + HY_OFF_CP + (size_t)(jc * HY_CS + HY_M0 - 32 * (8 * w - 63) + 8 * kq - 8 * cr) * 2;
    const LAS unsigned char* bbase = F.lds + HY_OFF_UB + (size_t)((r & 7) * HY_UR + HY_UP + 16 * (r >> 3) + 8 * kq) * 2;
#pragma unroll
    for (int i = 0; i < 8; ++i) C[i] = (f32x4){0.f, 0.f, 0.f, 0.f};
    bf16x8_t Bw[9];
#pragma unroll
    for (int i = 0; i < 8; ++i) Bw[i] = *(const LAS bf16x8_t*)(bbase + 64 * (63 + i));
    bf16x8_t An = *(const LAS bf16x8_t*)(abase);
#pragma unroll 1
    for (int Q = 0; Q < 8; ++Q) {
        const LAS unsigned char* ab = abase - 64 * (9 * Q);
        const LAS unsigned char* bb = bbase + 64 * (63 - 9 * Q);
#pragma unroll
        for (int qq = 0; qq < 9; ++qq) {
            const bf16x8_t A = An;
            An = *(const LAS bf16x8_t*)(ab - 64 * (qq + 1));
            Bw[(8 - qq + 9) % 9] = *(const LAS bf16x8_t*)(bb + 64 * (-1 - qq));
#pragma unroll
            for (int i = 7; i >= 0; --i) C[i] = __builtin_amdgcn_mfma_f32_16x16x32_bf16(A, Bw[(i - qq + 9) % 9], C[i], 0, 0, 0);
        }
    }
}
__device__ __forceinline__ void hyena_units(Frame& F, const Args& a) {
    const bf16* zT = (const bf16*)(F.ws + WS_ZT);
    const float* Hf = (const float*)(F.ws + WS_HF);
    const float* cw = a.in[I_HYCW]; const float* cbp = a.in[I_HYCB]; const float* skip = a.in[I_SKIP];
    bf16* yT = (bf16*)(F.ws + WS_YT);
    LAS unsigned char* UB = F.lds + HY_OFF_UB; LAS unsigned char* XB = F.lds + HY_OFF_X;
    int c = F.bid; if (c >= HYC) return;
    HyStage sA, sC, sG; HyFilt fB, fF;
    hy_short_load(sA, zT + (size_t)c * T, F.tid); hy_filt_load(fB, Hf, 0, c, F.tid); hy_short_load(sC, zT + (size_t)(HYC + c) * T, F.tid);
#pragma unroll 1
    for (;;) {
        const int lane = F.lane, w = F.wave, n = lane & 15, bb = n & 7, hh = n >> 3, rq = lane >> 4;
        __syncthreads();
        for (int p = F.tid; p < 8 * 272; p += 512) { const int b = p / 272, q = p - b * 272; const int el = (q < 128) ? 2 * q : (HY_UP + SEQ + 2 * (q - 128)); *(LAS unsigned*)(UB + (size_t)(b * HY_UR + el) * 2) = 0u; }
        { const int ch = c; hy_short_store(UB, HY_UR, HY_UP, sA, cw[ch], cw[1536 + ch], cw[3072 + ch], cbp[ch], F.tid); }
        hy_filt_build(F, fB);
        { const int ch = HYC + c; hy_short_store(XB, SEQ, 0, sC, cw[ch], cw[1536 + ch], cw[3072 + ch], cbp[ch], F.tid); }
        hy_filt_load(fF, Hf, 1, c, F.tid); hy_short_load(sG, zT + (size_t)(2 * HYC + c) * T, F.tid);
        __syncthreads();
        f32x4 C[8];
        hy_conv_mfma(F, C);
        __syncthreads();
        {   const float sk = skip[c];
#pragma unroll
            for (int i = 0; i < 8; ++i) {
                const int t0 = 32 * (8 * w + i) + 16 * hh + 4 * rq;
                LAS v2u* up = (LAS v2u*)(UB + (size_t)(bb * HY_UR + HY_UP + t0) * 2);
                const v2u uu = *up; const v2u xx = *(const LAS v2u*)(XB + (size_t)(bb * SEQ + t0) * 2);
                v2u o;
                o.x = pk2(bflo(xx.x) * (C[i][0] + bflo(uu.x) * sk), bfhi(xx.x) * (C[i][1] + bfhi(uu.x) * sk));
                o.y = pk2(bflo(xx.y) * (C[i][2] + bflo(uu.y) * sk), bfhi(xx.y) * (C[i][3] + bfhi(uu.y) * sk));
                *up = o;
            }
        }
        __syncthreads();
        hy_filt_build(F, fF);
        { const int ch = 2 * HYC + c; hy_short_store(XB, SEQ, 0, sG, cw[ch], cw[1536 + ch], cw[3072 + ch], cbp[ch], F.tid); }
        const int cn = c + F.G; const bool more = cn < HYC;
        if (more) { hy_short_load(sA, zT + (size_t)cn * T, F.tid); hy_filt_load(fB, Hf, 0, cn, F.tid); hy_short_load(sC, zT + (size_t)(HYC + cn) * T, F.tid); }
        __syncthreads();
        hy_conv_mfma(F, C);
        {   const float sk = skip[HYC + c];
#pragma unroll
            for (int i = 0; i < 8; ++i) {
                const int t0 = 32 * (8 * w + i) + 16 * hh + 4 * rq;
                const v2u uu = *(const LAS v2u*)(UB + (size_t)(bb * HY_UR + HY_UP + t0) * 2); const v2u xx = *(const LAS v2u*)(XB + (size_t)(bb * SEQ + t0) * 2);
                v2u o;
                o.x = pk2(bflo(xx.x) * (C[i][0] + bflo(uu.x) * sk), bfhi(xx.x) * (C[i][1] + bfhi(uu.x) * sk));
                o.y = pk2(bflo(xx.y) * (C[i][2] + bflo(uu.y) * sk), bfhi(xx.y) * (C[i][3] + bfhi(uu.y) * sk));
                *(v2u*)(yT + (size_t)c * T + bb * SEQ + t0) = o;
            }
        }
        if (!more) break;
        c = cn;
    }
}
__device__ __forceinline__ void hy_transpose_tile(Frame& F, int tile) {
    const bf16* yT = (const bf16*)(F.ws + WS_YT); bf16* mix = (bf16*)(F.ws + WS_MIX0);
    LAS unsigned* scr = (LAS unsigned*)(F.lds + F.wave * (64 * 36 * 4));
    const int lane = F.lane, ct = tile & 7, tt = tile >> 3, c0 = 64 * ct, tok0 = 64 * tt;
    const int rr = lane >> 3, ch = lane & 7;
    v4u raw[8];
#pragma unroll
    for (int i = 0; i < 8; ++i) raw[i] = __builtin_nontemporal_load((const v4u*)(yT + (size_t)(c0 + 8 * i + rr) * T + tok0 + 8 * ch));
#pragma unroll
    for (int i = 0; i < 8; ++i) {
        v4u o; o.x = __shfl_xor(raw[i].x, 8); o.y = __shfl_xor(raw[i].y, 8); o.z = __shfl_xor(raw[i].z, 8); o.w = __shfl_xor(raw[i].w, 8);
        const bool odd = rr & 1;
        const unsigned a0 = odd ? o.z : raw[i].x, a1 = odd ? o.w : raw[i].y;
        const unsigned b0 = odd ? raw[i].z : o.x, b1 = odd ? raw[i].w : o.y;
        const int cp = (8 * i + (rr & ~1)) >> 1;
        const int tb = 8 * ch + (odd ? 4 : 0);
        scr[(tb + 0) * 36 + cp] = (a0 & 0xffffu) | (b0 << 16);
        scr[(tb + 1) * 36 + cp] = (a0 >> 16) | (b0 & 0xffff0000u);
        scr[(tb + 2) * 36 + cp] = (a1 & 0xffffu) | (b1 << 16);
        scr[(tb + 3) * 36 + cp] = (a1 >> 16) | (b1 & 0xffff0000u);
    }
    LDS_WAIT(); asm volatile("" ::: "memory");
#pragma unroll
    for (int i = 0; i < 8; ++i) { const int tk = 8 * i + rr; const v4u w = *(const LAS v4u*)(scr + tk * 36 + 4 * ch);
        *(v4u*)(mix + (size_t)(tok0 + tk) * D + c0 + 8 * ch) = w; }
    LDS_WAIT(); asm volatile("" ::: "memory");
}

constexpr int AT_KSTR = 136, AT_VSTR = 144;
template <int OFF> __device__ __forceinline__ v2u ds_tr16(unsigned addr) { v2u r; asm volatile("ds_read_b64_tr_b16 %0, %1 offset:%2" : "=v"(r) : "v"(addr), "n"(OFF)); return r; }
template <int NT, int DT, int I = 0>
__device__ __forceinline__ void pv_issue(unsigned vb, unsigned vb2, v2u (&t)[NT]) {
    if constexpr (I < NT) {
        constexpr int off = (I >> 1) * 32 * AT_VSTR * 2 + (I & 1) * 16 * AT_VSTR * 2 + 32 * DT;
        if constexpr (off < 65536) t[I] = ds_tr16<off>(vb); else t[I] = ds_tr16<off - 32768>(vb2);
        pv_issue<NT, DT, I + 1>(vb, vb2, t);
    }
}
template <int N> __device__ __forceinline__ void lgkm_wait() { asm volatile("s_waitcnt lgkmcnt(%0)" :: "n"(N)); }
template <int NT, bool DIL, bool EDGE>
__device__ __forceinline__ void attn_wave16(const LAS unsigned char* Ks, const LAS unsigned char* Vs, int k0, const v4u (&raw)[4], const LAS float* gfl, const LAS float* bt, int relbase, int lbase, int L,
                                            bf16* orow, float* lse_out, int lane) {
    const int r = lane & 15, rq = lane >> 4;
    bf16x8_t Qf[4];
    {
        float ss = 0.f;
#pragma unroll
        for (int st = 0; st < 4; ++st) {
            const float a0 = bflo(raw[st].x), a1 = bfhi(raw[st].x), a2 = bflo(raw[st].y), a3 = bfhi(raw[st].y), a4 = bflo(raw[st].z), a5 = bfhi(raw[st].z), a6 = bflo(raw[st].w), a7 = bfhi(raw[st].w);
            ss += (a0 * a0 + a1 * a1) + (a2 * a2 + a3 * a3) + (a4 * a4 + a5 * a5) + (a6 * a6 + a7 * a7); }
        ss += __shfl_xor(ss, 16); ss += __shfl_xor(ss, 32);
        const float sc = (0.08838834764831845f * 1.4426950408889634f) * __builtin_amdgcn_rsqf(ss * (1.f / 128.f) + EPS);
#pragma unroll
        for (int st = 0; st < 4; ++st) { const f32x4 g0 = *(const LAS f32x4*)(gfl + 32 * st + 8 * rq), g1 = *(const LAS f32x4*)(gfl + 32 * st + 8 * rq + 4); v4u w;
            w.x = pk2(bflo(raw[st].x) * (sc * g0.x), bfhi(raw[st].x) * (sc * g0.y)); w.y = pk2(bflo(raw[st].y) * (sc * g0.z), bfhi(raw[st].y) * (sc * g0.w));
            w.z = pk2(bflo(raw[st].z) * (sc * g1.x), bfhi(raw[st].z) * (sc * g1.y)); w.w = pk2(bflo(raw[st].w) * (sc * g1.z), bfhi(raw[st].w) * (sc * g1.w));
            Qf[st] = __builtin_bit_cast(bf16x8_t, w); }
    }
    float bv[DIL ? NT : 1][4];
    if (DIL) {
#pragma unroll
        for (int kt = 0; kt < NT; ++kt)
#pragma unroll
            for (int g = 0; g < 4; ++g) bv[kt][g] = bt[relbase + 16 * kt + g + 128];
    }
    f32x4 S[NT];
    const LAS unsigned char* kb = Ks + (size_t)(k0 + r) * (AT_KSTR * 2) + 16 * rq;
    bf16x8_t Af[2][4];
#pragma unroll
    for (int st = 0; st < 4; ++st) Af[0][st] = *(const LAS bf16x8_t*)(kb + 64 * st);
#pragma unroll
    for (int kt = 0; kt < NT; ++kt) {
        if (kt + 1 < NT) {
#pragma unroll
            for (int st = 0; st < 4; ++st) Af[(kt + 1) & 1][st] = *(const LAS bf16x8_t*)(kb + (kt + 1) * 16 * (AT_KSTR * 2) + 64 * st);
        }
        f32x4 acc = (f32x4){0.f, 0.f, 0.f, 0.f};
        if (DIL) acc = (f32x4){bv[kt][0], bv[kt][1], bv[kt][2], bv[kt][3]};
#pragma unroll
        for (int st = 0; st < 4; ++st) acc = __builtin_amdgcn_mfma_f32_16x16x32_bf16(Af[kt & 1][st], Qf[st], acc, 0, 0, 0);
        S[kt] = acc;
        asm volatile("" ::: "memory");
    }
    float mx = -3.0e38f;
#pragma unroll
    for (int kt = 0; kt < NT; ++kt)
#pragma unroll
        for (int g = 0; g < 4; ++g) {
            float s = S[kt][g];
            if (DIL && EDGE) { const int lk = lbase + 16 * kt + g; const bool ok = (lk >= 0) && (lk < L); s = ok ? s : -3.0e38f; S[kt][g] = s; }
            mx = fmaxf(mx, s);
        }
    mx = fmaxf(mx, __shfl_xor(mx, 16)); mx = fmaxf(mx, __shfl_xor(mx, 32));
    float z = 0.f;
#pragma unroll
    for (int kt = 0; kt < NT; ++kt)
#pragma unroll
        for (int g = 0; g < 4; ++g) { const float p = __builtin_amdgcn_exp2f(S[kt][g] - mx); S[kt][g] = p; z += p; }
    z += __shfl_xor(z, 16); z += __shfl_xor(z, 32);
    const float iz = __builtin_amdgcn_rcpf(z);
    bf16x8_t Pf[NT / 2];
#pragma unroll
    for (int ks = 0; ks < NT / 2; ++ks) { v4u w; w.x = pk2(S[2 * ks][0], S[2 * ks][1]); w.y = pk2(S[2 * ks][2], S[2 * ks][3]); w.z = pk2(S[2 * ks + 1][0], S[2 * ks + 1][1]); w.w = pk2(S[2 * ks + 1][2], S[2 * ks + 1][3]);
        Pf[ks] = __builtin_bit_cast(bf16x8_t, w); }
    const unsigned vb = (unsigned)(size_t)Vs + (unsigned)(k0 + 4 * rq + (r >> 2)) * (AT_VSTR * 2) + 8 * (lane & 3), vb2 = vb + 32768;
    constexpr int WN = NT < 15 ? NT : 15;
    v2u Vt[2][NT];
    pv_issue<NT, 0>(vb, vb2, Vt[0]);
#define PV_STEP(DT) { \
        if (DT + 1 < 8) { pv_issue<NT, (DT + 1) & 7>(vb, vb2, Vt[(DT + 1) & 1]); lgkm_wait<WN>(); } else lgkm_wait<0>(); \
        _Pragma("unroll") for (int i = 0; i < NT; ++i) asm volatile("" : "+v"(Vt[DT & 1][i])); \
        f32x4 o = (f32x4){0.f, 0.f, 0.f, 0.f}; \
        _Pragma("unroll") for (int ks = 0; ks < NT / 2; ++ks) { const v2u lo = Vt[DT & 1][2 * ks], hi = Vt[DT & 1][2 * ks + 1]; \
            o = __builtin_amdgcn_mfma_f32_16x16x32_bf16(__builtin_bit_cast(bf16x8_t, ((v4u){lo.x, lo.y, hi.x, hi.y})), Pf[ks], o, 0, 0, 0); } \
        v2u ow; ow.x = pk2(o[0] * iz, o[1] * iz); ow.y = pk2(o[2] * iz, o[3] * iz); \
        *(v2u*)(orow + 16 * DT + 4 * rq) = ow; }
    PV_STEP(0) PV_STEP(1) PV_STEP(2) PV_STEP(3) PV_STEP(4) PV_STEP(5) PV_STEP(6) PV_STEP(7)
#undef PV_STEP
    if (DIL) { if (rq == 0) *lse_out = mx * 0.6931471805599453f + logf(z); }
}
template <int CTRL> __device__ __forceinline__ float dpp_f(float x) { return __builtin_bit_cast(float, __builtin_amdgcn_update_dpp(0, __builtin_bit_cast(int, x), CTRL, 0xf, 0xf, true)); }
template <int NK, int NB, int BS, class RowFn>
__device__ __forceinline__ void attn_stage_kv(LAS unsigned char* Ks, LAS unsigned char* Vs, const bf16* kbase, const bf16* vbase, RowFn rowoff, int wave, int lane) {
    const int rr = lane >> 4, cc = lane & 15;
#pragma unroll 1
    for (int bt = 0; bt < NB; ++bt) {
        v4u rk[BS], rv[BS]; bool ok[BS];
#pragma unroll
        for (int i = 0; i < BS; ++i) { const int j = ((bt * BS + i) * 8 + wave) * 4 + rr; const int off = rowoff(j); ok[i] = off >= 0;
            const unsigned ob = (ok[i] ? (unsigned)off * 2u : 0u) + 16u * cc;
            rk[i] = *(const v4u*)((const char*)kbase + ob); rv[i] = *(const v4u*)((const char*)vbase + ob); }
#pragma unroll
        for (int i = 0; i < BS; ++i) { const int j = ((bt * BS + i) * 8 + wave) * 4 + rr;
            const float k0 = bflo(rk[i].x), k1 = bfhi(rk[i].x), k2 = bflo(rk[i].y), k3 = bfhi(rk[i].y), k4 = bflo(rk[i].z), k5 = bfhi(rk[i].z), k6 = bflo(rk[i].w), k7 = bfhi(rk[i].w);
            float ss = (k0 * k0 + k1 * k1) + (k2 * k2 + k3 * k3) + (k4 * k4 + k5 * k5) + (k6 * k6 + k7 * k7);
            ss += dpp_f<0xB1>(ss); ss += dpp_f<0x4E>(ss); ss += dpp_f<0x141>(ss); ss += dpp_f<0x140>(ss);
            const float sc = ok[i] ? __builtin_amdgcn_rsqf(ss * (1.f / 128.f) + EPS) : 0.f;
            v4u w; w.x = pk2(k0 * sc, k1 * sc); w.y = pk2(k2 * sc, k3 * sc); w.z = pk2(k4 * sc, k5 * sc); w.w = pk2(k6 * sc, k7 * sc);
            if (((bt * BS + i + 1) * 32 <= NK) || j < NK) *(LAS v4u*)(Ks + (unsigned)j * (AT_KSTR * 2) + 16 * cc) = w; }
#pragma unroll
        for (int i = 0; i < BS; ++i) { const int j = ((bt * BS + i) * 8 + wave) * 4 + rr;
            v4u w = rv[i]; if (!ok[i]) w = (v4u){0u, 0u, 0u, 0u};
            if (((bt * BS + i + 1) * 32 <= NK) || j < NK) *(LAS v4u*)(Vs + (unsigned)j * (AT_VSTR * 2) + 16 * cc) = w; }
    }
}

constexpr int XA_OFF_V = 256 * AT_KSTR * 2;
static_assert(XA_OFF_V + 256 * AT_VSTR * 2 <= SCR_BYTES, "cross LDS");
__device__ __forceinline__ void cross_unit(Frame& F, const bf16* xq, const bf16* kv, const LAS float* gfl, bf16* mix, int unit) {
    int lane = (int)__builtin_amdgcn_mbcnt_hi(~0u, __builtin_amdgcn_mbcnt_lo(~0u, 0u)); asm volatile("" : "+v"(lane)); const int tid = F.wave * 64 + lane;
    const int b = unit >> 5, h = (unit >> 3) & 3, qc = unit & 7;
    LAS unsigned char* Ks = F.lds; LAS unsigned char* Vs = F.lds + XA_OFF_V;
    const bf16* kbase = kv + (size_t)(b * MEML) * 1024 + h * 128;
    v4u qraw[2][4];
#pragma unroll
    for (int t = 0; t < 2; ++t) { const int token = b * SEQ + qc * 256 + 16 * (F.wave + 8 * t) + (lane & 15);
#pragma unroll
        for (int st = 0; st < 4; ++st) qraw[t][st] = *(const v4u*)(xq + (size_t)token * 512 + h * 128 + 32 * st + 8 * (lane >> 4)); }
    __syncthreads();
    attn_stage_kv<MEML, 2, 4>(Ks, Vs, kbase, kbase + 512, [=](int j) { return j * 1024; }, F.wave, lane);
    __syncthreads();
#pragma unroll
    for (int t = 0; t < 2; ++t) {
        const int token = b * SEQ + qc * 256 + 16 * (F.wave + 8 * t) + (lane & 15);
        attn_wave16<16, false, false>(Ks, Vs, 0, qraw[t], gfl, nullptr, 0, 0, 0, mix + (size_t)token * D + 512 + h * 128, nullptr, lane);
    }
}
constexpr int DA_NK = 272, DA_OFF_V = DA_NK * AT_KSTR * 2, DA_OFF_BT = DA_OFF_V + DA_NK * AT_VSTR * 2;
static_assert(DA_OFF_BT + 320 * 4 <= SCR_BYTES, "dilated LDS");
__device__ __forceinline__ void dil_unit(Frame& F, const Args& a, const LAS float* gfl, int unit) {
    const int bh = unit / 48, sub = unit % 48, b = bh >> 2, h = bh & 3, g = sub >> 4, w16 = sub & 15;
    const int dil = (g == 0) ? 1 : (g == 1 ? 4 : 16), L = SEQ / dil, nch = L / 128;
    const int r = w16 / nch, n128 = w16 % nch;
    int lane = (int)__builtin_amdgcn_mbcnt_hi(~0u, __builtin_amdgcn_mbcnt_lo(~0u, 0u)); asm volatile("" : "+v"(lane)); const int tid = F.wave * 64 + lane;
    const bf16* qkv = (const bf16*)(F.ws + WS_QKV1);
    float* lse = (float*)(F.ws + WS_LSE);
    LAS unsigned char* Ks = F.lds; LAS unsigned char* Vs = F.lds + DA_OFF_V; LAS float* bt = (LAS float*)(F.lds + DA_OFF_BT);
    const int lk0 = 128 * n128 - 64;
    const bf16* base = qkv + (size_t)(b * SEQ + r) * NQKV + g * 512 + h * 128;
    const size_t lstep = (size_t)dil * NQKV;
    const int qi = 16 * F.wave + (lane & 15), lq = 128 * n128 + qi, token = b * SEQ + lq * dil + r;
    v4u qraw[4];
#pragma unroll
    for (int st = 0; st < 4; ++st) qraw[st] = *(const v4u*)(base + (size_t)lq * lstep + 32 * st + 8 * (lane >> 4));
    __syncthreads();
    if (tid < 320) { const int rel = tid - 128; bt[tid] = (rel >= -64 && rel <= 64) ? a.in[I_RELB][rel_bucket_dev(rel * dil) * 12 + g * 4 + h] * 1.4426950408889634f : -3.0e38f; }
    {   const int lstep32 = dil * NQKV;
        attn_stage_kv<DA_NK, 3, 3>(Ks, Vs, base + ATW, base + 2 * ATW, [=](int j) { const int lk = lk0 + j; return (lk >= 0 && lk < L) ? lk * lstep32 : -1; }, F.wave, lane); }
    __syncthreads();
    {
        const int k0 = 16 * F.wave, rq = lane >> 4;
        bf16* orow = (g == 0) ? (bf16*)(F.ws + WS_MIX1) + (size_t)token * D + h * 128 : (bf16*)(F.ws + WS_OG12) + ((size_t)(g - 1) * T + token) * 512 + h * 128;
        float* lp = lse + ((size_t)g * T + token) * 4 + h;
        if (n128 == 0 || n128 == nch - 1) attn_wave16<10, true, true>(Ks, Vs, k0, qraw, gfl, bt, k0 + 4 * rq - 64 - qi, lk0 + k0 + 4 * rq, L, orow, lp, lane);
        else attn_wave16<10, true, false>(Ks, Vs, k0, qraw, gfl, bt, k0 + 4 * rq - 64 - qi, lk0 + k0 + 4 * rq, L, orow, lp, lane);
    }
}
__device__ __forceinline__ void combine_phase(Frame& F, const Args& a) {
    moe_layout(F);
    const int gw = F.bid * NWAVES + F.wave, NGW = F.G * NWAVES, lane = F.lane;
    const int* toke = (const int*)(F.ws + WS_TOKE); const int* tokr = (const int*)(F.ws + WS_TOKR); const float* tokg = (const float*)(F.ws + WS_TOKG);
    const bf16* y = (const bf16*)(F.ws + WS_XS); const bf16* y2 = (const bf16*)(F.ws + WS_Y2);
    for (int token = gw; token < T; token += NGW) {
        const int e0 = toke[token * 2], e1 = toke[token * 2 + 1];
        const int s0 = ml_ps(F, e0) + tokr[token * 2], s1 = ml_ps(F, e1) + tokr[token * 2 + 1];
        const float g0 = tokg[token * 2], g1 = tokg[token * 2 + 1];
        f32x4* xo = (f32x4*)(a.out + (size_t)token * D); const v2u* xi = (const v2u*)((const bf16*)a.out + (size_t)token * 2048 + 1024);
        const v2u* y0 = (const v2u*)(y + (size_t)s0 * D); const v2u* y1 = (const v2u*)(y + (size_t)s1 * D);
        v2u xw[4], p0[4], p1[4];
#pragma unroll
        for (int j = 0; j < 4; ++j) { const int q = lane + 64 * j; xw[j] = __builtin_nontemporal_load(xi + q); p0[j] = __builtin_nontemporal_load(y0 + q); p1[j] = __builtin_nontemporal_load(y1 + q); }
        f32x4 r[4];
#pragma unroll
        for (int j = 0; j < 4; ++j) {
            const int q = lane + 64 * j;
            f32x4 x = (f32x4){bflo(xw[j].x), bfhi(xw[j].x), bflo(xw[j].y), bfhi(xw[j].y)};
            f32x4 a0 = (f32x4){bflo(p0[j].x), bfhi(p0[j].x), bflo(p0[j].y), bfhi(p0[j].y)}, a1 = (f32x4){bflo(p1[j].x), bfhi(p1[j].x), bflo(p1[j].y), bfhi(p1[j].y)};
            if (s0 >= 2 * T) { const v2u t = ((const v2u*)(y2 + (size_t)(s0 - 2 * T) * D))[q]; a0 = a0 + (f32x4){bflo(t.x), bfhi(t.x), bflo(t.y), bfhi(t.y)}; }
            if (s1 >= 2 * T) { const v2u t = ((const v2u*)(y2 + (size_t)(s1 - 2 * T) * D))[q]; a1 = a1 + (f32x4){bflo(t.x), bfhi(t.x), bflo(t.y), bfhi(t.y)}; }
            r[j] = x + g0 * a0 + g1 * a1;
        }
        asm volatile("s_waitcnt vmcnt(0)" ::: "memory");
#pragma unroll
        for (int j = 0; j < 4; ++j) __builtin_nontemporal_store(r[j], xo + lane + 64 * j);
    }
}

constexpr int NPHASE = 15;
__global__ void __launch_bounds__(NWAVES * 64, 2) mega_fwd(Args args) {
    extern __shared__ __attribute__((aligned(16))) unsigned char lds_raw[];
    Frame F;
    F.lds = (LAS unsigned char*)lds_raw; F.ws = args.ws;
    F.wave = __builtin_amdgcn_readfirstlane((int)threadIdx.x >> 6); F.G = gridDim.x; F.bid = blockIdx.x;
#define PH_BEGIN() do { int l_ = (int)__builtin_amdgcn_mbcnt_hi(~0u, __builtin_amdgcn_mbcnt_lo(~0u, 0u)); asm volatile("" : "+v"(l_)); F.lane = l_; F.tid = F.wave * 64 + l_; } while (0)
    PH_BEGIN();
    unsigned char* ws = args.ws;
    volatile LAS unsigned* MISC = (volatile LAS unsigned*)(F.lds + MISC_OFF);
    for (int u = F.tid; u < (LDS_BYTES - MISC_OFF) / 4; u += NWAVES * 64) MISC[u] = 0u;
    __syncthreads();
    const int lo = args.ph_lo, hi = args.ph_hi;
    const bool use_bar = (hi - lo) > 1;
    XcdBarrier bar; bar.bar = (unsigned*)(ws + WS_CTL) + CW_BAR + args.bslot * XCD_BAR_WORDS; bar.x = 0; bar.st = nullptr;
    if (use_bar) bar = xcd_barrier_post((unsigned*)(ws + WS_CTL) + CW_BAR + args.bslot * XCD_BAR_WORDS, MISC + 8, F.tid);
#define IN(k) (lo <= (k) && (k) < hi)
#define SEAM(k) do { if (IN(k) && IN((k) + 1)) { PH_BEGIN(); xcd_barrier(bar, F.tid); } } while (0)
    const int gw = F.bid * NWAVES + F.wave, NGW = F.G * NWAVES;
    LAS unsigned char* ring = F.lds;

    if (IN(0)) { PH_BEGIN(); p0_prologue(F, args); }
    SEAM(0);
    if (IN(1)) { PH_BEGIN();
        {   pg8::Gemm g{(const bf16*)(ws + WS_WIN0), (const bf16*)(ws + WS_XB), D, D, D, 0};
            pg8::StaticOrder S; S.init(ATW / 256, T / 256, F.G, F.bid);
            EpiB<3> E{(bf16*)(ws + WS_ZT), T, (const float*)(ws + WS_RSTD0), 1 << 30, nullptr, 0, nullptr, 1.0f};
            pg8::gemm_phase<EpiB<3>, pg8::StaticOrder, true>(ring, g, S, E, F.wave); }
        {   pg8::Gemm g{(const bf16*)(ws + WS_XB), (const bf16*)(ws + WS_WIN0) + (size_t)ATW * D, D, D, D, 0};
            pg8::StaticOrder S; S.init(T / 256, 2, F.G, (F.bid + 128) % F.G);
            EpiB<1> E{(bf16*)(ws + WS_XQ0), 512, (const float*)(ws + WS_RSTD0), 1 << 30, nullptr, 0, nullptr, 1.0f};
            pg8::gemm_phase<EpiB<1>, pg8::StaticOrder, true>(ring, g, S, E, F.wave); }
        {   pg8::Gemm g{(const bf16*)(ws + WS_MN), (const bf16*)(ws + WS_WKV), D, D, D, (size_t)D * D * 2};
            pg8::MoeOrder S; S.init(2 * TM / 256, 4, F.G, F.bid); S.t0 = TM / 256; S.t1 = S.t2 = S.t3 = S.t4 = S.t5 = S.t6 = 1 << 30; S.lay = nullptr; S.list = nullptr;
            EpiB<0> E{(bf16*)(ws + WS_KV), D, nullptr, 1 << 30, nullptr, 0, nullptr, 1.0f};
            pg8::gemm_phase<EpiB<0>, pg8::MoeOrder, true>(ring, g, S, E, F.wave); }
        if (F.G == 256 && F.bid >= 64) { PH_BEGIN(); moe_convert(F, args, 0, MOE_P1_HI, (F.bid - 64) * NWAVES + F.wave, 192 * NWAVES); }
    }
    SEAM(1);
    if (IN(2)) { PH_BEGIN();
        hyena_units(F, args);
        LAS float* gfx = (LAS float*)(F.lds + MISC_OFF + 3072);
        if (F.tid < 128) gfx[F.tid] = args.in[I_XQN][F.tid] * args.in[I_XKN][F.tid];
        __syncthreads();
        for (int u = F.bid; u < 256; u += F.G)
            cross_unit(F, (const bf16*)(ws + WS_XQ0), (const bf16*)(ws + WS_KV), gfx, (bf16*)(ws + WS_MIX0), u);
    }
    SEAM(2);
    if (IN(3)) { PH_BEGIN(); for (int t = gw; t < 2048; t += NGW) hy_transpose_tile(F, t); }
    SEAM(3);
    if (IN(4)) { PH_BEGIN();
        pg8::Gemm g{(const bf16*)(ws + WS_MIX0), (const bf16*)(ws + WS_WO), D, D, D, 0};
        pg8::StaticOrder S; S.init(T / 256, 4, F.G, F.bid);
        EpiRes<false, true> E{nullptr, (const bf16*)(ws + WS_XB), D, (bf16*)(ws + WS_XB), D, (float*)(ws + WS_SSQ16)};
        pg8::gemm_phase<EpiRes<false, true>, pg8::StaticOrder, true>(ring, g, S, E, F.wave);
    }
    SEAM(4);
    if (IN(5)) { PH_BEGIN();
        pg8::Gemm g{(const bf16*)(ws + WS_XB), (const bf16*)(ws + WS_WGU0), D, D, D, 0};
        pg8::StaticOrder S; S.init(T / 256, NGU / 256, F.G, F.bid);
        fill_rstd_table(F.lds, S, (const float*)(ws + WS_SSQ16), F.tid);
        EpiSwiglu<4> E{(bf16*)(ws + WS_HID0), FF, nullptr, (const LAS float*)(F.lds + RSL_OFF), 1.0f};
        pg8::gemm_phase<EpiSwiglu<4>, pg8::StaticOrder, true>(ring, g, S, E, F.wave);
        if (F.G == 256) { PH_BEGIN();
            if (F.bid >= 128) moe_convert(F, args, MOE_P1_HI, MOE_P5_MID, (F.bid - 128) * NWAVES + F.wave, 128 * NWAVES);
            moe_convert(F, args, MOE_P5_MID, MOE_P5_HI, F.bid * NWAVES + F.wave, 256 * NWAVES); }
    }
    SEAM(5);
    if (IN(6)) { PH_BEGIN();
        pg8::Gemm g{(const bf16*)(ws + WS_HID0), (const bf16*)(ws + WS_WD0), FF, FF, FF, 0};
        pg8::StaticOrder S; S.init(T / 256, 4, F.G, F.bid);
        EpiRes<false, true> E{nullptr, (const bf16*)(ws + WS_XB), D, (bf16*)(ws + WS_XB), D, (float*)(ws + WS_SSQ16)};
        pg8::gemm_phase<EpiRes<false, true>, pg8::StaticOrder, true>(ring, g, S, E, F.wave);
    }
    SEAM(6);
    if (IN(7)) { PH_BEGIN();
        pg8::Gemm g{(const bf16*)(ws + WS_XB), (const bf16*)(ws + WS_WIN1), D, D, D, 0};
        pg8::StaticOrder S; S.init(T / 256, NQ1 / 256, F.G, F.bid);
        fill_rstd_table(F.lds, S, (const float*)(ws + WS_SSQ16), F.tid);
        EpiB<4> E{(bf16*)(ws + WS_QKV1), NQKV, nullptr, NQKV / 256, (bf16*)(ws + WS_XQ1), 512, (const LAS float*)(F.lds + RSL_OFF), 1.0f};
        pg8::gemm_phase<EpiB<4>, pg8::StaticOrder, true>(ring, g, S, E, F.wave);
    }
    SEAM(7);
    if (IN(8)) { PH_BEGIN();
        LAS float* gfd = (LAS float*)(F.lds + MISC_OFF + 2560); LAS float* gfx = (LAS float*)(F.lds + MISC_OFF + 3072);
        if (F.tid < 128) { gfd[F.tid] = args.in[I_ATQN][F.tid] * args.in[I_ATKN][F.tid]; gfx[F.tid] = args.in[I_XQN][128 + F.tid] * args.in[I_XKN][128 + F.tid]; }
        __syncthreads();
        for (int u = F.bid; u < NB * 4 * 48; u += F.G) dil_unit(F, args, gfd, u);
        for (int u = F.bid; u < 256; u += F.G)
            cross_unit(F, (const bf16*)(ws + WS_XQ1), (const bf16*)(ws + WS_KV) + (size_t)TM * D, gfx, (bf16*)(ws + WS_MIX1), u);
    }
    SEAM(8);
    if (IN(9)) { PH_BEGIN(); for (int t = gw; t < T; t += NGW) merge_token(F, t); }
    SEAM(9);
    if (IN(10)) { PH_BEGIN();
        pg8::Gemm g{(const bf16*)(ws + WS_MIX1), (const bf16*)(ws + WS_WO) + (size_t)D * D, D, D, D, 0};
        pg8::StaticOrder S; S.init(T / 256, 4, F.G, F.bid);
        EpiRes<false, false> E{nullptr, (const bf16*)(ws + WS_XB), D, (bf16*)args.out + 1024, 2048, nullptr};
        pg8::gemm_phase<EpiRes<false, false>, pg8::StaticOrder, true>(ring, g, S, E, F.wave);
    }
    SEAM(10);
    if (IN(11)) { PH_BEGIN(); for (int blk = F.bid; blk < T / 64; blk += F.G) route_block(F, args, blk); }
    SEAM(11);
    if (IN(12)) { PH_BEGIN();
        moe_layout(F);
        pg8::Gemm g{(const bf16*)(ws + WS_XB3), (const bf16*)(ws + WS_WGU1), D / 2, D / 2, D / 2, (size_t)NGU * D};
        pg8::MoeOrder S; S.init(ml_total(F) / 256, NGU / 256, F.G, F.bid); S.lay = (const volatile LAS int*)(F.lds + MISC_OFF); S.list = (const int*)(ws + WS_LIST);
        S.t0 = ml_ps(F, 1) / 256; S.t1 = ml_ps(F, 2) / 256; S.t2 = ml_ps(F, 3) / 256; S.t3 = ml_ps(F, 4) / 256; S.t4 = ml_ps(F, 5) / 256; S.t5 = ml_ps(F, 6) / 256; S.t6 = ml_ps(F, 7) / 256;
        EpiSwiglu<5, true> E{(bf16*)(ws + WS_HID1), FF, nullptr, nullptr, 1.0f / MOE_WGU_SCALE};
        pg8::gemm_phase<EpiSwiglu<5, true>, pg8::MoeOrder, true, true, true>(ring, g, S, E, F.wave);
    }
    SEAM(12);
    if (IN(13)) { PH_BEGIN();
        moe_layout(F);
        const int nMt = ml_total(F) / 256;
        const int q1 = ml_ps(F, 1) / 256, q2 = ml_ps(F, 2) / 256, q3 = ml_ps(F, 3) / 256, q4 = ml_ps(F, 4) / 256, q5 = ml_ps(F, 5) / 256, q6 = ml_ps(F, 6) / 256, q7 = ml_ps(F, 7) / 256;
        {   pg8::Gemm g{(const bf16*)(ws + WS_HID1), (const bf16*)(ws + WS_WD1), FF / 2, FF / 2, FF / 2, (size_t)D * FF};
            pg8::MoeOrder S; S.init(nMt < 128 ? nMt : 128, 4, F.G, F.bid); S.lay = nullptr; S.list = nullptr;
            S.t0 = q1; S.t1 = q2; S.t2 = q3; S.t3 = q4; S.t4 = q5; S.t5 = q6; S.t6 = q7;
            EpiB<5> E{(bf16*)(ws + WS_XS), D, nullptr, 1 << 30, nullptr, 0, nullptr, 1.0f / MOE_WD_SCALE};
            pg8::gemm_phase<EpiB<5>, pg8::MoeOrder, true, false, true>(ring, g, S, E, F.wave); }
        if (nMt > 128) {
            const int half = F.G / 2; const bool second = F.bid >= half;
            pg8::Gemm g{(const bf16*)(ws + WS_HID1), (const bf16*)(ws + WS_WD1), FF / 2, FF / 2, second ? 640 : 768, (size_t)D * FF};
            pg8::MoeTailOrder2 S; S.pm0 = 128; S.ntail = nMt - 128; S.nN = 4; S.G = second ? F.G - half : half; S.c = second ? F.bid - half : F.bid; S.koff = second ? 12 * 128 : 0;
            S.t0 = q1; S.t1 = q2; S.t2 = q3; S.t3 = q4; S.t4 = q5; S.t5 = q6; S.t6 = q7;
            EpiB<5> E{(bf16*)(ws + WS_XS), D, nullptr, 1 << 30, (bf16*)(ws + WS_Y2) - (size_t)2 * T * D, D, nullptr, 1.0f / MOE_WD_SCALE};
            pg8::gemm_phase<EpiB<5>, pg8::MoeTailOrder2, true, false, true>(ring, g, S, E, F.wave); }
    }
    SEAM(13);
    if (IN(14)) { PH_BEGIN(); combine_phase(F, args); }
#undef IN
#undef SEAM
}

#ifndef MK_ONE_LAUNCH
#define MK_ONE_LAUNCH 1
#endif
extern "C" void kernel_launch(void* const* d_in, const int* in_sizes, int n_in, void* d_out, int out_size, void* d_ws, size_t ws_size, hipStream_t stream) {
    static int grid = 0;
    if (grid == 0) {
        if (n_in != 30 || in_sizes[0] != T * D || out_size != T * D || ws_size < WS_END) {
            fprintf(stderr, "kernel_launch: unexpected problem (n_in %d, in0 %d, out %d, ws %zu, need %zu); nothing launched\n", n_in, n_in > 0 ? in_sizes[0] : -1, out_size, ws_size, (size_t)WS_END); grid = -1; return; }
        int dev = 0, cus = 0, per_cu = 0;
        if (hipGetDevice(&dev) != hipSuccess || hipDeviceGetAttribute(&cus, hipDeviceAttributeMultiprocessorCount, dev) != hipSuccess) { grid = -1; return; }
        if (hipFuncSetAttribute((const void*)mega_fwd, hipFuncAttributeMaxDynamicSharedMemorySize, LDS_BYTES) != hipSuccess) { fprintf(stderr, "kernel_launch: hipFuncSetAttribute failed\n"); grid = -1; return; }
        if (hipOccupancyMaxActiveBlocksPerMultiprocessor(&per_cu, (const void*)mega_fwd, NWAVES * 64, LDS_BYTES) != hipSuccess || per_cu < 1)
            fprintf(stderr, "kernel_launch: note: occupancy query reports %d workgroups per CU\n", per_cu);
        (void)hipGetLastError();
        grid = cus;
    }
    if (grid < 0) return;
    if (hipMemsetAsync((char*)d_ws + WS_CTL, 0, CTL_ZERO_BYTES, stream) != hipSuccess) return;
    Args a{};
    for (int i = 0; i < 30; ++i) a.in[i] = (const float*)d_in[i];
    a.out = (float*)d_out; a.ws = (unsigned char*)d_ws;
#if defined(PROBE_PHASE)
    a.ph_lo = 0; a.ph_hi = PROBE_PHASE + 1; a.bslot = 0;
    hipLaunchKernelGGL(mega_fwd, dim3(grid), dim3(NWAVES * 64), LDS_BYTES, stream, a);
    a.ph_lo = PROBE_PHASE; a.ph_hi = NPHASE; a.bslot = 1;
    hipLaunchKernelGGL(mega_fwd, dim3(grid), dim3(NWAVES * 64), LDS_BYTES, stream, a);
#elif MK_ONE_LAUNCH
    a.ph_lo = 0; a.ph_hi = NPHASE; a.bslot = 0;
    hipLaunchKernelGGL(mega_fwd, dim3(grid), dim3(NWAVES * 64), LDS_BYTES, stream, a);
#else
    for (int p = 0; p < NPHASE; ++p) { a.ph_lo = p; a.ph_hi = p + 1; a.bslot = 0; hipLaunchKernelGGL(mega_fwd, dim3(grid), dim3(NWAVES * 64), LDS_BYTES, stream, a); }
#endif
}
```

```cpp
#include <hip/hip_runtime.h>
#include <cstdio>
#include <cstdint>

namespace pg8 {
#define PG8_LAS __attribute__((address_space(3)))
typedef unsigned short bf16_t;
typedef short bf16x8 __attribute__((ext_vector_type(8)));
typedef float f32x4 __attribute__((ext_vector_type(4)));
typedef unsigned u32x4 __attribute__((ext_vector_type(4)));
constexpr int BM = 256, BK = 64, HALF = 128, HTB = HALF * BK * 2  , STAGE_BYTES = 8 * HTB, NXCD = 8, WGM = 8;

__host__ __device__ __forceinline__ int lds_byte(int r, int c) { const int st = (r >> 4) * 2 + (c >> 5), rr = r & 15, cc = c & 31, ob = rr * 64 + cc * 2; return st * 1024 + (ob ^ (((ob >> 9) & 1) << 5)); }
__host__ __device__ __forceinline__ void stage_rc(int b, int& R, int& C) { const int st = b / 1024, sb = b % 1024, swz = sb ^ (((sb >> 9) & 1) << 5); R = (st >> 1) * 16 + swz / 64; C = (st & 1) * 32 + (swz % 64) / 2; }
__host__ __device__ __forceinline__ int perm32(int rho) { const int n = rho >> 4, i = rho & 15; return 8 * (i >> 2) + 4 * n + (i & 3); }

struct Unit { int pm, pn, e, koff, idx; };
struct Gemm { const bf16_t* A; const bf16_t* Bt; int lda, ldb, K; size_t estride; };

struct StaticOrder {
    int nM, nN, nwg, G, c;
    __device__ __forceinline__ int gather_row(const Unit&, int slot) const { return slot; }
    __host__ __device__ void init(int nM_, int nN_, int G_, int c_) { nM = nM_; nN = nN_; nwg = nM * nN; G = G_; c = c_; }
    __host__ __device__ bool next(int i, Unit& u) const {
        const long L = (long)i * G + c; if (L >= nwg) return false;
        int wgid = (int)L; { const int q = nwg / NXCD, r = nwg % NXCD, xcd = wgid % NXCD, off = wgid / NXCD; wgid = (xcd < r ? xcd * (q + 1) : r * (q + 1) + (xcd - r) * q) + off; }
        const int nig = WGM * nN, gid = wgid / nig, fm = gid * WGM, gsz = (nM - fm) < WGM ? (nM - fm) : WGM;
        u.pm = fm + ((wgid % nig) % gsz); u.pn = (wgid % nig) / gsz; u.e = 0; u.koff = 0; return true;
    }
};
struct MoeOrder : StaticOrder {
    int t0, t1, t2, t3, t4, t5, t6;
    const volatile PG8_LAS int* lay;
    const int* list;
    __device__ __forceinline__ int gather_row(const Unit& u, int slot) const { const int rank = slot - lay[40 + u.e]; return rank < lay[32 + u.e] ? list[(size_t)u.e * 16384 + rank] : 0; }
    __host__ __device__ bool next(int i, Unit& u) const {
        if (!StaticOrder::next(i, u)) return false;
        const int p = u.pm; u.e = (p >= t0) + (p >= t1) + (p >= t2) + (p >= t3) + (p >= t4) + (p >= t5) + (p >= t6); return true;
    }
};

struct MoeTailOrder {
    int pm0, ntail, nN, G, c, khalf; int t0, t1, t2, t3, t4, t5, t6;
    __device__ __forceinline__ int gather_row(const Unit&, int slot) const { return slot; }
    __device__ __forceinline__ bool next(int i, Unit& u) const {
        const int L = i * G + c; if (L >= ntail * nN * 2) return false;
        const int kh = L & 1, q = L >> 1; u.pn = q % nN; u.pm = pm0 + q / nN; u.koff = kh * khalf;
        const int p = u.pm; u.e = (p >= t0) + (p >= t1) + (p >= t2) + (p >= t3) + (p >= t4) + (p >= t5) + (p >= t6); return true;
    }
};
struct MoeTailOrder2 {
    int pm0, ntail, nN, G, c, koff; int t0, t1, t2, t3, t4, t5, t6;
    __device__ __forceinline__ int gather_row(const Unit&, int slot) const { return slot; }
    __device__ __forceinline__ bool next(int i, Unit& u) const {
        const int L = i * G + c; if (L >= ntail * nN) return false;
        u.pn = L % nN; u.pm = pm0 + L / nN; u.koff = koff;
        const int p = u.pm; u.e = (p >= t0) + (p >= t1) + (p >= t2) + (p >= t3) + (p >= t4) + (p >= t5) + (p >= t6); return true;
    }
};
__device__ __forceinline__ unsigned cvt_pk_bf16(float lo, float hi) { unsigned r; asm volatile("v_cvt_pk_bf16_f32 %0, %1, %2" : "=v"(r) : "v"(lo), "v"(hi)); return r; }

typedef int v8i __attribute__((ext_vector_type(8)));
typedef int v4i __attribute__((ext_vector_type(4)));
template <class Epi, class Sched, bool ALIGN_EPI, bool GATHER = false, bool FP8 = false>
__device__ __forceinline__ void gemm_phase(PG8_LAS unsigned char* lds, const Gemm g, const Sched& S, const Epi& E, const int wid) {
    int lane = (int)__builtin_amdgcn_mbcnt_hi(~0u, __builtin_amdgcn_mbcnt_lo(~0u, 0u)); asm volatile("" : "+v"(lane));
    const int tid = wid * 64 + lane, wr = wid >> 2, wc = wid & 3, fr = lane & 15, fq = lane >> 4;
    const int K = g.K, nt = K / BK;
    unsigned cvo[4], nvo[4], voffB[2]; int rowA[2], colA[2];
#pragma unroll
    for (int i = 0; i < 2; ++i) { int R, C; stage_rc(tid * 16 + i * 8192, R, C); const int Rb = (R & ~31) + perm32(R & 31); rowA[i] = R; colA[i] = C;
        voffB[i] = (unsigned)(Rb * g.ldb + C) * 2u; }
    const size_t kstep = (size_t)(BK * 2);
    const size_t hstepB = (size_t)HALF * g.ldb * 2;
    const size_t tstepA = GATHER ? (size_t)0 : (size_t)2 * HALF * g.lda * 2, tstepB = 2 * hstepB;
#define PG8_ROWOFFS(vo, u) do { _Pragma("unroll") for (int _h = 0; _h < 2; ++_h) _Pragma("unroll") for (int _i = 0; _i < 2; ++_i) { \
        const int _r = _h * HALF + rowA[_i]; const unsigned _row = GATHER ? (unsigned)S.gather_row(u, (u).pm * BM + _r) : (unsigned)_r; \
        (vo)[2 * _h + _i] = (_row * (unsigned)g.lda + (unsigned)colA[_i]) * 2u; } } while (0)
    const unsigned ldsw = (unsigned)wid * 1024u;
    const int aoff = lds_byte(wr * 64 + fr, fq * 8), boff = lds_byte(wc * 32 + fr, fq * 8);
#define PG8_SA(b, h) (((b) * 2 + (h)) * HTB)
#define PG8_SB(b, h) ((4 + (b) * 2 + (h)) * HTB)
#define PG8_STAGE(bufoff, gbase, voff) do { _Pragma("unroll") for (int _i = 0; _i < 2; ++_i) \
        __builtin_amdgcn_global_load_lds((const unsigned*)((const char*)(gbase) + (voff)[_i]), (PG8_LAS unsigned*)(lds + (bufoff) + ldsw + _i * 8192), 16, 0, 0); } while (0)
#define PG8_STAGEA(bufoff, gbase, vo, h) do { _Pragma("unroll") for (int _i = 0; _i < 2; ++_i) \
        __builtin_amdgcn_global_load_lds((const unsigned*)((const char*)(gbase) + (vo)[2 * (h) + _i]), (PG8_LAS unsigned*)(lds + (bufoff) + ldsw + _i * 8192), 16, 0, 0); } while (0)
#define PG8_LDA(dst, b, h) do { _Pragma("unroll") for (int m = 0; m < 4; ++m) dst[m] = __builtin_shufflevector(*(const PG8_LAS v4i*)(lds + PG8_SA(b, h) + aoff + m * 2048), *(const PG8_LAS v4i*)(lds + PG8_SA(b, h) + aoff + m * 2048 + 1024), 0, 1, 2, 3, 4, 5, 6, 7); } while (0)
#define PG8_LDB(dst, b, h) do { _Pragma("unroll") for (int n = 0; n < 2; ++n) dst[n] = __builtin_shufflevector(*(const PG8_LAS v4i*)(lds + PG8_SB(b, h) + boff + n * 2048), *(const PG8_LAS v4i*)(lds + PG8_SB(b, h) + boff + n * 2048 + 1024), 0, 1, 2, 3, 4, 5, 6, 7); } while (0)
#define PG8_HALF(x, k) __builtin_bit_cast(bf16x8, __builtin_shufflevector(x, x, 4 * (k), 4 * (k) + 1, 4 * (k) + 2, 4 * (k) + 3))
#define PG8_MMA(ai, bj, At, Bt) do { if constexpr (FP8) __builtin_amdgcn_sched_barrier(0); __builtin_amdgcn_s_setprio(1); _Pragma("unroll") for (int m = 0; m < 4; ++m) _Pragma("unroll") for (int n = 0; n < 2; ++n) { \
        if constexpr (FP8) acc[ai][bj][m][n] = __builtin_amdgcn_mfma_scale_f32_16x16x128_f8f6f4(Bt[n], At[m], acc[ai][bj][m][n], 0, 0, 0, 0x7f7f7f7f, 0, 0x7f7f7f7f); \
        else { acc[ai][bj][m][n] = __builtin_amdgcn_mfma_f32_16x16x32_bf16(PG8_HALF(Bt[n], 0), PG8_HALF(At[m], 0), acc[ai][bj][m][n], 0, 0, 0); \
               acc[ai][bj][m][n] = __builtin_amdgcn_mfma_f32_16x16x32_bf16(PG8_HALF(Bt[n], 1), PG8_HALF(At[m], 1), acc[ai][bj][m][n], 0, 0, 0); } } \
        if constexpr (FP8) { _Pragma("unroll") for (int m = 0; m < 4; ++m) _Pragma("unroll") for (int n = 0; n < 2; ++n) asm volatile("" : "+v"(acc[ai][bj][m][n])); }   \
        __builtin_amdgcn_s_setprio(0); if constexpr (FP8) __builtin_amdgcn_sched_barrier(0); } while (0)
#define PG8_WAIT_V(n) asm volatile("s_waitcnt vmcnt(" #n ")" ::: "memory")
#define PG8_WAIT_L(n) asm volatile("s_waitcnt lgkmcnt(" #n ")" ::: "memory")
#define PG8_BAR __builtin_amdgcn_s_barrier()
#define PG8_SCHED __builtin_amdgcn_sched_barrier(0)
    Unit cur, nxt; int ui = 0;
    if (!S.next(0, cur)) return;
    cur.idx = 0;
    f32x4 acc[2][2][4][2];
#pragma unroll
    for (int a = 0; a < 2; ++a)
#pragma unroll
        for (int b = 0; b < 2; ++b)
#pragma unroll
            for (int m = 0; m < 4; ++m)
#pragma unroll
                for (int n = 0; n < 2; ++n) acc[a][b][m][n] = (f32x4){0.f, 0.f, 0.f, 0.f};
    v8i At[4], B0[2], B1[2];
    const char* cA = (const char*)g.A + (size_t)cur.pm * tstepA + cur.koff; const char* cB = (const char*)g.Bt + (size_t)cur.e * g.estride + (size_t)cur.pn * tstepB + cur.koff;
    PG8_ROWOFFS(cvo, cur);
#pragma unroll
    for (int i = 0; i < 4; ++i) nvo[i] = cvo[i];
    PG8_STAGE(PG8_SB(0, 0), cB, voffB); PG8_STAGE(PG8_SB(0, 1), cB + hstepB, voffB); PG8_STAGEA(PG8_SA(0, 0), cA, cvo, 0); PG8_STAGEA(PG8_SA(0, 1), cA, cvo, 1);
    if (wr == 1) PG8_BAR;
    PG8_WAIT_V(2); PG8_BAR;
    PG8_STAGE(PG8_SB(1, 0), cB + kstep, voffB); PG8_STAGEA(PG8_SA(1, 0), cA + kstep, cvo, 0); PG8_STAGE(PG8_SB(1, 1), cB + hstepB + kstep, voffB);
    PG8_WAIT_V(6); PG8_BAR;
    for (;;) {
        const bool has_next = S.next(ui + 1, nxt); nxt.idx = ui + 1;
        const char* nA = has_next ? (const char*)g.A + (size_t)nxt.pm * tstepA + nxt.koff : cA;
        const char* nB = has_next ? (const char*)g.Bt + (size_t)nxt.e * g.estride + (size_t)nxt.pn * tstepB + nxt.koff : cB;
        if constexpr (GATHER) { if (has_next) PG8_ROWOFFS(nvo, nxt); }
        for (int t = 0; t < nt; t += 2) {
            const bool last = (t == nt - 2);
            const char* a1 = cA + (size_t)(t + 1) * kstep;
            const char* a2 = last ? nA : cA + (size_t)(t + 2) * kstep; const char* b2 = last ? nB : cB + (size_t)(t + 2) * kstep;
            const char* a3 = a2 + kstep; const char* b3 = b2 + kstep;
            unsigned vo2[4];
#pragma unroll
            for (int i = 0; i < 4; ++i) vo2[i] = (GATHER && last) ? nvo[i] : cvo[i];
            PG8_LDB(B0, 0, 0); PG8_LDB(B1, 0, 1); PG8_SCHED; PG8_LDA(At, 0, 0); PG8_STAGEA(PG8_SA(1, 1), a1, cvo, 1);
            PG8_WAIT_V(8); PG8_WAIT_L(0); PG8_BAR; PG8_MMA(0, 0, At, B0); PG8_MMA(0, 1, At, B1); PG8_BAR; PG8_SCHED;
            PG8_LDA(At, 0, 1); PG8_STAGE(PG8_SB(0, 0), b2, voffB); PG8_STAGE(PG8_SB(0, 1), b2 + hstepB, voffB); PG8_STAGEA(PG8_SA(0, 0), a2, vo2, 0);
            PG8_WAIT_V(8); PG8_WAIT_L(0); PG8_BAR; PG8_MMA(1, 0, At, B0); PG8_MMA(1, 1, At, B1); PG8_BAR; PG8_SCHED;
            PG8_LDB(B0, 1, 0); PG8_LDB(B1, 1, 1); PG8_SCHED; PG8_LDA(At, 1, 0); PG8_STAGEA(PG8_SA(0, 1), a2, vo2, 1);
            PG8_WAIT_V(8); PG8_WAIT_L(0); PG8_BAR; PG8_MMA(0, 0, At, B0); PG8_MMA(0, 1, At, B1); PG8_BAR; PG8_SCHED;
            PG8_LDA(At, 1, 1); PG8_STAGE(PG8_SB(1, 0), b3, voffB); PG8_STAGE(PG8_SB(1, 1), b3 + hstepB, voffB); PG8_STAGEA(PG8_SA(1, 0), a3, vo2, 0);
            PG8_WAIT_V(8); PG8_WAIT_L(0); PG8_BAR; PG8_MMA(1, 0, At, B0); PG8_MMA(1, 1, At, B1); PG8_BAR; PG8_SCHED;
        }
        if constexpr (ALIGN_EPI) { if (wr == 0) PG8_BAR; }
        E(acc, cur, wr, wc, fr, fq);
        if (!has_next) break;
#pragma unroll
        for (int a = 0; a < 2; ++a)
#pragma unroll
            for (int b = 0; b < 2; ++b)
#pragma unroll
                for (int m = 0; m < 4; ++m)
#pragma unroll
                    for (int n = 0; n < 2; ++n) acc[a][b][m][n] = (f32x4){0.f, 0.f, 0.f, 0.f};
        cur = nxt; cA = nA; cB = nB; ++ui;
        if constexpr (GATHER) {
#pragma unroll
            for (int i = 0; i < 4; ++i) cvo[i] = nvo[i]; }
        if constexpr (ALIGN_EPI) { if (wr == 1) PG8_BAR; }
    }
    PG8_WAIT_V(0);
    if constexpr (!ALIGN_EPI) { if (wr == 0) PG8_BAR; }
    PG8_BAR;
#undef PG8_SA
#undef PG8_SB
#undef PG8_STAGE
#undef PG8_STAGEA
#undef PG8_ROWOFFS
#undef PG8_LDA
#undef PG8_LDB
#undef PG8_MMA
#undef PG8_HALF
#undef PG8_WAIT_V
#undef PG8_WAIT_L
#undef PG8_BAR
#undef PG8_SCHED
}
}

constexpr int NB = 8, SEQ = 2048, D = 1024, T = NB * SEQ;
constexpr int MEML = 256, TM = NB * MEML;
constexpr int HYC = 512, NZ0 = 2048;
constexpr int FF = 2816, NGU = 2 * FF;
constexpr int ATW = 1536, NQKV = 3 * ATW, NQ1 = NQKV + 512;
constexpr int NE = 8, PMAX = 2 * T + NE * 256;
constexpr float EPS = 1e-6f;
constexpr float MOE_WGU_SCALE = 32.0f, MOE_WD_SCALE = 64.0f;
constexpr int NWAVES = 8;

constexpr size_t MiB = 1u << 20;
constexpr size_t WS_CTL = 0, CTL_ZERO_BYTES = 1 * MiB;
constexpr size_t WS_WGU1 = 1 * MiB;
constexpr size_t WS_WD1 = 89 * MiB;
constexpr size_t WS_SMALL = 133 * MiB;
constexpr size_t WS_RSTD0 = WS_SMALL;
constexpr size_t WS_SSQ16 = WS_SMALL + 64 * 1024;
constexpr size_t WS_LSE = WS_SSQ16 + 1 * MiB;
constexpr size_t WS_TOKE = WS_LSE + 768 * 1024;
constexpr size_t WS_TOKR = WS_TOKE + 128 * 1024;
constexpr size_t WS_TOKG = WS_TOKR + 128 * 1024;
constexpr size_t WS_RSTD3 = WS_TOKG + 128 * 1024;
constexpr size_t WS_LIST = WS_RSTD3 + 64 * 1024;
constexpr size_t WS_RSTDS = WS_LIST + 512 * 1024;
static_assert(WS_RSTDS + PMAX * 4 <= WS_SMALL + 4 * MiB, "small region");
constexpr size_t WS_WO = 137 * MiB;
constexpr size_t WS_WIN1 = 141 * MiB;
constexpr size_t WS_WKV = 151 * MiB;
constexpr size_t WS_WIN0 = 155 * MiB;
constexpr size_t WS_WGU0 = 159 * MiB;
constexpr size_t WS_WD0 = 170 * MiB;
constexpr size_t WS_KV = 176 * MiB;
constexpr size_t WS_XB = 184 * MiB;
constexpr size_t WS_YT = 336 * MiB;
constexpr size_t WS_MIX0 = 216 * MiB;
constexpr size_t WS_MN = 248 * MiB;
constexpr size_t WS_ZT = 256 * MiB;
constexpr size_t WS_XQ0 = 304 * MiB;
constexpr size_t WS_HF = 320 * MiB;
constexpr size_t WS_HID0 = 248 * MiB;
constexpr size_t WS_QKV1 = 248 * MiB;
constexpr size_t WS_XQ1 = 392 * MiB;
constexpr size_t WS_OG12 = 216 * MiB;
constexpr size_t WS_MIX1 = 141 * MiB;
constexpr size_t WS_XB3 = 137 * MiB;
constexpr size_t WS_XS = 137 * MiB;
constexpr size_t WS_HID1 = 205 * MiB;
constexpr size_t WS_Y2 = 392 * MiB;
constexpr size_t WS_END = 408 * MiB;
static_assert(WS_HID1 + (size_t)PMAX * FF * 2 <= WS_END && WS_XQ1 + (size_t)T * 512 * 2 <= WS_END && WS_XS + (size_t)PMAX * 2048 <= WS_HID1, "ws map");

constexpr int CW_CNT = 64;
constexpr int CW_BAR = 4096;

constexpr int SCR_BYTES = 155648;
constexpr int MISC_OFF = SCR_BYTES;
constexpr int LDS_BYTES = SCR_BYTES + 4096;

#define LAS __attribute__((address_space(3)))
typedef unsigned short bf16;
typedef unsigned v4u __attribute__((ext_vector_type(4)));
typedef unsigned v2u __attribute__((ext_vector_type(2)));
typedef float f32x4 __attribute__((ext_vector_type(4)));
typedef float f32x2 __attribute__((ext_vector_type(2)));
#define LDS_WAIT() asm volatile("s_waitcnt lgkmcnt(0)" ::: "memory")
__device__ __forceinline__ unsigned f2bf(float f) { unsigned u = __builtin_bit_cast(unsigned, f); return (u + 0x7fffu + ((u >> 16) & 1u)) >> 16; }
__device__ __forceinline__ unsigned pk2(float lo, float hi) { unsigned r; asm("v_cvt_pk_bf16_f32 %0, %1, %2" : "=v"(r) : "v"(lo), "v"(hi)); return r; }
__device__ __forceinline__ unsigned pk4_fp8(float a, float b, float c, float d) { unsigned w = 0u; w = __builtin_amdgcn_cvt_pk_fp8_f32(a, b, w, false); w = __builtin_amdgcn_cvt_pk_fp8_f32(c, d, w, true); return w; }
__device__ __forceinline__ float bflo(unsigned w) { return __builtin_bit_cast(float, w << 16); }
__device__ __forceinline__ float bfhi(unsigned w) { return __builtin_bit_cast(float, w & 0xffff0000u); }
__device__ __forceinline__ float bf1(bf16 b) { return __builtin_bit_cast(float, ((unsigned)b) << 16); }
__device__ __forceinline__ float wave_sum(float v) {
#pragma unroll
    for (int o = 1; o < 64; o <<= 1) v += __shfl_xor(v, o);
    return v;
}
__device__ __forceinline__ float wave_max(float v) {
#pragma unroll
    for (int o = 1; o < 64; o <<= 1) v = fmaxf(v, __shfl_xor(v, o));
    return v;
}

#define XB_TMO      128
#define XB_XCNT(j)  (256  + 64 * (j))
#define XB_XSUB(j)  (1280 + 64 * (j))
#define XB_XGEN(j)  (2304 + 64 * (j))
#define XB_TOP      3328
#define XB_TOPGEN   3392
#define XCD_BAR_WORDS 3456
#define XB_SPIN_CAP (1u << 18)

__device__ __forceinline__ unsigned xb_ld(unsigned* p)              { return __hip_atomic_load(p, __ATOMIC_RELAXED, __HIP_MEMORY_SCOPE_AGENT); }
__device__ __forceinline__ unsigned xb_add(unsigned* p, unsigned v) { return __hip_atomic_fetch_add(p, v, __ATOMIC_RELAXED, __HIP_MEMORY_SCOPE_AGENT); }
__device__ __forceinline__ unsigned xb_xcc_id() { return (unsigned)__builtin_amdgcn_s_getreg((3 << 11) | 20) & 0xFu; }
#define XB_SPIN(cond, bar) do { unsigned _sp = 0; while (cond) { __builtin_amdgcn_s_sleep(1); \
    if ((++_sp & 255u) == 0u) { if (xb_ld(&(bar)[XB_TMO])) break; if (_sp > XB_SPIN_CAP) { atomicAdd(&(bar)[XB_TMO], 1u); break; } } } } while (0)

struct XcdBarrier {
    unsigned* bar; unsigned x;
    volatile LAS unsigned* st;
};
__device__ __forceinline__ XcdBarrier xcd_barrier_post(unsigned* bar, volatile LAS unsigned* st, int tid) {
    XcdBarrier b; b.bar = bar; b.x = xb_xcc_id(); b.st = st;
    if (tid == 0) (void)xb_add(&bar[XB_XCNT(b.x)], 1u);
    return b;
}
__device__ __forceinline__ void xcd_barrier_complete(unsigned* bar, unsigned x, unsigned& nloc, unsigned& nx) {
    const unsigned G = gridDim.x * gridDim.y * gridDim.z;
    unsigned sum, cnt, mine, sp = 0u;
    for (;;) {
        sum = 0u; cnt = 0u; mine = 0u;
#pragma unroll
        for (unsigned j = 0; j < 16; ++j) { const unsigned c = xb_ld(&bar[XB_XCNT(j)]); sum += c; cnt += (c > 0u) ? 1u : 0u; mine = (j == x) ? c : mine; }
        if (sum == G) break;
        __builtin_amdgcn_s_sleep(1);
        if ((++sp & 255u) == 0u) { if (xb_ld(&bar[XB_TMO])) break; if (sp > XB_SPIN_CAP) { atomicAdd(&bar[XB_TMO], 1u); break; } }
    }
    nloc = mine > 0u ? mine : 1u; nx = cnt > 0u ? cnt : 1u;
}
__device__ __forceinline__ void xcd_barrier(const XcdBarrier& b, int tid) {
    asm volatile("s_waitcnt vmcnt(0)" ::: "memory");
    __syncthreads();
    if (tid == 0) {
        unsigned* bar = b.bar;
        __builtin_amdgcn_s_waitcnt(0);
        unsigned nloc = b.st[0], nx = b.st[1];
        if (nloc == 0u) { xcd_barrier_complete(bar, b.x, nloc, nx); b.st[0] = nloc; b.st[1] = nx; }
        const unsigned old = xb_add(&bar[XB_XSUB(b.x)], 1u);
        const unsigned gen = old / nloc;
        if (old + 1u == (gen + 1u) * nloc) {
            __builtin_amdgcn_fence(__ATOMIC_RELEASE, "agent");
            asm volatile("s_waitcnt vmcnt(0)" ::: "memory");
            const unsigned og = xb_add(&bar[XB_TOP], 1u);
            const unsigned tg = og / nx;
            if (og + 1u == (tg + 1u) * nx) xb_add(&bar[XB_TOPGEN], 1u);
            else XB_SPIN(xb_ld(&bar[XB_TOPGEN]) == tg, bar);
            __builtin_amdgcn_fence(__ATOMIC_ACQUIRE, "agent");
            xb_add(&bar[XB_XGEN(b.x)], 1u);
            asm volatile("s_waitcnt vmcnt(0)" ::: "memory");
        } else {
            XB_SPIN(xb_ld(&bar[XB_XGEN(b.x)]) == gen, bar);
            __builtin_amdgcn_fence(__ATOMIC_ACQUIRE, "agent");
            asm volatile("s_waitcnt vmcnt(0)" ::: "memory");
        }
    }
    __syncthreads();
}

struct Args { const float* in[30]; float* out; unsigned char* ws; int ph_lo, ph_hi, bslot, pad; };
enum { I_X = 0, I_MEM, I_RELB, I_NMIX, I_NMEM, I_NFFN, I_WKV, I_XQN, I_XKN, I_WOUT, I_HYWIN, I_HYCW, I_HYCB, I_FW1, I_FB1, I_FW2, I_FB2, I_FW3, I_FREQ, I_SKIP,
       I_ATWIN, I_ATQN, I_ATKN, I_FFG, I_FFU, I_FFD, I_ROUTER, I_MOEG, I_MOEU, I_MOED };

struct Frame {
    LAS unsigned char* lds;
    unsigned char* ws;
    int tid, lane, wave, G, bid;
};

constexpr int RSL_OFF = 131072;
template <int SCALE> struct EpiB {
    bf16* O; int ldc; const float* sc; int split_tile; bf16* O2; int ldc2; const LAS float* rsl; float kc;
    __device__ __forceinline__ void operator()(const f32x4 (&acc)[2][2][4][2], const pg8::Unit& u, int wr, int wc, int fr, int fq) const {
        const int row0 = u.pm * 256 + wr * 64 + fr;
        bf16* base = O; int ld = ldc; int colt = u.pn * 256;
        if (u.pn >= split_tile) { base = O2; ld = ldc2; colt -= split_tile * 256; }
        if (u.koff != 0) base = O2;
        const int col0 = colt + wc * 32 + 8 * fq;
        float rsv[2][4];
        if (SCALE == 1) {
#pragma unroll
            for (int ai = 0; ai < 2; ++ai)
#pragma unroll
                for (int m = 0; m < 4; ++m) rsv[ai][m] = sc[row0 + ai * 128 + m * 16];
            asm volatile("s_waitcnt vmcnt(0)" ::: "memory");
        }
        f32x4 cs[2][2];
        if (SCALE == 3) {
#pragma unroll
            for (int bj = 0; bj < 2; ++bj)
#pragma unroll
                for (int n = 0; n < 2; ++n) cs[bj][n] = *(const f32x4*)(sc + u.pn * 256 + bj * 128 + wc * 32 + 8 * fq + 4 * n);
            asm volatile("s_waitcnt vmcnt(0)" ::: "memory");
        }
#pragma unroll
        for (int ai = 0; ai < 2; ++ai)
#pragma unroll
            for (int m = 0; m < 4; ++m) {
                const int row = row0 + ai * 128 + m * 16;
                float rs = 1.f;
                if (SCALE == 1) rs = rsv[ai][m];
                if (SCALE == 2) { const f32x4* p = (const f32x4*)(sc + (size_t)row * 16); const f32x4 a = p[0], b = p[1], c = p[2], d = p[3];
                    const float s = ((a.x + a.y) + (a.z + a.w)) + ((b.x + b.y) + (b.z + b.w)) + ((c.x + c.y) + (c.z + c.w)) + ((d.x + d.y) + (d.z + d.w));
                    rs = 1.0f / sqrtf(s * (1.0f / D) + EPS); }
                if (SCALE == 4) rs = rsl[u.idx * 256 + (row - u.pm * 256)];
                if (SCALE == 5) rs = kc;
                bf16* rowp = base + (size_t)row * ld + col0;
#pragma unroll
                for (int bj = 0; bj < 2; ++bj) {
                    f32x4 v0 = acc[ai][bj][m][0], v1 = acc[ai][bj][m][1];
                    if (SCALE == 1 || SCALE == 2 || SCALE == 4 || SCALE == 5) { v0 = v0 * rs; v1 = v1 * rs; }
                    if (SCALE == 3) { v0 = v0 * cs[bj][0]; v1 = v1 * cs[bj][1]; }
                    v4u w; w.x = pk2(v0[0], v0[1]); w.y = pk2(v0[2], v0[3]); w.z = pk2(v1[0], v1[1]); w.w = pk2(v1[2], v1[3]);
                    *(v4u*)(rowp + bj * 128) = w;
                }
            }
    }
};
template <bool XF32, bool SSQ> struct EpiRes {
    const float* xf; const bf16* xi; int ldi; bf16* xo; int ldo; float* ssq16;
    __device__ __forceinline__ void operator()(const f32x4 (&acc)[2][2][4][2], const pg8::Unit& u, int wr, int wc, int fr, int fq) const {
        const int row0 = u.pm * 256 + wr * 64 + fr, col0 = u.pn * 256 + wc * 32 + 8 * fq;
        if constexpr (!XF32) {
            v4u res[2][4][2];
#pragma unroll
            for (int ai = 0; ai < 2; ++ai)
#pragma unroll
                for (int m = 0; m < 4; ++m)
#pragma unroll
                    for (int bj = 0; bj < 2; ++bj) res[ai][m][bj] = *(const v4u*)(xi + (size_t)(row0 + ai * 128 + m * 16) * ldi + col0 + bj * 128);
            asm volatile("s_waitcnt vmcnt(0)" ::: "memory");
#pragma unroll
            for (int ai = 0; ai < 2; ++ai)
#pragma unroll
                for (int m = 0; m < 4; ++m) {
                    const int row = row0 + ai * 128 + m * 16;
                    float ss = 0.f;
#pragma unroll
                    for (int bj = 0; bj < 2; ++bj) {
                        const v4u w0 = res[ai][m][bj];
                        const f32x4 r0 = (f32x4){bflo(w0.x), bfhi(w0.x), bflo(w0.y), bfhi(w0.y)}, r1 = (f32x4){bflo(w0.z), bfhi(w0.z), bflo(w0.w), bfhi(w0.w)};
                        const f32x4 v0 = acc[ai][bj][m][0] + r0, v1 = acc[ai][bj][m][1] + r1;
                        v4u w; w.x = pk2(v0[0], v0[1]); w.y = pk2(v0[2], v0[3]); w.z = pk2(v1[0], v1[1]); w.w = pk2(v1[2], v1[3]);
                        *(v4u*)(xo + (size_t)row * ldo + col0 + bj * 128) = w;
                        if (SSQ) ss += ((v0[0] * v0[0] + v0[1] * v0[1]) + (v0[2] * v0[2] + v0[3] * v0[3])) + ((v1[0] * v1[0] + v1[1] * v1[1]) + (v1[2] * v1[2] + v1[3] * v1[3]));
                    }
                    if (SSQ) { ss += __shfl_xor(ss, 16); ss += __shfl_xor(ss, 32);
                        if (fq == 0) ssq16[(size_t)row * 16 + u.pn * 4 + wc] = ss; }
                }
        } else {
#pragma unroll
            for (int ai = 0; ai < 2; ++ai)
#pragma unroll
                for (int m = 0; m < 4; ++m) {
                    const int row = row0 + ai * 128 + m * 16;
                    float ss = 0.f;
#pragma unroll
                    for (int bj = 0; bj < 2; ++bj) {
                        const size_t off = (size_t)row * D + col0 + bj * 128; const f32x4 r0 = *(const f32x4*)(xf + off), r1 = *(const f32x4*)(xf + off + 4);
                        const f32x4 v0 = acc[ai][bj][m][0] + r0, v1 = acc[ai][bj][m][1] + r1;
                        v4u w; w.x = pk2(v0[0], v0[1]); w.y = pk2(v0[2], v0[3]); w.z = pk2(v1[0], v1[1]); w.w = pk2(v1[2], v1[3]);
                        *(v4u*)(xo + (size_t)row * ldo + col0 + bj * 128) = w;
                        if (SSQ) ss += ((v0[0] * v0[0] + v0[1] * v0[1]) + (v0[2] * v0[2] + v0[3] * v0[3])) + ((v1[0] * v1[0] + v1[1] * v1[1]) + (v1[2] * v1[2] + v1[3] * v1[3]));
                    }
                    if (SSQ) { ss += __shfl_xor(ss, 16); ss += __shfl_xor(ss, 32);
                        if (fq == 0) ssq16[(size_t)row * 16 + u.pn * 4 + wc] = ss; }
                }
        }
    }
};
template <int SCALE, bool OUT8 = false> struct EpiSwiglu {
    bf16* H; int ldh; const float* sc; const LAS float* rsl; float kc;
    __device__ __forceinline__ void operator()(const f32x4 (&acc)[2][2][4][2], const pg8::Unit& u, int wr, int wc, int fr, int fq) const {
        const int row0 = u.pm * 256 + wr * 64 + fr, col0 = u.pn * 128 + wc * 32 + 8 * fq;
#pragma unroll
        for (int ai = 0; ai < 2; ++ai)
#pragma unroll
            for (int m = 0; m < 4; ++m) {
                const int row = row0 + ai * 128 + m * 16;
                float rs = 1.f;
                if (SCALE == 1) rs = sc[row];
                if (SCALE == 2) { const f32x4* p = (const f32x4*)(sc + (size_t)row * 16); const f32x4 a = p[0], b = p[1], c = p[2], d = p[3];
                    const float s = ((a.x + a.y) + (a.z + a.w)) + ((b.x + b.y) + (b.z + b.w)) + ((c.x + c.y) + (c.z + c.w)) + ((d.x + d.y) + (d.z + d.w));
                    rs = 1.0f / sqrtf(s * (1.0f / D) + EPS); }
                if (SCALE == 4) rs = rsl[u.idx * 256 + (row - u.pm * 256)];
                if (SCALE == 5) rs = kc;
                float h[8];
#pragma unroll
                for (int n = 0; n < 2; ++n)
#pragma unroll
                    for (int j = 0; j < 4; ++j) { const float gv = acc[ai][0][m][n][j] * rs, uv = acc[ai][1][m][n][j] * rs;
                        h[n * 4 + j] = gv * uv * __builtin_amdgcn_rcpf(1.0f + __expf(-gv)); }
                if (OUT8) { v2u w; w.x = pk4_fp8(h[0], h[1], h[2], h[3]); w.y = pk4_fp8(h[4], h[5], h[6], h[7]); *(v2u*)((unsigned char*)H + (size_t)row * ldh + col0) = w; }
                else { v4u w; w.x = pk2(h[0], h[1]); w.y = pk2(h[2], h[3]); w.z = pk2(h[4], h[5]); w.w = pk2(h[6], h[7]);
                    *(v4u*)(H + (size_t)row * ldh + col0) = w; }
            }
    }
};

template <class Sched>
__device__ __forceinline__ void fill_rstd_table(LAS unsigned char* lds, const Sched& S, const float* ssq16, int tid) {
    LAS float* rsl = (LAS float*)(lds + RSL_OFF);
    pg8::Unit u;
    for (int ui = 0; ui < 16 && S.next(ui, u); ++ui) {
        if (tid < 256) { const f32x4* p = (const f32x4*)(ssq16 + (size_t)(u.pm * 256 + tid) * 16); const f32x4 a = p[0], b = p[1], c = p[2], d = p[3];
            const float s = ((a.x + a.y) + (a.z + a.w)) + ((b.x + b.y) + (b.z + b.w)) + ((c.x + c.y) + (c.z + c.w)) + ((d.x + d.y) + (d.z + d.w));
            rsl[ui * 256 + tid] = 1.0f / sqrtf(s * (1.0f / D) + EPS); }
    }
    __syncthreads();
}

__device__ __forceinline__ void p0_transpose_item(const float* W, int K, int N, bf16* WT, const float* gain, int mode, LAS float* scr, int item, int lane) {
    const int nblk = N / 64, kb = item / nblk, nb = item % nblk, k0 = 64 * kb, n0 = 64 * nb;
    const int lr = lane >> 4, lc = lane & 15;
    f32x4 v[16];
#pragma unroll
    for (int i = 0; i < 16; ++i) v[i] = __builtin_nontemporal_load((const f32x4*)(W + (size_t)(k0 + 4 * i + lr) * N + n0 + 4 * lc));
    if (gain) {
#pragma unroll
        for (int i = 0; i < 16; ++i) v[i] = v[i] * gain[k0 + 4 * i + lr];
    }
#pragma unroll
    for (int i = 0; i < 16; ++i) { LAS float* s = scr + (4 * i + lr) * 65 + 4 * lc; s[0] = v[i].x; s[1] = v[i].y; s[2] = v[i].z; s[3] = v[i].w; }
    LDS_WAIT(); asm volatile("" ::: "memory");
    const int c = lane & 7;
    const int d0 = (mode == 0) ? n0 : (256 * (n0 / 128) + (n0 % 128) + (mode == 2 ? 128 : 0));
#pragma unroll
    for (int j = 0; j < 8; ++j) { const int n = (lane >> 3) + 8 * j; const LAS float* s = scr + (8 * c) * 65 + n;
        v4u o; o.x = pk2(s[0 * 65], s[1 * 65]); o.y = pk2(s[2 * 65], s[3 * 65]); o.z = pk2(s[4 * 65], s[5 * 65]); o.w = pk2(s[6 * 65], s[7 * 65]);
        *(v4u*)(WT + (size_t)(d0 + n) * K + k0 + 8 * c) = o; }
    LDS_WAIT(); asm volatile("" ::: "memory");
}
__device__ __forceinline__ void p0_transpose_item8(const float* W, int K, int N, unsigned char* WT8, const float* gain, float s8, int mode, LAS float* scr, int item, int lane) {
    const int nblk = N / 64, kb = item / nblk, nb = item % nblk, k0 = 64 * kb, n0 = 64 * nb;
    const int lr = lane >> 4, lc = lane & 15;
    f32x4 v[16];
#pragma unroll
    for (int i = 0; i < 16; ++i) v[i] = __builtin_nontemporal_load((const f32x4*)(W + (size_t)(k0 + 4 * i + lr) * N + n0 + 4 * lc));
#pragma unroll
    for (int i = 0; i < 16; ++i) { const float g = gain ? gain[k0 + 4 * i + lr] * s8 : s8; v[i] = v[i] * g; }
#pragma unroll
    for (int i = 0; i < 16; ++i) { LAS float* s = scr + (4 * i + lr) * 65 + 4 * lc; s[0] = v[i].x; s[1] = v[i].y; s[2] = v[i].z; s[3] = v[i].w; }
    LDS_WAIT(); asm volatile("" ::: "memory");
    const int c = lane & 3;
    const int d0 = (mode == 0) ? n0 : (256 * (n0 / 128) + (n0 % 128) + (mode == 2 ? 128 : 0));
#pragma unroll
    for (int j = 0; j < 4; ++j) { const int n = (lane >> 2) + 16 * j; const LAS float* s = scr + (16 * c) * 65 + n;
        v4u o; o.x = pk4_fp8(s[0 * 65], s[1 * 65], s[2 * 65], s[3 * 65]); o.y = pk4_fp8(s[4 * 65], s[5 * 65], s[6 * 65], s[7 * 65]);
        o.z = pk4_fp8(s[8 * 65], s[9 * 65], s[10 * 65], s[11 * 65]); o.w = pk4_fp8(s[12 * 65], s[13 * 65], s[14 * 65], s[15 * 65]);
        __builtin_nontemporal_store(o, (v4u*)(WT8 + (size_t)(d0 + n) * K + k0 + 16 * c)); }
    LDS_WAIT(); asm volatile("" ::: "memory");
}
__device__ __forceinline__ float row_to_bf16(const float* xrow, bf16* orow, const float* gain, bool normalize, int lane) {
    const f32x4* xr = (const f32x4*)xrow + lane;
    f32x4 v[4]; float s = 0.f;
#pragma unroll
    for (int j = 0; j < 4; ++j) { v[j] = __builtin_nontemporal_load(xr + 64 * j); s += (v[j].x * v[j].x + v[j].y * v[j].y) + (v[j].z * v[j].z + v[j].w * v[j].w); }
    const float rstd = 1.0f / sqrtf(wave_sum(s) * (1.f / D) + EPS);
    unsigned long long* o8 = (unsigned long long*)orow + lane;
#pragma unroll
    for (int j = 0; j < 4; ++j) {
        f32x4 w = v[j];
        if (normalize) { const f32x4 g = ((const f32x4*)gain)[lane + 64 * j]; w = w * rstd * g; }
        o8[64 * j] = (unsigned long long)pk2(w.x, w.y) | ((unsigned long long)pk2(w.z, w.w) << 32);
    }
    return rstd;
}
__device__ __forceinline__ void p0_filter_block(Frame& F, const Args& a, float* Hf, int jb) {
    const float* w1 = a.in[I_FW1]; const float* b1 = a.in[I_FB1]; const float* w2 = a.in[I_FW2]; const float* b2 = a.in[I_FB2]; const float* w3 = a.in[I_FW3]; const float* fr = a.in[I_FREQ];
    LAS float* h2s = (LAS float*)(F.lds + MISC_OFF + 256);
    const int lane = F.lane, j0 = jb * 8;
    LAS float* W1s = (LAS float*)F.lds; LAS float* W2s = W1s + 33 * 64;
    for (int i = F.tid; i < 33 * 64; i += 512) W1s[i] = w1[i];
    for (int i = F.tid; i < 64 * 64; i += 512) W2s[i] = w2[i];
    __syncthreads();
    {
        const int j = j0 + F.wave;
        const float freq = fr[lane], bb1 = b1[lane], bb2 = b2[lane];
        float feat = 0.f;
        {
            const int fi = (lane >= 17) ? lane - 17 : lane - 1;
            const float f = 1e-4f + (float)fi * ((15.0f - 1e-4f) / 15.0f);
            const float ang = (6.283185307179586f / 2048.0f) * (float)j * f;
            if (lane == 0) feat = (float)j * (1.0f / 2047.0f);
            else if (lane <= 16) feat = cosf(ang);
            else if (lane <= 32) feat = -sinf(ang);
        }
        float s1 = bb1;
#pragma unroll
        for (int i = 0; i < 33; ++i) s1 += __shfl(feat, i) * W1s[i * 64 + lane];
        const float h1 = sinf(freq * s1);
        float s2 = bb2;
#pragma unroll 16
        for (int i = 0; i < 64; ++i) s2 += __shfl(h1, i) * W2s[i * 64 + lane];
        h2s[lane * 8 + F.wave] = sinf(freq * s2);
    }
    __syncthreads();
    const int n0 = F.wave * 256;
    float acc[4][8];
#pragma unroll
    for (int q = 0; q < 4; ++q)
#pragma unroll
        for (int jj = 0; jj < 8; ++jj) acc[q][jj] = 0.f;
#pragma unroll 1
    for (int i0 = 0; i0 < 64; i0 += 8) {
        float w[8][4];
#pragma unroll
        for (int ii = 0; ii < 8; ++ii)
#pragma unroll
            for (int q = 0; q < 4; ++q) w[ii][q] = w3[(size_t)(i0 + ii) * 2048 + n0 + q * 64 + lane];
#pragma unroll
        for (int ii = 0; ii < 8; ++ii) {
            const f32x4 ha = *(const LAS f32x4*)(h2s + (i0 + ii) * 8), hb = *(const LAS f32x4*)(h2s + (i0 + ii) * 8 + 4);
#pragma unroll
            for (int q = 0; q < 4; ++q) {
                acc[q][0] += ha.x * w[ii][q]; acc[q][1] += ha.y * w[ii][q]; acc[q][2] += ha.z * w[ii][q]; acc[q][3] += ha.w * w[ii][q];
                acc[q][4] += hb.x * w[ii][q]; acc[q][5] += hb.y * w[ii][q]; acc[q][6] += hb.z * w[ii][q]; acc[q][7] += hb.w * w[ii][q]; }
        }
    }
    const float da = -3.0701134573253945f, db = -15.350567286626973f;
#pragma unroll
    for (int q = 0; q < 4; ++q) {
        const int n = n0 + q * 64 + lane, c = n & 511;
        const float delta = fabsf(da + (db - da) * ((float)c * (1.0f / 511.0f)));
        float o[8];
#pragma unroll
        for (int jj = 0; jj < 8; ++jj) { const float t = (float)(j0 + jj) * (1.0f / 2047.0f); o[jj] = acc[q][jj] * (expf(-t * delta) + 0.05f); }
        f32x4* dst = (f32x4*)(Hf + (size_t)n * 2048 + j0);
        dst[0] = (f32x4){o[0], o[1], o[2], o[3]}; dst[1] = (f32x4){o[4], o[5], o[6], o[7]};
    }
    __syncthreads();
}
constexpr int IT_MOE = 16 * 44, N_MOE_ITEMS = 24 * IT_MOE;
constexpr int MOE_P1_HI = 5376, MOE_P5_MID = MOE_P1_HI + 4096, MOE_P5_HI = 16896, MOE_P0_LO = MOE_P5_HI;
__device__ __forceinline__ void moe_convert(Frame& F, const Args& a, int lo, int hi, int gwl, int ngw) {
    LAS float* scr = (LAS float*)(F.lds + F.wave * 16640);
    unsigned char* ws = F.ws;
    for (int r = lo + gwl; r < hi; r += ngw) {
        const int mid = r / IT_MOE, li = r % IT_MOE, kind = mid >> 3, e = mid & 7;
        if (kind == 0) p0_transpose_item8(a.in[I_MOEG] + (size_t)e * D * FF, D, FF, ws + WS_WGU1 + (size_t)e * NGU * D, a.in[I_NFFN] + D, MOE_WGU_SCALE, 1, scr, li, F.lane);
        else if (kind == 1) p0_transpose_item8(a.in[I_MOEU] + (size_t)e * D * FF, D, FF, ws + WS_WGU1 + (size_t)e * NGU * D, a.in[I_NFFN] + D, MOE_WGU_SCALE, 2, scr, li, F.lane);
        else p0_transpose_item8(a.in[I_MOED] + (size_t)e * FF * D, FF, D, ws + WS_WD1 + (size_t)e * D * FF, nullptr, MOE_WD_SCALE, 0, scr, li, F.lane);
    }
}
__device__ __forceinline__ void p0_prologue(Frame& F, const Args& a) {
    LAS float* scr = (LAS float*)(F.lds + F.wave * 16640);
    const int gw = F.bid * NWAVES + F.wave, NGW = F.G * NWAVES;
    unsigned char* ws = F.ws;
    if (!(F.bid & 1)) { for (int jb = F.bid; jb < 256; jb += F.G) p0_filter_block(F, a, (float*)(ws + WS_HF), jb); }
    for (int m = gw; m < T; m += NGW) { const float r = row_to_bf16(a.in[I_X] + (size_t)m * D, (bf16*)(ws + WS_XB) + (size_t)m * D, nullptr, false, F.lane); if (F.lane == 0) ((float*)(ws + WS_RSTD0))[m] = r; }
    for (int m = gw; m < 2 * TM; m += NGW) { const int l = m / TM, r = m % TM;
        (void)row_to_bf16(a.in[I_MEM] + (size_t)r * D, (bf16*)(ws + WS_MN) + (size_t)m * D, a.in[I_NMEM] + l * D, true, F.lane); }
    constexpr int IT_A = 16 * 32, IT_SQ = 16 * 16, IT_G = 16 * 44, IT_D = 44 * 16, IT_W1 = 16 * 80;
    constexpr int NSMALL = IT_A + 4 * IT_SQ + 2 * IT_G + IT_D + IT_W1;
    for (int it = gw; it < NSMALL; it += NGW) {
        int r = it;
        if (r < IT_A) { p0_transpose_item(a.in[I_HYWIN], D, NZ0, (bf16*)(ws + WS_WIN0), a.in[I_NMIX], 0, scr, r, F.lane); continue; } r -= IT_A;
        if (r < IT_SQ) { p0_transpose_item(a.in[I_WKV], D, D, (bf16*)(ws + WS_WKV), nullptr, 0, scr, r, F.lane); continue; } r -= IT_SQ;
        if (r < IT_SQ) { p0_transpose_item(a.in[I_WKV] + (size_t)D * D, D, D, (bf16*)(ws + WS_WKV) + (size_t)D * D, nullptr, 0, scr, r, F.lane); continue; } r -= IT_SQ;
        if (r < IT_SQ) { p0_transpose_item(a.in[I_WOUT], D, D, (bf16*)(ws + WS_WO), nullptr, 0, scr, r, F.lane); continue; } r -= IT_SQ;
        if (r < IT_SQ) { p0_transpose_item(a.in[I_WOUT] + (size_t)D * D, D, D, (bf16*)(ws + WS_WO) + (size_t)D * D, nullptr, 0, scr, r, F.lane); continue; } r -= IT_SQ;
        if (r < IT_G) { p0_transpose_item(a.in[I_FFG], D, FF, (bf16*)(ws + WS_WGU0), a.in[I_NFFN], 1, scr, r, F.lane); continue; } r -= IT_G;
        if (r < IT_G) { p0_transpose_item(a.in[I_FFU], D, FF, (bf16*)(ws + WS_WGU0), a.in[I_NFFN], 2, scr, r, F.lane); continue; } r -= IT_G;
        if (r < IT_D) { p0_transpose_item(a.in[I_FFD], FF, D, (bf16*)(ws + WS_WD0), nullptr, 0, scr, r, F.lane); continue; } r -= IT_D;
        p0_transpose_item(a.in[I_ATWIN], D, NQ1, (bf16*)(ws + WS_WIN1), a.in[I_NMIX] + D, 0, scr, r, F.lane);
    }
    moe_convert(F, a, (F.G == 256) ? MOE_P0_LO : 0, N_MOE_ITEMS, gw, NGW);
    if (F.bid & 1) { __syncthreads(); for (int jb = F.bid; jb < 256; jb += F.G) p0_filter_block(F, a, (float*)(ws + WS_HF), jb); }
}
__device__ __forceinline__ float block_sum(Frame& F, float v) {
    LAS float* red = (LAS float*)(F.lds + MISC_OFF + 64);
    v = wave_sum(v);
    __syncthreads();
    if (F.lane == 0) red[F.wave] = v;
    __syncthreads();
    float s = 0.f;
#pragma unroll
    for (int w = 0; w < NWAVES; ++w) s += red[w];
    return s;
}
__device__ __forceinline__ int rel_bucket_dev(int rel) {
    const int n = rel < 0 ? -rel : rel;
    const int large = 8 + (n >= 15) + (n >= 27) + (n >= 50) + (n >= 91) + (n >= 166) + (n >= 305) + (n >= 559);
    return (rel > 0 ? 16 : 0) + (n < 8 ? n : large);
}
__device__ __forceinline__ void merge_token(Frame& F, int token) {
    const bf16* og = (const bf16*)(F.ws + WS_OG12); const float* lse = (const float*)(F.ws + WS_LSE);
    bf16* mix = (bf16*)(F.ws + WS_MIX1);
    const int lane = F.lane, h = lane >> 4;
    const float l0 = lse[(size_t)token * 4 + h], l1 = lse[((size_t)T + token) * 4 + h], l2 = lse[((size_t)2 * T + token) * 4 + h];
    const float mx = fmaxf(l0, fmaxf(l1, l2));
    float w0 = __expf(l0 - mx), w1 = __expf(l1 - mx), w2 = __expf(l2 - mx);
    const float iz = 1.0f / (w0 + w1 + w2); w0 *= iz; w1 *= iz; w2 *= iz;
    const v4u a0 = *(const v4u*)(mix + (size_t)token * D + 8 * lane);
    const v4u a1 = __builtin_nontemporal_load((const v4u*)(og + (size_t)token * 512 + 8 * lane));
    const v4u a2 = __builtin_nontemporal_load((const v4u*)(og + ((size_t)T + token) * 512 + 8 * lane));
    v4u o;
    o.x = pk2(w0 * bflo(a0.x) + w1 * bflo(a1.x) + w2 * bflo(a2.x), w0 * bfhi(a0.x) + w1 * bfhi(a1.x) + w2 * bfhi(a2.x));
    o.y = pk2(w0 * bflo(a0.y) + w1 * bflo(a1.y) + w2 * bflo(a2.y), w0 * bfhi(a0.y) + w1 * bfhi(a1.y) + w2 * bfhi(a2.y));
    o.z = pk2(w0 * bflo(a0.z) + w1 * bflo(a1.z) + w2 * bflo(a2.z), w0 * bfhi(a0.z) + w1 * bfhi(a1.z) + w2 * bfhi(a2.z));
    o.w = pk2(w0 * bflo(a0.w) + w1 * bflo(a1.w) + w2 * bflo(a2.w), w0 * bfhi(a0.w) + w1 * bfhi(a1.w) + w2 * bfhi(a2.w));
    *(v4u*)(mix + (size_t)token * D + 8 * lane) = o;
}

constexpr int RT_OFF_R = 0, RT_OFF_REC = 32768, RT_OFF_CNT = 32768 + 64 * 32;
__device__ __forceinline__ void route_block(Frame& F, const Args& a, int blk) {
    LAS float* RL = (LAS float*)(F.lds + RT_OFF_R); volatile LAS int* REC = (volatile LAS int*)(F.lds + RT_OFF_REC); LAS int* CNT = (LAS int*)(F.lds + RT_OFF_CNT);
    const int lane = F.lane;
    const float* g = a.in[I_NFFN] + D; const float* rt = a.in[I_ROUTER];
    __syncthreads();
    for (int i = F.tid; i < 2048; i += 512) { const f32x4 r = ((const f32x4*)rt)[i]; const float gg = g[i >> 1]; ((LAS f32x4*)RL)[i] = r * gg; }
    if (F.tid < 16) CNT[F.tid] = 0;
    __syncthreads();
    for (int q = 0; q < 8; ++q) {
        const int tl = F.wave * 8 + q, token = blk * 64 + tl;
        const bf16* xr = (const bf16*)a.out + (size_t)token * 2048 + 1024;
        f32x4 v[4]; float s = 0.f;
#pragma unroll
        for (int j = 0; j < 4; ++j) { const v2u w = __builtin_nontemporal_load((const v2u*)xr + lane + 64 * j); v[j] = (f32x4){bflo(w.x), bfhi(w.x), bflo(w.y), bfhi(w.y)}; s += (v[j].x * v[j].x + v[j].y * v[j].y) + (v[j].z * v[j].z + v[j].w * v[j].w); }
        const float rstd = 1.0f / sqrtf(wave_sum(s) * (1.f / D) + EPS);
        { unsigned* o4 = (unsigned*)(F.ws + WS_XB3 + (size_t)token * D) + lane;
#pragma unroll
          for (int j = 0; j < 4; ++j) o4[64 * j] = pk4_fp8(v[j].x * rstd, v[j].y * rstd, v[j].z * rstd, v[j].w * rstd); }
        float lg[8];
#pragma unroll
        for (int e = 0; e < 8; ++e) lg[e] = 0.f;
#pragma unroll
        for (int j = 0; j < 4; ++j) {
            const int k0 = 4 * (lane + 64 * j);
#pragma unroll
            for (int qq = 0; qq < 4; ++qq) {
                const float hn = v[j][qq] * rstd;
                const f32x4 r0 = *(const LAS f32x4*)(RL + (k0 + qq) * 8), r1 = *(const LAS f32x4*)(RL + (k0 + qq) * 8 + 4);
                lg[0] += hn * r0.x; lg[1] += hn * r0.y; lg[2] += hn * r0.z; lg[3] += hn * r0.w;
                lg[4] += hn * r1.x; lg[5] += hn * r1.y; lg[6] += hn * r1.z; lg[7] += hn * r1.w;
            }
        }
#pragma unroll
        for (int e = 0; e < 8; ++e) lg[e] = wave_sum(lg[e]);
        int i1 = 0; float v1 = lg[0];
#pragma unroll
        for (int e = 1; e < 8; ++e) if (lg[e] > v1) { v1 = lg[e]; i1 = e; }
        int i2 = -1; float v2 = -3.0e38f;
#pragma unroll
        for (int e = 0; e < 8; ++e) if (e != i1 && lg[e] > v2) { v2 = lg[e]; i2 = e; }
        const float e2 = __expf(v2 - v1), g1 = 1.0f / (1.0f + e2), g2 = e2 * g1;
        if (lane == 0) {
            const int r1 = __hip_atomic_fetch_add(CNT + i1, 1, __ATOMIC_RELAXED, __HIP_MEMORY_SCOPE_WORKGROUP);
            const int r2 = __hip_atomic_fetch_add(CNT + i2, 1, __ATOMIC_RELAXED, __HIP_MEMORY_SCOPE_WORKGROUP);
            REC[tl * 8 + 0] = i1; REC[tl * 8 + 1] = i2; REC[tl * 8 + 2] = r1; REC[tl * 8 + 3] = r2;
            REC[tl * 8 + 4] = __builtin_bit_cast(int, g1); REC[tl * 8 + 5] = __builtin_bit_cast(int, g2); REC[tl * 8 + 6] = __builtin_bit_cast(int, rstd);
        }
    }
    __syncthreads();
    if (F.tid < 8) { unsigned* cnt = (unsigned*)(F.ws + WS_CTL) + CW_CNT; CNT[8 + F.tid] = (int)__hip_atomic_fetch_add(cnt + F.tid, (unsigned)CNT[F.tid], __ATOMIC_RELAXED, __HIP_MEMORY_SCOPE_AGENT); }
    __syncthreads();
    if (F.tid < 64) {
        const int tl = F.tid, token = blk * 64 + tl;
        const int i1 = REC[tl * 8 + 0], i2 = REC[tl * 8 + 1], r1 = CNT[8 + i1] + REC[tl * 8 + 2], r2 = CNT[8 + i2] + REC[tl * 8 + 3];
        int* toke = (int*)(F.ws + WS_TOKE); int* tokr = (int*)(F.ws + WS_TOKR); int* tokg = (int*)(F.ws + WS_TOKG); int* list = (int*)(F.ws + WS_LIST);
        list[(size_t)i1 * T + r1] = token; list[(size_t)i2 * T + r2] = token;
        toke[token * 2] = i1; toke[token * 2 + 1] = i2; tokr[token * 2] = r1; tokr[token * 2 + 1] = r2;
        tokg[token * 2] = REC[tl * 8 + 4]; tokg[token * 2 + 1] = REC[tl * 8 + 5];
        ((int*)(F.ws + WS_RSTD3))[token] = REC[tl * 8 + 6];
    }
}
__device__ __forceinline__ void moe_layout(Frame& F) {
    volatile LAS int* M = (volatile LAS int*)(F.lds + MISC_OFF);
    __syncthreads();
    if (F.tid == 0) {
        const unsigned* cnt = (const unsigned*)(F.ws + WS_CTL) + CW_CNT;
        int acc = 0;
        for (int e = 0; e < 8; ++e) { const int c = (int)__hip_atomic_load(cnt + e, __ATOMIC_RELAXED, __HIP_MEMORY_SCOPE_AGENT); M[32 + e] = c; M[40 + e] = acc; acc += (c + 255) & ~255; }
        M[48] = acc;
    }
    __syncthreads();
}
__device__ __forceinline__ int ml_ps(Frame& F, int e) { return ((volatile LAS int*)(F.lds + MISC_OFF))[40 + e]; }
__device__ __forceinline__ int ml_cnt(Frame& F, int e) { return ((volatile LAS int*)(F.lds + MISC_OFF))[32 + e]; }
__device__ __forceinline__ int ml_total(Frame& F) { return ((volatile LAS int*)(F.lds + MISC_OFF))[48]; }
__device__ __forceinline__ int ml_expert(Frame& F, int slot) { int e = 0;
#pragma unroll
    for (int i = 1; i < 8; ++i) e += (slot >= ml_ps(F, i)) ? 1 : 0;
    return e; }

constexpr int HY_CS = 4168, HY_M0 = 2080, HY_UR = 2592, HY_UP = 256;
constexpr int HY_OFF_CP = 64, HY_OFF_UB = HY_OFF_CP + 8 * HY_CS * 2, HY_OFF_X = HY_OFF_UB + 8 * HY_UR * 2;
static_assert(HY_OFF_X + 8 * 2048 * 2 <= SCR_BYTES, "hyena LDS");
typedef short bf16x8_t __attribute__((ext_vector_type(8)));

struct HyStage { v4u raw[4]; float zm[4], zp[4]; };
struct HyFilt { float f[4], b[4]; };
__device__ __forceinline__ void hy_short_load(HyStage& s, const bf16* zr, int tid) {
#pragma unroll
    for (int k = 0; k < 4; ++k) {
        const int item = tid + 512 * k, b = item >> 8, t8 = (item & 255) * 8;
        const bf16* p = zr + b * SEQ + t8;
        s.raw[k] = __builtin_nontemporal_load((const v4u*)p);
        s.zm[k] = (t8 > 0) ? bf1(p[-1]) : 0.f; s.zp[k] = (t8 + 8 < SEQ) ? bf1(p[8]) : 0.f;
    }
}
__device__ __forceinline__ void hy_short_store(LAS unsigned char* dst, int stride_el, int pad_el, const HyStage& s, float w0, float w1, float w2, float cb, int tid) {
#pragma unroll
    for (int k = 0; k < 4; ++k) {
        const int item = tid + 512 * k, b = item >> 8, t8 = (item & 255) * 8;
        float z[10];
        z[0] = s.zm[k]; z[1] = bflo(s.raw[k].x); z[2] = bfhi(s.raw[k].x); z[3] = bflo(s.raw[k].y); z[4] = bfhi(s.raw[k].y); z[5] = bflo(s.raw[k].z); z[6] = bfhi(s.raw[k].z); z[7] = bflo(s.raw[k].w); z[8] = bfhi(s.raw[k].w); z[9] = s.zp[k];
        float o[8];
#pragma unroll
        for (int i = 0; i < 8; ++i) o[i] = cb + z[i] * w0 + z[i + 1] * w1 + z[i + 2] * w2;
        v4u w; w.x = pk2(o[0], o[1]); w.y = pk2(o[2], o[3]); w.z = pk2(o[4], o[5]); w.w = pk2(o[6], o[7]);
        *(LAS v4u*)(dst + (size_t)(b * stride_el + pad_el + t8) * 2) = w;
    }
}
__device__ __forceinline__ void hy_filt_load(HyFilt& q, const float* Hf, int o, int c, int tid) {
    const float* fw = Hf + ((size_t)(o * 2 + 0) * 512 + c) * 2048;
    const float* bw = Hf + ((size_t)(o * 2 + 1) * 512 + c) * 2048;
#pragma unroll
    for (int i = 0; i < 4; ++i) { const int j = tid + 512 * i; q.f[i] = __builtin_nontemporal_load(fw + j); q.b[i] = (j >= 1) ? __builtin_nontemporal_load(bw + j) : 0.f; }
}
__device__ __forceinline__ void hy_filt_build(Frame& F, const HyFilt& q) {
    LAS float* Kf = (LAS float*)(F.lds + HY_OFF_X);
    float s = 0.f;
#pragma unroll
    for (int i = 0; i < 4; ++i) s += fabsf(q.f[i]) + fabsf(q.b[i]);
    const float tot = block_sum(F, s);
    const float inv = 1.0f / (tot + 1e-6f);
#pragma unroll
    for (int i = 0; i < 4; ++i) { const int j = F.tid + 512 * i; Kf[HY_M0 - j] = q.f[i] * inv; if (j >= 1) Kf[HY_M0 + j] = q.b[i] * inv; }
    if (F.tid < 33) Kf[F.tid] = 0.f;
    if (F.tid < 48) Kf[4128 + F.tid] = 0.f;
    __syncthreads();
    LAS unsigned* cp = (LAS unsigned*)(F.lds + HY_OFF_CP);
    for (int p = F.tid; p < 8 * (HY_CS / 2); p += 512) { const int j = p / (HY_CS / 2), xp = p - j * (HY_CS / 2), x = 2 * xp + j; cp[p] = pk2(Kf[x], Kf[x + 1]); }
    __syncthreads();
}
__device__ __forceinline__ void hy_conv_mfma(Frame& F, f32x4 (&C)[8]) {
    const int lane = F.lane, w = F.wave, r = lane & 15, kq = lane >> 4;
    const int jc = (-r) & 7, cr = (r + 7) >> 3;
    const LAS unsigned char* abase = F.lds + HY_OFF_CP + (size_t)(jc * HY_CS + HY_M0 - 32 * (8 * w - 63) + 8 * kq - 8 * cr) * 2;
    const LAS unsigned char* bbase = F.lds + HY_OFF_UB + (size_t)((r & 7) * HY_UR + HY_UP + 16 * (r >> 3) + 8 * kq) * 2;
#pragma unroll
    for (int i = 0; i < 8; ++i) C[i] = (f32x4){0.f, 0.f, 0.f, 0.f};
    bf16x8_t Bw[9];
#pragma unroll
    for (int i = 0; i < 8; ++i) Bw[i] = *(const LAS bf16x8_t*)(bbase + 64 * (63 + i));
    bf16x8_t An = *(const LAS bf16x8_t*)(abase);
#pragma unroll 1
    for (int Q = 0; Q < 8; ++Q) {
        const LAS unsigned char* ab = abase - 64 * (9 * Q);
        const LAS unsigned char* bb = bbase + 64 * (63 - 9 * Q);
#pragma unroll
        for (int qq = 0; qq < 9; ++qq) {
            const bf16x8_t A = An;
            An = *(const LAS bf16x8_t*)(ab - 64 * (qq + 1));
            Bw[(8 - qq + 9) % 9] = *(const LAS bf16x8_t*)(bb + 64 * (-1 - qq));
#pragma unroll
            for (int i = 7; i >= 0; --i) C[i] = __builtin_amdgcn_mfma_f32_16x16x32_bf16(A, Bw[(i - qq + 9) % 9], C[i], 0, 0, 0);
        }
    }
}
__device__ __forceinline__ void hyena_units(Frame& F, const Args& a) {
    const bf16* zT = (const bf16*)(F.ws + WS_ZT);
    const float* Hf = (const float*)(F.ws + WS_HF);
    const float* cw = a.in[I_HYCW]; const float* cbp = a.in[I_HYCB]; const float* skip = a.in[I_SKIP];
    bf16* yT = (bf16*)(F.ws + WS_YT);
    LAS unsigned char* UB = F.lds + HY_OFF_UB; LAS unsigned char* XB = F.lds + HY_OFF_X;
    int c = F.bid; if (c >= HYC) return;
    HyStage sA, sC, sG; HyFilt fB, fF;
    hy_short_load(sA, zT + (size_t)c * T, F.tid); hy_filt_load(fB, Hf, 0, c, F.tid); hy_short_load(sC, zT + (size_t)(HYC + c) * T, F.tid);
#pragma unroll 1
    for (;;) {
        const int lane = F.lane, w = F.wave, n = lane & 15, bb = n & 7, hh = n >> 3, rq = lane >> 4;
        __syncthreads();
        for (int p = F.tid; p < 8 * 272; p += 512) { const int b = p / 272, q = p - b * 272; const int el = (q < 128) ? 2 * q : (HY_UP + SEQ + 2 * (q - 128)); *(LAS unsigned*)(UB + (size_t)(b * HY_UR + el) * 2) = 0u; }
        { const int ch = c; hy_short_store(UB, HY_UR, HY_UP, sA, cw[ch], cw[1536 + ch], cw[3072 + ch], cbp[ch], F.tid); }
        hy_filt_build(F, fB);
        { const int ch = HYC + c; hy_short_store(XB, SEQ, 0, sC, cw[ch], cw[1536 + ch], cw[3072 + ch], cbp[ch], F.tid); }
        hy_filt_load(fF, Hf, 1, c, F.tid); hy_short_load(sG, zT + (size_t)(2 * HYC + c) * T, F.tid);
        __syncthreads();
        f32x4 C[8];
        hy_conv_mfma(F, C);
        __syncthreads();
        {   const float sk = skip[c];
#pragma unroll
            for (int i = 0; i < 8; ++i) {
                const int t0 = 32 * (8 * w + i) + 16 * hh + 4 * rq;
                LAS v2u* up = (LAS v2u*)(UB + (size_t)(bb * HY_UR + HY_UP + t0) * 2);
                const v2u uu = *up; const v2u xx = *(const LAS v2u*)(XB + (size_t)(bb * SEQ + t0) * 2);
                v2u o;
                o.x = pk2(bflo(xx.x) * (C[i][0] + bflo(uu.x) * sk), bfhi(xx.x) * (C[i][1] + bfhi(uu.x) * sk));
                o.y = pk2(bflo(xx.y) * (C[i][2] + bflo(uu.y) * sk), bfhi(xx.y) * (C[i][3] + bfhi(uu.y) * sk));
                *up = o;
            }
        }
        __syncthreads();
        hy_filt_build(F, fF);
        { const int ch = 2 * HYC + c; hy_short_store(XB, SEQ, 0, sG, cw[ch], cw[1536 + ch], cw[3072 + ch], cbp[ch], F.tid); }
        const int cn = c + F.G; const bool more = cn < HYC;
        if (more) { hy_short_load(sA, zT + (size_t)cn * T, F.tid); hy_filt_load(fB, Hf, 0, cn, F.tid); hy_short_load(sC, zT + (size_t)(HYC + cn) * T, F.tid); }
        __syncthreads();
        hy_conv_mfma(F, C);
        {   const float sk = skip[HYC + c];
#pragma unroll
            for (int i = 0; i < 8; ++i) {
                const int t0 = 32 * (8 * w + i) + 16 * hh + 4 * rq;
                const v2u uu = *(const LAS v2u*)(UB + (size_t)(bb * HY_UR + HY_UP + t0) * 2); const v2u xx = *(const LAS v2u*)(XB + (size_t)(bb * SEQ + t0) * 2);
                v2u o;
                o.x = pk2(bflo(xx.x) * (C[i][0] + bflo(uu.x) * sk), bfhi(xx.x) * (C[i][1] + bfhi(uu.x) * sk));
                o.y = pk2(bflo(xx.y) * (C[i][2] + bflo(uu.y) * sk), bfhi(xx.y) * (C[i][3] + bfhi(uu.y) * sk));
                *(v2u*)(yT + (size_t)c * T + bb * SEQ + t0) = o;
            }
        }
        if (!more) break;
        c = cn;
    }
}
__device__ __forceinline__ void hy_transpose_tile(Frame& F, int tile) {
    const bf16* yT = (const bf16*)(F.ws + WS_YT); bf16* mix = (bf16*)(F.ws + WS_MIX0);
    LAS unsigned* scr = (LAS unsigned*)(F.lds + F.wave * (64 * 36 * 4));
    const int lane = F.lane, ct = tile & 7, tt = tile >> 3, c0 = 64 * ct, tok0 = 64 * tt;
    const int rr = lane >> 3, ch = lane & 7;
    v4u raw[8];
#pragma unroll
    for (int i = 0; i < 8; ++i) raw[i] = __builtin_nontemporal_load((const v4u*)(yT + (size_t)(c0 + 8 * i + rr) * T + tok0 + 8 * ch));
#pragma unroll
    for (int i = 0; i < 8; ++i) {
        v4u o; o.x = __shfl_xor(raw[i].x, 8); o.y = __shfl_xor(raw[i].y, 8); o.z = __shfl_xor(raw[i].z, 8); o.w = __shfl_xor(raw[i].w, 8);
        const bool odd = rr & 1;
        const unsigned a0 = odd ? o.z : raw[i].x, a1 = odd ? o.w : raw[i].y;
        const unsigned b0 = odd ? raw[i].z : o.x, b1 = odd ? raw[i].w : o.y;
        const int cp = (8 * i + (rr & ~1)) >> 1;
        const int tb = 8 * ch + (odd ? 4 : 0);
        scr[(tb + 0) * 36 + cp] = (a0 & 0xffffu) | (b0 << 16);
        scr[(tb + 1) * 36 + cp] = (a0 >> 16) | (b0 & 0xffff0000u);
        scr[(tb + 2) * 36 + cp] = (a1 & 0xffffu) | (b1 << 16);
        scr[(tb + 3) * 36 + cp] = (a1 >> 16) | (b1 & 0xffff0000u);
    }
    LDS_WAIT(); asm volatile("" ::: "memory");
#pragma unroll
    for (int i = 0; i < 8; ++i) { const int tk = 8 * i + rr; const v4u w = *(const LAS v4u*)(scr + tk * 36 + 4 * ch);
        *(v4u*)(mix + (size_t)(tok0 + tk) * D + c0 + 8 * ch) = w; }
    LDS_WAIT(); asm volatile("" ::: "memory");
}

constexpr int AT_KSTR = 136, AT_VSTR = 144;
template <int OFF> __device__ __forceinline__ v2u ds_tr16(unsigned addr) { v2u r; asm volatile("ds_read_b64_tr_b16 %0, %1 offset:%2" : "=v"(r) : "v"(addr), "n"(OFF)); return r; }
template <int NT, int DT, int I = 0>
__device__ __forceinline__ void pv_issue(unsigned vb, unsigned vb2, v2u (&t)[NT]) {
    if constexpr (I < NT) {
        constexpr int off = (I >> 1) * 32 * AT_VSTR * 2 + (I & 1) * 16 * AT_VSTR * 2 + 32 * DT;
        if constexpr (off < 65536) t[I] = ds_tr16<off>(vb); else t[I] = ds_tr16<off - 32768>(vb2);
        pv_issue<NT, DT, I + 1>(vb, vb2, t);
    }
}
template <int N> __device__ __forceinline__ void lgkm_wait() { asm volatile("s_waitcnt lgkmcnt(%0)" :: "n"(N)); }
template <int NT, bool DIL, bool EDGE>
__device__ __forceinline__ void attn_wave16(const LAS unsigned char* Ks, const LAS unsigned char* Vs, int k0, const v4u (&raw)[4], const LAS float* gfl, const LAS float* bt, int relbase, int lbase, int L,
                                            bf16* orow, float* lse_out, int lane) {
    const int r = lane & 15, rq = lane >> 4;
    bf16x8_t Qf[4];
    {
        float ss = 0.f;
#pragma unroll
        for (int st = 0; st < 4; ++st) {
            const float a0 = bflo(raw[st].x), a1 = bfhi(raw[st].x), a2 = bflo(raw[st].y), a3 = bfhi(raw[st].y), a4 = bflo(raw[st].z), a5 = bfhi(raw[st].z), a6 = bflo(raw[st].w), a7 = bfhi(raw[st].w);
            ss += (a0 * a0 + a1 * a1) + (a2 * a2 + a3 * a3) + (a4 * a4 + a5 * a5) + (a6 * a6 + a7 * a7); }
        ss += __shfl_xor(ss, 16); ss += __shfl_xor(ss, 32);
        const float sc = (0.08838834764831845f * 1.4426950408889634f) * __builtin_amdgcn_rsqf(ss * (1.f / 128.f) + EPS);
#pragma unroll
        for (int st = 0; st < 4; ++st) { const f32x4 g0 = *(const LAS f32x4*)(gfl + 32 * st + 8 * rq), g1 = *(const LAS f32x4*)(gfl + 32 * st + 8 * rq + 4); v4u w;
            w.x = pk2(bflo(raw[st].x) * (sc * g0.x), bfhi(raw[st].x) * (sc * g0.y)); w.y = pk2(bflo(raw[st].y) * (sc * g0.z), bfhi(raw[st].y) * (sc * g0.w));
            w.z = pk2(bflo(raw[st].z) * (sc * g1.x), bfhi(raw[st].z) * (sc * g1.y)); w.w = pk2(bflo(raw[st].w) * (sc * g1.z), bfhi(raw[st].w) * (sc * g1.w));
            Qf[st] = __builtin_bit_cast(bf16x8_t, w); }
    }
    float bv[DIL ? NT : 1][4];
    if (DIL) {
#pragma unroll
        for (int kt = 0; kt < NT; ++kt)
#pragma unroll
            for (int g = 0; g < 4; ++g) bv[kt][g] = bt[relbase + 16 * kt + g + 128];
    }
    f32x4 S[NT];
    const LAS unsigned char* kb = Ks + (size_t)(k0 + r) * (AT_KSTR * 2) + 16 * rq;
    bf16x8_t Af[2][4];
#pragma unroll
    for (int st = 0; st < 4; ++st) Af[0][st] = *(const LAS bf16x8_t*)(kb + 64 * st);
#pragma unroll
    for (int kt = 0; kt < NT; ++kt) {
        if (kt + 1 < NT) {
#pragma unroll
            for (int st = 0; st < 4; ++st) Af[(kt + 1) & 1][st] = *(const LAS bf16x8_t*)(kb + (kt + 1) * 16 * (AT_KSTR * 2) + 64 * st);
        }
        f32x4 acc = (f32x4){0.f, 0.f, 0.f, 0.f};
        if (DIL) acc = (f32x4){bv[kt][0], bv[kt][1], bv[kt][2], bv[kt][3]};
#pragma unroll
        for (int st = 0; st < 4; ++st) acc = __builtin_amdgcn_mfma_f32_16x16x32_bf16(Af[kt & 1][st], Qf[st], acc, 0, 0, 0);
        S[kt] = acc;
        asm volatile("" ::: "memory");
    }
    float mx = -3.0e38f;
#pragma unroll
    for (int kt = 0; kt < NT; ++kt)
#pragma unroll
        for (int g = 0; g < 4; ++g) {
            float s = S[kt][g];
            if (DIL && EDGE) { const int lk = lbase + 16 * kt + g; const bool ok = (lk >= 0) && (lk < L); s = ok ? s : -3.0e38f; S[kt][g] = s; }
            mx = fmaxf(mx, s);
        }
    mx = fmaxf(mx, __shfl_xor(mx, 16)); mx = fmaxf(mx, __shfl_xor(mx, 32));
    float z = 0.f;
#pragma unroll
    for (int kt = 0; kt < NT; ++kt)
#pragma unroll
        for (int g = 0; g < 4; ++g) { const float p = __builtin_amdgcn_exp2f(S[kt][g] - mx); S[kt][g] = p; z += p; }
    z += __shfl_xor(z, 16); z += __shfl_xor(z, 32);
    const float iz = __builtin_amdgcn_rcpf(z);
    bf16x8_t Pf[NT / 2];
#pragma unroll
    for (int ks = 0; ks < NT / 2; ++ks) { v4u w; w.x = pk2(S[2 * ks][0], S[2 * ks][1]); w.y = pk2(S[2 * ks][2], S[2 * ks][3]); w.z = pk2(S[2 * ks + 1][0], S[2 * ks + 1][1]); w.w = pk2(S[2 * ks + 1][2], S[2 * ks + 1][3]);
        Pf[ks] = __builtin_bit_cast(bf16x8_t, w); }
    const unsigned vb = (unsigned)(size_t)Vs + (unsigned)(k0 + 4 * rq + (r >> 2)) * (AT_VSTR * 2) + 8 * (lane & 3), vb2 = vb + 32768;
    constexpr int WN = NT < 15 ? NT : 15;
    v2u Vt[2][NT];
    pv_issue<NT, 0>(vb, vb2, Vt[0]);
#define PV_STEP(DT) { \
        if (DT + 1 < 8) { pv_issue<NT, (DT + 1) & 7>(vb, vb2, Vt[(DT + 1) & 1]); lgkm_wait<WN>(); } else lgkm_wait<0>(); \
        _Pragma("unroll") for (int i = 0; i < NT; ++i) asm volatile("" : "+v"(Vt[DT & 1][i])); \
        f32x4 o = (f32x4){0.f, 0.f, 0.f, 0.f}; \
        _Pragma("unroll") for (int ks = 0; ks < NT / 2; ++ks) { const v2u lo = Vt[DT & 1][2 * ks], hi = Vt[DT & 1][2 * ks + 1]; \
            o = __builtin_amdgcn_mfma_f32_16x16x32_bf16(__builtin_bit_cast(bf16x8_t, ((v4u){lo.x, lo.y, hi.x, hi.y})), Pf[ks], o, 0, 0, 0); } \
        v2u ow; ow.x = pk2(o[0] * iz, o[1] * iz); ow.y = pk2(o[2] * iz, o[3] * iz); \
        *(v2u*)(orow + 16 * DT + 4 * rq) = ow; }
    PV_STEP(0) PV_STEP(1) PV_STEP(2) PV_STEP(3) PV_STEP(4) PV_STEP(5) PV_STEP(6) PV_STEP(7)
#undef PV_STEP
    if (DIL) { if (rq == 0) *lse_out = mx * 0.6931471805599453f + logf(z); }
}
template <int CTRL> __device__ __forceinline__ float dpp_f(float x) { return __builtin_bit_cast(float, __builtin_amdgcn_update_dpp(0, __builtin_bit_cast(int, x), CTRL, 0xf, 0xf, true)); }
template <int NK, int NB, int BS, class RowFn>
__device__ __forceinline__ void attn_stage_kv(LAS unsigned char* Ks, LAS unsigned char* Vs, const bf16* kbase, const bf16* vbase, RowFn rowoff, int wave, int lane) {
    const int rr = lane >> 4, cc = lane & 15;
#pragma unroll 1
    for (int bt = 0; bt < NB; ++bt) {
        v4u rk[BS], rv[BS]; bool ok[BS];
#pragma unroll
        for (int i = 0; i < BS; ++i) { const int j = ((bt * BS + i) * 8 + wave) * 4 + rr; const int off = rowoff(j); ok[i] = off >= 0;
            const unsigned ob = (ok[i] ? (unsigned)off * 2u : 0u) + 16u * cc;
            rk[i] = *(const v4u*)((const char*)kbase + ob); rv[i] = *(const v4u*)((const char*)vbase + ob); }
#pragma unroll
        for (int i = 0; i < BS; ++i) { const int j = ((bt * BS + i) * 8 + wave) * 4 + rr;
            const float k0 = bflo(rk[i].x), k1 = bfhi(rk[i].x), k2 = bflo(rk[i].y), k3 = bfhi(rk[i].y), k4 = bflo(rk[i].z), k5 = bfhi(rk[i].z), k6 = bflo(rk[i].w), k7 = bfhi(rk[i].w);
            float ss = (k0 * k0 + k1 * k1) + (k2 * k2 + k3 * k3) + (k4 * k4 + k5 * k5) + (k6 * k6 + k7 * k7);
            ss += dpp_f<0xB1>(ss); ss += dpp_f<0x4E>(ss); ss += dpp_f<0x141>(ss); ss += dpp_f<0x140>(ss);
            const float sc = ok[i] ? __builtin_amdgcn_rsqf(ss * (1.f / 128.f) + EPS) : 0.f;
            v4u w; w.x = pk2(k0 * sc, k1 * sc); w.y = pk2(k2 * sc, k3 * sc); w.z = pk2(k4 * sc, k5 * sc); w.w = pk2(k6 * sc, k7 * sc);
            if (((bt * BS + i + 1) * 32 <= NK) || j < NK) *(LAS v4u*)(Ks + (unsigned)j * (AT_KSTR * 2) + 16 * cc) = w; }
#pragma unroll
        for (int i = 0; i < BS; ++i) { const int j = ((bt * BS + i) * 8 + wave) * 4 + rr;
            v4u w = rv[i]; if (!ok[i]) w = (v4u){0u, 0u, 0u, 0u};
            if (((bt * BS + i + 1) * 32 <= NK) || j < NK) *(LAS v4u*)(Vs + (unsigned)j * (AT_VSTR * 2) + 16 * cc) = w; }
    }
}

constexpr int XA_OFF_V = 256 * AT_KSTR * 2;
static_assert(XA_OFF_V + 256 * AT_VSTR * 2 <= SCR_BYTES, "cross LDS");
__device__ __forceinline__ void cross_unit(Frame& F, const bf16* xq, const bf16* kv, const LAS float* gfl, bf16* mix, int unit) {
    int lane = (int)__builtin_amdgcn_mbcnt_hi(~0u, __builtin_amdgcn_mbcnt_lo(~0u, 0u)); asm volatile("" : "+v"(lane)); const int tid = F.wave * 64 + lane;
    const int b = unit >> 5, h = (unit >> 3) & 3, qc = unit & 7;
    LAS unsigned char* Ks = F.lds; LAS unsigned char* Vs = F.lds + XA_OFF_V;
    const bf16* kbase = kv + (size_t)(b * MEML) * 1024 + h * 128;
    v4u qraw[2][4];
#pragma unroll
    for (int t = 0; t < 2; ++t) { const int token = b * SEQ + qc * 256 + 16 * (F.wave + 8 * t) + (lane & 15);
#pragma unroll
        for (int st = 0; st < 4; ++st) qraw[t][st] = *(const v4u*)(xq + (size_t)token * 512 + h * 128 + 32 * st + 8 * (lane >> 4)); }
    __syncthreads();
    attn_stage_kv<MEML, 1, 8>(Ks, Vs, kbase, kbase + 512, [=](int j) { return j * 1024; }, F.wave, lane);
    __syncthreads();
#pragma unroll
    for (int t = 0; t < 2; ++t) {
        const int token = b * SEQ + qc * 256 + 16 * (F.wave + 8 * t) + (lane & 15);
        attn_wave16<16, false, false>(Ks, Vs, 0, qraw[t], gfl, nullptr, 0, 0, 0, mix + (size_t)token * D + 512 + h * 128, nullptr, lane);
    }
}
constexpr int DA_NK = 272, DA_OFF_V = DA_NK * AT_KSTR * 2, DA_OFF_BT = DA_OFF_V + DA_NK * AT_VSTR * 2;
static_assert(DA_OFF_BT + 320 * 4 <= SCR_BYTES, "dilated LDS");
__device__ __forceinline__ void dil_unit(Frame& F, const Args& a, const LAS float* gfl, int unit) {
    const int bh = unit / 48, sub = unit % 48, b = bh >> 2, h = bh & 3, g = sub >> 4, w16 = sub & 15;
    const int dil = (g == 0) ? 1 : (g == 1 ? 4 : 16), L = SEQ / dil, nch = L / 128;
    const int r = w16 / nch, n128 = w16 % nch;
    int lane = (int)__builtin_amdgcn_mbcnt_hi(~0u, __builtin_amdgcn_mbcnt_lo(~0u, 0u)); asm volatile("" : "+v"(lane)); const int tid = F.wave * 64 + lane;
    const bf16* qkv = (const bf16*)(F.ws + WS_QKV1);
    float* lse = (float*)(F.ws + WS_LSE);
    LAS unsigned char* Ks = F.lds; LAS unsigned char* Vs = F.lds + DA_OFF_V; LAS float* bt = (LAS float*)(F.lds + DA_OFF_BT);
    const int lk0 = 128 * n128 - 64;
    const bf16* base = qkv + (size_t)(b * SEQ + r) * NQKV + g * 512 + h * 128;
    const size_t lstep = (size_t)dil * NQKV;
    const int qi = 16 * F.wave + (lane & 15), lq = 128 * n128 + qi, token = b * SEQ + lq * dil + r;
    v4u qraw[4];
#pragma unroll
    for (int st = 0; st < 4; ++st) qraw[st] = *(const v4u*)(base + (size_t)lq * lstep + 32 * st + 8 * (lane >> 4));
    __syncthreads();
    if (tid < 320) { const int rel = tid - 128; bt[tid] = (rel >= -64 && rel <= 64) ? a.in[I_RELB][rel_bucket_dev(rel * dil) * 12 + g * 4 + h] * 1.4426950408889634f : -3.0e38f; }
    {   const int lstep32 = dil * NQKV;
        attn_stage_kv<DA_NK, 1, 9>(Ks, Vs, base + ATW, base + 2 * ATW, [=](int j) { const int lk = lk0 + j; return (lk >= 0 && lk < L) ? lk * lstep32 : -1; }, F.wave, lane); }
    __syncthreads();
    {
        const int k0 = 16 * F.wave, rq = lane >> 4;
        bf16* orow = (g == 0) ? (bf16*)(F.ws + WS_MIX1) + (size_t)token * D + h * 128 : (bf16*)(F.ws + WS_OG12) + ((size_t)(g - 1) * T + token) * 512 + h * 128;
        float* lp = lse + ((size_t)g * T + token) * 4 + h;
        if (n128 == 0 || n128 == nch - 1) attn_wave16<10, true, true>(Ks, Vs, k0, qraw, gfl, bt, k0 + 4 * rq - 64 - qi, lk0 + k0 + 4 * rq, L, orow, lp, lane);
        else attn_wave16<10, true, false>(Ks, Vs, k0, qraw, gfl, bt, k0 + 4 * rq - 64 - qi, lk0 + k0 + 4 * rq, L, orow, lp, lane);
    }
}
__device__ __forceinline__ void combine_phase(Frame& F, const Args& a) {
    moe_layout(F);
    const int gw = F.bid * NWAVES + F.wave, NGW = F.G * NWAVES, lane = F.lane;
    const int* toke = (const int*)(F.ws + WS_TOKE); const int* tokr = (const int*)(F.ws + WS_TOKR); const float* tokg = (const float*)(F.ws + WS_TOKG);
    const bf16* y = (const bf16*)(F.ws + WS_XS); const bf16* y2 = (const bf16*)(F.ws + WS_Y2);
    for (int token = gw; token < T; token += NGW) {
        const int e0 = toke[token * 2], e1 = toke[token * 2 + 1];
        const int s0 = ml_ps(F, e0) + tokr[token * 2], s1 = ml_ps(F, e1) + tokr[token * 2 + 1];
        const float g0 = tokg[token * 2], g1 = tokg[token * 2 + 1];
        f32x4* xo = (f32x4*)(a.out + (size_t)token * D); const v2u* xi = (const v2u*)((const bf16*)a.out + (size_t)token * 2048 + 1024);
        const v2u* y0 = (const v2u*)(y + (size_t)s0 * D); const v2u* y1 = (const v2u*)(y + (size_t)s1 * D);
        v2u xw[4], p0[4], p1[4];
#pragma unroll
        for (int j = 0; j < 4; ++j) { const int q = lane + 64 * j; xw[j] = __builtin_nontemporal_load(xi + q); p0[j] = __builtin_nontemporal_load(y0 + q); p1[j] = __builtin_nontemporal_load(y1 + q); }
        f32x4 r[4];
#pragma unroll
        for (int j = 0; j < 4; ++j) {
            const int q = lane + 64 * j;
            f32x4 x = (f32x4){bflo(xw[j].x), bfhi(xw[j].x), bflo(xw[j].y), bfhi(xw[j].y)};
            f32x4 a0 = (f32x4){bflo(p0[j].x), bfhi(p0[j].x), bflo(p0[j].y), bfhi(p0[j].y)}, a1 = (f32x4){bflo(p1[j].x), bfhi(p1[j].x), bflo(p1[j].y), bfhi(p1[j].y)};
            if (s0 >= 2 * T) { const v2u t = ((const v2u*)(y2 + (size_t)(s0 - 2 * T) * D))[q]; a0 = a0 + (f32x4){bflo(t.x), bfhi(t.x), bflo(t.y), bfhi(t.y)}; }
            if (s1 >= 2 * T) { const v2u t = ((const v2u*)(y2 + (size_t)(s1 - 2 * T) * D))[q]; a1 = a1 + (f32x4){bflo(t.x), bfhi(t.x), bflo(t.y), bfhi(t.y)}; }
            r[j] = x + g0 * a0 + g1 * a1;
        }
        asm volatile("s_waitcnt vmcnt(0)" ::: "memory");
#pragma unroll
        for (int j = 0; j < 4; ++j) __builtin_nontemporal_store(r[j], xo + lane + 64 * j);
    }
}

constexpr int NPHASE = 15;
__global__ void __launch_bounds__(NWAVES * 64, 2) mega_fwd(Args args) {
    extern __shared__ __attribute__((aligned(16))) unsigned char lds_raw[];
    Frame F;
    F.lds = (LAS unsigned char*)lds_raw; F.ws = args.ws;
    F.wave = __builtin_amdgcn_readfirstlane((int)threadIdx.x >> 6); F.G = gridDim.x; F.bid = blockIdx.x;
#define PH_BEGIN() do { int l_ = (int)__builtin_amdgcn_mbcnt_hi(~0u, __builtin_amdgcn_mbcnt_lo(~0u, 0u)); asm volatile("" : "+v"(l_)); F.lane = l_; F.tid = F.wave * 64 + l_; } while (0)
    PH_BEGIN();
    unsigned char* ws = args.ws;
    volatile LAS unsigned* MISC = (volatile LAS unsigned*)(F.lds + MISC_OFF);
    for (int u = F.tid; u < (LDS_BYTES - MISC_OFF) / 4; u += NWAVES * 64) MISC[u] = 0u;
    __syncthreads();
    const int lo = args.ph_lo, hi = args.ph_hi;
    const bool use_bar = (hi - lo) > 1;
    XcdBarrier bar; bar.bar = (unsigned*)(ws + WS_CTL) + CW_BAR + args.bslot * XCD_BAR_WORDS; bar.x = 0; bar.st = nullptr;
    if (use_bar) bar = xcd_barrier_post((unsigned*)(ws + WS_CTL) + CW_BAR + args.bslot * XCD_BAR_WORDS, MISC + 8, F.tid);
#define IN(k) (lo <= (k) && (k) < hi)
#define SEAM(k) do { if (IN(k) && IN((k) + 1)) { PH_BEGIN(); xcd_barrier(bar, F.tid); } } while (0)
    const int gw = F.bid * NWAVES + F.wave, NGW = F.G * NWAVES;
    LAS unsigned char* ring = F.lds;

    if (IN(0)) { PH_BEGIN(); p0_prologue(F, args); }
    SEAM(0);
    if (IN(1)) { PH_BEGIN();
        {   pg8::Gemm g{(const bf16*)(ws + WS_WIN0), (const bf16*)(ws + WS_XB), D, D, D, 0};
            pg8::StaticOrder S; S.init(ATW / 256, T / 256, F.G, F.bid);
            EpiB<3> E{(bf16*)(ws + WS_ZT), T, (const float*)(ws + WS_RSTD0), 1 << 30, nullptr, 0, nullptr, 1.0f};
            pg8::gemm_phase<EpiB<3>, pg8::StaticOrder, true>(ring, g, S, E, F.wave); }
        {   pg8::Gemm g{(const bf16*)(ws + WS_XB), (const bf16*)(ws + WS_WIN0) + (size_t)ATW * D, D, D, D, 0};
            pg8::StaticOrder S; S.init(T / 256, 2, F.G, (F.bid + 128) % F.G);
            EpiB<1> E{(bf16*)(ws + WS_XQ0), 512, (const float*)(ws + WS_RSTD0), 1 << 30, nullptr, 0, nullptr, 1.0f};
            pg8::gemm_phase<EpiB<1>, pg8::StaticOrder, true>(ring, g, S, E, F.wave); }
        {   pg8::Gemm g{(const bf16*)(ws + WS_MN), (const bf16*)(ws + WS_WKV), D, D, D, (size_t)D * D * 2};
            pg8::MoeOrder S; S.init(2 * TM / 256, 4, F.G, F.bid); S.t0 = TM / 256; S.t1 = S.t2 = S.t3 = S.t4 = S.t5 = S.t6 = 1 << 30; S.lay = nullptr; S.list = nullptr;
            EpiB<0> E{(bf16*)(ws + WS_KV), D, nullptr, 1 << 30, nullptr, 0, nullptr, 1.0f};
            pg8::gemm_phase<EpiB<0>, pg8::MoeOrder, true>(ring, g, S, E, F.wave); }
        if (F.G == 256 && F.bid >= 64) { PH_BEGIN(); moe_convert(F, args, 0, MOE_P1_HI, (F.bid - 64) * NWAVES + F.wave, 192 * NWAVES); }
    }
    SEAM(1);
    if (IN(2)) { PH_BEGIN();
        hyena_units(F, args);
        LAS float* gfx = (LAS float*)(F.lds + MISC_OFF + 3072);
        if (F.tid < 128) gfx[F.tid] = args.in[I_XQN][F.tid] * args.in[I_XKN][F.tid];
        __syncthreads();
        for (int u = F.bid; u < 256; u += F.G)
            cross_unit(F, (const bf16*)(ws + WS_XQ0), (const bf16*)(ws + WS_KV), gfx, (bf16*)(ws + WS_MIX0), u);
    }
    SEAM(2);
    if (IN(3)) { PH_BEGIN(); for (int t = gw; t < 2048; t += NGW) hy_transpose_tile(F, t); }
    SEAM(3);
    if (IN(4)) { PH_BEGIN();
        pg8::Gemm g{(const bf16*)(ws + WS_MIX0), (const bf16*)(ws + WS_WO), D, D, D, 0};
        pg8::StaticOrder S; S.init(T / 256, 4, F.G, F.bid);
        EpiRes<false, true> E{nullptr, (const bf16*)(ws + WS_XB), D, (bf16*)(ws + WS_XB), D, (float*)(ws + WS_SSQ16)};
        pg8::gemm_phase<EpiRes<false, true>, pg8::StaticOrder, true>(ring, g, S, E, F.wave);
    }
    SEAM(4);
    if (IN(5)) { PH_BEGIN();
        pg8::Gemm g{(const bf16*)(ws + WS_XB), (const bf16*)(ws + WS_WGU0), D, D, D, 0};
        pg8::StaticOrder S; S.init(T / 256, NGU / 256, F.G, F.bid);
        fill_rstd_table(F.lds, S, (const float*)(ws + WS_SSQ16), F.tid);
        EpiSwiglu<4> E{(bf16*)(ws + WS_HID0), FF, nullptr, (const LAS float*)(F.lds + RSL_OFF), 1.0f};
        pg8::gemm_phase<EpiSwiglu<4>, pg8::StaticOrder, true>(ring, g, S, E, F.wave);
        if (F.G == 256) { PH_BEGIN();
            if (F.bid >= 128) moe_convert(F, args, MOE_P1_HI, MOE_P5_MID, (F.bid - 128) * NWAVES + F.wave, 128 * NWAVES);
            moe_convert(F, args, MOE_P5_MID, MOE_P5_HI, F.bid * NWAVES + F.wave, 256 * NWAVES); }
    }
    SEAM(5);
    if (IN(6)) { PH_BEGIN();
        pg8::Gemm g{(const bf16*)(ws + WS_HID0), (const bf16*)(ws + WS_WD0), FF, FF, FF, 0};
        pg8::StaticOrder S; S.init(T / 256, 4, F.G, F.bid);
        EpiRes<false, true> E{nullptr, (const bf16*)(ws + WS_XB), D, (bf16*)(ws + WS_XB), D, (float*)(ws + WS_SSQ16)};
        pg8::gemm_phase<EpiRes<false, true>, pg8::StaticOrder, true>(ring, g, S, E, F.wave);
    }
    SEAM(6);
    if (IN(7)) { PH_BEGIN();
        pg8::Gemm g{(const bf16*)(ws + WS_XB), (const bf16*)(ws + WS_WIN1), D, D, D, 0};
        pg8::StaticOrder S; S.init(T / 256, NQ1 / 256, F.G, F.bid);
        fill_rstd_table(F.lds, S, (const float*)(ws + WS_SSQ16), F.tid);
        EpiB<4> E{(bf16*)(ws + WS_QKV1), NQKV, nullptr, NQKV / 256, (bf16*)(ws + WS_XQ1), 512, (const LAS float*)(F.lds + RSL_OFF), 1.0f};
        pg8::gemm_phase<EpiB<4>, pg8::StaticOrder, true>(ring, g, S, E, F.wave);
    }
    SEAM(7);
    if (IN(8)) { PH_BEGIN();
        LAS float* gfd = (LAS float*)(F.lds + MISC_OFF + 2560); LAS float* gfx = (LAS float*)(F.lds + MISC_OFF + 3072);
        if (F.tid < 128) { gfd[F.tid] = args.in[I_ATQN][F.tid] * args.in[I_ATKN][F.tid]; gfx[F.tid] = args.in[I_XQN][128 + F.tid] * args.in[I_XKN][128 + F.tid]; }
        __syncthreads();
        for (int u = F.bid; u < NB * 4 * 48; u += F.G) dil_unit(F, args, gfd, u);
        for (int u = F.bid; u < 256; u += F.G)
            cross_unit(F, (const bf16*)(ws + WS_XQ1), (const bf16*)(ws + WS_KV) + (size_t)TM * D, gfx, (bf16*)(ws + WS_MIX1), u);
    }
    SEAM(8);
    if (IN(9)) { PH_BEGIN(); for (int t = gw; t < T; t += NGW) merge_token(F, t); }
    SEAM(9);
    if (IN(10)) { PH_BEGIN();
        pg8::Gemm g{(const bf16*)(ws + WS_MIX1), (const bf16*)(ws + WS_WO) + (size_t)D * D, D, D, D, 0};
        pg8::StaticOrder S; S.init(T / 256, 4, F.G, F.bid);
        EpiRes<false, false> E{nullptr, (const bf16*)(ws + WS_XB), D, (bf16*)args.out + 1024, 2048, nullptr};
        pg8::gemm_phase<EpiRes<false, false>, pg8::StaticOrder, true>(ring, g, S, E, F.wave);
    }
    SEAM(10);
    if (IN(11)) { PH_BEGIN(); for (int blk = F.bid; blk < T / 64; blk += F.G) route_block(F, args, blk); }
    SEAM(11);
    if (IN(12)) { PH_BEGIN();
        moe_layout(F);
        pg8::Gemm g{(const bf16*)(ws + WS_XB3), (const bf16*)(ws + WS_WGU1), D / 2, D / 2, D / 2, (size_t)NGU * D};
        pg8::MoeOrder S; S.init(ml_total(F) / 256, NGU / 256, F.G, F.bid); S.lay = (const volatile LAS int*)(F.lds + MISC_OFF); S.list = (const int*)(ws + WS_LIST);
        S.t0 = ml_ps(F, 1) / 256; S.t1 = ml_ps(F, 2) / 256; S.t2 = ml_ps(F, 3) / 256; S.t3 = ml_ps(F, 4) / 256; S.t4 = ml_ps(F, 5) / 256; S.t5 = ml_ps(F, 6) / 256; S.t6 = ml_ps(F, 7) / 256;
        EpiSwiglu<5, true> E{(bf16*)(ws + WS_HID1), FF, nullptr, nullptr, 1.0f / MOE_WGU_SCALE};
        pg8::gemm_phase<EpiSwiglu<5, true>, pg8::MoeOrder, true, true, true>(ring, g, S, E, F.wave);
    }
    SEAM(12);
    if (IN(13)) { PH_BEGIN();
        moe_layout(F);
        const int nMt = ml_total(F) / 256;
        const int q1 = ml_ps(F, 1) / 256, q2 = ml_ps(F, 2) / 256, q3 = ml_ps(F, 3) / 256, q4 = ml_ps(F, 4) / 256, q5 = ml_ps(F, 5) / 256, q6 = ml_ps(F, 6) / 256, q7 = ml_ps(F, 7) / 256;
        {   pg8::Gemm g{(const bf16*)(ws + WS_HID1), (const bf16*)(ws + WS_WD1), FF / 2, FF / 2, FF / 2, (size_t)D * FF};
            pg8::MoeOrder S; S.init(nMt < 128 ? nMt : 128, 4, F.G, F.bid); S.lay = nullptr; S.list = nullptr;
            S.t0 = q1; S.t1 = q2; S.t2 = q3; S.t3 = q4; S.t4 = q5; S.t5 = q6; S.t6 = q7;
            EpiB<5> E{(bf16*)(ws + WS_XS), D, nullptr, 1 << 30, nullptr, 0, nullptr, 1.0f / MOE_WD_SCALE};
            pg8::gemm_phase<EpiB<5>, pg8::MoeOrder, true, false, true>(ring, g, S, E, F.wave); }
        if (nMt > 128) {
            const int half = F.G / 2; const bool second = F.bid >= half;
            pg8::Gemm g{(const bf16*)(ws + WS_HID1), (const bf16*)(ws + WS_WD1), FF / 2, FF / 2, second ? 640 : 768, (size_t)D * FF};
            pg8::MoeTailOrder2 S; S.pm0 = 128; S.ntail = nMt - 128; S.nN = 4; S.G = second ? F.G - half : half; S.c = second ? F.bid - half : F.bid; S.koff = second ? 12 * 128 : 0;
            S.t0 = q1; S.t1 = q2; S.t2 = q3; S.t3 = q4; S.t4 = q5; S.t5 = q6; S.t6 = q7;
            EpiB<5> E{(bf16*)(ws + WS_XS), D, nullptr, 1 << 30, (bf16*)(ws + WS_Y2) - (size_t)2 * T * D, D, nullptr, 1.0f / MOE_WD_SCALE};
            pg8::gemm_phase<EpiB<5>, pg8::MoeTailOrder2, true, false, true>(ring, g, S, E, F.wave); }
    }
    SEAM(13);
    if (IN(14)) { PH_BEGIN(); combine_phase(F, args); }
#undef IN
#undef SEAM
}

#ifndef MK_ONE_LAUNCH
#define MK_ONE_LAUNCH 1
#endif
extern "C" void kernel_launch(void* const* d_in, const int* in_sizes, int n_in, void* d_out, int out_size, void* d_ws, size_t ws_size, hipStream_t stream) {
    static int grid = 0;
    if (grid == 0) {
        if (n_in != 30 || in_sizes[0] != T * D || out_size != T * D || ws_size < WS_END) {
            fprintf(stderr, "kernel_launch: unexpected problem (n_in %d, in0 %d, out %d, ws %zu, need %zu); nothing launched\n", n_in, n_in > 0 ? in_sizes[0] : -1, out_size, ws_size, (size_t)WS_END); grid = -1; return; }
        int dev = 0, cus = 0, per_cu = 0;
        if (hipGetDevice(&dev) != hipSuccess || hipDeviceGetAttribute(&cus, hipDeviceAttributeMultiprocessorCount, dev) != hipSuccess) { grid = -1; return; }
        if (hipFuncSetAttribute((const void*)mega_fwd, hipFuncAttributeMaxDynamicSharedMemorySize, LDS_BYTES) != hipSuccess) { fprintf(stderr, "kernel_launch: hipFuncSetAttribute failed\n"); grid = -1; return; }
        if (hipOccupancyMaxActiveBlocksPerMultiprocessor(&per_cu, (const void*)mega_fwd, NWAVES * 64, LDS_BYTES) != hipSuccess || per_cu < 1)
            fprintf(stderr, "kernel_launch: note: occupancy query reports %d workgroups per CU\n", per_cu);
        (void)hipGetLastError();
        grid = cus;
    }
    if (grid < 0) return;
    if (hipMemsetAsync((char*)d_ws + WS_CTL, 0, CTL_ZERO_BYTES, stream) != hipSuccess) return;
    Args a{};
    for (int i = 0; i < 30; ++i) a.in[i] = (const float*)d_in[i];
    a.out = (float*)d_out; a.ws = (unsigned char*)d_ws;
#if defined(PROBE_PHASE)
    a.ph_lo = 0; a.ph_hi = PROBE_PHASE + 1; a.bslot = 0;
    hipLaunchKernelGGL(mega_fwd, dim3(grid), dim3(NWAVES * 64), LDS_BYTES, stream, a);
    a.ph_lo = PROBE_PHASE; a.ph_hi = NPHASE; a.bslot = 1;
    hipLaunchKernelGGL(mega_fwd, dim3(grid), dim3(NWAVES * 64), LDS_BYTES, stream, a);
#elif MK_ONE_LAUNCH
    a.ph_lo = 0; a.ph_hi = NPHASE; a.bslot = 0;
    hipLaunchKernelGGL(mega_fwd, dim3(grid), dim3(NWAVES * 64), LDS_BYTES, stream, a);
#else
    for (int p = 0; p < NPHASE; ++p) { a.ph_lo = p; a.ph_hi = p + 1; a.bslot = 0; hipLaunchKernelGGL(mega_fwd, dim3(grid), dim3(NWAVES * 64), LDS_BYTES, stream, a); }
#endif
}
```

```cpp
#include <hip/hip_runtime.h>
#include <cstdio>
#include <cstdint>

namespace pg8 {
#define PG8_LAS __attribute__((address_space(3)))
typedef unsigned short bf16_t;
typedef short bf16x8 __attribute__((ext_vector_type(8)));
typedef float f32x4 __attribute__((ext_vector_type(4)));
typedef unsigned u32x4 __attribute__((ext_vector_type(4)));
constexpr int BM = 256, BK = 64, HALF = 128, HTB = HALF * BK * 2  , STAGE_BYTES = 8 * HTB, NXCD = 8, WGM = 8;

__host__ __device__ __forceinline__ int lds_byte(int r, int c) { const int st = (r >> 4) * 2 + (c >> 5), rr = r & 15, cc = c & 31, ob = rr * 64 + cc * 2; return st * 1024 + (ob ^ (((ob >> 9) & 1) << 5)); }
__host__ __device__ __forceinline__ void stage_rc(int b, int& R, int& C) { const int st = b / 1024, sb = b % 1024, swz = sb ^ (((sb >> 9) & 1) << 5); R = (st >> 1) * 16 + swz / 64; C = (st & 1) * 32 + (swz % 64) / 2; }
__host__ __device__ __forceinline__ int perm32(int rho) { const int n = rho >> 4, i = rho & 15; return 8 * (i >> 2) + 4 * n + (i & 3); }

struct Unit { int pm, pn, e, koff, idx; };
struct Gemm { const bf16_t* A; const bf16_t* Bt; int lda, ldb, K; size_t estride; };

struct StaticOrder {
    int nM, nN, nwg, G, c;
    __device__ __forceinline__ int gather_row(const Unit&, int slot) const { return slot; }
    __host__ __device__ void init(int nM_, int nN_, int G_, int c_) { nM = nM_; nN = nN_; nwg = nM * nN; G = G_; c = c_; }
    __host__ __device__ bool next(int i, Unit& u) const {
        const long L = (long)i * G + c; if (L >= nwg) return false;
        int wgid = (int)L; { const int q = nwg / NXCD, r = nwg % NXCD, xcd = wgid % NXCD, off = wgid / NXCD; wgid = (xcd < r ? xcd * (q + 1) : r * (q + 1) + (xcd - r) * q) + off; }
        const int nig = WGM * nN, gid = wgid / nig, fm = gid * WGM, gsz = (nM - fm) < WGM ? (nM - fm) : WGM;
        u.pm = fm + ((wgid % nig) % gsz); u.pn = (wgid % nig) / gsz; u.e = 0; u.koff = 0; return true;
    }
};
struct MoeOrder : StaticOrder {
    int t0, t1, t2, t3, t4, t5, t6;
    const volatile PG8_LAS int* lay;
    const int* list;
    __device__ __forceinline__ int gather_row(const Unit& u, int slot) const { const int rank = slot - lay[40 + u.e]; return rank < lay[32 + u.e] ? list[(size_t)u.e * 16384 + rank] : 0; }
    __device__ __forceinline__ void gather_rows4(const Unit& u, const int (&sl)[4], unsigned (&out)[4]) const {
        const int ps = lay[40 + u.e], cnt = lay[32 + u.e];
        int v[4]; bool ok[4];
#pragma unroll
        for (int k = 0; k < 4; ++k) { const int rank = sl[k] - ps; ok[k] = rank < cnt; v[k] = list[(size_t)u.e * 16384 + (ok[k] ? rank : 0)]; }
#pragma unroll
        for (int k = 0; k < 4; ++k) out[k] = ok[k] ? (unsigned)v[k] : 0u;
    }
    __host__ __device__ bool next(int i, Unit& u) const {
        if (!StaticOrder::next(i, u)) return false;
        const int p = u.pm; u.e = (p >= t0) + (p >= t1) + (p >= t2) + (p >= t3) + (p >= t4) + (p >= t5) + (p >= t6); return true;
    }
};

struct MoeTailOrder {
    int pm0, ntail, nN, G, c, khalf; int t0, t1, t2, t3, t4, t5, t6;
    __device__ __forceinline__ int gather_row(const Unit&, int slot) const { return slot; }
    __device__ __forceinline__ bool next(int i, Unit& u) const {
        const int L = i * G + c; if (L >= ntail * nN * 2) return false;
        const int kh = L & 1, q = L >> 1; u.pn = q % nN; u.pm = pm0 + q / nN; u.koff = kh * khalf;
        const int p = u.pm; u.e = (p >= t0) + (p >= t1) + (p >= t2) + (p >= t3) + (p >= t4) + (p >= t5) + (p >= t6); return true;
    }
};
struct MoeTailOrder2 {
    int pm0, ntail, nN, G, c, koff; int t0, t1, t2, t3, t4, t5, t6;
    __device__ __forceinline__ int gather_row(const Unit&, int slot) const { return slot; }
    __device__ __forceinline__ bool next(int i, Unit& u) const {
        const int L = i * G + c; if (L >= ntail * nN) return false;
        u.pn = L % nN; u.pm = pm0 + L / nN; u.koff = koff;
        const int p = u.pm; u.e = (p >= t0) + (p >= t1) + (p >= t2) + (p >= t3) + (p >= t4) + (p >= t5) + (p >= t6); return true;
    }
};
__device__ __forceinline__ unsigned cvt_pk_bf16(float lo, float hi) { unsigned r; asm volatile("v_cvt_pk_bf16_f32 %0, %1, %2" : "=v"(r) : "v"(lo), "v"(hi)); return r; }

typedef int v8i __attribute__((ext_vector_type(8)));
typedef int v4i __attribute__((ext_vector_type(4)));
template <class Epi, class Sched, bool ALIGN_EPI, bool GATHER = false, bool FP8 = false>
__device__ __forceinline__ void gemm_phase(PG8_LAS unsigned char* lds, const Gemm g, const Sched& S, const Epi& E, const int wid) {
    int lane = (int)__builtin_amdgcn_mbcnt_hi(~0u, __builtin_amdgcn_mbcnt_lo(~0u, 0u)); asm volatile("" : "+v"(lane));
    const int tid = wid * 64 + lane, wr = wid >> 2, wc = wid & 3, fr = lane & 15, fq = lane >> 4;
    const int K = g.K, nt = K / BK;
    unsigned cvo[4], nvo[4], voffB[2]; int rowA[2], colA[2];
#pragma unroll
    for (int i = 0; i < 2; ++i) { int R, C; stage_rc(tid * 16 + i * 8192, R, C); const int Rb = (R & ~31) + perm32(R & 31); rowA[i] = R; colA[i] = C;
        voffB[i] = (unsigned)(Rb * g.ldb + C) * 2u; }
    const size_t kstep = (size_t)(BK * 2);
    const size_t hstepB = (size_t)HALF * g.ldb * 2;
    const size_t tstepA = GATHER ? (size_t)0 : (size_t)2 * HALF * g.lda * 2, tstepB = 2 * hstepB;
#define PG8_ROWOFFS(vo, u) do { \
        if constexpr (GATHER) { int _sl[4]; unsigned _rw[4]; \
            _Pragma("unroll") for (int _h = 0; _h < 2; ++_h) _Pragma("unroll") for (int _i = 0; _i < 2; ++_i) _sl[2 * _h + _i] = (u).pm * BM + _h * HALF + rowA[_i]; \
            S.gather_rows4(u, _sl, _rw); \
            _Pragma("unroll") for (int _k = 0; _k < 4; ++_k) (vo)[_k] = (_rw[_k] * (unsigned)g.lda + (unsigned)colA[_k & 1]) * 2u; \
        } else { _Pragma("unroll") for (int _h = 0; _h < 2; ++_h) _Pragma("unroll") for (int _i = 0; _i < 2; ++_i) { \
            const int _r = _h * HALF + rowA[_i]; (vo)[2 * _h + _i] = ((unsigned)_r * (unsigned)g.lda + (unsigned)colA[_i]) * 2u; } } } while (0)
    const unsigned ldsw = (unsigned)wid * 1024u;
    const int aoff = lds_byte(wr * 64 + fr, fq * 8), boff = lds_byte(wc * 32 + fr, fq * 8);
#define PG8_SA(b, h) (((b) * 2 + (h)) * HTB)
#define PG8_SB(b, h) ((4 + (b) * 2 + (h)) * HTB)
#define PG8_STAGE(bufoff, gbase, voff) do { _Pragma("unroll") for (int _i = 0; _i < 2; ++_i) \
        __builtin_amdgcn_global_load_lds((const unsigned*)((const char*)(gbase) + (voff)[_i]), (PG8_LAS unsigned*)(lds + (bufoff) + ldsw + _i * 8192), 16, 0, 0); } while (0)
#define PG8_STAGEA(bufoff, gbase, vo, h) do { _Pragma("unroll") for (int _i = 0; _i < 2; ++_i) \
        __builtin_amdgcn_global_load_lds((const unsigned*)((const char*)(gbase) + (vo)[2 * (h) + _i]), (PG8_LAS unsigned*)(lds + (bufoff) + ldsw + _i * 8192), 16, 0, 0); } while (0)
#define PG8_LDA(dst, b, h) do { _Pragma("unroll") for (int m = 0; m < 4; ++m) dst[m] = __builtin_shufflevector(*(const PG8_LAS v4i*)(lds + PG8_SA(b, h) + aoff + m * 2048), *(const PG8_LAS v4i*)(lds + PG8_SA(b, h) + aoff + m * 2048 + 1024), 0, 1, 2, 3, 4, 5, 6, 7); } while (0)
#define PG8_LDB(dst, b, h) do { _Pragma("unroll") for (int n = 0; n < 2; ++n) dst[n] = __builtin_shufflevector(*(const PG8_LAS v4i*)(lds + PG8_SB(b, h) + boff + n * 2048), *(const PG8_LAS v4i*)(lds + PG8_SB(b, h) + boff + n * 2048 + 1024), 0, 1, 2, 3, 4, 5, 6, 7); } while (0)
#define PG8_HALF(x, k) __builtin_bit_cast(bf16x8, __builtin_shufflevector(x, x, 4 * (k), 4 * (k) + 1, 4 * (k) + 2, 4 * (k) + 3))
#define PG8_MMA(ai, bj, At, Bt) do { if constexpr (FP8) __builtin_amdgcn_sched_barrier(0); __builtin_amdgcn_s_setprio(1); _Pragma("unroll") for (int m = 0; m < 4; ++m) _Pragma("unroll") for (int n = 0; n < 2; ++n) { \
        if constexpr (FP8) acc[ai][bj][m][n] = __builtin_amdgcn_mfma_scale_f32_16x16x128_f8f6f4(Bt[n], At[m], acc[ai][bj][m][n], 0, 0, 0, 0x7f7f7f7f, 0, 0x7f7f7f7f); \
        else { acc[ai][bj][m][n] = __builtin_amdgcn_mfma_f32_16x16x32_bf16(PG8_HALF(Bt[n], 0), PG8_HALF(At[m], 0), acc[ai][bj][m][n], 0, 0, 0); \
               acc[ai][bj][m][n] = __builtin_amdgcn_mfma_f32_16x16x32_bf16(PG8_HALF(Bt[n], 1), PG8_HALF(At[m], 1), acc[ai][bj][m][n], 0, 0, 0); } } \
        if constexpr (FP8) { _Pragma("unroll") for (int m = 0; m < 4; ++m) _Pragma("unroll") for (int n = 0; n < 2; ++n) asm volatile("" : "+v"(acc[ai][bj][m][n])); }   \
        __builtin_amdgcn_s_setprio(0); if constexpr (FP8) __builtin_amdgcn_sched_barrier(0); } while (0)
#define PG8_WAIT_V(n) asm volatile("s_waitcnt vmcnt(" #n ")" ::: "memory")
#define PG8_WAIT_L(n) asm volatile("s_waitcnt lgkmcnt(" #n ")" ::: "memory")
#define PG8_BAR __builtin_amdgcn_s_barrier()
#define PG8_SCHED __builtin_amdgcn_sched_barrier(0)
    Unit cur, nxt; int ui = 0;
    if (!S.next(0, cur)) return;
    cur.idx = 0;
    f32x4 acc[2][2][4][2];
#pragma unroll
    for (int a = 0; a < 2; ++a)
#pragma unroll
        for (int b = 0; b < 2; ++b)
#pragma unroll
            for (int m = 0; m < 4; ++m)
#pragma unroll
                for (int n = 0; n < 2; ++n) acc[a][b][m][n] = (f32x4){0.f, 0.f, 0.f, 0.f};
    v8i At[4], B0[2], B1[2];
    const char* cA = (const char*)g.A + (size_t)cur.pm * tstepA + cur.koff; const char* cB = (const char*)g.Bt + (size_t)cur.e * g.estride + (size_t)cur.pn * tstepB + cur.koff;
    PG8_ROWOFFS(cvo, cur);
#pragma unroll
    for (int i = 0; i < 4; ++i) nvo[i] = cvo[i];
    PG8_STAGE(PG8_SB(0, 0), cB, voffB); PG8_STAGE(PG8_SB(0, 1), cB + hstepB, voffB); PG8_STAGEA(PG8_SA(0, 0), cA, cvo, 0); PG8_STAGEA(PG8_SA(0, 1), cA, cvo, 1);
    if (wr == 1) PG8_BAR;
    PG8_WAIT_V(2); PG8_BAR;
    PG8_STAGE(PG8_SB(1, 0), cB + kstep, voffB); PG8_STAGEA(PG8_SA(1, 0), cA + kstep, cvo, 0); PG8_STAGE(PG8_SB(1, 1), cB + hstepB + kstep, voffB);
    PG8_WAIT_V(6); PG8_BAR;
    for (;;) {
        const bool has_next = S.next(ui + 1, nxt); nxt.idx = ui + 1;
        const char* nA = has_next ? (const char*)g.A + (size_t)nxt.pm * tstepA + nxt.koff : cA;
        const char* nB = has_next ? (const char*)g.Bt + (size_t)nxt.e * g.estride + (size_t)nxt.pn * tstepB + nxt.koff : cB;
        if constexpr (GATHER) { if (has_next) PG8_ROWOFFS(nvo, nxt); }
        for (int t = 0; t < nt; t += 2) {
            const bool last = (t == nt - 2);
            const char* a1 = cA + (size_t)(t + 1) * kstep;
            const char* a2 = last ? nA : cA + (size_t)(t + 2) * kstep; const char* b2 = last ? nB : cB + (size_t)(t + 2) * kstep;
            const char* a3 = a2 + kstep; const char* b3 = b2 + kstep;
            unsigned vo2[4];
#pragma unroll
            for (int i = 0; i < 4; ++i) vo2[i] = (GATHER && last) ? nvo[i] : cvo[i];
            PG8_LDB(B0, 0, 0); PG8_LDB(B1, 0, 1); PG8_SCHED; PG8_LDA(At, 0, 0); PG8_STAGEA(PG8_SA(1, 1), a1, cvo, 1);
            PG8_WAIT_V(8); PG8_WAIT_L(0); PG8_BAR; PG8_MMA(0, 0, At, B0); PG8_MMA(0, 1, At, B1); PG8_BAR; PG8_SCHED;
            PG8_LDA(At, 0, 1); PG8_STAGE(PG8_SB(0, 0), b2, voffB); PG8_STAGE(PG8_SB(0, 1), b2 + hstepB, voffB); PG8_STAGEA(PG8_SA(0, 0), a2, vo2, 0);
            PG8_WAIT_V(8); PG8_WAIT_L(0); PG8_BAR; PG8_MMA(1, 0, At, B0); PG8_MMA(1, 1, At, B1); PG8_BAR; PG8_SCHED;
            PG8_LDB(B0, 1, 0); PG8_LDB(B1, 1, 1); PG8_SCHED; PG8_LDA(At, 1, 0); PG8_STAGEA(PG8_SA(0, 1), a2, vo2, 1);
            PG8_WAIT_V(8); PG8_WAIT_L(0); PG8_BAR; PG8_MMA(0, 0, At, B0); PG8_MMA(0, 1, At, B1); PG8_BAR; PG8_SCHED;
            PG8_LDA(At, 1, 1); PG8_STAGE(PG8_SB(1, 0), b3, voffB); PG8_STAGE(PG8_SB(1, 1), b3 + hstepB, voffB); PG8_STAGEA(PG8_SA(1, 0), a3, vo2, 0);
            PG8_WAIT_V(8); PG8_WAIT_L(0); PG8_BAR; PG8_MMA(1, 0, At, B0); PG8_MMA(1, 1, At, B1); PG8_BAR; PG8_SCHED;
        }
        if constexpr (ALIGN_EPI) { if (wr == 0) PG8_BAR; }
        E(acc, cur, wr, wc, fr, fq);
        if (!has_next) break;
#pragma unroll
        for (int a = 0; a < 2; ++a)
#pragma unroll
            for (int b = 0; b < 2; ++b)
#pragma unroll
                for (int m = 0; m < 4; ++m)
#pragma unroll
                    for (int n = 0; n < 2; ++n) acc[a][b][m][n] = (f32x4){0.f, 0.f, 0.f, 0.f};
        cur = nxt; cA = nA; cB = nB; ++ui;
        if constexpr (GATHER) {
#pragma unroll
            for (int i = 0; i < 4; ++i) cvo[i] = nvo[i]; }
        if constexpr (ALIGN_EPI) { if (wr == 1) PG8_BAR; }
    }
    PG8_WAIT_V(0);
    if constexpr (!ALIGN_EPI) { if (wr == 0) PG8_BAR; }
    PG8_BAR;
#undef PG8_SA
#undef PG8_SB
#undef PG8_STAGE
#undef PG8_STAGEA
#undef PG8_ROWOFFS
#undef PG8_LDA
#undef PG8_LDB
#undef PG8_MMA
#undef PG8_HALF
#undef PG8_WAIT_V
#undef PG8_WAIT_L
#undef PG8_BAR
#undef PG8_SCHED
}
}

constexpr int NB = 8, SEQ = 2048, D = 1024, T = NB * SEQ;
constexpr int MEML = 256, TM = NB * MEML;
constexpr int HYC = 512, NZ0 = 2048;
constexpr int FF = 2816, NGU = 2 * FF;
constexpr int ATW = 1536, NQKV = 3 * ATW, NQ1 = NQKV + 512;
constexpr int NE = 8, PMAX = 2 * T + NE * 256;
constexpr float EPS = 1e-6f;
constexpr float MOE_WGU_SCALE = 32.0f, MOE_WD_SCALE = 64.0f;
constexpr int NWAVES = 8;

constexpr size_t MiB = 1u << 20;
constexpr size_t WS_CTL = 0, CTL_ZERO_BYTES = 1 * MiB;
constexpr size_t WS_WGU1 = 1 * MiB;
constexpr size_t WS_WD1 = 89 * MiB;
constexpr size_t WS_SMALL = 133 * MiB;
constexpr size_t WS_RSTD0 = WS_SMALL;
constexpr size_t WS_SSQ16 = WS_SMALL + 64 * 1024;
constexpr size_t WS_LSE = WS_SSQ16 + 1 * MiB;
constexpr size_t WS_TOKE = WS_LSE + 768 * 1024;
constexpr size_t WS_TOKR = WS_TOKE + 128 * 1024;
constexpr size_t WS_TOKG = WS_TOKR + 128 * 1024;
constexpr size_t WS_RSTD3 = WS_TOKG + 128 * 1024;
constexpr size_t WS_LIST = WS_RSTD3 + 64 * 1024;
constexpr size_t WS_RSTDS = WS_LIST + 512 * 1024;
static_assert(WS_RSTDS + PMAX * 4 <= WS_SMALL + 4 * MiB, "small region");
constexpr size_t WS_WO = 137 * MiB;
constexpr size_t WS_WIN1 = 141 * MiB;
constexpr size_t WS_WKV = 151 * MiB;
constexpr size_t WS_WIN0 = 155 * MiB;
constexpr size_t WS_WGU0 = 159 * MiB;
constexpr size_t WS_WD0 = 170 * MiB;
constexpr size_t WS_KV = 176 * MiB;
constexpr size_t WS_XB = 184 * MiB;
constexpr size_t WS_YT = 336 * MiB;
constexpr size_t WS_MIX0 = 216 * MiB;
constexpr size_t WS_MN = 248 * MiB;
constexpr size_t WS_ZT = 256 * MiB;
constexpr size_t WS_XQ0 = 304 * MiB;
constexpr size_t WS_HF = 320 * MiB;
constexpr size_t WS_HID0 = 248 * MiB;
constexpr size_t WS_QKV1 = 248 * MiB;
constexpr size_t WS_XQ1 = 392 * MiB;
constexpr size_t WS_OG12 = 216 * MiB;
constexpr size_t WS_MIX1 = 141 * MiB;
constexpr size_t WS_XB3 = 392 * MiB;
constexpr size_t WS_XS = 137 * MiB;
constexpr size_t WS_HID1 = 205 * MiB;
constexpr size_t WS_Y2 = 392 * MiB;
constexpr size_t WS_END = 408 * MiB;
static_assert(WS_HID1 + (size_t)PMAX * FF * 2 <= WS_END && WS_XQ1 + (size_t)T * 512 * 2 <= WS_END && WS_XS + (size_t)PMAX * 2048 <= WS_HID1, "ws map");

constexpr int CW_CNT = 64;
constexpr int CW_PNL = 1024;
constexpr int CW_BAR = 4096;

constexpr int SCR_BYTES = 155648;
constexpr int MISC_OFF = SCR_BYTES;
constexpr int LDS_BYTES = SCR_BYTES + 4096;

#define LAS __attribute__((address_space(3)))
typedef unsigned short bf16;
typedef unsigned v4u __attribute__((ext_vector_type(4)));
typedef unsigned v2u __attribute__((ext_vector_type(2)));
typedef float f32x4 __attribute__((ext_vector_type(4)));
typedef float f32x2 __attribute__((ext_vector_type(2)));
#define LDS_WAIT() asm volatile("s_waitcnt lgkmcnt(0)" ::: "memory")
__device__ __forceinline__ unsigned f2bf(float f) { unsigned u = __builtin_bit_cast(unsigned, f); return (u + 0x7fffu + ((u >> 16) & 1u)) >> 16; }
__device__ __forceinline__ unsigned pk2(float lo, float hi) { unsigned r; asm("v_cvt_pk_bf16_f32 %0, %1, %2" : "=v"(r) : "v"(lo), "v"(hi)); return r; }
__device__ __forceinline__ unsigned pk4_fp8(float a, float b, float c, float d) { unsigned w = 0u; w = __builtin_amdgcn_cvt_pk_fp8_f32(a, b, w, false); w = __builtin_amdgcn_cvt_pk_fp8_f32(c, d, w, true); return w; }
__device__ __forceinline__ float bflo(unsigned w) { return __builtin_bit_cast(float, w << 16); }
__device__ __forceinline__ float bfhi(unsigned w) { return __builtin_bit_cast(float, w & 0xffff0000u); }
__device__ __forceinline__ float bf1(bf16 b) { return __builtin_bit_cast(float, ((unsigned)b) << 16); }
__device__ __forceinline__ float wave_sum(float v) {
#pragma unroll
    for (int o = 1; o < 64; o <<= 1) v += __shfl_xor(v, o);
    return v;
}
__device__ __forceinline__ float wave_max(float v) {
#pragma unroll
    for (int o = 1; o < 64; o <<= 1) v = fmaxf(v, __shfl_xor(v, o));
    return v;
}

#define XB_TMO      128
#define XB_XCNT(j)  (256  + 64 * (j))
#define XB_XSUB(j)  (1280 + 64 * (j))
#define XB_XGEN(j)  (2304 + 64 * (j))
#define XB_TOP      3328
#define XB_TOPGEN   3392
#define XCD_BAR_WORDS 3456
#define XB_SPIN_CAP (1u << 18)

__device__ __forceinline__ unsigned xb_ld(unsigned* p)              { return __hip_atomic_load(p, __ATOMIC_RELAXED, __HIP_MEMORY_SCOPE_AGENT); }
__device__ __forceinline__ unsigned xb_add(unsigned* p, unsigned v) { return __hip_atomic_fetch_add(p, v, __ATOMIC_RELAXED, __HIP_MEMORY_SCOPE_AGENT); }
__device__ __forceinline__ unsigned xb_xcc_id() { return (unsigned)__builtin_amdgcn_s_getreg((3 << 11) | 20) & 0xFu; }
#define XB_SPIN(cond, bar) do { unsigned _sp = 0; while (cond) { __builtin_amdgcn_s_sleep(1); \
    if ((++_sp & 255u) == 0u) { if (xb_ld(&(bar)[XB_TMO])) break; if (_sp > XB_SPIN_CAP) { atomicAdd(&(bar)[XB_TMO], 1u); break; } } } } while (0)

struct XcdBarrier {
    unsigned* bar; unsigned x;
    volatile LAS unsigned* st;
};
__device__ __forceinline__ XcdBarrier xcd_barrier_post(unsigned* bar, volatile LAS unsigned* st, int tid) {
    XcdBarrier b; b.bar = bar; b.x = xb_xcc_id(); b.st = st;
    if (tid == 0) st[2] = xb_add(&bar[XB_XCNT(b.x)], 1u);
    return b;
}
__device__ __forceinline__ void xcd_barrier_complete(unsigned* bar, unsigned x, unsigned& nloc, unsigned& nx, bool& even) {
    const unsigned G = gridDim.x * gridDim.y * gridDim.z;
    unsigned sum, cnt, mine, sp = 0u;
    for (;;) {
        sum = 0u; cnt = 0u; mine = 0u; even = true;
#pragma unroll
        for (unsigned j = 0; j < 16; ++j) { const unsigned c = xb_ld(&bar[XB_XCNT(j)]); sum += c; cnt += (c > 0u) ? 1u : 0u; mine = (j == x) ? c : mine; even = even && (c == (j < 8u ? G / 8u : 0u)); }
        if (sum == G) break;
        __builtin_amdgcn_s_sleep(1);
        if ((++sp & 255u) == 0u) { if (xb_ld(&bar[XB_TMO])) break; if (sp > XB_SPIN_CAP) { atomicAdd(&bar[XB_TMO], 1u); break; } }
    }
    nloc = mine > 0u ? mine : 1u; nx = cnt > 0u ? cnt : 1u;
}
__device__ __forceinline__ void xcd_barrier(const XcdBarrier& b, int tid) {
    asm volatile("s_waitcnt vmcnt(0)" ::: "memory");
    __syncthreads();
    if (tid == 0) {
        unsigned* bar = b.bar;
        __builtin_amdgcn_s_waitcnt(0);
        unsigned nloc = b.st[0], nx = b.st[1];
        if (nloc == 0u) { bool even; xcd_barrier_complete(bar, b.x, nloc, nx, even); b.st[0] = nloc; b.st[1] = nx; b.st[3] = even ? 1u : 2u; }
        const unsigned old = xb_add(&bar[XB_XSUB(b.x)], 1u);
        const unsigned gen = old / nloc;
        if (old + 1u == (gen + 1u) * nloc) {
            __builtin_amdgcn_fence(__ATOMIC_RELEASE, "agent");
            asm volatile("s_waitcnt vmcnt(0)" ::: "memory");
            const unsigned og = xb_add(&bar[XB_TOP], 1u);
            const unsigned tg = og / nx;
            if (og + 1u == (tg + 1u) * nx) xb_add(&bar[XB_TOPGEN], 1u);
            else XB_SPIN(xb_ld(&bar[XB_TOPGEN]) == tg, bar);
            __builtin_amdgcn_fence(__ATOMIC_ACQUIRE, "agent");
            xb_add(&bar[XB_XGEN(b.x)], 1u);
            asm volatile("s_waitcnt vmcnt(0)" ::: "memory");
        } else {
            XB_SPIN(xb_ld(&bar[XB_XGEN(b.x)]) == gen, bar);
            __builtin_amdgcn_fence(__ATOMIC_ACQUIRE, "agent");
            asm volatile("s_waitcnt vmcnt(0)" ::: "memory");
        }
    }
    __syncthreads();
}

__device__ __forceinline__ void xcd_local_barrier(const XcdBarrier& b, int tid) {
    asm volatile("s_waitcnt vmcnt(0)" ::: "memory");
    __syncthreads();
    if (tid == 0) {
        unsigned* bar = b.bar;
        __builtin_amdgcn_s_waitcnt(0);
        const unsigned nloc = b.st[0];
        const unsigned old = xb_add(&bar[XB_XSUB(b.x)], 1u);
        const unsigned gen = old / nloc;
        if (old + 1u == (gen + 1u) * nloc) xb_add(&bar[XB_XGEN(b.x)], 1u);
        else XB_SPIN(xb_ld(&bar[XB_XGEN(b.x)]) == gen, bar);
        __builtin_amdgcn_fence(__ATOMIC_ACQUIRE, "agent");
        asm volatile("s_waitcnt vmcnt(0)" ::: "memory");
    }
    __syncthreads();
}

__device__ __forceinline__ void panel_barrier(unsigned* cnt, unsigned target, unsigned* tmo, int tid) {
    asm volatile("s_waitcnt vmcnt(0)" ::: "memory");
    __syncthreads();
    if (tid == 0) {
        __builtin_amdgcn_s_waitcnt(0);
        xb_add(cnt, 1u);
        XB_SPIN(xb_ld(cnt) < target, tmo);
        __builtin_amdgcn_fence(__ATOMIC_ACQUIRE, "agent");
        asm volatile("s_waitcnt vmcnt(0)" ::: "memory");
    }
    __syncthreads();
}

struct Args { const float* in[30]; float* out; unsigned char* ws; int ph_lo, ph_hi, bslot, pad; };
enum { I_X = 0, I_MEM, I_RELB, I_NMIX, I_NMEM, I_NFFN, I_WKV, I_XQN, I_XKN, I_WOUT, I_HYWIN, I_HYCW, I_HYCB, I_FW1, I_FB1, I_FW2, I_FB2, I_FW3, I_FREQ, I_SKIP,
       I_ATWIN, I_ATQN, I_ATKN, I_FFG, I_FFU, I_FFD, I_ROUTER, I_MOEG, I_MOEU, I_MOED };

struct Frame {
    LAS unsigned char* lds;
    unsigned char* ws;
    int tid, lane, wave, G, bid;
    int vb, vcu; bool al;
};

constexpr int RSL_OFF = 131072;
template <int SCALE> struct EpiB {
    bf16* O; int ldc; const float* sc; int split_tile; bf16* O2; int ldc2; const LAS float* rsl; float kc;
    __device__ __forceinline__ void operator()(const f32x4 (&acc)[2][2][4][2], const pg8::Unit& u, int wr, int wc, int fr, int fq) const {
        const int row0 = u.pm * 256 + wr * 64 + fr;
        bf16* base = O; int ld = ldc; int colt = u.pn * 256;
        if (u.pn >= split_tile) { base = O2; ld = ldc2; colt -= split_tile * 256; }
        if (u.koff != 0) base = O2;
        const int col0 = colt + wc * 32 + 8 * fq;
        float rsv[2][4];
        if (SCALE == 1) {
#pragma unroll
            for (int ai = 0; ai < 2; ++ai)
#pragma unroll
                for (int m = 0; m < 4; ++m) rsv[ai][m] = sc[row0 + ai * 128 + m * 16];
            asm volatile("s_waitcnt vmcnt(0)" ::: "memory");
        }
        f32x4 cs[2][2];
        if (SCALE == 3) {
#pragma unroll
            for (int bj = 0; bj < 2; ++bj)
#pragma unroll
                for (int n = 0; n < 2; ++n) cs[bj][n] = *(const f32x4*)(sc + u.pn * 256 + bj * 128 + wc * 32 + 8 * fq + 4 * n);
            asm volatile("s_waitcnt vmcnt(0)" ::: "memory");
        }
#pragma unroll
        for (int ai = 0; ai < 2; ++ai)
#pragma unroll
            for (int m = 0; m < 4; ++m) {
                const int row = row0 + ai * 128 + m * 16;
                float rs = 1.f;
                if (SCALE == 1) rs = rsv[ai][m];
                if (SCALE == 2) { const f32x4* p = (const f32x4*)(sc + (size_t)row * 16); const f32x4 a = p[0], b = p[1], c = p[2], d = p[3];
                    const float s = ((a.x + a.y) + (a.z + a.w)) + ((b.x + b.y) + (b.z + b.w)) + ((c.x + c.y) + (c.z + c.w)) + ((d.x + d.y) + (d.z + d.w));
                    rs = 1.0f / sqrtf(s * (1.0f / D) + EPS); }
                if (SCALE == 4) rs = rsl[u.idx * 256 + (row - u.pm * 256)];
                if (SCALE == 5) rs = kc;
                bf16* rowp = base + (size_t)row * ld + col0;
#pragma unroll
                for (int bj = 0; bj < 2; ++bj) {
                    f32x4 v0 = acc[ai][bj][m][0], v1 = acc[ai][bj][m][1];
                    if (SCALE == 1 || SCALE == 2 || SCALE == 4 || SCALE == 5) { v0 = v0 * rs; v1 = v1 * rs; }
                    if (SCALE == 3) { v0 = v0 * cs[bj][0]; v1 = v1 * cs[bj][1]; }
                    v4u w; w.x = pk2(v0[0], v0[1]); w.y = pk2(v0[2], v0[3]); w.z = pk2(v1[0], v1[1]); w.w = pk2(v1[2], v1[3]);
                    *(v4u*)(rowp + bj * 128) = w;
                }
            }
    }
};
template <bool XF32, bool SSQ> struct EpiRes {
    const float* xf; const bf16* xi; int ldi; bf16* xo; int ldo; float* ssq16;
    __device__ __forceinline__ void operator()(const f32x4 (&acc)[2][2][4][2], const pg8::Unit& u, int wr, int wc, int fr, int fq) const {
        const int row0 = u.pm * 256 + wr * 64 + fr, col0 = u.pn * 256 + wc * 32 + 8 * fq;
        if constexpr (!XF32) {
            v4u res[2][4][2];
#pragma unroll
            for (int ai = 0; ai < 2; ++ai)
#pragma unroll
                for (int m = 0; m < 4; ++m)
#pragma unroll
                    for (int bj = 0; bj < 2; ++bj) res[ai][m][bj] = *(const v4u*)(xi + (size_t)(row0 + ai * 128 + m * 16) * ldi + col0 + bj * 128);
            asm volatile("s_waitcnt vmcnt(0)" ::: "memory");
#pragma unroll
            for (int ai = 0; ai < 2; ++ai)
#pragma unroll
                for (int m = 0; m < 4; ++m) {
                    const int row = row0 + ai * 128 + m * 16;
                    float ss = 0.f;
#pragma unroll
                    for (int bj = 0; bj < 2; ++bj) {
                        const v4u w0 = res[ai][m][bj];
                        const f32x4 r0 = (f32x4){bflo(w0.x), bfhi(w0.x), bflo(w0.y), bfhi(w0.y)}, r1 = (f32x4){bflo(w0.z), bfhi(w0.z), bflo(w0.w), bfhi(w0.w)};
                        const f32x4 v0 = acc[ai][bj][m][0] + r0, v1 = acc[ai][bj][m][1] + r1;
                        v4u w; w.x = pk2(v0[0], v0[1]); w.y = pk2(v0[2], v0[3]); w.z = pk2(v1[0], v1[1]); w.w = pk2(v1[2], v1[3]);
                        *(v4u*)(xo + (size_t)row * ldo + col0 + bj * 128) = w;
                        if (SSQ) ss += ((v0[0] * v0[0] + v0[1] * v0[1]) + (v0[2] * v0[2] + v0[3] * v0[3])) + ((v1[0] * v1[0] + v1[1] * v1[1]) + (v1[2] * v1[2] + v1[3] * v1[3]));
                    }
                    if (SSQ) { ss += __shfl_xor(ss, 16); ss += __shfl_xor(ss, 32);
                        if (fq == 0) ssq16[(size_t)row * 16 + u.pn * 4 + wc] = ss; }
                }
        } else {
#pragma unroll
            for (int ai = 0; ai < 2; ++ai)
#pragma unroll
                for (int m = 0; m < 4; ++m) {
                    const int row = row0 + ai * 128 + m * 16;
                    float ss = 0.f;
#pragma unroll
                    for (int bj = 0; bj < 2; ++bj) {
                        const size_t off = (size_t)row * D + col0 + bj * 128; const f32x4 r0 = *(const f32x4*)(xf + off), r1 = *(const f32x4*)(xf + off + 4);
                        const f32x4 v0 = acc[ai][bj][m][0] + r0, v1 = acc[ai][bj][m][1] + r1;
                        v4u w; w.x = pk2(v0[0], v0[1]); w.y = pk2(v0[2], v0[3]); w.z = pk2(v1[0], v1[1]); w.w = pk2(v1[2], v1[3]);
                        *(v4u*)(xo + (size_t)row * ldo + col0 + bj * 128) = w;
                        if (SSQ) ss += ((v0[0] * v0[0] + v0[1] * v0[1]) + (v0[2] * v0[2] + v0[3] * v0[3])) + ((v1[0] * v1[0] + v1[1] * v1[1]) + (v1[2] * v1[2] + v1[3] * v1[3]));
                    }
                    if (SSQ) { ss += __shfl_xor(ss, 16); ss += __shfl_xor(ss, 32);
                        if (fq == 0) ssq16[(size_t)row * 16 + u.pn * 4 + wc] = ss; }
                }
        }
    }
};
template <int SCALE, bool OUT8 = false> struct EpiSwiglu {
    bf16* H; int ldh; const float* sc; const LAS float* rsl; float kc;
    __device__ __forceinline__ void operator()(const f32x4 (&acc)[2][2][4][2], const pg8::Unit& u, int wr, int wc, int fr, int fq) const {
        const int row0 = u.pm * 256 + wr * 64 + fr, col0 = u.pn * 128 + wc * 32 + 8 * fq;
#pragma unroll
        for (int ai = 0; ai < 2; ++ai)
#pragma unroll
            for (int m = 0; m < 4; ++m) {
                const int row = row0 + ai * 128 + m * 16;
                float rs = 1.f;
                if (SCALE == 1) rs = sc[row];
                if (SCALE == 2) { const f32x4* p = (const f32x4*)(sc + (size_t)row * 16); const f32x4 a = p[0], b = p[1], c = p[2], d = p[3];
                    const float s = ((a.x + a.y) + (a.z + a.w)) + ((b.x + b.y) + (b.z + b.w)) + ((c.x + c.y) + (c.z + c.w)) + ((d.x + d.y) + (d.z + d.w));
                    rs = 1.0f / sqrtf(s * (1.0f / D) + EPS); }
                if (SCALE == 4) rs = rsl[u.idx * 256 + (row - u.pm * 256)];
                if (SCALE == 5) rs = kc;
                float h[8];
#pragma unroll
                for (int n = 0; n < 2; ++n)
#pragma unroll
                    for (int j = 0; j < 4; ++j) { const float gv = acc[ai][0][m][n][j] * rs, uv = acc[ai][1][m][n][j] * rs;
                        h[n * 4 + j] = gv * uv * __builtin_amdgcn_rcpf(1.0f + __expf(-gv)); }
                if (OUT8) { v2u w; w.x = pk4_fp8(h[0], h[1], h[2], h[3]); w.y = pk4_fp8(h[4], h[5], h[6], h[7]); *(v2u*)((unsigned char*)H + (size_t)row * ldh + col0) = w; }
                else { v4u w; w.x = pk2(h[0], h[1]); w.y = pk2(h[2], h[3]); w.z = pk2(h[4], h[5]); w.w = pk2(h[6], h[7]);
                    *(v4u*)(H + (size_t)row * ldh + col0) = w; }
            }
    }
};

template <class Sched>
__device__ __forceinline__ void fill_rstd_table(LAS unsigned char* lds, const Sched& S, const float* ssq16, int tid) {
    LAS float* rsl = (LAS float*)(lds + RSL_OFF);
    pg8::Unit u;
    for (int ui = 0; ui < 16 && S.next(ui, u); ++ui) {
        if (tid < 256) { const f32x4* p = (const f32x4*)(ssq16 + (size_t)(u.pm * 256 + tid) * 16); const f32x4 a = p[0], b = p[1], c = p[2], d = p[3];
            const float s = ((a.x + a.y) + (a.z + a.w)) + ((b.x + b.y) + (b.z + b.w)) + ((c.x + c.y) + (c.z + c.w)) + ((d.x + d.y) + (d.z + d.w));
            rsl[ui * 256 + tid] = 1.0f / sqrtf(s * (1.0f / D) + EPS); }
    }
    __syncthreads();
}

__device__ __forceinline__ void p0_transpose_item(const float* W, int K, int N, bf16* WT, const float* gain, int mode, LAS float* scr, int item, int lane) {
    const int nblk = N / 64, kb = item / nblk, nb = item % nblk, k0 = 64 * kb, n0 = 64 * nb;
    const int lr = lane >> 4, lc = lane & 15;
    f32x4 v[16];
#pragma unroll
    for (int i = 0; i < 16; ++i) v[i] = __builtin_nontemporal_load((const f32x4*)(W + (size_t)(k0 + 4 * i + lr) * N + n0 + 4 * lc));
    if (gain) {
#pragma unroll
        for (int i = 0; i < 16; ++i) v[i] = v[i] * gain[k0 + 4 * i + lr];
    }
#pragma unroll
    for (int i = 0; i < 16; ++i) { LAS float* s = scr + (4 * i + lr) * 65 + 4 * lc; s[0] = v[i].x; s[1] = v[i].y; s[2] = v[i].z; s[3] = v[i].w; }
    LDS_WAIT(); asm volatile("" ::: "memory");
    const int c = lane & 7;
    const int d0 = (mode == 0) ? n0 : (256 * (n0 / 128) + (n0 % 128) + (mode == 2 ? 128 : 0));
#pragma unroll
    for (int j = 0; j < 8; ++j) { const int n = (lane >> 3) + 8 * j; const LAS float* s = scr + (8 * c) * 65 + n;
        v4u o; o.x = pk2(s[0 * 65], s[1 * 65]); o.y = pk2(s[2 * 65], s[3 * 65]); o.z = pk2(s[4 * 65], s[5 * 65]); o.w = pk2(s[6 * 65], s[7 * 65]);
        *(v4u*)(WT + (size_t)(d0 + n) * K + k0 + 8 * c) = o; }
    LDS_WAIT(); asm volatile("" ::: "memory");
}
__device__ __forceinline__ void p0_transpose_item8(const float* W, int K, int N, unsigned char* WT8, const float* gain, float s8, int mode, LAS float* scr, int item, int lane) {
    const int nblk = N / 64, kb = item / nblk, nb = item % nblk, k0 = 64 * kb, n0 = 64 * nb;
    const int lr = lane >> 4, lc = lane & 15;
    f32x4 v[16];
#pragma unroll
    for (int i = 0; i < 16; ++i) v[i] = __builtin_nontemporal_load((const f32x4*)(W + (size_t)(k0 + 4 * i + lr) * N + n0 + 4 * lc));
#pragma unroll
    for (int i = 0; i < 16; ++i) { const float g = gain ? gain[k0 + 4 * i + lr] * s8 : s8; v[i] = v[i] * g; }
#pragma unroll
    for (int i = 0; i < 16; ++i) { LAS float* s = scr + (4 * i + lr) * 65 + 4 * lc; s[0] = v[i].x; s[1] = v[i].y; s[2] = v[i].z; s[3] = v[i].w; }
    LDS_WAIT(); asm volatile("" ::: "memory");
    const int c = lane & 3;
    const int d0 = (mode == 0) ? n0 : (256 * (n0 / 128) + (n0 % 128) + (mode == 2 ? 128 : 0));
#pragma unroll
    for (int j = 0; j < 4; ++j) { const int n = (lane >> 2) + 16 * j; const LAS float* s = scr + (16 * c) * 65 + n;
        v4u o; o.x = pk4_fp8(s[0 * 65], s[1 * 65], s[2 * 65], s[3 * 65]); o.y = pk4_fp8(s[4 * 65], s[5 * 65], s[6 * 65], s[7 * 65]);
        o.z = pk4_fp8(s[8 * 65], s[9 * 65], s[10 * 65], s[11 * 65]); o.w = pk4_fp8(s[12 * 65], s[13 * 65], s[14 * 65], s[15 * 65]);
        __builtin_nontemporal_store(o, (v4u*)(WT8 + (size_t)(d0 + n) * K + k0 + 16 * c)); }
    LDS_WAIT(); asm volatile("" ::: "memory");
}
__device__ __forceinline__ float row_to_bf16(const float* xrow, bf16* orow, const float* gain, bool normalize, int lane) {
    const f32x4* xr = (const f32x4*)xrow + lane;
    f32x4 v[4], gq[4]; float s = 0.f;
#pragma unroll
    for (int j = 0; j < 4; ++j) v[j] = __builtin_nontemporal_load(xr + 64 * j);
    if (normalize) {
#pragma unroll
        for (int j = 0; j < 4; ++j) gq[j] = ((const f32x4*)gain)[lane + 64 * j];
    }
#pragma unroll
    for (int j = 0; j < 4; ++j) s += (v[j].x * v[j].x + v[j].y * v[j].y) + (v[j].z * v[j].z + v[j].w * v[j].w);
    const float rstd = 1.0f / sqrtf(wave_sum(s) * (1.f / D) + EPS);
    unsigned long long* o8 = (unsigned long long*)orow + lane;
#pragma unroll
    for (int j = 0; j < 4; ++j) {
        f32x4 w = v[j];
        if (normalize) w = w * rstd * gq[j];
        o8[64 * j] = (unsigned long long)pk2(w.x, w.y) | ((unsigned long long)pk2(w.z, w.w) << 32);
    }
    return rstd;
}
__device__ __forceinline__ void p0_filter_block(Frame& F, const Args& a, float* Hf, int jb) {
    const float* w1 = a.in[I_FW1]; const float* b1 = a.in[I_FB1]; const float* w2 = a.in[I_FW2]; const float* b2 = a.in[I_FB2]; const float* w3 = a.in[I_FW3]; const float* fr = a.in[I_FREQ];
    LAS float* h2s = (LAS float*)(F.lds + MISC_OFF + 256);
    const int lane = F.lane, j0 = jb * 8;
    LAS float* W1s = (LAS float*)F.lds; LAS float* W2s = W1s + 33 * 64;
    for (int i = F.tid; i < 33 * 64; i += 512) W1s[i] = w1[i];
    for (int i = F.tid; i < 64 * 64; i += 512) W2s[i] = w2[i];
    __syncthreads();
    {
        const int j = j0 + F.wave;
        const float freq = fr[lane], bb1 = b1[lane], bb2 = b2[lane];
        float feat = 0.f;
        {
            const int fi = (lane >= 17) ? lane - 17 : lane - 1;
            const float f = 1e-4f + (float)fi * ((15.0f - 1e-4f) / 15.0f);
            const float ang = (6.283185307179586f / 2048.0f) * (float)j * f;
            if (lane == 0) feat = (float)j * (1.0f / 2047.0f);
            else if (lane <= 16) feat = cosf(ang);
            else if (lane <= 32) feat = -sinf(ang);
        }
        float s1 = bb1;
#pragma unroll
        for (int i = 0; i < 33; ++i) s1 += __shfl(feat, i) * W1s[i * 64 + lane];
        const float h1 = sinf(freq * s1);
        float s2 = bb2;
#pragma unroll 16
        for (int i = 0; i < 64; ++i) s2 += __shfl(h1, i) * W2s[i * 64 + lane];
        h2s[lane * 8 + F.wave] = sinf(freq * s2);
    }
    __syncthreads();
    const int n0 = F.wave * 256;
    float acc[4][8];
#pragma unroll
    for (int q = 0; q < 4; ++q)
#pragma unroll
        for (int jj = 0; jj < 8; ++jj) acc[q][jj] = 0.f;
#pragma unroll 1
    for (int i0 = 0; i0 < 64; i0 += 8) {
        float w[8][4];
#pragma unroll
        for (int ii = 0; ii < 8; ++ii)
#pragma unroll
            for (int q = 0; q < 4; ++q) w[ii][q] = w3[(size_t)(i0 + ii) * 2048 + n0 + q * 64 + lane];
#pragma unroll
        for (int ii = 0; ii < 8; ++ii) {
            const f32x4 ha = *(const LAS f32x4*)(h2s + (i0 + ii) * 8), hb = *(const LAS f32x4*)(h2s + (i0 + ii) * 8 + 4);
#pragma unroll
            for (int q = 0; q < 4; ++q) {
                acc[q][0] += ha.x * w[ii][q]; acc[q][1] += ha.y * w[ii][q]; acc[q][2] += ha.z * w[ii][q]; acc[q][3] += ha.w * w[ii][q];
                acc[q][4] += hb.x * w[ii][q]; acc[q][5] += hb.y * w[ii][q]; acc[q][6] += hb.z * w[ii][q]; acc[q][7] += hb.w * w[ii][q]; }
        }
    }
    const float da = -3.0701134573253945f, db = -15.350567286626973f;
#pragma unroll
    for (int q = 0; q < 4; ++q) {
        const int n = n0 + q * 64 + lane, c = n & 511;
        const float delta = fabsf(da + (db - da) * ((float)c * (1.0f / 511.0f)));
        float o[8];
#pragma unroll
        for (int jj = 0; jj < 8; ++jj) { const float t = (float)(j0 + jj) * (1.0f / 2047.0f); o[jj] = acc[q][jj] * (expf(-t * delta) + 0.05f); }
        f32x4* dst = (f32x4*)(Hf + (size_t)n * 2048 + j0);
        dst[0] = (f32x4){o[0], o[1], o[2], o[3]}; dst[1] = (f32x4){o[4], o[5], o[6], o[7]};
    }
    __syncthreads();
}
constexpr int IT_MOE = 16 * 44, N_MOE_ITEMS = 24 * IT_MOE;
constexpr int MOE_P1_HI = 5376, MOE_P5_MID = MOE_P1_HI + 4096, MOE_P5_HI = 16896, MOE_P0_LO = MOE_P5_HI, MOE_P12_LO = 16896 - 4672;
__device__ __forceinline__ void moe_convert(Frame& F, const Args& a, int lo, int hi, int gwl, int ngw) {
    LAS float* scr = (LAS float*)(F.lds + F.wave * 16640);
    unsigned char* ws = F.ws;
    for (int r = lo + gwl; r < hi; r += ngw) {
        const int mid = r / IT_MOE, li = r % IT_MOE, kind = mid >> 3, e = mid & 7;
        if (kind == 0) p0_transpose_item8(a.in[I_MOEG] + (size_t)e * D * FF, D, FF, ws + WS_WGU1 + (size_t)e * NGU * D, a.in[I_NFFN] + D, MOE_WGU_SCALE, 1, scr, li, F.lane);
        else if (kind == 1) p0_transpose_item8(a.in[I_MOEU] + (size_t)e * D * FF, D, FF, ws + WS_WGU1 + (size_t)e * NGU * D, a.in[I_NFFN] + D, MOE_WGU_SCALE, 2, scr, li, F.lane);
        else p0_transpose_item8(a.in[I_MOED] + (size_t)e * FF * D, FF, D, ws + WS_WD1 + (size_t)e * D * FF, nullptr, MOE_WD_SCALE, 0, scr, li, F.lane);
    }
}
__device__ __forceinline__ void p0_prologue(Frame& F, const Args& a) {
    LAS float* scr = (LAS float*)(F.lds + F.wave * 16640);
    const int gw = F.bid * NWAVES + F.wave, NGW = F.G * NWAVES;
    unsigned char* ws = F.ws;
    if (!(F.bid & 1)) { for (int jb = F.bid; jb < 256; jb += F.G) p0_filter_block(F, a, (float*)(ws + WS_HF), jb); }
    for (int m = gw; m < T; m += NGW) { const float r = row_to_bf16(a.in[I_X] + (size_t)m * D, (bf16*)(ws + WS_XB) + (size_t)m * D, nullptr, false, F.lane); if (F.lane == 0) ((float*)(ws + WS_RSTD0))[m] = r; }
    for (int m = gw; m < 2 * TM; m += NGW) { const int l = m / TM, r = m % TM;
        (void)row_to_bf16(a.in[I_MEM] + (size_t)r * D, (bf16*)(ws + WS_MN) + (size_t)m * D, a.in[I_NMEM] + l * D, true, F.lane); }
    constexpr int IT_A = 16 * 32, IT_SQ = 16 * 16, IT_G = 16 * 44, IT_D = 44 * 16, IT_W1 = 16 * 80;
    constexpr int NSMALL = IT_A + 4 * IT_SQ + 2 * IT_G + IT_D + IT_W1;
    for (int it = gw; it < NSMALL; it += NGW) {
        int r = it;
        if (r < IT_A) { p0_transpose_item(a.in[I_HYWIN], D, NZ0, (bf16*)(ws + WS_WIN0), a.in[I_NMIX], 0, scr, r, F.lane); continue; } r -= IT_A;
        if (r < IT_SQ) { p0_transpose_item(a.in[I_WKV], D, D, (bf16*)(ws + WS_WKV), nullptr, 0, scr, r, F.lane); continue; } r -= IT_SQ;
        if (r < IT_SQ) { p0_transpose_item(a.in[I_WKV] + (size_t)D * D, D, D, (bf16*)(ws + WS_WKV) + (size_t)D * D, nullptr, 0, scr, r, F.lane); continue; } r -= IT_SQ;
        if (r < IT_SQ) { p0_transpose_item(a.in[I_WOUT], D, D, (bf16*)(ws + WS_WO), nullptr, 0, scr, r, F.lane); continue; } r -= IT_SQ;
        if (r < IT_SQ) { p0_transpose_item(a.in[I_WOUT] + (size_t)D * D, D, D, (bf16*)(ws + WS_WO) + (size_t)D * D, nullptr, 0, scr, r, F.lane); continue; } r -= IT_SQ;
        if (r < IT_G) { p0_transpose_item(a.in[I_FFG], D, FF, (bf16*)(ws + WS_WGU0), a.in[I_NFFN], 1, scr, r, F.lane); continue; } r -= IT_G;
        if (r < IT_G) { p0_transpose_item(a.in[I_FFU], D, FF, (bf16*)(ws + WS_WGU0), a.in[I_NFFN], 2, scr, r, F.lane); continue; } r -= IT_G;
        if (r < IT_D) { p0_transpose_item(a.in[I_FFD], FF, D, (bf16*)(ws + WS_WD0), nullptr, 0, scr, r, F.lane); continue; } r -= IT_D;
        p0_transpose_item(a.in[I_ATWIN], D, NQ1, (bf16*)(ws + WS_WIN1), a.in[I_NMIX] + D, 0, scr, r, F.lane);
    }
    moe_convert(F, a, (F.G == 256) ? MOE_P0_LO : 0, N_MOE_ITEMS, gw, NGW);
    if (F.bid & 1) { __syncthreads(); for (int jb = F.bid; jb < 256; jb += F.G) p0_filter_block(F, a, (float*)(ws + WS_HF), jb); }
}
__device__ __forceinline__ float block_sum(Frame& F, float v) {
    LAS float* red = (LAS float*)(F.lds + MISC_OFF + 64);
    v = wave_sum(v);
    __syncthreads();
    if (F.lane == 0) red[F.wave] = v;
    __syncthreads();
    float s = 0.f;
#pragma unroll
    for (int w = 0; w < NWAVES; ++w) s += red[w];
    return s;
}
__device__ __forceinline__ int rel_bucket_dev(int rel) {
    const int n = rel < 0 ? -rel : rel;
    const int large = 8 + (n >= 15) + (n >= 27) + (n >= 50) + (n >= 91) + (n >= 166) + (n >= 305) + (n >= 559);
    return (rel > 0 ? 16 : 0) + (n < 8 ? n : large);
}
__device__ __forceinline__ void merge_token(Frame& F, int token) {
    const bf16* og = (const bf16*)(F.ws + WS_OG12); const float* lse = (const float*)(F.ws + WS_LSE);
    bf16* mix = (bf16*)(F.ws + WS_MIX1);
    const int lane = F.lane, h = lane >> 4;
    const float l0 = lse[(size_t)token * 4 + h], l1 = lse[((size_t)T + token) * 4 + h], l2 = lse[((size_t)2 * T + token) * 4 + h];
    const float mx = fmaxf(l0, fmaxf(l1, l2));
    float w0 = __expf(l0 - mx), w1 = __expf(l1 - mx), w2 = __expf(l2 - mx);
    const float iz = 1.0f / (w0 + w1 + w2); w0 *= iz; w1 *= iz; w2 *= iz;
    const v4u a0 = *(const v4u*)(mix + (size_t)token * D + 8 * lane);
    const v4u a1 = __builtin_nontemporal_load((const v4u*)(og + (size_t)token * 512 + 8 * lane));
    const v4u a2 = __builtin_nontemporal_load((const v4u*)(og + ((size_t)T + token) * 512 + 8 * lane));
    v4u o;
    o.x = pk2(w0 * bflo(a0.x) + w1 * bflo(a1.x) + w2 * bflo(a2.x), w0 * bfhi(a0.x) + w1 * bfhi(a1.x) + w2 * bfhi(a2.x));
    o.y = pk2(w0 * bflo(a0.y) + w1 * bflo(a1.y) + w2 * bflo(a2.y), w0 * bfhi(a0.y) + w1 * bfhi(a1.y) + w2 * bfhi(a2.y));
    o.z = pk2(w0 * bflo(a0.z) + w1 * bflo(a1.z) + w2 * bflo(a2.z), w0 * bfhi(a0.z) + w1 * bfhi(a1.z) + w2 * bfhi(a2.z));
    o.w = pk2(w0 * bflo(a0.w) + w1 * bflo(a1.w) + w2 * bflo(a2.w), w0 * bfhi(a0.w) + w1 * bfhi(a1.w) + w2 * bfhi(a2.w));
    *(v4u*)(mix + (size_t)token * D + 8 * lane) = o;
}

constexpr int RT_OFF_R = 0, RT_OFF_REC = 32768, RT_OFF_CNT = 32768 + 64 * 32;
constexpr int RT_BP = 2064, RT_OFF_BH = 36864, RT_OFF_BL = RT_OFF_BH + 8 * RT_BP, RT_OFF_X = RT_OFF_BL + 8 * RT_BP;
typedef short rt_bf16x8 __attribute__((ext_vector_type(8)));
__device__ __forceinline__ void route_block(Frame& F, const Args& a, int blk) {
    LAS float* RL = (LAS float*)(F.lds + RT_OFF_R); volatile LAS int* REC = (volatile LAS int*)(F.lds + RT_OFF_REC); LAS int* CNT = (LAS int*)(F.lds + RT_OFF_CNT);
    LAS unsigned char* BH = F.lds + RT_OFF_BH; LAS unsigned char* BL = F.lds + RT_OFF_BL;
    LAS float* XP = (LAS float*)(F.lds + RT_OFF_X); LAS float* XS = XP + 4 * 32 * 4; LAS float* XR = XS + 64;
    const int lane = F.lane;
    const float* g = a.in[I_NFFN] + D; const float* rtw = a.in[I_ROUTER];
    __syncthreads();
    for (int i = F.tid; i < 2048; i += 512) { const f32x4 r = ((const f32x4*)rtw)[i]; const float gg = g[i >> 1]; ((LAS f32x4*)RL)[i] = r * gg; }
    if (F.tid < 16) CNT[F.tid] = 0;
    __syncthreads();
    {
        const int n = F.tid & 7, kc = F.tid >> 3; unsigned hi[8], lo[8];
#pragma unroll
        for (int jj = 0; jj < 8; ++jj) { const float v0 = RL[(16 * kc + 2 * jj) * 8 + n], v1 = RL[(16 * kc + 2 * jj + 1) * 8 + n];
            hi[jj] = pk2(v0, v1); lo[jj] = pk2(v0 - bflo(hi[jj]), v1 - bfhi(hi[jj])); }
        LAS v4u* ph = (LAS v4u*)(BH + n * RT_BP + 32 * kc); LAS v4u* pl = (LAS v4u*)(BL + n * RT_BP + 32 * kc);
        ph[0] = (v4u){hi[0], hi[1], hi[2], hi[3]}; ph[1] = (v4u){hi[4], hi[5], hi[6], hi[7]}; pl[0] = (v4u){lo[0], lo[1], lo[2], lo[3]}; pl[1] = (v4u){lo[4], lo[5], lo[6], lo[7]};
    }
    __syncthreads();
    const int rt = F.wave & 3, kh = F.wave >> 2, r16 = lane & 15, kq = lane >> 4;
    const int tl = 16 * rt + r16, token = blk * 64 + tl, kb = 512 * kh + 128 * kq;
    const bf16* xr = (const bf16*)a.out + (size_t)token * 2048 + 1024 + kb;
    v4u raw[16];
#pragma unroll
    for (int s = 0; s < 16; ++s) raw[s] = __builtin_nontemporal_load((const v4u*)(xr + 8 * s));
    float ss = 0.f; f32x4 acc = (f32x4){0.f, 0.f, 0.f, 0.f};
    const bool bv = r16 < 8;
    const LAS unsigned char* bh = BH + (r16 & 7) * RT_BP + kb * 2; const LAS unsigned char* bl = BL + (r16 & 7) * RT_BP + kb * 2;
#pragma unroll
    for (int s = 0; s < 16; ++s) {
        const v4u w = raw[s];
        const float a0 = bflo(w.x), a1 = bfhi(w.x), a2 = bflo(w.y), a3 = bfhi(w.y), a4 = bflo(w.z), a5 = bfhi(w.z), a6 = bflo(w.w), a7 = bfhi(w.w);
        ss += ((a0 * a0 + a1 * a1) + (a2 * a2 + a3 * a3)) + ((a4 * a4 + a5 * a5) + (a6 * a6 + a7 * a7));
        v4u fh = (v4u){0u, 0u, 0u, 0u}, fl = (v4u){0u, 0u, 0u, 0u};
        if (bv) { fh = *(const LAS v4u*)(bh + 16 * s); fl = *(const LAS v4u*)(bl + 16 * s); }
        acc = __builtin_amdgcn_mfma_f32_16x16x32_bf16(__builtin_bit_cast(rt_bf16x8, fh), __builtin_bit_cast(rt_bf16x8, w), acc, 0, 0, 0);
        acc = __builtin_amdgcn_mfma_f32_16x16x32_bf16(__builtin_bit_cast(rt_bf16x8, fl), __builtin_bit_cast(rt_bf16x8, w), acc, 0, 0, 0);
    }
    ss += __shfl_xor(ss, 16); ss += __shfl_xor(ss, 32);
    if (kh == 1) { if (lane < 32) *(LAS f32x4*)(XP + (rt * 32 + lane) * 4) = acc; if (lane < 16) XS[rt * 16 + lane] = ss; }
    __syncthreads();
    if (kh == 0) {
        if (lane < 32) acc = acc + *(const LAS f32x4*)(XP + (rt * 32 + lane) * 4);
        ss += XS[rt * 16 + r16];
        const float rstd = 1.0f / sqrtf(ss * (1.f / D) + EPS);
        if (lane < 16) XR[tl] = rstd;
        const float u0 = __shfl_down(acc[0], 16), u1 = __shfl_down(acc[1], 16), u2 = __shfl_down(acc[2], 16), u3 = __shfl_down(acc[3], 16);
        if (lane < 16) {
            float lg[8] = {acc[0] * rstd, acc[1] * rstd, acc[2] * rstd, acc[3] * rstd, u0 * rstd, u1 * rstd, u2 * rstd, u3 * rstd};
            int i1 = 0; float v1 = lg[0];
#pragma unroll
            for (int e = 1; e < 8; ++e) if (lg[e] > v1) { v1 = lg[e]; i1 = e; }
            int i2 = -1; float v2 = -3.0e38f;
#pragma unroll
            for (int e = 0; e < 8; ++e) if (e != i1 && lg[e] > v2) { v2 = lg[e]; i2 = e; }
            const float e2 = __expf(v2 - v1), g1 = 1.0f / (1.0f + e2), g2 = e2 * g1;
            const int r1 = __hip_atomic_fetch_add(CNT + i1, 1, __ATOMIC_RELAXED, __HIP_MEMORY_SCOPE_WORKGROUP);
            const int r2 = __hip_atomic_fetch_add(CNT + i2, 1, __ATOMIC_RELAXED, __HIP_MEMORY_SCOPE_WORKGROUP);
            REC[tl * 8 + 0] = i1; REC[tl * 8 + 1] = i2; REC[tl * 8 + 2] = r1; REC[tl * 8 + 3] = r2;
            REC[tl * 8 + 4] = __builtin_bit_cast(int, g1); REC[tl * 8 + 5] = __builtin_bit_cast(int, g2); REC[tl * 8 + 6] = __builtin_bit_cast(int, rstd);
        }
    }
    __syncthreads();
    {
        const float rstd = XR[tl];
        v4u* o16 = (v4u*)(F.ws + WS_XB3 + (size_t)token * D + kb);
#pragma unroll
        for (int s = 0; s < 16; s += 2) {
            const v4u w0 = raw[s], w1 = raw[s + 1]; v4u o;
            o.x = pk4_fp8(bflo(w0.x) * rstd, bfhi(w0.x) * rstd, bflo(w0.y) * rstd, bfhi(w0.y) * rstd); o.y = pk4_fp8(bflo(w0.z) * rstd, bfhi(w0.z) * rstd, bflo(w0.w) * rstd, bfhi(w0.w) * rstd);
            o.z = pk4_fp8(bflo(w1.x) * rstd, bfhi(w1.x) * rstd, bflo(w1.y) * rstd, bfhi(w1.y) * rstd); o.w = pk4_fp8(bflo(w1.z) * rstd, bfhi(w1.z) * rstd, bflo(w1.w) * rstd, bfhi(w1.w) * rstd);
            o16[s >> 1] = o;
        }
    }
    __syncthreads();
    if (F.tid < 8) { unsigned* cnt = (unsigned*)(F.ws + WS_CTL) + CW_CNT; CNT[8 + F.tid] = (int)__hip_atomic_fetch_add(cnt + F.tid, (unsigned)CNT[F.tid], __ATOMIC_RELAXED, __HIP_MEMORY_SCOPE_AGENT); }
    __syncthreads();
    if (F.tid < 64) {
        const int tl = F.tid, token = blk * 64 + tl;
        const int i1 = REC[tl * 8 + 0], i2 = REC[tl * 8 + 1], r1 = CNT[8 + i1] + REC[tl * 8 + 2], r2 = CNT[8 + i2] + REC[tl * 8 + 3];
        int* toke = (int*)(F.ws + WS_TOKE); int* tokr = (int*)(F.ws + WS_TOKR); int* tokg = (int*)(F.ws + WS_TOKG); int* list = (int*)(F.ws + WS_LIST);
        list[(size_t)i1 * T + r1] = token; list[(size_t)i2 * T + r2] = token;
        toke[token * 2] = i1; toke[token * 2 + 1] = i2; tokr[token * 2] = r1; tokr[token * 2 + 1] = r2;
        tokg[token * 2] = REC[tl * 8 + 4]; tokg[token * 2 + 1] = REC[tl * 8 + 5];
        ((int*)(F.ws + WS_RSTD3))[token] = REC[tl * 8 + 6];
    }
}
__device__ __forceinline__ void moe_layout(Frame& F) {
    volatile LAS int* M = (volatile LAS int*)(F.lds + MISC_OFF);
    __syncthreads();
    if (F.tid == 0) {
        const unsigned* cnt = (const unsigned*)(F.ws + WS_CTL) + CW_CNT;
        int acc = 0;
        for (int e = 0; e < 8; ++e) { const int c = (int)__hip_atomic_load(cnt + e, __ATOMIC_RELAXED, __HIP_MEMORY_SCOPE_AGENT); M[32 + e] = c; M[40 + e] = acc; acc += (c + 255) & ~255; }
        M[48] = acc;
    }
    __syncthreads();
}
__device__ __forceinline__ int ml_ps(Frame& F, int e) { return ((volatile LAS int*)(F.lds + MISC_OFF))[40 + e]; }
__device__ __forceinline__ int ml_cnt(Frame& F, int e) { return ((volatile LAS int*)(F.lds + MISC_OFF))[32 + e]; }
__device__ __forceinline__ int ml_total(Frame& F) { return ((volatile LAS int*)(F.lds + MISC_OFF))[48]; }
__device__ __forceinline__ int ml_expert(Frame& F, int slot) { int e = 0;
#pragma unroll
    for (int i = 1; i < 8; ++i) e += (slot >= ml_ps(F, i)) ? 1 : 0;
    return e; }

constexpr int HY_CS = 4168, HY_M0 = 2080, HY_UR = 2592, HY_UP = 256;
constexpr int HY_OFF_CP = 64, HY_OFF_UB = HY_OFF_CP + 8 * HY_CS * 2, HY_OFF_X = HY_OFF_UB + 8 * HY_UR * 2;
static_assert(HY_OFF_X + 8 * 2048 * 2 <= SCR_BYTES, "hyena LDS");
typedef short bf16x8_t __attribute__((ext_vector_type(8)));

struct HyStage { v4u raw[4]; bf16 zm[4], zp[4]; };
struct HyFilt { float f[4], b[4]; };
__device__ __forceinline__ void hy_short_load(HyStage& s, const bf16* zr, int tid) {
#pragma unroll
    for (int k = 0; k < 4; ++k) {
        const int item = tid + 512 * k, b = item >> 8, t8 = (item & 255) * 8;
        const bf16* p = zr + b * SEQ + t8;
        s.raw[k] = __builtin_nontemporal_load((const v4u*)p);
        s.zm[k] = p[(t8 > 0) ? -1 : 0]; s.zp[k] = p[(t8 + 8 < SEQ) ? 8 : 7];
    }
}
__device__ __forceinline__ void hy_short_store(LAS unsigned char* dst, int stride_el, int pad_el, const HyStage& s, float w0, float w1, float w2, float cb, int tid) {
#pragma unroll
    for (int k = 0; k < 4; ++k) {
        const int item = tid + 512 * k, b = item >> 8, t8 = (item & 255) * 8;
        float z[10];
        z[0] = (t8 > 0) ? bf1(s.zm[k]) : 0.f; z[1] = bflo(s.raw[k].x); z[2] = bfhi(s.raw[k].x); z[3] = bflo(s.raw[k].y); z[4] = bfhi(s.raw[k].y); z[5] = bflo(s.raw[k].z); z[6] = bfhi(s.raw[k].z); z[7] = bflo(s.raw[k].w); z[8] = bfhi(s.raw[k].w); z[9] = (t8 + 8 < SEQ) ? bf1(s.zp[k]) : 0.f;
        float o[8];
#pragma unroll
        for (int i = 0; i < 8; ++i) o[i] = cb + z[i] * w0 + z[i + 1] * w1 + z[i + 2] * w2;
        v4u w; w.x = pk2(o[0], o[1]); w.y = pk2(o[2], o[3]); w.z = pk2(o[4], o[5]); w.w = pk2(o[6], o[7]);
        *(LAS v4u*)(dst + (size_t)(b * stride_el + pad_el + t8) * 2) = w;
    }
}
__device__ __forceinline__ void hy_filt_load(HyFilt& q, const float* Hf, int o, int c, int tid) {
    const float* fw = Hf + ((size_t)(o * 2 + 0) * 512 + c) * 2048;
    const float* bw = Hf + ((size_t)(o * 2 + 1) * 512 + c) * 2048;
#pragma unroll
    for (int i = 0; i < 4; ++i) { const int j = tid + 512 * i; q.f[i] = __builtin_nontemporal_load(fw + j); q.b[i] = (j >= 1) ? __builtin_nontemporal_load(bw + j) : 0.f; }
}
__device__ __forceinline__ void hy_filt_build(Frame& F, const HyFilt& q) {
    LAS float* Kf = (LAS float*)(F.lds + HY_OFF_X);
    float s = 0.f;
#pragma unroll
    for (int i = 0; i < 4; ++i) s += fabsf(q.f[i]) + fabsf(q.b[i]);
    const float tot = block_sum(F, s);
    const float inv = 1.0f / (tot + 1e-6f);
#pragma unroll
    for (int i = 0; i < 4; ++i) { const int j = F.tid + 512 * i; Kf[HY_M0 - j] = q.f[i] * inv; if (j >= 1) Kf[HY_M0 + j] = q.b[i] * inv; }
    if (F.tid < 33) Kf[F.tid] = 0.f;
    if (F.tid < 48) Kf[4128 + F.tid] = 0.f;
    __syncthreads();
    LAS unsigned* cp = (LAS unsigned*)(F.lds + HY_OFF_CP);
#pragma unroll
    for (int it = 0; it < 5; ++it) {
        const int m = F.tid + 512 * it;
        if (m < HY_CS / 2 + 3) {
            const float k0 = Kf[2 * m], k1 = Kf[2 * m + 1], k2 = Kf[2 * m + 2];
            const unsigned e = pk2(k0, k1), o = pk2(k1, k2);
#pragma unroll
            for (int k = 0; k < 4; ++k) { const int xp = m - k; if (xp >= 0 && xp < HY_CS / 2) { cp[(2 * k) * (HY_CS / 2) + xp] = e; cp[(2 * k + 1) * (HY_CS / 2) + xp] = o; } }
        }
    }
    __syncthreads();
}
__device__ __forceinline__ void hy_conv_mfma(Frame& F, f32x4 (&C)[8]) {
    const int lane = F.lane, w = F.wave, r = lane & 15, kq = lane >> 4;
    const int jc = (-r) & 7, cr = (r + 7) >> 3;
    const LAS unsigned char* abase = F.lds + HY_OFF_CP + (size_t)(jc * HY_CS + HY_M0 - 32 * (8 * w - 63) + 8 * kq - 8 * cr) * 2;
    const LAS unsigned char* bbase = F.lds + HY_OFF_UB + (size_t)((r & 7) * HY_UR + HY_UP + 16 * (r >> 3) + 8 * kq) * 2;
#pragma unroll
    for (int i = 0; i < 8; ++i) C[i] = (f32x4){0.f, 0.f, 0.f, 0.f};
    bf16x8_t Bw[9];
#pragma unroll
    for (int i = 0; i < 8; ++i) Bw[i] = *(const LAS bf16x8_t*)(bbase + 64 * (63 + i));
    bf16x8_t An = *(const LAS bf16x8_t*)(abase);
#pragma unroll 1
    for (int Q = 0; Q < 8; ++Q) {
        const LAS unsigned char* ab = abase - 64 * (9 * Q);
        const LAS unsigned char* bb = bbase + 64 * (63 - 9 * Q);
#pragma unroll
        for (int qq = 0; qq < 9; ++qq) {
            const bf16x8_t A = An;
            An = *(const LAS bf16x8_t*)(ab - 64 * (qq + 1));
            Bw[(8 - qq + 9) % 9] = *(const LAS bf16x8_t*)(bb + 64 * (-1 - qq));
#pragma unroll
            for (int i = 7; i >= 0; --i) C[i] = __builtin_amdgcn_mfma_f32_16x16x32_bf16(A, Bw[(i - qq + 9) % 9], C[i], 0, 0, 0);
        }
    }
}
#define HY_LDS_BARRIER() do { asm volatile("s_waitcnt lgkmcnt(0)" ::: "memory"); __builtin_amdgcn_s_barrier(); asm volatile("" ::: "memory"); } while (0)
__device__ __forceinline__ void hyena_units(Frame& F, const Args& a) {
    const bf16* zT = (const bf16*)(F.ws + WS_ZT);
    const float* Hf = (const float*)(F.ws + WS_HF);
    const float* cw = a.in[I_HYCW]; const float* cbp = a.in[I_HYCB]; const float* skip = a.in[I_SKIP];
    bf16* yT = (bf16*)(F.ws + WS_YT);
    LAS unsigned char* UB = F.lds + HY_OFF_UB; LAS unsigned char* XB = F.lds + HY_OFF_X;
    int c = F.bid; if (c >= HYC) return;
    HyStage sA, sC, sG; HyFilt fB, fF;
    hy_short_load(sA, zT + (size_t)c * T, F.tid); hy_filt_load(fB, Hf, 0, c, F.tid); hy_short_load(sC, zT + (size_t)(HYC + c) * T, F.tid);
#pragma unroll 1
    for (;;) {
        const int lane = F.lane, w = F.wave, n = lane & 15, bb = n & 7, hh = n >> 3, rq = lane >> 4;
        HY_LDS_BARRIER();
        for (int p = F.tid; p < 8 * 272; p += 512) { const int b = p / 272, q = p - b * 272; const int el = (q < 128) ? 2 * q : (HY_UP + SEQ + 2 * (q - 128)); *(LAS unsigned*)(UB + (size_t)(b * HY_UR + el) * 2) = 0u; }
        { const int ch = c; hy_short_store(UB, HY_UR, HY_UP, sA, cw[ch], cw[1536 + ch], cw[3072 + ch], cbp[ch], F.tid); }
        hy_filt_build(F, fB);
        { const int ch = HYC + c; hy_short_store(XB, SEQ, 0, sC, cw[ch], cw[1536 + ch], cw[3072 + ch], cbp[ch], F.tid); }
        hy_filt_load(fF, Hf, 1, c, F.tid); hy_short_load(sG, zT + (size_t)(2 * HYC + c) * T, F.tid);
        HY_LDS_BARRIER();
        f32x4 C[8];
        hy_conv_mfma(F, C);
        HY_LDS_BARRIER();
        {   const float sk = skip[c];
#pragma unroll
            for (int i = 0; i < 8; ++i) {
                const int t0 = 32 * (8 * w + i) + 16 * hh + 4 * rq;
                LAS v2u* up = (LAS v2u*)(UB + (size_t)(bb * HY_UR + HY_UP + t0) * 2);
                const v2u uu = *up; const v2u xx = *(const LAS v2u*)(XB + (size_t)(bb * SEQ + t0) * 2);
                v2u o;
                o.x = pk2(bflo(xx.x) * (C[i][0] + bflo(uu.x) * sk), bfhi(xx.x) * (C[i][1] + bfhi(uu.x) * sk));
                o.y = pk2(bflo(xx.y) * (C[i][2] + bflo(uu.y) * sk), bfhi(xx.y) * (C[i][3] + bfhi(uu.y) * sk));
                *up = o;
            }
        }
        HY_LDS_BARRIER();
        hy_filt_build(F, fF);
        { const int ch = 2 * HYC + c; hy_short_store(XB, SEQ, 0, sG, cw[ch], cw[1536 + ch], cw[3072 + ch], cbp[ch], F.tid); }
        const int cn = c + F.G; const bool more = cn < HYC;
        if (more) { hy_short_load(sA, zT + (size_t)cn * T, F.tid); hy_filt_load(fB, Hf, 0, cn, F.tid); hy_short_load(sC, zT + (size_t)(HYC + cn) * T, F.tid); }
        HY_LDS_BARRIER();
        hy_conv_mfma(F, C);
        {   const float sk = skip[HYC + c];
#pragma unroll
            for (int i = 0; i < 8; ++i) {
                const int t0 = 32 * (8 * w + i) + 16 * hh + 4 * rq;
                const v2u uu = *(const LAS v2u*)(UB + (size_t)(bb * HY_UR + HY_UP + t0) * 2); const v2u xx = *(const LAS v2u*)(XB + (size_t)(bb * SEQ + t0) * 2);
                v2u o;
                o.x = pk2(bflo(xx.x) * (C[i][0] + bflo(uu.x) * sk), bfhi(xx.x) * (C[i][1] + bfhi(uu.x) * sk));
                o.y = pk2(bflo(xx.y) * (C[i][2] + bflo(uu.y) * sk), bfhi(xx.y) * (C[i][3] + bfhi(uu.y) * sk));
                *(v2u*)(yT + (size_t)c * T + bb * SEQ + t0) = o;
            }
        }
        if (!more) break;
        c = cn;
    }
}
__device__ __forceinline__ void hy_transpose_tile(Frame& F, int tile) {
    const bf16* yT = (const bf16*)(F.ws + WS_YT); bf16* mix = (bf16*)(F.ws + WS_MIX0);
    LAS unsigned* scr = (LAS unsigned*)(F.lds + F.wave * (64 * 36 * 4));
    const int lane = F.lane, ct = tile & 7, tt = tile >> 3, c0 = 64 * ct, tok0 = 64 * tt;
    const int rr = lane >> 3, ch = lane & 7;
    v4u raw[8];
#pragma unroll
    for (int i = 0; i < 8; ++i) raw[i] = __builtin_nontemporal_load((const v4u*)(yT + (size_t)(c0 + 8 * i + rr) * T + tok0 + 8 * ch));
#pragma unroll
    for (int i = 0; i < 8; ++i) {
        v4u o; o.x = __shfl_xor(raw[i].x, 8); o.y = __shfl_xor(raw[i].y, 8); o.z = __shfl_xor(raw[i].z, 8); o.w = __shfl_xor(raw[i].w, 8);
        const bool odd = rr & 1;
        const unsigned a0 = odd ? o.z : raw[i].x, a1 = odd ? o.w : raw[i].y;
        const unsigned b0 = odd ? raw[i].z : o.x, b1 = odd ? raw[i].w : o.y;
        const int cp = (8 * i + (rr & ~1)) >> 1;
        const int tb = 8 * ch + (odd ? 4 : 0);
        scr[(tb + 0) * 36 + cp] = (a0 & 0xffffu) | (b0 << 16);
        scr[(tb + 1) * 36 + cp] = (a0 >> 16) | (b0 & 0xffff0000u);
        scr[(tb + 2) * 36 + cp] = (a1 & 0xffffu) | (b1 << 16);
        scr[(tb + 3) * 36 + cp] = (a1 >> 16) | (b1 & 0xffff0000u);
    }
    LDS_WAIT(); asm volatile("" ::: "memory");
#pragma unroll
    for (int i = 0; i < 8; ++i) { const int tk = 8 * i + rr; const v4u w = *(const LAS v4u*)(scr + tk * 36 + 4 * ch);
        *(v4u*)(mix + (size_t)(tok0 + tk) * D + c0 + 8 * ch) = w; }
    LDS_WAIT(); asm volatile("" ::: "memory");
}

constexpr int AT_KSTR = 136, AT_VSTR = 144;
template <int OFF> __device__ __forceinline__ v2u ds_tr16(unsigned addr) { v2u r; asm volatile("ds_read_b64_tr_b16 %0, %1 offset:%2" : "=v"(r) : "v"(addr), "n"(OFF)); return r; }
template <int NT, int DT, int I = 0>
__device__ __forceinline__ void pv_issue(unsigned vb, unsigned vb2, v2u (&t)[NT]) {
    if constexpr (I < NT) {
        constexpr int off = (I >> 1) * 32 * AT_VSTR * 2 + (I & 1) * 16 * AT_VSTR * 2 + 32 * DT;
        if constexpr (off < 65536) t[I] = ds_tr16<off>(vb); else t[I] = ds_tr16<off - 32768>(vb2);
        pv_issue<NT, DT, I + 1>(vb, vb2, t);
    }
}
template <int N> __device__ __forceinline__ void lgkm_wait() { asm volatile("s_waitcnt lgkmcnt(%0)" :: "n"(N)); }
template <int NT, bool DIL, bool EDGE>
__device__ __forceinline__ void attn_wave16(const LAS unsigned char* Ks, const LAS unsigned char* Vs, int k0, const v4u (&raw)[4], const LAS float* gfl, const LAS float* bt, int relbase, int lbase, int L,
                                            bf16* orow, float* lse_out, int lane) {
    const int r = lane & 15, rq = lane >> 4;
    bf16x8_t Qf[4];
    {
        float ss = 0.f;
#pragma unroll
        for (int st = 0; st < 4; ++st) {
            const float a0 = bflo(raw[st].x), a1 = bfhi(raw[st].x), a2 = bflo(raw[st].y), a3 = bfhi(raw[st].y), a4 = bflo(raw[st].z), a5 = bfhi(raw[st].z), a6 = bflo(raw[st].w), a7 = bfhi(raw[st].w);
            ss += (a0 * a0 + a1 * a1) + (a2 * a2 + a3 * a3) + (a4 * a4 + a5 * a5) + (a6 * a6 + a7 * a7); }
        ss += __shfl_xor(ss, 16); ss += __shfl_xor(ss, 32);
        const float sc = (0.08838834764831845f * 1.4426950408889634f) * __builtin_amdgcn_rsqf(ss * (1.f / 128.f) + EPS);
#pragma unroll
        for (int st = 0; st < 4; ++st) { const f32x4 g0 = *(const LAS f32x4*)(gfl + 32 * st + 8 * rq), g1 = *(const LAS f32x4*)(gfl + 32 * st + 8 * rq + 4); v4u w;
            w.x = pk2(bflo(raw[st].x) * (sc * g0.x), bfhi(raw[st].x) * (sc * g0.y)); w.y = pk2(bflo(raw[st].y) * (sc * g0.z), bfhi(raw[st].y) * (sc * g0.w));
            w.z = pk2(bflo(raw[st].z) * (sc * g1.x), bfhi(raw[st].z) * (sc * g1.y)); w.w = pk2(bflo(raw[st].w) * (sc * g1.z), bfhi(raw[st].w) * (sc * g1.w));
            Qf[st] = __builtin_bit_cast(bf16x8_t, w); }
    }
    float bv[DIL ? NT : 1][4];
    if (DIL) {
#pragma unroll
        for (int kt = 0; kt < NT; ++kt)
#pragma unroll
            for (int g = 0; g < 4; ++g) bv[kt][g] = bt[relbase + 16 * kt + g + 128];
    }
    f32x4 S[NT];
    const LAS unsigned char* kb = Ks + (size_t)(k0 + r) * (AT_KSTR * 2) + 16 * rq;
    bf16x8_t Af[2][4];
#pragma unroll
    for (int st = 0; st < 4; ++st) Af[0][st] = *(const LAS bf16x8_t*)(kb + 64 * st);
#pragma unroll
    for (int kt = 0; kt < NT; ++kt) {
        if (kt + 1 < NT) {
#pragma unroll
            for (int st = 0; st < 4; ++st) Af[(kt + 1) & 1][st] = *(const LAS bf16x8_t*)(kb + (kt + 1) * 16 * (AT_KSTR * 2) + 64 * st);
        }
        f32x4 acc = (f32x4){0.f, 0.f, 0.f, 0.f};
        if (DIL) acc = (f32x4){bv[kt][0], bv[kt][1], bv[kt][2], bv[kt][3]};
#pragma unroll
        for (int st = 0; st < 4; ++st) acc = __builtin_amdgcn_mfma_f32_16x16x32_bf16(Af[kt & 1][st], Qf[st], acc, 0, 0, 0);
        S[kt] = acc;
        asm volatile("" ::: "memory");
    }
    float mx = -3.0e38f;
#pragma unroll
    for (int kt = 0; kt < NT; ++kt)
#pragma unroll
        for (int g = 0; g < 4; ++g) {
            float s = S[kt][g];
            if (DIL && EDGE) { const int lk = lbase + 16 * kt + g; const bool ok = (lk >= 0) && (lk < L); s = ok ? s : -3.0e38f; S[kt][g] = s; }
            mx = fmaxf(mx, s);
        }
    mx = fmaxf(mx, __shfl_xor(mx, 16)); mx = fmaxf(mx, __shfl_xor(mx, 32));
    float z = 0.f;
#pragma unroll
    for (int kt = 0; kt < NT; ++kt)
#pragma unroll
        for (int g = 0; g < 4; ++g) { const float p = __builtin_amdgcn_exp2f(S[kt][g] - mx); S[kt][g] = p; z += p; }
    z += __shfl_xor(z, 16); z += __shfl_xor(z, 32);
    const float iz = __builtin_amdgcn_rcpf(z);
    bf16x8_t Pf[NT / 2];
#pragma unroll
    for (int ks = 0; ks < NT / 2; ++ks) { v4u w; w.x = pk2(S[2 * ks][0], S[2 * ks][1]); w.y = pk2(S[2 * ks][2], S[2 * ks][3]); w.z = pk2(S[2 * ks + 1][0], S[2 * ks + 1][1]); w.w = pk2(S[2 * ks + 1][2], S[2 * ks + 1][3]);
        Pf[ks] = __builtin_bit_cast(bf16x8_t, w); }
    const unsigned vb = (unsigned)(size_t)Vs + (unsigned)(k0 + 4 * rq + (r >> 2)) * (AT_VSTR * 2) + 8 * (lane & 3), vb2 = vb + 32768;
    constexpr int WN = NT < 15 ? NT : 15;
    v2u Vt[2][NT];
    pv_issue<NT, 0>(vb, vb2, Vt[0]);
#define PV_STEP(DT) { \
        if (DT + 1 < 8) { pv_issue<NT, (DT + 1) & 7>(vb, vb2, Vt[(DT + 1) & 1]); lgkm_wait<WN>(); } else lgkm_wait<0>(); \
        _Pragma("unroll") for (int i = 0; i < NT; ++i) asm volatile("" : "+v"(Vt[DT & 1][i])); \
        f32x4 o = (f32x4){0.f, 0.f, 0.f, 0.f}; \
        _Pragma("unroll") for (int ks = 0; ks < NT / 2; ++ks) { const v2u lo = Vt[DT & 1][2 * ks], hi = Vt[DT & 1][2 * ks + 1]; \
            o = __builtin_amdgcn_mfma_f32_16x16x32_bf16(__builtin_bit_cast(bf16x8_t, ((v4u){lo.x, lo.y, hi.x, hi.y})), Pf[ks], o, 0, 0, 0); } \
        v2u ow; ow.x = pk2(o[0] * iz, o[1] * iz); ow.y = pk2(o[2] * iz, o[3] * iz); \
        *(v2u*)(orow + 16 * DT + 4 * rq) = ow; }
    PV_STEP(0) PV_STEP(1) PV_STEP(2) PV_STEP(3) PV_STEP(4) PV_STEP(5) PV_STEP(6) PV_STEP(7)
#undef PV_STEP
    if (DIL) { if (rq == 0) *lse_out = mx * 0.6931471805599453f + logf(z); }
}
template <int NT>
__device__ __forceinline__ void attn_wave16x2(const LAS unsigned char* Ks, const LAS unsigned char* Vs, const v4u (&raw)[2][4], const LAS float* gfl, bf16* orow0, bf16* orow1, int lane) {
    const int r = lane & 15, rq = lane >> 4;
    bf16x8_t Qf[2][4];
#pragma unroll
    for (int t = 0; t < 2; ++t) {
        float ss = 0.f;
#pragma unroll
        for (int st = 0; st < 4; ++st) {
            const float a0 = bflo(raw[t][st].x), a1 = bfhi(raw[t][st].x), a2 = bflo(raw[t][st].y), a3 = bfhi(raw[t][st].y), a4 = bflo(raw[t][st].z), a5 = bfhi(raw[t][st].z), a6 = bflo(raw[t][st].w), a7 = bfhi(raw[t][st].w);
            ss += (a0 * a0 + a1 * a1) + (a2 * a2 + a3 * a3) + (a4 * a4 + a5 * a5) + (a6 * a6 + a7 * a7); }
        ss += __shfl_xor(ss, 16); ss += __shfl_xor(ss, 32);
        const float sc = (0.08838834764831845f * 1.4426950408889634f) * __builtin_amdgcn_rsqf(ss * (1.f / 128.f) + EPS);
#pragma unroll
        for (int st = 0; st < 4; ++st) { const f32x4 g0 = *(const LAS f32x4*)(gfl + 32 * st + 8 * rq), g1 = *(const LAS f32x4*)(gfl + 32 * st + 8 * rq + 4); v4u w;
            w.x = pk2(bflo(raw[t][st].x) * (sc * g0.x), bfhi(raw[t][st].x) * (sc * g0.y)); w.y = pk2(bflo(raw[t][st].y) * (sc * g0.z), bfhi(raw[t][st].y) * (sc * g0.w));
            w.z = pk2(bflo(raw[t][st].z) * (sc * g1.x), bfhi(raw[t][st].z) * (sc * g1.y)); w.w = pk2(bflo(raw[t][st].w) * (sc * g1.z), bfhi(raw[t][st].w) * (sc * g1.w));
            Qf[t][st] = __builtin_bit_cast(bf16x8_t, w); }
    }
    f32x4 S[2][NT];
    const LAS unsigned char* kb = Ks + (size_t)r * (AT_KSTR * 2) + 16 * rq;
    bf16x8_t Af[2][4];
#pragma unroll
    for (int st = 0; st < 4; ++st) Af[0][st] = *(const LAS bf16x8_t*)(kb + 64 * st);
#pragma unroll
    for (int kt = 0; kt < NT; ++kt) {
        if (kt + 1 < NT) {
#pragma unroll
            for (int st = 0; st < 4; ++st) Af[(kt + 1) & 1][st] = *(const LAS bf16x8_t*)(kb + (kt + 1) * 16 * (AT_KSTR * 2) + 64 * st);
        }
        f32x4 acc0 = (f32x4){0.f, 0.f, 0.f, 0.f}, acc1 = (f32x4){0.f, 0.f, 0.f, 0.f};
#pragma unroll
        for (int st = 0; st < 4; ++st) { acc0 = __builtin_amdgcn_mfma_f32_16x16x32_bf16(Af[kt & 1][st], Qf[0][st], acc0, 0, 0, 0); acc1 = __builtin_amdgcn_mfma_f32_16x16x32_bf16(Af[kt & 1][st], Qf[1][st], acc1, 0, 0, 0); }
        S[0][kt] = acc0; S[1][kt] = acc1;
        asm volatile("" ::: "memory");
    }
    bf16x8_t Pf[2][NT / 2]; float iz[2];
#pragma unroll
    for (int t = 0; t < 2; ++t) {
        float mx = -3.0e38f;
#pragma unroll
        for (int kt = 0; kt < NT; ++kt)
#pragma unroll
            for (int g = 0; g < 4; ++g) mx = fmaxf(mx, S[t][kt][g]);
        mx = fmaxf(mx, __shfl_xor(mx, 16)); mx = fmaxf(mx, __shfl_xor(mx, 32));
        float z = 0.f;
#pragma unroll
        for (int kt = 0; kt < NT; ++kt)
#pragma unroll
            for (int g = 0; g < 4; ++g) { const float p = __builtin_amdgcn_exp2f(S[t][kt][g] - mx); S[t][kt][g] = p; z += p; }
        z += __shfl_xor(z, 16); z += __shfl_xor(z, 32);
        iz[t] = __builtin_amdgcn_rcpf(z);
#pragma unroll
        for (int ks = 0; ks < NT / 2; ++ks) { v4u w; w.x = pk2(S[t][2 * ks][0], S[t][2 * ks][1]); w.y = pk2(S[t][2 * ks][2], S[t][2 * ks][3]); w.z = pk2(S[t][2 * ks + 1][0], S[t][2 * ks + 1][1]); w.w = pk2(S[t][2 * ks + 1][2], S[t][2 * ks + 1][3]);
            Pf[t][ks] = __builtin_bit_cast(bf16x8_t, w); }
    }
    const unsigned vb = (unsigned)(size_t)Vs + (unsigned)(4 * rq + (r >> 2)) * (AT_VSTR * 2) + 8 * (lane & 3), vb2 = vb + 32768;
    constexpr int WN = NT < 15 ? NT : 15;
    v2u Vt[2][NT];
    pv_issue<NT, 0>(vb, vb2, Vt[0]);
#define PV_STEP2(DT) { \
        if (DT + 1 < 8) { pv_issue<NT, (DT + 1) & 7>(vb, vb2, Vt[(DT + 1) & 1]); lgkm_wait<WN>(); } else lgkm_wait<0>(); \
        _Pragma("unroll") for (int i = 0; i < NT; ++i) asm volatile("" : "+v"(Vt[DT & 1][i])); \
        f32x4 o0 = (f32x4){0.f, 0.f, 0.f, 0.f}, o1 = (f32x4){0.f, 0.f, 0.f, 0.f}; \
        _Pragma("unroll") for (int ks = 0; ks < NT / 2; ++ks) { const v2u lo = Vt[DT & 1][2 * ks], hi = Vt[DT & 1][2 * ks + 1]; const bf16x8_t vf = __builtin_bit_cast(bf16x8_t, ((v4u){lo.x, lo.y, hi.x, hi.y})); \
            o0 = __builtin_amdgcn_mfma_f32_16x16x32_bf16(vf, Pf[0][ks], o0, 0, 0, 0); o1 = __builtin_amdgcn_mfma_f32_16x16x32_bf16(vf, Pf[1][ks], o1, 0, 0, 0); } \
        v2u ow; ow.x = pk2(o0[0] * iz[0], o0[1] * iz[0]); ow.y = pk2(o0[2] * iz[0], o0[3] * iz[0]); *(v2u*)(orow0 + 16 * DT + 4 * rq) = ow; \
        ow.x = pk2(o1[0] * iz[1], o1[1] * iz[1]); ow.y = pk2(o1[2] * iz[1], o1[3] * iz[1]); *(v2u*)(orow1 + 16 * DT + 4 * rq) = ow; }
    PV_STEP2(0) PV_STEP2(1) PV_STEP2(2) PV_STEP2(3) PV_STEP2(4) PV_STEP2(5) PV_STEP2(6) PV_STEP2(7)
#undef PV_STEP2
}
template <int CTRL> __device__ __forceinline__ float dpp_f(float x) { return __builtin_bit_cast(float, __builtin_amdgcn_update_dpp(0, __builtin_bit_cast(int, x), CTRL, 0xf, 0xf, true)); }
template <int NK, int NB, int BS, class RowFn>
__device__ __forceinline__ void attn_stage_kv(LAS unsigned char* Ks, LAS unsigned char* Vs, const bf16* kbase, const bf16* vbase, RowFn rowoff, int wave, int lane) {
    const int rr = lane >> 4, cc = lane & 15;
#pragma unroll 1
    for (int bt = 0; bt < NB; ++bt) {
        v4u rk[BS], rv[BS]; bool ok[BS];
#pragma unroll
        for (int i = 0; i < BS; ++i) { const int j = ((bt * BS + i) * 8 + wave) * 4 + rr; const int off = rowoff(j); ok[i] = off >= 0;
            const unsigned ob = (ok[i] ? (unsigned)off * 2u : 0u) + 16u * cc;
            rk[i] = *(const v4u*)((const char*)kbase + ob); rv[i] = *(const v4u*)((const char*)vbase + ob); }
#pragma unroll
        for (int i = 0; i < BS; ++i) { const int j = ((bt * BS + i) * 8 + wave) * 4 + rr;
            const float k0 = bflo(rk[i].x), k1 = bfhi(rk[i].x), k2 = bflo(rk[i].y), k3 = bfhi(rk[i].y), k4 = bflo(rk[i].z), k5 = bfhi(rk[i].z), k6 = bflo(rk[i].w), k7 = bfhi(rk[i].w);
            float ss = (k0 * k0 + k1 * k1) + (k2 * k2 + k3 * k3) + (k4 * k4 + k5 * k5) + (k6 * k6 + k7 * k7);
            ss += dpp_f<0xB1>(ss); ss += dpp_f<0x4E>(ss); ss += dpp_f<0x141>(ss); ss += dpp_f<0x140>(ss);
            const float sc = ok[i] ? __builtin_amdgcn_rsqf(ss * (1.f / 128.f) + EPS) : 0.f;
            v4u w; w.x = pk2(k0 * sc, k1 * sc); w.y = pk2(k2 * sc, k3 * sc); w.z = pk2(k4 * sc, k5 * sc); w.w = pk2(k6 * sc, k7 * sc);
            if (((bt * BS + i + 1) * 32 <= NK) || j < NK) *(LAS v4u*)(Ks + (unsigned)j * (AT_KSTR * 2) + 16 * cc) = w; }
#pragma unroll
        for (int i = 0; i < BS; ++i) { const int j = ((bt * BS + i) * 8 + wave) * 4 + rr;
            v4u w = rv[i]; if (!ok[i]) w = (v4u){0u, 0u, 0u, 0u};
            if (((bt * BS + i + 1) * 32 <= NK) || j < NK) *(LAS v4u*)(Vs + (unsigned)j * (AT_VSTR * 2) + 16 * cc) = w; }
    }
}

#define AT_LDS_BARRIER() do { asm volatile("s_waitcnt lgkmcnt(0)" ::: "memory"); __builtin_amdgcn_s_barrier(); asm volatile("" ::: "memory"); } while (0)
constexpr int XA_OFF_V = 256 * AT_KSTR * 2;
static_assert(XA_OFF_V + 256 * AT_VSTR * 2 <= SCR_BYTES, "cross LDS");
__device__ __forceinline__ void cross_unit(Frame& F, const bf16* xq, const bf16* kv, const LAS float* gfl, bf16* mix, int unit) {
    int lane = (int)__builtin_amdgcn_mbcnt_hi(~0u, __builtin_amdgcn_mbcnt_lo(~0u, 0u)); asm volatile("" : "+v"(lane)); const int tid = F.wave * 64 + lane;
    const int b = unit >> 5, h = (unit >> 3) & 3, qc = unit & 7;
    LAS unsigned char* Ks = F.lds; LAS unsigned char* Vs = F.lds + XA_OFF_V;
    const bf16* kbase = kv + (size_t)(b * MEML) * 1024 + h * 128;
    v4u qraw[2][4];
#pragma unroll
    for (int t = 0; t < 2; ++t) { const int token = b * SEQ + qc * 256 + 16 * (F.wave + 8 * t) + (lane & 15);
#pragma unroll
        for (int st = 0; st < 4; ++st) qraw[t][st] = *(const v4u*)(xq + (size_t)token * 512 + h * 128 + 32 * st + 8 * (lane >> 4)); }
    AT_LDS_BARRIER();
    attn_stage_kv<MEML, 1, 8>(Ks, Vs, kbase, kbase + 512, [=](int j) { return j * 1024; }, F.wave, lane);
    __syncthreads();
    {   const int tok0 = b * SEQ + qc * 256 + 16 * F.wave + (lane & 15);
        attn_wave16x2<16>(Ks, Vs, qraw, gfl, mix + (size_t)tok0 * D + 512 + h * 128, mix + (size_t)(tok0 + 128) * D + 512 + h * 128, lane); }
}
constexpr int DA_NK = 272, DA_OFF_V = DA_NK * AT_KSTR * 2, DA_OFF_BT = DA_OFF_V + DA_NK * AT_VSTR * 2;
static_assert(DA_OFF_BT + 320 * 4 <= SCR_BYTES, "dilated LDS");
__device__ __forceinline__ void dil_unit(Frame& F, const Args& a, const LAS float* gfl, int unit) {
    const int bh = unit / 48, sub = unit % 48, b = bh >> 2, h = bh & 3, g = sub >> 4, w16 = sub & 15;
    const int dil = (g == 0) ? 1 : (g == 1 ? 4 : 16), L = SEQ / dil, nch = L / 128;
    const int r = w16 / nch, n128 = w16 % nch;
    int lane = (int)__builtin_amdgcn_mbcnt_hi(~0u, __builtin_amdgcn_mbcnt_lo(~0u, 0u)); asm volatile("" : "+v"(lane)); const int tid = F.wave * 64 + lane;
    const bf16* qkv = (const bf16*)(F.ws + WS_QKV1);
    float* lse = (float*)(F.ws + WS_LSE);
    LAS unsigned char* Ks = F.lds; LAS unsigned char* Vs = F.lds + DA_OFF_V; LAS float* bt = (LAS float*)(F.lds + DA_OFF_BT);
    const int lk0 = 128 * n128 - 64;
    const bf16* base = qkv + (size_t)(b * SEQ + r) * NQKV + g * 512 + h * 128;
    const size_t lstep = (size_t)dil * NQKV;
    const int qi = 16 * F.wave + (lane & 15), lq = 128 * n128 + qi, token = b * SEQ + lq * dil + r;
    v4u qraw[4];
#pragma unroll
    for (int st = 0; st < 4; ++st) qraw[st] = *(const v4u*)(base + (size_t)lq * lstep + 32 * st + 8 * (lane >> 4));
    const int brel = tid - 128; const bool bin = (tid < 320) && brel >= -64 && brel <= 64;
    const float braw = a.in[I_RELB][(bin ? rel_bucket_dev(brel * dil) * 12 : 0) + g * 4 + h];
    AT_LDS_BARRIER();
    {   const int lstep32 = dil * NQKV;
        attn_stage_kv<DA_NK, 1, 9>(Ks, Vs, base + ATW, base + 2 * ATW, [=](int j) { const int lk = lk0 + j; return (lk >= 0 && lk < L) ? lk * lstep32 : -1; }, F.wave, lane); }
    if (tid < 320) bt[tid] = bin ? braw * 1.4426950408889634f : -3.0e38f;
    __syncthreads();
    {
        const int k0 = 16 * F.wave, rq = lane >> 4;
        bf16* orow = (g == 0) ? (bf16*)(F.ws + WS_MIX1) + (size_t)token * D + h * 128 : (bf16*)(F.ws + WS_OG12) + ((size_t)(g - 1) * T + token) * 512 + h * 128;
        float* lp = lse + ((size_t)g * T + token) * 4 + h;
        if (n128 == 0 || n128 == nch - 1) attn_wave16<10, true, true>(Ks, Vs, k0, qraw, gfl, bt, k0 + 4 * rq - 64 - qi, lk0 + k0 + 4 * rq, L, orow, lp, lane);
        else attn_wave16<10, true, false>(Ks, Vs, k0, qraw, gfl, bt, k0 + 4 * rq - 64 - qi, lk0 + k0 + 4 * rq, L, orow, lp, lane);
    }
}
__device__ __forceinline__ void combine_phase(Frame& F, const Args& a) {
    moe_layout(F);
    const int gw = F.bid * NWAVES + F.wave, NGW = F.G * NWAVES, lane = F.lane;
    const int* toke = (const int*)(F.ws + WS_TOKE); const int* tokr = (const int*)(F.ws + WS_TOKR); const float* tokg = (const float*)(F.ws + WS_TOKG);
    const bf16* y = (const bf16*)(F.ws + WS_XS); const bf16* y2 = (const bf16*)(F.ws + WS_Y2);
    for (int token = gw; token < T; token += NGW) {
        const int e0 = toke[token * 2], e1 = toke[token * 2 + 1];
        const int s0 = ml_ps(F, e0) + tokr[token * 2], s1 = ml_ps(F, e1) + tokr[token * 2 + 1];
        const float g0 = tokg[token * 2], g1 = tokg[token * 2 + 1];
        f32x4* xo = (f32x4*)(a.out + (size_t)token * D); const v2u* xi = (const v2u*)((const bf16*)a.out + (size_t)token * 2048 + 1024);
        const v2u* y0 = (const v2u*)(y + (size_t)s0 * D); const v2u* y1 = (const v2u*)(y + (size_t)s1 * D);
        v2u xw[4], p0[4], p1[4];
#pragma unroll
        for (int j = 0; j < 4; ++j) { const int q = lane + 64 * j; xw[j] = __builtin_nontemporal_load(xi + q); p0[j] = __builtin_nontemporal_load(y0 + q); p1[j] = __builtin_nontemporal_load(y1 + q); }
        f32x4 r[4];
#pragma unroll
        for (int j = 0; j < 4; ++j) {
            const int q = lane + 64 * j;
            f32x4 x = (f32x4){bflo(xw[j].x), bfhi(xw[j].x), bflo(xw[j].y), bfhi(xw[j].y)};
            f32x4 a0 = (f32x4){bflo(p0[j].x), bfhi(p0[j].x), bflo(p0[j].y), bfhi(p0[j].y)}, a1 = (f32x4){bflo(p1[j].x), bfhi(p1[j].x), bflo(p1[j].y), bfhi(p1[j].y)};
            if (s0 >= 2 * T) { const v2u t = ((const v2u*)(y2 + (size_t)(s0 - 2 * T) * D))[q]; a0 = a0 + (f32x4){bflo(t.x), bfhi(t.x), bflo(t.y), bfhi(t.y)}; }
            if (s1 >= 2 * T) { const v2u t = ((const v2u*)(y2 + (size_t)(s1 - 2 * T) * D))[q]; a1 = a1 + (f32x4){bflo(t.x), bfhi(t.x), bflo(t.y), bfhi(t.y)}; }
            r[j] = x + g0 * a0 + g1 * a1;
        }
        asm volatile("s_waitcnt vmcnt(0)" ::: "memory");
#pragma unroll
        for (int j = 0; j < 4; ++j) __builtin_nontemporal_store(r[j], xo + lane + 64 * j);
    }
}

constexpr int NPHASE = 15;
__global__ void __launch_bounds__(NWAVES * 64, 2) mega_fwd(Args args) {
    extern __shared__ __attribute__((aligned(16))) unsigned char lds_raw[];
    Frame F;
    F.lds = (LAS unsigned char*)lds_raw; F.ws = args.ws;
    F.wave = __builtin_amdgcn_readfirstlane((int)threadIdx.x >> 6); F.G = gridDim.x; F.bid = blockIdx.x;
#define PH_BEGIN() do { int l_ = (int)__builtin_amdgcn_mbcnt_hi(~0u, __builtin_amdgcn_mbcnt_lo(~0u, 0u)); asm volatile("" : "+v"(l_)); F.lane = l_; F.tid = F.wave * 64 + l_; } while (0)
    PH_BEGIN();
    unsigned char* ws = args.ws;
    volatile LAS unsigned* MISC = (volatile LAS unsigned*)(F.lds + MISC_OFF);
    for (int u = F.tid; u < (LDS_BYTES - MISC_OFF) / 4; u += NWAVES * 64) MISC[u] = 0u;
    __syncthreads();
    const int lo = args.ph_lo, hi = args.ph_hi;
    const bool use_bar = (hi - lo) > 1;
    XcdBarrier bar; bar.bar = (unsigned*)(ws + WS_CTL) + CW_BAR + args.bslot * XCD_BAR_WORDS; bar.x = 0; bar.st = nullptr;
    if (use_bar) bar = xcd_barrier_post((unsigned*)(ws + WS_CTL) + CW_BAR + args.bslot * XCD_BAR_WORDS, MISC + 8, F.tid);
#define IN(k) (lo <= (k) && (k) < hi)
#define SEAM(k) do { if (IN(k) && IN((k) + 1)) { PH_BEGIN(); xcd_barrier(bar, F.tid); } } while (0)
#define SEAMP(k) do { if (IN(k) && IN((k) + 1)) { PH_BEGIN(); if (F.al) { ++pnl_uses; panel_barrier((unsigned*)(ws + WS_CTL) + CW_PNL + 16 * ((F.vb & 7) * 8 + ((F.vb >> 3) & 7)), 4u * pnl_uses, bar.bar, F.tid); } else xcd_barrier(bar, F.tid); } } while (0)
#define SEAML(k) do { if (IN(k) && IN((k) + 1)) { PH_BEGIN(); if (F.al) xcd_local_barrier(bar, F.tid); else xcd_barrier(bar, F.tid); } } while (0)
    const int gw = F.bid * NWAVES + F.wave, NGW = F.G * NWAVES;
    F.vb = F.bid; F.vcu = F.bid; F.al = false;
    unsigned pnl_uses = 0u;
    LAS unsigned char* ring = F.lds;

    if (IN(0)) { PH_BEGIN(); p0_prologue(F, args); }
    SEAM(0);
    if (IN(0) && IN(1)) {
        const unsigned fl = MISC[11], rk = MISC[10];
        if (fl == 1u && F.G == 256) { F.al = true; F.vb = __builtin_amdgcn_readfirstlane((int)(rk * 8u + bar.x)); F.vcu = __builtin_amdgcn_readfirstlane((int)(bar.x * 32u + rk)); }
    }
    if (IN(1)) { PH_BEGIN();
        {   pg8::Gemm g{(const bf16*)(ws + WS_WIN0), (const bf16*)(ws + WS_XB), D, D, D, 0};
            pg8::StaticOrder S; S.init(ATW / 256, T / 256, F.G, F.bid);
            EpiB<3> E{(bf16*)(ws + WS_ZT), T, (const float*)(ws + WS_RSTD0), 1 << 30, nullptr, 0, nullptr, 1.0f};
            pg8::gemm_phase<EpiB<3>, pg8::StaticOrder, true>(ring, g, S, E, F.wave); }
        {   pg8::Gemm g{(const bf16*)(ws + WS_XB), (const bf16*)(ws + WS_WIN0) + (size_t)ATW * D, D, D, D, 0};
            pg8::StaticOrder S; S.init(T / 256, 2, F.G, (F.bid + 128) % F.G);
            EpiB<1> E{(bf16*)(ws + WS_XQ0), 512, (const float*)(ws + WS_RSTD0), 1 << 30, nullptr, 0, nullptr, 1.0f};
            pg8::gemm_phase<EpiB<1>, pg8::StaticOrder, true>(ring, g, S, E, F.wave); }
        {   pg8::Gemm g{(const bf16*)(ws + WS_MN), (const bf16*)(ws + WS_WKV), D, D, D, (size_t)D * D * 2};
            pg8::MoeOrder S; S.init(2 * TM / 256, 4, F.G, F.bid); S.t0 = TM / 256; S.t1 = S.t2 = S.t3 = S.t4 = S.t5 = S.t6 = 1 << 30; S.lay = nullptr; S.list = nullptr;
            EpiB<0> E{(bf16*)(ws + WS_KV), D, nullptr, 1 << 30, nullptr, 0, nullptr, 1.0f};
            pg8::gemm_phase<EpiB<0>, pg8::MoeOrder, true>(ring, g, S, E, F.wave); }
        if (F.G == 256 && F.bid >= 64) { PH_BEGIN(); moe_convert(F, args, 0, MOE_P1_HI, (F.bid - 64) * NWAVES + F.wave, 192 * NWAVES); }
    }
    SEAM(1);
    if (IN(2)) { PH_BEGIN();
        hyena_units(F, args);
        LAS float* gfx = (LAS float*)(F.lds + MISC_OFF + 3072);
        if (F.tid < 128) gfx[F.tid] = args.in[I_XQN][F.tid] * args.in[I_XKN][F.tid];
        __syncthreads();
        for (int u = F.bid; u < 256; u += F.G)
            cross_unit(F, (const bf16*)(ws + WS_XQ0), (const bf16*)(ws + WS_KV), gfx, (bf16*)(ws + WS_MIX0), u);
    }
    SEAM(2);
    if (IN(3)) { PH_BEGIN();
        if (F.al) { const int rank = F.vb >> 3; hy_transpose_tile(F, (((F.vb & 7) * 32 + 4 * (rank & 7) + (rank >> 3)) << 3) + F.wave); }
        else for (int t = F.vcu * NWAVES + F.wave; t < 2048; t += NGW) hy_transpose_tile(F, t); }
    SEAMP(3);
    if (IN(4)) { PH_BEGIN();
        if (F.al && ((F.vb >> 3) & 1)) { moe_convert(F, args, MOE_P5_MID, MOE_P12_LO, F.vb * NWAVES + F.wave, 256 * NWAVES); __syncthreads(); PH_BEGIN(); }
        pg8::Gemm g{(const bf16*)(ws + WS_MIX0), (const bf16*)(ws + WS_WO), D, D, D, 0};
        pg8::StaticOrder S; S.init(T / 256, 4, F.G, F.vb);
        EpiRes<false, true> E{nullptr, (const bf16*)(ws + WS_XB), D, (bf16*)(ws + WS_XB), D, (float*)(ws + WS_SSQ16)};
        pg8::gemm_phase<EpiRes<false, true>, pg8::StaticOrder, true>(ring, g, S, E, F.wave);
    }
    SEAMP(4);
    if (IN(5)) { PH_BEGIN();
        pg8::Gemm g{(const bf16*)(ws + WS_XB), (const bf16*)(ws + WS_WGU0), D, D, D, 0};
        pg8::StaticOrder S; S.init(T / 256, NGU / 256, F.G, F.vb);
        fill_rstd_table(F.lds, S, (const float*)(ws + WS_SSQ16), F.tid);
        EpiSwiglu<4> E{(bf16*)(ws + WS_HID0), FF, nullptr, (const LAS float*)(F.lds + RSL_OFF), 1.0f};
        pg8::gemm_phase<EpiSwiglu<4>, pg8::StaticOrder, true>(ring, g, S, E, F.wave);
        if (F.G == 256) { PH_BEGIN();
            if (F.vb >= 128) moe_convert(F, args, MOE_P1_HI, MOE_P5_MID, (F.vb - 128) * NWAVES + F.wave, 128 * NWAVES);
            if (!F.al) moe_convert(F, args, MOE_P5_MID, MOE_P12_LO, F.vb * NWAVES + F.wave, 256 * NWAVES); }
    }
    SEAMP(5);
    if (IN(6)) { PH_BEGIN();
        pg8::Gemm g{(const bf16*)(ws + WS_HID0), (const bf16*)(ws + WS_WD0), FF, FF, FF, 0};
        pg8::StaticOrder S; S.init(T / 256, 4, F.G, F.vb);
        EpiRes<false, true> E{nullptr, (const bf16*)(ws + WS_XB), D, (bf16*)(ws + WS_XB), D, (float*)(ws + WS_SSQ16)};
        pg8::gemm_phase<EpiRes<false, true>, pg8::StaticOrder, true>(ring, g, S, E, F.wave);
        if (F.al && !((F.vb >> 3) & 1)) { PH_BEGIN(); moe_convert(F, args, MOE_P5_MID, MOE_P12_LO, F.vb * NWAVES + F.wave, 256 * NWAVES); }
    }
    SEAM(6);
    if (IN(7)) { PH_BEGIN();
        pg8::Gemm g{(const bf16*)(ws + WS_XB), (const bf16*)(ws + WS_WIN1), D, D, D, 0};
        pg8::StaticOrder S; S.init(T / 256, NQ1 / 256, F.G, F.vb);
        fill_rstd_table(F.lds, S, (const float*)(ws + WS_SSQ16), F.tid);
        EpiB<4> E{(bf16*)(ws + WS_QKV1), NQKV, nullptr, NQKV / 256, (bf16*)(ws + WS_XQ1), 512, (const LAS float*)(F.lds + RSL_OFF), 1.0f};
        pg8::gemm_phase<EpiB<4>, pg8::StaticOrder, true>(ring, g, S, E, F.wave);
    }
    SEAM(7);
    if (IN(8)) { PH_BEGIN();
        LAS float* gfd = (LAS float*)(F.lds + MISC_OFF + 2560); LAS float* gfx = (LAS float*)(F.lds + MISC_OFF + 3072);
        if (F.tid < 128) { gfd[F.tid] = args.in[I_ATQN][F.tid] * args.in[I_ATKN][F.tid]; gfx[F.tid] = args.in[I_XQN][128 + F.tid] * args.in[I_XKN][128 + F.tid]; }
        __syncthreads();
        if (F.al) { for (int k = 0; k < 6; ++k) dil_unit(F, args, gfd, (F.vcu >> 5) * 192 + (F.vcu & 31) + 32 * k); }
        else for (int u = F.bid; u < NB * 4 * 48; u += F.G) dil_unit(F, args, gfd, u);
        for (int u = F.vcu; u < 256; u += F.G)
            cross_unit(F, (const bf16*)(ws + WS_XQ1), (const bf16*)(ws + WS_KV) + (size_t)TM * D, gfx, (bf16*)(ws + WS_MIX1), u);
    }
    SEAML(8);
    if (IN(9)) { PH_BEGIN();
        if (F.al) { const int rank = F.vb >> 3, tok0 = (F.vb & 7) * SEQ + 256 * (rank & 7) + 64 * (rank >> 3);
            for (int k = 0; k < 8; ++k) merge_token(F, tok0 + F.wave + 8 * k); }
        else for (int t = gw; t < T; t += NGW) merge_token(F, t); }
    SEAMP(9);
    if (IN(10)) { PH_BEGIN();
        pg8::Gemm g{(const bf16*)(ws + WS_MIX1), (const bf16*)(ws + WS_WO) + (size_t)D * D, D, D, D, 0};
        pg8::StaticOrder S; S.init(T / 256, 4, F.G, F.vb);
        EpiRes<false, false> E{nullptr, (const bf16*)(ws + WS_XB), D, (bf16*)args.out + 1024, 2048, nullptr};
        pg8::gemm_phase<EpiRes<false, false>, pg8::StaticOrder, true>(ring, g, S, E, F.wave);
    }
    SEAMP(10);
    if (IN(11)) { PH_BEGIN();
        if (F.al) { const int rank = F.vb >> 3; route_block(F, args, (F.vb & 7) * 32 + 4 * (rank & 7) + (rank >> 3)); }
        else for (int blk = F.vcu; blk < T / 64; blk += F.G) route_block(F, args, blk); }
    SEAM(11);
    if (IN(12)) { PH_BEGIN();
        moe_layout(F);
        pg8::Gemm g{(const bf16*)(ws + WS_XB3), (const bf16*)(ws + WS_WGU1), D / 2, D / 2, D / 2, (size_t)NGU * D};
        pg8::MoeOrder S; S.init(ml_total(F) / 256, NGU / 256, F.G, F.bid); S.lay = (const volatile LAS int*)(F.lds + MISC_OFF); S.list = (const int*)(ws + WS_LIST);
        S.t0 = ml_ps(F, 1) / 256; S.t1 = ml_ps(F, 2) / 256; S.t2 = ml_ps(F, 3) / 256; S.t3 = ml_ps(F, 4) / 256; S.t4 = ml_ps(F, 5) / 256; S.t5 = ml_ps(F, 6) / 256; S.t6 = ml_ps(F, 7) / 256;
        EpiSwiglu<5, true> E{(bf16*)(ws + WS_HID1), FF, nullptr, nullptr, 1.0f / MOE_WGU_SCALE};
        pg8::gemm_phase<EpiSwiglu<5, true>, pg8::MoeOrder, true, true, true>(ring, g, S, E, F.wave);
        if (F.G == 256) { PH_BEGIN();
            const int first = (ml_total(F) / 256) * (NGU / 256) - 11 * 256, f0 = first < 0 ? 0 : (first > 255 ? 255 : first);
            if (F.bid >= f0) moe_convert(F, args, MOE_P12_LO, N_MOE_ITEMS, (F.bid - f0) * NWAVES + F.wave, (256 - f0) * NWAVES); }
    }
    SEAM(12);
    if (IN(13)) { PH_BEGIN();
        moe_layout(F);
        const int nMt = ml_total(F) / 256;
        const int q1 = ml_ps(F, 1) / 256, q2 = ml_ps(F, 2) / 256, q3 = ml_ps(F, 3) / 256, q4 = ml_ps(F, 4) / 256, q5 = ml_ps(F, 5) / 256, q6 = ml_ps(F, 6) / 256, q7 = ml_ps(F, 7) / 256;
        {   pg8::Gemm g{(const bf16*)(ws + WS_HID1), (const bf16*)(ws + WS_WD1), FF / 2, FF / 2, FF / 2, (size_t)D * FF};
            pg8::MoeOrder S; S.init(nMt < 128 ? nMt : 128, 4, F.G, F.bid); S.lay = nullptr; S.list = nullptr;
            S.t0 = q1; S.t1 = q2; S.t2 = q3; S.t3 = q4; S.t4 = q5; S.t5 = q6; S.t6 = q7;
            EpiB<5> E{(bf16*)(ws + WS_XS), D, nullptr, 1 << 30, nullptr, 0, nullptr, 1.0f / MOE_WD_SCALE};
            pg8::gemm_phase<EpiB<5>, pg8::MoeOrder, true, false, true>(ring, g, S, E, F.wave); }
        if (nMt > 128) {
            const int half = F.G / 2; const bool second = F.bid >= half;
            pg8::Gemm g{(const bf16*)(ws + WS_HID1), (const bf16*)(ws + WS_WD1), FF / 2, FF / 2, second ? 640 : 768, (size_t)D * FF};
            pg8::MoeTailOrder2 S; S.pm0 = 128; S.ntail = nMt - 128; S.nN = 4; S.G = second ? F.G - half : half; S.c = second ? F.bid - half : F.bid; S.koff = second ? 12 * 128 : 0;
            S.t0 = q1; S.t1 = q2; S.t2 = q3; S.t3 = q4; S.t4 = q5; S.t5 = q6; S.t6 = q7;
            EpiB<5> E{(bf16*)(ws + WS_XS), D, nullptr, 1 << 30, (bf16*)(ws + WS_Y2) - (size_t)2 * T * D, D, nullptr, 1.0f / MOE_WD_SCALE};
            pg8::gemm_phase<EpiB<5>, pg8::MoeTailOrder2, true, false, true>(ring, g, S, E, F.wave); }
    }
    SEAM(13);
    if (IN(14)) { PH_BEGIN(); combine_phase(F, args); }
#undef IN
#undef SEAM
}

#ifndef MK_ONE_LAUNCH
#define MK_ONE_LAUNCH 1
#endif
extern "C" void kernel_launch(void* const* d_in, const int* in_sizes, int n_in, void* d_out, int out_size, void* d_ws, size_t ws_size, hipStream_t stream) {
    static int grid = 0;
    if (grid == 0) {
        if (n_in != 30 || in_sizes[0] != T * D || out_size != T * D || ws_size < WS_END) {
            fprintf(stderr, "kernel_launch: unexpected problem (n_in %d, in0 %d, out %d, ws %zu, need %zu); nothing launched\n", n_in, n_in > 0 ? in_sizes[0] : -1, out_size, ws_size, (size_t)WS_END); grid = -1; return; }
        int dev = 0, cus = 0, per_cu = 0;
        if (hipGetDevice(&dev) != hipSuccess || hipDeviceGetAttribute(&cus, hipDeviceAttributeMultiprocessorCount, dev) != hipSuccess) { grid = -1; return; }
        if (hipFuncSetAttribute((const void*)mega_fwd, hipFuncAttributeMaxDynamicSharedMemorySize, LDS_BYTES) != hipSuccess) { fprintf(stderr, "kernel_launch: hipFuncSetAttribute failed\n"); grid = -1; return; }
        if (hipOccupancyMaxActiveBlocksPerMultiprocessor(&per_cu, (const void*)mega_fwd, NWAVES * 64, LDS_BYTES) != hipSuccess || per_cu < 1)
            fprintf(stderr, "kernel_launch: note: occupancy query reports %d workgroups per CU\n", per_cu);
        (void)hipGetLastError();
        grid = cus;
    }
    if (grid < 0) return;
    if (hipMemsetAsync((char*)d_ws + WS_CTL, 0, CTL_ZERO_BYTES, stream) != hipSuccess) return;
    Args a{};
    for (int i = 0; i < 30; ++i) a.in[i] = (const float*)d_in[i];
    a.out = (float*)d_out; a.ws = (unsigned char*)d_ws;
#if defined(PROBE_PHASE)
    a.ph_lo = 0; a.ph_hi = PROBE_PHASE + 1; a.bslot = 0;
    hipLaunchKernelGGL(mega_fwd, dim3(grid), dim3(NWAVES * 64), LDS_BYTES, stream, a);
    a.ph_lo = PROBE_PHASE; a.ph_hi = NPHASE; a.bslot = 1;
    hipLaunchKernelGGL(mega_fwd, dim3(grid), dim3(NWAVES * 64), LDS_BYTES, stream, a);
#elif MK_ONE_LAUNCH
    a.ph_lo = 0; a.ph_hi = NPHASE; a.bslot = 0;
    hipLaunchKernelGGL(mega_fwd, dim3(grid), dim3(NWAVES * 64), LDS_BYTES, stream, a);
#else
    for (int p = 0; p < NPHASE; ++p) { a.ph_lo = p; a.ph_hi = p + 1; a.bslot = 0; hipLaunchKernelGGL(mega_fwd, dim3(grid), dim3(NWAVES * 64), LDS_BYTES, stream, a); }
#endif
}
```
